# Optimizing an MI355X kernel written in HIP

```python
import math
import jax, jax.numpy as jnp
from jax import lax
import numpy as np


D_MODEL = 1024
BATCH = 32
SEQ = 2048
DEPTH = 2
DEC_BATCH = 8
DEC_SEQ = 32
PAST_LEN = 1024

CHUNK = 64
Q_BLOCK = 128
DA_HEADS = 4
DA_HD = 64
DA_QK = 2 * DA_HD
DA_VD = 2 * DA_HD
DA_WIDTH = DA_HEADS * DA_VD
M_HEADS = 4
M_HD = 128
M_WIDTH = M_HEADS * M_HD
CONV_W = 4
D_FF = -(-8 * D_MODEL // (3 * 256)) * 256
IN_SIZES = (DA_HEADS * DA_QK, DA_HEADS * DA_QK, DA_WIDTH, 2 * M_WIDTH, M_WIDTH, 2 * M_HEADS, M_WIDTH)
IN_COLS = int(sum(IN_SIZES))
IN_SPLITS = tuple(int(v) for v in np.cumsum(IN_SIZES)[:-1])
ALPHA = (2 * DEPTH) ** 0.25
BETA = (8 * DEPTH) ** -0.25
LN_EPS = 1e-5
F32 = jnp.float32

kernel_name = 'diffattn_mlstm_streaming_encoder_step'


def layer_norm(x, g=None, b=None):
    xf = x.astype(F32)
    mu = xf.mean(-1, keepdims=True)
    var = jnp.mean(jnp.square(xf - mu), -1, keepdims=True)
    y = (xf - mu) * lax.rsqrt(var + LN_EPS)
    if g is not None:
        y = y * g.astype(F32) + b.astype(F32)
    return y.astype(x.dtype)


def head_norm(h, g, center):
    hf = h.astype(F32)
    if center:
        hf = hf - hf.mean(-1, keepdims=True)
    y = hf * lax.rsqrt(jnp.mean(hf * hf, -1, keepdims=True) + LN_EPS)
    return y.reshape(*h.shape[:-2], -1) * g.astype(F32)


def alibi_slopes(n):
    return jnp.asarray([2.0 ** (-8.0 * (i + 1) / n) for i in range(n)], F32)


def diff_attention(q, k, v, q_pos, k_pos, lam):
    s = jnp.einsum('bqhcd,bkhcd->bhcqk', q.astype(F32), k.astype(F32)) * (DA_HD ** -0.5)
    dist = jnp.abs(q_pos[:, None] - k_pos[None, :]).astype(F32)
    bias = -alibi_slopes(DA_HEADS)[:, None, None, None] * dist
    visible = (k_pos[None, :] // CHUNK) <= (q_pos[:, None] // CHUNK)
    s = jnp.where(visible, s + bias, -jnp.inf)
    p = jax.nn.softmax(s, axis=-1)
    w = p[:, :, 0] - lam * p[:, :, 1]
    return jnp.einsum('bhqk,bkhd->bqhd', w, v.astype(F32))


def diff_attention_prompt(q, k, v, lam):
    B, S = q.shape[0], q.shape[1]
    nblk = S // Q_BLOCK
    k_pos = jnp.arange(S)
    qb = q.reshape(B, nblk, Q_BLOCK, *q.shape[2:]).swapaxes(0, 1)

    def one_block(args):
        q_blk, i = args
        q_pos = i * Q_BLOCK + jnp.arange(Q_BLOCK)
        return diff_attention(q_blk, k, v, q_pos, k_pos, lam)

    out = lax.map(one_block, (qb, jnp.arange(nblk)))
    return out.swapaxes(0, 1).reshape(B, S, DA_HEADS, DA_VD)


def mlstm_chunk(state, inp):
    C, n, m = state
    q, k, v, ig, lf = inp
    L = q.shape[1]
    b = jnp.cumsum(lf, axis=1)
    Dm = b[:, :, None, :] - b[:, None, :, :] + ig[:, None, :, :]
    causal = jnp.tril(jnp.ones((L, L), dtype=bool))
    Dm = jnp.where(causal[None, :, :, None], Dm, -jnp.inf)
    inter = b + m[:, None, :]
    m_t = jnp.maximum(inter, Dm.max(axis=2))
    w_intra = jnp.exp(Dm - m_t[:, :, None, :])
    w_inter = jnp.exp(inter - m_t)
    qk = jnp.einsum('bthd,bshd->btsh', q, k) * w_intra
    num = jnp.einsum('btsh,bshd->bthd', qk, v) + w_inter[..., None] * jnp.einsum('bhvd,bthd->bthv', C, q)
    den = qk.sum(axis=2) + w_inter * jnp.einsum('bhd,bthd->bth', n, q)
    h = num / jnp.maximum(jnp.abs(den), jnp.exp(-m_t))[..., None]
    bL = b[:, -1]
    dec_s = bL[:, None, :] - b + ig
    m_new = jnp.maximum(bL + m, dec_s.max(axis=1))
    ws = jnp.exp(dec_s - m_new[:, None, :])
    wc = jnp.exp(bL + m - m_new)
    C_new = wc[..., None, None] * C + jnp.einsum('bsh,bshv,bshd->bhvd', ws, v, k)
    n_new = wc[..., None] * n + jnp.einsum('bsh,bshd->bhd', ws, k)
    return (C_new, n_new, m_new), h


def mlstm_prompt(q, k, v, ig, lf):
    B, S = q.shape[0], q.shape[1]
    nc = S // CHUNK

    def chunks(a):
        return a.reshape(B, nc, CHUNK, *a.shape[2:]).swapaxes(0, 1)

    init = (jnp.zeros((B, M_HEADS, M_HD, M_HD), F32), jnp.zeros((B, M_HEADS, M_HD), F32),
            jnp.zeros((B, M_HEADS), F32))
    state, h = lax.scan(mlstm_chunk, init, (chunks(q), chunks(k), chunks(v), chunks(ig), chunks(lf)))
    return h.swapaxes(0, 1).reshape(B, S, M_HEADS, M_HD), state


def causal_conv(u, buf, w, b):
    T = u.shape[1]
    full = jnp.concatenate([buf.astype(u.dtype), u], axis=1)
    y = b
    for j in range(CONV_W):
        y = y + full[:, j:j + T] * w[j]
    return jax.nn.silu(y), full[:, -(CONV_W - 1):]


def trunk_layer(x, c, layer, attend, recur, conv_buf,
                w_ada, b_ada, w_in, b_if, conv_w, conv_b, lam_p, da_norm_w, m_norm_w,
                w_br_a, w_br_b, w_gate, b_gate, w_o, ln1_g, ln1_b, w_gu, w_down, ln2_g, ln2_b):
    B, T, _ = x.shape
    mod = jnp.einsum('bd,de->be', jax.nn.silu(c), w_ada) + b_ada
    sh1, sc1, g1, sh2, sc2, g2 = jnp.split(mod[:, None, :], 6, axis=-1)
    h = layer_norm(x) * (1 + sc1) + sh1
    z = jnp.einsum('btd,de->bte', h, w_in)
    a_q, a_k, a_v, m_qk, m_v, m_if, m_o = jnp.split(z, IN_SPLITS, axis=-1)
    aq = a_q.reshape(B, T, DA_HEADS, 2, DA_HD)
    ak = a_k.reshape(B, T, DA_HEADS, 2, DA_HD)
    av = a_v.reshape(B, T, DA_HEADS, DA_VD)
    lam_init = 0.8 - 0.6 * math.exp(-0.3 * layer)
    lp = lam_p.astype(F32)
    lam = jnp.exp(jnp.sum(lp[0] * lp[1])) - jnp.exp(jnp.sum(lp[2] * lp[3])) + lam_init
    a_out = attend(aq, ak, av, lam)
    qk_c, conv_state = causal_conv(m_qk, conv_buf, conv_w, conv_b)
    mq, mk = jnp.split(qk_c, 2, axis=-1)
    mq = mq.reshape(B, T, M_HEADS, M_HD).astype(F32)
    mk = mk.reshape(B, T, M_HEADS, M_HD).astype(F32) * (M_HD ** -0.5)
    mv = m_v.reshape(B, T, M_HEADS, M_HD).astype(F32)
    gates = (m_if + b_if).astype(F32)
    ig = gates[..., :M_HEADS]
    lf = jax.nn.log_sigmoid(gates[..., M_HEADS:])
    m_out, m_state = recur(mq, mk, mv, ig, lf)
    a_n = head_norm(a_out, da_norm_w, False) * (1.0 - lam_init)
    m_n = head_norm(m_out, m_norm_w, True) * jax.nn.sigmoid(m_o.astype(F32))
    y_a = a_n.astype(x.dtype) @ w_br_a
    y_b = m_n.astype(x.dtype) @ w_br_b
    g_a, g_b = jnp.split(jax.nn.sigmoid(h @ w_gate + b_gate), 2, axis=-1)
    mix = (g_a * y_a + g_b * y_b) @ w_o
    x = layer_norm(ALPHA * x + (1 + g1) * mix, ln1_g, ln1_b)
    h2 = layer_norm(x) * (1 + sc2) + sh2
    gt, up = jnp.split(h2 @ w_gu, 2, axis=-1)
    ffn = (jax.nn.silu(gt) * up) @ w_down
    x = layer_norm(ALPHA * x + (1 + g2) * ffn, ln2_g, ln2_b)
    k_rows = ak.reshape(B, T, DA_HEADS, DA_QK)
    return x.astype(c.dtype), k_rows, av, m_state, conv_state


def setup_inputs(seed: int = 0) -> dict:
    key = jax.random.key(seed)
    ks = iter(jax.random.split(key, 48))

    def nrm(shape, s):
        return jax.random.normal(next(ks), shape, F32) * s

    col_scale = np.ones((IN_COLS,), np.float32)
    off = np.cumsum((0,) + IN_SIZES)
    col_scale[off[2]:off[3]] = BETA
    col_scale[off[4]:off[5]] = BETA
    b_if = jnp.concatenate([nrm((DEPTH, M_HEADS), 0.1),
                            jnp.broadcast_to(jnp.linspace(3.0, 6.0, M_HEADS), (DEPTH, M_HEADS)) + nrm((DEPTH, M_HEADS), 0.1)], -1)
    return {
        'x_prompt': nrm((BATCH, SEQ, D_MODEL), 1.0),
        'x_sample': nrm((DEC_BATCH, DEC_SEQ, D_MODEL), 1.0),
        'c_prompt': nrm((BATCH, D_MODEL), 1.0),
        'c_sample': nrm((DEC_BATCH, D_MODEL), 1.0),
        'cache_attn_k': nrm((DEPTH, DEC_BATCH, PAST_LEN, DA_HEADS, DA_QK), 1.0),
        'cache_attn_v': nrm((DEPTH, DEC_BATCH, PAST_LEN, DA_HEADS, DA_VD), 0.5),
        'state_mlstm_C': nrm((DEPTH, DEC_BATCH, M_HEADS, M_HD, M_HD), 0.3),
        'state_mlstm_n': nrm((DEPTH, DEC_BATCH, M_HEADS, M_HD), 0.3),
        'state_mlstm_m': nrm((DEPTH, DEC_BATCH, M_HEADS), 1.0),
        'state_mlstm_conv': nrm((DEPTH, DEC_BATCH, CONV_W - 1, 2 * M_WIDTH), 1.0),
        'w_ada': nrm((DEPTH, D_MODEL, 6 * D_MODEL), 0.2 * D_MODEL ** -0.5),
        'b_ada': nrm((DEPTH, 6 * D_MODEL), 0.01),
        'w_in': nrm((DEPTH, D_MODEL, IN_COLS), D_MODEL ** -0.5) * jnp.asarray(col_scale),
        'b_if': b_if,
        'conv_w': nrm((DEPTH, CONV_W, 2 * M_WIDTH), CONV_W ** -0.5),
        'conv_b': nrm((DEPTH, 2 * M_WIDTH), 0.01),
        'lam_p': nrm((DEPTH, 4, DA_HD), 0.1),
        'da_norm_w': 1.0 + nrm((DEPTH, DA_WIDTH), 0.02),
        'm_norm_w': 1.0 + nrm((DEPTH, M_WIDTH), 0.02),
        'w_br_a': nrm((DEPTH, DA_WIDTH, D_MODEL), BETA * DA_WIDTH ** -0.5),
        'w_br_b': nrm((DEPTH, M_WIDTH, D_MODEL), BETA * M_WIDTH ** -0.5),
        'w_gate': nrm((DEPTH, D_MODEL, 2 * D_MODEL), D_MODEL ** -0.5),
        'b_gate': nrm((DEPTH, 2 * D_MODEL), 0.01),
        'w_o': nrm((DEPTH, D_MODEL, D_MODEL), BETA * D_MODEL ** -0.5),
        'ln1_g': 1.0 + nrm((DEPTH, D_MODEL), 0.02),
        'ln1_b': nrm((DEPTH, D_MODEL), 0.01),
        'w_gu': nrm((DEPTH, D_MODEL, 2 * D_FF), D_MODEL ** -0.5),
        'w_down': nrm((DEPTH, D_FF, D_MODEL), BETA * D_FF ** -0.5),
        'ln2_g': 1.0 + nrm((DEPTH, D_MODEL), 0.02),
        'ln2_b': nrm((DEPTH, D_MODEL), 0.01),
    }


def reference(x_prompt, x_sample, c_prompt, c_sample, cache_attn_k, cache_attn_v,
              state_mlstm_C, state_mlstm_n, state_mlstm_m, state_mlstm_conv,
              w_ada, b_ada, w_in, b_if, conv_w, conv_b, lam_p, da_norm_w, m_norm_w,
              w_br_a, w_br_b, w_gate, b_gate, w_o, ln1_g, ln1_b, w_gu, w_down, ln2_g, ln2_b):
    xp, xs = x_prompt, x_sample
    Bp = xp.shape[0]
    Bs, Ts = xs.shape[0], xs.shape[1]
    P = cache_attn_k.shape[2]
    kp_l, vp_l, Cp_l, np_l, mp_l, cvp_l = [], [], [], [], [], []
    ks_l, vs_l, Cs_l, ns_l, ms_l, cvs_l = [], [], [], [], [], []
    for l in range(DEPTH):
        weights = (w_ada[l], b_ada[l], w_in[l], b_if[l], conv_w[l], conv_b[l], lam_p[l], da_norm_w[l],
                   m_norm_w[l], w_br_a[l], w_br_b[l], w_gate[l], b_gate[l], w_o[l], ln1_g[l], ln1_b[l],
                   w_gu[l], w_down[l], ln2_g[l], ln2_b[l])
        conv0 = jnp.zeros((Bp, CONV_W - 1, 2 * M_WIDTH), xp.dtype)
        xp, k_new, v_new, (C_f, n_f, m_f), cv = trunk_layer(
            xp, c_prompt, l, diff_attention_prompt, mlstm_prompt, conv0, *weights)
        kp_l.append(k_new); vp_l.append(v_new); Cp_l.append(C_f); np_l.append(n_f); mp_l.append(m_f); cvp_l.append(cv)

        ck = cache_attn_k[l].reshape(Bs, P, DA_HEADS, 2, DA_HD)
        cvv = cache_attn_v[l]

        def attend_sample(q, k, v, lam, ck=ck, cvv=cvv):
            k_all = jnp.concatenate([ck.astype(k.dtype), k], axis=1)
            v_all = jnp.concatenate([cvv.astype(v.dtype), v], axis=1)
            q_pos = P + jnp.arange(Ts)
            k_pos = jnp.arange(P + Ts)
            return diff_attention(q, k_all, v_all, q_pos, k_pos, lam)

        st = (state_mlstm_C[l].astype(F32), state_mlstm_n[l].astype(F32), state_mlstm_m[l].astype(F32))

        def recur_sample(q, k, v, ig, lf, st=st):
            st_new, h = mlstm_chunk(st, (q, k, v, ig, lf))
            return h, st_new

        xs, k_new, v_new, (C_f, n_f, m_f), cv = trunk_layer(
            xs, c_sample, l, attend_sample, recur_sample, state_mlstm_conv[l], *weights)
        ks_l.append(k_new); vs_l.append(v_new); Cs_l.append(C_f); ns_l.append(n_f); ms_l.append(m_f); cvs_l.append(cv)

    attn_k_prompt = jnp.stack(kp_l); attn_v_prompt = jnp.stack(vp_l)
    attn_k_sample = jnp.stack(ks_l); attn_v_sample = jnp.stack(vs_l)
    mlstm_C_prompt = jnp.stack(Cp_l); mlstm_n_prompt = jnp.stack(np_l)
    mlstm_m_prompt = jnp.stack(mp_l); mlstm_conv_prompt = jnp.stack(cvp_l)
    mlstm_C_sample = jnp.stack(Cs_l); mlstm_n_sample = jnp.stack(ns_l)
    mlstm_m_sample = jnp.stack(ms_l); mlstm_conv_sample = jnp.stack(cvs_l)
    return (xp, xs, attn_k_prompt, attn_v_prompt, attn_k_sample, attn_v_sample,
            mlstm_C_prompt, mlstm_n_prompt, mlstm_m_prompt, mlstm_conv_prompt,
            mlstm_C_sample, mlstm_n_sample, mlstm_m_sample, mlstm_conv_sample)
```

```cpp
#include <hip/hip_runtime.h>
#include <hip/hip_cooperative_groups.h>
#include <cstdio>
namespace cg = cooperative_groups;

#define DI __device__ __forceinline__
typedef unsigned short u16;
using bf16x8 = __attribute__((ext_vector_type(8))) short;
using f32x16 = __attribute__((ext_vector_type(16))) float;
#define MFMA(a, b, c) __builtin_amdgcn_mfma_f32_32x32x16_bf16((a), (b), (c), 0, 0, 0)

constexpr int TOKP = 65536, TOKS = 256, TOK = 65792;
constexpr int NTHR = 512;
constexpr float LN_EPS = 1e-5f;
constexpr float ALPHA = 1.41421356237f;
constexpr float LOG2E = 1.44269504089f;

constexpr size_t WS_WT_IN   = 0;
constexpr size_t WS_WT_GATE = WS_WT_IN + 2ull * 3584 * 1024 * 2;
constexpr size_t WS_WT_BRA  = WS_WT_GATE + 2ull * 2048 * 1024 * 2;
constexpr size_t WS_WT_BRB  = WS_WT_BRA + 2ull * 1024 * 512 * 2;
constexpr size_t WS_WT_O    = WS_WT_BRB + 2ull * 1024 * 512 * 2;
constexpr size_t WS_WT_GU   = WS_WT_O + 2ull * 1024 * 1024 * 2;
constexpr size_t WS_WT_DOWN = WS_WT_GU + 2ull * 5632 * 1024 * 2;
constexpr size_t WS_MOD     = WS_WT_DOWN + 2ull * 1024 * 2816 * 2;
constexpr size_t WS_GATES   = WS_MOD + 2ull * 40 * 6144 * 4;
constexpr size_t WS_CTR     = WS_GATES + (size_t)TOK * 8 * 4;
constexpr size_t WS_KS      = WS_CTR + 256;
constexpr size_t WS_VTS     = WS_KS + 2ull * 8 * 1056 * 512 * 2 + 65536;
constexpr size_t WS_MQKT_S  = WS_VTS + 2ull * 8 * 512 * 1056 * 2 + 65536;
constexpr size_t WS_MVT_S   = WS_MQKT_S + 8ull * 1024 * 32 * 2;
constexpr size_t WS_H       = WS_MVT_S + 8ull * 512 * 32 * 2;
constexpr size_t WS_AN      = WS_H;
constexpr size_t WS_MN      = WS_H + (size_t)TOK * 512 * 2;
constexpr size_t WS_ZQ      = WS_H + (size_t)TOK * 1024 * 2;
constexpr size_t WS_KB      = WS_ZQ + (size_t)TOK * 512 * 2;
constexpr size_t WS_VTP     = WS_KB + (size_t)TOKP * 512 * 2;
constexpr size_t WS_MQKT_P  = WS_VTP + 32ull * 512 * 2048 * 2;
constexpr size_t WS_MVT_P   = WS_MQKT_P + 32ull * 1024 * 2048 * 2;
constexpr size_t WS_MO      = WS_MVT_P + 32ull * 512 * 2048 * 2;
constexpr size_t WS_G       = WS_MO + (size_t)TOK * 512 * 2;
constexpr size_t WS_END     = WS_G + (size_t)TOK * 2048 * 2;
constexpr size_t WS_MIX     = WS_ZQ;
constexpr size_t WS_ACT     = WS_ZQ;

constexpr size_t O_YP  = 0;
constexpr size_t O_YS  = O_YP + (size_t)TOKP * 1024;
constexpr size_t O_KP  = O_YS + (size_t)TOKS * 1024;
constexpr size_t O_VP  = O_KP + 2ull * TOKP * 512;
constexpr size_t O_KSM = O_VP + 2ull * TOKP * 512;
constexpr size_t O_VSM = O_KSM + 2ull * TOKS * 512;
constexpr size_t O_CP  = O_VSM + 2ull * TOKS * 512;
constexpr size_t O_NP  = O_CP + 2ull * 32 * 4 * 128 * 128;
constexpr size_t O_MP  = O_NP + 2ull * 32 * 4 * 128;
constexpr size_t O_CVP = O_MP + 2ull * 32 * 4;
constexpr size_t O_CS  = O_CVP + 2ull * 32 * 3 * 1024;
constexpr size_t O_NS  = O_CS + 2ull * 8 * 4 * 128 * 128;
constexpr size_t O_MS  = O_NS + 2ull * 8 * 4 * 128;
constexpr size_t O_CVS = O_MS + 2ull * 8 * 4;

constexpr int LDS_BYTES = 143360;

struct Params {
  const float* in[30];
  float* out;
  unsigned char* ws;
};

DI u16 f2bf(float x) { unsigned u = __float_as_uint(x); u += 0x7fffu + ((u >> 16) & 1u); return (u16)(u >> 16); }
DI float bf2f(unsigned v) { return __uint_as_float(v << 16); }
DI unsigned pack2(float a, float b) { return (unsigned)f2bf(a) | ((unsigned)f2bf(b) << 16); }
DI float bflo(unsigned v) { return __uint_as_float(v << 16); }
DI float bfhi(unsigned v) { return __uint_as_float(v & 0xffff0000u); }
DI float sigmoidf_(float x) { return 1.f / (1.f + __expf(-x)); }
DI float siluf_(float x) { return x / (1.f + __expf(-x)); }
DI float fexp2(float x) { return __builtin_amdgcn_exp2f(x); }
DI int otid() { int t = threadIdx.x; asm volatile("" : "+v"(t)); return t; }
DI float shx(float v, int mask, int lane) { return __int_as_float(__builtin_amdgcn_ds_bpermute(((lane ^ mask) & 63) << 2, __float_as_int(v))); }
DI float shidx(float v, int src, int lane) { (void)lane; return __int_as_float(__builtin_amdgcn_ds_bpermute((src & 63) << 2, __float_as_int(v))); }
DI int crow(int i, int h) { return (i & 3) + 8 * (i >> 2) + 4 * h; }
DI bf16x8 pack8(const f32x16& x, int s) {
  uint4 u;
  u.x = pack2(x[8 * s + 0], x[8 * s + 1]); u.y = pack2(x[8 * s + 2], x[8 * s + 3]);
  u.z = pack2(x[8 * s + 4], x[8 * s + 5]); u.w = pack2(x[8 * s + 6], x[8 * s + 7]);
  return __builtin_bit_cast(bf16x8, u);
}
DI void zero16(f32x16& a) {
#pragma unroll
  for (int i = 0; i < 16; ++i) a[i] = 0.f;
}
DI int batch_of_row(int row) { return row < TOKP ? (row >> 11) : 32 + ((row - TOKP) >> 5); }

constexpr int GS_STRIDE = 144;
constexpr int GS_STAGE = (256 + 128) * GS_STRIDE;
constexpr int GS_BASE = 64;

DI void gemm_mainloop(f32x16 (&acc)[2][2], const u16* __restrict__ A, int lda, const u16* __restrict__ Wt, int ldw, int K,
                      int m0, int n0, unsigned char* smem) {
  const int tid = otid(), lane = tid & 63, w = tid >> 6;
  const int wm = w >> 1, wn = w & 1, r = lane & 31, h = lane >> 5;
  const int lrow = tid >> 3, lcc = tid & 7;
  const u16* ap = A + (size_t)(m0 + lrow) * lda + lcc * 8;
  const int bn = n0 + 2 * (lrow & 31) + ((lrow >> 5) & 1);
  const u16* bp = Wt + (size_t)bn * ldw + lcc * 8;
  const size_t astep = (size_t)64 * lda, bstep = (size_t)64 * ldw;
  unsigned char* sbase = smem + GS_BASE;
  const int woff = lrow * GS_STRIDE + lcc * 16;
  uint4 ra[4], rb[2];
#pragma unroll
  for (int i = 0; i < 4; ++i) ra[i] = *(const uint4*)(ap + i * astep);
#pragma unroll
  for (int i = 0; i < 2; ++i) rb[i] = *(const uint4*)(bp + i * bstep);
#pragma unroll
  for (int i = 0; i < 4; ++i) *(uint4*)(sbase + woff + i * 64 * GS_STRIDE) = ra[i];
#pragma unroll
  for (int i = 0; i < 2; ++i) *(uint4*)(sbase + 256 * GS_STRIDE + woff + i * 64 * GS_STRIDE) = rb[i];
  __syncthreads();
  const int nk = K >> 6;
  const int aoff = (wm * 64 + r) * GS_STRIDE + h * 16;
  const int boff = 256 * GS_STRIDE + (wn * 64 + r) * GS_STRIDE + h * 16;
  for (int kt = 0; kt < nk; ++kt) {
    const bool more = (kt + 1 < nk);
    if (more) {
      ap += 64; bp += 64;
#pragma unroll
      for (int i = 0; i < 4; ++i) ra[i] = *(const uint4*)(ap + i * astep);
#pragma unroll
      for (int i = 0; i < 2; ++i) rb[i] = *(const uint4*)(bp + i * bstep);
    }
    const unsigned char* st = sbase + (kt & 1) * GS_STAGE;
#pragma unroll
    for (int ks = 0; ks < 4; ++ks) {
      bf16x8 a0 = *(const bf16x8*)(st + aoff + ks * 32);
      bf16x8 a1 = *(const bf16x8*)(st + aoff + 32 * GS_STRIDE + ks * 32);
      bf16x8 b0 = *(const bf16x8*)(st + boff + ks * 32);
      bf16x8 b1 = *(const bf16x8*)(st + boff + 32 * GS_STRIDE + ks * 32);
      acc[0][0] = MFMA(a0, b0, acc[0][0]);
      acc[0][1] = MFMA(a0, b1, acc[0][1]);
      acc[1][0] = MFMA(a1, b0, acc[1][0]);
      acc[1][1] = MFMA(a1, b1, acc[1][1]);
    }
    if (more) {
      unsigned char* sn = sbase + ((kt + 1) & 1) * GS_STAGE;
#pragma unroll
      for (int i = 0; i < 4; ++i) *(uint4*)(sn + woff + i * 64 * GS_STRIDE) = ra[i];
#pragma unroll
      for (int i = 0; i < 2; ++i) *(uint4*)(sn + 256 * GS_STRIDE + woff + i * 64 * GS_STRIDE) = rb[i];
    }
    __syncthreads();
  }
}

DI int map_row(int maptype, int s) {
  if (maptype == 1) return s < 3072 ? s : (s < 3080 ? -1 : s - 8);
  if (maptype == 2) return s < 2816 ? 2 * s : 2 * (s - 2816) + 1;
  return s;
}
DI void transpose_task(const float* __restrict__ src, int Nsrc, u16* __restrict__ dst, int dld, int maptype, int kt, int nt,
                       unsigned char* smem) {
  float* tile = (float*)(smem + 64);
  const int tid = otid();
  const int k0 = kt * 64, s0 = nt * 64;
#pragma unroll
  for (int i = 0; i < 2; ++i) {
    const int kr = (tid >> 4) + 32 * i, nc = (tid & 15) * 4;
    float4 v = make_float4(0.f, 0.f, 0.f, 0.f);
    if (s0 + nc < Nsrc) v = *(const float4*)(src + (size_t)(k0 + kr) * Nsrc + s0 + nc);
    tile[kr * 65 + nc + 0] = v.x; tile[kr * 65 + nc + 1] = v.y; tile[kr * 65 + nc + 2] = v.z; tile[kr * 65 + nc + 3] = v.w;
  }
  __syncthreads();
  {
    const int n = tid >> 3, kc = (tid & 7) * 8;
    const int s = s0 + n;
    const int dr = (s < Nsrc) ? map_row(maptype, s) : -1;
    if (dr >= 0) {
      uint4 o;
      o.x = pack2(tile[(kc + 0) * 65 + n], tile[(kc + 1) * 65 + n]);
      o.y = pack2(tile[(kc + 2) * 65 + n], tile[(kc + 3) * 65 + n]);
      o.z = pack2(tile[(kc + 4) * 65 + n], tile[(kc + 5) * 65 + n]);
      o.w = pack2(tile[(kc + 6) * 65 + n], tile[(kc + 7) * 65 + n]);
      *(uint4*)(dst + (size_t)dr * dld + k0 + kc) = o;
    }
  }
  __syncthreads();
}

DI void adaln_task(const Params& p, int task, unsigned char* smem) {
  const int bhalf = task & 1, cg_ = (task >> 1) % 96, l = (task >> 1) / 96;
  float* cs = (float*)(smem + 64);
  float* red = (float*)(smem + 64 + 20 * 1024 * 4);
  const int tid = otid();
  const float* cp = p.in[2]; const float* csm = p.in[3];
  for (int idx = tid; idx < 20 * 1024; idx += NTHR) {
    const int bb = idx >> 10, d = idx & 1023, b = bhalf * 20 + bb;
    const float c = b < 32 ? cp[b * 1024 + d] : csm[(b - 32) * 1024 + d];
    cs[idx] = siluf_(c);
  }
  __syncthreads();
  const int dseg = tid >> 6, e = cg_ * 64 + (tid & 63);
  const float* wp = p.in[10] + ((size_t)l * 1024 + dseg * 128) * 6144 + e;
  float acc[20];
#pragma unroll
  for (int i = 0; i < 20; ++i) acc[i] = 0.f;
  for (int d = 0; d < 128; ++d) {
    const float wv = wp[(size_t)d * 6144];
    const float* c0 = cs + dseg * 128 + d;
#pragma unroll
    for (int i = 0; i < 20; ++i) acc[i] += c0[i * 1024] * wv;
  }
#pragma unroll
  for (int i = 0; i < 20; ++i) red[(dseg * 20 + i) * 64 + (tid & 63)] = acc[i];
  __syncthreads();
  float* mod = (float*)(p.ws + WS_MOD);
  for (int idx = tid; idx < 20 * 64; idx += NTHR) {
    const int bb = idx >> 6, ec = idx & 63;
    float s = 0.f;
#pragma unroll
    for (int q = 0; q < 8; ++q) s += red[(q * 20 + bb) * 64 + ec];
    const int ee = cg_ * 64 + ec;
    mod[((size_t)l * 40 + bhalf * 20 + bb) * 6144 + ee] = s + p.in[11][l * 6144 + ee];
  }
  __syncthreads();
}

DI void prologue(const Params& p, unsigned char* smem) {
  const int WT_TASKS_L = 912 + 512 + 128 + 128 + 256 + 1408 + 704;
  const int N_WT = 2 * WT_TASKS_L;
  const int N_ADA = 384, N_CK = 512, N_CV = 2048;
  const int total = N_WT + N_ADA + N_CK + N_CV;
  for (int task = blockIdx.x; task < total; task += gridDim.x) {
    if (task < N_WT) {
      const int l = task / WT_TASKS_L; int t = task % WT_TASKS_L;
      if (t < 912) { transpose_task(p.in[12] + (size_t)l * 1024 * 3592, 3592, (u16*)(p.ws + WS_WT_IN) + (size_t)l * 3584 * 1024, 1024, 1, t / 57, t % 57, smem); continue; }
      t -= 912;
      if (t < 512) { transpose_task(p.in[21] + (size_t)l * 1024 * 2048, 2048, (u16*)(p.ws + WS_WT_GATE) + (size_t)l * 2048 * 1024, 1024, 0, t / 32, t % 32, smem); continue; }
      t -= 512;
      if (t < 128) { transpose_task(p.in[19] + (size_t)l * 512 * 1024, 1024, (u16*)(p.ws + WS_WT_BRA) + (size_t)l * 1024 * 512, 512, 0, t / 16, t % 16, smem); continue; }
      t -= 128;
      if (t < 128) { transpose_task(p.in[20] + (size_t)l * 512 * 1024, 1024, (u16*)(p.ws + WS_WT_BRB) + (size_t)l * 1024 * 512, 512, 0, t / 16, t % 16, smem); continue; }
      t -= 128;
      if (t < 256) { transpose_task(p.in[23] + (size_t)l * 1024 * 1024, 1024, (u16*)(p.ws + WS_WT_O) + (size_t)l * 1024 * 1024, 1024, 0, t / 16, t % 16, smem); continue; }
      t -= 256;
      if (t < 1408) { transpose_task(p.in[26] + (size_t)l * 1024 * 5632, 5632, (u16*)(p.ws + WS_WT_GU) + (size_t)l * 5632 * 1024, 1024, 2, t / 88, t % 88, smem); continue; }
      t -= 1408;
      transpose_task(p.in[27] + (size_t)l * 2816 * 1024, 1024, (u16*)(p.ws + WS_WT_DOWN) + (size_t)l * 1024 * 2816, 2816, 0, t / 16, t % 16, smem);
    } else if (task < N_WT + N_ADA) {
      adaln_task(p, task - N_WT, smem);
    } else if (task < N_WT + N_ADA + N_CK) {
      const int t = task - N_WT - N_ADA;
      const float4* src = (const float4*)p.in[4];
      u16* dst = (u16*)(p.ws + WS_KS);
#pragma unroll
      for (int i = 0; i < 8; ++i) {
        const size_t f4 = (size_t)t * 4096 + i * 512 + otid();
        const float4 v = src[f4];
        const size_t e = f4 * 4;
        const size_t lb = e / (1024 * 512), rem = e % (1024 * 512);
        uint2 o; o.x = pack2(v.x, v.y); o.y = pack2(v.z, v.w);
        *(uint2*)(dst + lb * (1056 * 512) + rem) = o;
      }
    } else {
      const int t = task - N_WT - N_ADA - N_CK;
      const int lb = t >> 7, tt = t & 127;
      transpose_task(p.in[5] + (size_t)lb * 1024 * 512, 512, (u16*)(p.ws + WS_VTS) + (size_t)lb * 512 * 1056, 1056, 0, tt >> 3, tt & 7, smem);
    }
  }
}

DI float wave_sum(float v, int lane) {
#pragma unroll
  for (int off = 32; off >= 1; off >>= 1) v += shx(v, off, lane);
  return v;
}
DI void ln_pass(const Params& p, int mode, int l, unsigned char* smem) {
  const int tid = otid();
  const int lane = tid & 63, w = tid >> 6;
  const bool first = mode != 0;
  const bool second = (mode != 2) || (l + 1 < 2);
  const bool gates = (mode == 0) || (mode == 2 && l + 1 < 2);
  const int lm = (mode == 2) ? l + 1 : l;
  const int shi = (mode == 1) ? 3 : 0;
  const float* lng = (mode == 1) ? p.in[24] + l * 1024 : p.in[28] + l * 1024;
  const float* lnb = (mode == 1) ? p.in[25] + l * 1024 : p.in[29] + l * 1024;
  const float* mod = (const float*)(p.ws + WS_MOD);
  u16* H = (u16*)(p.ws + WS_H);
  float* gout = (float*)(p.ws + WS_GATES);
  float* wl = (float*)(smem + 64);
  float bif[8];
  if (gates) {
    const float* wi = p.in[12] + (size_t)lm * 1024 * 3592 + 3072;
    for (int idx = tid; idx < 8192; idx += NTHR) {
      const int c = idx >> 3, j = idx & 7;
      wl[j * 1024 + c] = wi[(size_t)c * 3592 + j];
    }
#pragma unroll
    for (int j = 0; j < 8; ++j) bif[j] = p.in[13][lm * 8 + j];
  }
  __syncthreads();
  for (int row = blockIdx.x * 8 + w; row < TOK; row += gridDim.x * 8) {
    float* xr = p.out + (size_t)row * 1024;
    const float* src = (mode == 0) ? (row < TOKP ? p.in[0] + (size_t)row * 1024 : p.in[1] + (size_t)(row - TOKP) * 1024) : xr;
    float v[16];
#pragma unroll
    for (int i = 0; i < 4; ++i) {
      const float4 t = *(const float4*)(src + i * 256 + lane * 4);
      v[i * 4 + 0] = t.x; v[i * 4 + 1] = t.y; v[i * 4 + 2] = t.z; v[i * 4 + 3] = t.w;
    }
    if (first) {
      float s = 0.f;
#pragma unroll
      for (int i = 0; i < 16; ++i) s += v[i];
      const float mean = wave_sum(s, lane) * (1.f / 1024.f);
      float q = 0.f;
#pragma unroll
      for (int i = 0; i < 16; ++i) { v[i] -= mean; q += v[i] * v[i]; }
      const float rstd = rsqrtf(wave_sum(q, lane) * (1.f / 1024.f) + LN_EPS);
#pragma unroll
      for (int i = 0; i < 4; ++i) {
        const int c = i * 256 + lane * 4;
        const float4 g = *(const float4*)(lng + c);
        const float4 b = *(const float4*)(lnb + c);
        v[i * 4 + 0] = v[i * 4 + 0] * rstd * g.x + b.x; v[i * 4 + 1] = v[i * 4 + 1] * rstd * g.y + b.y;
        v[i * 4 + 2] = v[i * 4 + 2] * rstd * g.z + b.z; v[i * 4 + 3] = v[i * 4 + 3] * rstd * g.w + b.w;
        *(float4*)(xr + c) = make_float4(v[i * 4 + 0], v[i * 4 + 1], v[i * 4 + 2], v[i * 4 + 3]);
      }
    }
    if (second) {
      float s = 0.f;
#pragma unroll
      for (int i = 0; i < 16; ++i) s += v[i];
      const float mean = wave_sum(s, lane) * (1.f / 1024.f);
      float q = 0.f;
#pragma unroll
      for (int i = 0; i < 16; ++i) { v[i] -= mean; q += v[i] * v[i]; }
      const float rstd = rsqrtf(wave_sum(q, lane) * (1.f / 1024.f) + LN_EPS);
      const int b = batch_of_row(row);
      const float* mb = mod + ((size_t)lm * 40 + b) * 6144;
#pragma unroll
      for (int i = 0; i < 4; ++i) {
        const int c = i * 256 + lane * 4;
        const float4 sh = *(const float4*)(mb + shi * 1024 + c);
        const float4 sc = *(const float4*)(mb + (shi + 1) * 1024 + c);
        v[i * 4 + 0] = v[i * 4 + 0] * rstd * (1.f + sc.x) + sh.x; v[i * 4 + 1] = v[i * 4 + 1] * rstd * (1.f + sc.y) + sh.y;
        v[i * 4 + 2] = v[i * 4 + 2] * rstd * (1.f + sc.z) + sh.z; v[i * 4 + 3] = v[i * 4 + 3] * rstd * (1.f + sc.w) + sh.w;
        uint2 o; o.x = pack2(v[i * 4 + 0], v[i * 4 + 1]); o.y = pack2(v[i * 4 + 2], v[i * 4 + 3]);
        *(uint2*)(H + (size_t)row * 1024 + c) = o;
      }
      if (gates) {
        float g8[8];
#pragma unroll
        for (int j = 0; j < 8; ++j) {
          float s2 = 0.f;
#pragma unroll
          for (int i = 0; i < 4; ++i) {
            const float4 wv = *(const float4*)(wl + j * 1024 + i * 256 + lane * 4);
            s2 += v[i * 4] * wv.x + v[i * 4 + 1] * wv.y + v[i * 4 + 2] * wv.z + v[i * 4 + 3] * wv.w;
          }
          g8[j] = wave_sum(s2, lane) + bif[j];
        }
        if (lane == 0) {
          *(float4*)(gout + (size_t)row * 8) = make_float4(g8[0], g8[1], g8[2], g8[3]);
          *(float4*)(gout + (size_t)row * 8 + 4) = make_float4(g8[4], g8[5], g8[6], g8[7]);
        }
      }
    }
  }
}

DI void phase_in_gate(const Params& p, int l, unsigned char* smem) {
  const int tid = otid(), lane = tid & 63, w = tid >> 6;
  const int wm = w >> 1, wn = w & 1, r = lane & 31, h = lane >> 5;
  const u16* H = (const u16*)(p.ws + WS_H);
  const int NT_IN = 28, NT_G = 16, MT = 257;
  const int total = MT * (NT_IN + NT_G);
  for (int t = blockIdx.x; t < total; t += gridDim.x) {
    f32x16 acc[2][2];
#pragma unroll
    for (int a = 0; a < 2; ++a)
#pragma unroll
      for (int b = 0; b < 2; ++b) zero16(acc[a][b]);
    if (t < MT * NT_IN) {
      const int mt = t / NT_IN, nt = t % NT_IN;
      const int m0 = mt * 256, n0 = nt * 128;
      gemm_mainloop(acc, H, 1024, (const u16*)(p.ws + WS_WT_IN) + (size_t)l * 3584 * 1024, 1024, 1024, m0, n0, smem);
      const bool prompt = m0 < TOKP;
      const int n = n0 + wn * 64 + 2 * r;
#pragma unroll
      for (int mi = 0; mi < 2; ++mi) {
        const int rb = m0 + wm * 64 + mi * 32 + 4 * h;
        if (n0 < 512) {
          u16* ZQ = (u16*)(p.ws + WS_ZQ);
#pragma unroll
          for (int i = 0; i < 16; ++i) {
            const int row = rb + (i & 3) + 8 * (i >> 2);
            *(unsigned*)(ZQ + (size_t)row * 512 + n) = pack2(acc[mi][0][i], acc[mi][1][i]);
          }
        } else if (n0 < 1536) {
          const bool isk = n0 < 1024;
          const int nn = n - (isk ? 512 : 1024);
          float* of = p.out + (isk ? (prompt ? O_KP : O_KSM) : (prompt ? O_VP : O_VSM));
#pragma unroll
          for (int i = 0; i < 16; ++i) {
            const int row = rb + (i & 3) + 8 * (i >> 2);
            const size_t orow = prompt ? ((size_t)l * TOKP + row) : ((size_t)l * TOKS + (row - TOKP));
            *(float2*)(of + orow * 512 + nn) = make_float2(acc[mi][0][i], acc[mi][1][i]);
            if (isk) {
              u16* kd;
              if (prompt) kd = (u16*)(p.ws + WS_KB) + (size_t)row * 512 + nn;
              else { const int rs = row - TOKP; kd = (u16*)(p.ws + WS_KS) + ((size_t)(l * 8 + (rs >> 5)) * 1056 + 1024 + (rs & 31)) * 512 + nn; }
              *(unsigned*)kd = pack2(acc[mi][0][i], acc[mi][1][i]);
            }
          }
          if (!isk) {
#pragma unroll
            for (int g = 0; g < 4; ++g) {
              const int row = rb + 8 * g;
#pragma unroll
              for (int j = 0; j < 2; ++j) {
                u16* vd;
                if (prompt) vd = (u16*)(p.ws + WS_VTP) + ((size_t)(row >> 11) * 512 + nn + j) * 2048 + (row & 2047);
                else { const int rs = row - TOKP; vd = (u16*)(p.ws + WS_VTS) + ((size_t)(l * 8 + (rs >> 5)) * 512 + nn + j) * 1056 + 1024 + (rs & 31); }
                uint2 o; o.x = pack2(acc[mi][j][4 * g], acc[mi][j][4 * g + 1]); o.y = pack2(acc[mi][j][4 * g + 2], acc[mi][j][4 * g + 3]);
                *(uint2*)vd = o;
              }
            }
          }
        } else if (n0 < 3072) {
          const bool isqk = n0 < 2560;
          const int ch = n - (isqk ? 1536 : 2560);
          const int nchn = isqk ? 1024 : 512;
#pragma unroll
          for (int g = 0; g < 4; ++g) {
            const int row = rb + 8 * g;
#pragma unroll
            for (int j = 0; j < 2; ++j) {
              u16* d;
              if (prompt) d = (u16*)(p.ws + (isqk ? WS_MQKT_P : WS_MVT_P)) + ((size_t)(row >> 11) * nchn + ch + j) * 2048 + (row & 2047);
              else { const int rs = row - TOKP; d = (u16*)(p.ws + (isqk ? WS_MQKT_S : WS_MVT_S)) + ((size_t)(rs >> 5) * nchn + ch + j) * 32 + (rs & 31); }
              uint2 o; o.x = pack2(acc[mi][j][4 * g], acc[mi][j][4 * g + 1]); o.y = pack2(acc[mi][j][4 * g + 2], acc[mi][j][4 * g + 3]);
              *(uint2*)d = o;
            }
          }
          if (isqk) {
#pragma unroll
            for (int i = 0; i < 16; ++i) {
              const int row = rb + (i & 3) + 8 * (i >> 2);
              if (prompt) {
                const int tt = row & 2047;
                if (tt >= 2045) *(float2*)(p.out + O_CVP + ((size_t)(l * 32 + (row >> 11)) * 3 + (tt - 2045)) * 1024 + ch) = make_float2(acc[mi][0][i], acc[mi][1][i]);
              } else {
                const int rs = row - TOKP, tt = rs & 31;
                if (tt >= 29) *(float2*)(p.out + O_CVS + ((size_t)(l * 8 + (rs >> 5)) * 3 + (tt - 29)) * 1024 + ch) = make_float2(acc[mi][0][i], acc[mi][1][i]);
              }
            }
          }
        } else {
          u16* MO = (u16*)(p.ws + WS_MO);
          const int nn = n - 3072;
#pragma unroll
          for (int i = 0; i < 16; ++i) {
            const int row = rb + (i & 3) + 8 * (i >> 2);
            *(unsigned*)(MO + (size_t)row * 512 + nn) = pack2(sigmoidf_(acc[mi][0][i]), sigmoidf_(acc[mi][1][i]));
          }
        }
      }
    } else {
      const int t2 = t - MT * NT_IN;
      const int mt = t2 / NT_G, nt = t2 % NT_G;
      const int m0 = mt * 256, n0 = nt * 128;
      gemm_mainloop(acc, H, 1024, (const u16*)(p.ws + WS_WT_GATE) + (size_t)l * 2048 * 1024, 1024, 1024, m0, n0, smem);
      const int n = n0 + wn * 64 + 2 * r;
      const float2 bg = *(const float2*)(p.in[22] + l * 2048 + n);
      u16* G = (u16*)(p.ws + WS_G);
#pragma unroll
      for (int mi = 0; mi < 2; ++mi) {
        const int rb = m0 + wm * 64 + mi * 32 + 4 * h;
#pragma unroll
        for (int i = 0; i < 16; ++i) {
          const int row = rb + (i & 3) + 8 * (i >> 2);
          *(unsigned*)(G + (size_t)row * 2048 + n) = pack2(sigmoidf_(acc[mi][0][i] + bg.x), sigmoidf_(acc[mi][1][i] + bg.y));
        }
      }
    }
  }
}

DI void phase_mix(const Params& p, int l, unsigned char* smem) {
  const int tid = otid(), lane = tid & 63, w = tid >> 6;
  const int wm = w >> 1, wn = w & 1, r = lane & 31, h = lane >> 5;
  const u16* G = (const u16*)(p.ws + WS_G);
  u16* MIX = (u16*)(p.ws + WS_MIX);
  const int NT = 8, MT = 257;
  for (int t = blockIdx.x; t < MT * NT; t += gridDim.x) {
    const int mt = t / NT, nt = t % NT;
    const int m0 = mt * 256, n0 = nt * 128;
    const int n = n0 + wn * 64 + 2 * r;
    f32x16 acc[2][2];
#pragma unroll
    for (int a = 0; a < 2; ++a)
#pragma unroll
      for (int b = 0; b < 2; ++b) zero16(acc[a][b]);
    gemm_mainloop(acc, (const u16*)(p.ws + WS_AN), 512, (const u16*)(p.ws + WS_WT_BRA) + (size_t)l * 1024 * 512, 512, 512, m0, n0, smem);
#pragma unroll
    for (int mi = 0; mi < 2; ++mi) {
      const int rb = m0 + wm * 64 + mi * 32 + 4 * h;
#pragma unroll
      for (int i = 0; i < 16; ++i) {
        const int row = rb + (i & 3) + 8 * (i >> 2);
        const unsigned g = *(const unsigned*)(G + (size_t)row * 2048 + n);
        *(unsigned*)(MIX + (size_t)row * 1024 + n) = pack2(bflo(g) * acc[mi][0][i], bfhi(g) * acc[mi][1][i]);
        acc[mi][0][i] = 0.f; acc[mi][1][i] = 0.f;
        if ((i & 3) == 3) __builtin_amdgcn_sched_barrier(0);
      }
    }
    gemm_mainloop(acc, (const u16*)(p.ws + WS_MN), 512, (const u16*)(p.ws + WS_WT_BRB) + (size_t)l * 1024 * 512, 512, 512, m0, n0, smem);
#pragma unroll
    for (int mi = 0; mi < 2; ++mi) {
      const int rb = m0 + wm * 64 + mi * 32 + 4 * h;
#pragma unroll
      for (int i = 0; i < 16; ++i) {
        const int row = rb + (i & 3) + 8 * (i >> 2);
        const unsigned g = *(const unsigned*)(G + (size_t)row * 2048 + 1024 + n);
        const unsigned pr = *(const unsigned*)(MIX + (size_t)row * 1024 + n);
        const float o0 = bflo(pr) + bflo(g) * acc[mi][0][i];
        const float o1 = bfhi(pr) + bfhi(g) * acc[mi][1][i];
        *(unsigned*)(MIX + (size_t)row * 1024 + n) = pack2(o0, o1);
        if ((i & 3) == 3) __builtin_amdgcn_sched_barrier(0);
      }
    }
  }
}

DI void phase_res(const Params& p, int l, int mode, unsigned char* smem) {
  const int tid = otid(), lane = tid & 63, w = tid >> 6;
  const int wm = w >> 1, wn = w & 1, r = lane & 31, h = lane >> 5;
  const float* mod = (const float*)(p.ws + WS_MOD);
  const int NT = 8, MT = 257;
  for (int t = blockIdx.x; t < MT * NT; t += gridDim.x) {
    const int mt = t / NT, nt = t % NT;
    const int m0 = mt * 256, n0 = nt * 128;
    const int n = n0 + wn * 64 + 2 * r;
    f32x16 acc[2][2];
#pragma unroll
    for (int a = 0; a < 2; ++a)
#pragma unroll
      for (int b = 0; b < 2; ++b) zero16(acc[a][b]);
    if (mode == 0) gemm_mainloop(acc, (const u16*)(p.ws + WS_MIX), 1024, (const u16*)(p.ws + WS_WT_O) + (size_t)l * 1024 * 1024, 1024, 1024, m0, n0, smem);
    else gemm_mainloop(acc, (const u16*)(p.ws + WS_ACT), 2816, (const u16*)(p.ws + WS_WT_DOWN) + (size_t)l * 1024 * 2816, 2816, 2816, m0, n0, smem);
    const int gi = (mode == 0) ? 2 : 5;
#pragma unroll
    for (int mi = 0; mi < 2; ++mi) {
      const int rb = m0 + wm * 64 + mi * 32 + 4 * h;
#pragma unroll
      for (int i = 0; i < 16; ++i) {
        const int row = rb + (i & 3) + 8 * (i >> 2);
        const int b = batch_of_row(row);
        const float2 gg = *(const float2*)(mod + ((size_t)l * 40 + b) * 6144 + gi * 1024 + n);
        float* xr = p.out + (size_t)row * 1024 + n;
        const float* xs = (mode == 0 && l == 0) ? (row < TOKP ? p.in[0] + (size_t)row * 1024 + n : p.in[1] + (size_t)(row - TOKP) * 1024 + n) : xr;
        const float2 xv = *(const float2*)xs;
        *(float2*)xr = make_float2(ALPHA * xv.x + (1.f + gg.x) * acc[mi][0][i], ALPHA * xv.y + (1.f + gg.y) * acc[mi][1][i]);
      }
    }
  }
}

DI void phase_gu(const Params& p, int l, unsigned char* smem) {
  const int tid = otid(), lane = tid & 63, w = tid >> 6;
  const int wm = w >> 1, wn = w & 1, r = lane & 31, h = lane >> 5;
  u16* ACT = (u16*)(p.ws + WS_ACT);
  const int NT = 44, MT = 257;
  for (int t = blockIdx.x; t < MT * NT; t += gridDim.x) {
    const int mt = t / NT, nt = t % NT;
    const int m0 = mt * 256, n0 = nt * 128;
    f32x16 acc[2][2];
#pragma unroll
    for (int a = 0; a < 2; ++a)
#pragma unroll
      for (int b = 0; b < 2; ++b) zero16(acc[a][b]);
    gemm_mainloop(acc, (const u16*)(p.ws + WS_H), 1024, (const u16*)(p.ws + WS_WT_GU) + (size_t)l * 5632 * 1024, 1024, 1024, m0, n0, smem);
    const int f = (n0 >> 1) + wn * 32 + r;
#pragma unroll
    for (int mi = 0; mi < 2; ++mi) {
      const int rb = m0 + wm * 64 + mi * 32 + 4 * h;
#pragma unroll
      for (int i = 0; i < 16; ++i) {
        const int row = rb + (i & 3) + 8 * (i >> 2);
        ACT[(size_t)row * 2816 + f] = f2bf(siluf_(acc[mi][0][i]) * acc[mi][1][i]);
      }
    }
  }
}

constexpr int AT_BASE = 64;
constexpr int AT_KBYTES = 64 * 272;
constexpr int AT_VBYTES = 128 * 136;
constexpr int AT_STAGE = AT_KBYTES + AT_VBYTES;

DI void attn_item(const Params& p, int l, int b, int head, int qt, float lam, float lam_init, unsigned char* smem) {
  const int tid = otid(), lane = tid & 63, w = tid >> 6, r = lane & 31, h = lane >> 5;
  const int comp = w & 1, rg = w >> 1;
  const bool prompt = b < 32;
  const int bs = b - 32;
  const u16* Kg = prompt ? (const u16*)(p.ws + WS_KB) + (size_t)b * 2048 * 512 : (const u16*)(p.ws + WS_KS) + (size_t)(l * 8 + bs) * 1056 * 512;
  const u16* Vg = prompt ? (const u16*)(p.ws + WS_VTP) + (size_t)b * 512 * 2048 : (const u16*)(p.ws + WS_VTS) + (size_t)(l * 8 + bs) * 512 * 1056;
  const int ldT = prompt ? 2048 : 1056;
  const int nkt = prompt ? 2 * qt + 2 : 17;
  const int nkeys = prompt ? 2048 : 1056;
  const int qtok0 = prompt ? b * 2048 + qt * 128 : TOKP + bs * 32;
  const int qpos0 = prompt ? qt * 128 : 1024;
  const bool active = prompt || rg == 0;
  const int my_nkt = prompt ? (rg < 2 ? nkt - 1 : nkt) : nkt;
  const u16* ZQ = (const u16*)(p.ws + WS_ZQ);
  bf16x8 qf[4];
  {
    const int qrow = active ? qtok0 + rg * 32 + r : qtok0;
#pragma unroll
    for (int ks = 0; ks < 4; ++ks) qf[ks] = *(const bf16x8*)(ZQ + (size_t)qrow * 512 + head * 128 + comp * 64 + ks * 16 + h * 8);
  }
  const float slope2 = exp2f(-2.f * (head + 1)) * LOG2E;
  const float c1 = 0.125f * LOG2E;
  const int qpos = qpos0 + rg * 32 + r;
  f32x16 O[4];
#pragma unroll
  for (int i = 0; i < 4; ++i) zero16(O[i]);
  float m_run = -INFINITY, l_run = 0.f;

  const int krow = tid >> 4, kcc = tid & 15;
  const int vrow = tid >> 3, vcc = tid & 7;
  const u16* kp = Kg + (size_t)krow * 512 + head * 128 + kcc * 8;
  const u16* vp = Vg + (size_t)(head * 128 + vrow) * ldT + vcc * 8;
  uint4 rk0, rk1, rv0, rv1;
  unsigned char* sb = smem + AT_BASE;
  rk0 = *(const uint4*)kp; rk1 = *(const uint4*)(kp + 32 * 512);
  rv0 = *(const uint4*)vp; rv1 = *(const uint4*)(vp + (size_t)64 * ldT);
  {
    *(uint4*)(sb + krow * 272 + kcc * 16) = rk0;
    *(uint4*)(sb + (krow + 32) * 272 + kcc * 16) = rk1;
    *(uint2*)(sb + AT_KBYTES + vrow * 136 + vcc * 16) = make_uint2(rv0.x, rv0.y);
    *(uint2*)(sb + AT_KBYTES + vrow * 136 + vcc * 16 + 8) = make_uint2(rv0.z, rv0.w);
    *(uint2*)(sb + AT_KBYTES + (vrow + 64) * 136 + vcc * 16) = make_uint2(rv1.x, rv1.y);
    *(uint2*)(sb + AT_KBYTES + (vrow + 64) * 136 + vcc * 16 + 8) = make_uint2(rv1.z, rv1.w);
  }
  __syncthreads();
  for (int kt = 0; kt < nkt; ++kt) {
    const bool more = kt + 1 < nkt;
    if (more) {
      kp += 64 * 512; vp += 64;
      rk0 = *(const uint4*)kp; rk1 = *(const uint4*)(kp + 32 * 512);
      rv0 = *(const uint4*)vp; rv1 = *(const uint4*)(vp + (size_t)64 * ldT);
    }
    if (active && kt < my_nkt) {
      const unsigned char* Kt = sb + (kt & 1) * AT_STAGE;
      const unsigned char* Vt = Kt + AT_KBYTES;
      f32x16 s[2];
      zero16(s[0]); zero16(s[1]);
#pragma unroll
      for (int ks = 0; ks < 4; ++ks) {
#pragma unroll
        for (int sub = 0; sub < 2; ++sub) {
          const bf16x8 kf = *(const bf16x8*)(Kt + (sub * 32 + r) * 272 + (comp * 64 + ks * 16 + h * 8) * 2);
          s[sub] = MFMA(kf, qf[ks], s[sub]);
        }
      }
      float mx = -INFINITY;
#pragma unroll
      for (int sub = 0; sub < 2; ++sub)
#pragma unroll
        for (int i = 0; i < 16; ++i) {
          const int key = kt * 64 + sub * 32 + crow(i, h);
          float v = s[sub][i] * c1 - slope2 * fabsf((float)(qpos - key));
          if (!prompt && key >= nkeys) v = -INFINITY;
          s[sub][i] = v;
          mx = fmaxf(mx, v);
        }
      mx = fmaxf(mx, shx(mx, 32, lane));
      const float m_new = fmaxf(m_run, mx);
      const float alpha = fexp2(m_run - m_new);
      m_run = m_new;
      float lsum = 0.f;
#pragma unroll
      for (int sub = 0; sub < 2; ++sub)
#pragma unroll
        for (int i = 0; i < 16; ++i) {
          const float pv = fexp2(s[sub][i] - m_new);
          lsum += pv;
          s[sub][i] = pv;
        }
      l_run = l_run * alpha + lsum;
#pragma unroll
      for (int dt = 0; dt < 4; ++dt)
#pragma unroll
        for (int i = 0; i < 16; ++i) O[dt][i] *= alpha;
#pragma unroll
      for (int sub = 0; sub < 2; ++sub)
#pragma unroll
        for (int s2 = 0; s2 < 2; ++s2) {
          const bf16x8 pf = pack8(s[sub], s2);
#pragma unroll
          for (int dt = 0; dt < 4; ++dt) {
            const unsigned char* va = Vt + (dt * 32 + r) * 136 + (sub * 32 + s2 * 16 + 4 * h) * 2;
            const uint2 lo = *(const uint2*)va;
            const uint2 hi = *(const uint2*)(va + 16);
            const uint4 vv = make_uint4(lo.x, lo.y, hi.x, hi.y);
            O[dt] = MFMA(__builtin_bit_cast(bf16x8, vv), pf, O[dt]);
          }
        }
    }
    if (more) {
      unsigned char* sn = sb + ((kt + 1) & 1) * AT_STAGE;
      *(uint4*)(sn + krow * 272 + kcc * 16) = rk0;
      *(uint4*)(sn + (krow + 32) * 272 + kcc * 16) = rk1;
      *(uint2*)(sn + AT_KBYTES + vrow * 136 + vcc * 16) = make_uint2(rv0.x, rv0.y);
      *(uint2*)(sn + AT_KBYTES + vrow * 136 + vcc * 16 + 8) = make_uint2(rv0.z, rv0.w);
      *(uint2*)(sn + AT_KBYTES + (vrow + 64) * 136 + vcc * 16) = make_uint2(rv1.x, rv1.y);
      *(uint2*)(sn + AT_KBYTES + (vrow + 64) * 136 + vcc * 16 + 8) = make_uint2(rv1.z, rv1.w);
    }
    __syncthreads();
  }
  float* exch = (float*)(smem + AT_BASE);
  float inv = 0.f;
  if (active) { const float lt = l_run + shx(l_run, 32, lane); inv = 1.f / lt; }
  if (active && comp == 1) {
    const float sc = inv * lam;
#pragma unroll
    for (int dt = 0; dt < 4; ++dt)
#pragma unroll
      for (int i = 0; i < 16; ++i) exch[(rg * 64 + dt * 16 + i) * 64 + lane] = O[dt][i] * sc;
  }
  __syncthreads();
  if (active && comp == 0) {
    float ss = 0.f;
#pragma unroll
    for (int dt = 0; dt < 4; ++dt)
#pragma unroll
      for (int i = 0; i < 16; ++i) {
        const float o = O[dt][i] * inv - exch[(rg * 64 + dt * 16 + i) * 64 + lane];
        O[dt][i] = o;
        ss += o * o;
      }
    ss += shx(ss, 32, lane);
    const float rs = rsqrtf(ss * (1.f / 128.f) + LN_EPS) * (1.f - lam_init);
    u16* AN = (u16*)(p.ws + WS_AN) + (size_t)(qtok0 + rg * 32 + r) * 512 + head * 128;
    const float* gw = p.in[17] + l * 512 + head * 128;
#pragma unroll
    for (int dt = 0; dt < 4; ++dt)
#pragma unroll
      for (int g = 0; g < 4; ++g) {
        const int dv = dt * 32 + 8 * g + 4 * h;
        const float4 g4 = *(const float4*)(gw + dv);
        uint2 o;
        o.x = pack2(O[dt][4 * g] * rs * g4.x, O[dt][4 * g + 1] * rs * g4.y);
        o.y = pack2(O[dt][4 * g + 2] * rs * g4.z, O[dt][4 * g + 3] * rs * g4.w);
        *(uint2*)(AN + dv) = o;
      }
  }
}

constexpr int ML_QS = 64;
constexpr int ML_KS = ML_QS + 64 * 272;
constexpr int ML_KT = ML_KS + 64 * 272;
constexpr int ML_VT = ML_KT + 128 * 144;
constexpr int ML_CB = ML_VT + 128 * 144;
constexpr int ML_HB = ML_CB + 128 * 272;
constexpr int ML_SM = ML_HB + 64 * 132 * 4;
static_assert(ML_SM + 528 * 4 <= LDS_BYTES, "lds");

DI void mlstm_item(const Params& p, int l, int b, int head, unsigned char* smem) {
  const int tid = otid(), lane = tid & 63, w = tid >> 6, r = lane & 31, h = lane >> 5;
  const bool prompt = b < 32;
  const int bs = b - 32;
  const int T = prompt ? 2048 : 32;
  const int nch = prompt ? 32 : 1;
  const int L = prompt ? 64 : 32;
  const int tokbase = prompt ? b * 2048 : TOKP + bs * 32;
  const u16* qkT = prompt ? (const u16*)(p.ws + WS_MQKT_P) + (size_t)b * 1024 * 2048 : (const u16*)(p.ws + WS_MQKT_S) + (size_t)bs * 1024 * 32;
  const u16* vTg = prompt ? (const u16*)(p.ws + WS_MVT_P) + (size_t)b * 512 * 2048 : (const u16*)(p.ws + WS_MVT_S) + (size_t)bs * 512 * 32;
  u16* qs = (u16*)(smem + ML_QS);
  u16* ksm = (u16*)(smem + ML_KS);
  u16* kTw = (u16*)(smem + ML_KT);
  u16* vT = (u16*)(smem + ML_VT);
  u16* Cbf = (u16*)(smem + ML_CB);
  float* hbuf = (float*)(smem + ML_HB);
  float* a_s = (float*)(smem + ML_SM);
  float* mx_s = a_s + 64;
  float* ws_s = a_s + 128;
  float* wi_s = a_s + 192;
  float* emt_s = a_s + 256;
  float* nq_s = a_s + 320;
  float* nvec = a_s + 384;
  float* scal = a_s + 512;

  const int vt = w & 3, kt0 = (w >> 2) * 2;
  f32x16 accC[2];
  float m_run = 0.f;
  if (prompt) {
    zero16(accC[0]); zero16(accC[1]);
    if (tid < 128) nvec[tid] = 0.f;
  } else {
    const float* Cs = p.in[6] + ((size_t)(l * 8 + bs) * 4 + head) * 128 * 128;
#pragma unroll
    for (int q = 0; q < 2; ++q)
#pragma unroll
      for (int g = 0; g < 4; ++g) {
        const float4 c4 = *(const float4*)(Cs + (size_t)(vt * 32 + r) * 128 + (kt0 + q) * 32 + 8 * g + 4 * h);
        accC[q][4 * g] = c4.x; accC[q][4 * g + 1] = c4.y; accC[q][4 * g + 2] = c4.z; accC[q][4 * g + 3] = c4.w;
      }
    if (tid < 128) nvec[tid] = p.in[7][((size_t)(l * 8 + bs) * 4 + head) * 128 + tid];
    m_run = p.in[8][(l * 8 + bs) * 4 + head];
  }
#pragma unroll
  for (int q = 0; q < 2; ++q)
#pragma unroll
    for (int g = 0; g < 4; ++g) {
      uint2 o; o.x = pack2(accC[q][4 * g], accC[q][4 * g + 1]); o.y = pack2(accC[q][4 * g + 2], accC[q][4 * g + 3]);
      *(uint2*)(Cbf + (vt * 32 + r) * 136 + (kt0 + q) * 32 + 8 * g + 4 * h) = o;
    }
  const float* gatesp = (const float*)(p.ws + WS_GATES);
  const int vi = w >> 1, ti = w & 1;

  for (int c = 0; c < nch; ++c) {
    const int t0 = c * 64;
    if (w == 0) {
      const int t = lane;
      float ig = -INFINITY, lf = 0.f;
      if (t < L) {
        const float* gp = gatesp + (size_t)(tokbase + t0 + t) * 8;
        ig = gp[head];
        const float fg = gp[4 + head];
        lf = fminf(fg, 0.f) - log1pf(__expf(-fabsf(fg)));
      }
      float bc = lf;
#pragma unroll
      for (int off = 1; off < 64; off <<= 1) { const float v = shidx(bc, lane - off, lane); if (lane >= off) bc += v; }
      const float a = ig - bc;
      float M = a;
#pragma unroll
      for (int off = 1; off < 64; off <<= 1) { const float v = shidx(M, lane - off, lane); if (lane >= off) M = fmaxf(M, v); }
      const float mx = fmaxf(m_run, M);
      const float bL = shidx(bc, 63, lane);
      const float mxL = shidx(mx, 63, lane);
      a_s[t] = a; mx_s[t] = mx;
      ws_s[t] = __expf(a - mxL);
      wi_s[t] = __expf(m_run - mx);
      emt_s[t] = __expf(-(bc + mx));
      if (lane == 0) scal[1] = __expf(m_run - mxL);
      m_run = bL + mxL;
    }
    const int ch2 = tid >> 1, th = tid & 1;
    const bool isk = ch2 >= 128;
    const int dd = ch2 & 127;
    const int ch = (isk ? 512 : 0) + head * 128 + dd;
    const u16* rp = qkT + (size_t)ch * T + t0 + th * 32;
    float um3 = 0.f, um2 = 0.f, um1 = 0.f;
    const bool ldrow = prompt || th == 0;
    if (prompt) {
      if (th == 1 || c > 0) {
        const uint2 pv = *(const uint2*)(rp - 4);
        um3 = bfhi(pv.x); um2 = bflo(pv.y); um1 = bfhi(pv.y);
      }
    } else if (th == 0) {
      const float* cvp = p.in[9] + (size_t)(l * 8 + bs) * 3 * 1024 + ch;
      um3 = cvp[0]; um2 = cvp[1024]; um1 = cvp[2048];
    }
    const float cw0 = p.in[14][(l * 4 + 0) * 1024 + ch], cw1 = p.in[14][(l * 4 + 1) * 1024 + ch];
    const float cw2 = p.in[14][(l * 4 + 2) * 1024 + ch], cw3 = p.in[14][(l * 4 + 3) * 1024 + ch];
    const float cb = p.in[15][l * 1024 + ch];
    __syncthreads();
    {
      u16* dstrm = (isk ? ksm : qs) + (th * 32) * 136 + dd;
      const float oscale = isk ? 0.08838834764831845f : 1.f;
#pragma unroll 1
      for (int i = 0; i < 4; ++i) {
        uint4 uu = make_uint4(0, 0, 0, 0);
        if (ldrow) uu = *(const uint4*)(rp + i * 8);
        float u[8];
        u[0] = bflo(uu.x); u[1] = bfhi(uu.x); u[2] = bflo(uu.y); u[3] = bfhi(uu.y);
        u[4] = bflo(uu.z); u[5] = bfhi(uu.z); u[6] = bflo(uu.w); u[7] = bfhi(uu.w);
        float y[8];
#pragma unroll
        for (int e = 0; e < 8; ++e) {
          const float x3 = (e >= 3) ? u[e - 3] : (e == 0 ? um3 : (e == 1 ? um2 : um1));
          const float x2 = (e >= 2) ? u[e - 2] : (e == 0 ? um2 : um1);
          const float x1 = (e >= 1) ? u[e - 1] : um1;
          const float yy = cb + cw0 * x3 + cw1 * x2 + cw2 * x1 + cw3 * u[e];
          y[e] = siluf_(yy) * oscale;
        }
        um3 = u[5]; um2 = u[6]; um1 = u[7];
#pragma unroll
        for (int e = 0; e < 8; ++e) dstrm[(i * 8 + e) * 136] = f2bf(y[e]);
        if (isk) {
          const float4 w0 = *(const float4*)(ws_s + th * 32 + i * 8);
          const float4 w1 = *(const float4*)(ws_s + th * 32 + i * 8 + 4);
          uint4 o;
          o.x = pack2(y[0] * w0.x, y[1] * w0.y); o.y = pack2(y[2] * w0.z, y[3] * w0.w);
          o.z = pack2(y[4] * w1.x, y[5] * w1.y); o.w = pack2(y[6] * w1.z, y[7] * w1.w);
          *(uint4*)(kTw + dd * 72 + th * 32 + i * 8) = o;
        }
      }
#pragma unroll
      for (int i = 0; i < 2; ++i) {
        const int id = tid + 512 * i, row = id >> 3, cc = id & 7;
        uint4 vv = make_uint4(0, 0, 0, 0);
        if (prompt || cc < 4) vv = *(const uint4*)(vTg + (size_t)(head * 128 + row) * T + t0 + cc * 8);
        *(uint4*)(vT + row * 72 + cc * 8) = vv;
      }
    }
    __syncthreads();
    {
      const int t = tid >> 3, part = tid & 7;
      const uint4 q0 = *(const uint4*)(qs + t * 136 + part * 16);
      const uint4 q1 = *(const uint4*)(qs + t * 136 + part * 16 + 8);
      const float* nv = nvec + part * 16;
      float s = bflo(q0.x) * nv[0] + bfhi(q0.x) * nv[1] + bflo(q0.y) * nv[2] + bfhi(q0.y) * nv[3]
              + bflo(q0.z) * nv[4] + bfhi(q0.z) * nv[5] + bflo(q0.w) * nv[6] + bfhi(q0.w) * nv[7]
              + bflo(q1.x) * nv[8] + bfhi(q1.x) * nv[9] + bflo(q1.y) * nv[10] + bfhi(q1.y) * nv[11]
              + bflo(q1.z) * nv[12] + bfhi(q1.z) * nv[13] + bflo(q1.w) * nv[14] + bfhi(q1.w) * nv[15];
      s += shx(s, 1, lane); s += shx(s, 2, lane); s += shx(s, 4, lane);
      if (part == 0) nq_s[t] = s;
    }
    f32x16 accS[2], accO;
    zero16(accS[0]); zero16(accS[1]); zero16(accO);
    {
#pragma unroll
      for (int ks = 0; ks < 8; ++ks) {
        const bf16x8 qfr = *(const bf16x8*)(qs + (ti * 32 + r) * 136 + ks * 16 + h * 8);
        const bf16x8 k0 = *(const bf16x8*)(ksm + r * 136 + ks * 16 + h * 8);
        accS[0] = MFMA(k0, qfr, accS[0]);
        if (ti == 1) {
          const bf16x8 k1 = *(const bf16x8*)(ksm + (32 + r) * 136 + ks * 16 + h * 8);
          accS[1] = MFMA(k1, qfr, accS[1]);
        }
        const bf16x8 cf = *(const bf16x8*)(Cbf + (vi * 32 + r) * 136 + ks * 16 + h * 8);
        accO = MFMA(cf, qfr, accO);
      }
    }
    const int tcol = ti * 32 + r;
    const float mxt = mx_s[tcol];
    const float wit = wi_s[tcol];
    float dsum = 0.f;
#pragma unroll
    for (int sub = 0; sub < 2; ++sub) {
      if (sub <= ti) {
#pragma unroll
        for (int g = 0; g < 4; ++g) {
          const float4 a4 = *(const float4*)(a_s + sub * 32 + 8 * g + 4 * h);
          const float av[4] = {a4.x, a4.y, a4.z, a4.w};
#pragma unroll
          for (int e = 0; e < 4; ++e) {
            const int s = sub * 32 + 8 * g + 4 * h + e;
            const float wgt = (s <= tcol) ? __expf(av[e] - mxt) : 0.f;
            const float pv = accS[sub][4 * g + e] * wgt;
            accS[sub][4 * g + e] = pv;
            dsum += pv;
          }
        }
      }
    }
    dsum += shx(dsum, 32, lane);
#pragma unroll
    for (int i = 0; i < 16; ++i) accO[i] *= wit;
#pragma unroll
    for (int sub = 0; sub < 2; ++sub) {
      if (sub <= ti) {
#pragma unroll
        for (int s2 = 0; s2 < 2; ++s2) {
          const bf16x8 pf = pack8(accS[sub], s2);
          const u16* va = vT + (vi * 32 + r) * 72 + sub * 32 + s2 * 16 + 4 * h;
          const uint2 lo = *(const uint2*)va;
          const uint2 hi = *(const uint2*)(va + 8);
          const uint4 vq = make_uint4(lo.x, lo.y, hi.x, hi.y);
          accO = MFMA(__builtin_bit_cast(bf16x8, vq), pf, accO);
        }
      }
    }
    __syncthreads();
    {
      const float den = dsum + wit * nq_s[tcol];
      const float dn = fmaxf(fabsf(den), emt_s[tcol]);
      const float rinv = 1.f / dn;
#pragma unroll
      for (int g = 0; g < 4; ++g)
        *(float4*)(hbuf + tcol * 132 + vi * 32 + 8 * g + 4 * h) =
            make_float4(accO[4 * g] * rinv, accO[4 * g + 1] * rinv, accO[4 * g + 2] * rinv, accO[4 * g + 3] * rinv);
    }
    {
      const float wc = scal[1];
#pragma unroll
      for (int q = 0; q < 2; ++q)
#pragma unroll
        for (int i = 0; i < 16; ++i) accC[q][i] *= wc;
#pragma unroll
      for (int k4 = 0; k4 < 4; ++k4) {
        const bf16x8 vf = *(const bf16x8*)(vT + (vt * 32 + r) * 72 + k4 * 16 + h * 8);
#pragma unroll
        for (int q = 0; q < 2; ++q) {
          const bf16x8 kf = *(const bf16x8*)(kTw + ((kt0 + q) * 32 + r) * 72 + k4 * 16 + h * 8);
          accC[q] = MFMA(kf, vf, accC[q]);
        }
      }
#pragma unroll
      for (int q = 0; q < 2; ++q)
#pragma unroll
        for (int g = 0; g < 4; ++g) {
          uint2 o; o.x = pack2(accC[q][4 * g], accC[q][4 * g + 1]); o.y = pack2(accC[q][4 * g + 2], accC[q][4 * g + 3]);
          *(uint2*)(Cbf + (vt * 32 + r) * 136 + (kt0 + q) * 32 + 8 * g + 4 * h) = o;
        }
      if (tid < 128) {
        float s = 0.f;
#pragma unroll
        for (int i = 0; i < 8; ++i) {
          const uint4 kk = *(const uint4*)(kTw + tid * 72 + i * 8);
          s += bflo(kk.x) + bfhi(kk.x) + bflo(kk.y) + bfhi(kk.y) + bflo(kk.z) + bfhi(kk.z) + bflo(kk.w) + bfhi(kk.w);
        }
        nvec[tid] = wc * nvec[tid] + s;
      }
    }
    __syncthreads();
    {
      const int t = tid >> 3, part = tid & 7;
      float x[16];
#pragma unroll
      for (int i = 0; i < 4; ++i) {
        const float4 f = *(const float4*)(hbuf + t * 132 + part * 16 + i * 4);
        x[i * 4] = f.x; x[i * 4 + 1] = f.y; x[i * 4 + 2] = f.z; x[i * 4 + 3] = f.w;
      }
      float s = 0.f;
#pragma unroll
      for (int i = 0; i < 16; ++i) s += x[i];
      s += shx(s, 1, lane); s += shx(s, 2, lane); s += shx(s, 4, lane);
      const float mean = s * (1.f / 128.f);
      float q = 0.f;
#pragma unroll
      for (int i = 0; i < 16; ++i) { x[i] -= mean; q += x[i] * x[i]; }
      q += shx(q, 1, lane); q += shx(q, 2, lane); q += shx(q, 4, lane);
      const float rstd = rsqrtf(q * (1.f / 128.f) + LN_EPS);
      if (t < L) {
        const size_t tok = (size_t)tokbase + t0 + t;
        const int cbase = head * 128 + part * 16;
        const float* gw = p.in[18] + l * 512 + cbase;
        const u16* mo = (const u16*)(p.ws + WS_MO) + tok * 512 + cbase;
        const uint4 m0 = *(const uint4*)mo;
        const uint4 m1 = *(const uint4*)(mo + 8);
        const float sg[16] = {bflo(m0.x), bfhi(m0.x), bflo(m0.y), bfhi(m0.y), bflo(m0.z), bfhi(m0.z), bflo(m0.w), bfhi(m0.w),
                              bflo(m1.x), bfhi(m1.x), bflo(m1.y), bfhi(m1.y), bflo(m1.z), bfhi(m1.z), bflo(m1.w), bfhi(m1.w)};
        float yv[16];
#pragma unroll
        for (int i = 0; i < 16; ++i) yv[i] = x[i] * rstd * gw[i] * sg[i];
        uint4 o0, o1;
        o0.x = pack2(yv[0], yv[1]); o0.y = pack2(yv[2], yv[3]); o0.z = pack2(yv[4], yv[5]); o0.w = pack2(yv[6], yv[7]);
        o1.x = pack2(yv[8], yv[9]); o1.y = pack2(yv[10], yv[11]); o1.z = pack2(yv[12], yv[13]); o1.w = pack2(yv[14], yv[15]);
        u16* mn = (u16*)(p.ws + WS_MN) + tok * 512 + cbase;
        *(uint4*)mn = o0;
        *(uint4*)(mn + 8) = o1;
      }
    }
  }
  {
    float* oc = p.out + (prompt ? O_CP + ((size_t)(l * 32 + b) * 4 + head) * 16384 : O_CS + ((size_t)(l * 8 + bs) * 4 + head) * 16384);
#pragma unroll
    for (int q = 0; q < 2; ++q)
#pragma unroll
      for (int g = 0; g < 4; ++g)
        *(float4*)(oc + (size_t)(vt * 32 + r) * 128 + (kt0 + q) * 32 + 8 * g + 4 * h) =
            make_float4(accC[q][4 * g], accC[q][4 * g + 1], accC[q][4 * g + 2], accC[q][4 * g + 3]);
    float* on = p.out + (prompt ? O_NP + ((size_t)(l * 32 + b) * 4 + head) * 128 : O_NS + ((size_t)(l * 8 + bs) * 4 + head) * 128);
    if (tid < 128) on[tid] = nvec[tid];
    if (tid == 0) {
      if (prompt) p.out[O_MP + (size_t)(l * 32 + b) * 4 + head] = m_run;
      else p.out[O_MS + (size_t)(l * 8 + bs) * 4 + head] = m_run;
    }
  }
}

DI void phase_mixers(const Params& p, int l, unsigned char* smem) {
  const int tid0 = otid();
  const int lane = tid0 & 63;
  const float* lp = p.in[16] + l * 256;
  float s1 = lp[lane] * lp[64 + lane], s2 = lp[128 + lane] * lp[192 + lane];
  s1 = wave_sum(s1, lane); s2 = wave_sum(s2, lane);
  const float lam_init = 0.8f - 0.6f * expf(-0.3f * (float)l);
  const float lam = expf(s1) - expf(s2) + lam_init;
  int* ctr = (int*)(p.ws + WS_CTR) + l;
  int* sitem = (int*)smem;
  const int N_ML = 160, N_AT = 2048 + 32;
  for (;;) {
    __syncthreads();
    if (tid0 == 0) *sitem = atomicAdd(ctr, 1);
    __syncthreads();
    const int item = *sitem;
    if (item >= N_ML + N_AT) break;
    if (item < N_ML) {
#ifndef NO_ML
      mlstm_item(p, l, item >> 2, item & 3, smem);
#endif
    } else {
#ifndef NO_AT
      const int a = item - N_ML;
      if (a < 2048) {
        const int qt = 15 - (a >> 7), rest = a & 127;
        attn_item(p, l, rest >> 2, rest & 3, qt, lam, lam_init, smem);
      } else {
        const int s = a - 2048;
        attn_item(p, l, 32 + (s >> 2), s & 3, 0, lam, lam_init, smem);
      }
#endif
    }
  }
}

DI void gbar(unsigned* bar, unsigned& epoch) {
  __syncthreads();
  epoch += gridDim.x;
  if (otid() == 0) {
    __threadfence();
    __hip_atomic_fetch_add(bar, 1u, __ATOMIC_RELAXED, __HIP_MEMORY_SCOPE_AGENT);
    while (__hip_atomic_load(bar, __ATOMIC_RELAXED, __HIP_MEMORY_SCOPE_AGENT) < epoch) __builtin_amdgcn_s_sleep(2);
    __threadfence();
  }
  __syncthreads();
}

__global__ void __launch_bounds__(NTHR) fwd_megakernel(Params p) {
  extern __shared__ __attribute__((aligned(16))) unsigned char smem[];
  cg::grid_group grid = cg::this_grid();
#ifndef PH
#define PH 0xffff
#endif
  unsigned* bar = (unsigned*)(p.ws + WS_CTR + 64);
  unsigned epoch = 0;
  if (PH & 1) prologue(p, smem);
  grid.sync();
  if (PH & 2) ln_pass(p, 0, 0, smem);
  gbar(bar, epoch);
#pragma unroll 1
  for (int l = 0; l < 2; ++l) {
    if (PH & 4) phase_in_gate(p, l, smem);
    gbar(bar, epoch);
    if (PH & 8) phase_mixers(p, l, smem);
    gbar(bar, epoch);
    if (PH & 16) phase_mix(p, l, smem);
    gbar(bar, epoch);
    if (PH & 32) phase_res(p, l, 0, smem);
    gbar(bar, epoch);
    if (PH & 64) ln_pass(p, 1, l, smem);
    gbar(bar, epoch);
    if (PH & 128) phase_gu(p, l, smem);
    gbar(bar, epoch);
    if (PH & 256) phase_res(p, l, 1, smem);
    gbar(bar, epoch);
    if (PH & 512) ln_pass(p, 2, l, smem);
    if (l == 0) gbar(bar, epoch);
  }
}

extern "C" void kernel_launch(void* const* d_in, const int* in_sizes, int n_in, void* d_out, int out_size, void* d_ws,
                              size_t ws_size, hipStream_t stream) {
  static int grid_blocks = 0;
  if (!grid_blocks) {
    int dev = 0, cus = 0, per_cu = 0;
    hipGetDevice(&dev);
    hipDeviceGetAttribute(&cus, hipDeviceAttributeMultiprocessorCount, dev);
    if (hipFuncSetAttribute((const void*)fwd_megakernel, hipFuncAttributeMaxDynamicSharedMemorySize, LDS_BYTES) != hipSuccess)
      fprintf(stderr, "kernel_launch: hipFuncSetAttribute failed\n");
    if (hipOccupancyMaxActiveBlocksPerMultiprocessor(&per_cu, (const void*)fwd_megakernel, NTHR, LDS_BYTES) != hipSuccess || per_cu < 1) {
      fprintf(stderr, "kernel_launch: occupancy query gave %d\n", per_cu);
      per_cu = 1;
    }
    (void)hipGetLastError();
    grid_blocks = cus * per_cu;
    if (ws_size < WS_END) fprintf(stderr, "kernel_launch: workspace too small: %zu < %zu\n", ws_size, (size_t)WS_END);
  }
  if (hipMemsetAsync((char*)d_ws + WS_CTR, 0, 256, stream) != hipSuccess) fprintf(stderr, "kernel_launch: memset failed\n");
  Params p{};
  for (int i = 0; i < 30; ++i) p.in[i] = (const float*)d_in[i];
  p.out = (float*)d_out;
  p.ws = (unsigned char*)d_ws;
  void* args[] = {&p};
  hipError_t e = hipLaunchCooperativeKernel((const void*)fwd_megakernel, dim3(grid_blocks), dim3(NTHR), args, LDS_BYTES, stream);
  if (e != hipSuccess) fprintf(stderr, "cooperative launch failed: %s (grid %d)\n", hipGetErrorString(e), grid_blocks);
}
```

```cpp
#include <hip/hip_runtime.h>
#include <hip/hip_cooperative_groups.h>
#include <cstdio>
namespace cg = cooperative_groups;

#define DI __device__ __forceinline__
typedef unsigned short u16;
using bf16x8 = __attribute__((ext_vector_type(8))) short;
using f32x16 = __attribute__((ext_vector_type(16))) float;
#define MFMA(a, b, c) __builtin_amdgcn_mfma_f32_32x32x16_bf16((a), (b), (c), 0, 0, 0)

constexpr int TOKP = 65536, TOKS = 256, TOK = 65792;
constexpr int NTHR = 512;
constexpr float LN_EPS = 1e-5f;
constexpr float ALPHA = 1.41421356237f;
constexpr float LOG2E = 1.44269504089f;

constexpr size_t WS_WT_IN   = 0;
constexpr size_t WS_WT_GATE = WS_WT_IN + 2ull * 3584 * 1024 * 2;
constexpr size_t WS_WT_BRA  = WS_WT_GATE + 2ull * 2048 * 1024 * 2;
constexpr size_t WS_WT_BRB  = WS_WT_BRA + 2ull * 1024 * 512 * 2;
constexpr size_t WS_WT_O    = WS_WT_BRB + 2ull * 1024 * 512 * 2;
constexpr size_t WS_WT_GU   = WS_WT_O + 2ull * 1024 * 1024 * 2;
constexpr size_t WS_WT_DOWN = WS_WT_GU + 2ull * 5632 * 1024 * 2;
constexpr size_t WS_MOD     = WS_WT_DOWN + 2ull * 1024 * 2816 * 2;
constexpr size_t WS_GATES   = WS_MOD + 2ull * 40 * 6144 * 4;
constexpr size_t WS_CTR     = WS_GATES + (size_t)TOK * 8 * 4;
constexpr size_t WS_KS      = WS_CTR + 256;
constexpr size_t WS_VTS     = WS_KS + 2ull * 8 * 1056 * 512 * 2 + 65536;
constexpr size_t WS_MQKT_S  = WS_VTS + 2ull * 8 * 512 * 1056 * 2 + 65536;
constexpr size_t WS_MVT_S   = WS_MQKT_S + 8ull * 1024 * 32 * 2;
constexpr size_t WS_H       = WS_MVT_S + 8ull * 512 * 32 * 2;
constexpr size_t WS_AN      = WS_H;
constexpr size_t WS_MN      = WS_H + (size_t)TOK * 512 * 2;
constexpr size_t WS_ZQ      = WS_H + (size_t)TOK * 1024 * 2;
constexpr size_t WS_KB      = WS_ZQ + (size_t)TOK * 512 * 2;
constexpr size_t WS_VTP     = WS_KB + (size_t)TOKP * 512 * 2;
constexpr size_t WS_MQKT_P  = WS_VTP + 32ull * 512 * 2048 * 2;
constexpr size_t WS_MVT_P   = WS_MQKT_P + 32ull * 1024 * 2048 * 2;
constexpr size_t WS_MO      = WS_MVT_P + 32ull * 512 * 2048 * 2;
constexpr size_t WS_G       = WS_MO + (size_t)TOK * 512 * 2;
constexpr size_t WS_END     = WS_G + (size_t)TOK * 2048 * 2;
constexpr size_t WS_MIX     = WS_ZQ;
constexpr size_t WS_ACT     = WS_ZQ;

constexpr size_t O_YP  = 0;
constexpr size_t O_YS  = O_YP + (size_t)TOKP * 1024;
constexpr size_t O_KP  = O_YS + (size_t)TOKS * 1024;
constexpr size_t O_VP  = O_KP + 2ull * TOKP * 512;
constexpr size_t O_KSM = O_VP + 2ull * TOKP * 512;
constexpr size_t O_VSM = O_KSM + 2ull * TOKS * 512;
constexpr size_t O_CP  = O_VSM + 2ull * TOKS * 512;
constexpr size_t O_NP  = O_CP + 2ull * 32 * 4 * 128 * 128;
constexpr size_t O_MP  = O_NP + 2ull * 32 * 4 * 128;
constexpr size_t O_CVP = O_MP + 2ull * 32 * 4;
constexpr size_t O_CS  = O_CVP + 2ull * 32 * 3 * 1024;
constexpr size_t O_NS  = O_CS + 2ull * 8 * 4 * 128 * 128;
constexpr size_t O_MS  = O_NS + 2ull * 8 * 4 * 128;
constexpr size_t O_CVS = O_MS + 2ull * 8 * 4;

constexpr int LDS_BYTES = 143360;

struct Params {
  const float* in[30];
  float* out;
  unsigned char* ws;
};

DI u16 f2bf(float x) { unsigned u = __float_as_uint(x); u += 0x7fffu + ((u >> 16) & 1u); return (u16)(u >> 16); }
DI float bf2f(unsigned v) { return __uint_as_float(v << 16); }
DI unsigned pack2(float a, float b) { return (unsigned)f2bf(a) | ((unsigned)f2bf(b) << 16); }
DI float bflo(unsigned v) { return __uint_as_float(v << 16); }
DI float bfhi(unsigned v) { return __uint_as_float(v & 0xffff0000u); }
DI float sigmoidf_(float x) { return 1.f / (1.f + __expf(-x)); }
DI float siluf_(float x) { return x / (1.f + __expf(-x)); }
DI float fexp2(float x) { return __builtin_amdgcn_exp2f(x); }
DI int otid() { int t = threadIdx.x; asm volatile("" : "+v"(t)); return t; }
DI float shx(float v, int mask, int lane) { return __int_as_float(__builtin_amdgcn_ds_bpermute(((lane ^ mask) & 63) << 2, __float_as_int(v))); }
DI float shidx(float v, int src, int lane) { (void)lane; return __int_as_float(__builtin_amdgcn_ds_bpermute((src & 63) << 2, __float_as_int(v))); }
DI int crow(int i, int h) { return (i & 3) + 8 * (i >> 2) + 4 * h; }
DI bf16x8 pack8(const f32x16& x, int s) {
  uint4 u;
  u.x = pack2(x[8 * s + 0], x[8 * s + 1]); u.y = pack2(x[8 * s + 2], x[8 * s + 3]);
  u.z = pack2(x[8 * s + 4], x[8 * s + 5]); u.w = pack2(x[8 * s + 6], x[8 * s + 7]);
  return __builtin_bit_cast(bf16x8, u);
}
DI void zero16(f32x16& a) {
#pragma unroll
  for (int i = 0; i < 16; ++i) a[i] = 0.f;
}
DI int batch_of_row(int row) { return row < TOKP ? (row >> 11) : 32 + ((row - TOKP) >> 5); }

constexpr int GS_STRIDE = 144;
constexpr int GS_STAGE = (256 + 128) * GS_STRIDE;
constexpr int GS_BASE = 64;

DI void gemm_mainloop(f32x16 (&acc)[2][2], const u16* __restrict__ A, int lda, const u16* __restrict__ Wt, int ldw, int K,
                      int m0, int n0, unsigned char* smem) {
  const int tid = otid(), lane = tid & 63, w = tid >> 6;
  const int wm = w >> 1, wn = w & 1, r = lane & 31, h = lane >> 5;
  const int lrow = tid >> 3, lcc = tid & 7;
  const u16* ap = A + (size_t)(m0 + lrow) * lda + lcc * 8;
  const int bn = n0 + 2 * (lrow & 31) + ((lrow >> 5) & 1);
  const u16* bp = Wt + (size_t)bn * ldw + lcc * 8;
  const size_t astep = (size_t)64 * lda, bstep = (size_t)64 * ldw;
  unsigned char* sbase = smem + GS_BASE;
  const int woff = lrow * GS_STRIDE + lcc * 16;
  uint4 ra0, ra1, ra2, ra3, rb0, rb1;
  ra0 = *(const uint4*)(ap); ra1 = *(const uint4*)(ap + astep); ra2 = *(const uint4*)(ap + 2 * astep); ra3 = *(const uint4*)(ap + 3 * astep);
  rb0 = *(const uint4*)(bp); rb1 = *(const uint4*)(bp + bstep);
  *(uint4*)(sbase + woff) = ra0; *(uint4*)(sbase + woff + 64 * GS_STRIDE) = ra1;
  *(uint4*)(sbase + woff + 128 * GS_STRIDE) = ra2; *(uint4*)(sbase + woff + 192 * GS_STRIDE) = ra3;
  *(uint4*)(sbase + 256 * GS_STRIDE + woff) = rb0; *(uint4*)(sbase + 256 * GS_STRIDE + woff + 64 * GS_STRIDE) = rb1;
  const int nk = K >> 6;
  {
    const int adv = (1 < nk) ? 64 : 0;
    ap += adv; bp += adv;
    ra0 = *(const uint4*)(ap); ra1 = *(const uint4*)(ap + astep); ra2 = *(const uint4*)(ap + 2 * astep); ra3 = *(const uint4*)(ap + 3 * astep);
    rb0 = *(const uint4*)(bp); rb1 = *(const uint4*)(bp + bstep);
  }
  __syncthreads();
  const int aoff = (wm * 64 + r) * GS_STRIDE + h * 16;
  const int boff = 256 * GS_STRIDE + (wn * 64 + r) * GS_STRIDE + h * 16;
  for (int kt = 0; kt < nk; ++kt) {
    const int adv = (kt + 2 < nk) ? 64 : 0;
    ap += adv; bp += adv;
    const uint4 na0 = *(const uint4*)(ap), na1 = *(const uint4*)(ap + astep), na2 = *(const uint4*)(ap + 2 * astep), na3 = *(const uint4*)(ap + 3 * astep);
    const uint4 nb0 = *(const uint4*)(bp), nb1 = *(const uint4*)(bp + bstep);
    __builtin_amdgcn_sched_barrier(0);
    const unsigned char* st = sbase + (kt & 1) * GS_STAGE;
    bf16x8 fa[4][2], fb[4][2];
#pragma unroll
    for (int ks = 0; ks < 4; ++ks) {
      fa[ks][0] = *(const bf16x8*)(st + aoff + ks * 32);
      fa[ks][1] = *(const bf16x8*)(st + aoff + 32 * GS_STRIDE + ks * 32);
      fb[ks][0] = *(const bf16x8*)(st + boff + ks * 32);
      fb[ks][1] = *(const bf16x8*)(st + boff + 32 * GS_STRIDE + ks * 32);
    }
    __builtin_amdgcn_sched_barrier(0);
#pragma unroll
    for (int ks = 0; ks < 4; ++ks) {
      acc[0][0] = MFMA(fa[ks][0], fb[ks][0], acc[0][0]);
      acc[0][1] = MFMA(fa[ks][0], fb[ks][1], acc[0][1]);
      acc[1][0] = MFMA(fa[ks][1], fb[ks][0], acc[1][0]);
      acc[1][1] = MFMA(fa[ks][1], fb[ks][1], acc[1][1]);
    }
    __builtin_amdgcn_sched_barrier(0);
    {
      unsigned char* sn = sbase + ((kt + 1) & 1) * GS_STAGE;
      *(uint4*)(sn + woff) = ra0; *(uint4*)(sn + woff + 64 * GS_STRIDE) = ra1;
      *(uint4*)(sn + woff + 128 * GS_STRIDE) = ra2; *(uint4*)(sn + woff + 192 * GS_STRIDE) = ra3;
      *(uint4*)(sn + 256 * GS_STRIDE + woff) = rb0; *(uint4*)(sn + 256 * GS_STRIDE + woff + 64 * GS_STRIDE) = rb1;
    }
    __syncthreads();
    ra0 = na0; ra1 = na1; ra2 = na2; ra3 = na3; rb0 = nb0; rb1 = nb1;
  }
}

DI int map_row(int maptype, int s) {
  if (maptype == 1) return s < 3072 ? s : (s < 3080 ? -1 : s - 8);
  if (maptype == 2) return s < 2816 ? 2 * s : 2 * (s - 2816) + 1;
  return s;
}
DI void transpose_task(const float* __restrict__ src, int Nsrc, u16* __restrict__ dst, int dld, int maptype, int kt, int nt,
                       unsigned char* smem) {
  float* tile = (float*)(smem + 64);
  const int tid = otid();
  const int k0 = kt * 64, s0 = nt * 64;
#pragma unroll
  for (int i = 0; i < 2; ++i) {
    const int kr = (tid >> 4) + 32 * i, nc = (tid & 15) * 4;
    float4 v = make_float4(0.f, 0.f, 0.f, 0.f);
    if (s0 + nc < Nsrc) v = *(const float4*)(src + (size_t)(k0 + kr) * Nsrc + s0 + nc);
    tile[kr * 65 + nc + 0] = v.x; tile[kr * 65 + nc + 1] = v.y; tile[kr * 65 + nc + 2] = v.z; tile[kr * 65 + nc + 3] = v.w;
  }
  __syncthreads();
  {
    const int n = tid >> 3, kc = (tid & 7) * 8;
    const int s = s0 + n;
    const int dr = (s < Nsrc) ? map_row(maptype, s) : -1;
    if (dr >= 0) {
      uint4 o;
      o.x = pack2(tile[(kc + 0) * 65 + n], tile[(kc + 1) * 65 + n]);
      o.y = pack2(tile[(kc + 2) * 65 + n], tile[(kc + 3) * 65 + n]);
      o.z = pack2(tile[(kc + 4) * 65 + n], tile[(kc + 5) * 65 + n]);
      o.w = pack2(tile[(kc + 6) * 65 + n], tile[(kc + 7) * 65 + n]);
      *(uint4*)(dst + (size_t)dr * dld + k0 + kc) = o;
    }
  }
  __syncthreads();
}

DI void adaln_task(const Params& p, int task, unsigned char* smem) {
  const int bhalf = task & 1, cg_ = (task >> 1) % 96, l = (task >> 1) / 96;
  float* cs = (float*)(smem + 64);
  float* red = (float*)(smem + 64 + 20 * 1024 * 4);
  const int tid = otid();
  const float* cp = p.in[2]; const float* csm = p.in[3];
  for (int idx = tid; idx < 20 * 1024; idx += NTHR) {
    const int bb = idx >> 10, d = idx & 1023, b = bhalf * 20 + bb;
    const float c = b < 32 ? cp[b * 1024 + d] : csm[(b - 32) * 1024 + d];
    cs[idx] = siluf_(c);
  }
  __syncthreads();
  const int dseg = tid >> 6, e = cg_ * 64 + (tid & 63);
  const float* wp = p.in[10] + ((size_t)l * 1024 + dseg * 128) * 6144 + e;
  float acc[20];
#pragma unroll
  for (int i = 0; i < 20; ++i) acc[i] = 0.f;
  for (int d = 0; d < 128; ++d) {
    const float wv = wp[(size_t)d * 6144];
    const float* c0 = cs + dseg * 128 + d;
#pragma unroll
    for (int i = 0; i < 20; ++i) acc[i] += c0[i * 1024] * wv;
  }
#pragma unroll
  for (int i = 0; i < 20; ++i) red[(dseg * 20 + i) * 64 + (tid & 63)] = acc[i];
  __syncthreads();
  float* mod = (float*)(p.ws + WS_MOD);
  for (int idx = tid; idx < 20 * 64; idx += NTHR) {
    const int bb = idx >> 6, ec = idx & 63;
    float s = 0.f;
#pragma unroll
    for (int q = 0; q < 8; ++q) s += red[(q * 20 + bb) * 64 + ec];
    const int ee = cg_ * 64 + ec;
    mod[((size_t)l * 40 + bhalf * 20 + bb) * 6144 + ee] = s + p.in[11][l * 6144 + ee];
  }
  __syncthreads();
}

DI void prologue(const Params& p, unsigned char* smem) {
  const int WT_TASKS_L = 912 + 512 + 128 + 128 + 256 + 1408 + 704;
  const int N_WT = 2 * WT_TASKS_L;
  const int N_ADA = 384, N_CK = 512, N_CV = 2048;
  const int total = N_WT + N_ADA + N_CK + N_CV;
  for (int task = blockIdx.x; task < total; task += gridDim.x) {
    if (task < N_WT) {
      const int l = task / WT_TASKS_L; int t = task % WT_TASKS_L;
      if (t < 912) { transpose_task(p.in[12] + (size_t)l * 1024 * 3592, 3592, (u16*)(p.ws + WS_WT_IN) + (size_t)l * 3584 * 1024, 1024, 1, t / 57, t % 57, smem); continue; }
      t -= 912;
      if (t < 512) { transpose_task(p.in[21] + (size_t)l * 1024 * 2048, 2048, (u16*)(p.ws + WS_WT_GATE) + (size_t)l * 2048 * 1024, 1024, 0, t / 32, t % 32, smem); continue; }
      t -= 512;
      if (t < 128) { transpose_task(p.in[19] + (size_t)l * 512 * 1024, 1024, (u16*)(p.ws + WS_WT_BRA) + (size_t)l * 1024 * 512, 512, 0, t / 16, t % 16, smem); continue; }
      t -= 128;
      if (t < 128) { transpose_task(p.in[20] + (size_t)l * 512 * 1024, 1024, (u16*)(p.ws + WS_WT_BRB) + (size_t)l * 1024 * 512, 512, 0, t / 16, t % 16, smem); continue; }
      t -= 128;
      if (t < 256) { transpose_task(p.in[23] + (size_t)l * 1024 * 1024, 1024, (u16*)(p.ws + WS_WT_O) + (size_t)l * 1024 * 1024, 1024, 0, t / 16, t % 16, smem); continue; }
      t -= 256;
      if (t < 1408) { transpose_task(p.in[26] + (size_t)l * 1024 * 5632, 5632, (u16*)(p.ws + WS_WT_GU) + (size_t)l * 5632 * 1024, 1024, 2, t / 88, t % 88, smem); continue; }
      t -= 1408;
      transpose_task(p.in[27] + (size_t)l * 2816 * 1024, 1024, (u16*)(p.ws + WS_WT_DOWN) + (size_t)l * 1024 * 2816, 2816, 0, t / 16, t % 16, smem);
    } else if (task < N_WT + N_ADA) {
      adaln_task(p, task - N_WT, smem);
    } else if (task < N_WT + N_ADA + N_CK) {
      const int t = task - N_WT - N_ADA;
      const float4* src = (const float4*)p.in[4];
      u16* dst = (u16*)(p.ws + WS_KS);
#pragma unroll
      for (int i = 0; i < 8; ++i) {
        const size_t f4 = (size_t)t * 4096 + i * 512 + otid();
        const float4 v = src[f4];
        const size_t e = f4 * 4;
        const size_t lb = e / (1024 * 512), rem = e % (1024 * 512);
        uint2 o; o.x = pack2(v.x, v.y); o.y = pack2(v.z, v.w);
        *(uint2*)(dst + lb * (1056 * 512) + rem) = o;
      }
    } else {
      const int t = task - N_WT - N_ADA - N_CK;
      const int lb = t >> 7, tt = t & 127;
      transpose_task(p.in[5] + (size_t)lb * 1024 * 512, 512, (u16*)(p.ws + WS_VTS) + (size_t)lb * 512 * 1056, 1056, 0, tt >> 3, tt & 7, smem);
    }
  }
}

DI float wave_sum(float v, int lane) {
#pragma unroll
  for (int off = 32; off >= 1; off >>= 1) v += shx(v, off, lane);
  return v;
}
DI void ln_pass(const Params& p, int mode, int l, unsigned char* smem) {
  const int tid = otid();
  const int lane = tid & 63, w = tid >> 6;
  const bool first = mode != 0;
  const bool second = (mode != 2) || (l + 1 < 2);
  const bool gates = (mode == 0) || (mode == 2 && l + 1 < 2);
  const int lm = (mode == 2) ? l + 1 : l;
  const int shi = (mode == 1) ? 3 : 0;
  const float* lng = (mode == 1) ? p.in[24] + l * 1024 : p.in[28] + l * 1024;
  const float* lnb = (mode == 1) ? p.in[25] + l * 1024 : p.in[29] + l * 1024;
  const float* mod = (const float*)(p.ws + WS_MOD);
  u16* H = (u16*)(p.ws + WS_H);
  float* gout = (float*)(p.ws + WS_GATES);
  float* wl = (float*)(smem + 64);
  float bif[8];
  if (gates) {
    const float* wi = p.in[12] + (size_t)lm * 1024 * 3592 + 3072;
    for (int idx = tid; idx < 8192; idx += NTHR) {
      const int c = idx >> 3, j = idx & 7;
      wl[j * 1024 + c] = wi[(size_t)c * 3592 + j];
    }
#pragma unroll
    for (int j = 0; j < 8; ++j) bif[j] = p.in[13][lm * 8 + j];
  }
  __syncthreads();
  for (int row = blockIdx.x * 8 + w; row < TOK; row += gridDim.x * 8) {
    float* xr = p.out + (size_t)row * 1024;
    const float* src = (mode == 0) ? (row < TOKP ? p.in[0] + (size_t)row * 1024 : p.in[1] + (size_t)(row - TOKP) * 1024) : xr;
    float v[16];
#pragma unroll
    for (int i = 0; i < 4; ++i) {
      const float4 t = *(const float4*)(src + i * 256 + lane * 4);
      v[i * 4 + 0] = t.x; v[i * 4 + 1] = t.y; v[i * 4 + 2] = t.z; v[i * 4 + 3] = t.w;
    }
    if (first) {
      float s = 0.f;
#pragma unroll
      for (int i = 0; i < 16; ++i) s += v[i];
      const float mean = wave_sum(s, lane) * (1.f / 1024.f);
      float q = 0.f;
#pragma unroll
      for (int i = 0; i < 16; ++i) { v[i] -= mean; q += v[i] * v[i]; }
      const float rstd = rsqrtf(wave_sum(q, lane) * (1.f / 1024.f) + LN_EPS);
#pragma unroll
      for (int i = 0; i < 4; ++i) {
        const int c = i * 256 + lane * 4;
        const float4 g = *(const float4*)(lng + c);
        const float4 b = *(const float4*)(lnb + c);
        v[i * 4 + 0] = v[i * 4 + 0] * rstd * g.x + b.x; v[i * 4 + 1] = v[i * 4 + 1] * rstd * g.y + b.y;
        v[i * 4 + 2] = v[i * 4 + 2] * rstd * g.z + b.z; v[i * 4 + 3] = v[i * 4 + 3] * rstd * g.w + b.w;
        *(float4*)(xr + c) = make_float4(v[i * 4 + 0], v[i * 4 + 1], v[i * 4 + 2], v[i * 4 + 3]);
      }
    }
    if (second) {
      float s = 0.f;
#pragma unroll
      for (int i = 0; i < 16; ++i) s += v[i];
      const float mean = wave_sum(s, lane) * (1.f / 1024.f);
      float q = 0.f;
#pragma unroll
      for (int i = 0; i < 16; ++i) { v[i] -= mean; q += v[i] * v[i]; }
      const float rstd = rsqrtf(wave_sum(q, lane) * (1.f / 1024.f) + LN_EPS);
      const int b = batch_of_row(row);
      const float* mb = mod + ((size_t)lm * 40 + b) * 6144;
#pragma unroll
      for (int i = 0; i < 4; ++i) {
        const int c = i * 256 + lane * 4;
        const float4 sh = *(const float4*)(mb + shi * 1024 + c);
        const float4 sc = *(const float4*)(mb + (shi + 1) * 1024 + c);
        v[i * 4 + 0] = v[i * 4 + 0] * rstd * (1.f + sc.x) + sh.x; v[i * 4 + 1] = v[i * 4 + 1] * rstd * (1.f + sc.y) + sh.y;
        v[i * 4 + 2] = v[i * 4 + 2] * rstd * (1.f + sc.z) + sh.z; v[i * 4 + 3] = v[i * 4 + 3] * rstd * (1.f + sc.w) + sh.w;
        uint2 o; o.x = pack2(v[i * 4 + 0], v[i * 4 + 1]); o.y = pack2(v[i * 4 + 2], v[i * 4 + 3]);
        *(uint2*)(H + (size_t)row * 1024 + c) = o;
      }
      if (gates) {
        float g8[8];
#pragma unroll
        for (int j = 0; j < 8; ++j) {
          float s2 = 0.f;
#pragma unroll
          for (int i = 0; i < 4; ++i) {
            const float4 wv = *(const float4*)(wl + j * 1024 + i * 256 + lane * 4);
            s2 += v[i * 4] * wv.x + v[i * 4 + 1] * wv.y + v[i * 4 + 2] * wv.z + v[i * 4 + 3] * wv.w;
          }
          g8[j] = wave_sum(s2, lane) + bif[j];
        }
        if (lane == 0) {
          *(float4*)(gout + (size_t)row * 8) = make_float4(g8[0], g8[1], g8[2], g8[3]);
          *(float4*)(gout + (size_t)row * 8 + 4) = make_float4(g8[4], g8[5], g8[6], g8[7]);
        }
      }
    }
  }
}

DI void phase_in_gate(const Params& p, int l, unsigned char* smem) {
  const int tid = otid(), lane = tid & 63, w = tid >> 6;
  const int wm = w >> 1, wn = w & 1, r = lane & 31, h = lane >> 5;
  const u16* H = (const u16*)(p.ws + WS_H);
  const int NT_IN = 28, NT_G = 16, MT = 257;
  const int total = MT * (NT_IN + NT_G);
  for (int t = blockIdx.x; t < total; t += gridDim.x) {
    f32x16 acc[2][2];
#pragma unroll
    for (int a = 0; a < 2; ++a)
#pragma unroll
      for (int b = 0; b < 2; ++b) zero16(acc[a][b]);
    if (t < MT * NT_IN) {
      const int mt = t / NT_IN, nt = t % NT_IN;
      const int m0 = mt * 256, n0 = nt * 128;
      gemm_mainloop(acc, H, 1024, (const u16*)(p.ws + WS_WT_IN) + (size_t)l * 3584 * 1024, 1024, 1024, m0, n0, smem);
      const bool prompt = m0 < TOKP;
      const int n = n0 + wn * 64 + 2 * r;
#pragma unroll
      for (int mi = 0; mi < 2; ++mi) {
        const int rb = m0 + wm * 64 + mi * 32 + 4 * h;
        if (n0 < 512) {
          u16* ZQ = (u16*)(p.ws + WS_ZQ);
#pragma unroll
          for (int i = 0; i < 16; ++i) {
            const int row = rb + (i & 3) + 8 * (i >> 2);
            *(unsigned*)(ZQ + (size_t)row * 512 + n) = pack2(acc[mi][0][i], acc[mi][1][i]);
          }
        } else if (n0 < 1536) {
          const bool isk = n0 < 1024;
          const int nn = n - (isk ? 512 : 1024);
          float* of = p.out + (isk ? (prompt ? O_KP : O_KSM) : (prompt ? O_VP : O_VSM));
#pragma unroll
          for (int i = 0; i < 16; ++i) {
            const int row = rb + (i & 3) + 8 * (i >> 2);
            const size_t orow = prompt ? ((size_t)l * TOKP + row) : ((size_t)l * TOKS + (row - TOKP));
            *(float2*)(of + orow * 512 + nn) = make_float2(acc[mi][0][i], acc[mi][1][i]);
            if (isk) {
              u16* kd;
              if (prompt) kd = (u16*)(p.ws + WS_KB) + (size_t)row * 512 + nn;
              else { const int rs = row - TOKP; kd = (u16*)(p.ws + WS_KS) + ((size_t)(l * 8 + (rs >> 5)) * 1056 + 1024 + (rs & 31)) * 512 + nn; }
              *(unsigned*)kd = pack2(acc[mi][0][i], acc[mi][1][i]);
            }
          }
          if (!isk) {
#pragma unroll
            for (int g = 0; g < 4; ++g) {
              const int row = rb + 8 * g;
#pragma unroll
              for (int j = 0; j < 2; ++j) {
                u16* vd;
                if (prompt) vd = (u16*)(p.ws + WS_VTP) + ((size_t)(row >> 11) * 512 + nn + j) * 2048 + (row & 2047);
                else { const int rs = row - TOKP; vd = (u16*)(p.ws + WS_VTS) + ((size_t)(l * 8 + (rs >> 5)) * 512 + nn + j) * 1056 + 1024 + (rs & 31); }
                uint2 o; o.x = pack2(acc[mi][j][4 * g], acc[mi][j][4 * g + 1]); o.y = pack2(acc[mi][j][4 * g + 2], acc[mi][j][4 * g + 3]);
                *(uint2*)vd = o;
              }
            }
          }
        } else if (n0 < 3072) {
          const bool isqk = n0 < 2560;
          const int ch = n - (isqk ? 1536 : 2560);
          const int nchn = isqk ? 1024 : 512;
#pragma unroll
          for (int g = 0; g < 4; ++g) {
            const int row = rb + 8 * g;
#pragma unroll
            for (int j = 0; j < 2; ++j) {
              u16* d;
              if (prompt) d = (u16*)(p.ws + (isqk ? WS_MQKT_P : WS_MVT_P)) + ((size_t)(row >> 11) * nchn + ch + j) * 2048 + (row & 2047);
              else { const int rs = row - TOKP; d = (u16*)(p.ws + (isqk ? WS_MQKT_S : WS_MVT_S)) + ((size_t)(rs >> 5) * nchn + ch + j) * 32 + (rs & 31); }
              uint2 o; o.x = pack2(acc[mi][j][4 * g], acc[mi][j][4 * g + 1]); o.y = pack2(acc[mi][j][4 * g + 2], acc[mi][j][4 * g + 3]);
              *(uint2*)d = o;
            }
          }
          if (isqk) {
#pragma unroll
            for (int i = 0; i < 16; ++i) {
              const int row = rb + (i & 3) + 8 * (i >> 2);
              if (prompt) {
                const int tt = row & 2047;
                if (tt >= 2045) *(float2*)(p.out + O_CVP + ((size_t)(l * 32 + (row >> 11)) * 3 + (tt - 2045)) * 1024 + ch) = make_float2(acc[mi][0][i], acc[mi][1][i]);
              } else {
                const int rs = row - TOKP, tt = rs & 31;
                if (tt >= 29) *(float2*)(p.out + O_CVS + ((size_t)(l * 8 + (rs >> 5)) * 3 + (tt - 29)) * 1024 + ch) = make_float2(acc[mi][0][i], acc[mi][1][i]);
              }
            }
          }
        } else {
          u16* MO = (u16*)(p.ws + WS_MO);
          const int nn = n - 3072;
#pragma unroll
          for (int i = 0; i < 16; ++i) {
            const int row = rb + (i & 3) + 8 * (i >> 2);
            *(unsigned*)(MO + (size_t)row * 512 + nn) = pack2(sigmoidf_(acc[mi][0][i]), sigmoidf_(acc[mi][1][i]));
          }
        }
      }
    } else {
      const int t2 = t - MT * NT_IN;
      const int mt = t2 / NT_G, nt = t2 % NT_G;
      const int m0 = mt * 256, n0 = nt * 128;
      gemm_mainloop(acc, H, 1024, (const u16*)(p.ws + WS_WT_GATE) + (size_t)l * 2048 * 1024, 1024, 1024, m0, n0, smem);
      const int n = n0 + wn * 64 + 2 * r;
      const float2 bg = *(const float2*)(p.in[22] + l * 2048 + n);
      u16* G = (u16*)(p.ws + WS_G);
#pragma unroll
      for (int mi = 0; mi < 2; ++mi) {
        const int rb = m0 + wm * 64 + mi * 32 + 4 * h;
#pragma unroll
        for (int i = 0; i < 16; ++i) {
          const int row = rb + (i & 3) + 8 * (i >> 2);
          *(unsigned*)(G + (size_t)row * 2048 + n) = pack2(sigmoidf_(acc[mi][0][i] + bg.x), sigmoidf_(acc[mi][1][i] + bg.y));
        }
      }
    }
  }
}

DI void phase_mix(const Params& p, int l, unsigned char* smem) {
  const int tid = otid(), lane = tid & 63, w = tid >> 6;
  const int wm = w >> 1, wn = w & 1, r = lane & 31, h = lane >> 5;
  const u16* G = (const u16*)(p.ws + WS_G);
  u16* MIX = (u16*)(p.ws + WS_MIX);
  const int NT = 8, MT = 257;
  const int cnt = (MT * NT - (int)blockIdx.x + (int)gridDim.x - 1) / (int)gridDim.x;
  for (int it = 0; it < 2 * cnt; ++it) {
    const int t = blockIdx.x + (it >> 1) * gridDim.x;
    const int half = it & 1;
    const int mt = t / NT, nt = t % NT;
    const int m0 = mt * 256, n0 = nt * 128;
    const int n = n0 + wn * 64 + 2 * r;
    f32x16 acc[2][2];
#pragma unroll
    for (int a = 0; a < 2; ++a)
#pragma unroll
      for (int b = 0; b < 2; ++b) zero16(acc[a][b]);
    const u16* Ap = (const u16*)(p.ws + (half ? WS_MN : WS_AN));
    const u16* Wp = (const u16*)(p.ws + (half ? WS_WT_BRB : WS_WT_BRA)) + (size_t)l * 1024 * 512;
    gemm_mainloop(acc, Ap, 512, Wp, 512, 512, m0, n0, smem);
    const int gofs = half * 1024 + n;
#pragma unroll
    for (int mi = 0; mi < 2; ++mi) {
      const int rb = m0 + wm * 64 + mi * 32 + 4 * h;
#pragma unroll
      for (int i = 0; i < 16; ++i) {
        const int row = rb + (i & 3) + 8 * (i >> 2);
        const unsigned g = *(const unsigned*)(G + (size_t)row * 2048 + gofs);
        float o0 = bflo(g) * acc[mi][0][i], o1 = bfhi(g) * acc[mi][1][i];
        unsigned* mp = (unsigned*)(MIX + (size_t)row * 1024 + n);
        if (half) { const unsigned pr = *mp; o0 += bflo(pr); o1 += bfhi(pr); }
        *mp = pack2(o0, o1);
      }
    }
  }
}

DI void phase_res(const Params& p, int l, int mode, unsigned char* smem) {
  const int tid = otid(), lane = tid & 63, w = tid >> 6;
  const int wm = w >> 1, wn = w & 1, r = lane & 31, h = lane >> 5;
  const float* mod = (const float*)(p.ws + WS_MOD);
  const int NT = 8, MT = 257;
  for (int t = blockIdx.x; t < MT * NT; t += gridDim.x) {
    const int mt = t / NT, nt = t % NT;
    const int m0 = mt * 256, n0 = nt * 128;
    const int n = n0 + wn * 64 + 2 * r;
    f32x16 acc[2][2];
#pragma unroll
    for (int a = 0; a < 2; ++a)
#pragma unroll
      for (int b = 0; b < 2; ++b) zero16(acc[a][b]);
    if (mode == 0) gemm_mainloop(acc, (const u16*)(p.ws + WS_MIX), 1024, (const u16*)(p.ws + WS_WT_O) + (size_t)l * 1024 * 1024, 1024, 1024, m0, n0, smem);
    else gemm_mainloop(acc, (const u16*)(p.ws + WS_ACT), 2816, (const u16*)(p.ws + WS_WT_DOWN) + (size_t)l * 1024 * 2816, 2816, 2816, m0, n0, smem);
    const int gi = (mode == 0) ? 2 : 5;
#pragma unroll
    for (int mi = 0; mi < 2; ++mi) {
      const int rb = m0 + wm * 64 + mi * 32 + 4 * h;
#pragma unroll
      for (int i = 0; i < 16; ++i) {
        const int row = rb + (i & 3) + 8 * (i >> 2);
        const int b = batch_of_row(row);
        const float2 gg = *(const float2*)(mod + ((size_t)l * 40 + b) * 6144 + gi * 1024 + n);
        float* xr = p.out + (size_t)row * 1024 + n;
        const float* xs = (mode == 0 && l == 0) ? (row < TOKP ? p.in[0] + (size_t)row * 1024 + n : p.in[1] + (size_t)(row - TOKP) * 1024 + n) : xr;
        const float2 xv = *(const float2*)xs;
        *(float2*)xr = make_float2(ALPHA * xv.x + (1.f + gg.x) * acc[mi][0][i], ALPHA * xv.y + (1.f + gg.y) * acc[mi][1][i]);
      }
    }
  }
}

DI void phase_gu(const Params& p, int l, unsigned char* smem) {
  const int tid = otid(), lane = tid & 63, w = tid >> 6;
  const int wm = w >> 1, wn = w & 1, r = lane & 31, h = lane >> 5;
  u16* ACT = (u16*)(p.ws + WS_ACT);
  const int NT = 44, MT = 257;
  for (int t = blockIdx.x; t < MT * NT; t += gridDim.x) {
    const int mt = t / NT, nt = t % NT;
    const int m0 = mt * 256, n0 = nt * 128;
    f32x16 acc[2][2];
#pragma unroll
    for (int a = 0; a < 2; ++a)
#pragma unroll
      for (int b = 0; b < 2; ++b) zero16(acc[a][b]);
    gemm_mainloop(acc, (const u16*)(p.ws + WS_H), 1024, (const u16*)(p.ws + WS_WT_GU) + (size_t)l * 5632 * 1024, 1024, 1024, m0, n0, smem);
    const int f = (n0 >> 1) + wn * 32 + r;
#pragma unroll
    for (int mi = 0; mi < 2; ++mi) {
      const int rb = m0 + wm * 64 + mi * 32 + 4 * h;
#pragma unroll
      for (int i = 0; i < 16; ++i) {
        const int row = rb + (i & 3) + 8 * (i >> 2);
        ACT[(size_t)row * 2816 + f] = f2bf(siluf_(acc[mi][0][i]) * acc[mi][1][i]);
      }
    }
  }
}

constexpr int AT_BASE = 64;
constexpr int AT_KBYTES = 64 * 272;
constexpr int AT_VBYTES = 128 * 136;
constexpr int AT_STAGE = AT_KBYTES + AT_VBYTES;

DI void attn_item(const Params& p, int l, int b, int head, int qt, float lam, float lam_init, unsigned char* smem) {
  const int tid = otid(), lane = tid & 63, w = tid >> 6, r = lane & 31, h = lane >> 5;
  const int comp = w & 1, rg = w >> 1;
  const bool prompt = b < 32;
  const int bs = b - 32;
  const u16* Kg = prompt ? (const u16*)(p.ws + WS_KB) + (size_t)b * 2048 * 512 : (const u16*)(p.ws + WS_KS) + (size_t)(l * 8 + bs) * 1056 * 512;
  const u16* Vg = prompt ? (const u16*)(p.ws + WS_VTP) + (size_t)b * 512 * 2048 : (const u16*)(p.ws + WS_VTS) + (size_t)(l * 8 + bs) * 512 * 1056;
  const int ldT = prompt ? 2048 : 1056;
  const int nkt = prompt ? 2 * qt + 2 : 17;
  const int nkeys = prompt ? 2048 : 1056;
  const int qtok0 = prompt ? b * 2048 + qt * 128 : TOKP + bs * 32;
  const int qpos0 = prompt ? qt * 128 : 1024;
  const bool active = prompt || rg == 0;
  const int my_nkt = prompt ? (rg < 2 ? nkt - 1 : nkt) : nkt;
  const u16* ZQ = (const u16*)(p.ws + WS_ZQ);
  bf16x8 qf[4];
  {
    const int qrow = active ? qtok0 + rg * 32 + r : qtok0;
#pragma unroll
    for (int ks = 0; ks < 4; ++ks) qf[ks] = *(const bf16x8*)(ZQ + (size_t)qrow * 512 + head * 128 + comp * 64 + ks * 16 + h * 8);
  }
  const float slope2 = exp2f(-2.f * (head + 1)) * LOG2E;
  const float c1 = 0.125f * LOG2E;
  const int qpos = qpos0 + rg * 32 + r;
  f32x16 O[4];
#pragma unroll
  for (int i = 0; i < 4; ++i) zero16(O[i]);
  float m_run = -INFINITY, l_run = 0.f;

  const int krow = tid >> 4, kcc = tid & 15;
  const int vrow = tid >> 3, vcc = tid & 7;
  const u16* kp = Kg + (size_t)krow * 512 + head * 128 + kcc * 8;
  const u16* vp = Vg + (size_t)(head * 128 + vrow) * ldT + vcc * 8;
  uint4 rk0, rk1, rv0, rv1;
  unsigned char* sb = smem + AT_BASE;
  rk0 = *(const uint4*)kp; rk1 = *(const uint4*)(kp + 32 * 512);
  rv0 = *(const uint4*)vp; rv1 = *(const uint4*)(vp + (size_t)64 * ldT);
  {
    *(uint4*)(sb + krow * 272 + kcc * 16) = rk0;
    *(uint4*)(sb + (krow + 32) * 272 + kcc * 16) = rk1;
    *(uint2*)(sb + AT_KBYTES + vrow * 136 + vcc * 16) = make_uint2(rv0.x, rv0.y);
    *(uint2*)(sb + AT_KBYTES + vrow * 136 + vcc * 16 + 8) = make_uint2(rv0.z, rv0.w);
    *(uint2*)(sb + AT_KBYTES + (vrow + 64) * 136 + vcc * 16) = make_uint2(rv1.x, rv1.y);
    *(uint2*)(sb + AT_KBYTES + (vrow + 64) * 136 + vcc * 16 + 8) = make_uint2(rv1.z, rv1.w);
  }
  __syncthreads();
  for (int kt = 0; kt < nkt; ++kt) {
    const bool more = kt + 1 < nkt;
    if (more) {
      kp += 64 * 512; vp += 64;
      rk0 = *(const uint4*)kp; rk1 = *(const uint4*)(kp + 32 * 512);
      rv0 = *(const uint4*)vp; rv1 = *(const uint4*)(vp + (size_t)64 * ldT);
    }
    if (active && kt < my_nkt) {
      const unsigned char* Kt = sb + (kt & 1) * AT_STAGE;
      const unsigned char* Vt = Kt + AT_KBYTES;
      f32x16 s[2];
      zero16(s[0]); zero16(s[1]);
#pragma unroll
      for (int ks = 0; ks < 4; ++ks) {
#pragma unroll
        for (int sub = 0; sub < 2; ++sub) {
          const bf16x8 kf = *(const bf16x8*)(Kt + (sub * 32 + r) * 272 + (comp * 64 + ks * 16 + h * 8) * 2);
          s[sub] = MFMA(kf, qf[ks], s[sub]);
        }
      }
      float mx = -INFINITY;
#pragma unroll
      for (int sub = 0; sub < 2; ++sub)
#pragma unroll
        for (int i = 0; i < 16; ++i) {
          const int key = kt * 64 + sub * 32 + crow(i, h);
          float v = s[sub][i] * c1 - slope2 * fabsf((float)(qpos - key));
          if (!prompt && key >= nkeys) v = -INFINITY;
          s[sub][i] = v;
          mx = fmaxf(mx, v);
        }
      mx = fmaxf(mx, shx(mx, 32, lane));
      const float m_new = fmaxf(m_run, mx);
      const float alpha = fexp2(m_run - m_new);
      m_run = m_new;
      float lsum = 0.f;
#pragma unroll
      for (int sub = 0; sub < 2; ++sub)
#pragma unroll
        for (int i = 0; i < 16; ++i) {
          const float pv = fexp2(s[sub][i] - m_new);
          lsum += pv;
          s[sub][i] = pv;
        }
      l_run = l_run * alpha + lsum;
#pragma unroll
      for (int dt = 0; dt < 4; ++dt)
#pragma unroll
        for (int i = 0; i < 16; ++i) O[dt][i] *= alpha;
#pragma unroll
      for (int sub = 0; sub < 2; ++sub)
#pragma unroll
        for (int s2 = 0; s2 < 2; ++s2) {
          const bf16x8 pf = pack8(s[sub], s2);
#pragma unroll
          for (int dt = 0; dt < 4; ++dt) {
            const unsigned char* va = Vt + (dt * 32 + r) * 136 + (sub * 32 + s2 * 16 + 4 * h) * 2;
            const uint2 lo = *(const uint2*)va;
            const uint2 hi = *(const uint2*)(va + 16);
            const uint4 vv = make_uint4(lo.x, lo.y, hi.x, hi.y);
            O[dt] = MFMA(__builtin_bit_cast(bf16x8, vv), pf, O[dt]);
          }
        }
    }
    if (more) {
      unsigned char* sn = sb + ((kt + 1) & 1) * AT_STAGE;
      *(uint4*)(sn + krow * 272 + kcc * 16) = rk0;
      *(uint4*)(sn + (krow + 32) * 272 + kcc * 16) = rk1;
      *(uint2*)(sn + AT_KBYTES + vrow * 136 + vcc * 16) = make_uint2(rv0.x, rv0.y);
      *(uint2*)(sn + AT_KBYTES + vrow * 136 + vcc * 16 + 8) = make_uint2(rv0.z, rv0.w);
      *(uint2*)(sn + AT_KBYTES + (vrow + 64) * 136 + vcc * 16) = make_uint2(rv1.x, rv1.y);
      *(uint2*)(sn + AT_KBYTES + (vrow + 64) * 136 + vcc * 16 + 8) = make_uint2(rv1.z, rv1.w);
    }
    __syncthreads();
  }
  float* exch = (float*)(smem + AT_BASE);
  float inv = 0.f;
  if (active) { const float lt = l_run + shx(l_run, 32, lane); inv = 1.f / lt; }
  if (active && comp == 1) {
    const float sc = inv * lam;
#pragma unroll
    for (int dt = 0; dt < 4; ++dt)
#pragma unroll
      for (int i = 0; i < 16; ++i) exch[(rg * 64 + dt * 16 + i) * 64 + lane] = O[dt][i] * sc;
  }
  __syncthreads();
  if (active && comp == 0) {
    float ss = 0.f;
#pragma unroll
    for (int dt = 0; dt < 4; ++dt)
#pragma unroll
      for (int i = 0; i < 16; ++i) {
        const float o = O[dt][i] * inv - exch[(rg * 64 + dt * 16 + i) * 64 + lane];
        O[dt][i] = o;
        ss += o * o;
      }
    ss += shx(ss, 32, lane);
    const float rs = rsqrtf(ss * (1.f / 128.f) + LN_EPS) * (1.f - lam_init);
    u16* AN = (u16*)(p.ws + WS_AN) + (size_t)(qtok0 + rg * 32 + r) * 512 + head * 128;
    const float* gw = p.in[17] + l * 512 + head * 128;
#pragma unroll
    for (int dt = 0; dt < 4; ++dt)
#pragma unroll
      for (int g = 0; g < 4; ++g) {
        const int dv = dt * 32 + 8 * g + 4 * h;
        const float4 g4 = *(const float4*)(gw + dv);
        uint2 o;
        o.x = pack2(O[dt][4 * g] * rs * g4.x, O[dt][4 * g + 1] * rs * g4.y);
        o.y = pack2(O[dt][4 * g + 2] * rs * g4.z, O[dt][4 * g + 3] * rs * g4.w);
        *(uint2*)(AN + dv) = o;
      }
  }
}

constexpr int ML_QS = 64;
constexpr int ML_KS = ML_QS + 64 * 272;
constexpr int ML_KT = ML_KS + 64 * 272;
constexpr int ML_VT = ML_KT + 128 * 144;
constexpr int ML_CB = ML_VT + 128 * 144;
constexpr int ML_HB = ML_CB + 128 * 272;
constexpr int ML_SM = ML_HB + 64 * 132 * 4;
static_assert(ML_SM + 528 * 4 <= LDS_BYTES, "lds");

DI void mlstm_item(const Params& p, int l, int b, int head, unsigned char* smem) {
  const int tid = otid(), lane = tid & 63, w = tid >> 6, r = lane & 31, h = lane >> 5;
  const bool prompt = b < 32;
  const int bs = b - 32;
  const int T = prompt ? 2048 : 32;
  const int nch = prompt ? 32 : 1;
  const int L = prompt ? 64 : 32;
  const int tokbase = prompt ? b * 2048 : TOKP + bs * 32;
  const u16* qkT = prompt ? (const u16*)(p.ws + WS_MQKT_P) + (size_t)b * 1024 * 2048 : (const u16*)(p.ws + WS_MQKT_S) + (size_t)bs * 1024 * 32;
  const u16* vTg = prompt ? (const u16*)(p.ws + WS_MVT_P) + (size_t)b * 512 * 2048 : (const u16*)(p.ws + WS_MVT_S) + (size_t)bs * 512 * 32;
  u16* qs = (u16*)(smem + ML_QS);
  u16* ksm = (u16*)(smem + ML_KS);
  u16* kTw = (u16*)(smem + ML_KT);
  u16* vT = (u16*)(smem + ML_VT);
  u16* Cbf = (u16*)(smem + ML_CB);
  float* hbuf = (float*)(smem + ML_HB);
  float* a_s = (float*)(smem + ML_SM);
  float* mx_s = a_s + 64;
  float* ws_s = a_s + 128;
  float* wi_s = a_s + 192;
  float* emt_s = a_s + 256;
  float* nq_s = a_s + 320;
  float* nvec = a_s + 384;
  float* scal = a_s + 512;

  const int vt = w & 3, kt0 = (w >> 2) * 2;
  f32x16 accC[2];
  float m_run = 0.f;
  if (prompt) {
    zero16(accC[0]); zero16(accC[1]);
    if (tid < 128) nvec[tid] = 0.f;
  } else {
    const float* Cs = p.in[6] + ((size_t)(l * 8 + bs) * 4 + head) * 128 * 128;
#pragma unroll
    for (int q = 0; q < 2; ++q)
#pragma unroll
      for (int g = 0; g < 4; ++g) {
        const float4 c4 = *(const float4*)(Cs + (size_t)(vt * 32 + r) * 128 + (kt0 + q) * 32 + 8 * g + 4 * h);
        accC[q][4 * g] = c4.x; accC[q][4 * g + 1] = c4.y; accC[q][4 * g + 2] = c4.z; accC[q][4 * g + 3] = c4.w;
      }
    if (tid < 128) nvec[tid] = p.in[7][((size_t)(l * 8 + bs) * 4 + head) * 128 + tid];
    m_run = p.in[8][(l * 8 + bs) * 4 + head];
  }
#pragma unroll
  for (int q = 0; q < 2; ++q)
#pragma unroll
    for (int g = 0; g < 4; ++g) {
      uint2 o; o.x = pack2(accC[q][4 * g], accC[q][4 * g + 1]); o.y = pack2(accC[q][4 * g + 2], accC[q][4 * g + 3]);
      *(uint2*)(Cbf + (vt * 32 + r) * 136 + (kt0 + q) * 32 + 8 * g + 4 * h) = o;
    }
  const float* gatesp = (const float*)(p.ws + WS_GATES);
  const int vi = w >> 1, ti = w & 1;

  for (int c = 0; c < nch; ++c) {
    const int t0 = c * 64;
    if (w == 0) {
      const int t = lane;
      float ig = -INFINITY, lf = 0.f;
      if (t < L) {
        const float* gp = gatesp + (size_t)(tokbase + t0 + t) * 8;
        ig = gp[head];
        const float fg = gp[4 + head];
        lf = fminf(fg, 0.f) - log1pf(__expf(-fabsf(fg)));
      }
      float bc = lf;
#pragma unroll
      for (int off = 1; off < 64; off <<= 1) { const float v = shidx(bc, lane - off, lane); if (lane >= off) bc += v; }
      const float a = ig - bc;
      float M = a;
#pragma unroll
      for (int off = 1; off < 64; off <<= 1) { const float v = shidx(M, lane - off, lane); if (lane >= off) M = fmaxf(M, v); }
      const float mx = fmaxf(m_run, M);
      const float bL = shidx(bc, 63, lane);
      const float mxL = shidx(mx, 63, lane);
      a_s[t] = a; mx_s[t] = mx;
      ws_s[t] = __expf(a - mxL);
      wi_s[t] = __expf(m_run - mx);
      emt_s[t] = __expf(-(bc + mx));
      if (lane == 0) scal[1] = __expf(m_run - mxL);
      m_run = bL + mxL;
    }
    const int ch2 = tid >> 1, th = tid & 1;
    const bool isk = ch2 >= 128;
    const int dd = ch2 & 127;
    const int ch = (isk ? 512 : 0) + head * 128 + dd;
    const u16* rp = qkT + (size_t)ch * T + t0 + th * 32;
    float um3 = 0.f, um2 = 0.f, um1 = 0.f;
    const bool ldrow = prompt || th == 0;
    if (prompt) {
      if (th == 1 || c > 0) {
        const uint2 pv = *(const uint2*)(rp - 4);
        um3 = bfhi(pv.x); um2 = bflo(pv.y); um1 = bfhi(pv.y);
      }
    } else if (th == 0) {
      const float* cvp = p.in[9] + (size_t)(l * 8 + bs) * 3 * 1024 + ch;
      um3 = cvp[0]; um2 = cvp[1024]; um1 = cvp[2048];
    }
    const float cw0 = p.in[14][(l * 4 + 0) * 1024 + ch], cw1 = p.in[14][(l * 4 + 1) * 1024 + ch];
    const float cw2 = p.in[14][(l * 4 + 2) * 1024 + ch], cw3 = p.in[14][(l * 4 + 3) * 1024 + ch];
    const float cb = p.in[15][l * 1024 + ch];
    __syncthreads();
    {
      u16* dstrm = (isk ? ksm : qs) + (th * 32) * 136 + dd;
      const float oscale = isk ? 0.08838834764831845f : 1.f;
#pragma unroll 1
      for (int i = 0; i < 4; ++i) {
        uint4 uu = make_uint4(0, 0, 0, 0);
        if (ldrow) uu = *(const uint4*)(rp + i * 8);
        float u[8];
        u[0] = bflo(uu.x); u[1] = bfhi(uu.x); u[2] = bflo(uu.y); u[3] = bfhi(uu.y);
        u[4] = bflo(uu.z); u[5] = bfhi(uu.z); u[6] = bflo(uu.w); u[7] = bfhi(uu.w);
        float y[8];
#pragma unroll
        for (int e = 0; e < 8; ++e) {
          const float x3 = (e >= 3) ? u[e - 3] : (e == 0 ? um3 : (e == 1 ? um2 : um1));
          const float x2 = (e >= 2) ? u[e - 2] : (e == 0 ? um2 : um1);
          const float x1 = (e >= 1) ? u[e - 1] : um1;
          const float yy = cb + cw0 * x3 + cw1 * x2 + cw2 * x1 + cw3 * u[e];
          y[e] = siluf_(yy) * oscale;
        }
        um3 = u[5]; um2 = u[6]; um1 = u[7];
#pragma unroll
        for (int e = 0; e < 8; ++e) dstrm[(i * 8 + e) * 136] = f2bf(y[e]);
        if (isk) {
          const float4 w0 = *(const float4*)(ws_s + th * 32 + i * 8);
          const float4 w1 = *(const float4*)(ws_s + th * 32 + i * 8 + 4);
          uint4 o;
          o.x = pack2(y[0] * w0.x, y[1] * w0.y); o.y = pack2(y[2] * w0.z, y[3] * w0.w);
          o.z = pack2(y[4] * w1.x, y[5] * w1.y); o.w = pack2(y[6] * w1.z, y[7] * w1.w);
          *(uint4*)(kTw + dd * 72 + th * 32 + i * 8) = o;
        }
      }
#pragma unroll
      for (int i = 0; i < 2; ++i) {
        const int id = tid + 512 * i, row = id >> 3, cc = id & 7;
        uint4 vv = make_uint4(0, 0, 0, 0);
        if (prompt || cc < 4) vv = *(const uint4*)(vTg + (size_t)(head * 128 + row) * T + t0 + cc * 8);
        *(uint4*)(vT + row * 72 + cc * 8) = vv;
      }
    }
    __syncthreads();
    {
      const int t = tid >> 3, part = tid & 7;
      const uint4 q0 = *(const uint4*)(qs + t * 136 + part * 16);
      const uint4 q1 = *(const uint4*)(qs + t * 136 + part * 16 + 8);
      const float* nv = nvec + part * 16;
      float s = bflo(q0.x) * nv[0] + bfhi(q0.x) * nv[1] + bflo(q0.y) * nv[2] + bfhi(q0.y) * nv[3]
              + bflo(q0.z) * nv[4] + bfhi(q0.z) * nv[5] + bflo(q0.w) * nv[6] + bfhi(q0.w) * nv[7]
              + bflo(q1.x) * nv[8] + bfhi(q1.x) * nv[9] + bflo(q1.y) * nv[10] + bfhi(q1.y) * nv[11]
              + bflo(q1.z) * nv[12] + bfhi(q1.z) * nv[13] + bflo(q1.w) * nv[14] + bfhi(q1.w) * nv[15];
      s += shx(s, 1, lane); s += shx(s, 2, lane); s += shx(s, 4, lane);
      if (part == 0) nq_s[t] = s;
    }
    f32x16 accS[2], accO;
    zero16(accS[0]); zero16(accS[1]); zero16(accO);
    {
#pragma unroll
      for (int ks = 0; ks < 8; ++ks) {
        const bf16x8 qfr = *(const bf16x8*)(qs + (ti * 32 + r) * 136 + ks * 16 + h * 8);
        const bf16x8 k0 = *(const bf16x8*)(ksm + r * 136 + ks * 16 + h * 8);
        accS[0] = MFMA(k0, qfr, accS[0]);
        if (ti == 1) {
          const bf16x8 k1 = *(const bf16x8*)(ksm + (32 + r) * 136 + ks * 16 + h * 8);
          accS[1] = MFMA(k1, qfr, accS[1]);
        }
        const bf16x8 cf = *(const bf16x8*)(Cbf + (vi * 32 + r) * 136 + ks * 16 + h * 8);
        accO = MFMA(cf, qfr, accO);
      }
    }
    const int tcol = ti * 32 + r;
    const float mxt = mx_s[tcol];
    const float wit = wi_s[tcol];
    float dsum = 0.f;
#pragma unroll
    for (int sub = 0; sub < 2; ++sub) {
      if (sub <= ti) {
#pragma unroll
        for (int g = 0; g < 4; ++g) {
          const float4 a4 = *(const float4*)(a_s + sub * 32 + 8 * g + 4 * h);
          const float av[4] = {a4.x, a4.y, a4.z, a4.w};
#pragma unroll
          for (int e = 0; e < 4; ++e) {
            const int s = sub * 32 + 8 * g + 4 * h + e;
            const float wgt = (s <= tcol) ? __expf(av[e] - mxt) : 0.f;
            const float pv = accS[sub][4 * g + e] * wgt;
            accS[sub][4 * g + e] = pv;
            dsum += pv;
          }
        }
      }
    }
    dsum += shx(dsum, 32, lane);
#pragma unroll
    for (int i = 0; i < 16; ++i) accO[i] *= wit;
#pragma unroll
    for (int sub = 0; sub < 2; ++sub) {
      if (sub <= ti) {
#pragma unroll
        for (int s2 = 0; s2 < 2; ++s2) {
          const bf16x8 pf = pack8(accS[sub], s2);
          const u16* va = vT + (vi * 32 + r) * 72 + sub * 32 + s2 * 16 + 4 * h;
          const uint2 lo = *(const uint2*)va;
          const uint2 hi = *(const uint2*)(va + 8);
          const uint4 vq = make_uint4(lo.x, lo.y, hi.x, hi.y);
          accO = MFMA(__builtin_bit_cast(bf16x8, vq), pf, accO);
        }
      }
    }
    __syncthreads();
    {
      const float den = dsum + wit * nq_s[tcol];
      const float dn = fmaxf(fabsf(den), emt_s[tcol]);
      const float rinv = 1.f / dn;
#pragma unroll
      for (int g = 0; g < 4; ++g)
        *(float4*)(hbuf + tcol * 132 + vi * 32 + 8 * g + 4 * h) =
            make_float4(accO[4 * g] * rinv, accO[4 * g + 1] * rinv, accO[4 * g + 2] * rinv, accO[4 * g + 3] * rinv);
    }
    {
      const float wc = scal[1];
#pragma unroll
      for (int q = 0; q < 2; ++q)
#pragma unroll
        for (int i = 0; i < 16; ++i) accC[q][i] *= wc;
#pragma unroll
      for (int k4 = 0; k4 < 4; ++k4) {
        const bf16x8 vf = *(const bf16x8*)(vT + (vt * 32 + r) * 72 + k4 * 16 + h * 8);
#pragma unroll
        for (int q = 0; q < 2; ++q) {
          const bf16x8 kf = *(const bf16x8*)(kTw + ((kt0 + q) * 32 + r) * 72 + k4 * 16 + h * 8);
          accC[q] = MFMA(kf, vf, accC[q]);
        }
      }
#pragma unroll
      for (int q = 0; q < 2; ++q)
#pragma unroll
        for (int g = 0; g < 4; ++g) {
          uint2 o; o.x = pack2(accC[q][4 * g], accC[q][4 * g + 1]); o.y = pack2(accC[q][4 * g + 2], accC[q][4 * g + 3]);
          *(uint2*)(Cbf + (vt * 32 + r) * 136 + (kt0 + q) * 32 + 8 * g + 4 * h) = o;
        }
      if (tid < 128) {
        float s = 0.f;
#pragma unroll
        for (int i = 0; i < 8; ++i) {
          const uint4 kk = *(const uint4*)(kTw + tid * 72 + i * 8);
          s += bflo(kk.x) + bfhi(kk.x) + bflo(kk.y) + bfhi(kk.y) + bflo(kk.z) + bfhi(kk.z) + bflo(kk.w) + bfhi(kk.w);
        }
        nvec[tid] = wc * nvec[tid] + s;
      }
    }
    __syncthreads();
    {
      const int t = tid >> 3, part = tid & 7;
      float x[16];
#pragma unroll
      for (int i = 0; i < 4; ++i) {
        const float4 f = *(const float4*)(hbuf + t * 132 + part * 16 + i * 4);
        x[i * 4] = f.x; x[i * 4 + 1] = f.y; x[i * 4 + 2] = f.z; x[i * 4 + 3] = f.w;
      }
      float s = 0.f;
#pragma unroll
      for (int i = 0; i < 16; ++i) s += x[i];
      s += shx(s, 1, lane); s += shx(s, 2, lane); s += shx(s, 4, lane);
      const float mean = s * (1.f / 128.f);
      float q = 0.f;
#pragma unroll
      for (int i = 0; i < 16; ++i) { x[i] -= mean; q += x[i] * x[i]; }
      q += shx(q, 1, lane); q += shx(q, 2, lane); q += shx(q, 4, lane);
      const float rstd = rsqrtf(q * (1.f / 128.f) + LN_EPS);
      if (t < L) {
        const size_t tok = (size_t)tokbase + t0 + t;
        const int cbase = head * 128 + part * 16;
        const float* gw = p.in[18] + l * 512 + cbase;
        const u16* mo = (const u16*)(p.ws + WS_MO) + tok * 512 + cbase;
        const uint4 m0 = *(const uint4*)mo;
        const uint4 m1 = *(const uint4*)(mo + 8);
        const float sg[16] = {bflo(m0.x), bfhi(m0.x), bflo(m0.y), bfhi(m0.y), bflo(m0.z), bfhi(m0.z), bflo(m0.w), bfhi(m0.w),
                              bflo(m1.x), bfhi(m1.x), bflo(m1.y), bfhi(m1.y), bflo(m1.z), bfhi(m1.z), bflo(m1.w), bfhi(m1.w)};
        float yv[16];
#pragma unroll
        for (int i = 0; i < 16; ++i) yv[i] = x[i] * rstd * gw[i] * sg[i];
        uint4 o0, o1;
        o0.x = pack2(yv[0], yv[1]); o0.y = pack2(yv[2], yv[3]); o0.z = pack2(yv[4], yv[5]); o0.w = pack2(yv[6], yv[7]);
        o1.x = pack2(yv[8], yv[9]); o1.y = pack2(yv[10], yv[11]); o1.z = pack2(yv[12], yv[13]); o1.w = pack2(yv[14], yv[15]);
        u16* mn = (u16*)(p.ws + WS_MN) + tok * 512 + cbase;
        *(uint4*)mn = o0;
        *(uint4*)(mn + 8) = o1;
      }
    }
  }
  {
    float* oc = p.out + (prompt ? O_CP + ((size_t)(l * 32 + b) * 4 + head) * 16384 : O_CS + ((size_t)(l * 8 + bs) * 4 + head) * 16384);
#pragma unroll
    for (int q = 0; q < 2; ++q)
#pragma unroll
      for (int g = 0; g < 4; ++g)
        *(float4*)(oc + (size_t)(vt * 32 + r) * 128 + (kt0 + q) * 32 + 8 * g + 4 * h) =
            make_float4(accC[q][4 * g], accC[q][4 * g + 1], accC[q][4 * g + 2], accC[q][4 * g + 3]);
    float* on = p.out + (prompt ? O_NP + ((size_t)(l * 32 + b) * 4 + head) * 128 : O_NS + ((size_t)(l * 8 + bs) * 4 + head) * 128);
    if (tid < 128) on[tid] = nvec[tid];
    if (tid == 0) {
      if (prompt) p.out[O_MP + (size_t)(l * 32 + b) * 4 + head] = m_run;
      else p.out[O_MS + (size_t)(l * 8 + bs) * 4 + head] = m_run;
    }
  }
}

DI void phase_mixers(const Params& p, int l, unsigned char* smem) {
  const int tid0 = otid();
  const int lane = tid0 & 63;
  const float* lp = p.in[16] + l * 256;
  float s1 = lp[lane] * lp[64 + lane], s2 = lp[128 + lane] * lp[192 + lane];
  s1 = wave_sum(s1, lane); s2 = wave_sum(s2, lane);
  const float lam_init = 0.8f - 0.6f * expf(-0.3f * (float)l);
  const float lam = expf(s1) - expf(s2) + lam_init;
  int* ctr = (int*)(p.ws + WS_CTR) + l;
  int* sitem = (int*)smem;
  const int N_ML = 160, N_AT = 2048 + 32;
  for (;;) {
    __syncthreads();
    if (tid0 == 0) *sitem = atomicAdd(ctr, 1);
    __syncthreads();
    const int item = *sitem;
    if (item >= N_ML + N_AT) break;
    if (item < N_ML) {
#ifndef NO_ML
      mlstm_item(p, l, item >> 2, item & 3, smem);
#endif
    } else {
#ifndef NO_AT
      const int a = item - N_ML;
      if (a < 2048) {
        const int qt = 15 - (a >> 7), rest = a & 127;
        attn_item(p, l, rest >> 2, rest & 3, qt, lam, lam_init, smem);
      } else {
        const int s = a - 2048;
        attn_item(p, l, 32 + (s >> 2), s & 3, 0, lam, lam_init, smem);
      }
#endif
    }
  }
}

DI void gbar(unsigned* bar, unsigned& epoch) {
  __syncthreads();
  epoch += gridDim.x;
  if (otid() == 0) {
    __threadfence();
    __hip_atomic_fetch_add(bar, 1u, __ATOMIC_RELAXED, __HIP_MEMORY_SCOPE_AGENT);
    while (__hip_atomic_load(bar, __ATOMIC_RELAXED, __HIP_MEMORY_SCOPE_AGENT) < epoch) __builtin_amdgcn_s_sleep(2);
    __threadfence();
  }
  __syncthreads();
}

__global__ void __launch_bounds__(NTHR) fwd_megakernel(Params p) {
  extern __shared__ __attribute__((aligned(16))) unsigned char smem[];
  cg::grid_group grid = cg::this_grid();
#ifndef PH
#define PH 0xffff
#endif
  unsigned* bar = (unsigned*)(p.ws + WS_CTR + 64);
  unsigned epoch = 0;
  if (PH & 1) prologue(p, smem);
  grid.sync();
  if (PH & 2) ln_pass(p, 0, 0, smem);
  gbar(bar, epoch);
#pragma unroll 1
  for (int l = 0; l < 2; ++l) {
    if (PH & 4) phase_in_gate(p, l, smem);
    gbar(bar, epoch);
    if (PH & 8) phase_mixers(p, l, smem);
    gbar(bar, epoch);
    if (PH & 16) phase_mix(p, l, smem);
    gbar(bar, epoch);
    if (PH & 32) phase_res(p, l, 0, smem);
    gbar(bar, epoch);
    if (PH & 64) ln_pass(p, 1, l, smem);
    gbar(bar, epoch);
    if (PH & 128) phase_gu(p, l, smem);
    gbar(bar, epoch);
    if (PH & 256) phase_res(p, l, 1, smem);
    gbar(bar, epoch);
    if (PH & 512) ln_pass(p, 2, l, smem);
    if (l == 0) gbar(bar, epoch);
  }
}

extern "C" void kernel_launch(void* const* d_in, const int* in_sizes, int n_in, void* d_out, int out_size, void* d_ws,
                              size_t ws_size, hipStream_t stream) {
  static int grid_blocks = 0;
  if (!grid_blocks) {
    int dev = 0, cus = 0, per_cu = 0;
    hipGetDevice(&dev);
    hipDeviceGetAttribute(&cus, hipDeviceAttributeMultiprocessorCount, dev);
    if (hipFuncSetAttribute((const void*)fwd_megakernel, hipFuncAttributeMaxDynamicSharedMemorySize, LDS_BYTES) != hipSuccess)
      fprintf(stderr, "kernel_launch: hipFuncSetAttribute failed\n");
    if (hipOccupancyMaxActiveBlocksPerMultiprocessor(&per_cu, (const void*)fwd_megakernel, NTHR, LDS_BYTES) != hipSuccess || per_cu < 1) {
      fprintf(stderr, "kernel_launch: occupancy query gave %d\n", per_cu);
      per_cu = 1;
    }
    (void)hipGetLastError();
    grid_blocks = cus * per_cu;
    if (ws_size < WS_END) fprintf(stderr, "kernel_launch: workspace too small: %zu < %zu\n", ws_size, (size_t)WS_END);
  }
  if (hipMemsetAsync((char*)d_ws + WS_CTR, 0, 256, stream) != hipSuccess) fprintf(stderr, "kernel_launch: memset failed\n");
  Params p{};
  for (int i = 0; i < 30; ++i) p.in[i] = (const float*)d_in[i];
  p.out = (float*)d_out;
  p.ws = (unsigned char*)d_ws;
  void* args[] = {&p};
  hipError_t e = hipLaunchCooperativeKernel((const void*)fwd_megakernel, dim3(grid_blocks), dim3(NTHR), args, LDS_BYTES, stream);
  if (e != hipSuccess) fprintf(stderr, "cooperative launch failed: %s (grid %d)\n", hipGetErrorString(e), grid_blocks);
}
```

```cpp
#include <hip/hip_runtime.h>
#include <hip/hip_cooperative_groups.h>
#include <cstdio>
namespace cg = cooperative_groups;

#define DI __device__ __forceinline__
typedef unsigned short u16;
using bf16x8 = __attribute__((ext_vector_type(8))) short;
using f32x16 = __attribute__((ext_vector_type(16))) float;
#define MFMA(a, b, c) __builtin_amdgcn_mfma_f32_32x32x16_bf16((a), (b), (c), 0, 0, 0)

constexpr int TOKP = 65536, TOKS = 256, TOK = 65792;
constexpr int NTHR = 512;
constexpr float LN_EPS = 1e-5f;
constexpr float ALPHA = 1.41421356237f;
constexpr float LOG2E = 1.44269504089f;

constexpr size_t WS_WT_IN   = 0;
constexpr size_t WS_WT_GATE = WS_WT_IN + 2ull * 3584 * 1024 * 2;
constexpr size_t WS_WT_BRA  = WS_WT_GATE + 2ull * 2048 * 1024 * 2;
constexpr size_t WS_WT_BRB  = WS_WT_BRA + 2ull * 1024 * 512 * 2;
constexpr size_t WS_WT_O    = WS_WT_BRB + 2ull * 1024 * 512 * 2;
constexpr size_t WS_WT_GU   = WS_WT_O + 2ull * 1024 * 1024 * 2;
constexpr size_t WS_WT_DOWN = WS_WT_GU + 2ull * 5632 * 1024 * 2;
constexpr size_t WS_MOD     = WS_WT_DOWN + 2ull * 1024 * 2816 * 2;
constexpr size_t WS_GATES   = WS_MOD + 2ull * 40 * 6144 * 4;
constexpr size_t WS_CTR     = WS_GATES + (size_t)TOK * 8 * 4;
constexpr size_t WS_KS      = WS_CTR + 256;
constexpr size_t WS_VTS     = WS_KS + 2ull * 8 * 1056 * 512 * 2 + 65536;
constexpr size_t WS_MQKT_S  = WS_VTS + 2ull * 8 * 512 * 1056 * 2 + 65536;
constexpr size_t WS_MVT_S   = WS_MQKT_S + 8ull * 1024 * 32 * 2;
constexpr size_t WS_H       = WS_MVT_S + 8ull * 512 * 32 * 2;
constexpr size_t WS_AN      = WS_H;
constexpr size_t WS_MN      = WS_H + (size_t)TOK * 512 * 2;
constexpr size_t WS_ZQ      = WS_H + (size_t)TOK * 1024 * 2;
constexpr size_t WS_KB      = WS_ZQ + (size_t)TOK * 512 * 2;
constexpr size_t WS_VTP     = WS_KB + (size_t)TOKP * 512 * 2;
constexpr size_t WS_MQKT_P  = WS_VTP + 32ull * 512 * 2048 * 2;
constexpr size_t WS_MVT_P   = WS_MQKT_P + 32ull * 1024 * 2048 * 2;
constexpr size_t WS_MO      = WS_MVT_P + 32ull * 512 * 2048 * 2;
constexpr size_t WS_G       = WS_MO + (size_t)TOK * 512 * 2;
constexpr size_t WS_END     = WS_G + (size_t)TOK * 2048 * 2;
constexpr size_t WS_MIX     = WS_ZQ;
constexpr size_t WS_ACT     = WS_ZQ;

constexpr size_t O_YP  = 0;
constexpr size_t O_YS  = O_YP + (size_t)TOKP * 1024;
constexpr size_t O_KP  = O_YS + (size_t)TOKS * 1024;
constexpr size_t O_VP  = O_KP + 2ull * TOKP * 512;
constexpr size_t O_KSM = O_VP + 2ull * TOKP * 512;
constexpr size_t O_VSM = O_KSM + 2ull * TOKS * 512;
constexpr size_t O_CP  = O_VSM + 2ull * TOKS * 512;
constexpr size_t O_NP  = O_CP + 2ull * 32 * 4 * 128 * 128;
constexpr size_t O_MP  = O_NP + 2ull * 32 * 4 * 128;
constexpr size_t O_CVP = O_MP + 2ull * 32 * 4;
constexpr size_t O_CS  = O_CVP + 2ull * 32 * 3 * 1024;
constexpr size_t O_NS  = O_CS + 2ull * 8 * 4 * 128 * 128;
constexpr size_t O_MS  = O_NS + 2ull * 8 * 4 * 128;
constexpr size_t O_CVS = O_MS + 2ull * 8 * 4;

constexpr int LDS_BYTES = 148480;

struct Params {
  const float* in[30];
  float* out;
  unsigned char* ws;
};

DI u16 f2bf(float x) { unsigned u = __float_as_uint(x); u += 0x7fffu + ((u >> 16) & 1u); return (u16)(u >> 16); }
DI float bf2f(unsigned v) { return __uint_as_float(v << 16); }
DI unsigned pack2(float a, float b) { return (unsigned)f2bf(a) | ((unsigned)f2bf(b) << 16); }
DI float bflo(unsigned v) { return __uint_as_float(v << 16); }
DI float bfhi(unsigned v) { return __uint_as_float(v & 0xffff0000u); }
DI float sigmoidf_(float x) { return 1.f / (1.f + __expf(-x)); }
DI float siluf_(float x) { return x / (1.f + __expf(-x)); }
DI float fexp2(float x) { return __builtin_amdgcn_exp2f(x); }
DI int otid() { int t = threadIdx.x; asm volatile("" : "+v"(t)); return t; }
DI float shx(float v, int mask, int lane) { return __int_as_float(__builtin_amdgcn_ds_bpermute(((lane ^ mask) & 63) << 2, __float_as_int(v))); }
DI float shidx(float v, int src, int lane) { (void)lane; return __int_as_float(__builtin_amdgcn_ds_bpermute((src & 63) << 2, __float_as_int(v))); }
DI int crow(int i, int h) { return (i & 3) + 8 * (i >> 2) + 4 * h; }
DI bf16x8 pack8(const f32x16& x, int s) {
  uint4 u;
  u.x = pack2(x[8 * s + 0], x[8 * s + 1]); u.y = pack2(x[8 * s + 2], x[8 * s + 3]);
  u.z = pack2(x[8 * s + 4], x[8 * s + 5]); u.w = pack2(x[8 * s + 6], x[8 * s + 7]);
  return __builtin_bit_cast(bf16x8, u);
}
DI void zero16(f32x16& a) {
#pragma unroll
  for (int i = 0; i < 16; ++i) a[i] = 0.f;
}
DI int batch_of_row(int row) { return row < TOKP ? (row >> 11) : 32 + ((row - TOKP) >> 5); }

constexpr int GS_STRIDE = 144;
constexpr int GS_STAGE = 512 * GS_STRIDE;
constexpr int GS_BASE = 64;

DI void gemm_mainloop(f32x16 (&acc)[4][2], const u16* __restrict__ A, int lda, const u16* __restrict__ Wt, int ldw, int K,
                      int m0, int n0, unsigned char* smem) {
  const int tid = otid(), lane = tid & 63, w = tid >> 6;
  const int wm = w >> 2, wn = w & 3, r = lane & 31, h = lane >> 5;
  const int lrow = tid >> 3, lcc = tid & 7;
  const u16* ap = A + (size_t)(m0 + lrow) * lda + lcc * 8;
  const int bn = n0 + 2 * (lrow & 31) + ((lrow >> 5) & 1);
  const u16* bp = Wt + (size_t)bn * ldw + lcc * 8;
  const size_t astep = (size_t)64 * lda, bstep = (size_t)64 * ldw;
  unsigned char* sbase = smem + GS_BASE;
  const int woff = lrow * GS_STRIDE + lcc * 16;
  const int nk = K >> 6;
  uint4 s0, s1, s2, s3, s4, s5, s6, s7;
#define G_ISSUE() do { s0 = *(const uint4*)(ap); s1 = *(const uint4*)(ap + astep); s2 = *(const uint4*)(ap + 2 * astep); s3 = *(const uint4*)(ap + 3 * astep); \
    s4 = *(const uint4*)(bp); s5 = *(const uint4*)(bp + bstep); s6 = *(const uint4*)(bp + 2 * bstep); s7 = *(const uint4*)(bp + 3 * bstep); } while (0)
#define G_WRITE(sn) do { *(uint4*)((sn) + woff) = s0; *(uint4*)((sn) + woff + 64 * GS_STRIDE) = s1; *(uint4*)((sn) + woff + 128 * GS_STRIDE) = s2; \
    *(uint4*)((sn) + woff + 192 * GS_STRIDE) = s3; *(uint4*)((sn) + woff + 256 * GS_STRIDE) = s4; *(uint4*)((sn) + woff + 320 * GS_STRIDE) = s5; \
    *(uint4*)((sn) + woff + 384 * GS_STRIDE) = s6; *(uint4*)((sn) + woff + 448 * GS_STRIDE) = s7; } while (0)
  G_ISSUE();
  G_WRITE(sbase);
  { const int adv = (1 < nk) ? 64 : 0; ap += adv; bp += adv; }
  G_ISSUE();
  __syncthreads();
  const int aoff = (wm * 128 + r) * GS_STRIDE + h * 16;
  const int boff = (256 + wn * 64 + r) * GS_STRIDE + h * 16;
  for (int kt = 0; kt < nk; ++kt) {
    G_WRITE(sbase + ((kt + 1) & 1) * GS_STAGE);
    { const int adv = (kt + 2 < nk) ? 64 : 0; ap += adv; bp += adv; }
    G_ISSUE();
    __builtin_amdgcn_sched_barrier(0);
    const unsigned char* st = sbase + (kt & 1) * GS_STAGE;
#pragma unroll
    for (int ks = 0; ks < 4; ++ks) {
      bf16x8 fa[4], fb[2];
#pragma unroll
      for (int mi = 0; mi < 4; ++mi) fa[mi] = *(const bf16x8*)(st + aoff + mi * 32 * GS_STRIDE + ks * 32);
      fb[0] = *(const bf16x8*)(st + boff + ks * 32);
      fb[1] = *(const bf16x8*)(st + boff + 32 * GS_STRIDE + ks * 32);
#pragma unroll
      for (int mi = 0; mi < 4; ++mi) {
        acc[mi][0] = MFMA(fa[mi], fb[0], acc[mi][0]);
        acc[mi][1] = MFMA(fa[mi], fb[1], acc[mi][1]);
      }
      __builtin_amdgcn_sched_barrier(0);
    }
    __syncthreads();
  }
#undef G_ISSUE
#undef G_WRITE
}

DI bool tile_of(int i, int MT, int NT, int& mt, int& nt) {
  const int per = gridDim.x >> 3;
  const int L = i * (int)gridDim.x + (int)(blockIdx.x & 7) * per + (int)(blockIdx.x >> 3);
  if (L >= MT * NT) return false;
  const int nig = 8 * NT, gid = L / nig, fm = gid * 8, gsz = min(MT - fm, 8), rem = L - gid * nig;
  mt = fm + rem % gsz; nt = rem / gsz;
  return true;
}

DI int map_row(int maptype, int s) {
  if (maptype == 1) return s < 3072 ? s : (s < 3080 ? -1 : s - 8);
  if (maptype == 2) return s < 2816 ? 2 * s : 2 * (s - 2816) + 1;
  return s;
}
DI void transpose_task(const float* __restrict__ src, int Nsrc, u16* __restrict__ dst, int dld, int maptype, int kt, int nt,
                       unsigned char* smem) {
  float* tile = (float*)(smem + 64);
  const int tid = otid();
  const int k0 = kt * 64, s0 = nt * 64;
#pragma unroll
  for (int i = 0; i < 2; ++i) {
    const int kr = (tid >> 4) + 32 * i, nc = (tid & 15) * 4;
    float4 v = make_float4(0.f, 0.f, 0.f, 0.f);
    if (s0 + nc < Nsrc) v = *(const float4*)(src + (size_t)(k0 + kr) * Nsrc + s0 + nc);
    tile[kr * 65 + nc + 0] = v.x; tile[kr * 65 + nc + 1] = v.y; tile[kr * 65 + nc + 2] = v.z; tile[kr * 65 + nc + 3] = v.w;
  }
  __syncthreads();
  {
    const int n = tid >> 3, kc = (tid & 7) * 8;
    const int s = s0 + n;
    const int dr = (s < Nsrc) ? map_row(maptype, s) : -1;
    if (dr >= 0) {
      uint4 o;
      o.x = pack2(tile[(kc + 0) * 65 + n], tile[(kc + 1) * 65 + n]);
      o.y = pack2(tile[(kc + 2) * 65 + n], tile[(kc + 3) * 65 + n]);
      o.z = pack2(tile[(kc + 4) * 65 + n], tile[(kc + 5) * 65 + n]);
      o.w = pack2(tile[(kc + 6) * 65 + n], tile[(kc + 7) * 65 + n]);
      *(uint4*)(dst + (size_t)dr * dld + k0 + kc) = o;
    }
  }
  __syncthreads();
}

DI void adaln_task(const Params& p, int task, unsigned char* smem) {
  const int bhalf = task & 1, cg_ = (task >> 1) % 96, l = (task >> 1) / 96;
  float* cs = (float*)(smem + 64);
  float* red = (float*)(smem + 64 + 20 * 1024 * 4);
  const int tid = otid();
  const float* cp = p.in[2]; const float* csm = p.in[3];
  for (int idx = tid; idx < 20 * 1024; idx += NTHR) {
    const int bb = idx >> 10, d = idx & 1023, b = bhalf * 20 + bb;
    const float c = b < 32 ? cp[b * 1024 + d] : csm[(b - 32) * 1024 + d];
    cs[idx] = siluf_(c);
  }
  __syncthreads();
  const int dseg = tid >> 6, e = cg_ * 64 + (tid & 63);
  const float* wp = p.in[10] + ((size_t)l * 1024 + dseg * 128) * 6144 + e;
  float acc[20];
#pragma unroll
  for (int i = 0; i < 20; ++i) acc[i] = 0.f;
  for (int d = 0; d < 128; ++d) {
    const float wv = wp[(size_t)d * 6144];
    const float* c0 = cs + dseg * 128 + d;
#pragma unroll
    for (int i = 0; i < 20; ++i) acc[i] += c0[i * 1024] * wv;
  }
#pragma unroll
  for (int i = 0; i < 20; ++i) red[(dseg * 20 + i) * 64 + (tid & 63)] = acc[i];
  __syncthreads();
  float* mod = (float*)(p.ws + WS_MOD);
  for (int idx = tid; idx < 20 * 64; idx += NTHR) {
    const int bb = idx >> 6, ec = idx & 63;
    float s = 0.f;
#pragma unroll
    for (int q = 0; q < 8; ++q) s += red[(q * 20 + bb) * 64 + ec];
    const int ee = cg_ * 64 + ec;
    mod[((size_t)l * 40 + bhalf * 20 + bb) * 6144 + ee] = s + p.in[11][l * 6144 + ee];
  }
  __syncthreads();
}

DI void prologue(const Params& p, unsigned char* smem) {
  const int WT_TASKS_L = 912 + 512 + 128 + 128 + 256 + 1408 + 704;
  const int N_WT = 2 * WT_TASKS_L;
  const int N_ADA = 384, N_CK = 512, N_CV = 2048;
  const int total = N_WT + N_ADA + N_CK + N_CV;
  for (int task = blockIdx.x; task < total; task += gridDim.x) {
    if (task < N_WT) {
      const int l = task / WT_TASKS_L; int t = task % WT_TASKS_L;
      if (t < 912) { transpose_task(p.in[12] + (size_t)l * 1024 * 3592, 3592, (u16*)(p.ws + WS_WT_IN) + (size_t)l * 3584 * 1024, 1024, 1, t / 57, t % 57, smem); continue; }
      t -= 912;
      if (t < 512) { transpose_task(p.in[21] + (size_t)l * 1024 * 2048, 2048, (u16*)(p.ws + WS_WT_GATE) + (size_t)l * 2048 * 1024, 1024, 0, t / 32, t % 32, smem); continue; }
      t -= 512;
      if (t < 128) { transpose_task(p.in[19] + (size_t)l * 512 * 1024, 1024, (u16*)(p.ws + WS_WT_BRA) + (size_t)l * 1024 * 512, 512, 0, t / 16, t % 16, smem); continue; }
      t -= 128;
      if (t < 128) { transpose_task(p.in[20] + (size_t)l * 512 * 1024, 1024, (u16*)(p.ws + WS_WT_BRB) + (size_t)l * 1024 * 512, 512, 0, t / 16, t % 16, smem); continue; }
      t -= 128;
      if (t < 256) { transpose_task(p.in[23] + (size_t)l * 1024 * 1024, 1024, (u16*)(p.ws + WS_WT_O) + (size_t)l * 1024 * 1024, 1024, 0, t / 16, t % 16, smem); continue; }
      t -= 256;
      if (t < 1408) { transpose_task(p.in[26] + (size_t)l * 1024 * 5632, 5632, (u16*)(p.ws + WS_WT_GU) + (size_t)l * 5632 * 1024, 1024, 2, t / 88, t % 88, smem); continue; }
      t -= 1408;
      transpose_task(p.in[27] + (size_t)l * 2816 * 1024, 1024, (u16*)(p.ws + WS_WT_DOWN) + (size_t)l * 1024 * 2816, 2816, 0, t / 16, t % 16, smem);
    } else if (task < N_WT + N_ADA) {
      adaln_task(p, task - N_WT, smem);
    } else if (task < N_WT + N_ADA + N_CK) {
      const int t = task - N_WT - N_ADA;
      const float4* src = (const float4*)p.in[4];
      u16* dst = (u16*)(p.ws + WS_KS);
#pragma unroll
      for (int i = 0; i < 8; ++i) {
        const size_t f4 = (size_t)t * 4096 + i * 512 + otid();
        const float4 v = src[f4];
        const size_t e = f4 * 4;
        const size_t lb = e / (1024 * 512), rem = e % (1024 * 512);
        uint2 o; o.x = pack2(v.x, v.y); o.y = pack2(v.z, v.w);
        *(uint2*)(dst + lb * (1056 * 512) + rem) = o;
      }
    } else {
      const int t = task - N_WT - N_ADA - N_CK;
      const int lb = t >> 7, tt = t & 127;
      transpose_task(p.in[5] + (size_t)lb * 1024 * 512, 512, (u16*)(p.ws + WS_VTS) + (size_t)lb * 512 * 1056, 1056, 0, tt >> 3, tt & 7, smem);
    }
  }
}

DI float wave_sum(float v, int lane) {
#pragma unroll
  for (int off = 32; off >= 1; off >>= 1) v += shx(v, off, lane);
  return v;
}
DI void ln_pass(const Params& p, int mode, int l, unsigned char* smem) {
  const int tid = otid();
  const int lane = tid & 63, w = tid >> 6;
  const bool first = mode != 0;
  const bool second = (mode != 2) || (l + 1 < 2);
  const bool gates = (mode == 0) || (mode == 2 && l + 1 < 2);
  const int lm = (mode == 2) ? l + 1 : l;
  const int shi = (mode == 1) ? 3 : 0;
  const float* lng = (mode == 1) ? p.in[24] + l * 1024 : p.in[28] + l * 1024;
  const float* lnb = (mode == 1) ? p.in[25] + l * 1024 : p.in[29] + l * 1024;
  const float* mod = (const float*)(p.ws + WS_MOD);
  u16* H = (u16*)(p.ws + WS_H);
  float* gout = (float*)(p.ws + WS_GATES);
  float* wl = (float*)(smem + 64);
  float bif[8];
  if (gates) {
    const float* wi = p.in[12] + (size_t)lm * 1024 * 3592 + 3072;
    for (int idx = tid; idx < 8192; idx += NTHR) {
      const int c = idx >> 3, j = idx & 7;
      wl[j * 1024 + c] = wi[(size_t)c * 3592 + j];
    }
#pragma unroll
    for (int j = 0; j < 8; ++j) bif[j] = p.in[13][lm * 8 + j];
  }
  __syncthreads();
  for (int row = blockIdx.x * 8 + w; row < TOK; row += gridDim.x * 8) {
    float* xr = p.out + (size_t)row * 1024;
    const float* src = (mode == 0) ? (row < TOKP ? p.in[0] + (size_t)row * 1024 : p.in[1] + (size_t)(row - TOKP) * 1024) : xr;
    float v[16];
#pragma unroll
    for (int i = 0; i < 4; ++i) {
      const float4 t = *(const float4*)(src + i * 256 + lane * 4);
      v[i * 4 + 0] = t.x; v[i * 4 + 1] = t.y; v[i * 4 + 2] = t.z; v[i * 4 + 3] = t.w;
    }
    if (first) {
      float s = 0.f;
#pragma unroll
      for (int i = 0; i < 16; ++i) s += v[i];
      const float mean = wave_sum(s, lane) * (1.f / 1024.f);
      float q = 0.f;
#pragma unroll
      for (int i = 0; i < 16; ++i) { v[i] -= mean; q += v[i] * v[i]; }
      const float rstd = rsqrtf(wave_sum(q, lane) * (1.f / 1024.f) + LN_EPS);
#pragma unroll
      for (int i = 0; i < 4; ++i) {
        const int c = i * 256 + lane * 4;
        const float4 g = *(const float4*)(lng + c);
        const float4 b = *(const float4*)(lnb + c);
        v[i * 4 + 0] = v[i * 4 + 0] * rstd * g.x + b.x; v[i * 4 + 1] = v[i * 4 + 1] * rstd * g.y + b.y;
        v[i * 4 + 2] = v[i * 4 + 2] * rstd * g.z + b.z; v[i * 4 + 3] = v[i * 4 + 3] * rstd * g.w + b.w;
        *(float4*)(xr + c) = make_float4(v[i * 4 + 0], v[i * 4 + 1], v[i * 4 + 2], v[i * 4 + 3]);
      }
    }
    if (second) {
      float s = 0.f;
#pragma unroll
      for (int i = 0; i < 16; ++i) s += v[i];
      const float mean = wave_sum(s, lane) * (1.f / 1024.f);
      float q = 0.f;
#pragma unroll
      for (int i = 0; i < 16; ++i) { v[i] -= mean; q += v[i] * v[i]; }
      const float rstd = rsqrtf(wave_sum(q, lane) * (1.f / 1024.f) + LN_EPS);
      const int b = batch_of_row(row);
      const float* mb = mod + ((size_t)lm * 40 + b) * 6144;
#pragma unroll
      for (int i = 0; i < 4; ++i) {
        const int c = i * 256 + lane * 4;
        const float4 sh = *(const float4*)(mb + shi * 1024 + c);
        const float4 sc = *(const float4*)(mb + (shi + 1) * 1024 + c);
        v[i * 4 + 0] = v[i * 4 + 0] * rstd * (1.f + sc.x) + sh.x; v[i * 4 + 1] = v[i * 4 + 1] * rstd * (1.f + sc.y) + sh.y;
        v[i * 4 + 2] = v[i * 4 + 2] * rstd * (1.f + sc.z) + sh.z; v[i * 4 + 3] = v[i * 4 + 3] * rstd * (1.f + sc.w) + sh.w;
        uint2 o; o.x = pack2(v[i * 4 + 0], v[i * 4 + 1]); o.y = pack2(v[i * 4 + 2], v[i * 4 + 3]);
        *(uint2*)(H + (size_t)row * 1024 + c) = o;
      }
      if (gates) {
        float g8[8];
#pragma unroll
        for (int j = 0; j < 8; ++j) {
          float s2 = 0.f;
#pragma unroll
          for (int i = 0; i < 4; ++i) {
            const float4 wv = *(const float4*)(wl + j * 1024 + i * 256 + lane * 4);
            s2 += v[i * 4] * wv.x + v[i * 4 + 1] * wv.y + v[i * 4 + 2] * wv.z + v[i * 4 + 3] * wv.w;
          }
          g8[j] = wave_sum(s2, lane) + bif[j];
        }
        if (lane == 0) {
          *(float4*)(gout + (size_t)row * 8) = make_float4(g8[0], g8[1], g8[2], g8[3]);
          *(float4*)(gout + (size_t)row * 8 + 4) = make_float4(g8[4], g8[5], g8[6], g8[7]);
        }
      }
    }
  }
}

constexpr int EP_LD = 264;
constexpr int EP_LDT = 68;
DI void zero_acc(f32x16 (&acc)[4][2]) {
#pragma unroll
  for (int a = 0; a < 4; ++a)
#pragma unroll
    for (int b = 0; b < 2; ++b) zero16(acc[a][b]);
}
DI void stage_rm(const f32x16& a0, const f32x16& a1, float* stg, int wm, int wn, int r, int h) {
#pragma unroll
  for (int i = 0; i < 16; ++i) *(float2*)(stg + (wm * 32 + crow(i, h)) * EP_LD + wn * 64 + 2 * r) = make_float2(a0[i], a1[i]);
}
DI void stage_tr(const f32x16& a0, const f32x16& a1, float* stg, int wm, int wn, int r, int h) {
#pragma unroll
  for (int g = 0; g < 4; ++g) {
    *(float4*)(stg + (wn * 64 + 2 * r) * EP_LDT + wm * 32 + 8 * g + 4 * h) = make_float4(a0[4 * g], a0[4 * g + 1], a0[4 * g + 2], a0[4 * g + 3]);
    *(float4*)(stg + (wn * 64 + 2 * r + 1) * EP_LDT + wm * 32 + 8 * g + 4 * h) = make_float4(a1[4 * g], a1[4 * g + 1], a1[4 * g + 2], a1[4 * g + 3]);
  }
}
DI int grow_of(int m0, int mi, int lr) { return m0 + (lr >> 5) * 128 + mi * 32 + (lr & 31); }
DI uint4 pack8f(const float4& a, const float4& b) {
  uint4 o; o.x = pack2(a.x, a.y); o.y = pack2(a.z, a.w); o.z = pack2(b.x, b.y); o.w = pack2(b.z, b.w); return o;
}

DI void write_tr(const Params& p, int l, int m0, int mi, const float* stg, int tid, int which, int chbase) {
  const bool prompt = m0 < TOKP;
#pragma unroll
  for (int q = 0; q < 4; ++q) {
    const int cid = q * NTHR + tid, ch = cid >> 3, tc = cid & 7;
    const float4 v0 = *(const float4*)(stg + ch * EP_LDT + tc * 8);
    const float4 v1 = *(const float4*)(stg + ch * EP_LDT + tc * 8 + 4);
    const int row0 = grow_of(m0, mi, tc * 8);
    const int chg = chbase + ch;
    u16* d;
    if (prompt) {
      const int b = row0 >> 11, t = row0 & 2047;
      if (which == 0) d = (u16*)(p.ws + WS_VTP) + ((size_t)b * 512 + chg) * 2048 + t;
      else if (which == 1) d = (u16*)(p.ws + WS_MQKT_P) + ((size_t)b * 1024 + chg) * 2048 + t;
      else d = (u16*)(p.ws + WS_MVT_P) + ((size_t)b * 512 + chg) * 2048 + t;
    } else {
      const int rs = row0 - TOKP, bs = rs >> 5, t = rs & 31;
      if (which == 0) d = (u16*)(p.ws + WS_VTS) + ((size_t)(l * 8 + bs) * 512 + chg) * 1056 + 1024 + t;
      else if (which == 1) d = (u16*)(p.ws + WS_MQKT_S) + ((size_t)bs * 1024 + chg) * 32 + t;
      else d = (u16*)(p.ws + WS_MVT_S) + ((size_t)bs * 512 + chg) * 32 + t;
    }
    *(uint4*)d = pack8f(v0, v1);
  }
}

DI void epi_in(const Params& p, int l, int m0, int n0, f32x16 (&acc)[4][2], unsigned char* smem) {
  const int tid = otid(), lane = tid & 63, w = tid >> 6;
  const int wm = w >> 2, wn = w & 3, r = lane & 31, h = lane >> 5;
  const bool prompt = m0 < TOKP;
  float* stg = (float*)(smem + GS_BASE);
  const int seg = n0 < 512 ? 0 : (n0 < 1024 ? 1 : (n0 < 1536 ? 2 : (n0 < 2560 ? 3 : (n0 < 3072 ? 4 : 5))));
  if (seg == 3) {
    const int ch = n0 - 1536 + wn * 64 + 2 * r;
#pragma unroll
    for (int mi = 0; mi < 4; ++mi) {
      const int rb = m0 + wm * 128 + mi * 32 + 4 * h;
#pragma unroll
      for (int i = 0; i < 16; ++i) {
        const int row = rb + (i & 3) + 8 * (i >> 2);
        if (prompt) {
          const int tt = row & 2047;
          if (tt >= 2045) *(float2*)(p.out + O_CVP + ((size_t)(l * 32 + (row >> 11)) * 3 + (tt - 2045)) * 1024 + ch) = make_float2(acc[mi][0][i], acc[mi][1][i]);
        } else {
          const int rs = row - TOKP, tt = rs & 31;
          if (tt >= 29) *(float2*)(p.out + O_CVS + ((size_t)(l * 8 + (rs >> 5)) * 3 + (tt - 29)) * 1024 + ch) = make_float2(acc[mi][0][i], acc[mi][1][i]);
        }
      }
    }
  }
#pragma unroll
  for (int mi = 0; mi < 4; ++mi) {
    if (seg == 0 || seg == 1 || seg == 2 || seg == 5) {
      __syncthreads();
      stage_rm(acc[mi][0], acc[mi][1], stg, wm, wn, r, h);
      __syncthreads();
#pragma unroll
      for (int q = 0; q < 4; ++q) {
        const int cid = q * NTHR + tid, lr = cid >> 5, c8 = (cid & 31) * 8;
        const float4 v0 = *(const float4*)(stg + lr * EP_LD + c8);
        const float4 v1 = *(const float4*)(stg + lr * EP_LD + c8 + 4);
        const int row = grow_of(m0, mi, lr);
        const int n = n0 + c8;
        if (seg == 0) {
          *(uint4*)((u16*)(p.ws + WS_ZQ) + (size_t)row * 512 + n) = pack8f(v0, v1);
        } else if (seg == 5) {
          const float4 s0 = make_float4(sigmoidf_(v0.x), sigmoidf_(v0.y), sigmoidf_(v0.z), sigmoidf_(v0.w));
          const float4 s1 = make_float4(sigmoidf_(v1.x), sigmoidf_(v1.y), sigmoidf_(v1.z), sigmoidf_(v1.w));
          *(uint4*)((u16*)(p.ws + WS_MO) + (size_t)row * 512 + (n - 3072)) = pack8f(s0, s1);
        } else {
          const bool isk = seg == 1;
          const int nn = n - (isk ? 512 : 1024);
          float* of = p.out + (isk ? (prompt ? O_KP : O_KSM) : (prompt ? O_VP : O_VSM));
          const size_t orow = prompt ? ((size_t)l * TOKP + row) : ((size_t)l * TOKS + (row - TOKP));
          *(float4*)(of + orow * 512 + nn) = v0;
          *(float4*)(of + orow * 512 + nn + 4) = v1;
          if (isk) {
            u16* kd;
            if (prompt) kd = (u16*)(p.ws + WS_KB) + (size_t)row * 512 + nn;
            else { const int rs = row - TOKP; kd = (u16*)(p.ws + WS_KS) + ((size_t)(l * 8 + (rs >> 5)) * 1056 + 1024 + (rs & 31)) * 512 + nn; }
            *(uint4*)kd = pack8f(v0, v1);
          }
        }
      }
    }
    if (seg == 2 || seg == 3 || seg == 4) {
      __syncthreads();
      stage_tr(acc[mi][0], acc[mi][1], stg, wm, wn, r, h);
      __syncthreads();
      write_tr(p, l, m0, mi, stg, tid, seg == 2 ? 0 : (seg == 3 ? 1 : 2), n0 - (seg == 2 ? 1024 : (seg == 3 ? 1536 : 2560)));
    }
  }
  __syncthreads();
}

DI void phase_in_gate(const Params& p, int l, unsigned char* smem) {
  const int tid = otid(), lane = tid & 63, w = tid >> 6;
  const int wm = w >> 2, wn = w & 3, r = lane & 31, h = lane >> 5;
  const u16* H = (const u16*)(p.ws + WS_H);
  float* stg = (float*)(smem + GS_BASE);
  const int NT = 14 + 8, MT = 257;
  for (int it = 0;; ++it) {
    int mt, nt;
    if (!tile_of(it, MT, NT, mt, nt)) break;
    f32x16 acc[4][2];
    zero_acc(acc);
    const int m0 = mt * 256;
    if (nt < 14) {
      const int n0 = nt * 256;
      gemm_mainloop(acc, H, 1024, (const u16*)(p.ws + WS_WT_IN) + (size_t)l * 3584 * 1024, 1024, 1024, m0, n0, smem);
      epi_in(p, l, m0, n0, acc, smem);
    } else {
      const int n0 = (nt - 14) * 256;
      gemm_mainloop(acc, H, 1024, (const u16*)(p.ws + WS_WT_GATE) + (size_t)l * 2048 * 1024, 1024, 1024, m0, n0, smem);
      u16* G = (u16*)(p.ws + WS_G);
#pragma unroll
      for (int mi = 0; mi < 4; ++mi) {
        __syncthreads();
        stage_rm(acc[mi][0], acc[mi][1], stg, wm, wn, r, h);
        __syncthreads();
#pragma unroll
        for (int q = 0; q < 4; ++q) {
          const int cid = q * NTHR + tid, lr = cid >> 5, c8 = (cid & 31) * 8;
          float4 v0 = *(const float4*)(stg + lr * EP_LD + c8);
          float4 v1 = *(const float4*)(stg + lr * EP_LD + c8 + 4);
          const int row = grow_of(m0, mi, lr), n = n0 + c8;
          const float4 b0 = *(const float4*)(p.in[22] + l * 2048 + n);
          const float4 b1 = *(const float4*)(p.in[22] + l * 2048 + n + 4);
          v0 = make_float4(sigmoidf_(v0.x + b0.x), sigmoidf_(v0.y + b0.y), sigmoidf_(v0.z + b0.z), sigmoidf_(v0.w + b0.w));
          v1 = make_float4(sigmoidf_(v1.x + b1.x), sigmoidf_(v1.y + b1.y), sigmoidf_(v1.z + b1.z), sigmoidf_(v1.w + b1.w));
          *(uint4*)(G + (size_t)row * 2048 + n) = pack8f(v0, v1);
        }
      }
      __syncthreads();
    }
  }
}

DI void phase_mix(const Params& p, int l, unsigned char* smem) {
  const int tid = otid(), lane = tid & 63, w = tid >> 6;
  const int wm = w >> 2, wn = w & 3, r = lane & 31, h = lane >> 5;
  const u16* G = (const u16*)(p.ws + WS_G);
  u16* MIX = (u16*)(p.ws + WS_MIX);
  float* stg = (float*)(smem + GS_BASE);
  const int NT = 4, MT = 257;
  for (int it = 0;; ++it) {
    int mt, nt;
    if (!tile_of(it >> 1, MT, NT, mt, nt)) break;
    const int half = it & 1;
    const int m0 = mt * 256, n0 = nt * 256;
    f32x16 acc[4][2];
    zero_acc(acc);
    const u16* Ap = (const u16*)(p.ws + (half ? WS_MN : WS_AN));
    const u16* Wp = (const u16*)(p.ws + (half ? WS_WT_BRB : WS_WT_BRA)) + (size_t)l * 1024 * 512;
    gemm_mainloop(acc, Ap, 512, Wp, 512, 512, m0, n0, smem);
#pragma unroll
    for (int mi = 0; mi < 4; ++mi) {
      __syncthreads();
      stage_rm(acc[mi][0], acc[mi][1], stg, wm, wn, r, h);
      __syncthreads();
#pragma unroll
      for (int q = 0; q < 4; ++q) {
        const int cid = q * NTHR + tid, lr = cid >> 5, c8 = (cid & 31) * 8;
        const float4 v0 = *(const float4*)(stg + lr * EP_LD + c8);
        const float4 v1 = *(const float4*)(stg + lr * EP_LD + c8 + 4);
        const int row = grow_of(m0, mi, lr), n = n0 + c8;
        const uint4 g = *(const uint4*)(G + (size_t)row * 2048 + half * 1024 + n);
        float4 o0 = make_float4(bflo(g.x) * v0.x, bfhi(g.x) * v0.y, bflo(g.y) * v0.z, bfhi(g.y) * v0.w);
        float4 o1 = make_float4(bflo(g.z) * v1.x, bfhi(g.z) * v1.y, bflo(g.w) * v1.z, bfhi(g.w) * v1.w);
        uint4* mp = (uint4*)(MIX + (size_t)row * 1024 + n);
        if (half) {
          const uint4 pr = *mp;
          o0.x += bflo(pr.x); o0.y += bfhi(pr.x); o0.z += bflo(pr.y); o0.w += bfhi(pr.y);
          o1.x += bflo(pr.z); o1.y += bfhi(pr.z); o1.z += bflo(pr.w); o1.w += bfhi(pr.w);
        }
        *mp = pack8f(o0, o1);
      }
    }
    __syncthreads();
  }
}

DI void phase_res(const Params& p, int l, int mode, unsigned char* smem) {
  const int tid = otid(), lane = tid & 63, w = tid >> 6;
  const int wm = w >> 2, wn = w & 3, r = lane & 31, h = lane >> 5;
  const float* mod = (const float*)(p.ws + WS_MOD);
  float* stg = (float*)(smem + GS_BASE);
  const int NT = 4, MT = 257;
  for (int it = 0;; ++it) {
    int mt, nt;
    if (!tile_of(it, MT, NT, mt, nt)) break;
    const int m0 = mt * 256, n0 = nt * 256;
    f32x16 acc[4][2];
    zero_acc(acc);
    if (mode == 0) gemm_mainloop(acc, (const u16*)(p.ws + WS_MIX), 1024, (const u16*)(p.ws + WS_WT_O) + (size_t)l * 1024 * 1024, 1024, 1024, m0, n0, smem);
    else gemm_mainloop(acc, (const u16*)(p.ws + WS_ACT), 2816, (const u16*)(p.ws + WS_WT_DOWN) + (size_t)l * 1024 * 2816, 2816, 2816, m0, n0, smem);
    const int gi = (mode == 0) ? 2 : 5;
#pragma unroll
    for (int mi = 0; mi < 4; ++mi) {
      __syncthreads();
      stage_rm(acc[mi][0], acc[mi][1], stg, wm, wn, r, h);
      __syncthreads();
#pragma unroll
      for (int q = 0; q < 8; ++q) {
        const int cid = q * NTHR + tid, lr = cid >> 6, c4 = (cid & 63) * 4;
        const float4 v = *(const float4*)(stg + lr * EP_LD + c4);
        const int row = grow_of(m0, mi, lr), n = n0 + c4;
        const int b = batch_of_row(row);
        const float4 gg = *(const float4*)(mod + ((size_t)l * 40 + b) * 6144 + gi * 1024 + n);
        float* xr = p.out + (size_t)row * 1024 + n;
        const float* xs = (mode == 0 && l == 0) ? (row < TOKP ? p.in[0] + (size_t)row * 1024 + n : p.in[1] + (size_t)(row - TOKP) * 1024 + n) : xr;
        const float4 xv = *(const float4*)xs;
        *(float4*)xr = make_float4(ALPHA * xv.x + (1.f + gg.x) * v.x, ALPHA * xv.y + (1.f + gg.y) * v.y,
                                   ALPHA * xv.z + (1.f + gg.z) * v.z, ALPHA * xv.w + (1.f + gg.w) * v.w);
      }
    }
    __syncthreads();
  }
}

DI void phase_gu(const Params& p, int l, unsigned char* smem) {
  const int tid = otid(), lane = tid & 63, w = tid >> 6;
  const int wm = w >> 2, wn = w & 3, r = lane & 31, h = lane >> 5;
  u16* ACT = (u16*)(p.ws + WS_ACT);
  float* stg = (float*)(smem + GS_BASE);
  const int NT = 22, MT = 257;
  for (int it = 0;; ++it) {
    int mt, nt;
    if (!tile_of(it, MT, NT, mt, nt)) break;
    const int m0 = mt * 256, n0 = nt * 256;
    f32x16 acc[4][2];
    zero_acc(acc);
    gemm_mainloop(acc, (const u16*)(p.ws + WS_H), 1024, (const u16*)(p.ws + WS_WT_GU) + (size_t)l * 5632 * 1024, 1024, 1024, m0, n0, smem);
#pragma unroll
    for (int mi = 0; mi < 4; ++mi) {
      __syncthreads();
      stage_rm(acc[mi][0], acc[mi][1], stg, wm, wn, r, h);
      __syncthreads();
#pragma unroll
      for (int q = 0; q < 2; ++q) {
        const int cid = q * NTHR + tid, lr = cid >> 4, c16 = (cid & 15) * 16;
        const float4 v0 = *(const float4*)(stg + lr * EP_LD + c16);
        const float4 v1 = *(const float4*)(stg + lr * EP_LD + c16 + 4);
        const float4 v2 = *(const float4*)(stg + lr * EP_LD + c16 + 8);
        const float4 v3 = *(const float4*)(stg + lr * EP_LD + c16 + 12);
        const int row = grow_of(m0, mi, lr);
        uint4 o;
        o.x = pack2(siluf_(v0.x) * v0.y, siluf_(v0.z) * v0.w);
        o.y = pack2(siluf_(v1.x) * v1.y, siluf_(v1.z) * v1.w);
        o.z = pack2(siluf_(v2.x) * v2.y, siluf_(v2.z) * v2.w);
        o.w = pack2(siluf_(v3.x) * v3.y, siluf_(v3.z) * v3.w);
        *(uint4*)(ACT + (size_t)row * 2816 + (n0 >> 1) + (c16 >> 1)) = o;
      }
    }
    __syncthreads();
  }
}

constexpr int AT_BASE = 64;
constexpr int AT_KBYTES = 64 * 272;
constexpr int AT_VBYTES = 128 * 136;
constexpr int AT_STAGE = AT_KBYTES + AT_VBYTES;

DI void attn_item(const Params& p, int l, int b, int head, int qt, float lam, float lam_init, unsigned char* smem) {
  const int tid = otid(), lane = tid & 63, w = tid >> 6, r = lane & 31, h = lane >> 5;
  const int comp = w & 1, rg = w >> 1;
  const bool prompt = b < 32;
  const int bs = b - 32;
  const u16* Kg = prompt ? (const u16*)(p.ws + WS_KB) + (size_t)b * 2048 * 512 : (const u16*)(p.ws + WS_KS) + (size_t)(l * 8 + bs) * 1056 * 512;
  const u16* Vg = prompt ? (const u16*)(p.ws + WS_VTP) + (size_t)b * 512 * 2048 : (const u16*)(p.ws + WS_VTS) + (size_t)(l * 8 + bs) * 512 * 1056;
  const int ldT = prompt ? 2048 : 1056;
  const int nkt = prompt ? 2 * qt + 2 : 17;
  const int nkeys = prompt ? 2048 : 1056;
  const int qtok0 = prompt ? b * 2048 + qt * 128 : TOKP + bs * 32;
  const int qpos0 = prompt ? qt * 128 : 1024;
  const bool active = prompt || rg == 0;
  const int my_nkt = prompt ? (rg < 2 ? nkt - 1 : nkt) : nkt;
  const u16* ZQ = (const u16*)(p.ws + WS_ZQ);
  bf16x8 qf[4];
  {
    const int qrow = active ? qtok0 + rg * 32 + r : qtok0;
#pragma unroll
    for (int ks = 0; ks < 4; ++ks) qf[ks] = *(const bf16x8*)(ZQ + (size_t)qrow * 512 + head * 128 + comp * 64 + ks * 16 + h * 8);
  }
  const float slope2 = exp2f(-2.f * (head + 1)) * LOG2E;
  const float c1 = 0.125f * LOG2E;
  const int qpos = qpos0 + rg * 32 + r;
  f32x16 O[4];
#pragma unroll
  for (int i = 0; i < 4; ++i) zero16(O[i]);
  float m_run = -INFINITY, l_run = 0.f;

  const int krow = tid >> 4, kcc = tid & 15;
  const int vrow = tid >> 3, vcc = tid & 7;
  const u16* kp = Kg + (size_t)krow * 512 + head * 128 + kcc * 8;
  const u16* vp = Vg + (size_t)(head * 128 + vrow) * ldT + vcc * 8;
  uint4 rk0, rk1, rv0, rv1;
  unsigned char* sb = smem + AT_BASE;
  rk0 = *(const uint4*)kp; rk1 = *(const uint4*)(kp + 32 * 512);
  rv0 = *(const uint4*)vp; rv1 = *(const uint4*)(vp + (size_t)64 * ldT);
  {
    *(uint4*)(sb + krow * 272 + kcc * 16) = rk0;
    *(uint4*)(sb + (krow + 32) * 272 + kcc * 16) = rk1;
    *(uint2*)(sb + AT_KBYTES + vrow * 136 + vcc * 16) = make_uint2(rv0.x, rv0.y);
    *(uint2*)(sb + AT_KBYTES + vrow * 136 + vcc * 16 + 8) = make_uint2(rv0.z, rv0.w);
    *(uint2*)(sb + AT_KBYTES + (vrow + 64) * 136 + vcc * 16) = make_uint2(rv1.x, rv1.y);
    *(uint2*)(sb + AT_KBYTES + (vrow + 64) * 136 + vcc * 16 + 8) = make_uint2(rv1.z, rv1.w);
  }
  __syncthreads();
  for (int kt = 0; kt < nkt; ++kt) {
    const bool more = kt + 1 < nkt;
    if (more) {
      kp += 64 * 512; vp += 64;
      rk0 = *(const uint4*)kp; rk1 = *(const uint4*)(kp + 32 * 512);
      rv0 = *(const uint4*)vp; rv1 = *(const uint4*)(vp + (size_t)64 * ldT);
    }
    if (active && kt < my_nkt) {
      const unsigned char* Kt = sb + (kt & 1) * AT_STAGE;
      const unsigned char* Vt = Kt + AT_KBYTES;
      f32x16 s[2];
      zero16(s[0]); zero16(s[1]);
#pragma unroll
      for (int ks = 0; ks < 4; ++ks) {
#pragma unroll
        for (int sub = 0; sub < 2; ++sub) {
          const bf16x8 kf = *(const bf16x8*)(Kt + (sub * 32 + r) * 272 + (comp * 64 + ks * 16 + h * 8) * 2);
          s[sub] = MFMA(kf, qf[ks], s[sub]);
        }
      }
      float mx = -INFINITY;
#pragma unroll
      for (int sub = 0; sub < 2; ++sub)
#pragma unroll
        for (int i = 0; i < 16; ++i) {
          const int key = kt * 64 + sub * 32 + crow(i, h);
          float v = s[sub][i] * c1 - slope2 * fabsf((float)(qpos - key));
          if (!prompt && key >= nkeys) v = -INFINITY;
          s[sub][i] = v;
          mx = fmaxf(mx, v);
        }
      mx = fmaxf(mx, shx(mx, 32, lane));
      const float m_new = fmaxf(m_run, mx);
      const float alpha = fexp2(m_run - m_new);
      m_run = m_new;
      float lsum = 0.f;
#pragma unroll
      for (int sub = 0; sub < 2; ++sub)
#pragma unroll
        for (int i = 0; i < 16; ++i) {
          const float pv = fexp2(s[sub][i] - m_new);
          lsum += pv;
          s[sub][i] = pv;
        }
      l_run = l_run * alpha + lsum;
#pragma unroll
      for (int dt = 0; dt < 4; ++dt)
#pragma unroll
        for (int i = 0; i < 16; ++i) O[dt][i] *= alpha;
#pragma unroll
      for (int sub = 0; sub < 2; ++sub)
#pragma unroll
        for (int s2 = 0; s2 < 2; ++s2) {
          const bf16x8 pf = pack8(s[sub], s2);
#pragma unroll
          for (int dt = 0; dt < 4; ++dt) {
            const unsigned char* va = Vt + (dt * 32 + r) * 136 + (sub * 32 + s2 * 16 + 4 * h) * 2;
            const uint2 lo = *(const uint2*)va;
            const uint2 hi = *(const uint2*)(va + 16);
            const uint4 vv = make_uint4(lo.x, lo.y, hi.x, hi.y);
            O[dt] = MFMA(__builtin_bit_cast(bf16x8, vv), pf, O[dt]);
          }
        }
    }
    if (more) {
      unsigned char* sn = sb + ((kt + 1) & 1) * AT_STAGE;
      *(uint4*)(sn + krow * 272 + kcc * 16) = rk0;
      *(uint4*)(sn + (krow + 32) * 272 + kcc * 16) = rk1;
      *(uint2*)(sn + AT_KBYTES + vrow * 136 + vcc * 16) = make_uint2(rv0.x, rv0.y);
      *(uint2*)(sn + AT_KBYTES + vrow * 136 + vcc * 16 + 8) = make_uint2(rv0.z, rv0.w);
      *(uint2*)(sn + AT_KBYTES + (vrow + 64) * 136 + vcc * 16) = make_uint2(rv1.x, rv1.y);
      *(uint2*)(sn + AT_KBYTES + (vrow + 64) * 136 + vcc * 16 + 8) = make_uint2(rv1.z, rv1.w);
    }
    __syncthreads();
  }
  float* exch = (float*)(smem + AT_BASE);
  float inv = 0.f;
  if (active) { const float lt = l_run + shx(l_run, 32, lane); inv = 1.f / lt; }
  if (active && comp == 1) {
    const float sc = inv * lam;
#pragma unroll
    for (int dt = 0; dt < 4; ++dt)
#pragma unroll
      for (int i = 0; i < 16; ++i) exch[(rg * 64 + dt * 16 + i) * 64 + lane] = O[dt][i] * sc;
  }
  __syncthreads();
  if (active && comp == 0) {
    float ss = 0.f;
#pragma unroll
    for (int dt = 0; dt < 4; ++dt)
#pragma unroll
      for (int i = 0; i < 16; ++i) {
        const float o = O[dt][i] * inv - exch[(rg * 64 + dt * 16 + i) * 64 + lane];
        O[dt][i] = o;
        ss += o * o;
      }
    ss += shx(ss, 32, lane);
    const float rs = rsqrtf(ss * (1.f / 128.f) + LN_EPS) * (1.f - lam_init);
    u16* AN = (u16*)(p.ws + WS_AN) + (size_t)(qtok0 + rg * 32 + r) * 512 + head * 128;
    const float* gw = p.in[17] + l * 512 + head * 128;
#pragma unroll
    for (int dt = 0; dt < 4; ++dt)
#pragma unroll
      for (int g = 0; g < 4; ++g) {
        const int dv = dt * 32 + 8 * g + 4 * h;
        const float4 g4 = *(const float4*)(gw + dv);
        uint2 o;
        o.x = pack2(O[dt][4 * g] * rs * g4.x, O[dt][4 * g + 1] * rs * g4.y);
        o.y = pack2(O[dt][4 * g + 2] * rs * g4.z, O[dt][4 * g + 3] * rs * g4.w);
        *(uint2*)(AN + dv) = o;
      }
  }
}

constexpr int ML_QS = 64;
constexpr int ML_KS = ML_QS + 64 * 272;
constexpr int ML_KT = ML_KS + 64 * 272;
constexpr int ML_VT = ML_KT + 128 * 144;
constexpr int ML_CB = ML_VT + 128 * 144;
constexpr int ML_HB = ML_CB + 128 * 272;
constexpr int ML_SM = ML_HB + 64 * 132 * 4;
static_assert(ML_SM + 528 * 4 <= LDS_BYTES, "lds");

DI void mlstm_item(const Params& p, int l, int b, int head, unsigned char* smem) {
  const int tid = otid(), lane = tid & 63, w = tid >> 6, r = lane & 31, h = lane >> 5;
  const bool prompt = b < 32;
  const int bs = b - 32;
  const int T = prompt ? 2048 : 32;
  const int nch = prompt ? 32 : 1;
  const int L = prompt ? 64 : 32;
  const int tokbase = prompt ? b * 2048 : TOKP + bs * 32;
  const u16* qkT = prompt ? (const u16*)(p.ws + WS_MQKT_P) + (size_t)b * 1024 * 2048 : (const u16*)(p.ws + WS_MQKT_S) + (size_t)bs * 1024 * 32;
  const u16* vTg = prompt ? (const u16*)(p.ws + WS_MVT_P) + (size_t)b * 512 * 2048 : (const u16*)(p.ws + WS_MVT_S) + (size_t)bs * 512 * 32;
  u16* qs = (u16*)(smem + ML_QS);
  u16* ksm = (u16*)(smem + ML_KS);
  u16* kTw = (u16*)(smem + ML_KT);
  u16* vT = (u16*)(smem + ML_VT);
  u16* Cbf = (u16*)(smem + ML_CB);
  float* hbuf = (float*)(smem + ML_HB);
  float* a_s = (float*)(smem + ML_SM);
  float* mx_s = a_s + 64;
  float* ws_s = a_s + 128;
  float* wi_s = a_s + 192;
  float* emt_s = a_s + 256;
  float* nq_s = a_s + 320;
  float* nvec = a_s + 384;
  float* scal = a_s + 512;

  const int vt = w & 3, kt0 = (w >> 2) * 2;
  f32x16 accC[2];
  float m_run = 0.f;
  if (prompt) {
    zero16(accC[0]); zero16(accC[1]);
    if (tid < 128) nvec[tid] = 0.f;
  } else {
    const float* Cs = p.in[6] + ((size_t)(l * 8 + bs) * 4 + head) * 128 * 128;
#pragma unroll
    for (int q = 0; q < 2; ++q)
#pragma unroll
      for (int g = 0; g < 4; ++g) {
        const float4 c4 = *(const float4*)(Cs + (size_t)(vt * 32 + r) * 128 + (kt0 + q) * 32 + 8 * g + 4 * h);
        accC[q][4 * g] = c4.x; accC[q][4 * g + 1] = c4.y; accC[q][4 * g + 2] = c4.z; accC[q][4 * g + 3] = c4.w;
      }
    if (tid < 128) nvec[tid] = p.in[7][((size_t)(l * 8 + bs) * 4 + head) * 128 + tid];
    m_run = p.in[8][(l * 8 + bs) * 4 + head];
  }
#pragma unroll
  for (int q = 0; q < 2; ++q)
#pragma unroll
    for (int g = 0; g < 4; ++g) {
      uint2 o; o.x = pack2(accC[q][4 * g], accC[q][4 * g + 1]); o.y = pack2(accC[q][4 * g + 2], accC[q][4 * g + 3]);
      *(uint2*)(Cbf + (vt * 32 + r) * 136 + (kt0 + q) * 32 + 8 * g + 4 * h) = o;
    }
  const float* gatesp = (const float*)(p.ws + WS_GATES);
  const int vi = w >> 1, ti = w & 1;

  for (int c = 0; c < nch; ++c) {
    const int t0 = c * 64;
    if (w == 0) {
      const int t = lane;
      float ig = -INFINITY, lf = 0.f;
      if (t < L) {
        const float* gp = gatesp + (size_t)(tokbase + t0 + t) * 8;
        ig = gp[head];
        const float fg = gp[4 + head];
        lf = fminf(fg, 0.f) - log1pf(__expf(-fabsf(fg)));
      }
      float bc = lf;
#pragma unroll
      for (int off = 1; off < 64; off <<= 1) { const float v = shidx(bc, lane - off, lane); if (lane >= off) bc += v; }
      const float a = ig - bc;
      float M = a;
#pragma unroll
      for (int off = 1; off < 64; off <<= 1) { const float v = shidx(M, lane - off, lane); if (lane >= off) M = fmaxf(M, v); }
      const float mx = fmaxf(m_run, M);
      const float bL = shidx(bc, 63, lane);
      const float mxL = shidx(mx, 63, lane);
      a_s[t] = a; mx_s[t] = mx;
      ws_s[t] = __expf(a - mxL);
      wi_s[t] = __expf(m_run - mx);
      emt_s[t] = __expf(-(bc + mx));
      if (lane == 0) scal[1] = __expf(m_run - mxL);
      m_run = bL + mxL;
    }
    const int ch2 = tid >> 1, th = tid & 1;
    const bool isk = ch2 >= 128;
    const int dd = ch2 & 127;
    const int ch = (isk ? 512 : 0) + head * 128 + dd;
    const u16* rp = qkT + (size_t)ch * T + t0 + th * 32;
    float um3 = 0.f, um2 = 0.f, um1 = 0.f;
    const bool ldrow = prompt || th == 0;
    if (prompt) {
      if (th == 1 || c > 0) {
        const uint2 pv = *(const uint2*)(rp - 4);
        um3 = bfhi(pv.x); um2 = bflo(pv.y); um1 = bfhi(pv.y);
      }
    } else if (th == 0) {
      const float* cvp = p.in[9] + (size_t)(l * 8 + bs) * 3 * 1024 + ch;
      um3 = cvp[0]; um2 = cvp[1024]; um1 = cvp[2048];
    }
    const float cw0 = p.in[14][(l * 4 + 0) * 1024 + ch], cw1 = p.in[14][(l * 4 + 1) * 1024 + ch];
    const float cw2 = p.in[14][(l * 4 + 2) * 1024 + ch], cw3 = p.in[14][(l * 4 + 3) * 1024 + ch];
    const float cb = p.in[15][l * 1024 + ch];
    __syncthreads();
    {
      u16* dstrm = (isk ? ksm : qs) + (th * 32) * 136 + dd;
      const float oscale = isk ? 0.08838834764831845f : 1.f;
#pragma unroll 1
      for (int i = 0; i < 4; ++i) {
        uint4 uu = make_uint4(0, 0, 0, 0);
        if (ldrow) uu = *(const uint4*)(rp + i * 8);
        float u[8];
        u[0] = bflo(uu.x); u[1] = bfhi(uu.x); u[2] = bflo(uu.y); u[3] = bfhi(uu.y);
        u[4] = bflo(uu.z); u[5] = bfhi(uu.z); u[6] = bflo(uu.w); u[7] = bfhi(uu.w);
        float y[8];
#pragma unroll
        for (int e = 0; e < 8; ++e) {
          const float x3 = (e >= 3) ? u[e - 3] : (e == 0 ? um3 : (e == 1 ? um2 : um1));
          const float x2 = (e >= 2) ? u[e - 2] : (e == 0 ? um2 : um1);
          const float x1 = (e >= 1) ? u[e - 1] : um1;
          const float yy = cb + cw0 * x3 + cw1 * x2 + cw2 * x1 + cw3 * u[e];
          y[e] = siluf_(yy) * oscale;
        }
        um3 = u[5]; um2 = u[6]; um1 = u[7];
#pragma unroll
        for (int e = 0; e < 8; ++e) dstrm[(i * 8 + e) * 136] = f2bf(y[e]);
        if (isk) {
          const float4 w0 = *(const float4*)(ws_s + th * 32 + i * 8);
          const float4 w1 = *(const float4*)(ws_s + th * 32 + i * 8 + 4);
          uint4 o;
          o.x = pack2(y[0] * w0.x, y[1] * w0.y); o.y = pack2(y[2] * w0.z, y[3] * w0.w);
          o.z = pack2(y[4] * w1.x, y[5] * w1.y); o.w = pack2(y[6] * w1.z, y[7] * w1.w);
          *(uint4*)(kTw + dd * 72 + th * 32 + i * 8) = o;
        }
      }
#pragma unroll
      for (int i = 0; i < 2; ++i) {
        const int id = tid + 512 * i, row = id >> 3, cc = id & 7;
        uint4 vv = make_uint4(0, 0, 0, 0);
        if (prompt || cc < 4) vv = *(const uint4*)(vTg + (size_t)(head * 128 + row) * T + t0 + cc * 8);
        *(uint4*)(vT + row * 72 + cc * 8) = vv;
      }
    }
    __syncthreads();
    {
      const int t = tid >> 3, part = tid & 7;
      const uint4 q0 = *(const uint4*)(qs + t * 136 + part * 16);
      const uint4 q1 = *(const uint4*)(qs + t * 136 + part * 16 + 8);
      const float* nv = nvec + part * 16;
      float s = bflo(q0.x) * nv[0] + bfhi(q0.x) * nv[1] + bflo(q0.y) * nv[2] + bfhi(q0.y) * nv[3]
              + bflo(q0.z) * nv[4] + bfhi(q0.z) * nv[5] + bflo(q0.w) * nv[6] + bfhi(q0.w) * nv[7]
              + bflo(q1.x) * nv[8] + bfhi(q1.x) * nv[9] + bflo(q1.y) * nv[10] + bfhi(q1.y) * nv[11]
              + bflo(q1.z) * nv[12] + bfhi(q1.z) * nv[13] + bflo(q1.w) * nv[14] + bfhi(q1.w) * nv[15];
      s += shx(s, 1, lane); s += shx(s, 2, lane); s += shx(s, 4, lane);
      if (part == 0) nq_s[t] = s;
    }
    f32x16 accS[2], accO;
    zero16(accS[0]); zero16(accS[1]); zero16(accO);
    {
#pragma unroll
      for (int ks = 0; ks < 8; ++ks) {
        const bf16x8 qfr = *(const bf16x8*)(qs + (ti * 32 + r) * 136 + ks * 16 + h * 8);
        const bf16x8 k0 = *(const bf16x8*)(ksm + r * 136 + ks * 16 + h * 8);
        accS[0] = MFMA(k0, qfr, accS[0]);
        if (ti == 1) {
          const bf16x8 k1 = *(const bf16x8*)(ksm + (32 + r) * 136 + ks * 16 + h * 8);
          accS[1] = MFMA(k1, qfr, accS[1]);
        }
        const bf16x8 cf = *(const bf16x8*)(Cbf + (vi * 32 + r) * 136 + ks * 16 + h * 8);
        accO = MFMA(cf, qfr, accO);
      }
    }
    const int tcol = ti * 32 + r;
    const float mxt = mx_s[tcol];
    const float wit = wi_s[tcol];
    float dsum = 0.f;
#pragma unroll
    for (int sub = 0; sub < 2; ++sub) {
      if (sub <= ti) {
#pragma unroll
        for (int g = 0; g < 4; ++g) {
          const float4 a4 = *(const float4*)(a_s + sub * 32 + 8 * g + 4 * h);
          const float av[4] = {a4.x, a4.y, a4.z, a4.w};
#pragma unroll
          for (int e = 0; e < 4; ++e) {
            const int s = sub * 32 + 8 * g + 4 * h + e;
            const float wgt = (s <= tcol) ? __expf(av[e] - mxt) : 0.f;
            const float pv = accS[sub][4 * g + e] * wgt;
            accS[sub][4 * g + e] = pv;
            dsum += pv;
          }
        }
      }
    }
    dsum += shx(dsum, 32, lane);
#pragma unroll
    for (int i = 0; i < 16; ++i) accO[i] *= wit;
#pragma unroll
    for (int sub = 0; sub < 2; ++sub) {
      if (sub <= ti) {
#pragma unroll
        for (int s2 = 0; s2 < 2; ++s2) {
          const bf16x8 pf = pack8(accS[sub], s2);
          const u16* va = vT + (vi * 32 + r) * 72 + sub * 32 + s2 * 16 + 4 * h;
          const uint2 lo = *(const uint2*)va;
          const uint2 hi = *(const uint2*)(va + 8);
          const uint4 vq = make_uint4(lo.x, lo.y, hi.x, hi.y);
          accO = MFMA(__builtin_bit_cast(bf16x8, vq), pf, accO);
        }
      }
    }
    __syncthreads();
    {
      const float den = dsum + wit * nq_s[tcol];
      const float dn = fmaxf(fabsf(den), emt_s[tcol]);
      const float rinv = 1.f / dn;
#pragma unroll
      for (int g = 0; g < 4; ++g)
        *(float4*)(hbuf + tcol * 132 + vi * 32 + 8 * g + 4 * h) =
            make_float4(accO[4 * g] * rinv, accO[4 * g + 1] * rinv, accO[4 * g + 2] * rinv, accO[4 * g + 3] * rinv);
    }
    {
      const float wc = scal[1];
#pragma unroll
      for (int q = 0; q < 2; ++q)
#pragma unroll
        for (int i = 0; i < 16; ++i) accC[q][i] *= wc;
#pragma unroll
      for (int k4 = 0; k4 < 4; ++k4) {
        const bf16x8 vf = *(const bf16x8*)(vT + (vt * 32 + r) * 72 + k4 * 16 + h * 8);
#pragma unroll
        for (int q = 0; q < 2; ++q) {
          const bf16x8 kf = *(const bf16x8*)(kTw + ((kt0 + q) * 32 + r) * 72 + k4 * 16 + h * 8);
          accC[q] = MFMA(kf, vf, accC[q]);
        }
      }
#pragma unroll
      for (int q = 0; q < 2; ++q)
#pragma unroll
        for (int g = 0; g < 4; ++g) {
          uint2 o; o.x = pack2(accC[q][4 * g], accC[q][4 * g + 1]); o.y = pack2(accC[q][4 * g + 2], accC[q][4 * g + 3]);
          *(uint2*)(Cbf + (vt * 32 + r) * 136 + (kt0 + q) * 32 + 8 * g + 4 * h) = o;
        }
      if (tid < 128) {
        float s = 0.f;
#pragma unroll
        for (int i = 0; i < 8; ++i) {
          const uint4 kk = *(const uint4*)(kTw + tid * 72 + i * 8);
          s += bflo(kk.x) + bfhi(kk.x) + bflo(kk.y) + bfhi(kk.y) + bflo(kk.z) + bfhi(kk.z) + bflo(kk.w) + bfhi(kk.w);
        }
        nvec[tid] = wc * nvec[tid] + s;
      }
    }
    __syncthreads();
    {
      const int t = tid >> 3, part = tid & 7;
      float x[16];
#pragma unroll
      for (int i = 0; i < 4; ++i) {
        const float4 f = *(const float4*)(hbuf + t * 132 + part * 16 + i * 4);
        x[i * 4] = f.x; x[i * 4 + 1] = f.y; x[i * 4 + 2] = f.z; x[i * 4 + 3] = f.w;
      }
      float s = 0.f;
#pragma unroll
      for (int i = 0; i < 16; ++i) s += x[i];
      s += shx(s, 1, lane); s += shx(s, 2, lane); s += shx(s, 4, lane);
      const float mean = s * (1.f / 128.f);
      float q = 0.f;
#pragma unroll
      for (int i = 0; i < 16; ++i) { x[i] -= mean; q += x[i] * x[i]; }
      q += shx(q, 1, lane); q += shx(q, 2, lane); q += shx(q, 4, lane);
      const float rstd = rsqrtf(q * (1.f / 128.f) + LN_EPS);
      if (t < L) {
        const size_t tok = (size_t)tokbase + t0 + t;
        const int cbase = head * 128 + part * 16;
        const float* gw = p.in[18] + l * 512 + cbase;
        const u16* mo = (const u16*)(p.ws + WS_MO) + tok * 512 + cbase;
        const uint4 m0 = *(const uint4*)mo;
        const uint4 m1 = *(const uint4*)(mo + 8);
        const float sg[16] = {bflo(m0.x), bfhi(m0.x), bflo(m0.y), bfhi(m0.y), bflo(m0.z), bfhi(m0.z), bflo(m0.w), bfhi(m0.w),
                              bflo(m1.x), bfhi(m1.x), bflo(m1.y), bfhi(m1.y), bflo(m1.z), bfhi(m1.z), bflo(m1.w), bfhi(m1.w)};
        float yv[16];
#pragma unroll
        for (int i = 0; i < 16; ++i) yv[i] = x[i] * rstd * gw[i] * sg[i];
        uint4 o0, o1;
        o0.x = pack2(yv[0], yv[1]); o0.y = pack2(yv[2], yv[3]); o0.z = pack2(yv[4], yv[5]); o0.w = pack2(yv[6], yv[7]);
        o1.x = pack2(yv[8], yv[9]); o1.y = pack2(yv[10], yv[11]); o1.z = pack2(yv[12], yv[13]); o1.w = pack2(yv[14], yv[15]);
        u16* mn = (u16*)(p.ws + WS_MN) + tok * 512 + cbase;
        *(uint4*)mn = o0;
        *(uint4*)(mn + 8) = o1;
      }
    }
  }
  {
    float* oc = p.out + (prompt ? O_CP + ((size_t)(l * 32 + b) * 4 + head) * 16384 : O_CS + ((size_t)(l * 8 + bs) * 4 + head) * 16384);
#pragma unroll
    for (int q = 0; q < 2; ++q)
#pragma unroll
      for (int g = 0; g < 4; ++g)
        *(float4*)(oc + (size_t)(vt * 32 + r) * 128 + (kt0 + q) * 32 + 8 * g + 4 * h) =
            make_float4(accC[q][4 * g], accC[q][4 * g + 1], accC[q][4 * g + 2], accC[q][4 * g + 3]);
    float* on = p.out + (prompt ? O_NP + ((size_t)(l * 32 + b) * 4 + head) * 128 : O_NS + ((size_t)(l * 8 + bs) * 4 + head) * 128);
    if (tid < 128) on[tid] = nvec[tid];
    if (tid == 0) {
      if (prompt) p.out[O_MP + (size_t)(l * 32 + b) * 4 + head] = m_run;
      else p.out[O_MS + (size_t)(l * 8 + bs) * 4 + head] = m_run;
    }
  }
}

DI void phase_mixers(const Params& p, int l, unsigned char* smem) {
  const int tid0 = otid();
  const int lane = tid0 & 63;
  const float* lp = p.in[16] + l * 256;
  float s1 = lp[lane] * lp[64 + lane], s2 = lp[128 + lane] * lp[192 + lane];
  s1 = wave_sum(s1, lane); s2 = wave_sum(s2, lane);
  const float lam_init = 0.8f - 0.6f * expf(-0.3f * (float)l);
  const float lam = expf(s1) - expf(s2) + lam_init;
  int* ctr = (int*)(p.ws + WS_CTR) + l;
  int* sitem = (int*)smem;
  const int N_ML = 160, N_AT = 2048 + 32;
  for (;;) {
    __syncthreads();
    if (tid0 == 0) *sitem = atomicAdd(ctr, 1);
    __syncthreads();
    const int item = *sitem;
    if (item >= N_ML + N_AT) break;
    if (item < N_ML) {
#ifndef NO_ML
      mlstm_item(p, l, item >> 2, item & 3, smem);
#endif
    } else {
#ifndef NO_AT
      const int a = item - N_ML;
      if (a < 2048) {
        const int qt = 15 - (a >> 7), rest = a & 127;
        attn_item(p, l, rest >> 2, rest & 3, qt, lam, lam_init, smem);
      } else {
        const int s = a - 2048;
        attn_item(p, l, 32 + (s >> 2), s & 3, 0, lam, lam_init, smem);
      }
#endif
    }
  }
}

DI void gbar(unsigned* bar, unsigned& epoch) {
  __syncthreads();
  epoch += gridDim.x;
  if (otid() == 0) {
    __threadfence();
    __hip_atomic_fetch_add(bar, 1u, __ATOMIC_RELAXED, __HIP_MEMORY_SCOPE_AGENT);
    while (__hip_atomic_load(bar, __ATOMIC_RELAXED, __HIP_MEMORY_SCOPE_AGENT) < epoch) __builtin_amdgcn_s_sleep(2);
    __threadfence();
  }
  __syncthreads();
}

__global__ void __launch_bounds__(NTHR) fwd_megakernel(Params p) {
  extern __shared__ __attribute__((aligned(16))) unsigned char smem[];
  cg::grid_group grid = cg::this_grid();
#ifndef PH
#define PH 0xffff
#endif
  unsigned* bar = (unsigned*)(p.ws + WS_CTR + 64);
  unsigned epoch = 0;
  if (PH & 1) prologue(p, smem);
  grid.sync();
  if (PH & 1) prologue(p, smem);
  grid.sync();
  if (PH & 2) ln_pass(p, 0, 0, smem);
  gbar(bar, epoch);
#pragma unroll 1
  for (int l = 0; l < 2; ++l) {
    if (PH & 4) phase_in_gate(p, l, smem);
    gbar(bar, epoch);
    if (PH & 8) phase_mixers(p, l, smem);
    gbar(bar, epoch);
    if (PH & 16) phase_mix(p, l, smem);
    gbar(bar, epoch);
    if (PH & 32) phase_res(p, l, 0, smem);
    gbar(bar, epoch);
    if (PH & 64) ln_pass(p, 1, l, smem);
    gbar(bar, epoch);
    if (PH & 128) phase_gu(p, l, smem);
    gbar(bar, epoch);
    if (PH & 256) phase_res(p, l, 1, smem);
    gbar(bar, epoch);
    if (PH & 512) ln_pass(p, 2, l, smem);
    if (l == 0) gbar(bar, epoch);
  }
}

extern "C" void kernel_launch(void* const* d_in, const int* in_sizes, int n_in, void* d_out, int out_size, void* d_ws,
                              size_t ws_size, hipStream_t stream) {
  static int grid_blocks = 0;
  if (!grid_blocks) {
    int dev = 0, cus = 0, per_cu = 0;
    hipGetDevice(&dev);
    hipDeviceGetAttribute(&cus, hipDeviceAttributeMultiprocessorCount, dev);
    if (hipFuncSetAttribute((const void*)fwd_megakernel, hipFuncAttributeMaxDynamicSharedMemorySize, LDS_BYTES) != hipSuccess)
      fprintf(stderr, "kernel_launch: hipFuncSetAttribute failed\n");
    if (hipOccupancyMaxActiveBlocksPerMultiprocessor(&per_cu, (const void*)fwd_megakernel, NTHR, LDS_BYTES) != hipSuccess || per_cu < 1) {
      fprintf(stderr, "kernel_launch: occupancy query gave %d\n", per_cu);
      per_cu = 1;
    }
    (void)hipGetLastError();
    grid_blocks = cus * per_cu;
    if (ws_size < WS_END) fprintf(stderr, "kernel_launch: workspace too small: %zu < %zu\n", ws_size, (size_t)WS_END);
  }
  if (hipMemsetAsync((char*)d_ws + WS_CTR, 0, 256, stream) != hipSuccess) fprintf(stderr, "kernel_launch: memset failed\n");
  Params p{};
  for (int i = 0; i < 30; ++i) p.in[i] = (const float*)d_in[i];
  p.out = (float*)d_out;
  p.ws = (unsigned char*)d_ws;
  void* args[] = {&p};
  hipError_t e = hipLaunchCooperativeKernel((const void*)fwd_megakernel, dim3(grid_blocks), dim3(NTHR), args, LDS_BYTES, stream);
  if (e != hipSuccess) fprintf(stderr, "cooperative launch failed: %s (grid %d)\n", hipGetErrorString(e), grid_blocks);
}
```

```cpp
#include <hip/hip_runtime.h>
#include <hip/hip_cooperative_groups.h>
#include <cstdio>
namespace cg = cooperative_groups;

#define DI __device__ __forceinline__
typedef unsigned short u16;
using bf16x8 = __attribute__((ext_vector_type(8))) short;
using f32x16 = __attribute__((ext_vector_type(16))) float;
#define MFMA(a, b, c) __builtin_amdgcn_mfma_f32_32x32x16_bf16((a), (b), (c), 0, 0, 0)

constexpr int TOKP = 65536, TOKS = 256, TOK = 65792;
constexpr int NTHR = 512;
constexpr float LN_EPS = 1e-5f;
constexpr float ALPHA = 1.41421356237f;
constexpr float LOG2E = 1.44269504089f;

constexpr size_t WS_WT_IN   = 0;
constexpr size_t WS_WT_GATE = WS_WT_IN + 2ull * 3584 * 1024 * 2;
constexpr size_t WS_WT_BRA  = WS_WT_GATE + 2ull * 2048 * 1024 * 2;
constexpr size_t WS_WT_BRB  = WS_WT_BRA + 2ull * 1024 * 512 * 2;
constexpr size_t WS_WT_O    = WS_WT_BRB + 2ull * 1024 * 512 * 2;
constexpr size_t WS_WT_GU   = WS_WT_O + 2ull * 1024 * 1024 * 2;
constexpr size_t WS_WT_DOWN = WS_WT_GU + 2ull * 5632 * 1024 * 2;
constexpr size_t WS_MOD     = WS_WT_DOWN + 2ull * 1024 * 2816 * 2;
constexpr size_t WS_GATES   = WS_MOD + 2ull * 40 * 6144 * 4;
constexpr size_t WS_CTR     = WS_GATES + (size_t)TOK * 8 * 4;
constexpr size_t WS_KS      = WS_CTR + 256;
constexpr size_t WS_VTS     = WS_KS + 2ull * 8 * 1056 * 512 * 2 + 65536;
constexpr size_t WS_MQKT_S  = WS_VTS + 2ull * 8 * 512 * 1056 * 2 + 65536;
constexpr size_t WS_MVT_S   = WS_MQKT_S + 8ull * 1024 * 32 * 2;
constexpr size_t WS_H       = WS_MVT_S + 8ull * 512 * 32 * 2;
constexpr size_t WS_AN      = WS_H;
constexpr size_t WS_MN      = WS_H + (size_t)TOK * 512 * 2;
constexpr size_t WS_ZQ      = WS_H + (size_t)TOK * 1024 * 2;
constexpr size_t WS_KB      = WS_ZQ + (size_t)TOK * 512 * 2;
constexpr size_t WS_VTP     = WS_KB + (size_t)TOKP * 512 * 2;
constexpr size_t WS_MQKT_P  = WS_VTP + 32ull * 512 * 2048 * 2;
constexpr size_t WS_MVT_P   = WS_MQKT_P + 32ull * 1024 * 2048 * 2;
constexpr size_t WS_MO      = WS_MVT_P + 32ull * 512 * 2048 * 2;
constexpr size_t WS_G       = WS_MO + (size_t)TOK * 512 * 2;
constexpr size_t WS_END     = WS_G + (size_t)TOK * 2048 * 2;
constexpr size_t WS_MIX     = WS_ZQ;
constexpr size_t WS_ACT     = WS_ZQ;

constexpr size_t O_YP  = 0;
constexpr size_t O_YS  = O_YP + (size_t)TOKP * 1024;
constexpr size_t O_KP  = O_YS + (size_t)TOKS * 1024;
constexpr size_t O_VP  = O_KP + 2ull * TOKP * 512;
constexpr size_t O_KSM = O_VP + 2ull * TOKP * 512;
constexpr size_t O_VSM = O_KSM + 2ull * TOKS * 512;
constexpr size_t O_CP  = O_VSM + 2ull * TOKS * 512;
constexpr size_t O_NP  = O_CP + 2ull * 32 * 4 * 128 * 128;
constexpr size_t O_MP  = O_NP + 2ull * 32 * 4 * 128;
constexpr size_t O_CVP = O_MP + 2ull * 32 * 4;
constexpr size_t O_CS  = O_CVP + 2ull * 32 * 3 * 1024;
constexpr size_t O_NS  = O_CS + 2ull * 8 * 4 * 128 * 128;
constexpr size_t O_MS  = O_NS + 2ull * 8 * 4 * 128;
constexpr size_t O_CVS = O_MS + 2ull * 8 * 4;

constexpr int LDS_BYTES = 148480;

struct Params {
  const float* in[30];
  float* out;
  unsigned char* ws;
};

DI u16 f2bf(float x) { unsigned u = __float_as_uint(x); u += 0x7fffu + ((u >> 16) & 1u); return (u16)(u >> 16); }
DI float bf2f(unsigned v) { return __uint_as_float(v << 16); }
typedef __bf16 bf16x2_t __attribute__((ext_vector_type(2)));
typedef float f32x2_t __attribute__((ext_vector_type(2)));
DI unsigned pack2(float a, float b) {
  f32x2_t v = {a, b};
  return __builtin_bit_cast(unsigned, __builtin_convertvector(v, bf16x2_t));
}
DI float bflo(unsigned v) { return __uint_as_float(v << 16); }
DI float bfhi(unsigned v) { return __uint_as_float(v & 0xffff0000u); }
DI float sigmoidf_(float x) { return 1.f / (1.f + __expf(-x)); }
DI float siluf_(float x) { return x / (1.f + __expf(-x)); }
DI float fexp2(float x) { return __builtin_amdgcn_exp2f(x); }
DI int otid() { int t = threadIdx.x; asm volatile("" : "+v"(t)); return t; }
DI float shx(float v, int mask, int lane) { return __int_as_float(__builtin_amdgcn_ds_bpermute(((lane ^ mask) & 63) << 2, __float_as_int(v))); }
DI float shidx(float v, int src, int lane) { (void)lane; return __int_as_float(__builtin_amdgcn_ds_bpermute((src & 63) << 2, __float_as_int(v))); }
DI int crow(int i, int h) { return (i & 3) + 8 * (i >> 2) + 4 * h; }
DI bf16x8 pack8(const f32x16& x, int s) {
  uint4 u;
  u.x = pack2(x[8 * s + 0], x[8 * s + 1]); u.y = pack2(x[8 * s + 2], x[8 * s + 3]);
  u.z = pack2(x[8 * s + 4], x[8 * s + 5]); u.w = pack2(x[8 * s + 6], x[8 * s + 7]);
  return __builtin_bit_cast(bf16x8, u);
}
DI void zero16(f32x16& a) {
#pragma unroll
  for (int i = 0; i < 16; ++i) a[i] = 0.f;
}
DI int batch_of_row(int row) { return row < TOKP ? (row >> 11) : 32 + ((row - TOKP) >> 5); }

constexpr int GS_STRIDE = 144;
constexpr int GS_STAGE = 512 * GS_STRIDE;
constexpr int GS_BASE = 64;

DI void gemm_mainloop(f32x16 (&acc)[4][2], const u16* __restrict__ A, int lda, const u16* __restrict__ Wt, int ldw, int K,
                      int m0, int n0, unsigned char* smem) {
  const int tid = otid(), lane = tid & 63, w = tid >> 6;
  const int wm = w >> 2, wn = w & 3, r = lane & 31, h = lane >> 5;
  const int lrow = tid >> 3, lcc = tid & 7;
  const u16* ap = A + (size_t)(m0 + lrow) * lda + lcc * 8;
  const int bn = n0 + 2 * (lrow & 31) + ((lrow >> 5) & 1);
  const u16* bp = Wt + (size_t)bn * ldw + lcc * 8;
  const size_t astep = (size_t)64 * lda, bstep = (size_t)64 * ldw;
  unsigned char* sbase = smem + GS_BASE;
  const int woff = lrow * GS_STRIDE + lcc * 16;
  const int nk = K >> 6;
  uint4 s0, s1, s2, s3, s4, s5, s6, s7, u0, u1, u2, u3, u4, u5, u6, u7;
  int kn = 1;
#define G_ADV() do { const int adv = (kn < nk) ? 64 : 0; ap += adv; bp += adv; ++kn; } while (0)
#define G_ISSUE_A() do { s0 = *(const uint4*)(ap); s1 = *(const uint4*)(ap + astep); s2 = *(const uint4*)(ap + 2 * astep); s3 = *(const uint4*)(ap + 3 * astep); \
    s4 = *(const uint4*)(bp); s5 = *(const uint4*)(bp + bstep); s6 = *(const uint4*)(bp + 2 * bstep); s7 = *(const uint4*)(bp + 3 * bstep); } while (0)
#define G_ISSUE_B() do { u0 = *(const uint4*)(ap); u1 = *(const uint4*)(ap + astep); u2 = *(const uint4*)(ap + 2 * astep); u3 = *(const uint4*)(ap + 3 * astep); \
    u4 = *(const uint4*)(bp); u5 = *(const uint4*)(bp + bstep); u6 = *(const uint4*)(bp + 2 * bstep); u7 = *(const uint4*)(bp + 3 * bstep); } while (0)
#define G_WRITE_A(sn) do { *(uint4*)((sn) + woff) = s0; *(uint4*)((sn) + woff + 64 * GS_STRIDE) = s1; *(uint4*)((sn) + woff + 128 * GS_STRIDE) = s2; \
    *(uint4*)((sn) + woff + 192 * GS_STRIDE) = s3; *(uint4*)((sn) + woff + 256 * GS_STRIDE) = s4; *(uint4*)((sn) + woff + 320 * GS_STRIDE) = s5; \
    *(uint4*)((sn) + woff + 384 * GS_STRIDE) = s6; *(uint4*)((sn) + woff + 448 * GS_STRIDE) = s7; } while (0)
#define G_WRITE_B(sn) do { *(uint4*)((sn) + woff) = u0; *(uint4*)((sn) + woff + 64 * GS_STRIDE) = u1; *(uint4*)((sn) + woff + 128 * GS_STRIDE) = u2; \
    *(uint4*)((sn) + woff + 192 * GS_STRIDE) = u3; *(uint4*)((sn) + woff + 256 * GS_STRIDE) = u4; *(uint4*)((sn) + woff + 320 * GS_STRIDE) = u5; \
    *(uint4*)((sn) + woff + 384 * GS_STRIDE) = u6; *(uint4*)((sn) + woff + 448 * GS_STRIDE) = u7; } while (0)
  const int aoff = (wm * 128 + r) * GS_STRIDE + h * 16;
  const int boff = (256 + wn * 64 + r) * GS_STRIDE + h * 16;
#define G_COMPUTE(st) do { _Pragma("unroll") for (int ks = 0; ks < 4; ++ks) {                                              \
      bf16x8 fa[4], fb[2];                                                                                               \
      _Pragma("unroll") for (int mi = 0; mi < 4; ++mi) fa[mi] = *(const bf16x8*)((st) + aoff + mi * 32 * GS_STRIDE + ks * 32); \
      fb[0] = *(const bf16x8*)((st) + boff + ks * 32);                                                                   \
      fb[1] = *(const bf16x8*)((st) + boff + 32 * GS_STRIDE + ks * 32);                                                  \
      _Pragma("unroll") for (int mi = 0; mi < 4; ++mi) {                                                                 \
        acc[mi][0] = MFMA(fa[mi], fb[0], acc[mi][0]);                                                                    \
        acc[mi][1] = MFMA(fa[mi], fb[1], acc[mi][1]);                                                                    \
      }                                                                                                                  \
      __builtin_amdgcn_sched_barrier(0);                                                                                 \
    } } while (0)
  G_ISSUE_A();
  G_WRITE_A(sbase);
  G_ADV(); G_ISSUE_A();
  G_ADV(); G_ISSUE_B();
  __syncthreads();
  for (int kt = 0; kt < nk; kt += 2) {
    G_WRITE_A(sbase + GS_STAGE);
    G_ADV(); G_ISSUE_A();
    __builtin_amdgcn_sched_barrier(0);
    G_COMPUTE(sbase);
    __syncthreads();
    G_WRITE_B(sbase);
    G_ADV(); G_ISSUE_B();
    __builtin_amdgcn_sched_barrier(0);
    G_COMPUTE(sbase + GS_STAGE);
    __syncthreads();
  }
#undef G_ADV
#undef G_ISSUE_A
#undef G_ISSUE_B
#undef G_WRITE_A
#undef G_WRITE_B
#undef G_COMPUTE
}

DI int rot_unused_(int) { return 0; }
DI bool tile_of(int i, int MT, int NT, int& mt, int& nt) {
  const int per = gridDim.x >> 3;
  const int L = i * (int)gridDim.x + (int)(blockIdx.x & 7) * per + (int)(blockIdx.x >> 3);
  if (L >= MT * NT) return false;
  const int nig = 8 * NT, gid = L / nig, fm = gid * 8, gsz = min(MT - fm, 8), rem = L - gid * nig;
  mt = fm + rem % gsz; nt = rem / gsz;
  return true;
}


template <class PF, class EF>
DI void gemm_stream(int lda, int ldw, int K, unsigned char* smem, PF ptrs, EF epi) {
  const int tid = otid(), lane = tid & 63, w = tid >> 6;
  const int wm = w >> 2, wn = w & 3, r = lane & 31, h = lane >> 5;
  const int lrow = tid >> 3, lcc = tid & 7;
  const size_t astep = (size_t)64 * lda, bstep = (size_t)64 * ldw;
  unsigned char* sbase = smem + GS_BASE;
  const int woff = lrow * GS_STRIDE + lcc * 16;
  const int nk = K >> 6;
  const u16 *ap, *bp;
  if (!ptrs(0, ap, bp)) return;
  int it_iss = 0, kq = 0;
  bool live = true;
  uint4 s0, s1, s2, s3, s4, s5, s6, s7;
#define G_ADV() do { if (live) { if (++kq == nk) { const u16 *na_, *nb_; if (ptrs(it_iss + 1, na_, nb_)) { ++it_iss; ap = na_; bp = nb_; kq = 0; } else live = false; } \
    else { ap += 64; bp += 64; } } } while (0)
#define G_ISSUE_A() do { s0 = *(const uint4*)(ap); s1 = *(const uint4*)(ap + astep); s2 = *(const uint4*)(ap + 2 * astep); s3 = *(const uint4*)(ap + 3 * astep); \
    s4 = *(const uint4*)(bp); s5 = *(const uint4*)(bp + bstep); s6 = *(const uint4*)(bp + 2 * bstep); s7 = *(const uint4*)(bp + 3 * bstep); } while (0)
#define G_WRITE_A(sn) do { *(uint4*)((sn) + woff) = s0; *(uint4*)((sn) + woff + 64 * GS_STRIDE) = s1; *(uint4*)((sn) + woff + 128 * GS_STRIDE) = s2; \
    *(uint4*)((sn) + woff + 192 * GS_STRIDE) = s3; *(uint4*)((sn) + woff + 256 * GS_STRIDE) = s4; *(uint4*)((sn) + woff + 320 * GS_STRIDE) = s5; \
    *(uint4*)((sn) + woff + 384 * GS_STRIDE) = s6; *(uint4*)((sn) + woff + 448 * GS_STRIDE) = s7; } while (0)
  const int aoff = (wm * 128 + r) * GS_STRIDE + h * 16;
  const int boff = (256 + wn * 64 + r) * GS_STRIDE + h * 16;
#define G_COMPUTE(st) do { _Pragma("unroll") for (int ks = 0; ks < 4; ++ks) {                                              \
      bf16x8 fa[4], fb[2];                                                                                               \
      _Pragma("unroll") for (int mi = 0; mi < 4; ++mi) fa[mi] = *(const bf16x8*)((st) + aoff + mi * 32 * GS_STRIDE + ks * 32); \
      fb[0] = *(const bf16x8*)((st) + boff + ks * 32);                                                                   \
      fb[1] = *(const bf16x8*)((st) + boff + 32 * GS_STRIDE + ks * 32);                                                  \
      _Pragma("unroll") for (int mi = 0; mi < 4; ++mi) {                                                                 \
        acc[mi][0] = MFMA(fa[mi], fb[0], acc[mi][0]);                                                                    \
        acc[mi][1] = MFMA(fa[mi], fb[1], acc[mi][1]);                                                                    \
      }                                                                                                                  \
      __builtin_amdgcn_sched_barrier(0);                                                                                 \
    } } while (0)
  G_ISSUE_A();
  G_WRITE_A(sbase);
  G_ADV(); G_ISSUE_A();
  __syncthreads();
  for (int it = 0;; ++it) {
    f32x16 acc[4][2];
#pragma unroll
    for (int a = 0; a < 4; ++a)
#pragma unroll
      for (int b = 0; b < 2; ++b) zero16(acc[a][b]);
    for (int kt = 0; kt < nk; kt += 2) {
      G_WRITE_A(sbase + GS_STAGE);
      G_ADV(); G_ISSUE_A();
      __builtin_amdgcn_sched_barrier(0);
      G_COMPUTE(sbase);
      __syncthreads();
      G_WRITE_A(sbase);
      G_ADV(); G_ISSUE_A();
      __builtin_amdgcn_sched_barrier(0);
      G_COMPUTE(sbase + GS_STAGE);
      __syncthreads();
    }
    epi(it, acc);
    const u16 *da_, *db_;
    if (!ptrs(it + 1, da_, db_)) break;
  }
#undef G_ADV
#undef G_ISSUE_A
#undef G_WRITE_A
#undef G_COMPUTE
}

DI int map_row(int maptype, int s) {
  if (maptype == 1) return s < 3072 ? s : (s < 3080 ? -1 : s - 8);
  if (maptype == 2) return s < 2816 ? 2 * s : 2 * (s - 2816) + 1;
  return s;
}
DI void transpose_task(const float* __restrict__ src, int Nsrc, u16* __restrict__ dst, int dld, int maptype, int kt, int nt,
                       unsigned char* smem) {
  float* tile = (float*)(smem + 64);
  const int tid = otid();
  const int k0 = kt * 64, s0 = nt * 64;
#pragma unroll
  for (int i = 0; i < 2; ++i) {
    const int kr = (tid >> 4) + 32 * i, nc = (tid & 15) * 4;
    float4 v = make_float4(0.f, 0.f, 0.f, 0.f);
    if (s0 + nc < Nsrc) v = *(const float4*)(src + (size_t)(k0 + kr) * Nsrc + s0 + nc);
    tile[kr * 65 + nc + 0] = v.x; tile[kr * 65 + nc + 1] = v.y; tile[kr * 65 + nc + 2] = v.z; tile[kr * 65 + nc + 3] = v.w;
  }
  __syncthreads();
  {
    const int n = tid >> 3, kc = (tid & 7) * 8;
    const int s = s0 + n;
    const int dr = (s < Nsrc) ? map_row(maptype, s) : -1;
    if (dr >= 0) {
      uint4 o;
      o.x = pack2(tile[(kc + 0) * 65 + n], tile[(kc + 1) * 65 + n]);
      o.y = pack2(tile[(kc + 2) * 65 + n], tile[(kc + 3) * 65 + n]);
      o.z = pack2(tile[(kc + 4) * 65 + n], tile[(kc + 5) * 65 + n]);
      o.w = pack2(tile[(kc + 6) * 65 + n], tile[(kc + 7) * 65 + n]);
      *(uint4*)(dst + (size_t)dr * dld + k0 + kc) = o;
    }
  }
  __syncthreads();
}

DI void adaln_task(const Params& p, int task, unsigned char* smem) {
  const int bhalf = task & 1, cg_ = (task >> 1) % 96, l = (task >> 1) / 96;
  float* cs = (float*)(smem + 64);
  float* red = (float*)(smem + 64 + 20 * 1024 * 4);
  const int tid = otid();
  const float* cp = p.in[2]; const float* csm = p.in[3];
  for (int idx = tid; idx < 20 * 1024; idx += NTHR) {
    const int bb = idx >> 10, d = idx & 1023, b = bhalf * 20 + bb;
    const float c = b < 32 ? cp[b * 1024 + d] : csm[(b - 32) * 1024 + d];
    cs[idx] = siluf_(c);
  }
  __syncthreads();
  const int dseg = tid >> 6, e = cg_ * 64 + (tid & 63);
  const float* wp = p.in[10] + ((size_t)l * 1024 + dseg * 128) * 6144 + e;
  float acc[20];
#pragma unroll
  for (int i = 0; i < 20; ++i) acc[i] = 0.f;
  for (int d = 0; d < 128; ++d) {
    const float wv = wp[(size_t)d * 6144];
    const float* c0 = cs + dseg * 128 + d;
#pragma unroll
    for (int i = 0; i < 20; ++i) acc[i] += c0[i * 1024] * wv;
  }
#pragma unroll
  for (int i = 0; i < 20; ++i) red[(dseg * 20 + i) * 64 + (tid & 63)] = acc[i];
  __syncthreads();
  float* mod = (float*)(p.ws + WS_MOD);
  for (int idx = tid; idx < 20 * 64; idx += NTHR) {
    const int bb = idx >> 6, ec = idx & 63;
    float s = 0.f;
#pragma unroll
    for (int q = 0; q < 8; ++q) s += red[(q * 20 + bb) * 64 + ec];
    const int ee = cg_ * 64 + ec;
    mod[((size_t)l * 40 + bhalf * 20 + bb) * 6144 + ee] = s + p.in[11][l * 6144 + ee];
  }
  __syncthreads();
}

DI void prologue(const Params& p, unsigned char* smem) {
  const int WT_TASKS_L = 912 + 512 + 128 + 128 + 256 + 1408 + 704;
  const int N_WT = 2 * WT_TASKS_L;
  const int N_ADA = 384, N_CK = 512, N_CV = 2048;
  const int total = N_WT + N_ADA + N_CK + N_CV;
  for (int task = blockIdx.x; task < total; task += gridDim.x) {
    if (task < N_WT) {
      const int l = task / WT_TASKS_L; int t = task % WT_TASKS_L;
      if (t < 912) { transpose_task(p.in[12] + (size_t)l * 1024 * 3592, 3592, (u16*)(p.ws + WS_WT_IN) + (size_t)l * 3584 * 1024, 1024, 1, t / 57, t % 57, smem); continue; }
      t -= 912;
      if (t < 512) { transpose_task(p.in[21] + (size_t)l * 1024 * 2048, 2048, (u16*)(p.ws + WS_WT_GATE) + (size_t)l * 2048 * 1024, 1024, 0, t / 32, t % 32, smem); continue; }
      t -= 512;
      if (t < 128) { transpose_task(p.in[19] + (size_t)l * 512 * 1024, 1024, (u16*)(p.ws + WS_WT_BRA) + (size_t)l * 1024 * 512, 512, 0, t / 16, t % 16, smem); continue; }
      t -= 128;
      if (t < 128) { transpose_task(p.in[20] + (size_t)l * 512 * 1024, 1024, (u16*)(p.ws + WS_WT_BRB) + (size_t)l * 1024 * 512, 512, 0, t / 16, t % 16, smem); continue; }
      t -= 128;
      if (t < 256) { transpose_task(p.in[23] + (size_t)l * 1024 * 1024, 1024, (u16*)(p.ws + WS_WT_O) + (size_t)l * 1024 * 1024, 1024, 0, t / 16, t % 16, smem); continue; }
      t -= 256;
      if (t < 1408) { transpose_task(p.in[26] + (size_t)l * 1024 * 5632, 5632, (u16*)(p.ws + WS_WT_GU) + (size_t)l * 5632 * 1024, 1024, 2, t / 88, t % 88, smem); continue; }
      t -= 1408;
      transpose_task(p.in[27] + (size_t)l * 2816 * 1024, 1024, (u16*)(p.ws + WS_WT_DOWN) + (size_t)l * 1024 * 2816, 2816, 0, t / 16, t % 16, smem);
    } else if (task < N_WT + N_ADA) {
      adaln_task(p, task - N_WT, smem);
    } else if (task < N_WT + N_ADA + N_CK) {
      const int t = task - N_WT - N_ADA;
      const float4* src = (const float4*)p.in[4];
      u16* dst = (u16*)(p.ws + WS_KS);
#pragma unroll
      for (int i = 0; i < 8; ++i) {
        const size_t f4 = (size_t)t * 4096 + i * 512 + otid();
        const float4 v = src[f4];
        const size_t e = f4 * 4;
        const size_t lb = e / (1024 * 512), rem = e % (1024 * 512);
        uint2 o; o.x = pack2(v.x, v.y); o.y = pack2(v.z, v.w);
        *(uint2*)(dst + lb * (1056 * 512) + rem) = o;
      }
    } else {
      const int t = task - N_WT - N_ADA - N_CK;
      const int lb = t >> 7, tt = t & 127;
      transpose_task(p.in[5] + (size_t)lb * 1024 * 512, 512, (u16*)(p.ws + WS_VTS) + (size_t)lb * 512 * 1056, 1056, 0, tt >> 3, tt & 7, smem);
    }
  }
}

DI float wave_sum(float v, int lane) {
#pragma unroll
  for (int off = 32; off >= 1; off >>= 1) v += shx(v, off, lane);
  return v;
}
DI void ln_pass(const Params& p, int mode, int l, unsigned char* smem) {
  const int tid = otid();
  const int lane = tid & 63, w = tid >> 6;
  const bool first = mode != 0;
  const bool second = (mode != 2) || (l + 1 < 2);
  const bool gates = (mode == 0) || (mode == 2 && l + 1 < 2);
  const int lm = (mode == 2) ? l + 1 : l;
  const int shi = (mode == 1) ? 3 : 0;
  const float* lng = (mode == 1) ? p.in[24] + l * 1024 : p.in[28] + l * 1024;
  const float* lnb = (mode == 1) ? p.in[25] + l * 1024 : p.in[29] + l * 1024;
  const float* mod = (const float*)(p.ws + WS_MOD);
  u16* H = (u16*)(p.ws + WS_H);
  float* gout = (float*)(p.ws + WS_GATES);
  float* wl = (float*)(smem + 64);
  float bif[8];
  if (gates) {
    const float* wi = p.in[12] + (size_t)lm * 1024 * 3592 + 3072;
    for (int idx = tid; idx < 8192; idx += NTHR) {
      const int c = idx >> 3, j = idx & 7;
      wl[j * 1024 + c] = wi[(size_t)c * 3592 + j];
    }
#pragma unroll
    for (int j = 0; j < 8; ++j) bif[j] = p.in[13][lm * 8 + j];
  }
  __syncthreads();
  for (int row = blockIdx.x * 8 + w; row < TOK; row += gridDim.x * 8) {
    float* xr = p.out + (size_t)row * 1024;
    const float* src = (mode == 0) ? (row < TOKP ? p.in[0] + (size_t)row * 1024 : p.in[1] + (size_t)(row - TOKP) * 1024) : xr;
    float v[16];
#pragma unroll
    for (int i = 0; i < 4; ++i) {
      const float4 t = *(const float4*)(src + i * 256 + lane * 4);
      v[i * 4 + 0] = t.x; v[i * 4 + 1] = t.y; v[i * 4 + 2] = t.z; v[i * 4 + 3] = t.w;
    }
    if (first) {
      float s = 0.f;
#pragma unroll
      for (int i = 0; i < 16; ++i) s += v[i];
      const float mean = wave_sum(s, lane) * (1.f / 1024.f);
      float q = 0.f;
#pragma unroll
      for (int i = 0; i < 16; ++i) { v[i] -= mean; q += v[i] * v[i]; }
      const float rstd = rsqrtf(wave_sum(q, lane) * (1.f / 1024.f) + LN_EPS);
#pragma unroll
      for (int i = 0; i < 4; ++i) {
        const int c = i * 256 + lane * 4;
        const float4 g = *(const float4*)(lng + c);
        const float4 b = *(const float4*)(lnb + c);
        v[i * 4 + 0] = v[i * 4 + 0] * rstd * g.x + b.x; v[i * 4 + 1] = v[i * 4 + 1] * rstd * g.y + b.y;
        v[i * 4 + 2] = v[i * 4 + 2] * rstd * g.z + b.z; v[i * 4 + 3] = v[i * 4 + 3] * rstd * g.w + b.w;
        *(float4*)(xr + c) = make_float4(v[i * 4 + 0], v[i * 4 + 1], v[i * 4 + 2], v[i * 4 + 3]);
      }
    }
    if (second) {
      float s = 0.f;
#pragma unroll
      for (int i = 0; i < 16; ++i) s += v[i];
      const float mean = wave_sum(s, lane) * (1.f / 1024.f);
      float q = 0.f;
#pragma unroll
      for (int i = 0; i < 16; ++i) { v[i] -= mean; q += v[i] * v[i]; }
      const float rstd = rsqrtf(wave_sum(q, lane) * (1.f / 1024.f) + LN_EPS);
      const int b = batch_of_row(row);
      const float* mb = mod + ((size_t)lm * 40 + b) * 6144;
#pragma unroll
      for (int i = 0; i < 4; ++i) {
        const int c = i * 256 + lane * 4;
        const float4 sh = *(const float4*)(mb + shi * 1024 + c);
        const float4 sc = *(const float4*)(mb + (shi + 1) * 1024 + c);
        v[i * 4 + 0] = v[i * 4 + 0] * rstd * (1.f + sc.x) + sh.x; v[i * 4 + 1] = v[i * 4 + 1] * rstd * (1.f + sc.y) + sh.y;
        v[i * 4 + 2] = v[i * 4 + 2] * rstd * (1.f + sc.z) + sh.z; v[i * 4 + 3] = v[i * 4 + 3] * rstd * (1.f + sc.w) + sh.w;
        uint2 o; o.x = pack2(v[i * 4 + 0], v[i * 4 + 1]); o.y = pack2(v[i * 4 + 2], v[i * 4 + 3]);
        *(uint2*)(H + (size_t)row * 1024 + c) = o;
      }
      if (gates) {
        float g8[8];
#pragma unroll
        for (int j = 0; j < 8; ++j) {
          float s2 = 0.f;
#pragma unroll
          for (int i = 0; i < 4; ++i) {
            const float4 wv = *(const float4*)(wl + j * 1024 + i * 256 + lane * 4);
            s2 += v[i * 4] * wv.x + v[i * 4 + 1] * wv.y + v[i * 4 + 2] * wv.z + v[i * 4 + 3] * wv.w;
          }
          g8[j] = wave_sum(s2, lane) + bif[j];
        }
        if (lane == 0) {
          *(float4*)(gout + (size_t)row * 8) = make_float4(g8[0], g8[1], g8[2], g8[3]);
          *(float4*)(gout + (size_t)row * 8 + 4) = make_float4(g8[4], g8[5], g8[6], g8[7]);
        }
      }
    }
  }
}

constexpr int EP_LD = 264;
constexpr int EP_LDT = 68;
DI void zero_acc(f32x16 (&acc)[4][2]) {
#pragma unroll
  for (int a = 0; a < 4; ++a)
#pragma unroll
    for (int b = 0; b < 2; ++b) zero16(acc[a][b]);
}
DI void stage_rm(const f32x16& a0, const f32x16& a1, float* stg, int wm, int wn, int r, int h) {
#pragma unroll
  for (int i = 0; i < 16; ++i) *(float2*)(stg + (wm * 32 + crow(i, h)) * EP_LD + wn * 64 + 2 * r) = make_float2(a0[i], a1[i]);
}
DI void stage_tr(const f32x16& a0, const f32x16& a1, float* stg, int wm, int wn, int r, int h) {
#pragma unroll
  for (int g = 0; g < 4; ++g) {
    *(float4*)(stg + (wn * 64 + 2 * r) * EP_LDT + wm * 32 + 8 * g + 4 * h) = make_float4(a0[4 * g], a0[4 * g + 1], a0[4 * g + 2], a0[4 * g + 3]);
    *(float4*)(stg + (wn * 64 + 2 * r + 1) * EP_LDT + wm * 32 + 8 * g + 4 * h) = make_float4(a1[4 * g], a1[4 * g + 1], a1[4 * g + 2], a1[4 * g + 3]);
  }
}
DI int grow_of(int m0, int mi, int lr) { return m0 + (lr >> 5) * 128 + mi * 32 + (lr & 31); }
DI uint4 pack8f(const float4& a, const float4& b) {
  uint4 o; o.x = pack2(a.x, a.y); o.y = pack2(a.z, a.w); o.z = pack2(b.x, b.y); o.w = pack2(b.z, b.w); return o;
}

DI void write_tr(const Params& p, int l, int m0, int mi, const float* stg, int tid, int which, int chbase) {
  const bool prompt = m0 < TOKP;
#pragma unroll 1
  for (int q = 0; q < 4; ++q) {
    const int cid = q * NTHR + tid, ch = cid >> 3, tc = cid & 7;
    const float4 v0 = *(const float4*)(stg + ch * EP_LDT + tc * 8);
    const float4 v1 = *(const float4*)(stg + ch * EP_LDT + tc * 8 + 4);
    const int row0 = grow_of(m0, mi, tc * 8);
    const int chg = chbase + ch;
    u16* d;
    if (prompt) {
      const int b = row0 >> 11, t = row0 & 2047;
      if (which == 0) d = (u16*)(p.ws + WS_VTP) + ((size_t)b * 512 + chg) * 2048 + t;
      else if (which == 1) d = (u16*)(p.ws + WS_MQKT_P) + ((size_t)b * 1024 + chg) * 2048 + t;
      else d = (u16*)(p.ws + WS_MVT_P) + ((size_t)b * 512 + chg) * 2048 + t;
    } else {
      const int rs = row0 - TOKP, bs = rs >> 5, t = rs & 31;
      if (which == 0) d = (u16*)(p.ws + WS_VTS) + ((size_t)(l * 8 + bs) * 512 + chg) * 1056 + 1024 + t;
      else if (which == 1) d = (u16*)(p.ws + WS_MQKT_S) + ((size_t)bs * 1024 + chg) * 32 + t;
      else d = (u16*)(p.ws + WS_MVT_S) + ((size_t)bs * 512 + chg) * 32 + t;
    }
    *(uint4*)d = pack8f(v0, v1);
  }
}

DI void epi_in(const Params& p, int l, int m0, int n0, f32x16 (&acc)[4][2], unsigned char* smem) {
  const int tid = otid(), lane = tid & 63, w = tid >> 6;
  const int wm = w >> 2, wn = w & 3, r = lane & 31, h = lane >> 5;
  const bool prompt = m0 < TOKP;
  float* stg = (float*)(smem + GS_BASE + GS_STAGE);
  const int seg = n0 < 512 ? 0 : (n0 < 1024 ? 1 : (n0 < 1536 ? 2 : (n0 < 2560 ? 3 : (n0 < 3072 ? 4 : 5))));
  if (seg == 3) {
    const int ch = n0 - 1536 + wn * 64 + 2 * r;
#pragma unroll
    for (int mi = 0; mi < 4; ++mi) {
      const int rb = m0 + wm * 128 + mi * 32 + 4 * h;
#pragma unroll
      for (int i = 0; i < 16; ++i) {
        const int row = rb + (i & 3) + 8 * (i >> 2);
        if (prompt) {
          const int tt = row & 2047;
          if (tt >= 2045) *(float2*)(p.out + O_CVP + ((size_t)(l * 32 + (row >> 11)) * 3 + (tt - 2045)) * 1024 + ch) = make_float2(acc[mi][0][i], acc[mi][1][i]);
        } else {
          const int rs = row - TOKP, tt = rs & 31;
          if (tt >= 29) *(float2*)(p.out + O_CVS + ((size_t)(l * 8 + (rs >> 5)) * 3 + (tt - 29)) * 1024 + ch) = make_float2(acc[mi][0][i], acc[mi][1][i]);
        }
      }
    }
  }
#pragma unroll
  for (int mi = 0; mi < 4; ++mi) {
    if (seg == 0 || seg == 1 || seg == 2 || seg == 5) {
      __syncthreads();
      stage_rm(acc[mi][0], acc[mi][1], stg, wm, wn, r, h);
      __syncthreads();
#pragma unroll 1
      for (int q = 0; q < 4; ++q) {
        const int cid = q * NTHR + tid, lr = cid >> 5, c8 = (cid & 31) * 8;
        const float4 v0 = *(const float4*)(stg + lr * EP_LD + c8);
        const float4 v1 = *(const float4*)(stg + lr * EP_LD + c8 + 4);
        const int row = grow_of(m0, mi, lr);
        const int n = n0 + c8;
        if (seg == 0) {
          *(uint4*)((u16*)(p.ws + WS_ZQ) + (size_t)row * 512 + n) = pack8f(v0, v1);
        } else if (seg == 5) {
          const float4 s0 = make_float4(sigmoidf_(v0.x), sigmoidf_(v0.y), sigmoidf_(v0.z), sigmoidf_(v0.w));
          const float4 s1 = make_float4(sigmoidf_(v1.x), sigmoidf_(v1.y), sigmoidf_(v1.z), sigmoidf_(v1.w));
          *(uint4*)((u16*)(p.ws + WS_MO) + (size_t)row * 512 + (n - 3072)) = pack8f(s0, s1);
        } else {
          const bool isk = seg == 1;
          const int nn = n - (isk ? 512 : 1024);
          float* of = p.out + (isk ? (prompt ? O_KP : O_KSM) : (prompt ? O_VP : O_VSM));
          const size_t orow = prompt ? ((size_t)l * TOKP + row) : ((size_t)l * TOKS + (row - TOKP));
          *(float4*)(of + orow * 512 + nn) = v0;
          *(float4*)(of + orow * 512 + nn + 4) = v1;
          if (isk) {
            u16* kd;
            if (prompt) kd = (u16*)(p.ws + WS_KB) + (size_t)row * 512 + nn;
            else { const int rs = row - TOKP; kd = (u16*)(p.ws + WS_KS) + ((size_t)(l * 8 + (rs >> 5)) * 1056 + 1024 + (rs & 31)) * 512 + nn; }
            *(uint4*)kd = pack8f(v0, v1);
          }
        }
      }
    }
    if (seg == 2 || seg == 3 || seg == 4) {
      __syncthreads();
      stage_tr(acc[mi][0], acc[mi][1], stg, wm, wn, r, h);
      __syncthreads();
      write_tr(p, l, m0, mi, stg, tid, seg == 2 ? 0 : (seg == 3 ? 1 : 2), n0 - (seg == 2 ? 1024 : (seg == 3 ? 1536 : 2560)));
    }
  }
  __syncthreads();
}

DI void phase_in_gate(const Params& p, int l, unsigned char* smem) {
  const int tid = otid(), lane = tid & 63, w = tid >> 6;
  const int wm = w >> 2, wn = w & 3, r = lane & 31, h = lane >> 5;
  const int lrow = tid >> 3, lcc = tid & 7, brow = 2 * (lrow & 31) + ((lrow >> 5) & 1);
  const u16* H = (const u16*)(p.ws + WS_H);
  const u16* Win = (const u16*)(p.ws + WS_WT_IN) + (size_t)l * 3584 * 1024;
  const u16* Wg = (const u16*)(p.ws + WS_WT_GATE) + (size_t)l * 2048 * 1024;
  float* stg = (float*)(smem + GS_BASE + GS_STAGE);
  const int NT = 14 + 8, MT = 257;
  auto ptrs = [&](int it, const u16*& ap, const u16*& bp) -> bool {
    int mt, nt;
    if (!tile_of(it, MT, NT, mt, nt)) return false;
    ap = H + (size_t)(mt * 256 + lrow) * 1024 + lcc * 8;
    bp = (nt < 14 ? Win + (size_t)(nt * 256 + brow) * 1024 : Wg + (size_t)((nt - 14) * 256 + brow) * 1024) + lcc * 8;
    return true;
  };
  auto epi = [&](int it, f32x16 (&acc)[4][2]) {
    int mt, nt;
    tile_of(it, MT, NT, mt, nt);
    const int m0 = mt * 256;
    if (nt < 14) {
      epi_in(p, l, m0, nt * 256, acc, smem);
    } else {
      const int n0 = (nt - 14) * 256;
      u16* G = (u16*)(p.ws + WS_G);
#pragma unroll
      for (int mi = 0; mi < 4; ++mi) {
        __syncthreads();
        stage_rm(acc[mi][0], acc[mi][1], stg, wm, wn, r, h);
        __syncthreads();
#pragma unroll
        for (int q = 0; q < 4; ++q) {
          const int cid = q * NTHR + tid, lr = cid >> 5, c8 = (cid & 31) * 8;
          float4 v0 = *(const float4*)(stg + lr * EP_LD + c8);
          float4 v1 = *(const float4*)(stg + lr * EP_LD + c8 + 4);
          const int row = grow_of(m0, mi, lr), n = n0 + c8;
          const float4 b0 = *(const float4*)(p.in[22] + l * 2048 + n);
          const float4 b1 = *(const float4*)(p.in[22] + l * 2048 + n + 4);
          v0 = make_float4(sigmoidf_(v0.x + b0.x), sigmoidf_(v0.y + b0.y), sigmoidf_(v0.z + b0.z), sigmoidf_(v0.w + b0.w));
          v1 = make_float4(sigmoidf_(v1.x + b1.x), sigmoidf_(v1.y + b1.y), sigmoidf_(v1.z + b1.z), sigmoidf_(v1.w + b1.w));
          *(uint4*)(G + (size_t)row * 2048 + n) = pack8f(v0, v1);
        }
      }
      __syncthreads();
    }
  };
  gemm_stream(1024, 1024, 1024, smem, ptrs, epi);
}

DI void phase_mix(const Params& p, int l, unsigned char* smem) {
  const int tid = otid(), lane = tid & 63, w = tid >> 6;
  const int wm = w >> 2, wn = w & 3, r = lane & 31, h = lane >> 5;
  const int lrow = tid >> 3, lcc = tid & 7, brow = 2 * (lrow & 31) + ((lrow >> 5) & 1);
  const u16* G = (const u16*)(p.ws + WS_G);
  u16* MIX = (u16*)(p.ws + WS_MIX);
  float* stg = (float*)(smem + GS_BASE + GS_STAGE);
  const int NT = 4, MT = 257;
  auto ptrs = [&](int it, const u16*& ap, const u16*& bp) -> bool {
    int mt, nt;
    if (!tile_of(it >> 1, MT, NT, mt, nt)) return false;
    const int half = it & 1;
    ap = (const u16*)(p.ws + (half ? WS_MN : WS_AN)) + (size_t)(mt * 256 + lrow) * 512 + lcc * 8;
    bp = (const u16*)(p.ws + (half ? WS_WT_BRB : WS_WT_BRA)) + (size_t)l * 1024 * 512 + (size_t)(nt * 256 + brow) * 512 + lcc * 8;
    return true;
  };
  auto epi = [&](int it, f32x16 (&acc)[4][2]) {
    int mt, nt;
    tile_of(it >> 1, MT, NT, mt, nt);
    const int half = it & 1;
    const int m0 = mt * 256, n0 = nt * 256;
#pragma unroll
    for (int mi = 0; mi < 4; ++mi) {
      __syncthreads();
      stage_rm(acc[mi][0], acc[mi][1], stg, wm, wn, r, h);
      __syncthreads();
#pragma unroll
      for (int q = 0; q < 4; ++q) {
        const int cid = q * NTHR + tid, lr = cid >> 5, c8 = (cid & 31) * 8;
        const float4 v0 = *(const float4*)(stg + lr * EP_LD + c8);
        const float4 v1 = *(const float4*)(stg + lr * EP_LD + c8 + 4);
        const int row = grow_of(m0, mi, lr), n = n0 + c8;
        const uint4 g = *(const uint4*)(G + (size_t)row * 2048 + half * 1024 + n);
        float4 o0 = make_float4(bflo(g.x) * v0.x, bfhi(g.x) * v0.y, bflo(g.y) * v0.z, bfhi(g.y) * v0.w);
        float4 o1 = make_float4(bflo(g.z) * v1.x, bfhi(g.z) * v1.y, bflo(g.w) * v1.z, bfhi(g.w) * v1.w);
        uint4* mp = (uint4*)(MIX + (size_t)row * 1024 + n);
        if (half) {
          const uint4 pr = *mp;
          o0.x += bflo(pr.x); o0.y += bfhi(pr.x); o0.z += bflo(pr.y); o0.w += bfhi(pr.y);
          o1.x += bflo(pr.z); o1.y += bfhi(pr.z); o1.z += bflo(pr.w); o1.w += bfhi(pr.w);
        }
        *mp = pack8f(o0, o1);
      }
    }
    __syncthreads();
  };
  gemm_stream(512, 512, 512, smem, ptrs, epi);
}

DI void phase_res(const Params& p, int l, int mode, unsigned char* smem) {
  const int tid = otid(), lane = tid & 63, w = tid >> 6;
  const int wm = w >> 2, wn = w & 3, r = lane & 31, h = lane >> 5;
  const int lrow = tid >> 3, lcc = tid & 7, brow = 2 * (lrow & 31) + ((lrow >> 5) & 1);
  const float* mod = (const float*)(p.ws + WS_MOD);
  float* stg = (float*)(smem + GS_BASE + GS_STAGE);
  const int NT = 4, MT = 257;
  const int K = (mode == 0) ? 1024 : 2816;
  const u16* Ab = (const u16*)(p.ws + (mode == 0 ? WS_MIX : WS_ACT));
  const u16* Wb = (mode == 0) ? (const u16*)(p.ws + WS_WT_O) + (size_t)l * 1024 * 1024 : (const u16*)(p.ws + WS_WT_DOWN) + (size_t)l * 1024 * 2816;
  const int gi = (mode == 0) ? 2 : 5;
  auto ptrs = [&](int it, const u16*& ap, const u16*& bp) -> bool {
    int mt, nt;
    if (!tile_of(it, MT, NT, mt, nt)) return false;
    ap = Ab + (size_t)(mt * 256 + lrow) * K + lcc * 8;
    bp = Wb + (size_t)(nt * 256 + brow) * K + lcc * 8;
    return true;
  };
  auto epi = [&](int it, f32x16 (&acc)[4][2]) {
    int mt, nt;
    tile_of(it, MT, NT, mt, nt);
    const int m0 = mt * 256, n0 = nt * 256;
#pragma unroll
    for (int mi = 0; mi < 4; ++mi) {
      __syncthreads();
      stage_rm(acc[mi][0], acc[mi][1], stg, wm, wn, r, h);
      __syncthreads();
#pragma unroll
      for (int q = 0; q < 8; ++q) {
        const int cid = q * NTHR + tid, lr = cid >> 6, c4 = (cid & 63) * 4;
        const float4 v = *(const float4*)(stg + lr * EP_LD + c4);
        const int row = grow_of(m0, mi, lr), n = n0 + c4;
        const int b = batch_of_row(row);
        const float4 gg = *(const float4*)(mod + ((size_t)l * 40 + b) * 6144 + gi * 1024 + n);
        float* xr = p.out + (size_t)row * 1024 + n;
        const float* xs = (mode == 0 && l == 0) ? (row < TOKP ? p.in[0] + (size_t)row * 1024 + n : p.in[1] + (size_t)(row - TOKP) * 1024 + n) : xr;
        const float4 xv = *(const float4*)xs;
        *(float4*)xr = make_float4(ALPHA * xv.x + (1.f + gg.x) * v.x, ALPHA * xv.y + (1.f + gg.y) * v.y,
                                   ALPHA * xv.z + (1.f + gg.z) * v.z, ALPHA * xv.w + (1.f + gg.w) * v.w);
      }
    }
    __syncthreads();
  };
  gemm_stream(K, K, K, smem, ptrs, epi);
}

DI void phase_gu(const Params& p, int l, unsigned char* smem) {
  const int tid = otid(), lane = tid & 63, w = tid >> 6;
  const int wm = w >> 2, wn = w & 3, r = lane & 31, h = lane >> 5;
  const int lrow = tid >> 3, lcc = tid & 7, brow = 2 * (lrow & 31) + ((lrow >> 5) & 1);
  u16* ACT = (u16*)(p.ws + WS_ACT);
  const u16* Hh = (const u16*)(p.ws + WS_H);
  const u16* Wb = (const u16*)(p.ws + WS_WT_GU) + (size_t)l * 5632 * 1024;
  float* stg = (float*)(smem + GS_BASE + GS_STAGE);
  const int NT = 22, MT = 257;
  auto ptrs = [&](int it, const u16*& ap, const u16*& bp) -> bool {
    int mt, nt;
    if (!tile_of(it, MT, NT, mt, nt)) return false;
    ap = Hh + (size_t)(mt * 256 + lrow) * 1024 + lcc * 8;
    bp = Wb + (size_t)(nt * 256 + brow) * 1024 + lcc * 8;
    return true;
  };
  auto epi = [&](int it, f32x16 (&acc)[4][2]) {
    int mt, nt;
    tile_of(it, MT, NT, mt, nt);
    const int m0 = mt * 256, n0 = nt * 256;
#pragma unroll
    for (int mi = 0; mi < 4; ++mi) {
      __syncthreads();
      stage_rm(acc[mi][0], acc[mi][1], stg, wm, wn, r, h);
      __syncthreads();
#pragma unroll
      for (int q = 0; q < 2; ++q) {
        const int cid = q * NTHR + tid, lr = cid >> 4, c16 = (cid & 15) * 16;
        const float4 v0 = *(const float4*)(stg + lr * EP_LD + c16);
        const float4 v1 = *(const float4*)(stg + lr * EP_LD + c16 + 4);
        const float4 v2 = *(const float4*)(stg + lr * EP_LD + c16 + 8);
        const float4 v3 = *(const float4*)(stg + lr * EP_LD + c16 + 12);
        const int row = grow_of(m0, mi, lr);
        uint4 o;
        o.x = pack2(siluf_(v0.x) * v0.y, siluf_(v0.z) * v0.w);
        o.y = pack2(siluf_(v1.x) * v1.y, siluf_(v1.z) * v1.w);
        o.z = pack2(siluf_(v2.x) * v2.y, siluf_(v2.z) * v2.w);
        o.w = pack2(siluf_(v3.x) * v3.y, siluf_(v3.z) * v3.w);
        *(uint4*)(ACT + (size_t)row * 2816 + (n0 >> 1) + (c16 >> 1)) = o;
      }
    }
    __syncthreads();
  };
  gemm_stream(1024, 1024, 1024, smem, ptrs, epi);
}

constexpr int AT_BASE = 64;
constexpr int AT_KBYTES = 64 * 272;
constexpr int AT_VBYTES = 128 * 136;
constexpr int AT_STAGE = AT_KBYTES + AT_VBYTES;

DI void attn_item(const Params& p, int l, int b, int head, int qt, float lam, float lam_init, unsigned char* smem) {
  const int tid = otid(), lane = tid & 63, w = tid >> 6, r = lane & 31, h = lane >> 5;
  const int comp = w & 1, rg = w >> 1;
  const bool prompt = b < 32;
  const int bs = b - 32;
  const u16* Kg = prompt ? (const u16*)(p.ws + WS_KB) + (size_t)b * 2048 * 512 : (const u16*)(p.ws + WS_KS) + (size_t)(l * 8 + bs) * 1056 * 512;
  const u16* Vg = prompt ? (const u16*)(p.ws + WS_VTP) + (size_t)b * 512 * 2048 : (const u16*)(p.ws + WS_VTS) + (size_t)(l * 8 + bs) * 512 * 1056;
  const int ldT = prompt ? 2048 : 1056;
  const int nkt = prompt ? 2 * qt + 2 : 17;
  const int nkeys = prompt ? 2048 : 1056;
  const int qtok0 = prompt ? b * 2048 + qt * 128 : TOKP + bs * 32;
  const int qpos0 = prompt ? qt * 128 : 1024;
  const bool active = prompt || rg == 0;
  const int my_nkt = prompt ? (rg < 2 ? nkt - 1 : nkt) : nkt;
  const u16* ZQ = (const u16*)(p.ws + WS_ZQ);
  bf16x8 qf[4];
  {
    const int qrow = active ? qtok0 + rg * 32 + r : qtok0;
#pragma unroll
    for (int ks = 0; ks < 4; ++ks) qf[ks] = *(const bf16x8*)(ZQ + (size_t)qrow * 512 + head * 128 + comp * 64 + ks * 16 + h * 8);
  }
  const float slope2 = exp2f(-2.f * (head + 1)) * LOG2E;
  const float c1 = 0.125f * LOG2E;
  const int qpos = qpos0 + rg * 32 + r;
  f32x16 O[4];
#pragma unroll
  for (int i = 0; i < 4; ++i) zero16(O[i]);
  float m_run = -INFINITY, l_run = 0.f;

  const int krow = tid >> 4, kcc = tid & 15;
  const int vrow = tid >> 3, vcc = tid & 7;
  const u16* kp = Kg + (size_t)((nkt - 1) * 64 + krow) * 512 + head * 128 + kcc * 8;
  const u16* vp = Vg + (size_t)(head * 128 + vrow) * ldT + (nkt - 1) * 64 + vcc * 8;
  uint4 rk0, rk1, rv0, rv1;
  unsigned char* sb = smem + AT_BASE;
  rk0 = *(const uint4*)kp; rk1 = *(const uint4*)(kp + 32 * 512);
  rv0 = *(const uint4*)vp; rv1 = *(const uint4*)(vp + (size_t)64 * ldT);
  {
    *(uint4*)(sb + krow * 272 + kcc * 16) = rk0;
    *(uint4*)(sb + (krow + 32) * 272 + kcc * 16) = rk1;
    *(uint2*)(sb + AT_KBYTES + vrow * 136 + vcc * 16) = make_uint2(rv0.x, rv0.y);
    *(uint2*)(sb + AT_KBYTES + vrow * 136 + vcc * 16 + 8) = make_uint2(rv0.z, rv0.w);
    *(uint2*)(sb + AT_KBYTES + (vrow + 64) * 136 + vcc * 16) = make_uint2(rv1.x, rv1.y);
    *(uint2*)(sb + AT_KBYTES + (vrow + 64) * 136 + vcc * 16 + 8) = make_uint2(rv1.z, rv1.w);
  }
  __syncthreads();
  for (int j = 0; j < nkt; ++j) {
    const int kt = nkt - 1 - j;
    const bool more = j + 1 < nkt;
    if (more) {
      kp -= 64 * 512; vp -= 64;
      rk0 = *(const uint4*)kp; rk1 = *(const uint4*)(kp + 32 * 512);
      rv0 = *(const uint4*)vp; rv1 = *(const uint4*)(vp + (size_t)64 * ldT);
    }
    if (active && kt < my_nkt) {
      const unsigned char* Kt = sb + (j & 1) * AT_STAGE;
      const unsigned char* Vt = Kt + AT_KBYTES;
      f32x16 s[2];
      zero16(s[0]); zero16(s[1]);
#pragma unroll
      for (int ks = 0; ks < 4; ++ks) {
#pragma unroll
        for (int sub = 0; sub < 2; ++sub) {
          const bf16x8 kf = *(const bf16x8*)(Kt + (sub * 32 + r) * 272 + (comp * 64 + ks * 16 + h * 8) * 2);
          s[sub] = MFMA(kf, qf[ks], s[sub]);
        }
      }
      float mx = -INFINITY;
      const float qk0 = (float)(qpos - kt * 64 - 4 * h);
#pragma unroll
      for (int sub = 0; sub < 2; ++sub)
#pragma unroll
        for (int i = 0; i < 16; ++i) {
          const float d = qk0 - (float)(sub * 32 + (i & 3) + 8 * (i >> 2));
          float v = s[sub][i] * c1 - slope2 * fabsf(d);
          s[sub][i] = v;
        }
      if (!prompt) {
#pragma unroll
        for (int sub = 0; sub < 2; ++sub)
#pragma unroll
          for (int i = 0; i < 16; ++i) {
            const int key = kt * 64 + sub * 32 + crow(i, h);
            if (key >= nkeys) s[sub][i] = -INFINITY;
          }
      }
#pragma unroll
      for (int sub = 0; sub < 2; ++sub)
#pragma unroll
        for (int i = 0; i < 16; ++i) mx = fmaxf(mx, s[sub][i]);
      mx = fmaxf(mx, shx(mx, 32, lane));
      const bool livelane = !(mx - m_run < -150.f);
      if (__ballot(livelane) != 0ull) {
        const float m_new = fmaxf(m_run, mx);
        const float alpha = fexp2(m_run - m_new);
        m_run = m_new;
        float lsum = 0.f;
#pragma unroll
        for (int sub = 0; sub < 2; ++sub)
#pragma unroll
          for (int i = 0; i < 16; ++i) {
            const float pv = fexp2(s[sub][i] - m_new);
            lsum += pv;
            s[sub][i] = pv;
          }
        l_run = l_run * alpha + lsum;
        if (__ballot(alpha != 1.f) != 0ull) {
#pragma unroll
          for (int dt = 0; dt < 4; ++dt)
#pragma unroll
            for (int i = 0; i < 16; ++i) O[dt][i] *= alpha;
        }
#pragma unroll
        for (int sub = 0; sub < 2; ++sub)
#pragma unroll
          for (int s2 = 0; s2 < 2; ++s2) {
            const bf16x8 pf = pack8(s[sub], s2);
#pragma unroll
            for (int dt = 0; dt < 4; ++dt) {
              const unsigned char* va = Vt + (dt * 32 + r) * 136 + (sub * 32 + s2 * 16 + 4 * h) * 2;
              const uint2 lo = *(const uint2*)va;
              const uint2 hi = *(const uint2*)(va + 16);
              const uint4 vv = make_uint4(lo.x, lo.y, hi.x, hi.y);
              O[dt] = MFMA(__builtin_bit_cast(bf16x8, vv), pf, O[dt]);
            }
          }
      }
    }
    if (more) {
      unsigned char* sn = sb + ((j + 1) & 1) * AT_STAGE;
      *(uint4*)(sn + krow * 272 + kcc * 16) = rk0;
      *(uint4*)(sn + (krow + 32) * 272 + kcc * 16) = rk1;
      *(uint2*)(sn + AT_KBYTES + vrow * 136 + vcc * 16) = make_uint2(rv0.x, rv0.y);
      *(uint2*)(sn + AT_KBYTES + vrow * 136 + vcc * 16 + 8) = make_uint2(rv0.z, rv0.w);
      *(uint2*)(sn + AT_KBYTES + (vrow + 64) * 136 + vcc * 16) = make_uint2(rv1.x, rv1.y);
      *(uint2*)(sn + AT_KBYTES + (vrow + 64) * 136 + vcc * 16 + 8) = make_uint2(rv1.z, rv1.w);
    }
    __syncthreads();
  }
  float* exch = (float*)(smem + AT_BASE);
  float inv = 0.f;
  if (active) { const float lt = l_run + shx(l_run, 32, lane); inv = 1.f / lt; }
  if (active && comp == 1) {
    const float sc = inv * lam;
#pragma unroll
    for (int dt = 0; dt < 4; ++dt)
#pragma unroll
      for (int i = 0; i < 16; ++i) exch[(rg * 64 + dt * 16 + i) * 64 + lane] = O[dt][i] * sc;
  }
  __syncthreads();
  if (active && comp == 0) {
    float ss = 0.f;
#pragma unroll
    for (int dt = 0; dt < 4; ++dt)
#pragma unroll
      for (int i = 0; i < 16; ++i) {
        const float o = O[dt][i] * inv - exch[(rg * 64 + dt * 16 + i) * 64 + lane];
        O[dt][i] = o;
        ss += o * o;
      }
    ss += shx(ss, 32, lane);
    const float rs = rsqrtf(ss * (1.f / 128.f) + LN_EPS) * (1.f - lam_init);
    u16* AN = (u16*)(p.ws + WS_AN) + (size_t)(qtok0 + rg * 32 + r) * 512 + head * 128;
    const float* gw = p.in[17] + l * 512 + head * 128;
#pragma unroll
    for (int dt = 0; dt < 4; ++dt)
#pragma unroll
      for (int g = 0; g < 4; ++g) {
        const int dv = dt * 32 + 8 * g + 4 * h;
        const float4 g4 = *(const float4*)(gw + dv);
        uint2 o;
        o.x = pack2(O[dt][4 * g] * rs * g4.x, O[dt][4 * g + 1] * rs * g4.y);
        o.y = pack2(O[dt][4 * g + 2] * rs * g4.z, O[dt][4 * g + 3] * rs * g4.w);
        *(uint2*)(AN + dv) = o;
      }
  }
}

constexpr int ML_QS = 64;
constexpr int ML_KS = ML_QS + 64 * 272;
constexpr int ML_KT = ML_KS + 64 * 272;
constexpr int ML_VT = ML_KT + 128 * 144;
constexpr int ML_CB = ML_VT + 128 * 144;
constexpr int ML_HB = ML_CB + 128 * 272;
constexpr int ML_SM = ML_HB + 64 * 132 * 4;
static_assert(ML_SM + 528 * 4 <= LDS_BYTES, "lds");

DI void mlstm_item(const Params& p, int l, int b, int head, unsigned char* smem) {
  const int tid = otid(), lane = tid & 63, w = tid >> 6, r = lane & 31, h = lane >> 5;
  const bool prompt = b < 32;
  const int bs = b - 32;
  const int T = prompt ? 2048 : 32;
  const int nch = prompt ? 32 : 1;
  const int L = prompt ? 64 : 32;
  const int tokbase = prompt ? b * 2048 : TOKP + bs * 32;
  const u16* qkT = prompt ? (const u16*)(p.ws + WS_MQKT_P) + (size_t)b * 1024 * 2048 : (const u16*)(p.ws + WS_MQKT_S) + (size_t)bs * 1024 * 32;
  const u16* vTg = prompt ? (const u16*)(p.ws + WS_MVT_P) + (size_t)b * 512 * 2048 : (const u16*)(p.ws + WS_MVT_S) + (size_t)bs * 512 * 32;
  u16* qs = (u16*)(smem + ML_QS);
  u16* ksm = (u16*)(smem + ML_KS);
  u16* kTw = (u16*)(smem + ML_KT);
  u16* vT = (u16*)(smem + ML_VT);
  u16* Cbf = (u16*)(smem + ML_CB);
  float* hbuf = (float*)(smem + ML_HB);
  float* a_s = (float*)(smem + ML_SM);
  float* mx_s = a_s + 64;
  float* ws_s = a_s + 128;
  float* wi_s = a_s + 192;
  float* emt_s = a_s + 256;
  float* nq_s = a_s + 320;
  float* nvec = a_s + 384;
  float* scal = a_s + 512;

  const int vt = w & 3, kt0 = (w >> 2) * 2;
  f32x16 accC[2];
  float m_run = 0.f;
  if (prompt) {
    zero16(accC[0]); zero16(accC[1]);
    if (tid < 128) nvec[tid] = 0.f;
  } else {
    const float* Cs = p.in[6] + ((size_t)(l * 8 + bs) * 4 + head) * 128 * 128;
#pragma unroll
    for (int q = 0; q < 2; ++q)
#pragma unroll
      for (int g = 0; g < 4; ++g) {
        const float4 c4 = *(const float4*)(Cs + (size_t)(vt * 32 + r) * 128 + (kt0 + q) * 32 + 8 * g + 4 * h);
        accC[q][4 * g] = c4.x; accC[q][4 * g + 1] = c4.y; accC[q][4 * g + 2] = c4.z; accC[q][4 * g + 3] = c4.w;
      }
    if (tid < 128) nvec[tid] = p.in[7][((size_t)(l * 8 + bs) * 4 + head) * 128 + tid];
    m_run = p.in[8][(l * 8 + bs) * 4 + head];
  }
#pragma unroll
  for (int q = 0; q < 2; ++q)
#pragma unroll
    for (int g = 0; g < 4; ++g) {
      uint2 o; o.x = pack2(accC[q][4 * g], accC[q][4 * g + 1]); o.y = pack2(accC[q][4 * g + 2], accC[q][4 * g + 3]);
      *(uint2*)(Cbf + (vt * 32 + r) * 136 + (kt0 + q) * 32 + 8 * g + 4 * h) = o;
    }
  const float* gatesp = (const float*)(p.ws + WS_GATES);
  const int vi = w >> 1, ti = w & 1;

  for (int c = 0; c < nch; ++c) {
    const int t0 = c * 64;
    if (w == 0) {
      const int t = lane;
      float ig = -INFINITY, lf = 0.f;
      if (t < L) {
        const float* gp = gatesp + (size_t)(tokbase + t0 + t) * 8;
        ig = gp[head];
        const float fg = gp[4 + head];
        lf = fminf(fg, 0.f) - log1pf(__expf(-fabsf(fg)));
      }
      float bc = lf;
#pragma unroll
      for (int off = 1; off < 64; off <<= 1) { const float v = shidx(bc, lane - off, lane); if (lane >= off) bc += v; }
      const float a = ig - bc;
      float M = a;
#pragma unroll
      for (int off = 1; off < 64; off <<= 1) { const float v = shidx(M, lane - off, lane); if (lane >= off) M = fmaxf(M, v); }
      const float mx = fmaxf(m_run, M);
      const float bL = shidx(bc, 63, lane);
      const float mxL = shidx(mx, 63, lane);
      a_s[t] = a; mx_s[t] = mx;
      ws_s[t] = __expf(a - mxL);
      wi_s[t] = __expf(m_run - mx);
      emt_s[t] = __expf(-(bc + mx));
      if (lane == 0) scal[1] = __expf(m_run - mxL);
      m_run = bL + mxL;
    }
    const int ch2 = tid >> 1, th = tid & 1;
    const bool isk = ch2 >= 128;
    const int dd = ch2 & 127;
    const int ch = (isk ? 512 : 0) + head * 128 + dd;
    const u16* rp = qkT + (size_t)ch * T + t0 + th * 32;
    float um3 = 0.f, um2 = 0.f, um1 = 0.f;
    const bool ldrow = prompt || th == 0;
    if (prompt) {
      if (th == 1 || c > 0) {
        const uint2 pv = *(const uint2*)(rp - 4);
        um3 = bfhi(pv.x); um2 = bflo(pv.y); um1 = bfhi(pv.y);
      }
    } else if (th == 0) {
      const float* cvp = p.in[9] + (size_t)(l * 8 + bs) * 3 * 1024 + ch;
      um3 = cvp[0]; um2 = cvp[1024]; um1 = cvp[2048];
    }
    const float cw0 = p.in[14][(l * 4 + 0) * 1024 + ch], cw1 = p.in[14][(l * 4 + 1) * 1024 + ch];
    const float cw2 = p.in[14][(l * 4 + 2) * 1024 + ch], cw3 = p.in[14][(l * 4 + 3) * 1024 + ch];
    const float cb = p.in[15][l * 1024 + ch];
    __syncthreads();
    {
      u16* dstrm = (isk ? ksm : qs) + (th * 32) * 136 + dd;
      const float oscale = isk ? 0.08838834764831845f : 1.f;
#pragma unroll 1
      for (int i = 0; i < 4; ++i) {
        uint4 uu = make_uint4(0, 0, 0, 0);
        if (ldrow) uu = *(const uint4*)(rp + i * 8);
        float u[8];
        u[0] = bflo(uu.x); u[1] = bfhi(uu.x); u[2] = bflo(uu.y); u[3] = bfhi(uu.y);
        u[4] = bflo(uu.z); u[5] = bfhi(uu.z); u[6] = bflo(uu.w); u[7] = bfhi(uu.w);
        float y[8];
#pragma unroll
        for (int e = 0; e < 8; ++e) {
          const float x3 = (e >= 3) ? u[e - 3] : (e == 0 ? um3 : (e == 1 ? um2 : um1));
          const float x2 = (e >= 2) ? u[e - 2] : (e == 0 ? um2 : um1);
          const float x1 = (e >= 1) ? u[e - 1] : um1;
          const float yy = cb + cw0 * x3 + cw1 * x2 + cw2 * x1 + cw3 * u[e];
          y[e] = siluf_(yy) * oscale;
        }
        um3 = u[5]; um2 = u[6]; um1 = u[7];
#pragma unroll
        for (int e = 0; e < 8; ++e) dstrm[(i * 8 + e) * 136] = f2bf(y[e]);
        if (isk) {
          const float4 w0 = *(const float4*)(ws_s + th * 32 + i * 8);
          const float4 w1 = *(const float4*)(ws_s + th * 32 + i * 8 + 4);
          uint4 o;
          o.x = pack2(y[0] * w0.x, y[1] * w0.y); o.y = pack2(y[2] * w0.z, y[3] * w0.w);
          o.z = pack2(y[4] * w1.x, y[5] * w1.y); o.w = pack2(y[6] * w1.z, y[7] * w1.w);
          *(uint4*)(kTw + dd * 72 + th * 32 + i * 8) = o;
        }
      }
#pragma unroll
      for (int i = 0; i < 2; ++i) {
        const int id = tid + 512 * i, row = id >> 3, cc = id & 7;
        uint4 vv = make_uint4(0, 0, 0, 0);
        if (prompt || cc < 4) vv = *(const uint4*)(vTg + (size_t)(head * 128 + row) * T + t0 + cc * 8);
        *(uint4*)(vT + row * 72 + cc * 8) = vv;
      }
    }
    __syncthreads();
    {
      const int t = tid >> 3, part = tid & 7;
      const uint4 q0 = *(const uint4*)(qs + t * 136 + part * 16);
      const uint4 q1 = *(const uint4*)(qs + t * 136 + part * 16 + 8);
      const float* nv = nvec + part * 16;
      float s = bflo(q0.x) * nv[0] + bfhi(q0.x) * nv[1] + bflo(q0.y) * nv[2] + bfhi(q0.y) * nv[3]
              + bflo(q0.z) * nv[4] + bfhi(q0.z) * nv[5] + bflo(q0.w) * nv[6] + bfhi(q0.w) * nv[7]
              + bflo(q1.x) * nv[8] + bfhi(q1.x) * nv[9] + bflo(q1.y) * nv[10] + bfhi(q1.y) * nv[11]
              + bflo(q1.z) * nv[12] + bfhi(q1.z) * nv[13] + bflo(q1.w) * nv[14] + bfhi(q1.w) * nv[15];
      s += shx(s, 1, lane); s += shx(s, 2, lane); s += shx(s, 4, lane);
      if (part == 0) nq_s[t] = s;
    }
    f32x16 accS[2], accO;
    zero16(accS[0]); zero16(accS[1]); zero16(accO);
    {
#pragma unroll
      for (int ks = 0; ks < 8; ++ks) {
        const bf16x8 qfr = *(const bf16x8*)(qs + (ti * 32 + r) * 136 + ks * 16 + h * 8);
        const bf16x8 k0 = *(const bf16x8*)(ksm + r * 136 + ks * 16 + h * 8);
        accS[0] = MFMA(k0, qfr, accS[0]);
        if (ti == 1) {
          const bf16x8 k1 = *(const bf16x8*)(ksm + (32 + r) * 136 + ks * 16 + h * 8);
          accS[1] = MFMA(k1, qfr, accS[1]);
        }
        const bf16x8 cf = *(const bf16x8*)(Cbf + (vi * 32 + r) * 136 + ks * 16 + h * 8);
        accO = MFMA(cf, qfr, accO);
      }
    }
    const int tcol = ti * 32 + r;
    const float mxt = mx_s[tcol];
    const float wit = wi_s[tcol];
    float dsum = 0.f;
#pragma unroll
    for (int sub = 0; sub < 2; ++sub) {
      if (sub <= ti) {
#pragma unroll
        for (int g = 0; g < 4; ++g) {
          const float4 a4 = *(const float4*)(a_s + sub * 32 + 8 * g + 4 * h);
          const float av[4] = {a4.x, a4.y, a4.z, a4.w};
#pragma unroll
          for (int e = 0; e < 4; ++e) {
            const int s = sub * 32 + 8 * g + 4 * h + e;
            const float wgt = (s <= tcol) ? __expf(av[e] - mxt) : 0.f;
            const float pv = accS[sub][4 * g + e] * wgt;
            accS[sub][4 * g + e] = pv;
            dsum += pv;
          }
        }
      }
    }
    dsum += shx(dsum, 32, lane);
#pragma unroll
    for (int i = 0; i < 16; ++i) accO[i] *= wit;
#pragma unroll
    for (int sub = 0; sub < 2; ++sub) {
      if (sub <= ti) {
#pragma unroll
        for (int s2 = 0; s2 < 2; ++s2) {
          const bf16x8 pf = pack8(accS[sub], s2);
          const u16* va = vT + (vi * 32 + r) * 72 + sub * 32 + s2 * 16 + 4 * h;
          const uint2 lo = *(const uint2*)va;
          const uint2 hi = *(const uint2*)(va + 8);
          const uint4 vq = make_uint4(lo.x, lo.y, hi.x, hi.y);
          accO = MFMA(__builtin_bit_cast(bf16x8, vq), pf, accO);
        }
      }
    }
    __syncthreads();
    {
      const float den = dsum + wit * nq_s[tcol];
      const float dn = fmaxf(fabsf(den), emt_s[tcol]);
      const float rinv = 1.f / dn;
#pragma unroll
      for (int g = 0; g < 4; ++g)
        *(float4*)(hbuf + tcol * 132 + vi * 32 + 8 * g + 4 * h) =
            make_float4(accO[4 * g] * rinv, accO[4 * g + 1] * rinv, accO[4 * g + 2] * rinv, accO[4 * g + 3] * rinv);
    }
    {
      const float wc = scal[1];
#pragma unroll
      for (int q = 0; q < 2; ++q)
#pragma unroll
        for (int i = 0; i < 16; ++i) accC[q][i] *= wc;
#pragma unroll
      for (int k4 = 0; k4 < 4; ++k4) {
        const bf16x8 vf = *(const bf16x8*)(vT + (vt * 32 + r) * 72 + k4 * 16 + h * 8);
#pragma unroll
        for (int q = 0; q < 2; ++q) {
          const bf16x8 kf = *(const bf16x8*)(kTw + ((kt0 + q) * 32 + r) * 72 + k4 * 16 + h * 8);
          accC[q] = MFMA(kf, vf, accC[q]);
        }
      }
#pragma unroll
      for (int q = 0; q < 2; ++q)
#pragma unroll
        for (int g = 0; g < 4; ++g) {
          uint2 o; o.x = pack2(accC[q][4 * g], accC[q][4 * g + 1]); o.y = pack2(accC[q][4 * g + 2], accC[q][4 * g + 3]);
          *(uint2*)(Cbf + (vt * 32 + r) * 136 + (kt0 + q) * 32 + 8 * g + 4 * h) = o;
        }
      if (tid < 128) {
        float s = 0.f;
#pragma unroll
        for (int i = 0; i < 8; ++i) {
          const uint4 kk = *(const uint4*)(kTw + tid * 72 + i * 8);
          s += bflo(kk.x) + bfhi(kk.x) + bflo(kk.y) + bfhi(kk.y) + bflo(kk.z) + bfhi(kk.z) + bflo(kk.w) + bfhi(kk.w);
        }
        nvec[tid] = wc * nvec[tid] + s;
      }
    }
    __syncthreads();
    {
      const int t = tid >> 3, part = tid & 7;
      float x[16];
#pragma unroll
      for (int i = 0; i < 4; ++i) {
        const float4 f = *(const float4*)(hbuf + t * 132 + part * 16 + i * 4);
        x[i * 4] = f.x; x[i * 4 + 1] = f.y; x[i * 4 + 2] = f.z; x[i * 4 + 3] = f.w;
      }
      float s = 0.f;
#pragma unroll
      for (int i = 0; i < 16; ++i) s += x[i];
      s += shx(s, 1, lane); s += shx(s, 2, lane); s += shx(s, 4, lane);
      const float mean = s * (1.f / 128.f);
      float q = 0.f;
#pragma unroll
      for (int i = 0; i < 16; ++i) { x[i] -= mean; q += x[i] * x[i]; }
      q += shx(q, 1, lane); q += shx(q, 2, lane); q += shx(q, 4, lane);
      const float rstd = rsqrtf(q * (1.f / 128.f) + LN_EPS);
      if (t < L) {
        const size_t tok = (size_t)tokbase + t0 + t;
        const int cbase = head * 128 + part * 16;
        const float* gw = p.in[18] + l * 512 + cbase;
        const u16* mo = (const u16*)(p.ws + WS_MO) + tok * 512 + cbase;
        const uint4 m0 = *(const uint4*)mo;
        const uint4 m1 = *(const uint4*)(mo + 8);
        const float sg[16] = {bflo(m0.x), bfhi(m0.x), bflo(m0.y), bfhi(m0.y), bflo(m0.z), bfhi(m0.z), bflo(m0.w), bfhi(m0.w),
                              bflo(m1.x), bfhi(m1.x), bflo(m1.y), bfhi(m1.y), bflo(m1.z), bfhi(m1.z), bflo(m1.w), bfhi(m1.w)};
        float yv[16];
#pragma unroll
        for (int i = 0; i < 16; ++i) yv[i] = x[i] * rstd * gw[i] * sg[i];
        uint4 o0, o1;
        o0.x = pack2(yv[0], yv[1]); o0.y = pack2(yv[2], yv[3]); o0.z = pack2(yv[4], yv[5]); o0.w = pack2(yv[6], yv[7]);
        o1.x = pack2(yv[8], yv[9]); o1.y = pack2(yv[10], yv[11]); o1.z = pack2(yv[12], yv[13]); o1.w = pack2(yv[14], yv[15]);
        u16* mn = (u16*)(p.ws + WS_MN) + tok * 512 + cbase;
        *(uint4*)mn = o0;
        *(uint4*)(mn + 8) = o1;
      }
    }
  }
  {
    float* oc = p.out + (prompt ? O_CP + ((size_t)(l * 32 + b) * 4 + head) * 16384 : O_CS + ((size_t)(l * 8 + bs) * 4 + head) * 16384);
#pragma unroll
    for (int q = 0; q < 2; ++q)
#pragma unroll
      for (int g = 0; g < 4; ++g)
        *(float4*)(oc + (size_t)(vt * 32 + r) * 128 + (kt0 + q) * 32 + 8 * g + 4 * h) =
            make_float4(accC[q][4 * g], accC[q][4 * g + 1], accC[q][4 * g + 2], accC[q][4 * g + 3]);
    float* on = p.out + (prompt ? O_NP + ((size_t)(l * 32 + b) * 4 + head) * 128 : O_NS + ((size_t)(l * 8 + bs) * 4 + head) * 128);
    if (tid < 128) on[tid] = nvec[tid];
    if (tid == 0) {
      if (prompt) p.out[O_MP + (size_t)(l * 32 + b) * 4 + head] = m_run;
      else p.out[O_MS + (size_t)(l * 8 + bs) * 4 + head] = m_run;
    }
  }
}

DI void phase_mixers(const Params& p, int l, unsigned char* smem) {
  const int tid0 = otid();
  const int lane = tid0 & 63;
  const float* lp = p.in[16] + l * 256;
  float s1 = lp[lane] * lp[64 + lane], s2 = lp[128 + lane] * lp[192 + lane];
  s1 = wave_sum(s1, lane); s2 = wave_sum(s2, lane);
  const float lam_init = 0.8f - 0.6f * expf(-0.3f * (float)l);
  const float lam = expf(s1) - expf(s2) + lam_init;
  int* ctr = (int*)(p.ws + WS_CTR) + l;
  int* sitem = (int*)smem;
  const int N_ML = 160, N_AT = 2048 + 32;
  for (;;) {
    __syncthreads();
    if (tid0 == 0) *sitem = atomicAdd(ctr, 1);
    __syncthreads();
    const int item = *sitem;
    if (item >= N_ML + N_AT) break;
    if (item < N_ML) {
#ifndef NO_ML
      mlstm_item(p, l, item >> 2, item & 3, smem);
#endif
    } else {
#ifndef NO_AT
      const int a = item - N_ML;
      if (a < 2048) {
        const int qt = 15 - (a >> 7), rest = a & 127;
        attn_item(p, l, rest >> 2, rest & 3, qt, lam, lam_init, smem);
      } else {
        const int s = a - 2048;
        attn_item(p, l, 32 + (s >> 2), s & 3, 0, lam, lam_init, smem);
      }
#endif
    }
  }
}

DI void gbar(unsigned* bar, unsigned& epoch) {
  __syncthreads();
  epoch += gridDim.x;
  if (otid() == 0) {
    __threadfence();
    __hip_atomic_fetch_add(bar, 1u, __ATOMIC_RELAXED, __HIP_MEMORY_SCOPE_AGENT);
    while (__hip_atomic_load(bar, __ATOMIC_RELAXED, __HIP_MEMORY_SCOPE_AGENT) < epoch) __builtin_amdgcn_s_sleep(2);
    __threadfence();
  }
  __syncthreads();
}

__global__ void __launch_bounds__(NTHR) fwd_megakernel(Params p) {
  extern __shared__ __attribute__((aligned(16))) unsigned char smem[];
  cg::grid_group grid = cg::this_grid();
#ifndef PH
#define PH 0xffff
#endif
  unsigned* bar = (unsigned*)(p.ws + WS_CTR + 64);
  unsigned epoch = 0;
  if (PH & 1) prologue(p, smem);
  grid.sync();
  if (PH & 1) prologue(p, smem);
  grid.sync();
  if (PH & 2) ln_pass(p, 0, 0, smem);
  gbar(bar, epoch);
#pragma unroll 1
  for (int l = 0; l < 2; ++l) {
    if (PH & 4) phase_in_gate(p, l, smem);
    gbar(bar, epoch);
    if (PH & 8) phase_mixers(p, l, smem);
    gbar(bar, epoch);
    if (PH & 16) phase_mix(p, l, smem);
    gbar(bar, epoch);
    if (PH & 32) phase_res(p, l, 0, smem);
    gbar(bar, epoch);
    if (PH & 64) ln_pass(p, 1, l, smem);
    gbar(bar, epoch);
    if (PH & 128) phase_gu(p, l, smem);
    gbar(bar, epoch);
    if (PH & 256) phase_res(p, l, 1, smem);
    gbar(bar, epoch);
    if (PH & 512) ln_pass(p, 2, l, smem);
    if (l == 0) gbar(bar, epoch);
  }
}

extern "C" void kernel_launch(void* const* d_in, const int* in_sizes, int n_in, void* d_out, int out_size, void* d_ws,
                              size_t ws_size, hipStream_t stream) {
  static int grid_blocks = 0;
  if (!grid_blocks) {
    int dev = 0, cus = 0, per_cu = 0;
    hipGetDevice(&dev);
    hipDeviceGetAttribute(&cus, hipDeviceAttributeMultiprocessorCount, dev);
    if (hipFuncSetAttribute((const void*)fwd_megakernel, hipFuncAttributeMaxDynamicSharedMemorySize, LDS_BYTES) != hipSuccess)
      fprintf(stderr, "kernel_launch: hipFuncSetAttribute failed\n");
    if (hipOccupancyMaxActiveBlocksPerMultiprocessor(&per_cu, (const void*)fwd_megakernel, NTHR, LDS_BYTES) != hipSuccess || per_cu < 1) {
      fprintf(stderr, "kernel_launch: occupancy query gave %d\n", per_cu);
      per_cu = 1;
    }
    (void)hipGetLastError();
    grid_blocks = cus * per_cu;
    if (ws_size < WS_END) fprintf(stderr, "kernel_launch: workspace too small: %zu < %zu\n", ws_size, (size_t)WS_END);
  }
  if (hipMemsetAsync((char*)d_ws + WS_CTR, 0, 256, stream) != hipSuccess) fprintf(stderr, "kernel_launch: memset failed\n");
  Params p{};
  for (int i = 0; i < 30; ++i) p.in[i] = (const float*)d_in[i];
  p.out = (float*)d_out;
  p.ws = (unsigned char*)d_ws;
  void* args[] = {&p};
  hipError_t e = hipLaunchCooperativeKernel((const void*)fwd_megakernel, dim3(grid_blocks), dim3(NTHR), args, LDS_BYTES, stream);
  if (e != hipSuccess) fprintf(stderr, "cooperative launch failed: %s (grid %d)\n", hipGetErrorString(e), grid_blocks);
}
```

```cpp
#include <hip/hip_runtime.h>
#include <hip/hip_cooperative_groups.h>
#include <cstdio>
namespace cg = cooperative_groups;

#define DI __device__ __forceinline__
typedef unsigned short u16;
using bf16x8 = __attribute__((ext_vector_type(8))) short;
using f32x16 = __attribute__((ext_vector_type(16))) float;
#define MFMA(a, b, c) __builtin_amdgcn_mfma_f32_32x32x16_bf16((a), (b), (c), 0, 0, 0)

constexpr int TOKP = 65536, TOKS = 256, TOK = 65792;
constexpr int NTHR = 512;
constexpr float LN_EPS = 1e-5f;
constexpr float ALPHA = 1.41421356237f;
constexpr float LOG2E = 1.44269504089f;

constexpr size_t WS_WT_IN   = 0;
constexpr size_t WS_WT_GATE = WS_WT_IN + 2ull * 3584 * 1024 * 2;
constexpr size_t WS_WT_BRA  = WS_WT_GATE + 2ull * 2048 * 1024 * 2;
constexpr size_t WS_WT_BRB  = WS_WT_BRA + 2ull * 1024 * 512 * 2;
constexpr size_t WS_WT_O    = WS_WT_BRB + 2ull * 1024 * 512 * 2;
constexpr size_t WS_WT_GU   = WS_WT_O + 2ull * 1024 * 1024 * 2;
constexpr size_t WS_WT_DOWN = WS_WT_GU + 2ull * 5632 * 1024 * 2;
constexpr size_t WS_MOD     = WS_WT_DOWN + 2ull * 1024 * 2816 * 2;
constexpr size_t WS_GATES   = WS_MOD + 2ull * 40 * 6144 * 4;
constexpr size_t WS_CTR     = WS_GATES + (size_t)TOK * 8 * 4;
constexpr size_t WS_KS      = WS_CTR + 256;
constexpr size_t WS_VTS     = WS_KS + 2ull * 8 * 1056 * 512 * 2 + 65536;
constexpr size_t WS_MQKT_S  = WS_VTS + 2ull * 8 * 512 * 1056 * 2 + 65536;
constexpr size_t WS_MVT_S   = WS_MQKT_S + 8ull * 1024 * 32 * 2;
constexpr size_t WS_H       = WS_MVT_S + 8ull * 512 * 32 * 2;
constexpr size_t WS_AN      = WS_H;
constexpr size_t WS_MN      = WS_H + (size_t)TOK * 512 * 2;
constexpr size_t WS_ZQ      = WS_H + (size_t)TOK * 1024 * 2;
constexpr size_t WS_KB      = WS_ZQ + (size_t)TOK * 512 * 2;
constexpr size_t WS_VTP     = WS_KB + (size_t)TOKP * 512 * 2;
constexpr size_t WS_MQKT_P  = WS_VTP + 32ull * 512 * 2048 * 2;
constexpr size_t WS_MVT_P   = WS_MQKT_P + 32ull * 1024 * 2048 * 2;
constexpr size_t WS_MO      = WS_MVT_P + 32ull * 512 * 2048 * 2;
constexpr size_t WS_G       = WS_MO + (size_t)TOK * 512 * 2;
constexpr size_t WS_END     = WS_G + (size_t)TOK * 2048 * 2;
constexpr size_t WS_MIX     = WS_ZQ;
constexpr size_t WS_ACT     = WS_ZQ;

constexpr size_t O_YP  = 0;
constexpr size_t O_YS  = O_YP + (size_t)TOKP * 1024;
constexpr size_t O_KP  = O_YS + (size_t)TOKS * 1024;
constexpr size_t O_VP  = O_KP + 2ull * TOKP * 512;
constexpr size_t O_KSM = O_VP + 2ull * TOKP * 512;
constexpr size_t O_VSM = O_KSM + 2ull * TOKS * 512;
constexpr size_t O_CP  = O_VSM + 2ull * TOKS * 512;
constexpr size_t O_NP  = O_CP + 2ull * 32 * 4 * 128 * 128;
constexpr size_t O_MP  = O_NP + 2ull * 32 * 4 * 128;
constexpr size_t O_CVP = O_MP + 2ull * 32 * 4;
constexpr size_t O_CS  = O_CVP + 2ull * 32 * 3 * 1024;
constexpr size_t O_NS  = O_CS + 2ull * 8 * 4 * 128 * 128;
constexpr size_t O_MS  = O_NS + 2ull * 8 * 4 * 128;
constexpr size_t O_CVS = O_MS + 2ull * 8 * 4;

constexpr int LDS_BYTES = 148480;

struct Params {
  const float* in[30];
  float* out;
  unsigned char* ws;
};

DI u16 f2bf(float x) { unsigned u = __float_as_uint(x); u += 0x7fffu + ((u >> 16) & 1u); return (u16)(u >> 16); }
DI float bf2f(unsigned v) { return __uint_as_float(v << 16); }
typedef __bf16 bf16x2_t __attribute__((ext_vector_type(2)));
typedef float f32x2_t __attribute__((ext_vector_type(2)));
DI unsigned pack2(float a, float b) {
  f32x2_t v = {a, b};
  return __builtin_bit_cast(unsigned, __builtin_convertvector(v, bf16x2_t));
}
DI float bflo(unsigned v) { return __uint_as_float(v << 16); }
DI float bfhi(unsigned v) { return __uint_as_float(v & 0xffff0000u); }
DI float sigmoidf_(float x) { return 1.f / (1.f + __expf(-x)); }
DI float siluf_(float x) { return x / (1.f + __expf(-x)); }
DI float fexp2(float x) { return __builtin_amdgcn_exp2f(x); }
DI int otid() { int t = threadIdx.x; asm volatile("" : "+v"(t)); return t; }
DI float shx(float v, int mask, int lane) { return __int_as_float(__builtin_amdgcn_ds_bpermute(((lane ^ mask) & 63) << 2, __float_as_int(v))); }
DI float shidx(float v, int src, int lane) { (void)lane; return __int_as_float(__builtin_amdgcn_ds_bpermute((src & 63) << 2, __float_as_int(v))); }
DI int crow(int i, int h) { return (i & 3) + 8 * (i >> 2) + 4 * h; }
DI bf16x8 pack8(const f32x16& x, int s) {
  uint4 u;
  u.x = pack2(x[8 * s + 0], x[8 * s + 1]); u.y = pack2(x[8 * s + 2], x[8 * s + 3]);
  u.z = pack2(x[8 * s + 4], x[8 * s + 5]); u.w = pack2(x[8 * s + 6], x[8 * s + 7]);
  return __builtin_bit_cast(bf16x8, u);
}
DI void zero16(f32x16& a) {
#pragma unroll
  for (int i = 0; i < 16; ++i) a[i] = 0.f;
}
DI int batch_of_row(int row) { return row < TOKP ? (row >> 11) : 32 + ((row - TOKP) >> 5); }

constexpr int GS_STRIDE = 144;
constexpr int GS_STAGE = 512 * GS_STRIDE;
constexpr int GS_BASE = 64;

DI void gemm_mainloop(f32x16 (&acc)[4][2], const u16* __restrict__ A, int lda, const u16* __restrict__ Wt, int ldw, int K,
                      int m0, int n0, unsigned char* smem) {
  const int tid = otid(), lane = tid & 63, w = tid >> 6;
  const int wm = w >> 2, wn = w & 3, r = lane & 31, h = lane >> 5;
  const int lrow = tid >> 3, lcc = tid & 7;
  const u16* ap = A + (size_t)(m0 + lrow) * lda + lcc * 8;
  const int bn = n0 + 2 * (lrow & 31) + ((lrow >> 5) & 1);
  const u16* bp = Wt + (size_t)bn * ldw + lcc * 8;
  const size_t astep = (size_t)64 * lda, bstep = (size_t)64 * ldw;
  unsigned char* sbase = smem + GS_BASE;
  const int woff = lrow * GS_STRIDE + lcc * 16;
  const int nk = K >> 6;
  uint4 s0, s1, s2, s3, s4, s5, s6, s7, u0, u1, u2, u3, u4, u5, u6, u7;
  int kn = 1;
#define G_ADV() do { const int adv = (kn < nk) ? 64 : 0; ap += adv; bp += adv; ++kn; } while (0)
#define G_ISSUE_A() do { s0 = *(const uint4*)(ap); s1 = *(const uint4*)(ap + astep); s2 = *(const uint4*)(ap + 2 * astep); s3 = *(const uint4*)(ap + 3 * astep); \
    s4 = *(const uint4*)(bp); s5 = *(const uint4*)(bp + bstep); s6 = *(const uint4*)(bp + 2 * bstep); s7 = *(const uint4*)(bp + 3 * bstep); } while (0)
#define G_ISSUE_B() do { u0 = *(const uint4*)(ap); u1 = *(const uint4*)(ap + astep); u2 = *(const uint4*)(ap + 2 * astep); u3 = *(const uint4*)(ap + 3 * astep); \
    u4 = *(const uint4*)(bp); u5 = *(const uint4*)(bp + bstep); u6 = *(const uint4*)(bp + 2 * bstep); u7 = *(const uint4*)(bp + 3 * bstep); } while (0)
#define G_WRITE_A(sn) do { *(uint4*)((sn) + woff) = s0; *(uint4*)((sn) + woff + 64 * GS_STRIDE) = s1; *(uint4*)((sn) + woff + 128 * GS_STRIDE) = s2; \
    *(uint4*)((sn) + woff + 192 * GS_STRIDE) = s3; *(uint4*)((sn) + woff + 256 * GS_STRIDE) = s4; *(uint4*)((sn) + woff + 320 * GS_STRIDE) = s5; \
    *(uint4*)((sn) + woff + 384 * GS_STRIDE) = s6; *(uint4*)((sn) + woff + 448 * GS_STRIDE) = s7; } while (0)
#define G_WRITE_B(sn) do { *(uint4*)((sn) + woff) = u0; *(uint4*)((sn) + woff + 64 * GS_STRIDE) = u1; *(uint4*)((sn) + woff + 128 * GS_STRIDE) = u2; \
    *(uint4*)((sn) + woff + 192 * GS_STRIDE) = u3; *(uint4*)((sn) + woff + 256 * GS_STRIDE) = u4; *(uint4*)((sn) + woff + 320 * GS_STRIDE) = u5; \
    *(uint4*)((sn) + woff + 384 * GS_STRIDE) = u6; *(uint4*)((sn) + woff + 448 * GS_STRIDE) = u7; } while (0)
  const int aoff = (wm * 128 + r) * GS_STRIDE + h * 16;
  const int boff = (256 + wn * 64 + r) * GS_STRIDE + h * 16;
#define G_COMPUTE(st) do { _Pragma("unroll") for (int ks = 0; ks < 4; ++ks) {                                              \
      bf16x8 fa[4], fb[2];                                                                                               \
      _Pragma("unroll") for (int mi = 0; mi < 4; ++mi) fa[mi] = *(const bf16x8*)((st) + aoff + mi * 32 * GS_STRIDE + ks * 32); \
      fb[0] = *(const bf16x8*)((st) + boff + ks * 32);                                                                   \
      fb[1] = *(const bf16x8*)((st) + boff + 32 * GS_STRIDE + ks * 32);                                                  \
      _Pragma("unroll") for (int mi = 0; mi < 4; ++mi) {                                                                 \
        acc[mi][0] = MFMA(fa[mi], fb[0], acc[mi][0]);                                                                    \
        acc[mi][1] = MFMA(fa[mi], fb[1], acc[mi][1]);                                                                    \
      }                                                                                                                  \
      __builtin_amdgcn_sched_barrier(0);                                                                                 \
    } } while (0)
  G_ISSUE_A();
  G_WRITE_A(sbase);
  G_ADV(); G_ISSUE_A();
  G_ADV(); G_ISSUE_B();
  __syncthreads();
  for (int kt = 0; kt < nk; kt += 2) {
    G_WRITE_A(sbase + GS_STAGE);
    G_ADV(); G_ISSUE_A();
    __builtin_amdgcn_sched_barrier(0);
    G_COMPUTE(sbase);
    __syncthreads();
    G_WRITE_B(sbase);
    G_ADV(); G_ISSUE_B();
    __builtin_amdgcn_sched_barrier(0);
    G_COMPUTE(sbase + GS_STAGE);
    __syncthreads();
  }
#undef G_ADV
#undef G_ISSUE_A
#undef G_ISSUE_B
#undef G_WRITE_A
#undef G_WRITE_B
#undef G_COMPUTE
}

DI int rot_unused_(int) { return 0; }
DI bool tile_of(int i, int MT, int NT, int& mt, int& nt) {
  const int per = gridDim.x >> 3;
  const int L = i * (int)gridDim.x + (int)(blockIdx.x & 7) * per + (int)(blockIdx.x >> 3);
  if (L >= MT * NT) return false;
  const int nig = 8 * NT, gid = L / nig, fm = gid * 8, gsz = min(MT - fm, 8), rem = L - gid * nig;
  mt = fm + rem % gsz; nt = rem / gsz;
  return true;
}


template <class PF, class EF>
DI void gemm_stream(int lda, int ldw, int K, unsigned char* smem, PF ptrs, EF epi) {
  const int tid = otid(), lane = tid & 63, w = tid >> 6;
  const int wm = w >> 2, wn = w & 3, r = lane & 31, h = lane >> 5;
  const int lrow = tid >> 3, lcc = tid & 7;
  const size_t astep = (size_t)64 * lda, bstep = (size_t)64 * ldw;
  unsigned char* sbase = smem + GS_BASE;
  const int woff = lrow * GS_STRIDE + lcc * 16;
  const int nk = K >> 6;
  const u16 *ap, *bp;
  if (!ptrs(0, ap, bp)) return;
  int it_iss = 0, kq = 0;
  bool live = true;
  uint4 s0, s1, s2, s3, s4, s5, s6, s7;
#define G_ADV() do { if (live) { if (++kq == nk) { const u16 *na_, *nb_; if (ptrs(it_iss + 1, na_, nb_)) { ++it_iss; ap = na_; bp = nb_; kq = 0; } else live = false; } \
    else { ap += 64; bp += 64; } } } while (0)
#define G_ISSUE_A() do { s0 = *(const uint4*)(ap); s1 = *(const uint4*)(ap + astep); s2 = *(const uint4*)(ap + 2 * astep); s3 = *(const uint4*)(ap + 3 * astep); \
    s4 = *(const uint4*)(bp); s5 = *(const uint4*)(bp + bstep); s6 = *(const uint4*)(bp + 2 * bstep); s7 = *(const uint4*)(bp + 3 * bstep); } while (0)
#define G_WRITE_A(sn) do { *(uint4*)((sn) + woff) = s0; *(uint4*)((sn) + woff + 64 * GS_STRIDE) = s1; *(uint4*)((sn) + woff + 128 * GS_STRIDE) = s2; \
    *(uint4*)((sn) + woff + 192 * GS_STRIDE) = s3; *(uint4*)((sn) + woff + 256 * GS_STRIDE) = s4; *(uint4*)((sn) + woff + 320 * GS_STRIDE) = s5; \
    *(uint4*)((sn) + woff + 384 * GS_STRIDE) = s6; *(uint4*)((sn) + woff + 448 * GS_STRIDE) = s7; } while (0)
  const int aoff = (wm * 128 + r) * GS_STRIDE + h * 16;
  const int boff = (256 + wn * 64 + r) * GS_STRIDE + h * 16;
#define G_COMPUTE(st) do { _Pragma("unroll") for (int ks = 0; ks < 4; ++ks) {                                              \
      bf16x8 fa[4], fb[2];                                                                                               \
      _Pragma("unroll") for (int mi = 0; mi < 4; ++mi) fa[mi] = *(const bf16x8*)((st) + aoff + mi * 32 * GS_STRIDE + ks * 32); \
      fb[0] = *(const bf16x8*)((st) + boff + ks * 32);                                                                   \
      fb[1] = *(const bf16x8*)((st) + boff + 32 * GS_STRIDE + ks * 32);                                                  \
      _Pragma("unroll") for (int mi = 0; mi < 4; ++mi) {                                                                 \
        acc[mi][0] = MFMA(fa[mi], fb[0], acc[mi][0]);                                                                    \
        acc[mi][1] = MFMA(fa[mi], fb[1], acc[mi][1]);                                                                    \
      }                                                                                                                  \
      __builtin_amdgcn_sched_barrier(0);                                                                                 \
    } } while (0)
  G_ISSUE_A();
  G_WRITE_A(sbase);
  G_ADV(); G_ISSUE_A();
  __syncthreads();
  for (int it = 0;; ++it) {
    f32x16 acc[4][2];
#pragma unroll
    for (int a = 0; a < 4; ++a)
#pragma unroll
      for (int b = 0; b < 2; ++b) zero16(acc[a][b]);
    for (int kt = 0; kt < nk; kt += 2) {
      G_WRITE_A(sbase + GS_STAGE);
      G_ADV(); G_ISSUE_A();
      __builtin_amdgcn_sched_barrier(0);
      G_COMPUTE(sbase);
      __syncthreads();
      G_WRITE_A(sbase);
      G_ADV(); G_ISSUE_A();
      __builtin_amdgcn_sched_barrier(0);
      G_COMPUTE(sbase + GS_STAGE);
      __syncthreads();
    }
    epi(it, acc);
    const u16 *da_, *db_;
    if (!ptrs(it + 1, da_, db_)) break;
  }
#undef G_ADV
#undef G_ISSUE_A
#undef G_WRITE_A
#undef G_COMPUTE
}

DI int map_row(int maptype, int s) {
  if (maptype == 1) return s < 3072 ? s : (s < 3080 ? -1 : s - 8);
  if (maptype == 2) return s < 2816 ? 2 * s : 2 * (s - 2816) + 1;
  return s;
}
DI void transpose_task(const float* __restrict__ src, int Nsrc, u16* __restrict__ dst, int dld, int maptype, int kt, int nt,
                       unsigned char* smem) {
  float* tile = (float*)(smem + 64);
  const int tid = otid();
  const int k0 = kt * 64, s0 = nt * 64;
#pragma unroll
  for (int i = 0; i < 2; ++i) {
    const int kr = (tid >> 4) + 32 * i, nc = (tid & 15) * 4;
    float4 v = make_float4(0.f, 0.f, 0.f, 0.f);
    if (s0 + nc < Nsrc) v = *(const float4*)(src + (size_t)(k0 + kr) * Nsrc + s0 + nc);
    tile[kr * 65 + nc + 0] = v.x; tile[kr * 65 + nc + 1] = v.y; tile[kr * 65 + nc + 2] = v.z; tile[kr * 65 + nc + 3] = v.w;
  }
  __syncthreads();
  {
    const int n = tid >> 3, kc = (tid & 7) * 8;
    const int s = s0 + n;
    const int dr = (s < Nsrc) ? map_row(maptype, s) : -1;
    if (dr >= 0) {
      uint4 o;
      o.x = pack2(tile[(kc + 0) * 65 + n], tile[(kc + 1) * 65 + n]);
      o.y = pack2(tile[(kc + 2) * 65 + n], tile[(kc + 3) * 65 + n]);
      o.z = pack2(tile[(kc + 4) * 65 + n], tile[(kc + 5) * 65 + n]);
      o.w = pack2(tile[(kc + 6) * 65 + n], tile[(kc + 7) * 65 + n]);
      *(uint4*)(dst + (size_t)dr * dld + k0 + kc) = o;
    }
  }
  __syncthreads();
}

DI void adaln_task(const Params& p, int task, unsigned char* smem) {
  const int bhalf = task & 1, cg_ = (task >> 1) % 96, l = (task >> 1) / 96;
  float* cs = (float*)(smem + 64);
  float* red = (float*)(smem + 64 + 20 * 1024 * 4);
  const int tid = otid();
  const float* cp = p.in[2]; const float* csm = p.in[3];
  for (int idx = tid; idx < 20 * 1024; idx += NTHR) {
    const int bb = idx >> 10, d = idx & 1023, b = bhalf * 20 + bb;
    const float c = b < 32 ? cp[b * 1024 + d] : csm[(b - 32) * 1024 + d];
    cs[idx] = siluf_(c);
  }
  __syncthreads();
  const int dseg = tid >> 6, e = cg_ * 64 + (tid & 63);
  const float* wp = p.in[10] + ((size_t)l * 1024 + dseg * 128) * 6144 + e;
  float acc[20];
#pragma unroll
  for (int i = 0; i < 20; ++i) acc[i] = 0.f;
  for (int d = 0; d < 128; ++d) {
    const float wv = wp[(size_t)d * 6144];
    const float* c0 = cs + dseg * 128 + d;
#pragma unroll
    for (int i = 0; i < 20; ++i) acc[i] += c0[i * 1024] * wv;
  }
#pragma unroll
  for (int i = 0; i < 20; ++i) red[(dseg * 20 + i) * 64 + (tid & 63)] = acc[i];
  __syncthreads();
  float* mod = (float*)(p.ws + WS_MOD);
  for (int idx = tid; idx < 20 * 64; idx += NTHR) {
    const int bb = idx >> 6, ec = idx & 63;
    float s = 0.f;
#pragma unroll
    for (int q = 0; q < 8; ++q) s += red[(q * 20 + bb) * 64 + ec];
    const int ee = cg_ * 64 + ec;
    mod[((size_t)l * 40 + bhalf * 20 + bb) * 6144 + ee] = s + p.in[11][l * 6144 + ee];
  }
  __syncthreads();
}

DI void prologue(const Params& p, unsigned char* smem) {
  const int WT_TASKS_L = 912 + 512 + 128 + 128 + 256 + 1408 + 704;
  const int N_WT = 2 * WT_TASKS_L;
  const int N_ADA = 384, N_CK = 512, N_CV = 2048;
  const int total = N_WT + N_ADA + N_CK + N_CV;
  for (int task = blockIdx.x; task < total; task += gridDim.x) {
    if (task < N_WT) {
      const int l = task / WT_TASKS_L; int t = task % WT_TASKS_L;
      if (t < 912) { transpose_task(p.in[12] + (size_t)l * 1024 * 3592, 3592, (u16*)(p.ws + WS_WT_IN) + (size_t)l * 3584 * 1024, 1024, 1, t / 57, t % 57, smem); continue; }
      t -= 912;
      if (t < 512) { transpose_task(p.in[21] + (size_t)l * 1024 * 2048, 2048, (u16*)(p.ws + WS_WT_GATE) + (size_t)l * 2048 * 1024, 1024, 0, t / 32, t % 32, smem); continue; }
      t -= 512;
      if (t < 128) { transpose_task(p.in[19] + (size_t)l * 512 * 1024, 1024, (u16*)(p.ws + WS_WT_BRA) + (size_t)l * 1024 * 512, 512, 0, t / 16, t % 16, smem); continue; }
      t -= 128;
      if (t < 128) { transpose_task(p.in[20] + (size_t)l * 512 * 1024, 1024, (u16*)(p.ws + WS_WT_BRB) + (size_t)l * 1024 * 512, 512, 0, t / 16, t % 16, smem); continue; }
      t -= 128;
      if (t < 256) { transpose_task(p.in[23] + (size_t)l * 1024 * 1024, 1024, (u16*)(p.ws + WS_WT_O) + (size_t)l * 1024 * 1024, 1024, 0, t / 16, t % 16, smem); continue; }
      t -= 256;
      if (t < 1408) { transpose_task(p.in[26] + (size_t)l * 1024 * 5632, 5632, (u16*)(p.ws + WS_WT_GU) + (size_t)l * 5632 * 1024, 1024, 2, t / 88, t % 88, smem); continue; }
      t -= 1408;
      transpose_task(p.in[27] + (size_t)l * 2816 * 1024, 1024, (u16*)(p.ws + WS_WT_DOWN) + (size_t)l * 1024 * 2816, 2816, 0, t / 16, t % 16, smem);
    } else if (task < N_WT + N_ADA) {
      adaln_task(p, task - N_WT, smem);
    } else if (task < N_WT + N_ADA + N_CK) {
      const int t = task - N_WT - N_ADA;
      const float4* src = (const float4*)p.in[4];
      u16* dst = (u16*)(p.ws + WS_KS);
#pragma unroll
      for (int i = 0; i < 8; ++i) {
        const size_t f4 = (size_t)t * 4096 + i * 512 + otid();
        const float4 v = src[f4];
        const size_t e = f4 * 4;
        const size_t lb = e / (1024 * 512), rem = e % (1024 * 512);
        uint2 o; o.x = pack2(v.x, v.y); o.y = pack2(v.z, v.w);
        *(uint2*)(dst + lb * (1056 * 512) + rem) = o;
      }
    } else {
      const int t = task - N_WT - N_ADA - N_CK;
      const int lb = t >> 7, tt = t & 127;
      transpose_task(p.in[5] + (size_t)lb * 1024 * 512, 512, (u16*)(p.ws + WS_VTS) + (size_t)lb * 512 * 1056, 1056, 0, tt >> 3, tt & 7, smem);
    }
  }
}

DI float wave_sum(float v, int lane) {
#pragma unroll
  for (int off = 32; off >= 1; off >>= 1) v += shx(v, off, lane);
  return v;
}
DI void ln_pass(const Params& p, int mode, int l, unsigned char* smem) {
  const int tid = otid();
  const int lane = tid & 63, w = tid >> 6;
  const bool first = mode != 0;
  const bool second = (mode != 2) || (l + 1 < 2);
  const bool gates = (mode == 0) || (mode == 2 && l + 1 < 2);
  const int lm = (mode == 2) ? l + 1 : l;
  const int shi = (mode == 1) ? 3 : 0;
  const float* lng = (mode == 1) ? p.in[24] + l * 1024 : p.in[28] + l * 1024;
  const float* lnb = (mode == 1) ? p.in[25] + l * 1024 : p.in[29] + l * 1024;
  const float* mod = (const float*)(p.ws + WS_MOD);
  u16* H = (u16*)(p.ws + WS_H);
  float* gout = (float*)(p.ws + WS_GATES);
  float* wl = (float*)(smem + 64);
  float bif[8];
  if (gates) {
    const float* wi = p.in[12] + (size_t)lm * 1024 * 3592 + 3072;
    for (int idx = tid; idx < 8192; idx += NTHR) {
      const int c = idx >> 3, j = idx & 7;
      wl[j * 1024 + c] = wi[(size_t)c * 3592 + j];
    }
#pragma unroll
    for (int j = 0; j < 8; ++j) bif[j] = p.in[13][lm * 8 + j];
  }
  __syncthreads();
  float lg[16], lb[16];
  if (first) {
#pragma unroll
    for (int i = 0; i < 4; ++i) {
      const float4 g = *(const float4*)(lng + i * 256 + lane * 4);
      const float4 b = *(const float4*)(lnb + i * 256 + lane * 4);
      lg[i * 4] = g.x; lg[i * 4 + 1] = g.y; lg[i * 4 + 2] = g.z; lg[i * 4 + 3] = g.w;
      lb[i * 4] = b.x; lb[i * 4 + 1] = b.y; lb[i * 4 + 2] = b.z; lb[i * 4 + 3] = b.w;
    }
  }
  auto process = [&](int row, float (&v)[16], const float (&msh)[16], const float (&msc)[16]) {
    float* xr = p.out + (size_t)row * 1024;
    if (first) {
      float s = 0.f;
#pragma unroll
      for (int i = 0; i < 16; ++i) s += v[i];
      const float mean = wave_sum(s, lane) * (1.f / 1024.f);
      float q = 0.f;
#pragma unroll
      for (int i = 0; i < 16; ++i) { v[i] -= mean; q += v[i] * v[i]; }
      const float rstd = rsqrtf(wave_sum(q, lane) * (1.f / 1024.f) + LN_EPS);
#pragma unroll
      for (int i = 0; i < 4; ++i) {
#pragma unroll
        for (int e = 0; e < 4; ++e) v[i * 4 + e] = v[i * 4 + e] * rstd * lg[i * 4 + e] + lb[i * 4 + e];
        *(float4*)(xr + i * 256 + lane * 4) = make_float4(v[i * 4 + 0], v[i * 4 + 1], v[i * 4 + 2], v[i * 4 + 3]);
      }
    }
    if (second) {
      float s = 0.f;
#pragma unroll
      for (int i = 0; i < 16; ++i) s += v[i];
      const float mean = wave_sum(s, lane) * (1.f / 1024.f);
      float q = 0.f;
#pragma unroll
      for (int i = 0; i < 16; ++i) { v[i] -= mean; q += v[i] * v[i]; }
      const float rstd = rsqrtf(wave_sum(q, lane) * (1.f / 1024.f) + LN_EPS);
#pragma unroll
      for (int i = 0; i < 4; ++i) {
#pragma unroll
        for (int e = 0; e < 4; ++e) v[i * 4 + e] = v[i * 4 + e] * rstd * msc[i * 4 + e] + msh[i * 4 + e];
        uint2 o; o.x = pack2(v[i * 4 + 0], v[i * 4 + 1]); o.y = pack2(v[i * 4 + 2], v[i * 4 + 3]);
        *(uint2*)(H + (size_t)row * 1024 + i * 256 + lane * 4) = o;
      }
      if (gates) {
        float g8[8];
#pragma unroll
        for (int j = 0; j < 8; ++j) {
          float s2 = 0.f;
#pragma unroll
          for (int i = 0; i < 4; ++i) {
            const float4 wv = *(const float4*)(wl + j * 1024 + i * 256 + lane * 4);
            s2 += v[i * 4] * wv.x + v[i * 4 + 1] * wv.y + v[i * 4 + 2] * wv.z + v[i * 4 + 3] * wv.w;
          }
          g8[j] = wave_sum(s2, lane) + bif[j];
        }
        if (lane == 0) {
          *(float4*)(gout + (size_t)row * 8) = make_float4(g8[0], g8[1], g8[2], g8[3]);
          *(float4*)(gout + (size_t)row * 8 + 4) = make_float4(g8[4], g8[5], g8[6], g8[7]);
        }
      }
    }
  };
  auto load_mod = [&](int row, float (&msh)[16], float (&msc)[16]) {
    const float* mb = mod + ((size_t)lm * 40 + batch_of_row(row)) * 6144;
#pragma unroll
    for (int i = 0; i < 4; ++i) {
      const float4 sh = *(const float4*)(mb + shi * 1024 + i * 256 + lane * 4);
      const float4 sc = *(const float4*)(mb + (shi + 1) * 1024 + i * 256 + lane * 4);
      msh[i * 4] = sh.x; msh[i * 4 + 1] = sh.y; msh[i * 4 + 2] = sh.z; msh[i * 4 + 3] = sh.w;
      msc[i * 4] = 1.f + sc.x; msc[i * 4 + 1] = 1.f + sc.y; msc[i * 4 + 2] = 1.f + sc.z; msc[i * 4 + 3] = 1.f + sc.w;
    }
  };
  for (int chunk = blockIdx.x * 8 + w; chunk < TOKP / 32; chunk += gridDim.x * 8) {
    const int row0 = chunk * 32;
    float msh[16], msc[16];
    if (second) load_mod(row0, msh, msc);
    const float* src0 = (mode == 0) ? p.in[0] + (size_t)row0 * 1024 : p.out + (size_t)row0 * 1024;
    float4 nx0 = *(const float4*)(src0 + lane * 4), nx1 = *(const float4*)(src0 + 256 + lane * 4);
    float4 nx2 = *(const float4*)(src0 + 512 + lane * 4), nx3 = *(const float4*)(src0 + 768 + lane * 4);
    for (int ri = 0; ri < 32; ++ri) {
      float v[16];
      v[0] = nx0.x; v[1] = nx0.y; v[2] = nx0.z; v[3] = nx0.w; v[4] = nx1.x; v[5] = nx1.y; v[6] = nx1.z; v[7] = nx1.w;
      v[8] = nx2.x; v[9] = nx2.y; v[10] = nx2.z; v[11] = nx2.w; v[12] = nx3.x; v[13] = nx3.y; v[14] = nx3.z; v[15] = nx3.w;
      {
        const float* sn = src0 + (size_t)(ri < 31 ? ri + 1 : 31) * 1024;
        nx0 = *(const float4*)(sn + lane * 4); nx1 = *(const float4*)(sn + 256 + lane * 4);
        nx2 = *(const float4*)(sn + 512 + lane * 4); nx3 = *(const float4*)(sn + 768 + lane * 4);
      }
      __builtin_amdgcn_sched_barrier(0);
      process(row0 + ri, v, msh, msc);
    }
  }
  if (w == 0) {
    for (int row = TOKP + blockIdx.x; row < TOK; row += gridDim.x) {
      float msh[16], msc[16];
      if (second) load_mod(row, msh, msc);
      const float* src = (mode == 0) ? p.in[1] + (size_t)(row - TOKP) * 1024 : p.out + (size_t)row * 1024;
      float v[16];
#pragma unroll
      for (int i = 0; i < 4; ++i) {
        const float4 t = *(const float4*)(src + i * 256 + lane * 4);
        v[i * 4 + 0] = t.x; v[i * 4 + 1] = t.y; v[i * 4 + 2] = t.z; v[i * 4 + 3] = t.w;
      }
      process(row, v, msh, msc);
    }
  }
}

constexpr int EP_LD = 264;
constexpr int EP_LDT = 68;
DI void zero_acc(f32x16 (&acc)[4][2]) {
#pragma unroll
  for (int a = 0; a < 4; ++a)
#pragma unroll
    for (int b = 0; b < 2; ++b) zero16(acc[a][b]);
}
DI void stage_rm(const f32x16& a0, const f32x16& a1, float* stg, int wm, int wn, int r, int h) {
#pragma unroll
  for (int i = 0; i < 16; ++i) *(float2*)(stg + (wm * 32 + crow(i, h)) * EP_LD + wn * 64 + 2 * r) = make_float2(a0[i], a1[i]);
}
DI void stage_tr(const f32x16& a0, const f32x16& a1, float* stg, int wm, int wn, int r, int h) {
#pragma unroll
  for (int g = 0; g < 4; ++g) {
    *(float4*)(stg + (wn * 64 + 2 * r) * EP_LDT + wm * 32 + 8 * g + 4 * h) = make_float4(a0[4 * g], a0[4 * g + 1], a0[4 * g + 2], a0[4 * g + 3]);
    *(float4*)(stg + (wn * 64 + 2 * r + 1) * EP_LDT + wm * 32 + 8 * g + 4 * h) = make_float4(a1[4 * g], a1[4 * g + 1], a1[4 * g + 2], a1[4 * g + 3]);
  }
}
DI int grow_of(int m0, int mi, int lr) { return m0 + (lr >> 5) * 128 + mi * 32 + (lr & 31); }
DI uint4 pack8f(const float4& a, const float4& b) {
  uint4 o; o.x = pack2(a.x, a.y); o.y = pack2(a.z, a.w); o.z = pack2(b.x, b.y); o.w = pack2(b.z, b.w); return o;
}

DI void write_tr(const Params& p, int l, int m0, int mi, const float* stg, int tid, int which, int chbase) {
  const bool prompt = m0 < TOKP;
#pragma unroll 1
  for (int q = 0; q < 4; ++q) {
    const int cid = q * NTHR + tid, ch = cid >> 3, tc = cid & 7;
    const float4 v0 = *(const float4*)(stg + ch * EP_LDT + tc * 8);
    const float4 v1 = *(const float4*)(stg + ch * EP_LDT + tc * 8 + 4);
    const int row0 = grow_of(m0, mi, tc * 8);
    const int chg = chbase + ch;
    u16* d;
    if (prompt) {
      const int b = row0 >> 11, t = row0 & 2047;
      if (which == 0) d = (u16*)(p.ws + WS_VTP) + ((size_t)b * 512 + chg) * 2048 + t;
      else if (which == 1) d = (u16*)(p.ws + WS_MQKT_P) + ((size_t)b * 1024 + chg) * 2048 + t;
      else d = (u16*)(p.ws + WS_MVT_P) + ((size_t)b * 512 + chg) * 2048 + t;
    } else {
      const int rs = row0 - TOKP, bs = rs >> 5, t = rs & 31;
      if (which == 0) d = (u16*)(p.ws + WS_VTS) + ((size_t)(l * 8 + bs) * 512 + chg) * 1056 + 1024 + t;
      else if (which == 1) d = (u16*)(p.ws + WS_MQKT_S) + ((size_t)bs * 1024 + chg) * 32 + t;
      else d = (u16*)(p.ws + WS_MVT_S) + ((size_t)bs * 512 + chg) * 32 + t;
    }
    *(uint4*)d = pack8f(v0, v1);
  }
}

DI void epi_in(const Params& p, int l, int m0, int n0, f32x16 (&acc)[4][2], unsigned char* smem) {
  const int tid = otid(), lane = tid & 63, w = tid >> 6;
  const int wm = w >> 2, wn = w & 3, r = lane & 31, h = lane >> 5;
  const bool prompt = m0 < TOKP;
  float* stg = (float*)(smem + GS_BASE + GS_STAGE);
  const int seg = n0 < 512 ? 0 : (n0 < 1024 ? 1 : (n0 < 1536 ? 2 : (n0 < 2560 ? 3 : (n0 < 3072 ? 4 : 5))));
  if (seg == 3) {
    const int ch = n0 - 1536 + wn * 64 + 2 * r;
#pragma unroll
    for (int mi = 0; mi < 4; ++mi) {
      const int rb = m0 + wm * 128 + mi * 32 + 4 * h;
#pragma unroll
      for (int i = 0; i < 16; ++i) {
        const int row = rb + (i & 3) + 8 * (i >> 2);
        if (prompt) {
          const int tt = row & 2047;
          if (tt >= 2045) *(float2*)(p.out + O_CVP + ((size_t)(l * 32 + (row >> 11)) * 3 + (tt - 2045)) * 1024 + ch) = make_float2(acc[mi][0][i], acc[mi][1][i]);
        } else {
          const int rs = row - TOKP, tt = rs & 31;
          if (tt >= 29) *(float2*)(p.out + O_CVS + ((size_t)(l * 8 + (rs >> 5)) * 3 + (tt - 29)) * 1024 + ch) = make_float2(acc[mi][0][i], acc[mi][1][i]);
        }
      }
    }
  }
#pragma unroll
  for (int mi = 0; mi < 4; ++mi) {
    if (seg == 0 || seg == 1 || seg == 2 || seg == 5) {
      __syncthreads();
      stage_rm(acc[mi][0], acc[mi][1], stg, wm, wn, r, h);
      __syncthreads();
#pragma unroll 1
      for (int q = 0; q < 4; ++q) {
        const int cid = q * NTHR + tid, lr = cid >> 5, c8 = (cid & 31) * 8;
        const float4 v0 = *(const float4*)(stg + lr * EP_LD + c8);
        const float4 v1 = *(const float4*)(stg + lr * EP_LD + c8 + 4);
        const int row = grow_of(m0, mi, lr);
        const int n = n0 + c8;
        if (seg == 0) {
          *(uint4*)((u16*)(p.ws + WS_ZQ) + (size_t)row * 512 + n) = pack8f(v0, v1);
        } else if (seg == 5) {
          const float4 s0 = make_float4(sigmoidf_(v0.x), sigmoidf_(v0.y), sigmoidf_(v0.z), sigmoidf_(v0.w));
          const float4 s1 = make_float4(sigmoidf_(v1.x), sigmoidf_(v1.y), sigmoidf_(v1.z), sigmoidf_(v1.w));
          *(uint4*)((u16*)(p.ws + WS_MO) + (size_t)row * 512 + (n - 3072)) = pack8f(s0, s1);
        } else {
          const bool isk = seg == 1;
          const int nn = n - (isk ? 512 : 1024);
          float* of = p.out + (isk ? (prompt ? O_KP : O_KSM) : (prompt ? O_VP : O_VSM));
          const size_t orow = prompt ? ((size_t)l * TOKP + row) : ((size_t)l * TOKS + (row - TOKP));
          *(float4*)(of + orow * 512 + nn) = v0;
          *(float4*)(of + orow * 512 + nn + 4) = v1;
          if (isk) {
            u16* kd;
            if (prompt) kd = (u16*)(p.ws + WS_KB) + (size_t)row * 512 + nn;
            else { const int rs = row - TOKP; kd = (u16*)(p.ws + WS_KS) + ((size_t)(l * 8 + (rs >> 5)) * 1056 + 1024 + (rs & 31)) * 512 + nn; }
            *(uint4*)kd = pack8f(v0, v1);
          }
        }
      }
    }
    if (seg == 2 || seg == 3 || seg == 4) {
      __syncthreads();
      stage_tr(acc[mi][0], acc[mi][1], stg, wm, wn, r, h);
      __syncthreads();
      write_tr(p, l, m0, mi, stg, tid, seg == 2 ? 0 : (seg == 3 ? 1 : 2), n0 - (seg == 2 ? 1024 : (seg == 3 ? 1536 : 2560)));
    }
  }
  __syncthreads();
}

DI void phase_in_gate(const Params& p, int l, unsigned char* smem) {
  const int tid = otid(), lane = tid & 63, w = tid >> 6;
  const int wm = w >> 2, wn = w & 3, r = lane & 31, h = lane >> 5;
  const int lrow = tid >> 3, lcc = tid & 7, brow = 2 * (lrow & 31) + ((lrow >> 5) & 1);
  const u16* H = (const u16*)(p.ws + WS_H);
  const u16* Win = (const u16*)(p.ws + WS_WT_IN) + (size_t)l * 3584 * 1024;
  const u16* Wg = (const u16*)(p.ws + WS_WT_GATE) + (size_t)l * 2048 * 1024;
  float* stg = (float*)(smem + GS_BASE + GS_STAGE);
  const int NT = 14 + 8, MT = 257;
  auto ptrs = [&](int it, const u16*& ap, const u16*& bp) -> bool {
    int mt, nt;
    if (!tile_of(it, MT, NT, mt, nt)) return false;
    ap = H + (size_t)(mt * 256 + lrow) * 1024 + lcc * 8;
    bp = (nt < 14 ? Win + (size_t)(nt * 256 + brow) * 1024 : Wg + (size_t)((nt - 14) * 256 + brow) * 1024) + lcc * 8;
    return true;
  };
  auto epi = [&](int it, f32x16 (&acc)[4][2]) {
    int mt, nt;
    tile_of(it, MT, NT, mt, nt);
    const int m0 = mt * 256;
    if (nt < 14) {
      epi_in(p, l, m0, nt * 256, acc, smem);
    } else {
      const int n0 = (nt - 14) * 256;
      u16* G = (u16*)(p.ws + WS_G);
#pragma unroll
      for (int mi = 0; mi < 4; ++mi) {
        __syncthreads();
        stage_rm(acc[mi][0], acc[mi][1], stg, wm, wn, r, h);
        __syncthreads();
#pragma unroll
        for (int q = 0; q < 4; ++q) {
          const int cid = q * NTHR + tid, lr = cid >> 5, c8 = (cid & 31) * 8;
          float4 v0 = *(const float4*)(stg + lr * EP_LD + c8);
          float4 v1 = *(const float4*)(stg + lr * EP_LD + c8 + 4);
          const int row = grow_of(m0, mi, lr), n = n0 + c8;
          const float4 b0 = *(const float4*)(p.in[22] + l * 2048 + n);
          const float4 b1 = *(const float4*)(p.in[22] + l * 2048 + n + 4);
          v0 = make_float4(sigmoidf_(v0.x + b0.x), sigmoidf_(v0.y + b0.y), sigmoidf_(v0.z + b0.z), sigmoidf_(v0.w + b0.w));
          v1 = make_float4(sigmoidf_(v1.x + b1.x), sigmoidf_(v1.y + b1.y), sigmoidf_(v1.z + b1.z), sigmoidf_(v1.w + b1.w));
          *(uint4*)(G + (size_t)row * 2048 + n) = pack8f(v0, v1);
        }
      }
      __syncthreads();
    }
  };
  gemm_stream(1024, 1024, 1024, smem, ptrs, epi);
}

DI void phase_mix(const Params& p, int l, unsigned char* smem) {
  const int tid = otid(), lane = tid & 63, w = tid >> 6;
  const int wm = w >> 2, wn = w & 3, r = lane & 31, h = lane >> 5;
  const int lrow = tid >> 3, lcc = tid & 7, brow = 2 * (lrow & 31) + ((lrow >> 5) & 1);
  const u16* G = (const u16*)(p.ws + WS_G);
  u16* MIX = (u16*)(p.ws + WS_MIX);
  float* stg = (float*)(smem + GS_BASE + GS_STAGE);
  const int NT = 4, MT = 257;
  auto ptrs = [&](int it, const u16*& ap, const u16*& bp) -> bool {
    int mt, nt;
    if (!tile_of(it >> 1, MT, NT, mt, nt)) return false;
    const int half = it & 1;
    ap = (const u16*)(p.ws + (half ? WS_MN : WS_AN)) + (size_t)(mt * 256 + lrow) * 512 + lcc * 8;
    bp = (const u16*)(p.ws + (half ? WS_WT_BRB : WS_WT_BRA)) + (size_t)l * 1024 * 512 + (size_t)(nt * 256 + brow) * 512 + lcc * 8;
    return true;
  };
  auto epi = [&](int it, f32x16 (&acc)[4][2]) {
    int mt, nt;
    tile_of(it >> 1, MT, NT, mt, nt);
    const int half = it & 1;
    const int m0 = mt * 256, n0 = nt * 256;
#pragma unroll
    for (int mi = 0; mi < 4; ++mi) {
      __syncthreads();
      stage_rm(acc[mi][0], acc[mi][1], stg, wm, wn, r, h);
      __syncthreads();
#pragma unroll
      for (int q = 0; q < 4; ++q) {
        const int cid = q * NTHR + tid, lr = cid >> 5, c8 = (cid & 31) * 8;
        const float4 v0 = *(const float4*)(stg + lr * EP_LD + c8);
        const float4 v1 = *(const float4*)(stg + lr * EP_LD + c8 + 4);
        const int row = grow_of(m0, mi, lr), n = n0 + c8;
        const uint4 g = *(const uint4*)(G + (size_t)row * 2048 + half * 1024 + n);
        float4 o0 = make_float4(bflo(g.x) * v0.x, bfhi(g.x) * v0.y, bflo(g.y) * v0.z, bfhi(g.y) * v0.w);
        float4 o1 = make_float4(bflo(g.z) * v1.x, bfhi(g.z) * v1.y, bflo(g.w) * v1.z, bfhi(g.w) * v1.w);
        uint4* mp = (uint4*)(MIX + (size_t)row * 1024 + n);
        if (half) {
          const uint4 pr = *mp;
          o0.x += bflo(pr.x); o0.y += bfhi(pr.x); o0.z += bflo(pr.y); o0.w += bfhi(pr.y);
          o1.x += bflo(pr.z); o1.y += bfhi(pr.z); o1.z += bflo(pr.w); o1.w += bfhi(pr.w);
        }
        *mp = pack8f(o0, o1);
      }
    }
    __syncthreads();
  };
  gemm_stream(512, 512, 512, smem, ptrs, epi);
}

DI void phase_res(const Params& p, int l, int mode, unsigned char* smem) {
  const int tid = otid(), lane = tid & 63, w = tid >> 6;
  const int wm = w >> 2, wn = w & 3, r = lane & 31, h = lane >> 5;
  const int lrow = tid >> 3, lcc = tid & 7, brow = 2 * (lrow & 31) + ((lrow >> 5) & 1);
  const float* mod = (const float*)(p.ws + WS_MOD);
  float* stg = (float*)(smem + GS_BASE + GS_STAGE);
  const int NT = 4, MT = 257;
  const int K = (mode == 0) ? 1024 : 2816;
  const u16* Ab = (const u16*)(p.ws + (mode == 0 ? WS_MIX : WS_ACT));
  const u16* Wb = (mode == 0) ? (const u16*)(p.ws + WS_WT_O) + (size_t)l * 1024 * 1024 : (const u16*)(p.ws + WS_WT_DOWN) + (size_t)l * 1024 * 2816;
  const int gi = (mode == 0) ? 2 : 5;
  auto ptrs = [&](int it, const u16*& ap, const u16*& bp) -> bool {
    int mt, nt;
    if (!tile_of(it, MT, NT, mt, nt)) return false;
    ap = Ab + (size_t)(mt * 256 + lrow) * K + lcc * 8;
    bp = Wb + (size_t)(nt * 256 + brow) * K + lcc * 8;
    return true;
  };
  auto epi = [&](int it, f32x16 (&acc)[4][2]) {
    int mt, nt;
    tile_of(it, MT, NT, mt, nt);
    const int m0 = mt * 256, n0 = nt * 256;
#pragma unroll
    for (int mi = 0; mi < 4; ++mi) {
      __syncthreads();
      stage_rm(acc[mi][0], acc[mi][1], stg, wm, wn, r, h);
      __syncthreads();
#pragma unroll
      for (int q = 0; q < 8; ++q) {
        const int cid = q * NTHR + tid, lr = cid >> 6, c4 = (cid & 63) * 4;
        const float4 v = *(const float4*)(stg + lr * EP_LD + c4);
        const int row = grow_of(m0, mi, lr), n = n0 + c4;
        const int b = batch_of_row(row);
        const float4 gg = *(const float4*)(mod + ((size_t)l * 40 + b) * 6144 + gi * 1024 + n);
        float* xr = p.out + (size_t)row * 1024 + n;
        const float* xs = (mode == 0 && l == 0) ? (row < TOKP ? p.in[0] + (size_t)row * 1024 + n : p.in[1] + (size_t)(row - TOKP) * 1024 + n) : xr;
        const float4 xv = *(const float4*)xs;
        *(float4*)xr = make_float4(ALPHA * xv.x + (1.f + gg.x) * v.x, ALPHA * xv.y + (1.f + gg.y) * v.y,
                                   ALPHA * xv.z + (1.f + gg.z) * v.z, ALPHA * xv.w + (1.f + gg.w) * v.w);
      }
    }
    __syncthreads();
  };
  gemm_stream(K, K, K, smem, ptrs, epi);
}

DI void phase_gu(const Params& p, int l, unsigned char* smem) {
  const int tid = otid(), lane = tid & 63, w = tid >> 6;
  const int wm = w >> 2, wn = w & 3, r = lane & 31, h = lane >> 5;
  const int lrow = tid >> 3, lcc = tid & 7, brow = 2 * (lrow & 31) + ((lrow >> 5) & 1);
  u16* ACT = (u16*)(p.ws + WS_ACT);
  const u16* Hh = (const u16*)(p.ws + WS_H);
  const u16* Wb = (const u16*)(p.ws + WS_WT_GU) + (size_t)l * 5632 * 1024;
  float* stg = (float*)(smem + GS_BASE + GS_STAGE);
  const int NT = 22, MT = 257;
  auto ptrs = [&](int it, const u16*& ap, const u16*& bp) -> bool {
    int mt, nt;
    if (!tile_of(it, MT, NT, mt, nt)) return false;
    ap = Hh + (size_t)(mt * 256 + lrow) * 1024 + lcc * 8;
    bp = Wb + (size_t)(nt * 256 + brow) * 1024 + lcc * 8;
    return true;
  };
  auto epi = [&](int it, f32x16 (&acc)[4][2]) {
    int mt, nt;
    tile_of(it, MT, NT, mt, nt);
    const int m0 = mt * 256, n0 = nt * 256;
#pragma unroll
    for (int mi = 0; mi < 4; ++mi) {
      __syncthreads();
      stage_rm(acc[mi][0], acc[mi][1], stg, wm, wn, r, h);
      __syncthreads();
#pragma unroll
      for (int q = 0; q < 2; ++q) {
        const int cid = q * NTHR + tid, lr = cid >> 4, c16 = (cid & 15) * 16;
        const float4 v0 = *(const float4*)(stg + lr * EP_LD + c16);
        const float4 v1 = *(const float4*)(stg + lr * EP_LD + c16 + 4);
        const float4 v2 = *(const float4*)(stg + lr * EP_LD + c16 + 8);
        const float4 v3 = *(const float4*)(stg + lr * EP_LD + c16 + 12);
        const int row = grow_of(m0, mi, lr);
        uint4 o;
        o.x = pack2(siluf_(v0.x) * v0.y, siluf_(v0.z) * v0.w);
        o.y = pack2(siluf_(v1.x) * v1.y, siluf_(v1.z) * v1.w);
        o.z = pack2(siluf_(v2.x) * v2.y, siluf_(v2.z) * v2.w);
        o.w = pack2(siluf_(v3.x) * v3.y, siluf_(v3.z) * v3.w);
        *(uint4*)(ACT + (size_t)row * 2816 + (n0 >> 1) + (c16 >> 1)) = o;
      }
    }
    __syncthreads();
  };
  gemm_stream(1024, 1024, 1024, smem, ptrs, epi);
}

constexpr int AT_BASE = 64;
constexpr int AT_KBYTES = 64 * 272;
constexpr int AT_VBYTES = 128 * 136;
constexpr int AT_STAGE = AT_KBYTES + AT_VBYTES;

DI void attn_item(const Params& p, int l, int b, int head, int qt, float lam, float lam_init, unsigned char* smem) {
  const int tid = otid(), lane = tid & 63, w = tid >> 6, r = lane & 31, h = lane >> 5;
  const int comp = w & 1, rg = w >> 1;
  const bool prompt = b < 32;
  const int bs = b - 32;
  const u16* Kg = prompt ? (const u16*)(p.ws + WS_KB) + (size_t)b * 2048 * 512 : (const u16*)(p.ws + WS_KS) + (size_t)(l * 8 + bs) * 1056 * 512;
  const u16* Vg = prompt ? (const u16*)(p.ws + WS_VTP) + (size_t)b * 512 * 2048 : (const u16*)(p.ws + WS_VTS) + (size_t)(l * 8 + bs) * 512 * 1056;
  const int ldT = prompt ? 2048 : 1056;
  const int nkt = prompt ? 2 * qt + 2 : 17;
  const int nkeys = prompt ? 2048 : 1056;
  const int qtok0 = prompt ? b * 2048 + qt * 128 : TOKP + bs * 32;
  const int qpos0 = prompt ? qt * 128 : 1024;
  const bool active = prompt || rg == 0;
  const int my_nkt = prompt ? (rg < 2 ? nkt - 1 : nkt) : nkt;
  const u16* ZQ = (const u16*)(p.ws + WS_ZQ);
  bf16x8 qf[4];
  {
    const int qrow = active ? qtok0 + rg * 32 + r : qtok0;
#pragma unroll
    for (int ks = 0; ks < 4; ++ks) qf[ks] = *(const bf16x8*)(ZQ + (size_t)qrow * 512 + head * 128 + comp * 64 + ks * 16 + h * 8);
  }
  const float slope2 = exp2f(-2.f * (head + 1)) * LOG2E;
  const float c1 = 0.125f * LOG2E;
  const int qpos = qpos0 + rg * 32 + r;
  f32x16 O[4];
#pragma unroll
  for (int i = 0; i < 4; ++i) zero16(O[i]);
  float m_run = -INFINITY, l_run = 0.f;

  const int krow = tid >> 4, kcc = tid & 15;
  const int vrow = tid >> 3, vcc = tid & 7;
  const u16* kp = Kg + (size_t)((nkt - 1) * 64 + krow) * 512 + head * 128 + kcc * 8;
  const u16* vp = Vg + (size_t)(head * 128 + vrow) * ldT + (nkt - 1) * 64 + vcc * 8;
  uint4 rk0, rk1, rv0, rv1;
  unsigned char* sb = smem + AT_BASE;
  rk0 = *(const uint4*)kp; rk1 = *(const uint4*)(kp + 32 * 512);
  rv0 = *(const uint4*)vp; rv1 = *(const uint4*)(vp + (size_t)64 * ldT);
  {
    *(uint4*)(sb + krow * 272 + kcc * 16) = rk0;
    *(uint4*)(sb + (krow + 32) * 272 + kcc * 16) = rk1;
    *(uint2*)(sb + AT_KBYTES + vrow * 136 + vcc * 16) = make_uint2(rv0.x, rv0.y);
    *(uint2*)(sb + AT_KBYTES + vrow * 136 + vcc * 16 + 8) = make_uint2(rv0.z, rv0.w);
    *(uint2*)(sb + AT_KBYTES + (vrow + 64) * 136 + vcc * 16) = make_uint2(rv1.x, rv1.y);
    *(uint2*)(sb + AT_KBYTES + (vrow + 64) * 136 + vcc * 16 + 8) = make_uint2(rv1.z, rv1.w);
  }
  __syncthreads();
  for (int j = 0; j < nkt; ++j) {
    const int kt = nkt - 1 - j;
    const bool more = j + 1 < nkt;
    if (more) {
      kp -= 64 * 512; vp -= 64;
      rk0 = *(const uint4*)kp; rk1 = *(const uint4*)(kp + 32 * 512);
      rv0 = *(const uint4*)vp; rv1 = *(const uint4*)(vp + (size_t)64 * ldT);
    }
    if (active && kt < my_nkt) {
      const unsigned char* Kt = sb + (j & 1) * AT_STAGE;
      const unsigned char* Vt = Kt + AT_KBYTES;
      f32x16 s[2];
      zero16(s[0]); zero16(s[1]);
#pragma unroll
      for (int ks = 0; ks < 4; ++ks) {
#pragma unroll
        for (int sub = 0; sub < 2; ++sub) {
          const bf16x8 kf = *(const bf16x8*)(Kt + (sub * 32 + r) * 272 + (comp * 64 + ks * 16 + h * 8) * 2);
          s[sub] = MFMA(kf, qf[ks], s[sub]);
        }
      }
      float mx = -INFINITY;
      const float qk0 = (float)(qpos - kt * 64 - 4 * h);
#pragma unroll
      for (int sub = 0; sub < 2; ++sub)
#pragma unroll
        for (int i = 0; i < 16; ++i) {
          const float d = qk0 - (float)(sub * 32 + (i & 3) + 8 * (i >> 2));
          float v = s[sub][i] * c1 - slope2 * fabsf(d);
          s[sub][i] = v;
        }
      if (!prompt) {
#pragma unroll
        for (int sub = 0; sub < 2; ++sub)
#pragma unroll
          for (int i = 0; i < 16; ++i) {
            const int key = kt * 64 + sub * 32 + crow(i, h);
            if (key >= nkeys) s[sub][i] = -INFINITY;
          }
      }
#pragma unroll
      for (int sub = 0; sub < 2; ++sub)
#pragma unroll
        for (int i = 0; i < 16; ++i) mx = fmaxf(mx, s[sub][i]);
      mx = fmaxf(mx, shx(mx, 32, lane));
      const bool livelane = !(mx - m_run < -150.f);
      if (__ballot(livelane) != 0ull) {
        const float m_new = fmaxf(m_run, mx);
        const float alpha = fexp2(m_run - m_new);
        m_run = m_new;
        float lsum = 0.f;
#pragma unroll
        for (int sub = 0; sub < 2; ++sub)
#pragma unroll
          for (int i = 0; i < 16; ++i) {
            const float pv = fexp2(s[sub][i] - m_new);
            lsum += pv;
            s[sub][i] = pv;
          }
        l_run = l_run * alpha + lsum;
        if (__ballot(alpha != 1.f) != 0ull) {
#pragma unroll
          for (int dt = 0; dt < 4; ++dt)
#pragma unroll
            for (int i = 0; i < 16; ++i) O[dt][i] *= alpha;
        }
#pragma unroll
        for (int sub = 0; sub < 2; ++sub)
#pragma unroll
          for (int s2 = 0; s2 < 2; ++s2) {
            const bf16x8 pf = pack8(s[sub], s2);
#pragma unroll
            for (int dt = 0; dt < 4; ++dt) {
              const unsigned char* va = Vt + (dt * 32 + r) * 136 + (sub * 32 + s2 * 16 + 4 * h) * 2;
              const uint2 lo = *(const uint2*)va;
              const uint2 hi = *(const uint2*)(va + 16);
              const uint4 vv = make_uint4(lo.x, lo.y, hi.x, hi.y);
              O[dt] = MFMA(__builtin_bit_cast(bf16x8, vv), pf, O[dt]);
            }
          }
      }
    }
    if (more) {
      unsigned char* sn = sb + ((j + 1) & 1) * AT_STAGE;
      *(uint4*)(sn + krow * 272 + kcc * 16) = rk0;
      *(uint4*)(sn + (krow + 32) * 272 + kcc * 16) = rk1;
      *(uint2*)(sn + AT_KBYTES + vrow * 136 + vcc * 16) = make_uint2(rv0.x, rv0.y);
      *(uint2*)(sn + AT_KBYTES + vrow * 136 + vcc * 16 + 8) = make_uint2(rv0.z, rv0.w);
      *(uint2*)(sn + AT_KBYTES + (vrow + 64) * 136 + vcc * 16) = make_uint2(rv1.x, rv1.y);
      *(uint2*)(sn + AT_KBYTES + (vrow + 64) * 136 + vcc * 16 + 8) = make_uint2(rv1.z, rv1.w);
    }
    __syncthreads();
  }
  float* exch = (float*)(smem + AT_BASE);
  float inv = 0.f;
  if (active) { const float lt = l_run + shx(l_run, 32, lane); inv = 1.f / lt; }
  if (active && comp == 1) {
    const float sc = inv * lam;
#pragma unroll
    for (int dt = 0; dt < 4; ++dt)
#pragma unroll
      for (int i = 0; i < 16; ++i) exch[(rg * 64 + dt * 16 + i) * 64 + lane] = O[dt][i] * sc;
  }
  __syncthreads();
  if (active && comp == 0) {
    float ss = 0.f;
#pragma unroll
    for (int dt = 0; dt < 4; ++dt)
#pragma unroll
      for (int i = 0; i < 16; ++i) {
        const float o = O[dt][i] * inv - exch[(rg * 64 + dt * 16 + i) * 64 + lane];
        O[dt][i] = o;
        ss += o * o;
      }
    ss += shx(ss, 32, lane);
    const float rs = rsqrtf(ss * (1.f / 128.f) + LN_EPS) * (1.f - lam_init);
    u16* AN = (u16*)(p.ws + WS_AN) + (size_t)(qtok0 + rg * 32 + r) * 512 + head * 128;
    const float* gw = p.in[17] + l * 512 + head * 128;
#pragma unroll
    for (int dt = 0; dt < 4; ++dt)
#pragma unroll
      for (int g = 0; g < 4; ++g) {
        const int dv = dt * 32 + 8 * g + 4 * h;
        const float4 g4 = *(const float4*)(gw + dv);
        uint2 o;
        o.x = pack2(O[dt][4 * g] * rs * g4.x, O[dt][4 * g + 1] * rs * g4.y);
        o.y = pack2(O[dt][4 * g + 2] * rs * g4.z, O[dt][4 * g + 3] * rs * g4.w);
        *(uint2*)(AN + dv) = o;
      }
  }
}

constexpr int ML_QS = 64;
constexpr int ML_KS = ML_QS + 64 * 272;
constexpr int ML_KT = ML_KS + 64 * 272;
constexpr int ML_VT = ML_KT + 128 * 144;
constexpr int ML_CB = ML_VT + 128 * 144;
constexpr int ML_HB = ML_CB + 128 * 272;
constexpr int ML_SM = ML_HB + 64 * 132 * 4;
static_assert(ML_SM + 528 * 4 <= LDS_BYTES, "lds");

DI void mlstm_item(const Params& p, int l, int b, int head, unsigned char* smem) {
  const int tid = otid(), lane = tid & 63, w = tid >> 6, r = lane & 31, h = lane >> 5;
  const bool prompt = b < 32;
  const int bs = b - 32;
  const int T = prompt ? 2048 : 32;
  const int nch = prompt ? 32 : 1;
  const int L = prompt ? 64 : 32;
  const int tokbase = prompt ? b * 2048 : TOKP + bs * 32;
  const u16* qkT = prompt ? (const u16*)(p.ws + WS_MQKT_P) + (size_t)b * 1024 * 2048 : (const u16*)(p.ws + WS_MQKT_S) + (size_t)bs * 1024 * 32;
  const u16* vTg = prompt ? (const u16*)(p.ws + WS_MVT_P) + (size_t)b * 512 * 2048 : (const u16*)(p.ws + WS_MVT_S) + (size_t)bs * 512 * 32;
  u16* qs = (u16*)(smem + ML_QS);
  u16* ksm = (u16*)(smem + ML_KS);
  u16* kTw = (u16*)(smem + ML_KT);
  u16* vT = (u16*)(smem + ML_VT);
  u16* Cbf = (u16*)(smem + ML_CB);
  float* hbuf = (float*)(smem + ML_HB);
  float* a_s = (float*)(smem + ML_SM);
  float* mx_s = a_s + 64;
  float* ws_s = a_s + 128;
  float* wi_s = a_s + 192;
  float* emt_s = a_s + 256;
  float* nq_s = a_s + 320;
  float* nvec = a_s + 384;
  float* scal = a_s + 512;

  const int vt = w & 3, kt0 = (w >> 2) * 2;
  f32x16 accC[2];
  float m_run = 0.f;
  if (prompt) {
    zero16(accC[0]); zero16(accC[1]);
    if (tid < 128) nvec[tid] = 0.f;
  } else {
    const float* Cs = p.in[6] + ((size_t)(l * 8 + bs) * 4 + head) * 128 * 128;
#pragma unroll
    for (int q = 0; q < 2; ++q)
#pragma unroll
      for (int g = 0; g < 4; ++g) {
        const float4 c4 = *(const float4*)(Cs + (size_t)(vt * 32 + r) * 128 + (kt0 + q) * 32 + 8 * g + 4 * h);
        accC[q][4 * g] = c4.x; accC[q][4 * g + 1] = c4.y; accC[q][4 * g + 2] = c4.z; accC[q][4 * g + 3] = c4.w;
      }
    if (tid < 128) nvec[tid] = p.in[7][((size_t)(l * 8 + bs) * 4 + head) * 128 + tid];
    m_run = p.in[8][(l * 8 + bs) * 4 + head];
  }
#pragma unroll
  for (int q = 0; q < 2; ++q)
#pragma unroll
    for (int g = 0; g < 4; ++g) {
      uint2 o; o.x = pack2(accC[q][4 * g], accC[q][4 * g + 1]); o.y = pack2(accC[q][4 * g + 2], accC[q][4 * g + 3]);
      *(uint2*)(Cbf + (vt * 32 + r) * 136 + (kt0 + q) * 32 + 8 * g + 4 * h) = o;
    }
  const float* gatesp = (const float*)(p.ws + WS_GATES);
  const int vi = w >> 1, ti = w & 1;

  for (int c = 0; c < nch; ++c) {
    const int t0 = c * 64;
    if (w == 0) {
      const int t = lane;
      float ig = -INFINITY, lf = 0.f;
      if (t < L) {
        const float* gp = gatesp + (size_t)(tokbase + t0 + t) * 8;
        ig = gp[head];
        const float fg = gp[4 + head];
        lf = fminf(fg, 0.f) - log1pf(__expf(-fabsf(fg)));
      }
      float bc = lf;
#pragma unroll
      for (int off = 1; off < 64; off <<= 1) { const float v = shidx(bc, lane - off, lane); if (lane >= off) bc += v; }
      const float a = ig - bc;
      float M = a;
#pragma unroll
      for (int off = 1; off < 64; off <<= 1) { const float v = shidx(M, lane - off, lane); if (lane >= off) M = fmaxf(M, v); }
      const float mx = fmaxf(m_run, M);
      const float bL = shidx(bc, 63, lane);
      const float mxL = shidx(mx, 63, lane);
      a_s[t] = a; mx_s[t] = mx;
      ws_s[t] = __expf(a - mxL);
      wi_s[t] = __expf(m_run - mx);
      emt_s[t] = __expf(-(bc + mx));
      if (lane == 0) scal[1] = __expf(m_run - mxL);
      m_run = bL + mxL;
    }
    const int ch2 = tid >> 1, th = tid & 1;
    const bool isk = ch2 >= 128;
    const int dd = ch2 & 127;
    const int ch = (isk ? 512 : 0) + head * 128 + dd;
    const u16* rp = qkT + (size_t)ch * T + t0 + th * 32;
    float um3 = 0.f, um2 = 0.f, um1 = 0.f;
    const bool ldrow = prompt || th == 0;
    if (prompt) {
      if (th == 1 || c > 0) {
        const uint2 pv = *(const uint2*)(rp - 4);
        um3 = bfhi(pv.x); um2 = bflo(pv.y); um1 = bfhi(pv.y);
      }
    } else if (th == 0) {
      const float* cvp = p.in[9] + (size_t)(l * 8 + bs) * 3 * 1024 + ch;
      um3 = cvp[0]; um2 = cvp[1024]; um1 = cvp[2048];
    }
    const float cw0 = p.in[14][(l * 4 + 0) * 1024 + ch], cw1 = p.in[14][(l * 4 + 1) * 1024 + ch];
    const float cw2 = p.in[14][(l * 4 + 2) * 1024 + ch], cw3 = p.in[14][(l * 4 + 3) * 1024 + ch];
    const float cb = p.in[15][l * 1024 + ch];
    __syncthreads();
    {
      u16* dstrm = (isk ? ksm : qs) + (th * 32) * 136 + dd;
      const float oscale = isk ? 0.08838834764831845f : 1.f;
#pragma unroll 1
      for (int i = 0; i < 4; ++i) {
        uint4 uu = make_uint4(0, 0, 0, 0);
        if (ldrow) uu = *(const uint4*)(rp + i * 8);
        float u[8];
        u[0] = bflo(uu.x); u[1] = bfhi(uu.x); u[2] = bflo(uu.y); u[3] = bfhi(uu.y);
        u[4] = bflo(uu.z); u[5] = bfhi(uu.z); u[6] = bflo(uu.w); u[7] = bfhi(uu.w);
        float y[8];
#pragma unroll
        for (int e = 0; e < 8; ++e) {
          const float x3 = (e >= 3) ? u[e - 3] : (e == 0 ? um3 : (e == 1 ? um2 : um1));
          const float x2 = (e >= 2) ? u[e - 2] : (e == 0 ? um2 : um1);
          const float x1 = (e >= 1) ? u[e - 1] : um1;
          const float yy = cb + cw0 * x3 + cw1 * x2 + cw2 * x1 + cw3 * u[e];
          y[e] = siluf_(yy) * oscale;
        }
        um3 = u[5]; um2 = u[6]; um1 = u[7];
#pragma unroll
        for (int e = 0; e < 8; ++e) dstrm[(i * 8 + e) * 136] = f2bf(y[e]);
        if (isk) {
          const float4 w0 = *(const float4*)(ws_s + th * 32 + i * 8);
          const float4 w1 = *(const float4*)(ws_s + th * 32 + i * 8 + 4);
          uint4 o;
          o.x = pack2(y[0] * w0.x, y[1] * w0.y); o.y = pack2(y[2] * w0.z, y[3] * w0.w);
          o.z = pack2(y[4] * w1.x, y[5] * w1.y); o.w = pack2(y[6] * w1.z, y[7] * w1.w);
          *(uint4*)(kTw + dd * 72 + th * 32 + i * 8) = o;
        }
      }
#pragma unroll
      for (int i = 0; i < 2; ++i) {
        const int id = tid + 512 * i, row = id >> 3, cc = id & 7;
        uint4 vv = make_uint4(0, 0, 0, 0);
        if (prompt || cc < 4) vv = *(const uint4*)(vTg + (size_t)(head * 128 + row) * T + t0 + cc * 8);
        *(uint4*)(vT + row * 72 + cc * 8) = vv;
      }
    }
    __syncthreads();
    {
      const int t = tid >> 3, part = tid & 7;
      const uint4 q0 = *(const uint4*)(qs + t * 136 + part * 16);
      const uint4 q1 = *(const uint4*)(qs + t * 136 + part * 16 + 8);
      const float* nv = nvec + part * 16;
      float s = bflo(q0.x) * nv[0] + bfhi(q0.x) * nv[1] + bflo(q0.y) * nv[2] + bfhi(q0.y) * nv[3]
              + bflo(q0.z) * nv[4] + bfhi(q0.z) * nv[5] + bflo(q0.w) * nv[6] + bfhi(q0.w) * nv[7]
              + bflo(q1.x) * nv[8] + bfhi(q1.x) * nv[9] + bflo(q1.y) * nv[10] + bfhi(q1.y) * nv[11]
              + bflo(q1.z) * nv[12] + bfhi(q1.z) * nv[13] + bflo(q1.w) * nv[14] + bfhi(q1.w) * nv[15];
      s += shx(s, 1, lane); s += shx(s, 2, lane); s += shx(s, 4, lane);
      if (part == 0) nq_s[t] = s;
    }
    f32x16 accS[2], accO;
    zero16(accS[0]); zero16(accS[1]); zero16(accO);
    {
#pragma unroll
      for (int ks = 0; ks < 8; ++ks) {
        const bf16x8 qfr = *(const bf16x8*)(qs + (ti * 32 + r) * 136 + ks * 16 + h * 8);
        const bf16x8 k0 = *(const bf16x8*)(ksm + r * 136 + ks * 16 + h * 8);
        accS[0] = MFMA(k0, qfr, accS[0]);
        if (ti == 1) {
          const bf16x8 k1 = *(const bf16x8*)(ksm + (32 + r) * 136 + ks * 16 + h * 8);
          accS[1] = MFMA(k1, qfr, accS[1]);
        }
        const bf16x8 cf = *(const bf16x8*)(Cbf + (vi * 32 + r) * 136 + ks * 16 + h * 8);
        accO = MFMA(cf, qfr, accO);
      }
    }
    const int tcol = ti * 32 + r;
    const float mxt = mx_s[tcol];
    const float wit = wi_s[tcol];
    float dsum = 0.f;
#pragma unroll
    for (int sub = 0; sub < 2; ++sub) {
      if (sub <= ti) {
#pragma unroll
        for (int g = 0; g < 4; ++g) {
          const float4 a4 = *(const float4*)(a_s + sub * 32 + 8 * g + 4 * h);
          const float av[4] = {a4.x, a4.y, a4.z, a4.w};
#pragma unroll
          for (int e = 0; e < 4; ++e) {
            const int s = sub * 32 + 8 * g + 4 * h + e;
            const float wgt = (s <= tcol) ? __expf(av[e] - mxt) : 0.f;
            const float pv = accS[sub][4 * g + e] * wgt;
            accS[sub][4 * g + e] = pv;
            dsum += pv;
          }
        }
      }
    }
    dsum += shx(dsum, 32, lane);
#pragma unroll
    for (int i = 0; i < 16; ++i) accO[i] *= wit;
#pragma unroll
    for (int sub = 0; sub < 2; ++sub) {
      if (sub <= ti) {
#pragma unroll
        for (int s2 = 0; s2 < 2; ++s2) {
          const bf16x8 pf = pack8(accS[sub], s2);
          const u16* va = vT + (vi * 32 + r) * 72 + sub * 32 + s2 * 16 + 4 * h;
          const uint2 lo = *(const uint2*)va;
          const uint2 hi = *(const uint2*)(va + 8);
          const uint4 vq = make_uint4(lo.x, lo.y, hi.x, hi.y);
          accO = MFMA(__builtin_bit_cast(bf16x8, vq), pf, accO);
        }
      }
    }
    __syncthreads();
    {
      const float den = dsum + wit * nq_s[tcol];
      const float dn = fmaxf(fabsf(den), emt_s[tcol]);
      const float rinv = 1.f / dn;
#pragma unroll
      for (int g = 0; g < 4; ++g)
        *(float4*)(hbuf + tcol * 132 + vi * 32 + 8 * g + 4 * h) =
            make_float4(accO[4 * g] * rinv, accO[4 * g + 1] * rinv, accO[4 * g + 2] * rinv, accO[4 * g + 3] * rinv);
    }
    {
      const float wc = scal[1];
#pragma unroll
      for (int q = 0; q < 2; ++q)
#pragma unroll
        for (int i = 0; i < 16; ++i) accC[q][i] *= wc;
#pragma unroll
      for (int k4 = 0; k4 < 4; ++k4) {
        const bf16x8 vf = *(const bf16x8*)(vT + (vt * 32 + r) * 72 + k4 * 16 + h * 8);
#pragma unroll
        for (int q = 0; q < 2; ++q) {
          const bf16x8 kf = *(const bf16x8*)(kTw + ((kt0 + q) * 32 + r) * 72 + k4 * 16 + h * 8);
          accC[q] = MFMA(kf, vf, accC[q]);
        }
      }
#pragma unroll
      for (int q = 0; q < 2; ++q)
#pragma unroll
        for (int g = 0; g < 4; ++g) {
          uint2 o; o.x = pack2(accC[q][4 * g], accC[q][4 * g + 1]); o.y = pack2(accC[q][4 * g + 2], accC[q][4 * g + 3]);
          *(uint2*)(Cbf + (vt * 32 + r) * 136 + (kt0 + q) * 32 + 8 * g + 4 * h) = o;
        }
      if (tid < 128) {
        float s = 0.f;
#pragma unroll
        for (int i = 0; i < 8; ++i) {
          const uint4 kk = *(const uint4*)(kTw + tid * 72 + i * 8);
          s += bflo(kk.x) + bfhi(kk.x) + bflo(kk.y) + bfhi(kk.y) + bflo(kk.z) + bfhi(kk.z) + bflo(kk.w) + bfhi(kk.w);
        }
        nvec[tid] = wc * nvec[tid] + s;
      }
    }
    __syncthreads();
    {
      const int t = tid >> 3, part = tid & 7;
      float x[16];
#pragma unroll
      for (int i = 0; i < 4; ++i) {
        const float4 f = *(const float4*)(hbuf + t * 132 + part * 16 + i * 4);
        x[i * 4] = f.x; x[i * 4 + 1] = f.y; x[i * 4 + 2] = f.z; x[i * 4 + 3] = f.w;
      }
      float s = 0.f;
#pragma unroll
      for (int i = 0; i < 16; ++i) s += x[i];
      s += shx(s, 1, lane); s += shx(s, 2, lane); s += shx(s, 4, lane);
      const float mean = s * (1.f / 128.f);
      float q = 0.f;
#pragma unroll
      for (int i = 0; i < 16; ++i) { x[i] -= mean; q += x[i] * x[i]; }
      q += shx(q, 1, lane); q += shx(q, 2, lane); q += shx(q, 4, lane);
      const float rstd = rsqrtf(q * (1.f / 128.f) + LN_EPS);
      if (t < L) {
        const size_t tok = (size_t)tokbase + t0 + t;
        const int cbase = head * 128 + part * 16;
        const float* gw = p.in[18] + l * 512 + cbase;
        const u16* mo = (const u16*)(p.ws + WS_MO) + tok * 512 + cbase;
        const uint4 m0 = *(const uint4*)mo;
        const uint4 m1 = *(const uint4*)(mo + 8);
        const float sg[16] = {bflo(m0.x), bfhi(m0.x), bflo(m0.y), bfhi(m0.y), bflo(m0.z), bfhi(m0.z), bflo(m0.w), bfhi(m0.w),
                              bflo(m1.x), bfhi(m1.x), bflo(m1.y), bfhi(m1.y), bflo(m1.z), bfhi(m1.z), bflo(m1.w), bfhi(m1.w)};
        float yv[16];
#pragma unroll
        for (int i = 0; i < 16; ++i) yv[i] = x[i] * rstd * gw[i] * sg[i];
        uint4 o0, o1;
        o0.x = pack2(yv[0], yv[1]); o0.y = pack2(yv[2], yv[3]); o0.z = pack2(yv[4], yv[5]); o0.w = pack2(yv[6], yv[7]);
        o1.x = pack2(yv[8], yv[9]); o1.y = pack2(yv[10], yv[11]); o1.z = pack2(yv[12], yv[13]); o1.w = pack2(yv[14], yv[15]);
        u16* mn = (u16*)(p.ws + WS_MN) + tok * 512 + cbase;
        *(uint4*)mn = o0;
        *(uint4*)(mn + 8) = o1;
      }
    }
  }
  {
    float* oc = p.out + (prompt ? O_CP + ((size_t)(l * 32 + b) * 4 + head) * 16384 : O_CS + ((size_t)(l * 8 + bs) * 4 + head) * 16384);
#pragma unroll
    for (int q = 0; q < 2; ++q)
#pragma unroll
      for (int g = 0; g < 4; ++g)
        *(float4*)(oc + (size_t)(vt * 32 + r) * 128 + (kt0 + q) * 32 + 8 * g + 4 * h) =
            make_float4(accC[q][4 * g], accC[q][4 * g + 1], accC[q][4 * g + 2], accC[q][4 * g + 3]);
    float* on = p.out + (prompt ? O_NP + ((size_t)(l * 32 + b) * 4 + head) * 128 : O_NS + ((size_t)(l * 8 + bs) * 4 + head) * 128);
    if (tid < 128) on[tid] = nvec[tid];
    if (tid == 0) {
      if (prompt) p.out[O_MP + (size_t)(l * 32 + b) * 4 + head] = m_run;
      else p.out[O_MS + (size_t)(l * 8 + bs) * 4 + head] = m_run;
    }
  }
}

DI void phase_mixers(const Params& p, int l, unsigned char* smem) {
  const int tid0 = otid();
  const int lane = tid0 & 63;
  const float* lp = p.in[16] + l * 256;
  float s1 = lp[lane] * lp[64 + lane], s2 = lp[128 + lane] * lp[192 + lane];
  s1 = wave_sum(s1, lane); s2 = wave_sum(s2, lane);
  const float lam_init = 0.8f - 0.6f * expf(-0.3f * (float)l);
  const float lam = expf(s1) - expf(s2) + lam_init;
  int* ctr = (int*)(p.ws + WS_CTR) + l;
  int* sitem = (int*)smem;
  const int N_ML = 160, N_AT = 2048 + 32;
  for (;;) {
    __syncthreads();
    if (tid0 == 0) *sitem = atomicAdd(ctr, 1);
    __syncthreads();
    const int item = *sitem;
    if (item >= N_ML + N_AT) break;
    if (item < N_ML) {
#ifndef NO_ML
      mlstm_item(p, l, item >> 2, item & 3, smem);
#endif
    } else {
#ifndef NO_AT
      const int a = item - N_ML;
      if (a < 2048) {
        const int qt = 15 - (a >> 7), rest = a & 127;
        attn_item(p, l, rest >> 2, rest & 3, qt, lam, lam_init, smem);
      } else {
        const int s = a - 2048;
        attn_item(p, l, 32 + (s >> 2), s & 3, 0, lam, lam_init, smem);
      }
#endif
    }
  }
}

DI void gbar(unsigned* bar, unsigned& epoch) {
  __syncthreads();
  epoch += gridDim.x;
  if (otid() == 0) {
    __threadfence();
    __hip_atomic_fetch_add(bar, 1u, __ATOMIC_RELAXED, __HIP_MEMORY_SCOPE_AGENT);
    while (__hip_atomic_load(bar, __ATOMIC_RELAXED, __HIP_MEMORY_SCOPE_AGENT) < epoch) __builtin_amdgcn_s_sleep(2);
    __threadfence();
  }
  __syncthreads();
}

__global__ void __launch_bounds__(NTHR) fwd_megakernel(Params p) {
  extern __shared__ __attribute__((aligned(16))) unsigned char smem[];
  cg::grid_group grid = cg::this_grid();
#ifndef PH
#define PH 0xffff
#endif
  unsigned* bar = (unsigned*)(p.ws + WS_CTR + 64);
  unsigned epoch = 0;
  if (PH & 1) prologue(p, smem);
  grid.sync();
  if (PH & 1) prologue(p, smem);
  grid.sync();
  if (PH & 2) ln_pass(p, 0, 0, smem);
  gbar(bar, epoch);
#pragma unroll 1
  for (int l = 0; l < 2; ++l) {
    if (PH & 4) phase_in_gate(p, l, smem);
    gbar(bar, epoch);
    if (PH & 8) phase_mixers(p, l, smem);
    gbar(bar, epoch);
    if (PH & 16) phase_mix(p, l, smem);
    gbar(bar, epoch);
    if (PH & 32) phase_res(p, l, 0, smem);
    gbar(bar, epoch);
    if (PH & 64) ln_pass(p, 1, l, smem);
    gbar(bar, epoch);
    if (PH & 128) phase_gu(p, l, smem);
    gbar(bar, epoch);
    if (PH & 256) phase_res(p, l, 1, smem);
    gbar(bar, epoch);
    if (PH & 512) ln_pass(p, 2, l, smem);
    if (l == 0) gbar(bar, epoch);
  }
}

extern "C" void kernel_launch(void* const* d_in, const int* in_sizes, int n_in, void* d_out, int out_size, void* d_ws,
                              size_t ws_size, hipStream_t stream) {
  static int grid_blocks = 0;
  if (!grid_blocks) {
    int dev = 0, cus = 0, per_cu = 0;
    hipGetDevice(&dev);
    hipDeviceGetAttribute(&cus, hipDeviceAttributeMultiprocessorCount, dev);
    if (hipFuncSetAttribute((const void*)fwd_megakernel, hipFuncAttributeMaxDynamicSharedMemorySize, LDS_BYTES) != hipSuccess)
      fprintf(stderr, "kernel_launch: hipFuncSetAttribute failed\n");
    if (hipOccupancyMaxActiveBlocksPerMultiprocessor(&per_cu, (const void*)fwd_megakernel, NTHR, LDS_BYTES) != hipSuccess || per_cu < 1) {
      fprintf(stderr, "kernel_launch: occupancy query gave %d\n", per_cu);
      per_cu = 1;
    }
    (void)hipGetLastError();
    grid_blocks = cus * per_cu;
    if (ws_size < WS_END) fprintf(stderr, "kernel_launch: workspace too small: %zu < %zu\n", ws_size, (size_t)WS_END);
  }
  if (hipMemsetAsync((char*)d_ws + WS_CTR, 0, 256, stream) != hipSuccess) fprintf(stderr, "kernel_launch: memset failed\n");
  Params p{};
  for (int i = 0; i < 30; ++i) p.in[i] = (const float*)d_in[i];
  p.out = (float*)d_out;
  p.ws = (unsigned char*)d_ws;
  void* args[] = {&p};
  hipError_t e = hipLaunchCooperativeKernel((const void*)fwd_megakernel, dim3(grid_blocks), dim3(NTHR), args, LDS_BYTES, stream);
  if (e != hipSuccess) fprintf(stderr, "cooperative launch failed: %s (grid %d)\n", hipGetErrorString(e), grid_blocks);
}
```

```cpp
#include <hip/hip_runtime.h>
#include <hip/hip_cooperative_groups.h>
#include <cstdio>
namespace cg = cooperative_groups;

#define DI __device__ __forceinline__
typedef unsigned short u16;
using bf16x8 = __attribute__((ext_vector_type(8))) short;
using f32x16 = __attribute__((ext_vector_type(16))) float;
#define MFMA(a, b, c) __builtin_amdgcn_mfma_f32_32x32x16_bf16((a), (b), (c), 0, 0, 0)

constexpr int TOKP = 65536, TOKS = 256, TOK = 65792;
constexpr int NTHR = 512;
constexpr float LN_EPS = 1e-5f;
constexpr float ALPHA = 1.41421356237f;
constexpr float LOG2E = 1.44269504089f;

constexpr size_t WS_WT_IN   = 0;
constexpr size_t WS_WT_GATE = WS_WT_IN + 2ull * 3584 * 1024 * 2;
constexpr size_t WS_WT_BRA  = WS_WT_GATE + 2ull * 2048 * 1024 * 2;
constexpr size_t WS_WT_BRB  = WS_WT_BRA + 2ull * 1024 * 512 * 2;
constexpr size_t WS_WT_O    = WS_WT_BRB + 2ull * 1024 * 512 * 2;
constexpr size_t WS_WT_GU   = WS_WT_O + 2ull * 1024 * 1024 * 2;
constexpr size_t WS_WT_DOWN = WS_WT_GU + 2ull * 5632 * 1024 * 2;
constexpr size_t WS_MOD     = WS_WT_DOWN + 2ull * 1024 * 2816 * 2;
constexpr size_t WS_GATES   = WS_MOD + 2ull * 40 * 6144 * 4;
constexpr size_t WS_CTR     = WS_GATES + (size_t)TOK * 8 * 4;
constexpr size_t WS_KS      = WS_CTR + 256;
constexpr size_t WS_VTS     = WS_KS + 2ull * 8 * 1056 * 512 * 2 + 65536;
constexpr size_t WS_MQKT_S  = WS_VTS + 2ull * 8 * 512 * 1056 * 2 + 65536;
constexpr size_t WS_MVT_S   = WS_MQKT_S + 8ull * 1024 * 32 * 2;
constexpr size_t WS_H       = WS_MVT_S + 8ull * 512 * 32 * 2;
constexpr size_t WS_AN      = WS_H;
constexpr size_t WS_MN      = WS_H + (size_t)TOK * 512 * 2;
constexpr size_t WS_ZQ      = WS_H + (size_t)TOK * 1024 * 2;
constexpr size_t WS_KB      = WS_ZQ + (size_t)TOK * 512 * 2;
constexpr size_t WS_VTP     = WS_KB + (size_t)TOKP * 512 * 2;
constexpr size_t WS_MQKT_P  = WS_VTP + 32ull * 512 * 2048 * 2;
constexpr size_t WS_MVT_P   = WS_MQKT_P + 32ull * 1024 * 2048 * 2;
constexpr size_t WS_MO      = WS_MVT_P + 32ull * 512 * 2048 * 2;
constexpr size_t WS_G       = WS_MO + (size_t)TOK * 512 * 2;
constexpr size_t WS_END     = WS_G + (size_t)TOK * 2048 * 2;
constexpr size_t WS_MIX     = WS_ZQ;
constexpr size_t WS_ACT     = WS_ZQ;

constexpr size_t O_YP  = 0;
constexpr size_t O_YS  = O_YP + (size_t)TOKP * 1024;
constexpr size_t O_KP  = O_YS + (size_t)TOKS * 1024;
constexpr size_t O_VP  = O_KP + 2ull * TOKP * 512;
constexpr size_t O_KSM = O_VP + 2ull * TOKP * 512;
constexpr size_t O_VSM = O_KSM + 2ull * TOKS * 512;
constexpr size_t O_CP  = O_VSM + 2ull * TOKS * 512;
constexpr size_t O_NP  = O_CP + 2ull * 32 * 4 * 128 * 128;
constexpr size_t O_MP  = O_NP + 2ull * 32 * 4 * 128;
constexpr size_t O_CVP = O_MP + 2ull * 32 * 4;
constexpr size_t O_CS  = O_CVP + 2ull * 32 * 3 * 1024;
constexpr size_t O_NS  = O_CS + 2ull * 8 * 4 * 128 * 128;
constexpr size_t O_MS  = O_NS + 2ull * 8 * 4 * 128;
constexpr size_t O_CVS = O_MS + 2ull * 8 * 4;

constexpr int LDS_BYTES = 148480;

struct Params {
  const float* in[30];
  float* out;
  unsigned char* ws;
};

DI u16 f2bf(float x) { unsigned u = __float_as_uint(x); u += 0x7fffu + ((u >> 16) & 1u); return (u16)(u >> 16); }
DI float bf2f(unsigned v) { return __uint_as_float(v << 16); }
typedef __bf16 bf16x2_t __attribute__((ext_vector_type(2)));
typedef float f32x2_t __attribute__((ext_vector_type(2)));
DI unsigned pack2(float a, float b) {
  f32x2_t v = {a, b};
  return __builtin_bit_cast(unsigned, __builtin_convertvector(v, bf16x2_t));
}
DI float bflo(unsigned v) { return __uint_as_float(v << 16); }
DI float bfhi(unsigned v) { return __uint_as_float(v & 0xffff0000u); }
DI float sigmoidf_(float x) { return 1.f / (1.f + __expf(-x)); }
DI float siluf_(float x) { return x / (1.f + __expf(-x)); }
DI float fexp2(float x) { return __builtin_amdgcn_exp2f(x); }
DI int otid() { int t = threadIdx.x; asm volatile("" : "+v"(t)); return t; }
DI float shx(float v, int mask, int lane) { return __int_as_float(__builtin_amdgcn_ds_bpermute(((lane ^ mask) & 63) << 2, __float_as_int(v))); }
DI float shidx(float v, int src, int lane) { (void)lane; return __int_as_float(__builtin_amdgcn_ds_bpermute((src & 63) << 2, __float_as_int(v))); }
DI int crow(int i, int h) { return (i & 3) + 8 * (i >> 2) + 4 * h; }
DI bf16x8 pack8(const f32x16& x, int s) {
  uint4 u;
  u.x = pack2(x[8 * s + 0], x[8 * s + 1]); u.y = pack2(x[8 * s + 2], x[8 * s + 3]);
  u.z = pack2(x[8 * s + 4], x[8 * s + 5]); u.w = pack2(x[8 * s + 6], x[8 * s + 7]);
  return __builtin_bit_cast(bf16x8, u);
}
DI void zero16(f32x16& a) {
#pragma unroll
  for (int i = 0; i < 16; ++i) a[i] = 0.f;
}
DI int batch_of_row(int row) { return row < TOKP ? (row >> 11) : 32 + ((row - TOKP) >> 5); }

constexpr int GS_STRIDE = 144;
constexpr int GS_STAGE = 512 * GS_STRIDE;
constexpr int GS_BASE = 64;

DI void gemm_mainloop(f32x16 (&acc)[4][2], const u16* __restrict__ A, int lda, const u16* __restrict__ Wt, int ldw, int K,
                      int m0, int n0, unsigned char* smem) {
  const int tid = otid(), lane = tid & 63, w = tid >> 6;
  const int wm = w >> 2, wn = w & 3, r = lane & 31, h = lane >> 5;
  const int lrow = tid >> 3, lcc = tid & 7;
  const u16* ap = A + (size_t)(m0 + lrow) * lda + lcc * 8;
  const int bn = n0 + 2 * (lrow & 31) + ((lrow >> 5) & 1);
  const u16* bp = Wt + (size_t)bn * ldw + lcc * 8;
  const size_t astep = (size_t)64 * lda, bstep = (size_t)64 * ldw;
  unsigned char* sbase = smem + GS_BASE;
  const int woff = lrow * GS_STRIDE + lcc * 16;
  const int nk = K >> 6;
  uint4 s0, s1, s2, s3, s4, s5, s6, s7, u0, u1, u2, u3, u4, u5, u6, u7;
  int kn = 1;
#define G_ADV() do { const int adv = (kn < nk) ? 64 : 0; ap += adv; bp += adv; ++kn; } while (0)
#define G_ISSUE_A() do { s0 = *(const uint4*)(ap); s1 = *(const uint4*)(ap + astep); s2 = *(const uint4*)(ap + 2 * astep); s3 = *(const uint4*)(ap + 3 * astep); \
    s4 = *(const uint4*)(bp); s5 = *(const uint4*)(bp + bstep); s6 = *(const uint4*)(bp + 2 * bstep); s7 = *(const uint4*)(bp + 3 * bstep); } while (0)
#define G_ISSUE_B() do { u0 = *(const uint4*)(ap); u1 = *(const uint4*)(ap + astep); u2 = *(const uint4*)(ap + 2 * astep); u3 = *(const uint4*)(ap + 3 * astep); \
    u4 = *(const uint4*)(bp); u5 = *(const uint4*)(bp + bstep); u6 = *(const uint4*)(bp + 2 * bstep); u7 = *(const uint4*)(bp + 3 * bstep); } while (0)
#define G_WRITE_A(sn) do { *(uint4*)((sn) + woff) = s0; *(uint4*)((sn) + woff + 64 * GS_STRIDE) = s1; *(uint4*)((sn) + woff + 128 * GS_STRIDE) = s2; \
    *(uint4*)((sn) + woff + 192 * GS_STRIDE) = s3; *(uint4*)((sn) + woff + 256 * GS_STRIDE) = s4; *(uint4*)((sn) + woff + 320 * GS_STRIDE) = s5; \
    *(uint4*)((sn) + woff + 384 * GS_STRIDE) = s6; *(uint4*)((sn) + woff + 448 * GS_STRIDE) = s7; } while (0)
#define G_WRITE_B(sn) do { *(uint4*)((sn) + woff) = u0; *(uint4*)((sn) + woff + 64 * GS_STRIDE) = u1; *(uint4*)((sn) + woff + 128 * GS_STRIDE) = u2; \
    *(uint4*)((sn) + woff + 192 * GS_STRIDE) = u3; *(uint4*)((sn) + woff + 256 * GS_STRIDE) = u4; *(uint4*)((sn) + woff + 320 * GS_STRIDE) = u5; \
    *(uint4*)((sn) + woff + 384 * GS_STRIDE) = u6; *(uint4*)((sn) + woff + 448 * GS_STRIDE) = u7; } while (0)
  const int aoff = (wm * 128 + r) * GS_STRIDE + h * 16;
  const int boff = (256 + wn * 64 + r) * GS_STRIDE + h * 16;
#define G_COMPUTE(st) do { _Pragma("unroll") for (int ks = 0; ks < 4; ++ks) {                                              \
      bf16x8 fa[4], fb[2];                                                                                               \
      _Pragma("unroll") for (int mi = 0; mi < 4; ++mi) fa[mi] = *(const bf16x8*)((st) + aoff + mi * 32 * GS_STRIDE + ks * 32); \
      fb[0] = *(const bf16x8*)((st) + boff + ks * 32);                                                                   \
      fb[1] = *(const bf16x8*)((st) + boff + 32 * GS_STRIDE + ks * 32);                                                  \
      _Pragma("unroll") for (int mi = 0; mi < 4; ++mi) {                                                                 \
        acc[mi][0] = MFMA(fa[mi], fb[0], acc[mi][0]);                                                                    \
        acc[mi][1] = MFMA(fa[mi], fb[1], acc[mi][1]);                                                                    \
      }                                                                                                                  \
      __builtin_amdgcn_sched_barrier(0);                                                                                 \
    } } while (0)
  G_ISSUE_A();
  G_WRITE_A(sbase);
  G_ADV(); G_ISSUE_A();
  G_ADV(); G_ISSUE_B();
  __syncthreads();
  for (int kt = 0; kt < nk; kt += 2) {
    G_WRITE_A(sbase + GS_STAGE);
    G_ADV(); G_ISSUE_A();
    __builtin_amdgcn_sched_barrier(0);
    G_COMPUTE(sbase);
    __syncthreads();
    G_WRITE_B(sbase);
    G_ADV(); G_ISSUE_B();
    __builtin_amdgcn_sched_barrier(0);
    G_COMPUTE(sbase + GS_STAGE);
    __syncthreads();
  }
#undef G_ADV
#undef G_ISSUE_A
#undef G_ISSUE_B
#undef G_WRITE_A
#undef G_WRITE_B
#undef G_COMPUTE
}

DI int rot_unused_(int) { return 0; }
DI bool tile_of(int i, int MT, int NT, int& mt, int& nt) {
  const int per = gridDim.x >> 3;
  const int L = i * (int)gridDim.x + (int)(blockIdx.x & 7) * per + (int)(blockIdx.x >> 3);
  if (L >= MT * NT) return false;
  const int nig = 8 * NT, gid = L / nig, fm = gid * 8, gsz = min(MT - fm, 8), rem = L - gid * nig;
  mt = fm + rem % gsz; nt = rem / gsz;
  return true;
}


template <class PF, class EF>
DI void gemm_stream(int lda, int ldw, int K, unsigned char* smem, PF ptrs, EF epi) {
  const int tid = otid(), lane = tid & 63, w = tid >> 6;
  const int wm = w >> 2, wn = w & 3, r = lane & 31, h = lane >> 5;
  unsigned char* sbase = smem + GS_BASE;
  constexpr int HS = 80, SLOT = 512 * HS;
  const int lrow4 = tid >> 2, lc4 = tid & 3;
  const int woff = lrow4 * HS + lc4 * 16;
  const int nh = K >> 5;
  const int brow4 = ((lrow4 >> 6) * 64) + 2 * (lrow4 & 31) + ((lrow4 >> 5) & 1);
  const unsigned oa0 = (unsigned)(lrow4 * lda + lc4 * 8) * 2u, oa1 = oa0 + (unsigned)(128 * lda) * 2u;
  const unsigned ob0 = (unsigned)(brow4 * ldw + lc4 * 8) * 2u, ob1 = ob0 + (unsigned)(128 * ldw) * 2u;
  const int aoff = (wm * 128 + r) * HS + h * 16;
  const int boff = (256 + wn * 64 + r) * HS + h * 16;
#define RAWBAR() do { asm volatile("s_waitcnt lgkmcnt(0)" ::: "memory"); __builtin_amdgcn_s_barrier(); asm volatile("" ::: "memory"); } while (0)
#define BAR0() do { asm volatile("" ::: "memory"); __builtin_amdgcn_s_barrier(); asm volatile("" ::: "memory"); } while (0)
  for (int it = 0;; ++it) {
    const char *ap, *bp;
    {
      const u16 *ta, *tb;
      if (!ptrs(it, ta, tb)) break;
      ap = (const char*)ta; bp = (const char*)tb;
    }
    f32x16 acc[4][2];
#pragma unroll
    for (int a = 0; a < 4; ++a)
#pragma unroll
      for (int b = 0; b < 2; ++b) zero16(acc[a][b]);
    uint4 s0, s1, s2, s3, u0, u1, u2, u3;
    int kn = 0;
#define H_ADV() do { const int adv = (kn + 1 < nh) ? 64 : 0; ap += adv; bp += adv; ++kn; } while (0)
#define H_ISSUE_A() do { s0 = *(const uint4*)(ap + oa0); s1 = *(const uint4*)(ap + oa1); s2 = *(const uint4*)(bp + ob0); s3 = *(const uint4*)(bp + ob1); } while (0)
#define H_ISSUE_B() do { u0 = *(const uint4*)(ap + oa0); u1 = *(const uint4*)(ap + oa1); u2 = *(const uint4*)(bp + ob0); u3 = *(const uint4*)(bp + ob1); } while (0)
#define H_WRITE_A(sl) do { *(uint4*)((sl) + woff) = s0; *(uint4*)((sl) + woff + 128 * HS) = s1; *(uint4*)((sl) + woff + 256 * HS) = s2; *(uint4*)((sl) + woff + 384 * HS) = s3; } while (0)
#define H_WRITE_B(sl) do { *(uint4*)((sl) + woff) = u0; *(uint4*)((sl) + woff + 128 * HS) = u1; *(uint4*)((sl) + woff + 256 * HS) = u2; *(uint4*)((sl) + woff + 384 * HS) = u3; } while (0)
#define H_READ(sl) do { _Pragma("unroll") for (int ks = 0; ks < 2; ++ks) {                                        \
      _Pragma("unroll") for (int mi = 0; mi < 4; ++mi) fa[ks][mi] = *(const bf16x8*)((sl) + aoff + mi * 32 * HS + ks * 32); \
      fb[ks][0] = *(const bf16x8*)((sl) + boff + ks * 32);                                                        \
      fb[ks][1] = *(const bf16x8*)((sl) + boff + 32 * HS + ks * 32); } } while (0)
#define H_MMA() do { _Pragma("unroll") for (int ks = 0; ks < 2; ++ks) { _Pragma("unroll") for (int mi = 0; mi < 4; ++mi) {  \
      acc[mi][0] = MFMA(fa[ks][mi], fb[ks][0], acc[mi][0]);                                                       \
      acc[mi][1] = MFMA(fa[ks][mi], fb[ks][1], acc[mi][1]); } } } while (0)
    H_ISSUE_A(); H_ADV(); H_ISSUE_B();
    H_WRITE_A(sbase);
    H_WRITE_B(sbase + SLOT);
    H_ADV(); H_ISSUE_A(); H_ADV(); H_ISSUE_B();
    __syncthreads();
    if (wm == 1) BAR0();
    int rs = 0, ws = 2;
#pragma unroll 1
    for (int hh = 0; hh < nh; hh += 2) {
      bf16x8 fa[2][4], fb[2][2];
      H_READ(sbase + rs * SLOT);
      H_WRITE_A(sbase + ws * SLOT);
      H_ADV(); H_ISSUE_A();
      __builtin_amdgcn_sched_barrier(0);
      RAWBAR();
      __builtin_amdgcn_sched_barrier(0);
      H_MMA();
      __builtin_amdgcn_sched_barrier(0);
      BAR0();
      rs = (rs == 2) ? 0 : rs + 1; ws = (ws == 2) ? 0 : ws + 1;
      H_READ(sbase + rs * SLOT);
      H_WRITE_B(sbase + ws * SLOT);
      H_ADV(); H_ISSUE_B();
      __builtin_amdgcn_sched_barrier(0);
      RAWBAR();
      __builtin_amdgcn_sched_barrier(0);
      H_MMA();
      __builtin_amdgcn_sched_barrier(0);
      BAR0();
      rs = (rs == 2) ? 0 : rs + 1; ws = (ws == 2) ? 0 : ws + 1;
    }
    if (wm == 0) BAR0();
    epi(it, acc);
#undef H_ADV
#undef H_ISSUE_A
#undef H_ISSUE_B
#undef H_WRITE_A
#undef H_WRITE_B
#undef H_READ
#undef H_MMA
  }
#undef RAWBAR
#undef BAR0
}

DI int map_row(int maptype, int s) {
  if (maptype == 1) return s < 3072 ? s : (s < 3080 ? -1 : s - 8);
  if (maptype == 2) return s < 2816 ? 2 * s : 2 * (s - 2816) + 1;
  return s;
}
DI void transpose_task(const float* __restrict__ src, int Nsrc, u16* __restrict__ dst, int dld, int maptype, int kt, int nt,
                       unsigned char* smem) {
  float* tile = (float*)(smem + 64);
  const int tid = otid();
  const int k0 = kt * 64, s0 = nt * 64;
#pragma unroll
  for (int i = 0; i < 2; ++i) {
    const int kr = (tid >> 4) + 32 * i, nc = (tid & 15) * 4;
    float4 v = make_float4(0.f, 0.f, 0.f, 0.f);
    if (s0 + nc < Nsrc) v = *(const float4*)(src + (size_t)(k0 + kr) * Nsrc + s0 + nc);
    tile[kr * 65 + nc + 0] = v.x; tile[kr * 65 + nc + 1] = v.y; tile[kr * 65 + nc + 2] = v.z; tile[kr * 65 + nc + 3] = v.w;
  }
  __syncthreads();
  {
    const int n = tid >> 3, kc = (tid & 7) * 8;
    const int s = s0 + n;
    const int dr = (s < Nsrc) ? map_row(maptype, s) : -1;
    if (dr >= 0) {
      uint4 o;
      o.x = pack2(tile[(kc + 0) * 65 + n], tile[(kc + 1) * 65 + n]);
      o.y = pack2(tile[(kc + 2) * 65 + n], tile[(kc + 3) * 65 + n]);
      o.z = pack2(tile[(kc + 4) * 65 + n], tile[(kc + 5) * 65 + n]);
      o.w = pack2(tile[(kc + 6) * 65 + n], tile[(kc + 7) * 65 + n]);
      *(uint4*)(dst + (size_t)dr * dld + k0 + kc) = o;
    }
  }
  __syncthreads();
}

DI void adaln_task(const Params& p, int task, unsigned char* smem) {
  const int bhalf = task & 1, cg_ = (task >> 1) % 96, l = (task >> 1) / 96;
  float* cs = (float*)(smem + 64);
  float* red = (float*)(smem + 64 + 20 * 1024 * 4);
  const int tid = otid();
  const float* cp = p.in[2]; const float* csm = p.in[3];
  for (int idx = tid; idx < 20 * 1024; idx += NTHR) {
    const int bb = idx >> 10, d = idx & 1023, b = bhalf * 20 + bb;
    const float c = b < 32 ? cp[b * 1024 + d] : csm[(b - 32) * 1024 + d];
    cs[idx] = siluf_(c);
  }
  __syncthreads();
  const int dseg = tid >> 6, e = cg_ * 64 + (tid & 63);
  const float* wp = p.in[10] + ((size_t)l * 1024 + dseg * 128) * 6144 + e;
  float acc[20];
#pragma unroll
  for (int i = 0; i < 20; ++i) acc[i] = 0.f;
  for (int d = 0; d < 128; ++d) {
    const float wv = wp[(size_t)d * 6144];
    const float* c0 = cs + dseg * 128 + d;
#pragma unroll
    for (int i = 0; i < 20; ++i) acc[i] += c0[i * 1024] * wv;
  }
#pragma unroll
  for (int i = 0; i < 20; ++i) red[(dseg * 20 + i) * 64 + (tid & 63)] = acc[i];
  __syncthreads();
  float* mod = (float*)(p.ws + WS_MOD);
  for (int idx = tid; idx < 20 * 64; idx += NTHR) {
    const int bb = idx >> 6, ec = idx & 63;
    float s = 0.f;
#pragma unroll
    for (int q = 0; q < 8; ++q) s += red[(q * 20 + bb) * 64 + ec];
    const int ee = cg_ * 64 + ec;
    mod[((size_t)l * 40 + bhalf * 20 + bb) * 6144 + ee] = s + p.in[11][l * 6144 + ee];
  }
  __syncthreads();
}

DI void prologue(const Params& p, unsigned char* smem) {
  const int WT_TASKS_L = 912 + 512 + 128 + 128 + 256 + 1408 + 704;
  const int N_WT = 2 * WT_TASKS_L;
  const int N_ADA = 384, N_CK = 512, N_CV = 2048;
  const int total = N_WT + N_ADA + N_CK + N_CV;
  for (int task = blockIdx.x; task < total; task += gridDim.x) {
    if (task < N_WT) {
      const int l = task / WT_TASKS_L; int t = task % WT_TASKS_L;
      if (t < 912) { transpose_task(p.in[12] + (size_t)l * 1024 * 3592, 3592, (u16*)(p.ws + WS_WT_IN) + (size_t)l * 3584 * 1024, 1024, 1, t / 57, t % 57, smem); continue; }
      t -= 912;
      if (t < 512) { transpose_task(p.in[21] + (size_t)l * 1024 * 2048, 2048, (u16*)(p.ws + WS_WT_GATE) + (size_t)l * 2048 * 1024, 1024, 0, t / 32, t % 32, smem); continue; }
      t -= 512;
      if (t < 128) { transpose_task(p.in[19] + (size_t)l * 512 * 1024, 1024, (u16*)(p.ws + WS_WT_BRA) + (size_t)l * 1024 * 512, 512, 0, t / 16, t % 16, smem); continue; }
      t -= 128;
      if (t < 128) { transpose_task(p.in[20] + (size_t)l * 512 * 1024, 1024, (u16*)(p.ws + WS_WT_BRB) + (size_t)l * 1024 * 512, 512, 0, t / 16, t % 16, smem); continue; }
      t -= 128;
      if (t < 256) { transpose_task(p.in[23] + (size_t)l * 1024 * 1024, 1024, (u16*)(p.ws + WS_WT_O) + (size_t)l * 1024 * 1024, 1024, 0, t / 16, t % 16, smem); continue; }
      t -= 256;
      if (t < 1408) { transpose_task(p.in[26] + (size_t)l * 1024 * 5632, 5632, (u16*)(p.ws + WS_WT_GU) + (size_t)l * 5632 * 1024, 1024, 2, t / 88, t % 88, smem); continue; }
      t -= 1408;
      transpose_task(p.in[27] + (size_t)l * 2816 * 1024, 1024, (u16*)(p.ws + WS_WT_DOWN) + (size_t)l * 1024 * 2816, 2816, 0, t / 16, t % 16, smem);
    } else if (task < N_WT + N_ADA) {
      adaln_task(p, task - N_WT, smem);
    } else if (task < N_WT + N_ADA + N_CK) {
      const int t = task - N_WT - N_ADA;
      const float4* src = (const float4*)p.in[4];
      u16* dst = (u16*)(p.ws + WS_KS);
#pragma unroll
      for (int i = 0; i < 8; ++i) {
        const size_t f4 = (size_t)t * 4096 + i * 512 + otid();
        const float4 v = src[f4];
        const size_t e = f4 * 4;
        const size_t lb = e / (1024 * 512), rem = e % (1024 * 512);
        uint2 o; o.x = pack2(v.x, v.y); o.y = pack2(v.z, v.w);
        *(uint2*)(dst + lb * (1056 * 512) + rem) = o;
      }
    } else {
      const int t = task - N_WT - N_ADA - N_CK;
      const int lb = t >> 7, tt = t & 127;
      transpose_task(p.in[5] + (size_t)lb * 1024 * 512, 512, (u16*)(p.ws + WS_VTS) + (size_t)lb * 512 * 1056, 1056, 0, tt >> 3, tt & 7, smem);
    }
  }
}

DI float wave_sum(float v, int lane) {
#pragma unroll
  for (int off = 32; off >= 1; off >>= 1) v += shx(v, off, lane);
  return v;
}
DI void ln_pass(const Params& p, int mode, int l, unsigned char* smem) {
  const int tid = otid();
  const int lane = tid & 63, w = tid >> 6;
  const bool first = mode != 0;
  const bool second = (mode != 2) || (l + 1 < 2);
  const bool gates = (mode == 0) || (mode == 2 && l + 1 < 2);
  const int lm = (mode == 2) ? l + 1 : l;
  const int shi = (mode == 1) ? 3 : 0;
  const float* lng = (mode == 1) ? p.in[24] + l * 1024 : p.in[28] + l * 1024;
  const float* lnb = (mode == 1) ? p.in[25] + l * 1024 : p.in[29] + l * 1024;
  const float* mod = (const float*)(p.ws + WS_MOD);
  u16* H = (u16*)(p.ws + WS_H);
  float* gout = (float*)(p.ws + WS_GATES);
  float* wl = (float*)(smem + 64);
  float bif[8];
  if (gates) {
    const float* wi = p.in[12] + (size_t)lm * 1024 * 3592 + 3072;
    for (int idx = tid; idx < 8192; idx += NTHR) {
      const int c = idx >> 3, j = idx & 7;
      wl[j * 1024 + c] = wi[(size_t)c * 3592 + j];
    }
#pragma unroll
    for (int j = 0; j < 8; ++j) bif[j] = p.in[13][lm * 8 + j];
  }
  __syncthreads();
  float lg[16], lb[16];
  if (first) {
#pragma unroll
    for (int i = 0; i < 4; ++i) {
      const float4 g = *(const float4*)(lng + i * 256 + lane * 4);
      const float4 b = *(const float4*)(lnb + i * 256 + lane * 4);
      lg[i * 4] = g.x; lg[i * 4 + 1] = g.y; lg[i * 4 + 2] = g.z; lg[i * 4 + 3] = g.w;
      lb[i * 4] = b.x; lb[i * 4 + 1] = b.y; lb[i * 4 + 2] = b.z; lb[i * 4 + 3] = b.w;
    }
  }
  auto process = [&](int row, float (&v)[16], const float (&msh)[16], const float (&msc)[16]) {
    float* xr = p.out + (size_t)row * 1024;
    if (first) {
      float s = 0.f;
#pragma unroll
      for (int i = 0; i < 16; ++i) s += v[i];
      const float mean = wave_sum(s, lane) * (1.f / 1024.f);
      float q = 0.f;
#pragma unroll
      for (int i = 0; i < 16; ++i) { v[i] -= mean; q += v[i] * v[i]; }
      const float rstd = rsqrtf(wave_sum(q, lane) * (1.f / 1024.f) + LN_EPS);
#pragma unroll
      for (int i = 0; i < 4; ++i) {
#pragma unroll
        for (int e = 0; e < 4; ++e) v[i * 4 + e] = v[i * 4 + e] * rstd * lg[i * 4 + e] + lb[i * 4 + e];
        *(float4*)(xr + i * 256 + lane * 4) = make_float4(v[i * 4 + 0], v[i * 4 + 1], v[i * 4 + 2], v[i * 4 + 3]);
      }
    }
    if (second) {
      float s = 0.f;
#pragma unroll
      for (int i = 0; i < 16; ++i) s += v[i];
      const float mean = wave_sum(s, lane) * (1.f / 1024.f);
      float q = 0.f;
#pragma unroll
      for (int i = 0; i < 16; ++i) { v[i] -= mean; q += v[i] * v[i]; }
      const float rstd = rsqrtf(wave_sum(q, lane) * (1.f / 1024.f) + LN_EPS);
#pragma unroll
      for (int i = 0; i < 4; ++i) {
#pragma unroll
        for (int e = 0; e < 4; ++e) v[i * 4 + e] = v[i * 4 + e] * rstd * msc[i * 4 + e] + msh[i * 4 + e];
        uint2 o; o.x = pack2(v[i * 4 + 0], v[i * 4 + 1]); o.y = pack2(v[i * 4 + 2], v[i * 4 + 3]);
        *(uint2*)(H + (size_t)row * 1024 + i * 256 + lane * 4) = o;
      }
      if (gates) {
        float g8[8];
#pragma unroll
        for (int j = 0; j < 8; ++j) {
          float s2 = 0.f;
#pragma unroll
          for (int i = 0; i < 4; ++i) {
            const float4 wv = *(const float4*)(wl + j * 1024 + i * 256 + lane * 4);
            s2 += v[i * 4] * wv.x + v[i * 4 + 1] * wv.y + v[i * 4 + 2] * wv.z + v[i * 4 + 3] * wv.w;
          }
          g8[j] = wave_sum(s2, lane) + bif[j];
        }
        if (lane == 0) {
          *(float4*)(gout + (size_t)row * 8) = make_float4(g8[0], g8[1], g8[2], g8[3]);
          *(float4*)(gout + (size_t)row * 8 + 4) = make_float4(g8[4], g8[5], g8[6], g8[7]);
        }
      }
    }
  };
  auto load_mod = [&](int row, float (&msh)[16], float (&msc)[16]) {
    const float* mb = mod + ((size_t)lm * 40 + batch_of_row(row)) * 6144;
#pragma unroll
    for (int i = 0; i < 4; ++i) {
      const float4 sh = *(const float4*)(mb + shi * 1024 + i * 256 + lane * 4);
      const float4 sc = *(const float4*)(mb + (shi + 1) * 1024 + i * 256 + lane * 4);
      msh[i * 4] = sh.x; msh[i * 4 + 1] = sh.y; msh[i * 4 + 2] = sh.z; msh[i * 4 + 3] = sh.w;
      msc[i * 4] = 1.f + sc.x; msc[i * 4 + 1] = 1.f + sc.y; msc[i * 4 + 2] = 1.f + sc.z; msc[i * 4 + 3] = 1.f + sc.w;
    }
  };
  for (int chunk = blockIdx.x * 8 + w; chunk < TOKP / 32; chunk += gridDim.x * 8) {
    const int row0 = chunk * 32;
    float msh[16], msc[16];
    if (second) load_mod(row0, msh, msc);
    const float* src0 = (mode == 0) ? p.in[0] + (size_t)row0 * 1024 : p.out + (size_t)row0 * 1024;
    float4 nx0 = *(const float4*)(src0 + lane * 4), nx1 = *(const float4*)(src0 + 256 + lane * 4);
    float4 nx2 = *(const float4*)(src0 + 512 + lane * 4), nx3 = *(const float4*)(src0 + 768 + lane * 4);
    for (int ri = 0; ri < 32; ++ri) {
      float v[16];
      v[0] = nx0.x; v[1] = nx0.y; v[2] = nx0.z; v[3] = nx0.w; v[4] = nx1.x; v[5] = nx1.y; v[6] = nx1.z; v[7] = nx1.w;
      v[8] = nx2.x; v[9] = nx2.y; v[10] = nx2.z; v[11] = nx2.w; v[12] = nx3.x; v[13] = nx3.y; v[14] = nx3.z; v[15] = nx3.w;
      {
        const float* sn = src0 + (size_t)(ri < 31 ? ri + 1 : 31) * 1024;
        nx0 = *(const float4*)(sn + lane * 4); nx1 = *(const float4*)(sn + 256 + lane * 4);
        nx2 = *(const float4*)(sn + 512 + lane * 4); nx3 = *(const float4*)(sn + 768 + lane * 4);
      }
      __builtin_amdgcn_sched_barrier(0);
      process(row0 + ri, v, msh, msc);
    }
  }
  if (w == 0) {
    for (int row = TOKP + blockIdx.x; row < TOK; row += gridDim.x) {
      float msh[16], msc[16];
      if (second) load_mod(row, msh, msc);
      const float* src = (mode == 0) ? p.in[1] + (size_t)(row - TOKP) * 1024 : p.out + (size_t)row * 1024;
      float v[16];
#pragma unroll
      for (int i = 0; i < 4; ++i) {
        const float4 t = *(const float4*)(src + i * 256 + lane * 4);
        v[i * 4 + 0] = t.x; v[i * 4 + 1] = t.y; v[i * 4 + 2] = t.z; v[i * 4 + 3] = t.w;
      }
      process(row, v, msh, msc);
    }
  }
}

constexpr int EP_LD = 264;
constexpr int EP_LDT = 68;
DI void zero_acc(f32x16 (&acc)[4][2]) {
#pragma unroll
  for (int a = 0; a < 4; ++a)
#pragma unroll
    for (int b = 0; b < 2; ++b) zero16(acc[a][b]);
}
DI void stage_rm(const f32x16& a0, const f32x16& a1, float* stg, int wm, int wn, int r, int h) {
#pragma unroll
  for (int i = 0; i < 16; ++i) *(float2*)(stg + (wm * 32 + crow(i, h)) * EP_LD + wn * 64 + 2 * r) = make_float2(a0[i], a1[i]);
}
DI void stage_tr(const f32x16& a0, const f32x16& a1, float* stg, int wm, int wn, int r, int h) {
#pragma unroll
  for (int g = 0; g < 4; ++g) {
    *(float4*)(stg + (wn * 64 + 2 * r) * EP_LDT + wm * 32 + 8 * g + 4 * h) = make_float4(a0[4 * g], a0[4 * g + 1], a0[4 * g + 2], a0[4 * g + 3]);
    *(float4*)(stg + (wn * 64 + 2 * r + 1) * EP_LDT + wm * 32 + 8 * g + 4 * h) = make_float4(a1[4 * g], a1[4 * g + 1], a1[4 * g + 2], a1[4 * g + 3]);
  }
}
DI int grow_of(int m0, int mi, int lr) { return m0 + (lr >> 5) * 128 + mi * 32 + (lr & 31); }
DI uint4 pack8f(const float4& a, const float4& b) {
  uint4 o; o.x = pack2(a.x, a.y); o.y = pack2(a.z, a.w); o.z = pack2(b.x, b.y); o.w = pack2(b.z, b.w); return o;
}

DI void write_tr(const Params& p, int l, int m0, int mi, const float* stg, int tid, int which, int chbase) {
  const bool prompt = m0 < TOKP;
#pragma unroll 1
  for (int q = 0; q < 4; ++q) {
    const int cid = q * NTHR + tid, ch = cid >> 3, tc = cid & 7;
    const float4 v0 = *(const float4*)(stg + ch * EP_LDT + tc * 8);
    const float4 v1 = *(const float4*)(stg + ch * EP_LDT + tc * 8 + 4);
    const int row0 = grow_of(m0, mi, tc * 8);
    const int chg = chbase + ch;
    u16* d;
    if (prompt) {
      const int b = row0 >> 11, t = row0 & 2047;
      if (which == 0) d = (u16*)(p.ws + WS_VTP) + ((size_t)b * 512 + chg) * 2048 + t;
      else if (which == 1) d = (u16*)(p.ws + WS_MQKT_P) + ((size_t)b * 1024 + chg) * 2048 + t;
      else d = (u16*)(p.ws + WS_MVT_P) + ((size_t)b * 512 + chg) * 2048 + t;
    } else {
      const int rs = row0 - TOKP, bs = rs >> 5, t = rs & 31;
      if (which == 0) d = (u16*)(p.ws + WS_VTS) + ((size_t)(l * 8 + bs) * 512 + chg) * 1056 + 1024 + t;
      else if (which == 1) d = (u16*)(p.ws + WS_MQKT_S) + ((size_t)bs * 1024 + chg) * 32 + t;
      else d = (u16*)(p.ws + WS_MVT_S) + ((size_t)bs * 512 + chg) * 32 + t;
    }
    *(uint4*)d = pack8f(v0, v1);
  }
}

DI void epi_in(const Params& p, int l, int m0, int n0, f32x16 (&acc)[4][2], unsigned char* smem) {
  const int tid = otid(), lane = tid & 63, w = tid >> 6;
  const int wm = w >> 2, wn = w & 3, r = lane & 31, h = lane >> 5;
  const bool prompt = m0 < TOKP;
  float* stg = (float*)(smem + GS_BASE + GS_STAGE);
  const int seg = n0 < 512 ? 0 : (n0 < 1024 ? 1 : (n0 < 1536 ? 2 : (n0 < 2560 ? 3 : (n0 < 3072 ? 4 : 5))));
  if (seg == 3) {
    const int ch = n0 - 1536 + wn * 64 + 2 * r;
#pragma unroll
    for (int mi = 0; mi < 4; ++mi) {
      const int rb = m0 + wm * 128 + mi * 32 + 4 * h;
#pragma unroll
      for (int i = 0; i < 16; ++i) {
        const int row = rb + (i & 3) + 8 * (i >> 2);
        if (prompt) {
          const int tt = row & 2047;
          if (tt >= 2045) *(float2*)(p.out + O_CVP + ((size_t)(l * 32 + (row >> 11)) * 3 + (tt - 2045)) * 1024 + ch) = make_float2(acc[mi][0][i], acc[mi][1][i]);
        } else {
          const int rs = row - TOKP, tt = rs & 31;
          if (tt >= 29) *(float2*)(p.out + O_CVS + ((size_t)(l * 8 + (rs >> 5)) * 3 + (tt - 29)) * 1024 + ch) = make_float2(acc[mi][0][i], acc[mi][1][i]);
        }
      }
    }
  }
#pragma unroll
  for (int mi = 0; mi < 4; ++mi) {
    if (seg == 0 || seg == 1 || seg == 2 || seg == 5) {
      __syncthreads();
      stage_rm(acc[mi][0], acc[mi][1], stg, wm, wn, r, h);
      __syncthreads();
#pragma unroll 1
      for (int q = 0; q < 4; ++q) {
        const int cid = q * NTHR + tid, lr = cid >> 5, c8 = (cid & 31) * 8;
        const float4 v0 = *(const float4*)(stg + lr * EP_LD + c8);
        const float4 v1 = *(const float4*)(stg + lr * EP_LD + c8 + 4);
        const int row = grow_of(m0, mi, lr);
        const int n = n0 + c8;
        if (seg == 0) {
          *(uint4*)((u16*)(p.ws + WS_ZQ) + (size_t)row * 512 + n) = pack8f(v0, v1);
        } else if (seg == 5) {
          const float4 s0 = make_float4(sigmoidf_(v0.x), sigmoidf_(v0.y), sigmoidf_(v0.z), sigmoidf_(v0.w));
          const float4 s1 = make_float4(sigmoidf_(v1.x), sigmoidf_(v1.y), sigmoidf_(v1.z), sigmoidf_(v1.w));
          *(uint4*)((u16*)(p.ws + WS_MO) + (size_t)row * 512 + (n - 3072)) = pack8f(s0, s1);
        } else {
          const bool isk = seg == 1;
          const int nn = n - (isk ? 512 : 1024);
          float* of = p.out + (isk ? (prompt ? O_KP : O_KSM) : (prompt ? O_VP : O_VSM));
          const size_t orow = prompt ? ((size_t)l * TOKP + row) : ((size_t)l * TOKS + (row - TOKP));
          *(float4*)(of + orow * 512 + nn) = v0;
          *(float4*)(of + orow * 512 + nn + 4) = v1;
          if (isk) {
            u16* kd;
            if (prompt) kd = (u16*)(p.ws + WS_KB) + (size_t)row * 512 + nn;
            else { const int rs = row - TOKP; kd = (u16*)(p.ws + WS_KS) + ((size_t)(l * 8 + (rs >> 5)) * 1056 + 1024 + (rs & 31)) * 512 + nn; }
            *(uint4*)kd = pack8f(v0, v1);
          }
        }
      }
    }
    if (seg == 2 || seg == 3 || seg == 4) {
      __syncthreads();
      stage_tr(acc[mi][0], acc[mi][1], stg, wm, wn, r, h);
      __syncthreads();
      write_tr(p, l, m0, mi, stg, tid, seg == 2 ? 0 : (seg == 3 ? 1 : 2), n0 - (seg == 2 ? 1024 : (seg == 3 ? 1536 : 2560)));
    }
  }
  __syncthreads();
}

DI void phase_in_gate(const Params& p, int l, unsigned char* smem) {
  const int tid = otid(), lane = tid & 63, w = tid >> 6;
  const int wm = w >> 2, wn = w & 3, r = lane & 31, h = lane >> 5;
  const u16* H = (const u16*)(p.ws + WS_H);
  const u16* Win = (const u16*)(p.ws + WS_WT_IN) + (size_t)l * 3584 * 1024;
  const u16* Wg = (const u16*)(p.ws + WS_WT_GATE) + (size_t)l * 2048 * 1024;
  float* stg = (float*)(smem + GS_BASE + GS_STAGE);
  const int NT = 14 + 8, MT = 257;
  auto ptrs = [&](int it, const u16*& ap, const u16*& bp) -> bool {
    int mt, nt;
    if (!tile_of(it, MT, NT, mt, nt)) return false;
    ap = H + (size_t)(mt * 256) * 1024;
    bp = (nt < 14 ? Win + (size_t)(nt * 256) * 1024 : Wg + (size_t)((nt - 14) * 256) * 1024);
    return true;
  };
  auto epi = [&](int it, f32x16 (&acc)[4][2]) {
    const int tid = otid(), lane = tid & 63, w = tid >> 6;
    const int wm = w >> 2, wn = w & 3, r = lane & 31, h = lane >> 5;
    int mt, nt;
    tile_of(it, MT, NT, mt, nt);
    const int m0 = mt * 256;
    if (nt < 14) {
      epi_in(p, l, m0, nt * 256, acc, smem);
    } else {
      const int n0 = (nt - 14) * 256;
      u16* G = (u16*)(p.ws + WS_G);
#pragma unroll
      for (int mi = 0; mi < 4; ++mi) {
        __syncthreads();
        stage_rm(acc[mi][0], acc[mi][1], stg, wm, wn, r, h);
        __syncthreads();
#pragma unroll 1
        for (int q = 0; q < 4; ++q) {
          const int cid = q * NTHR + tid, lr = cid >> 5, c8 = (cid & 31) * 8;
          float4 v0 = *(const float4*)(stg + lr * EP_LD + c8);
          float4 v1 = *(const float4*)(stg + lr * EP_LD + c8 + 4);
          const int row = grow_of(m0, mi, lr), n = n0 + c8;
          const float4 b0 = *(const float4*)(p.in[22] + l * 2048 + n);
          const float4 b1 = *(const float4*)(p.in[22] + l * 2048 + n + 4);
          v0 = make_float4(sigmoidf_(v0.x + b0.x), sigmoidf_(v0.y + b0.y), sigmoidf_(v0.z + b0.z), sigmoidf_(v0.w + b0.w));
          v1 = make_float4(sigmoidf_(v1.x + b1.x), sigmoidf_(v1.y + b1.y), sigmoidf_(v1.z + b1.z), sigmoidf_(v1.w + b1.w));
          *(uint4*)(G + (size_t)row * 2048 + n) = pack8f(v0, v1);
        }
      }
      __syncthreads();
    }
  };
  gemm_stream(1024, 1024, 1024, smem, ptrs, epi);
}

DI void phase_mix(const Params& p, int l, unsigned char* smem) {
  const int tid = otid(), lane = tid & 63, w = tid >> 6;
  const int wm = w >> 2, wn = w & 3, r = lane & 31, h = lane >> 5;
  const u16* G = (const u16*)(p.ws + WS_G);
  u16* MIX = (u16*)(p.ws + WS_MIX);
  float* stg = (float*)(smem + GS_BASE + GS_STAGE);
  const int NT = 4, MT = 257;
  auto ptrs = [&](int it, const u16*& ap, const u16*& bp) -> bool {
    int mt, nt;
    if (!tile_of(it >> 1, MT, NT, mt, nt)) return false;
    const int half = it & 1;
    ap = (const u16*)(p.ws + (half ? WS_MN : WS_AN)) + (size_t)(mt * 256) * 512;
    bp = (const u16*)(p.ws + (half ? WS_WT_BRB : WS_WT_BRA)) + (size_t)l * 1024 * 512 + (size_t)(nt * 256) * 512;
    return true;
  };
  auto epi = [&](int it, f32x16 (&acc)[4][2]) {
    const int tid = otid(), lane = tid & 63, w = tid >> 6;
    const int wm = w >> 2, wn = w & 3, r = lane & 31, h = lane >> 5;
    int mt, nt;
    tile_of(it >> 1, MT, NT, mt, nt);
    const int half = it & 1;
    const int m0 = mt * 256, n0 = nt * 256;
#pragma unroll
    for (int mi = 0; mi < 4; ++mi) {
      __syncthreads();
      stage_rm(acc[mi][0], acc[mi][1], stg, wm, wn, r, h);
      __syncthreads();
#pragma unroll 1
      for (int q = 0; q < 4; ++q) {
        const int cid = q * NTHR + tid, lr = cid >> 5, c8 = (cid & 31) * 8;
        const float4 v0 = *(const float4*)(stg + lr * EP_LD + c8);
        const float4 v1 = *(const float4*)(stg + lr * EP_LD + c8 + 4);
        const int row = grow_of(m0, mi, lr), n = n0 + c8;
        const uint4 g = *(const uint4*)(G + (size_t)row * 2048 + half * 1024 + n);
        float4 o0 = make_float4(bflo(g.x) * v0.x, bfhi(g.x) * v0.y, bflo(g.y) * v0.z, bfhi(g.y) * v0.w);
        float4 o1 = make_float4(bflo(g.z) * v1.x, bfhi(g.z) * v1.y, bflo(g.w) * v1.z, bfhi(g.w) * v1.w);
        uint4* mp = (uint4*)(MIX + (size_t)row * 1024 + n);
        if (half) {
          const uint4 pr = *mp;
          o0.x += bflo(pr.x); o0.y += bfhi(pr.x); o0.z += bflo(pr.y); o0.w += bfhi(pr.y);
          o1.x += bflo(pr.z); o1.y += bfhi(pr.z); o1.z += bflo(pr.w); o1.w += bfhi(pr.w);
        }
        *mp = pack8f(o0, o1);
      }
    }
    __syncthreads();
  };
  gemm_stream(512, 512, 512, smem, ptrs, epi);
}

DI void phase_res(const Params& p, int l, int mode, unsigned char* smem) {
  const int tid = otid(), lane = tid & 63, w = tid >> 6;
  const int wm = w >> 2, wn = w & 3, r = lane & 31, h = lane >> 5;
  const float* mod = (const float*)(p.ws + WS_MOD);
  float* stg = (float*)(smem + GS_BASE + GS_STAGE);
  const int NT = 4, MT = 257;
  const int K = (mode == 0) ? 1024 : 2816;
  const u16* Ab = (const u16*)(p.ws + (mode == 0 ? WS_MIX : WS_ACT));
  const u16* Wb = (mode == 0) ? (const u16*)(p.ws + WS_WT_O) + (size_t)l * 1024 * 1024 : (const u16*)(p.ws + WS_WT_DOWN) + (size_t)l * 1024 * 2816;
  const int gi = (mode == 0) ? 2 : 5;
  auto ptrs = [&](int it, const u16*& ap, const u16*& bp) -> bool {
    int mt, nt;
    if (!tile_of(it, MT, NT, mt, nt)) return false;
    ap = Ab + (size_t)(mt * 256) * K;
    bp = Wb + (size_t)(nt * 256) * K;
    return true;
  };
  auto epi = [&](int it, f32x16 (&acc)[4][2]) {
    const int tid = otid(), lane = tid & 63, w = tid >> 6;
    const int wm = w >> 2, wn = w & 3, r = lane & 31, h = lane >> 5;
    int mt, nt;
    tile_of(it, MT, NT, mt, nt);
    const int m0 = mt * 256, n0 = nt * 256;
#pragma unroll
    for (int mi = 0; mi < 4; ++mi) {
      __syncthreads();
      stage_rm(acc[mi][0], acc[mi][1], stg, wm, wn, r, h);
      __syncthreads();
#pragma unroll 1
      for (int q = 0; q < 8; ++q) {
        const int cid = q * NTHR + tid, lr = cid >> 6, c4 = (cid & 63) * 4;
        const float4 v = *(const float4*)(stg + lr * EP_LD + c4);
        const int row = grow_of(m0, mi, lr), n = n0 + c4;
        const int b = batch_of_row(row);
        const float4 gg = *(const float4*)(mod + ((size_t)l * 40 + b) * 6144 + gi * 1024 + n);
        float* xr = p.out + (size_t)row * 1024 + n;
        const float* xs = (mode == 0 && l == 0) ? (row < TOKP ? p.in[0] + (size_t)row * 1024 + n : p.in[1] + (size_t)(row - TOKP) * 1024 + n) : xr;
        const float4 xv = *(const float4*)xs;
        *(float4*)xr = make_float4(ALPHA * xv.x + (1.f + gg.x) * v.x, ALPHA * xv.y + (1.f + gg.y) * v.y,
                                   ALPHA * xv.z + (1.f + gg.z) * v.z, ALPHA * xv.w + (1.f + gg.w) * v.w);
      }
    }
    __syncthreads();
  };
  gemm_stream(K, K, K, smem, ptrs, epi);
}

DI void phase_gu(const Params& p, int l, unsigned char* smem) {
  const int tid = otid(), lane = tid & 63, w = tid >> 6;
  const int wm = w >> 2, wn = w & 3, r = lane & 31, h = lane >> 5;
  u16* ACT = (u16*)(p.ws + WS_ACT);
  const u16* Hh = (const u16*)(p.ws + WS_H);
  const u16* Wb = (const u16*)(p.ws + WS_WT_GU) + (size_t)l * 5632 * 1024;
  float* stg = (float*)(smem + GS_BASE + GS_STAGE);
  const int NT = 22, MT = 257;
  auto ptrs = [&](int it, const u16*& ap, const u16*& bp) -> bool {
    int mt, nt;
    if (!tile_of(it, MT, NT, mt, nt)) return false;
    ap = Hh + (size_t)(mt * 256) * 1024;
    bp = Wb + (size_t)(nt * 256) * 1024;
    return true;
  };
  auto epi = [&](int it, f32x16 (&acc)[4][2]) {
    const int tid = otid(), lane = tid & 63, w = tid >> 6;
    const int wm = w >> 2, wn = w & 3, r = lane & 31, h = lane >> 5;
    int mt, nt;
    tile_of(it, MT, NT, mt, nt);
    const int m0 = mt * 256, n0 = nt * 256;
#pragma unroll
    for (int mi = 0; mi < 4; ++mi) {
      __syncthreads();
      stage_rm(acc[mi][0], acc[mi][1], stg, wm, wn, r, h);
      __syncthreads();
#pragma unroll 1
      for (int q = 0; q < 2; ++q) {
        const int cid = q * NTHR + tid, lr = cid >> 4, c16 = (cid & 15) * 16;
        const float4 v0 = *(const float4*)(stg + lr * EP_LD + c16);
        const float4 v1 = *(const float4*)(stg + lr * EP_LD + c16 + 4);
        const float4 v2 = *(const float4*)(stg + lr * EP_LD + c16 + 8);
        const float4 v3 = *(const float4*)(stg + lr * EP_LD + c16 + 12);
        const int row = grow_of(m0, mi, lr);
        uint4 o;
        o.x = pack2(siluf_(v0.x) * v0.y, siluf_(v0.z) * v0.w);
        o.y = pack2(siluf_(v1.x) * v1.y, siluf_(v1.z) * v1.w);
        o.z = pack2(siluf_(v2.x) * v2.y, siluf_(v2.z) * v2.w);
        o.w = pack2(siluf_(v3.x) * v3.y, siluf_(v3.z) * v3.w);
        *(uint4*)(ACT + (size_t)row * 2816 + (n0 >> 1) + (c16 >> 1)) = o;
      }
    }
    __syncthreads();
  };
  gemm_stream(1024, 1024, 1024, smem, ptrs, epi);
}

constexpr int AT_BASE = 64;
constexpr int AT_KBYTES = 64 * 272;
constexpr int AT_VBYTES = 128 * 136;
constexpr int AT_STAGE = AT_KBYTES + AT_VBYTES;

DI void attn_item(const Params& p, int l, int b, int head, int qt, float lam, float lam_init, unsigned char* smem) {
  const int tid = otid(), lane = tid & 63, w = tid >> 6, r = lane & 31, h = lane >> 5;
  const int comp = w & 1, rg = w >> 1;
  const bool prompt = b < 32;
  const int bs = b - 32;
  const u16* Kg = prompt ? (const u16*)(p.ws + WS_KB) + (size_t)b * 2048 * 512 : (const u16*)(p.ws + WS_KS) + (size_t)(l * 8 + bs) * 1056 * 512;
  const u16* Vg = prompt ? (const u16*)(p.ws + WS_VTP) + (size_t)b * 512 * 2048 : (const u16*)(p.ws + WS_VTS) + (size_t)(l * 8 + bs) * 512 * 1056;
  const int ldT = prompt ? 2048 : 1056;
  const int nkt = prompt ? 2 * qt + 2 : 17;
  const int nkeys = prompt ? 2048 : 1056;
  const int qtok0 = prompt ? b * 2048 + qt * 128 : TOKP + bs * 32;
  const int qpos0 = prompt ? qt * 128 : 1024;
  const bool active = prompt || rg == 0;
  const int my_nkt = prompt ? (rg < 2 ? nkt - 1 : nkt) : nkt;
  const u16* ZQ = (const u16*)(p.ws + WS_ZQ);
  bf16x8 qf[4];
  {
    const int qrow = active ? qtok0 + rg * 32 + r : qtok0;
#pragma unroll
    for (int ks = 0; ks < 4; ++ks) qf[ks] = *(const bf16x8*)(ZQ + (size_t)qrow * 512 + head * 128 + comp * 64 + ks * 16 + h * 8);
  }
  const float slope2 = exp2f(-2.f * (head + 1)) * LOG2E;
  const float c1 = 0.125f * LOG2E;
  const int qpos = qpos0 + rg * 32 + r;
  f32x16 O[4];
#pragma unroll
  for (int i = 0; i < 4; ++i) zero16(O[i]);
  float m_run = -INFINITY, l_run = 0.f;

  const int krow = tid >> 4, kcc = tid & 15;
  const int vrow = tid >> 3, vcc = tid & 7;
  const u16* kp = Kg + (size_t)((nkt - 1) * 64 + krow) * 512 + head * 128 + kcc * 8;
  const u16* vp = Vg + (size_t)(head * 128 + vrow) * ldT + (nkt - 1) * 64 + vcc * 8;
  uint4 rk0, rk1, rv0, rv1;
  unsigned char* sb = smem + AT_BASE;
  rk0 = *(const uint4*)kp; rk1 = *(const uint4*)(kp + 32 * 512);
  rv0 = *(const uint4*)vp; rv1 = *(const uint4*)(vp + (size_t)64 * ldT);
  {
    *(uint4*)(sb + krow * 272 + kcc * 16) = rk0;
    *(uint4*)(sb + (krow + 32) * 272 + kcc * 16) = rk1;
    *(uint2*)(sb + AT_KBYTES + vrow * 136 + vcc * 16) = make_uint2(rv0.x, rv0.y);
    *(uint2*)(sb + AT_KBYTES + vrow * 136 + vcc * 16 + 8) = make_uint2(rv0.z, rv0.w);
    *(uint2*)(sb + AT_KBYTES + (vrow + 64) * 136 + vcc * 16) = make_uint2(rv1.x, rv1.y);
    *(uint2*)(sb + AT_KBYTES + (vrow + 64) * 136 + vcc * 16 + 8) = make_uint2(rv1.z, rv1.w);
  }
  __syncthreads();
  for (int j = 0; j < nkt; ++j) {
    const int kt = nkt - 1 - j;
    const bool more = j + 1 < nkt;
    if (more) {
      kp -= 64 * 512; vp -= 64;
      rk0 = *(const uint4*)kp; rk1 = *(const uint4*)(kp + 32 * 512);
      rv0 = *(const uint4*)vp; rv1 = *(const uint4*)(vp + (size_t)64 * ldT);
    }
    if (active && kt < my_nkt) {
      const unsigned char* Kt = sb + (j & 1) * AT_STAGE;
      const unsigned char* Vt = Kt + AT_KBYTES;
      f32x16 s[2];
      zero16(s[0]); zero16(s[1]);
#pragma unroll
      for (int ks = 0; ks < 4; ++ks) {
#pragma unroll
        for (int sub = 0; sub < 2; ++sub) {
          const bf16x8 kf = *(const bf16x8*)(Kt + (sub * 32 + r) * 272 + (comp * 64 + ks * 16 + h * 8) * 2);
          s[sub] = MFMA(kf, qf[ks], s[sub]);
        }
      }
      float mx = -INFINITY;
      const float qk0 = (float)(qpos - kt * 64 - 4 * h);
#pragma unroll
      for (int sub = 0; sub < 2; ++sub)
#pragma unroll
        for (int i = 0; i < 16; ++i) {
          const float d = qk0 - (float)(sub * 32 + (i & 3) + 8 * (i >> 2));
          float v = s[sub][i] * c1 - slope2 * fabsf(d);
          s[sub][i] = v;
        }
      if (!prompt) {
#pragma unroll
        for (int sub = 0; sub < 2; ++sub)
#pragma unroll
          for (int i = 0; i < 16; ++i) {
            const int key = kt * 64 + sub * 32 + crow(i, h);
            if (key >= nkeys) s[sub][i] = -INFINITY;
          }
      }
#pragma unroll
      for (int sub = 0; sub < 2; ++sub)
#pragma unroll
        for (int i = 0; i < 16; ++i) mx = fmaxf(mx, s[sub][i]);
      mx = fmaxf(mx, shx(mx, 32, lane));
      const bool livelane = !(mx - m_run < -150.f);
      if (__ballot(livelane) != 0ull) {
        const float m_new = fmaxf(m_run, mx);
        const float alpha = fexp2(m_run - m_new);
        m_run = m_new;
        float lsum = 0.f;
#pragma unroll
        for (int sub = 0; sub < 2; ++sub)
#pragma unroll
          for (int i = 0; i < 16; ++i) {
            const float pv = fexp2(s[sub][i] - m_new);
            lsum += pv;
            s[sub][i] = pv;
          }
        l_run = l_run * alpha + lsum;
        if (__ballot(alpha != 1.f) != 0ull) {
#pragma unroll
          for (int dt = 0; dt < 4; ++dt)
#pragma unroll
            for (int i = 0; i < 16; ++i) O[dt][i] *= alpha;
        }
#pragma unroll
        for (int sub = 0; sub < 2; ++sub)
#pragma unroll
          for (int s2 = 0; s2 < 2; ++s2) {
            const bf16x8 pf = pack8(s[sub], s2);
#pragma unroll
            for (int dt = 0; dt < 4; ++dt) {
              const unsigned char* va = Vt + (dt * 32 + r) * 136 + (sub * 32 + s2 * 16 + 4 * h) * 2;
              const uint2 lo = *(const uint2*)va;
              const uint2 hi = *(const uint2*)(va + 16);
              const uint4 vv = make_uint4(lo.x, lo.y, hi.x, hi.y);
              O[dt] = MFMA(__builtin_bit_cast(bf16x8, vv), pf, O[dt]);
            }
          }
      }
    }
    if (more) {
      unsigned char* sn = sb + ((j + 1) & 1) * AT_STAGE;
      *(uint4*)(sn + krow * 272 + kcc * 16) = rk0;
      *(uint4*)(sn + (krow + 32) * 272 + kcc * 16) = rk1;
      *(uint2*)(sn + AT_KBYTES + vrow * 136 + vcc * 16) = make_uint2(rv0.x, rv0.y);
      *(uint2*)(sn + AT_KBYTES + vrow * 136 + vcc * 16 + 8) = make_uint2(rv0.z, rv0.w);
      *(uint2*)(sn + AT_KBYTES + (vrow + 64) * 136 + vcc * 16) = make_uint2(rv1.x, rv1.y);
      *(uint2*)(sn + AT_KBYTES + (vrow + 64) * 136 + vcc * 16 + 8) = make_uint2(rv1.z, rv1.w);
    }
    __syncthreads();
  }
  float* exch = (float*)(smem + AT_BASE);
  float inv = 0.f;
  if (active) { const float lt = l_run + shx(l_run, 32, lane); inv = 1.f / lt; }
  if (active && comp == 1) {
    const float sc = inv * lam;
#pragma unroll
    for (int dt = 0; dt < 4; ++dt)
#pragma unroll
      for (int i = 0; i < 16; ++i) exch[(rg * 64 + dt * 16 + i) * 64 + lane] = O[dt][i] * sc;
  }
  __syncthreads();
  if (active && comp == 0) {
    float ss = 0.f;
#pragma unroll
    for (int dt = 0; dt < 4; ++dt)
#pragma unroll
      for (int i = 0; i < 16; ++i) {
        const float o = O[dt][i] * inv - exch[(rg * 64 + dt * 16 + i) * 64 + lane];
        O[dt][i] = o;
        ss += o * o;
      }
    ss += shx(ss, 32, lane);
    const float rs = rsqrtf(ss * (1.f / 128.f) + LN_EPS) * (1.f - lam_init);
    u16* AN = (u16*)(p.ws + WS_AN) + (size_t)(qtok0 + rg * 32 + r) * 512 + head * 128;
    const float* gw = p.in[17] + l * 512 + head * 128;
#pragma unroll
    for (int dt = 0; dt < 4; ++dt)
#pragma unroll
      for (int g = 0; g < 4; ++g) {
        const int dv = dt * 32 + 8 * g + 4 * h;
        const float4 g4 = *(const float4*)(gw + dv);
        uint2 o;
        o.x = pack2(O[dt][4 * g] * rs * g4.x, O[dt][4 * g + 1] * rs * g4.y);
        o.y = pack2(O[dt][4 * g + 2] * rs * g4.z, O[dt][4 * g + 3] * rs * g4.w);
        *(uint2*)(AN + dv) = o;
      }
  }
}

constexpr int ML_QS = 64;
constexpr int ML_KS = ML_QS + 64 * 272;
constexpr int ML_KT = ML_KS + 64 * 272;
constexpr int ML_VT = ML_KT + 128 * 144;
constexpr int ML_CB = ML_VT + 128 * 144;
constexpr int ML_HB = ML_CB + 128 * 272;
constexpr int ML_SM = ML_HB + 64 * 132 * 4;
static_assert(ML_SM + 528 * 4 <= LDS_BYTES, "lds");

DI void mlstm_item(const Params& p, int l, int b, int head, unsigned char* smem) {
  const int tid = otid(), lane = tid & 63, w = tid >> 6, r = lane & 31, h = lane >> 5;
  const bool prompt = b < 32;
  const int bs = b - 32;
  const int T = prompt ? 2048 : 32;
  const int nch = prompt ? 32 : 1;
  const int L = prompt ? 64 : 32;
  const int tokbase = prompt ? b * 2048 : TOKP + bs * 32;
  const u16* qkT = prompt ? (const u16*)(p.ws + WS_MQKT_P) + (size_t)b * 1024 * 2048 : (const u16*)(p.ws + WS_MQKT_S) + (size_t)bs * 1024 * 32;
  const u16* vTg = prompt ? (const u16*)(p.ws + WS_MVT_P) + (size_t)b * 512 * 2048 : (const u16*)(p.ws + WS_MVT_S) + (size_t)bs * 512 * 32;
  u16* qs = (u16*)(smem + ML_QS);
  u16* ksm = (u16*)(smem + ML_KS);
  u16* kTw = (u16*)(smem + ML_KT);
  u16* vT = (u16*)(smem + ML_VT);
  u16* Cbf = (u16*)(smem + ML_CB);
  float* hbuf = (float*)(smem + ML_HB);
  float* a_s = (float*)(smem + ML_SM);
  float* mx_s = a_s + 64;
  float* ws_s = a_s + 128;
  float* wi_s = a_s + 192;
  float* emt_s = a_s + 256;
  float* nq_s = a_s + 320;
  float* nvec = a_s + 384;
  float* scal = a_s + 512;

  const int vt = w & 3, kt0 = (w >> 2) * 2;
  f32x16 accC[2];
  float m_run = 0.f;
  if (prompt) {
    zero16(accC[0]); zero16(accC[1]);
    if (tid < 128) nvec[tid] = 0.f;
  } else {
    const float* Cs = p.in[6] + ((size_t)(l * 8 + bs) * 4 + head) * 128 * 128;
#pragma unroll
    for (int q = 0; q < 2; ++q)
#pragma unroll
      for (int g = 0; g < 4; ++g) {
        const float4 c4 = *(const float4*)(Cs + (size_t)(vt * 32 + r) * 128 + (kt0 + q) * 32 + 8 * g + 4 * h);
        accC[q][4 * g] = c4.x; accC[q][4 * g + 1] = c4.y; accC[q][4 * g + 2] = c4.z; accC[q][4 * g + 3] = c4.w;
      }
    if (tid < 128) nvec[tid] = p.in[7][((size_t)(l * 8 + bs) * 4 + head) * 128 + tid];
    m_run = p.in[8][(l * 8 + bs) * 4 + head];
  }
#pragma unroll
  for (int q = 0; q < 2; ++q)
#pragma unroll
    for (int g = 0; g < 4; ++g) {
      uint2 o; o.x = pack2(accC[q][4 * g], accC[q][4 * g + 1]); o.y = pack2(accC[q][4 * g + 2], accC[q][4 * g + 3]);
      *(uint2*)(Cbf + (vt * 32 + r) * 136 + (kt0 + q) * 32 + 8 * g + 4 * h) = o;
    }
  const float* gatesp = (const float*)(p.ws + WS_GATES);
  const int vi = w >> 1, ti = w & 1;

  float ig_n = -INFINITY, fg_n = 0.f;
  if (w == 0 && lane < L) {
    const float* gp = gatesp + (size_t)(tokbase + lane) * 8;
    ig_n = gp[head]; fg_n = gp[4 + head];
  }
  for (int c = 0; c < nch; ++c) {
    const int t0 = c * 64;
    if (w == 0) {
      const int t = lane;
      float ig = -INFINITY, lf = 0.f;
      if (t < L) {
        ig = ig_n;
        const float fg = fg_n;
        lf = fminf(fg, 0.f) - log1pf(__expf(-fabsf(fg)));
        if (c + 1 < nch) {
          const float* gp = gatesp + (size_t)(tokbase + t0 + 64 + t) * 8;
          ig_n = gp[head]; fg_n = gp[4 + head];
        }
      }
      float bc = lf;
#pragma unroll
      for (int off = 1; off < 64; off <<= 1) { const float v = shidx(bc, lane - off, lane); if (lane >= off) bc += v; }
      const float a = ig - bc;
      float M = a;
#pragma unroll
      for (int off = 1; off < 64; off <<= 1) { const float v = shidx(M, lane - off, lane); if (lane >= off) M = fmaxf(M, v); }
      const float mx = fmaxf(m_run, M);
      const float bL = shidx(bc, 63, lane);
      const float mxL = shidx(mx, 63, lane);
      a_s[t] = a; mx_s[t] = mx;
      ws_s[t] = __expf(a - mxL);
      wi_s[t] = __expf(m_run - mx);
      emt_s[t] = __expf(-(bc + mx));
      if (lane == 0) scal[1] = __expf(m_run - mxL);
      m_run = bL + mxL;
    }
    const int ch2 = tid >> 1, th = tid & 1;
    const bool isk = ch2 >= 128;
    const int dd = ch2 & 127;
    const int ch = (isk ? 512 : 0) + head * 128 + dd;
    const u16* rp = qkT + (size_t)ch * T + t0 + th * 32;
    float um3 = 0.f, um2 = 0.f, um1 = 0.f;
    const bool ldrow = prompt || th == 0;
    uint4 uu0 = make_uint4(0, 0, 0, 0), uu1 = uu0, uu2 = uu0, uu3 = uu0, vv0 = uu0, vv1 = uu0;
    if (ldrow) { uu0 = *(const uint4*)(rp); uu1 = *(const uint4*)(rp + 8); uu2 = *(const uint4*)(rp + 16); uu3 = *(const uint4*)(rp + 24); }
    {
      const int row = tid >> 3, cc = tid & 7;
      if (prompt || cc < 4) {
        vv0 = *(const uint4*)(vTg + (size_t)(head * 128 + row) * T + t0 + cc * 8);
        vv1 = *(const uint4*)(vTg + (size_t)(head * 128 + row + 64) * T + t0 + cc * 8);
      }
    }
    if (prompt) {
      if (th == 1 || c > 0) {
        const uint2 pv = *(const uint2*)(rp - 4);
        um3 = bfhi(pv.x); um2 = bflo(pv.y); um1 = bfhi(pv.y);
      }
    } else if (th == 0) {
      const float* cvp = p.in[9] + (size_t)(l * 8 + bs) * 3 * 1024 + ch;
      um3 = cvp[0]; um2 = cvp[1024]; um1 = cvp[2048];
    }
    const float cw0 = p.in[14][(l * 4 + 0) * 1024 + ch], cw1 = p.in[14][(l * 4 + 1) * 1024 + ch];
    const float cw2 = p.in[14][(l * 4 + 2) * 1024 + ch], cw3 = p.in[14][(l * 4 + 3) * 1024 + ch];
    const float cb = p.in[15][l * 1024 + ch];
    __syncthreads();
    {
      u16* dstrm = (isk ? ksm : qs) + (th * 32) * 136 + dd;
      const float oscale = isk ? 0.08838834764831845f : 1.f;
#pragma unroll
      for (int i = 0; i < 4; ++i) {
        const uint4 uu = (i == 0) ? uu0 : (i == 1 ? uu1 : (i == 2 ? uu2 : uu3));
        float u[8];
        u[0] = bflo(uu.x); u[1] = bfhi(uu.x); u[2] = bflo(uu.y); u[3] = bfhi(uu.y);
        u[4] = bflo(uu.z); u[5] = bfhi(uu.z); u[6] = bflo(uu.w); u[7] = bfhi(uu.w);
        float y[8];
#pragma unroll
        for (int e = 0; e < 8; ++e) {
          const float x3 = (e >= 3) ? u[e - 3] : (e == 0 ? um3 : (e == 1 ? um2 : um1));
          const float x2 = (e >= 2) ? u[e - 2] : (e == 0 ? um2 : um1);
          const float x1 = (e >= 1) ? u[e - 1] : um1;
          const float yy = cb + cw0 * x3 + cw1 * x2 + cw2 * x1 + cw3 * u[e];
          y[e] = siluf_(yy) * oscale;
        }
        um3 = u[5]; um2 = u[6]; um1 = u[7];
#pragma unroll
        for (int e = 0; e < 8; ++e) dstrm[(i * 8 + e) * 136] = f2bf(y[e]);
        if (isk) {
          const float4 w0 = *(const float4*)(ws_s + th * 32 + i * 8);
          const float4 w1 = *(const float4*)(ws_s + th * 32 + i * 8 + 4);
          uint4 o;
          o.x = pack2(y[0] * w0.x, y[1] * w0.y); o.y = pack2(y[2] * w0.z, y[3] * w0.w);
          o.z = pack2(y[4] * w1.x, y[5] * w1.y); o.w = pack2(y[6] * w1.z, y[7] * w1.w);
          *(uint4*)(kTw + dd * 72 + th * 32 + i * 8) = o;
        }
      }
      {
        const int row = tid >> 3, cc = tid & 7;
        *(uint4*)(vT + row * 72 + cc * 8) = vv0;
        *(uint4*)(vT + (row + 64) * 72 + cc * 8) = vv1;
      }
    }
    __syncthreads();
    {
      const int t = tid >> 3, part = tid & 7;
      const uint4 q0 = *(const uint4*)(qs + t * 136 + part * 16);
      const uint4 q1 = *(const uint4*)(qs + t * 136 + part * 16 + 8);
      const float* nv = nvec + part * 16;
      float s = bflo(q0.x) * nv[0] + bfhi(q0.x) * nv[1] + bflo(q0.y) * nv[2] + bfhi(q0.y) * nv[3]
              + bflo(q0.z) * nv[4] + bfhi(q0.z) * nv[5] + bflo(q0.w) * nv[6] + bfhi(q0.w) * nv[7]
              + bflo(q1.x) * nv[8] + bfhi(q1.x) * nv[9] + bflo(q1.y) * nv[10] + bfhi(q1.y) * nv[11]
              + bflo(q1.z) * nv[12] + bfhi(q1.z) * nv[13] + bflo(q1.w) * nv[14] + bfhi(q1.w) * nv[15];
      s += shx(s, 1, lane); s += shx(s, 2, lane); s += shx(s, 4, lane);
      if (part == 0) nq_s[t] = s;
    }
    f32x16 accS[2], accO;
    zero16(accS[0]); zero16(accS[1]); zero16(accO);
    {
#pragma unroll
      for (int ks = 0; ks < 8; ++ks) {
        const bf16x8 qfr = *(const bf16x8*)(qs + (ti * 32 + r) * 136 + ks * 16 + h * 8);
        const bf16x8 k0 = *(const bf16x8*)(ksm + r * 136 + ks * 16 + h * 8);
        accS[0] = MFMA(k0, qfr, accS[0]);
        if (ti == 1) {
          const bf16x8 k1 = *(const bf16x8*)(ksm + (32 + r) * 136 + ks * 16 + h * 8);
          accS[1] = MFMA(k1, qfr, accS[1]);
        }
        const bf16x8 cf = *(const bf16x8*)(Cbf + (vi * 32 + r) * 136 + ks * 16 + h * 8);
        accO = MFMA(cf, qfr, accO);
      }
    }
    const int tcol = ti * 32 + r;
    const float mxt = mx_s[tcol];
    const float wit = wi_s[tcol];
    float dsum = 0.f;
#pragma unroll
    for (int sub = 0; sub < 2; ++sub) {
      if (sub <= ti) {
#pragma unroll
        for (int g = 0; g < 4; ++g) {
          const float4 a4 = *(const float4*)(a_s + sub * 32 + 8 * g + 4 * h);
          const float av[4] = {a4.x, a4.y, a4.z, a4.w};
#pragma unroll
          for (int e = 0; e < 4; ++e) {
            const int s = sub * 32 + 8 * g + 4 * h + e;
            const float wgt = (s <= tcol) ? __expf(av[e] - mxt) : 0.f;
            const float pv = accS[sub][4 * g + e] * wgt;
            accS[sub][4 * g + e] = pv;
            dsum += pv;
          }
        }
      }
    }
    dsum += shx(dsum, 32, lane);
#pragma unroll
    for (int i = 0; i < 16; ++i) accO[i] *= wit;
#pragma unroll
    for (int sub = 0; sub < 2; ++sub) {
      if (sub <= ti) {
#pragma unroll
        for (int s2 = 0; s2 < 2; ++s2) {
          const bf16x8 pf = pack8(accS[sub], s2);
          const u16* va = vT + (vi * 32 + r) * 72 + sub * 32 + s2 * 16 + 4 * h;
          const uint2 lo = *(const uint2*)va;
          const uint2 hi = *(const uint2*)(va + 8);
          const uint4 vq = make_uint4(lo.x, lo.y, hi.x, hi.y);
          accO = MFMA(__builtin_bit_cast(bf16x8, vq), pf, accO);
        }
      }
    }
    __syncthreads();
    {
      const float den = dsum + wit * nq_s[tcol];
      const float dn = fmaxf(fabsf(den), emt_s[tcol]);
      const float rinv = 1.f / dn;
#pragma unroll
      for (int g = 0; g < 4; ++g)
        *(float4*)(hbuf + tcol * 132 + vi * 32 + 8 * g + 4 * h) =
            make_float4(accO[4 * g] * rinv, accO[4 * g + 1] * rinv, accO[4 * g + 2] * rinv, accO[4 * g + 3] * rinv);
    }
    {
      const float wc = scal[1];
#pragma unroll
      for (int q = 0; q < 2; ++q)
#pragma unroll
        for (int i = 0; i < 16; ++i) accC[q][i] *= wc;
#pragma unroll
      for (int k4 = 0; k4 < 4; ++k4) {
        const bf16x8 vf = *(const bf16x8*)(vT + (vt * 32 + r) * 72 + k4 * 16 + h * 8);
#pragma unroll
        for (int q = 0; q < 2; ++q) {
          const bf16x8 kf = *(const bf16x8*)(kTw + ((kt0 + q) * 32 + r) * 72 + k4 * 16 + h * 8);
          accC[q] = MFMA(kf, vf, accC[q]);
        }
      }
#pragma unroll
      for (int q = 0; q < 2; ++q)
#pragma unroll
        for (int g = 0; g < 4; ++g) {
          uint2 o; o.x = pack2(accC[q][4 * g], accC[q][4 * g + 1]); o.y = pack2(accC[q][4 * g + 2], accC[q][4 * g + 3]);
          *(uint2*)(Cbf + (vt * 32 + r) * 136 + (kt0 + q) * 32 + 8 * g + 4 * h) = o;
        }
      if (tid < 128) {
        float s = 0.f;
#pragma unroll
        for (int i = 0; i < 8; ++i) {
          const uint4 kk = *(const uint4*)(kTw + tid * 72 + i * 8);
          s += bflo(kk.x) + bfhi(kk.x) + bflo(kk.y) + bfhi(kk.y) + bflo(kk.z) + bfhi(kk.z) + bflo(kk.w) + bfhi(kk.w);
        }
        nvec[tid] = wc * nvec[tid] + s;
      }
    }
    __syncthreads();
    {
      const int t = tid >> 3, part = tid & 7;
      float x[16];
#pragma unroll
      for (int i = 0; i < 4; ++i) {
        const float4 f = *(const float4*)(hbuf + t * 132 + part * 16 + i * 4);
        x[i * 4] = f.x; x[i * 4 + 1] = f.y; x[i * 4 + 2] = f.z; x[i * 4 + 3] = f.w;
      }
      float s = 0.f;
#pragma unroll
      for (int i = 0; i < 16; ++i) s += x[i];
      s += shx(s, 1, lane); s += shx(s, 2, lane); s += shx(s, 4, lane);
      const float mean = s * (1.f / 128.f);
      float q = 0.f;
#pragma unroll
      for (int i = 0; i < 16; ++i) { x[i] -= mean; q += x[i] * x[i]; }
      q += shx(q, 1, lane); q += shx(q, 2, lane); q += shx(q, 4, lane);
      const float rstd = rsqrtf(q * (1.f / 128.f) + LN_EPS);
      if (t < L) {
        const size_t tok = (size_t)tokbase + t0 + t;
        const int cbase = head * 128 + part * 16;
        const float* gw = p.in[18] + l * 512 + cbase;
        const u16* mo = (const u16*)(p.ws + WS_MO) + tok * 512 + cbase;
        const uint4 m0 = *(const uint4*)mo;
        const uint4 m1 = *(const uint4*)(mo + 8);
        const float sg[16] = {bflo(m0.x), bfhi(m0.x), bflo(m0.y), bfhi(m0.y), bflo(m0.z), bfhi(m0.z), bflo(m0.w), bfhi(m0.w),
                              bflo(m1.x), bfhi(m1.x), bflo(m1.y), bfhi(m1.y), bflo(m1.z), bfhi(m1.z), bflo(m1.w), bfhi(m1.w)};
        float yv[16];
#pragma unroll
        for (int i = 0; i < 16; ++i) yv[i] = x[i] * rstd * gw[i] * sg[i];
        uint4 o0, o1;
        o0.x = pack2(yv[0], yv[1]); o0.y = pack2(yv[2], yv[3]); o0.z = pack2(yv[4], yv[5]); o0.w = pack2(yv[6], yv[7]);
        o1.x = pack2(yv[8], yv[9]); o1.y = pack2(yv[10], yv[11]); o1.z = pack2(yv[12], yv[13]); o1.w = pack2(yv[14], yv[15]);
        u16* mn = (u16*)(p.ws + WS_MN) + tok * 512 + cbase;
        *(uint4*)mn = o0;
        *(uint4*)(mn + 8) = o1;
      }
    }
  }
  {
    float* oc = p.out + (prompt ? O_CP + ((size_t)(l * 32 + b) * 4 + head) * 16384 : O_CS + ((size_t)(l * 8 + bs) * 4 + head) * 16384);
#pragma unroll
    for (int q = 0; q < 2; ++q)
#pragma unroll
      for (int g = 0; g < 4; ++g)
        *(float4*)(oc + (size_t)(vt * 32 + r) * 128 + (kt0 + q) * 32 + 8 * g + 4 * h) =
            make_float4(accC[q][4 * g], accC[q][4 * g + 1], accC[q][4 * g + 2], accC[q][4 * g + 3]);
    float* on = p.out + (prompt ? O_NP + ((size_t)(l * 32 + b) * 4 + head) * 128 : O_NS + ((size_t)(l * 8 + bs) * 4 + head) * 128);
    if (tid < 128) on[tid] = nvec[tid];
    if (tid == 0) {
      if (prompt) p.out[O_MP + (size_t)(l * 32 + b) * 4 + head] = m_run;
      else p.out[O_MS + (size_t)(l * 8 + bs) * 4 + head] = m_run;
    }
  }
}

DI void phase_mixers(const Params& p, int l, unsigned char* smem) {
  const int tid0 = otid();
  const int lane = tid0 & 63;
  const float* lp = p.in[16] + l * 256;
  float s1 = lp[lane] * lp[64 + lane], s2 = lp[128 + lane] * lp[192 + lane];
  s1 = wave_sum(s1, lane); s2 = wave_sum(s2, lane);
  const float lam_init = 0.8f - 0.6f * expf(-0.3f * (float)l);
  const float lam = expf(s1) - expf(s2) + lam_init;
  int* ctr = (int*)(p.ws + WS_CTR) + l;
  int* sitem = (int*)smem;
  const int N_ML = 160, N_AT = 2048 + 32;
  for (;;) {
    __syncthreads();
    if (tid0 == 0) *sitem = atomicAdd(ctr, 1);
    __syncthreads();
    const int item = *sitem;
    if (item >= N_ML + N_AT) break;
    if (item < N_ML) {
#ifndef NO_ML
      mlstm_item(p, l, item >> 2, item & 3, smem);
#endif
    } else {
#ifndef NO_AT
      const int a = item - N_ML;
      if (a < 2048) {
        const int qt = 15 - (a >> 7), rest = a & 127;
        attn_item(p, l, rest >> 2, rest & 3, qt, lam, lam_init, smem);
      } else {
        const int s = a - 2048;
        attn_item(p, l, 32 + (s >> 2), s & 3, 0, lam, lam_init, smem);
      }
#endif
    }
  }
}

DI void gbar(unsigned* bar, unsigned& epoch) {
  __syncthreads();
  epoch += gridDim.x;
  if (otid() == 0) {
    __threadfence();
    __hip_atomic_fetch_add(bar, 1u, __ATOMIC_RELAXED, __HIP_MEMORY_SCOPE_AGENT);
    while (__hip_atomic_load(bar, __ATOMIC_RELAXED, __HIP_MEMORY_SCOPE_AGENT) < epoch) __builtin_amdgcn_s_sleep(2);
    __threadfence();
  }
  __syncthreads();
}

__global__ void __launch_bounds__(NTHR) fwd_megakernel(Params p) {
  extern __shared__ __attribute__((aligned(16))) unsigned char smem[];
  cg::grid_group grid = cg::this_grid();
#ifndef PH
#define PH 0xffff
#endif
  unsigned* bar = (unsigned*)(p.ws + WS_CTR + 64);
  unsigned epoch = 0;
  if (PH & 1) prologue(p, smem);
  grid.sync();
  if (PH & 1) prologue(p, smem);
  grid.sync();
  if (PH & 2) ln_pass(p, 0, 0, smem);
  gbar(bar, epoch);
#pragma unroll 1
  for (int l = 0; l < 2; ++l) {
    if (PH & 4) phase_in_gate(p, l, smem);
    gbar(bar, epoch);
    if (PH & 8) phase_mixers(p, l, smem);
    gbar(bar, epoch);
    if (PH & 16) phase_mix(p, l, smem);
    gbar(bar, epoch);
    if (PH & 32) phase_res(p, l, 0, smem);
    gbar(bar, epoch);
    if (PH & 64) ln_pass(p, 1, l, smem);
    gbar(bar, epoch);
    if (PH & 128) phase_gu(p, l, smem);
    gbar(bar, epoch);
    if (PH & 256) phase_res(p, l, 1, smem);
    gbar(bar, epoch);
    if (PH & 512) ln_pass(p, 2, l, smem);
    if (l == 0) gbar(bar, epoch);
  }
}

extern "C" void kernel_launch(void* const* d_in, const int* in_sizes, int n_in, void* d_out, int out_size, void* d_ws,
                              size_t ws_size, hipStream_t stream) {
  static int grid_blocks = 0;
  if (!grid_blocks) {
    int dev = 0, cus = 0, per_cu = 0;
    hipGetDevice(&dev);
    hipDeviceGetAttribute(&cus, hipDeviceAttributeMultiprocessorCount, dev);
    if (hipFuncSetAttribute((const void*)fwd_megakernel, hipFuncAttributeMaxDynamicSharedMemorySize, LDS_BYTES) != hipSuccess)
      fprintf(stderr, "kernel_launch: hipFuncSetAttribute failed\n");
    if (hipOccupancyMaxActiveBlocksPerMultiprocessor(&per_cu, (const void*)fwd_megakernel, NTHR, LDS_BYTES) != hipSuccess || per_cu < 1) {
      fprintf(stderr, "kernel_launch: occupancy query gave %d\n", per_cu);
      per_cu = 1;
    }
    (void)hipGetLastError();
    grid_blocks = cus * per_cu;
    if (ws_size < WS_END) fprintf(stderr, "kernel_launch: workspace too small: %zu < %zu\n", ws_size, (size_t)WS_END);
  }
  if (hipMemsetAsync((char*)d_ws + WS_CTR, 0, 256, stream) != hipSuccess) fprintf(stderr, "kernel_launch: memset failed\n");
  Params p{};
  for (int i = 0; i < 30; ++i) p.in[i] = (const float*)d_in[i];
  p.out = (float*)d_out;
  p.ws = (unsigned char*)d_ws;
  void* args[] = {&p};
  hipError_t e = hipLaunchCooperativeKernel((const void*)fwd_megakernel, dim3(grid_blocks), dim3(NTHR), args, LDS_BYTES, stream);
  if (e != hipSuccess) fprintf(stderr, "cooperative launch failed: %s (grid %d)\n", hipGetErrorString(e), grid_blocks);
}
```

```cpp
#include <hip/hip_runtime.h>
#include <hip/hip_cooperative_groups.h>
#include <cstdio>
namespace cg = cooperative_groups;

#define DI __device__ __forceinline__
typedef unsigned short u16;
using bf16x8 = __attribute__((ext_vector_type(8))) short;
using f32x16 = __attribute__((ext_vector_type(16))) float;
#define MFMA(a, b, c) __builtin_amdgcn_mfma_f32_32x32x16_bf16((a), (b), (c), 0, 0, 0)

constexpr int TOKP = 65536, TOKS = 256, TOK = 65792;
constexpr int NTHR = 512;
constexpr float LN_EPS = 1e-5f;
constexpr float ALPHA = 1.41421356237f;
constexpr float LOG2E = 1.44269504089f;

constexpr size_t WS_WT_IN   = 0;
constexpr size_t WS_WT_GATE = WS_WT_IN + 2ull * 3584 * 1024 * 2;
constexpr size_t WS_WT_BRA  = WS_WT_GATE + 2ull * 2048 * 1024 * 2;
constexpr size_t WS_WT_BRB  = WS_WT_BRA + 2ull * 1024 * 512 * 2;
constexpr size_t WS_WT_O    = WS_WT_BRB + 2ull * 1024 * 512 * 2;
constexpr size_t WS_WT_GU   = WS_WT_O + 2ull * 1024 * 1024 * 2;
constexpr size_t WS_WT_DOWN = WS_WT_GU + 2ull * 5632 * 1024 * 2;
constexpr size_t WS_MOD     = WS_WT_DOWN + 2ull * 1024 * 2816 * 2;
constexpr size_t WS_GATES   = WS_MOD + 2ull * 40 * 6144 * 4;
constexpr size_t WS_CTR     = WS_GATES + (size_t)TOK * 8 * 4;
constexpr size_t WS_KS      = WS_CTR + 256;
constexpr size_t WS_VTS     = WS_KS + 2ull * 8 * 1056 * 512 * 2 + 65536;
constexpr size_t WS_MQKT_S  = WS_VTS + 2ull * 8 * 512 * 1056 * 2 + 65536;
constexpr size_t WS_MVT_S   = WS_MQKT_S + 8ull * 1024 * 32 * 2;
constexpr size_t WS_H       = WS_MVT_S + 8ull * 512 * 32 * 2;
constexpr size_t WS_AN      = WS_H;
constexpr size_t WS_MN      = WS_H + (size_t)TOK * 512 * 2;
constexpr size_t WS_ZQ      = WS_H + (size_t)TOK * 1024 * 2;
constexpr size_t WS_KB      = WS_ZQ + (size_t)TOK * 512 * 2;
constexpr size_t WS_VTP     = WS_KB + (size_t)TOKP * 512 * 2;
constexpr size_t WS_MQKT_P  = WS_VTP + 32ull * 512 * 2048 * 2;
constexpr size_t WS_MVT_P   = WS_MQKT_P + 32ull * 1024 * 2048 * 2;
constexpr size_t WS_MO      = WS_MVT_P + 32ull * 512 * 2048 * 2;
constexpr size_t WS_G       = WS_MO + (size_t)TOK * 512 * 2;
constexpr size_t WS_END     = WS_G + (size_t)TOK * 2048 * 2;
constexpr size_t WS_MIX     = WS_ZQ;
constexpr size_t WS_ACT     = WS_ZQ;

constexpr size_t O_YP  = 0;
constexpr size_t O_YS  = O_YP + (size_t)TOKP * 1024;
constexpr size_t O_KP  = O_YS + (size_t)TOKS * 1024;
constexpr size_t O_VP  = O_KP + 2ull * TOKP * 512;
constexpr size_t O_KSM = O_VP + 2ull * TOKP * 512;
constexpr size_t O_VSM = O_KSM + 2ull * TOKS * 512;
constexpr size_t O_CP  = O_VSM + 2ull * TOKS * 512;
constexpr size_t O_NP  = O_CP + 2ull * 32 * 4 * 128 * 128;
constexpr size_t O_MP  = O_NP + 2ull * 32 * 4 * 128;
constexpr size_t O_CVP = O_MP + 2ull * 32 * 4;
constexpr size_t O_CS  = O_CVP + 2ull * 32 * 3 * 1024;
constexpr size_t O_NS  = O_CS + 2ull * 8 * 4 * 128 * 128;
constexpr size_t O_MS  = O_NS + 2ull * 8 * 4 * 128;
constexpr size_t O_CVS = O_MS + 2ull * 8 * 4;

constexpr int LDS_BYTES = 148480;

struct Params {
  const float* in[30];
  float* out;
  unsigned char* ws;
};

DI u16 f2bf(float x) { unsigned u = __float_as_uint(x); u += 0x7fffu + ((u >> 16) & 1u); return (u16)(u >> 16); }
DI float bf2f(unsigned v) { return __uint_as_float(v << 16); }
typedef __bf16 bf16x2_t __attribute__((ext_vector_type(2)));
typedef float f32x2_t __attribute__((ext_vector_type(2)));
DI unsigned pack2(float a, float b) {
  f32x2_t v = {a, b};
  return __builtin_bit_cast(unsigned, __builtin_convertvector(v, bf16x2_t));
}
DI float bflo(unsigned v) { return __uint_as_float(v << 16); }
DI float bfhi(unsigned v) { return __uint_as_float(v & 0xffff0000u); }
DI float sigmoidf_(float x) { return 1.f / (1.f + __expf(-x)); }
DI float siluf_(float x) { return x / (1.f + __expf(-x)); }
DI float fexp2(float x) { return __builtin_amdgcn_exp2f(x); }
DI int otid() { int t = threadIdx.x; asm volatile("" : "+v"(t)); return t; }
DI float shx(float v, int mask, int lane) { return __int_as_float(__builtin_amdgcn_ds_bpermute(((lane ^ mask) & 63) << 2, __float_as_int(v))); }
DI float shidx(float v, int src, int lane) { (void)lane; return __int_as_float(__builtin_amdgcn_ds_bpermute((src & 63) << 2, __float_as_int(v))); }
DI int crow(int i, int h) { return (i & 3) + 8 * (i >> 2) + 4 * h; }
DI bf16x8 pack8(const f32x16& x, int s) {
  uint4 u;
  u.x = pack2(x[8 * s + 0], x[8 * s + 1]); u.y = pack2(x[8 * s + 2], x[8 * s + 3]);
  u.z = pack2(x[8 * s + 4], x[8 * s + 5]); u.w = pack2(x[8 * s + 6], x[8 * s + 7]);
  return __builtin_bit_cast(bf16x8, u);
}
DI void zero16(f32x16& a) {
#pragma unroll
  for (int i = 0; i < 16; ++i) a[i] = 0.f;
}
DI int batch_of_row(int row) { return row < TOKP ? (row >> 11) : 32 + ((row - TOKP) >> 5); }

constexpr int GS_STRIDE = 144;
constexpr int GS_STAGE = 512 * GS_STRIDE;
constexpr int GS_BASE = 64;

DI void gemm_mainloop(f32x16 (&acc)[4][2], const u16* __restrict__ A, int lda, const u16* __restrict__ Wt, int ldw, int K,
                      int m0, int n0, unsigned char* smem) {
  const int tid = otid(), lane = tid & 63, w = tid >> 6;
  const int wm = w >> 2, wn = w & 3, r = lane & 31, h = lane >> 5;
  const int lrow = tid >> 3, lcc = tid & 7;
  const u16* ap = A + (size_t)(m0 + lrow) * lda + lcc * 8;
  const int bn = n0 + 2 * (lrow & 31) + ((lrow >> 5) & 1);
  const u16* bp = Wt + (size_t)bn * ldw + lcc * 8;
  const size_t astep = (size_t)64 * lda, bstep = (size_t)64 * ldw;
  unsigned char* sbase = smem + GS_BASE;
  const int woff = lrow * GS_STRIDE + lcc * 16;
  const int nk = K >> 6;
  uint4 s0, s1, s2, s3, s4, s5, s6, s7, u0, u1, u2, u3, u4, u5, u6, u7;
  int kn = 1;
#define G_ADV() do { const int adv = (kn < nk) ? 64 : 0; ap += adv; bp += adv; ++kn; } while (0)
#define G_ISSUE_A() do { s0 = *(const uint4*)(ap); s1 = *(const uint4*)(ap + astep); s2 = *(const uint4*)(ap + 2 * astep); s3 = *(const uint4*)(ap + 3 * astep); \
    s4 = *(const uint4*)(bp); s5 = *(const uint4*)(bp + bstep); s6 = *(const uint4*)(bp + 2 * bstep); s7 = *(const uint4*)(bp + 3 * bstep); } while (0)
#define G_ISSUE_B() do { u0 = *(const uint4*)(ap); u1 = *(const uint4*)(ap + astep); u2 = *(const uint4*)(ap + 2 * astep); u3 = *(const uint4*)(ap + 3 * astep); \
    u4 = *(const uint4*)(bp); u5 = *(const uint4*)(bp + bstep); u6 = *(const uint4*)(bp + 2 * bstep); u7 = *(const uint4*)(bp + 3 * bstep); } while (0)
#define G_WRITE_A(sn) do { *(uint4*)((sn) + woff) = s0; *(uint4*)((sn) + woff + 64 * GS_STRIDE) = s1; *(uint4*)((sn) + woff + 128 * GS_STRIDE) = s2; \
    *(uint4*)((sn) + woff + 192 * GS_STRIDE) = s3; *(uint4*)((sn) + woff + 256 * GS_STRIDE) = s4; *(uint4*)((sn) + woff + 320 * GS_STRIDE) = s5; \
    *(uint4*)((sn) + woff + 384 * GS_STRIDE) = s6; *(uint4*)((sn) + woff + 448 * GS_STRIDE) = s7; } while (0)
#define G_WRITE_B(sn) do { *(uint4*)((sn) + woff) = u0; *(uint4*)((sn) + woff + 64 * GS_STRIDE) = u1; *(uint4*)((sn) + woff + 128 * GS_STRIDE) = u2; \
    *(uint4*)((sn) + woff + 192 * GS_STRIDE) = u3; *(uint4*)((sn) + woff + 256 * GS_STRIDE) = u4; *(uint4*)((sn) + woff + 320 * GS_STRIDE) = u5; \
    *(uint4*)((sn) + woff + 384 * GS_STRIDE) = u6; *(uint4*)((sn) + woff + 448 * GS_STRIDE) = u7; } while (0)
  const int aoff = (wm * 128 + r) * GS_STRIDE + h * 16;
  const int boff = (256 + wn * 64 + r) * GS_STRIDE + h * 16;
#define G_COMPUTE(st) do { _Pragma("unroll") for (int ks = 0; ks < 4; ++ks) {                                              \
      bf16x8 fa[4], fb[2];                                                                                               \
      _Pragma("unroll") for (int mi = 0; mi < 4; ++mi) fa[mi] = *(const bf16x8*)((st) + aoff + mi * 32 * GS_STRIDE + ks * 32); \
      fb[0] = *(const bf16x8*)((st) + boff + ks * 32);                                                                   \
      fb[1] = *(const bf16x8*)((st) + boff + 32 * GS_STRIDE + ks * 32);                                                  \
      _Pragma("unroll") for (int mi = 0; mi < 4; ++mi) {                                                                 \
        acc[mi][0] = MFMA(fa[mi], fb[0], acc[mi][0]);                                                                    \
        acc[mi][1] = MFMA(fa[mi], fb[1], acc[mi][1]);                                                                    \
      }                                                                                                                  \
      __builtin_amdgcn_sched_barrier(0);                                                                                 \
    } } while (0)
  G_ISSUE_A();
  G_WRITE_A(sbase);
  G_ADV(); G_ISSUE_A();
  G_ADV(); G_ISSUE_B();
  __syncthreads();
  for (int kt = 0; kt < nk; kt += 2) {
    G_WRITE_A(sbase + GS_STAGE);
    G_ADV(); G_ISSUE_A();
    __builtin_amdgcn_sched_barrier(0);
    G_COMPUTE(sbase);
    __syncthreads();
    G_WRITE_B(sbase);
    G_ADV(); G_ISSUE_B();
    __builtin_amdgcn_sched_barrier(0);
    G_COMPUTE(sbase + GS_STAGE);
    __syncthreads();
  }
#undef G_ADV
#undef G_ISSUE_A
#undef G_ISSUE_B
#undef G_WRITE_A
#undef G_WRITE_B
#undef G_COMPUTE
}

DI int rot_unused_(int) { return 0; }
DI bool tile_of(int i, int MT, int NT, int& mt, int& nt) {
  const int per = gridDim.x >> 3;
  const int L = i * (int)gridDim.x + (int)(blockIdx.x & 7) * per + (int)(blockIdx.x >> 3);
  if (L >= MT * NT) return false;
  const int nig = 8 * NT, gid = L / nig, fm = gid * 8, gsz = min(MT - fm, 8), rem = L - gid * nig;
  mt = fm + rem % gsz; nt = rem / gsz;
  return true;
}


template <class PF, class EF>
DI void gemm_stream(int lda, int ldw, int K, unsigned char* smem, PF ptrs, EF epi) {
  const int tid = otid(), lane = tid & 63, w = tid >> 6;
  const int wm = w >> 2, wn = w & 3, r = lane & 31, h = lane >> 5;
  unsigned char* sbase = smem + GS_BASE;
  constexpr int SLOT = 512 * 64;
  const int nh = K >> 5;
  const int c0 = (h ^ ((r >> 2) & 3)) * 16, c1 = c0 ^ 32;
  const int aoff = (wm * 128 + r) * 64, boff = (256 + wn * 64 + r) * 64;
  const int lr16 = lane >> 2, lchunk = (lane & 3) ^ ((lane >> 4) & 3);
  const bool isB = w >= 4;
  const unsigned goff = isB ? (unsigned)((((w - 4) * 64 + 2 * lr16) * ldw + lchunk * 8) * 2)
                            : (unsigned)(((w * 64 + lr16) * lda + lchunk * 8) * 2);
  const unsigned st1 = isB ? (unsigned)(32 * ldw * 2) : (unsigned)(16 * lda * 2);
  const unsigned st2 = isB ? (unsigned)(1 * ldw * 2) : (unsigned)(32 * lda * 2);
#define WAIT_V(n) asm volatile("s_waitcnt vmcnt(" #n ")" ::: "memory")
#define RAWBAR() do { asm volatile("s_waitcnt lgkmcnt(0)" ::: "memory"); __builtin_amdgcn_s_barrier(); asm volatile("" ::: "memory"); } while (0)
#define BAR0() do { asm volatile("" ::: "memory"); __builtin_amdgcn_s_barrier(); asm volatile("" ::: "memory"); } while (0)
#define H_DMA(slotp) do { const char* gsrc_ = (isB ? bp : ap) + goff; unsigned char* ld_ = (slotp) + w * 4096;            \
    __builtin_amdgcn_global_load_lds((const unsigned*)(gsrc_), (unsigned*)(ld_), 16, 0, 0);                                  \
    __builtin_amdgcn_global_load_lds((const unsigned*)(gsrc_ + st1), (unsigned*)(ld_ + 1024), 16, 0, 0);                     \
    __builtin_amdgcn_global_load_lds((const unsigned*)(gsrc_ + st2), (unsigned*)(ld_ + 2048), 16, 0, 0);                     \
    __builtin_amdgcn_global_load_lds((const unsigned*)(gsrc_ + st2 + st1), (unsigned*)(ld_ + 3072), 16, 0, 0); } while (0)
#define H_READ(sl) do { _Pragma("unroll") for (int mi = 0; mi < 4; ++mi) {                                                   \
      fa[0][mi] = *(const bf16x8*)((sl) + aoff + mi * 2048 + c0); fa[1][mi] = *(const bf16x8*)((sl) + aoff + mi * 2048 + c1); } \
    fb[0][0] = *(const bf16x8*)((sl) + boff + c0); fb[1][0] = *(const bf16x8*)((sl) + boff + c1);                            \
    fb[0][1] = *(const bf16x8*)((sl) + boff + 2048 + c0); fb[1][1] = *(const bf16x8*)((sl) + boff + 2048 + c1); } while (0)
#define H_MMA() do { _Pragma("unroll") for (int ks = 0; ks < 2; ++ks) { _Pragma("unroll") for (int mi = 0; mi < 4; ++mi) {  \
      acc[mi][0] = MFMA(fa[ks][mi], fb[ks][0], acc[mi][0]);                                                       \
      acc[mi][1] = MFMA(fa[ks][mi], fb[ks][1], acc[mi][1]); } } } while (0)
  for (int it = 0;; ++it) {
    const char *ap, *bp;
    {
      const u16 *ta, *tb;
      if (!ptrs(it, ta, tb)) break;
      ap = (const char*)ta; bp = (const char*)tb;
    }
    f32x16 acc[4][2];
#pragma unroll
    for (int a = 0; a < 4; ++a)
#pragma unroll
      for (int b = 0; b < 2; ++b) zero16(acc[a][b]);
    H_DMA(sbase); ap += 64; bp += 64;
    H_DMA(sbase + SLOT); ap += 64; bp += 64;
    H_DMA(sbase + 2 * SLOT); ap += 64; bp += 64;
    WAIT_V(8);
    BAR0();
    if (wm == 1) BAR0();
    int rs = 0;
#pragma unroll 1
    for (int hh = 0; hh < nh; ++hh) {
      bf16x8 fa[2][4], fb[2][2];
      const int rem = nh - 2 - hh;
      H_READ(sbase + rs * SLOT);
      if (hh + 3 < nh) { H_DMA(sbase + ((rs + 3) & 3) * SLOT); ap += 64; bp += 64; }
      if (wm == 1) {
        if (rem >= 2) WAIT_V(8); else if (rem == 1) WAIT_V(4); else WAIT_V(0);
      }
      __builtin_amdgcn_sched_barrier(0);
      RAWBAR();
      __builtin_amdgcn_sched_barrier(0);
      H_MMA();
      __builtin_amdgcn_sched_barrier(0);
      if (wm == 0) {
        if (rem >= 2) WAIT_V(8); else if (rem == 1) WAIT_V(4); else WAIT_V(0);
      }
      BAR0();
      rs = (rs + 1) & 3;
    }
    if (wm == 0) BAR0();
    epi(it, acc);
  }
#undef WAIT_V
#undef RAWBAR
#undef BAR0
#undef H_DMA
#undef H_READ
#undef H_MMA
}

DI int map_row(int maptype, int s) {
  if (maptype == 1) return s < 3072 ? s : (s < 3080 ? -1 : s - 8);
  if (maptype == 2) return s < 2816 ? 2 * s : 2 * (s - 2816) + 1;
  return s;
}
DI void transpose_task(const float* __restrict__ src, int Nsrc, u16* __restrict__ dst, int dld, int maptype, int kt, int nt,
                       unsigned char* smem) {
  float* tile = (float*)(smem + 64);
  const int tid = otid();
  const int k0 = kt * 64, s0 = nt * 64;
#pragma unroll
  for (int i = 0; i < 2; ++i) {
    const int kr = (tid >> 4) + 32 * i, nc = (tid & 15) * 4;
    float4 v = make_float4(0.f, 0.f, 0.f, 0.f);
    if (s0 + nc < Nsrc) v = *(const float4*)(src + (size_t)(k0 + kr) * Nsrc + s0 + nc);
    tile[kr * 65 + nc + 0] = v.x; tile[kr * 65 + nc + 1] = v.y; tile[kr * 65 + nc + 2] = v.z; tile[kr * 65 + nc + 3] = v.w;
  }
  __syncthreads();
  {
    const int n = tid >> 3, kc = (tid & 7) * 8;
    const int s = s0 + n;
    const int dr = (s < Nsrc) ? map_row(maptype, s) : -1;
    if (dr >= 0) {
      uint4 o;
      o.x = pack2(tile[(kc + 0) * 65 + n], tile[(kc + 1) * 65 + n]);
      o.y = pack2(tile[(kc + 2) * 65 + n], tile[(kc + 3) * 65 + n]);
      o.z = pack2(tile[(kc + 4) * 65 + n], tile[(kc + 5) * 65 + n]);
      o.w = pack2(tile[(kc + 6) * 65 + n], tile[(kc + 7) * 65 + n]);
      *(uint4*)(dst + (size_t)dr * dld + k0 + kc) = o;
    }
  }
  __syncthreads();
}

DI void adaln_task(const Params& p, int task, unsigned char* smem) {
  const int bhalf = task & 1, cg_ = (task >> 1) % 96, l = (task >> 1) / 96;
  float* cs = (float*)(smem + 64);
  float* red = (float*)(smem + 64 + 20 * 1024 * 4);
  const int tid = otid();
  const float* cp = p.in[2]; const float* csm = p.in[3];
  for (int idx = tid; idx < 20 * 1024; idx += NTHR) {
    const int bb = idx >> 10, d = idx & 1023, b = bhalf * 20 + bb;
    const float c = b < 32 ? cp[b * 1024 + d] : csm[(b - 32) * 1024 + d];
    cs[idx] = siluf_(c);
  }
  __syncthreads();
  const int dseg = tid >> 6, e = cg_ * 64 + (tid & 63);
  const float* wp = p.in[10] + ((size_t)l * 1024 + dseg * 128) * 6144 + e;
  float acc[20];
#pragma unroll
  for (int i = 0; i < 20; ++i) acc[i] = 0.f;
  for (int d = 0; d < 128; ++d) {
    const float wv = wp[(size_t)d * 6144];
    const float* c0 = cs + dseg * 128 + d;
#pragma unroll
    for (int i = 0; i < 20; ++i) acc[i] += c0[i * 1024] * wv;
  }
#pragma unroll
  for (int i = 0; i < 20; ++i) red[(dseg * 20 + i) * 64 + (tid & 63)] = acc[i];
  __syncthreads();
  float* mod = (float*)(p.ws + WS_MOD);
  for (int idx = tid; idx < 20 * 64; idx += NTHR) {
    const int bb = idx >> 6, ec = idx & 63;
    float s = 0.f;
#pragma unroll
    for (int q = 0; q < 8; ++q) s += red[(q * 20 + bb) * 64 + ec];
    const int ee = cg_ * 64 + ec;
    mod[((size_t)l * 40 + bhalf * 20 + bb) * 6144 + ee] = s + p.in[11][l * 6144 + ee];
  }
  __syncthreads();
}

DI void prologue(const Params& p, unsigned char* smem) {
  const int WT_TASKS_L = 912 + 512 + 128 + 128 + 256 + 1408 + 704;
  const int N_WT = 2 * WT_TASKS_L;
  const int N_ADA = 384, N_CK = 512, N_CV = 2048;
  const int total = N_WT + N_ADA + N_CK + N_CV;
  for (int task = blockIdx.x; task < total; task += gridDim.x) {
    if (task < N_WT) {
      const int l = task / WT_TASKS_L; int t = task % WT_TASKS_L;
      if (t < 912) { transpose_task(p.in[12] + (size_t)l * 1024 * 3592, 3592, (u16*)(p.ws + WS_WT_IN) + (size_t)l * 3584 * 1024, 1024, 1, t / 57, t % 57, smem); continue; }
      t -= 912;
      if (t < 512) { transpose_task(p.in[21] + (size_t)l * 1024 * 2048, 2048, (u16*)(p.ws + WS_WT_GATE) + (size_t)l * 2048 * 1024, 1024, 0, t / 32, t % 32, smem); continue; }
      t -= 512;
      if (t < 128) { transpose_task(p.in[19] + (size_t)l * 512 * 1024, 1024, (u16*)(p.ws + WS_WT_BRA) + (size_t)l * 1024 * 512, 512, 0, t / 16, t % 16, smem); continue; }
      t -= 128;
      if (t < 128) { transpose_task(p.in[20] + (size_t)l * 512 * 1024, 1024, (u16*)(p.ws + WS_WT_BRB) + (size_t)l * 1024 * 512, 512, 0, t / 16, t % 16, smem); continue; }
      t -= 128;
      if (t < 256) { transpose_task(p.in[23] + (size_t)l * 1024 * 1024, 1024, (u16*)(p.ws + WS_WT_O) + (size_t)l * 1024 * 1024, 1024, 0, t / 16, t % 16, smem); continue; }
      t -= 256;
      if (t < 1408) { transpose_task(p.in[26] + (size_t)l * 1024 * 5632, 5632, (u16*)(p.ws + WS_WT_GU) + (size_t)l * 5632 * 1024, 1024, 2, t / 88, t % 88, smem); continue; }
      t -= 1408;
      transpose_task(p.in[27] + (size_t)l * 2816 * 1024, 1024, (u16*)(p.ws + WS_WT_DOWN) + (size_t)l * 1024 * 2816, 2816, 0, t / 16, t % 16, smem);
    } else if (task < N_WT + N_ADA) {
      adaln_task(p, task - N_WT, smem);
    } else if (task < N_WT + N_ADA + N_CK) {
      const int t = task - N_WT - N_ADA;
      const float4* src = (const float4*)p.in[4];
      u16* dst = (u16*)(p.ws + WS_KS);
#pragma unroll
      for (int i = 0; i < 8; ++i) {
        const size_t f4 = (size_t)t * 4096 + i * 512 + otid();
        const float4 v = src[f4];
        const size_t e = f4 * 4;
        const size_t lb = e / (1024 * 512), rem = e % (1024 * 512);
        uint2 o; o.x = pack2(v.x, v.y); o.y = pack2(v.z, v.w);
        *(uint2*)(dst + lb * (1056 * 512) + rem) = o;
      }
    } else {
      const int t = task - N_WT - N_ADA - N_CK;
      const int lb = t >> 7, tt = t & 127;
      transpose_task(p.in[5] + (size_t)lb * 1024 * 512, 512, (u16*)(p.ws + WS_VTS) + (size_t)lb * 512 * 1056, 1056, 0, tt >> 3, tt & 7, smem);
    }
  }
}

DI float wave_sum(float v, int lane) {
#pragma unroll
  for (int off = 32; off >= 1; off >>= 1) v += shx(v, off, lane);
  return v;
}
DI void ln_pass(const Params& p, int mode, int l, unsigned char* smem) {
  const int tid = otid();
  const int lane = tid & 63, w = tid >> 6;
  const bool first = mode != 0;
  const bool second = (mode != 2) || (l + 1 < 2);
  const bool gates = (mode == 0) || (mode == 2 && l + 1 < 2);
  const int lm = (mode == 2) ? l + 1 : l;
  const int shi = (mode == 1) ? 3 : 0;
  const float* lng = (mode == 1) ? p.in[24] + l * 1024 : p.in[28] + l * 1024;
  const float* lnb = (mode == 1) ? p.in[25] + l * 1024 : p.in[29] + l * 1024;
  const float* mod = (const float*)(p.ws + WS_MOD);
  u16* H = (u16*)(p.ws + WS_H);
  float* gout = (float*)(p.ws + WS_GATES);
  float* wl = (float*)(smem + 64);
  float bif[8];
  if (gates) {
    const float* wi = p.in[12] + (size_t)lm * 1024 * 3592 + 3072;
    for (int idx = tid; idx < 8192; idx += NTHR) {
      const int c = idx >> 3, j = idx & 7;
      wl[j * 1024 + c] = wi[(size_t)c * 3592 + j];
    }
#pragma unroll
    for (int j = 0; j < 8; ++j) bif[j] = p.in[13][lm * 8 + j];
  }
  __syncthreads();
  float lg[16], lb[16];
  if (first) {
#pragma unroll
    for (int i = 0; i < 4; ++i) {
      const float4 g = *(const float4*)(lng + i * 256 + lane * 4);
      const float4 b = *(const float4*)(lnb + i * 256 + lane * 4);
      lg[i * 4] = g.x; lg[i * 4 + 1] = g.y; lg[i * 4 + 2] = g.z; lg[i * 4 + 3] = g.w;
      lb[i * 4] = b.x; lb[i * 4 + 1] = b.y; lb[i * 4 + 2] = b.z; lb[i * 4 + 3] = b.w;
    }
  }
  auto process = [&](int row, float (&v)[16], const float (&msh)[16], const float (&msc)[16]) {
    float* xr = p.out + (size_t)row * 1024;
    if (first) {
      float s = 0.f;
#pragma unroll
      for (int i = 0; i < 16; ++i) s += v[i];
      const float mean = wave_sum(s, lane) * (1.f / 1024.f);
      float q = 0.f;
#pragma unroll
      for (int i = 0; i < 16; ++i) { v[i] -= mean; q += v[i] * v[i]; }
      const float rstd = rsqrtf(wave_sum(q, lane) * (1.f / 1024.f) + LN_EPS);
#pragma unroll
      for (int i = 0; i < 4; ++i) {
#pragma unroll
        for (int e = 0; e < 4; ++e) v[i * 4 + e] = v[i * 4 + e] * rstd * lg[i * 4 + e] + lb[i * 4 + e];
        *(float4*)(xr + i * 256 + lane * 4) = make_float4(v[i * 4 + 0], v[i * 4 + 1], v[i * 4 + 2], v[i * 4 + 3]);
      }
    }
    if (second) {
      float s = 0.f;
#pragma unroll
      for (int i = 0; i < 16; ++i) s += v[i];
      const float mean = wave_sum(s, lane) * (1.f / 1024.f);
      float q = 0.f;
#pragma unroll
      for (int i = 0; i < 16; ++i) { v[i] -= mean; q += v[i] * v[i]; }
      const float rstd = rsqrtf(wave_sum(q, lane) * (1.f / 1024.f) + LN_EPS);
#pragma unroll
      for (int i = 0; i < 4; ++i) {
#pragma unroll
        for (int e = 0; e < 4; ++e) v[i * 4 + e] = v[i * 4 + e] * rstd * msc[i * 4 + e] + msh[i * 4 + e];
        uint2 o; o.x = pack2(v[i * 4 + 0], v[i * 4 + 1]); o.y = pack2(v[i * 4 + 2], v[i * 4 + 3]);
        *(uint2*)(H + (size_t)row * 1024 + i * 256 + lane * 4) = o;
      }
      if (gates) {
        float g8[8];
#pragma unroll
        for (int j = 0; j < 8; ++j) {
          float s2 = 0.f;
#pragma unroll
          for (int i = 0; i < 4; ++i) {
            const float4 wv = *(const float4*)(wl + j * 1024 + i * 256 + lane * 4);
            s2 += v[i * 4] * wv.x + v[i * 4 + 1] * wv.y + v[i * 4 + 2] * wv.z + v[i * 4 + 3] * wv.w;
          }
          g8[j] = wave_sum(s2, lane) + bif[j];
        }
        if (lane == 0) {
          *(float4*)(gout + (size_t)row * 8) = make_float4(g8[0], g8[1], g8[2], g8[3]);
          *(float4*)(gout + (size_t)row * 8 + 4) = make_float4(g8[4], g8[5], g8[6], g8[7]);
        }
      }
    }
  };
  auto load_mod = [&](int row, float (&msh)[16], float (&msc)[16]) {
    const float* mb = mod + ((size_t)lm * 40 + batch_of_row(row)) * 6144;
#pragma unroll
    for (int i = 0; i < 4; ++i) {
      const float4 sh = *(const float4*)(mb + shi * 1024 + i * 256 + lane * 4);
      const float4 sc = *(const float4*)(mb + (shi + 1) * 1024 + i * 256 + lane * 4);
      msh[i * 4] = sh.x; msh[i * 4 + 1] = sh.y; msh[i * 4 + 2] = sh.z; msh[i * 4 + 3] = sh.w;
      msc[i * 4] = 1.f + sc.x; msc[i * 4 + 1] = 1.f + sc.y; msc[i * 4 + 2] = 1.f + sc.z; msc[i * 4 + 3] = 1.f + sc.w;
    }
  };
  for (int chunk = blockIdx.x * 8 + w; chunk < TOKP / 32; chunk += gridDim.x * 8) {
    const int row0 = chunk * 32;
    float msh[16], msc[16];
    if (second) load_mod(row0, msh, msc);
    const float* src0 = (mode == 0) ? p.in[0] + (size_t)row0 * 1024 : p.out + (size_t)row0 * 1024;
    float4 nx0 = *(const float4*)(src0 + lane * 4), nx1 = *(const float4*)(src0 + 256 + lane * 4);
    float4 nx2 = *(const float4*)(src0 + 512 + lane * 4), nx3 = *(const float4*)(src0 + 768 + lane * 4);
    for (int ri = 0; ri < 32; ++ri) {
      float v[16];
      v[0] = nx0.x; v[1] = nx0.y; v[2] = nx0.z; v[3] = nx0.w; v[4] = nx1.x; v[5] = nx1.y; v[6] = nx1.z; v[7] = nx1.w;
      v[8] = nx2.x; v[9] = nx2.y; v[10] = nx2.z; v[11] = nx2.w; v[12] = nx3.x; v[13] = nx3.y; v[14] = nx3.z; v[15] = nx3.w;
      {
        const float* sn = src0 + (size_t)(ri < 31 ? ri + 1 : 31) * 1024;
        nx0 = *(const float4*)(sn + lane * 4); nx1 = *(const float4*)(sn + 256 + lane * 4);
        nx2 = *(const float4*)(sn + 512 + lane * 4); nx3 = *(const float4*)(sn + 768 + lane * 4);
      }
      __builtin_amdgcn_sched_barrier(0);
      process(row0 + ri, v, msh, msc);
    }
  }
  if (w == 0) {
    for (int row = TOKP + blockIdx.x; row < TOK; row += gridDim.x) {
      float msh[16], msc[16];
      if (second) load_mod(row, msh, msc);
      const float* src = (mode == 0) ? p.in[1] + (size_t)(row - TOKP) * 1024 : p.out + (size_t)row * 1024;
      float v[16];
#pragma unroll
      for (int i = 0; i < 4; ++i) {
        const float4 t = *(const float4*)(src + i * 256 + lane * 4);
        v[i * 4 + 0] = t.x; v[i * 4 + 1] = t.y; v[i * 4 + 2] = t.z; v[i * 4 + 3] = t.w;
      }
      process(row, v, msh, msc);
    }
  }
}


DI void micro_partial(f32x16& acc, const u16* A, int lda, const u16* Wt, int ldw, int K, int row0, int n0, int w, int r, int h) {
  const int kb = w * (K >> 3), n16 = K >> 7;
  const u16* ap = A + (size_t)(row0 + r) * lda + kb + h * 8;
  const u16* bp = Wt + (size_t)(n0 + r) * ldw + kb + h * 8;
#pragma unroll 4
  for (int k = 0; k < n16; ++k) {
    const bf16x8 a = *(const bf16x8*)(ap + k * 16);
    const bf16x8 b = *(const bf16x8*)(bp + k * 16);
    acc = MFMA(a, b, acc);
  }
}
DI void micro_reduce_store(const f32x16& acc, float* red, int w, int lane) {
#pragma unroll
  for (int i = 0; i < 16; ++i) red[(w * 16 + i) * 64 + lane] = acc[i];
}
DI float micro_sum(const float* red, int i, int lane) {
  float s = 0.f;
#pragma unroll
  for (int q = 0; q < 8; ++q) s += red[(q * 16 + i) * 64 + lane];
  return s;
}

constexpr int EP_LD = 264;
constexpr int EP_LDT = 68;
DI void zero_acc(f32x16 (&acc)[4][2]) {
#pragma unroll
  for (int a = 0; a < 4; ++a)
#pragma unroll
    for (int b = 0; b < 2; ++b) zero16(acc[a][b]);
}
DI void stage_rm(const f32x16& a0, const f32x16& a1, float* stg, int wm, int wn, int r, int h) {
#pragma unroll
  for (int i = 0; i < 16; ++i) *(float2*)(stg + (wm * 32 + crow(i, h)) * EP_LD + wn * 64 + 2 * r) = make_float2(a0[i], a1[i]);
}
DI void stage_tr(const f32x16& a0, const f32x16& a1, float* stg, int wm, int wn, int r, int h) {
#pragma unroll
  for (int g = 0; g < 4; ++g) {
    *(float4*)(stg + (wn * 64 + 2 * r) * EP_LDT + wm * 32 + 8 * g + 4 * h) = make_float4(a0[4 * g], a0[4 * g + 1], a0[4 * g + 2], a0[4 * g + 3]);
    *(float4*)(stg + (wn * 64 + 2 * r + 1) * EP_LDT + wm * 32 + 8 * g + 4 * h) = make_float4(a1[4 * g], a1[4 * g + 1], a1[4 * g + 2], a1[4 * g + 3]);
  }
}
DI int grow_of(int m0, int mi, int lr) { return m0 + (lr >> 5) * 128 + mi * 32 + (lr & 31); }
DI uint4 pack8f(const float4& a, const float4& b) {
  uint4 o; o.x = pack2(a.x, a.y); o.y = pack2(a.z, a.w); o.z = pack2(b.x, b.y); o.w = pack2(b.z, b.w); return o;
}

DI void write_tr(const Params& p, int l, int m0, int mi, const float* stg, int tid, int which, int chbase) {
  const bool prompt = m0 < TOKP;
#pragma unroll 1
  for (int q = 0; q < 4; ++q) {
    const int cid = q * NTHR + tid, ch = cid >> 3, tc = cid & 7;
    const float4 v0 = *(const float4*)(stg + ch * EP_LDT + tc * 8);
    const float4 v1 = *(const float4*)(stg + ch * EP_LDT + tc * 8 + 4);
    const int row0 = grow_of(m0, mi, tc * 8);
    const int chg = chbase + ch;
    u16* d;
    if (prompt) {
      const int b = row0 >> 11, t = row0 & 2047;
      if (which == 0) d = (u16*)(p.ws + WS_VTP) + ((size_t)b * 512 + chg) * 2048 + t;
      else if (which == 1) d = (u16*)(p.ws + WS_MQKT_P) + ((size_t)b * 1024 + chg) * 2048 + t;
      else d = (u16*)(p.ws + WS_MVT_P) + ((size_t)b * 512 + chg) * 2048 + t;
    } else {
      const int rs = row0 - TOKP, bs = rs >> 5, t = rs & 31;
      if (which == 0) d = (u16*)(p.ws + WS_VTS) + ((size_t)(l * 8 + bs) * 512 + chg) * 1056 + 1024 + t;
      else if (which == 1) d = (u16*)(p.ws + WS_MQKT_S) + ((size_t)bs * 1024 + chg) * 32 + t;
      else d = (u16*)(p.ws + WS_MVT_S) + ((size_t)bs * 512 + chg) * 32 + t;
    }
    *(uint4*)d = pack8f(v0, v1);
  }
}

DI void epi_in(const Params& p, int l, int m0, int n0, f32x16 (&acc)[4][2], unsigned char* smem) {
  const int tid = otid(), lane = tid & 63, w = tid >> 6;
  const int wm = w >> 2, wn = w & 3, r = lane & 31, h = lane >> 5;
  const bool prompt = m0 < TOKP;
  float* stg = (float*)(smem + GS_BASE + GS_STAGE);
  const int seg = n0 < 512 ? 0 : (n0 < 1024 ? 1 : (n0 < 1536 ? 2 : (n0 < 2560 ? 3 : (n0 < 3072 ? 4 : 5))));
  if (seg == 3) {
    const int ch = n0 - 1536 + wn * 64 + 2 * r;
#pragma unroll
    for (int mi = 0; mi < 4; ++mi) {
      const int rb = m0 + wm * 128 + mi * 32 + 4 * h;
#pragma unroll
      for (int i = 0; i < 16; ++i) {
        const int row = rb + (i & 3) + 8 * (i >> 2);
        if (prompt) {
          const int tt = row & 2047;
          if (tt >= 2045) *(float2*)(p.out + O_CVP + ((size_t)(l * 32 + (row >> 11)) * 3 + (tt - 2045)) * 1024 + ch) = make_float2(acc[mi][0][i], acc[mi][1][i]);
        } else {
          const int rs = row - TOKP, tt = rs & 31;
          if (tt >= 29) *(float2*)(p.out + O_CVS + ((size_t)(l * 8 + (rs >> 5)) * 3 + (tt - 29)) * 1024 + ch) = make_float2(acc[mi][0][i], acc[mi][1][i]);
        }
      }
    }
  }
#pragma unroll
  for (int mi = 0; mi < 4; ++mi) {
    if (seg == 0 || seg == 1 || seg == 2 || seg == 5) {
      __syncthreads();
      stage_rm(acc[mi][0], acc[mi][1], stg, wm, wn, r, h);
      __syncthreads();
#pragma unroll 1
      for (int q = 0; q < 4; ++q) {
        const int cid = q * NTHR + tid, lr = cid >> 5, c8 = (cid & 31) * 8;
        const float4 v0 = *(const float4*)(stg + lr * EP_LD + c8);
        const float4 v1 = *(const float4*)(stg + lr * EP_LD + c8 + 4);
        const int row = grow_of(m0, mi, lr);
        const int n = n0 + c8;
        if (seg == 0) {
          *(uint4*)((u16*)(p.ws + WS_ZQ) + (size_t)row * 512 + n) = pack8f(v0, v1);
        } else if (seg == 5) {
          const float4 s0 = make_float4(sigmoidf_(v0.x), sigmoidf_(v0.y), sigmoidf_(v0.z), sigmoidf_(v0.w));
          const float4 s1 = make_float4(sigmoidf_(v1.x), sigmoidf_(v1.y), sigmoidf_(v1.z), sigmoidf_(v1.w));
          *(uint4*)((u16*)(p.ws + WS_MO) + (size_t)row * 512 + (n - 3072)) = pack8f(s0, s1);
        } else {
          const bool isk = seg == 1;
          const int nn = n - (isk ? 512 : 1024);
          float* of = p.out + (isk ? (prompt ? O_KP : O_KSM) : (prompt ? O_VP : O_VSM));
          const size_t orow = prompt ? ((size_t)l * TOKP + row) : ((size_t)l * TOKS + (row - TOKP));
          *(float4*)(of + orow * 512 + nn) = v0;
          *(float4*)(of + orow * 512 + nn + 4) = v1;
          if (isk) {
            u16* kd;
            if (prompt) kd = (u16*)(p.ws + WS_KB) + (size_t)row * 512 + nn;
            else { const int rs = row - TOKP; kd = (u16*)(p.ws + WS_KS) + ((size_t)(l * 8 + (rs >> 5)) * 1056 + 1024 + (rs & 31)) * 512 + nn; }
            *(uint4*)kd = pack8f(v0, v1);
          }
        }
      }
    }
    if (seg == 2 || seg == 3 || seg == 4) {
      __syncthreads();
      stage_tr(acc[mi][0], acc[mi][1], stg, wm, wn, r, h);
      __syncthreads();
      write_tr(p, l, m0, mi, stg, tid, seg == 2 ? 0 : (seg == 3 ? 1 : 2), n0 - (seg == 2 ? 1024 : (seg == 3 ? 1536 : 2560)));
    }
  }
  __syncthreads();
}

DI void phase_in_gate(const Params& p, int l, unsigned char* smem) {
  const int tid = otid(), lane = tid & 63, w = tid >> 6;
  const int wm = w >> 2, wn = w & 3, r = lane & 31, h = lane >> 5;
  const u16* H = (const u16*)(p.ws + WS_H);
  const u16* Win = (const u16*)(p.ws + WS_WT_IN) + (size_t)l * 3584 * 1024;
  const u16* Wg = (const u16*)(p.ws + WS_WT_GATE) + (size_t)l * 2048 * 1024;
  float* stg = (float*)(smem + GS_BASE + GS_STAGE);
  const int NT = 14 + 8, MT = 257;
  auto ptrs = [&](int it, const u16*& ap, const u16*& bp) -> bool {
    int mt, nt;
    if (!tile_of(it, MT, NT, mt, nt)) return false;
    ap = H + (size_t)(mt * 256) * 1024;
    bp = (nt < 14 ? Win + (size_t)(nt * 256) * 1024 : Wg + (size_t)((nt - 14) * 256) * 1024);
    return true;
  };
  auto epi = [&](int it, f32x16 (&acc)[4][2]) {
    const int tid = otid(), lane = tid & 63, w = tid >> 6;
    const int wm = w >> 2, wn = w & 3, r = lane & 31, h = lane >> 5;
    int mt, nt;
    tile_of(it, MT, NT, mt, nt);
    const int m0 = mt * 256;
    if (nt < 14) {
      epi_in(p, l, m0, nt * 256, acc, smem);
    } else {
      const int n0 = (nt - 14) * 256;
      u16* G = (u16*)(p.ws + WS_G);
#pragma unroll
      for (int mi = 0; mi < 4; ++mi) {
        __syncthreads();
        stage_rm(acc[mi][0], acc[mi][1], stg, wm, wn, r, h);
        __syncthreads();
#pragma unroll 1
        for (int q = 0; q < 4; ++q) {
          const int cid = q * NTHR + tid, lr = cid >> 5, c8 = (cid & 31) * 8;
          float4 v0 = *(const float4*)(stg + lr * EP_LD + c8);
          float4 v1 = *(const float4*)(stg + lr * EP_LD + c8 + 4);
          const int row = grow_of(m0, mi, lr), n = n0 + c8;
          const float4 b0 = *(const float4*)(p.in[22] + l * 2048 + n);
          const float4 b1 = *(const float4*)(p.in[22] + l * 2048 + n + 4);
          v0 = make_float4(sigmoidf_(v0.x + b0.x), sigmoidf_(v0.y + b0.y), sigmoidf_(v0.z + b0.z), sigmoidf_(v0.w + b0.w));
          v1 = make_float4(sigmoidf_(v1.x + b1.x), sigmoidf_(v1.y + b1.y), sigmoidf_(v1.z + b1.z), sigmoidf_(v1.w + b1.w));
          *(uint4*)(G + (size_t)row * 2048 + n) = pack8f(v0, v1);
        }
      }
      __syncthreads();
    }
  };
  gemm_stream(1024, 1024, 1024, smem, ptrs, epi);
}

DI void phase_mix(const Params& p, int l, unsigned char* smem) {
  const int tid = otid(), lane = tid & 63, w = tid >> 6;
  const int wm = w >> 2, wn = w & 3, r = lane & 31, h = lane >> 5;
  const u16* G = (const u16*)(p.ws + WS_G);
  u16* MIX = (u16*)(p.ws + WS_MIX);
  float* stg = (float*)(smem + GS_BASE + GS_STAGE);
  const int NT = 4, MT = 256;
  auto ptrs = [&](int it, const u16*& ap, const u16*& bp) -> bool {
    int mt, nt;
    if (!tile_of(it >> 1, MT, NT, mt, nt)) return false;
    const int half = it & 1;
    ap = (const u16*)(p.ws + (half ? WS_MN : WS_AN)) + (size_t)(mt * 256) * 512;
    bp = (const u16*)(p.ws + (half ? WS_WT_BRB : WS_WT_BRA)) + (size_t)l * 1024 * 512 + (size_t)(nt * 256) * 512;
    return true;
  };
  auto epi = [&](int it, f32x16 (&acc)[4][2]) {
    const int tid = otid(), lane = tid & 63, w = tid >> 6;
    const int wm = w >> 2, wn = w & 3, r = lane & 31, h = lane >> 5;
    int mt, nt;
    tile_of(it >> 1, MT, NT, mt, nt);
    const int half = it & 1;
    const int m0 = mt * 256, n0 = nt * 256;
#pragma unroll
    for (int mi = 0; mi < 4; ++mi) {
      __syncthreads();
      stage_rm(acc[mi][0], acc[mi][1], stg, wm, wn, r, h);
      __syncthreads();
#pragma unroll 1
      for (int q = 0; q < 4; ++q) {
        const int cid = q * NTHR + tid, lr = cid >> 5, c8 = (cid & 31) * 8;
        const float4 v0 = *(const float4*)(stg + lr * EP_LD + c8);
        const float4 v1 = *(const float4*)(stg + lr * EP_LD + c8 + 4);
        const int row = grow_of(m0, mi, lr), n = n0 + c8;
        const uint4 g = *(const uint4*)(G + (size_t)row * 2048 + half * 1024 + n);
        float4 o0 = make_float4(bflo(g.x) * v0.x, bfhi(g.x) * v0.y, bflo(g.y) * v0.z, bfhi(g.y) * v0.w);
        float4 o1 = make_float4(bflo(g.z) * v1.x, bfhi(g.z) * v1.y, bflo(g.w) * v1.z, bfhi(g.w) * v1.w);
        uint4* mp = (uint4*)(MIX + (size_t)row * 1024 + n);
        if (half) {
          const uint4 pr = *mp;
          o0.x += bflo(pr.x); o0.y += bfhi(pr.x); o0.z += bflo(pr.y); o0.w += bfhi(pr.y);
          o1.x += bflo(pr.z); o1.y += bfhi(pr.z); o1.z += bflo(pr.w); o1.w += bfhi(pr.w);
        }
        *mp = pack8f(o0, o1);
      }
    }
    __syncthreads();
  };
  gemm_stream(512, 512, 512, smem, ptrs, epi);
  {
    const int tid2 = otid(), lane = tid2 & 63, w = tid2 >> 6, r = lane & 31, h = lane >> 5;
    float* red = (float*)(smem + 64);
    for (int mtile = blockIdx.x; mtile < 256; mtile += gridDim.x) {
      const int row0 = TOKP + (mtile >> 5) * 32, n0 = (mtile & 31) * 32;
      f32x16 pa, pb;
      zero16(pa); zero16(pb);
      micro_partial(pa, (const u16*)(p.ws + WS_AN), 512, (const u16*)(p.ws + WS_WT_BRA) + (size_t)l * 1024 * 512, 512, 512, row0, n0, w, r, h);
      micro_partial(pb, (const u16*)(p.ws + WS_MN), 512, (const u16*)(p.ws + WS_WT_BRB) + (size_t)l * 1024 * 512, 512, 512, row0, n0, w, r, h);
      __syncthreads();
      micro_reduce_store(pa, red, w, lane);
      micro_reduce_store(pb, red + 8192, w, lane);
      __syncthreads();
#pragma unroll
      for (int q = 0; q < 2; ++q) {
        const int i = w + 8 * q;
        const float sa = micro_sum(red, i, lane), sb = micro_sum(red + 8192, i, lane);
        const int row = row0 + crow(i, h), n = n0 + r;
        const float ga = bf2f(G[(size_t)row * 2048 + n]), gb = bf2f(G[(size_t)row * 2048 + 1024 + n]);
        MIX[(size_t)row * 1024 + n] = f2bf(ga * sa + gb * sb);
      }
    }
    __syncthreads();
  }
}

DI void phase_res(const Params& p, int l, int mode, unsigned char* smem) {
  const int tid = otid(), lane = tid & 63, w = tid >> 6;
  const int wm = w >> 2, wn = w & 3, r = lane & 31, h = lane >> 5;
  const float* mod = (const float*)(p.ws + WS_MOD);
  float* stg = (float*)(smem + GS_BASE + GS_STAGE);
  const int NT = 4, MT = 256;
  const int K = (mode == 0) ? 1024 : 2816;
  const u16* Ab = (const u16*)(p.ws + (mode == 0 ? WS_MIX : WS_ACT));
  const u16* Wb = (mode == 0) ? (const u16*)(p.ws + WS_WT_O) + (size_t)l * 1024 * 1024 : (const u16*)(p.ws + WS_WT_DOWN) + (size_t)l * 1024 * 2816;
  const int gi = (mode == 0) ? 2 : 5;
  auto ptrs = [&](int it, const u16*& ap, const u16*& bp) -> bool {
    int mt, nt;
    if (!tile_of(it, MT, NT, mt, nt)) return false;
    ap = Ab + (size_t)(mt * 256) * K;
    bp = Wb + (size_t)(nt * 256) * K;
    return true;
  };
  auto epi = [&](int it, f32x16 (&acc)[4][2]) {
    const int tid = otid(), lane = tid & 63, w = tid >> 6;
    const int wm = w >> 2, wn = w & 3, r = lane & 31, h = lane >> 5;
    int mt, nt;
    tile_of(it, MT, NT, mt, nt);
    const int m0 = mt * 256, n0 = nt * 256;
#pragma unroll
    for (int mi = 0; mi < 4; ++mi) {
      __syncthreads();
      stage_rm(acc[mi][0], acc[mi][1], stg, wm, wn, r, h);
      __syncthreads();
#pragma unroll 1
      for (int q = 0; q < 8; ++q) {
        const int cid = q * NTHR + tid, lr = cid >> 6, c4 = (cid & 63) * 4;
        const float4 v = *(const float4*)(stg + lr * EP_LD + c4);
        const int row = grow_of(m0, mi, lr), n = n0 + c4;
        const int b = batch_of_row(row);
        const float4 gg = *(const float4*)(mod + ((size_t)l * 40 + b) * 6144 + gi * 1024 + n);
        float* xr = p.out + (size_t)row * 1024 + n;
        const float* xs = (mode == 0 && l == 0) ? (row < TOKP ? p.in[0] + (size_t)row * 1024 + n : p.in[1] + (size_t)(row - TOKP) * 1024 + n) : xr;
        const float4 xv = *(const float4*)xs;
        *(float4*)xr = make_float4(ALPHA * xv.x + (1.f + gg.x) * v.x, ALPHA * xv.y + (1.f + gg.y) * v.y,
                                   ALPHA * xv.z + (1.f + gg.z) * v.z, ALPHA * xv.w + (1.f + gg.w) * v.w);
      }
    }
    __syncthreads();
  };
  gemm_stream(K, K, K, smem, ptrs, epi);
  {
    const int tid2 = otid(), lane = tid2 & 63, w = tid2 >> 6, r = lane & 31, h = lane >> 5;
    float* red = (float*)(smem + 64);
    for (int mtile = blockIdx.x; mtile < 256; mtile += gridDim.x) {
      const int row0 = TOKP + (mtile >> 5) * 32, n0 = (mtile & 31) * 32;
      f32x16 pa;
      zero16(pa);
      micro_partial(pa, Ab, K, Wb, K, K, row0, n0, w, r, h);
      __syncthreads();
      micro_reduce_store(pa, red, w, lane);
      __syncthreads();
#pragma unroll
      for (int q = 0; q < 2; ++q) {
        const int i = w + 8 * q;
        const float sa = micro_sum(red, i, lane);
        const int row = row0 + crow(i, h), n = n0 + r;
        const float gg = mod[((size_t)l * 40 + batch_of_row(row)) * 6144 + gi * 1024 + n];
        float* xr = p.out + (size_t)row * 1024 + n;
        const float xv = (mode == 0 && l == 0) ? p.in[1][(size_t)(row - TOKP) * 1024 + n] : *xr;
        *xr = ALPHA * xv + (1.f + gg) * sa;
      }
    }
    __syncthreads();
  }
}

DI void phase_gu(const Params& p, int l, unsigned char* smem) {
  const int tid = otid(), lane = tid & 63, w = tid >> 6;
  const int wm = w >> 2, wn = w & 3, r = lane & 31, h = lane >> 5;
  u16* ACT = (u16*)(p.ws + WS_ACT);
  const u16* Hh = (const u16*)(p.ws + WS_H);
  const u16* Wb = (const u16*)(p.ws + WS_WT_GU) + (size_t)l * 5632 * 1024;
  float* stg = (float*)(smem + GS_BASE + GS_STAGE);
  const int NT = 22, MT = 257;
  auto ptrs = [&](int it, const u16*& ap, const u16*& bp) -> bool {
    int mt, nt;
    if (!tile_of(it, MT, NT, mt, nt)) return false;
    ap = Hh + (size_t)(mt * 256) * 1024;
    bp = Wb + (size_t)(nt * 256) * 1024;
    return true;
  };
  auto epi = [&](int it, f32x16 (&acc)[4][2]) {
    const int tid = otid(), lane = tid & 63, w = tid >> 6;
    const int wm = w >> 2, wn = w & 3, r = lane & 31, h = lane >> 5;
    int mt, nt;
    tile_of(it, MT, NT, mt, nt);
    const int m0 = mt * 256, n0 = nt * 256;
#pragma unroll
    for (int mi = 0; mi < 4; ++mi) {
      __syncthreads();
      stage_rm(acc[mi][0], acc[mi][1], stg, wm, wn, r, h);
      __syncthreads();
#pragma unroll 1
      for (int q = 0; q < 2; ++q) {
        const int cid = q * NTHR + tid, lr = cid >> 4, c16 = (cid & 15) * 16;
        const float4 v0 = *(const float4*)(stg + lr * EP_LD + c16);
        const float4 v1 = *(const float4*)(stg + lr * EP_LD + c16 + 4);
        const float4 v2 = *(const float4*)(stg + lr * EP_LD + c16 + 8);
        const float4 v3 = *(const float4*)(stg + lr * EP_LD + c16 + 12);
        const int row = grow_of(m0, mi, lr);
        uint4 o;
        o.x = pack2(siluf_(v0.x) * v0.y, siluf_(v0.z) * v0.w);
        o.y = pack2(siluf_(v1.x) * v1.y, siluf_(v1.z) * v1.w);
        o.z = pack2(siluf_(v2.x) * v2.y, siluf_(v2.z) * v2.w);
        o.w = pack2(siluf_(v3.x) * v3.y, siluf_(v3.z) * v3.w);
        *(uint4*)(ACT + (size_t)row * 2816 + (n0 >> 1) + (c16 >> 1)) = o;
      }
    }
    __syncthreads();
  };
  gemm_stream(1024, 1024, 1024, smem, ptrs, epi);
}

constexpr int AT_BASE = 64;
constexpr int AT_KBYTES = 64 * 272;
constexpr int AT_VBYTES = 128 * 136;
constexpr int AT_STAGE = AT_KBYTES + AT_VBYTES;

DI void attn_item(const Params& p, int l, int b, int head, int qt, float lam, float lam_init, unsigned char* smem) {
  const int tid = otid(), lane = tid & 63, w = tid >> 6, r = lane & 31, h = lane >> 5;
  const int comp = w & 1, rg = w >> 1;
  const bool prompt = b < 32;
  const int bs = b - 32;
  const u16* Kg = prompt ? (const u16*)(p.ws + WS_KB) + (size_t)b * 2048 * 512 : (const u16*)(p.ws + WS_KS) + (size_t)(l * 8 + bs) * 1056 * 512;
  const u16* Vg = prompt ? (const u16*)(p.ws + WS_VTP) + (size_t)b * 512 * 2048 : (const u16*)(p.ws + WS_VTS) + (size_t)(l * 8 + bs) * 512 * 1056;
  const int ldT = prompt ? 2048 : 1056;
  const int nkt = prompt ? 2 * qt + 2 : 17;
  const int nkeys = prompt ? 2048 : 1056;
  const int qtok0 = prompt ? b * 2048 + qt * 128 : TOKP + bs * 32;
  const int qpos0 = prompt ? qt * 128 : 1024;
  const bool active = prompt || rg == 0;
  const int my_nkt = prompt ? (rg < 2 ? nkt - 1 : nkt) : nkt;
  const u16* ZQ = (const u16*)(p.ws + WS_ZQ);
  bf16x8 qf[4];
  {
    const int qrow = active ? qtok0 + rg * 32 + r : qtok0;
#pragma unroll
    for (int ks = 0; ks < 4; ++ks) qf[ks] = *(const bf16x8*)(ZQ + (size_t)qrow * 512 + head * 128 + comp * 64 + ks * 16 + h * 8);
  }
  const float slope2 = exp2f(-2.f * (head + 1)) * LOG2E;
  const float c1 = 0.125f * LOG2E;
  const int qpos = qpos0 + rg * 32 + r;
  f32x16 O[4];
#pragma unroll
  for (int i = 0; i < 4; ++i) zero16(O[i]);
  float m_run = -INFINITY, l_run = 0.f;

  const int krow = tid >> 4, kcc = tid & 15;
  const int vrow = tid >> 3, vcc = tid & 7;
  const u16* kp = Kg + (size_t)((nkt - 1) * 64 + krow) * 512 + head * 128 + kcc * 8;
  const u16* vp = Vg + (size_t)(head * 128 + vrow) * ldT + (nkt - 1) * 64 + vcc * 8;
  uint4 rk0, rk1, rv0, rv1;
  unsigned char* sb = smem + AT_BASE;
  rk0 = *(const uint4*)kp; rk1 = *(const uint4*)(kp + 32 * 512);
  rv0 = *(const uint4*)vp; rv1 = *(const uint4*)(vp + (size_t)64 * ldT);
  {
    *(uint4*)(sb + krow * 272 + kcc * 16) = rk0;
    *(uint4*)(sb + (krow + 32) * 272 + kcc * 16) = rk1;
    *(uint2*)(sb + AT_KBYTES + vrow * 136 + vcc * 16) = make_uint2(rv0.x, rv0.y);
    *(uint2*)(sb + AT_KBYTES + vrow * 136 + vcc * 16 + 8) = make_uint2(rv0.z, rv0.w);
    *(uint2*)(sb + AT_KBYTES + (vrow + 64) * 136 + vcc * 16) = make_uint2(rv1.x, rv1.y);
    *(uint2*)(sb + AT_KBYTES + (vrow + 64) * 136 + vcc * 16 + 8) = make_uint2(rv1.z, rv1.w);
  }
  __syncthreads();
  for (int j = 0; j < nkt; ++j) {
    const int kt = nkt - 1 - j;
    const bool more = j + 1 < nkt;
    if (more) {
      kp -= 64 * 512; vp -= 64;
      rk0 = *(const uint4*)kp; rk1 = *(const uint4*)(kp + 32 * 512);
      rv0 = *(const uint4*)vp; rv1 = *(const uint4*)(vp + (size_t)64 * ldT);
    }
    if (active && kt < my_nkt) {
      const unsigned char* Kt = sb + (j & 1) * AT_STAGE;
      const unsigned char* Vt = Kt + AT_KBYTES;
      f32x16 s[2];
      zero16(s[0]); zero16(s[1]);
#pragma unroll
      for (int ks = 0; ks < 4; ++ks) {
#pragma unroll
        for (int sub = 0; sub < 2; ++sub) {
          const bf16x8 kf = *(const bf16x8*)(Kt + (sub * 32 + r) * 272 + (comp * 64 + ks * 16 + h * 8) * 2);
          s[sub] = MFMA(kf, qf[ks], s[sub]);
        }
      }
      float mx = -INFINITY;
      const float qk0 = (float)(qpos - kt * 64 - 4 * h);
#pragma unroll
      for (int sub = 0; sub < 2; ++sub)
#pragma unroll
        for (int i = 0; i < 16; ++i) {
          const float d = qk0 - (float)(sub * 32 + (i & 3) + 8 * (i >> 2));
          float v = s[sub][i] * c1 - slope2 * fabsf(d);
          s[sub][i] = v;
        }
      if (!prompt) {
#pragma unroll
        for (int sub = 0; sub < 2; ++sub)
#pragma unroll
          for (int i = 0; i < 16; ++i) {
            const int key = kt * 64 + sub * 32 + crow(i, h);
            if (key >= nkeys) s[sub][i] = -INFINITY;
          }
      }
#pragma unroll
      for (int sub = 0; sub < 2; ++sub)
#pragma unroll
        for (int i = 0; i < 16; ++i) mx = fmaxf(mx, s[sub][i]);
      mx = fmaxf(mx, shx(mx, 32, lane));
      const bool livelane = !(mx - m_run < -150.f);
      if (__ballot(livelane) != 0ull) {
        const float m_new = fmaxf(m_run, mx);
        const float alpha = fexp2(m_run - m_new);
        m_run = m_new;
        float lsum = 0.f;
#pragma unroll
        for (int sub = 0; sub < 2; ++sub)
#pragma unroll
          for (int i = 0; i < 16; ++i) {
            const float pv = fexp2(s[sub][i] - m_new);
            lsum += pv;
            s[sub][i] = pv;
          }
        l_run = l_run * alpha + lsum;
        if (__ballot(alpha != 1.f) != 0ull) {
#pragma unroll
          for (int dt = 0; dt < 4; ++dt)
#pragma unroll
            for (int i = 0; i < 16; ++i) O[dt][i] *= alpha;
        }
#pragma unroll
        for (int sub = 0; sub < 2; ++sub)
#pragma unroll
          for (int s2 = 0; s2 < 2; ++s2) {
            const bf16x8 pf = pack8(s[sub], s2);
#pragma unroll
            for (int dt = 0; dt < 4; ++dt) {
              const unsigned char* va = Vt + (dt * 32 + r) * 136 + (sub * 32 + s2 * 16 + 4 * h) * 2;
              const uint2 lo = *(const uint2*)va;
              const uint2 hi = *(const uint2*)(va + 16);
              const uint4 vv = make_uint4(lo.x, lo.y, hi.x, hi.y);
              O[dt] = MFMA(__builtin_bit_cast(bf16x8, vv), pf, O[dt]);
            }
          }
      }
    }
    if (more) {
      unsigned char* sn = sb + ((j + 1) & 1) * AT_STAGE;
      *(uint4*)(sn + krow * 272 + kcc * 16) = rk0;
      *(uint4*)(sn + (krow + 32) * 272 + kcc * 16) = rk1;
      *(uint2*)(sn + AT_KBYTES + vrow * 136 + vcc * 16) = make_uint2(rv0.x, rv0.y);
      *(uint2*)(sn + AT_KBYTES + vrow * 136 + vcc * 16 + 8) = make_uint2(rv0.z, rv0.w);
      *(uint2*)(sn + AT_KBYTES + (vrow + 64) * 136 + vcc * 16) = make_uint2(rv1.x, rv1.y);
      *(uint2*)(sn + AT_KBYTES + (vrow + 64) * 136 + vcc * 16 + 8) = make_uint2(rv1.z, rv1.w);
    }
    __syncthreads();
  }
  float* exch = (float*)(smem + AT_BASE);
  float inv = 0.f;
  if (active) { const float lt = l_run + shx(l_run, 32, lane); inv = 1.f / lt; }
  if (active && comp == 1) {
    const float sc = inv * lam;
#pragma unroll
    for (int dt = 0; dt < 4; ++dt)
#pragma unroll
      for (int i = 0; i < 16; ++i) exch[(rg * 64 + dt * 16 + i) * 64 + lane] = O[dt][i] * sc;
  }
  __syncthreads();
  if (active && comp == 0) {
    float ss = 0.f;
#pragma unroll
    for (int dt = 0; dt < 4; ++dt)
#pragma unroll
      for (int i = 0; i < 16; ++i) {
        const float o = O[dt][i] * inv - exch[(rg * 64 + dt * 16 + i) * 64 + lane];
        O[dt][i] = o;
        ss += o * o;
      }
    ss += shx(ss, 32, lane);
    const float rs = rsqrtf(ss * (1.f / 128.f) + LN_EPS) * (1.f - lam_init);
    u16* AN = (u16*)(p.ws + WS_AN) + (size_t)(qtok0 + rg * 32 + r) * 512 + head * 128;
    const float* gw = p.in[17] + l * 512 + head * 128;
#pragma unroll
    for (int dt = 0; dt < 4; ++dt)
#pragma unroll
      for (int g = 0; g < 4; ++g) {
        const int dv = dt * 32 + 8 * g + 4 * h;
        const float4 g4 = *(const float4*)(gw + dv);
        uint2 o;
        o.x = pack2(O[dt][4 * g] * rs * g4.x, O[dt][4 * g + 1] * rs * g4.y);
        o.y = pack2(O[dt][4 * g + 2] * rs * g4.z, O[dt][4 * g + 3] * rs * g4.w);
        *(uint2*)(AN + dv) = o;
      }
  }
}

constexpr int ML_QS = 64;
constexpr int ML_KS = ML_QS + 64 * 272;
constexpr int ML_KT = ML_KS + 64 * 272;
constexpr int ML_VT = ML_KT + 128 * 144;
constexpr int ML_CB = ML_VT + 128 * 144;
constexpr int ML_HB = ML_CB + 128 * 272;
constexpr int ML_SM = ML_HB + 64 * 132 * 4;
static_assert(ML_SM + 528 * 4 <= LDS_BYTES, "lds");

DI void mlstm_item(const Params& p, int l, int b, int head, unsigned char* smem) {
  const int tid = otid(), lane = tid & 63, w = tid >> 6, r = lane & 31, h = lane >> 5;
  const bool prompt = b < 32;
  const int bs = b - 32;
  const int T = prompt ? 2048 : 32;
  const int nch = prompt ? 32 : 1;
  const int L = prompt ? 64 : 32;
  const int tokbase = prompt ? b * 2048 : TOKP + bs * 32;
  const u16* qkT = prompt ? (const u16*)(p.ws + WS_MQKT_P) + (size_t)b * 1024 * 2048 : (const u16*)(p.ws + WS_MQKT_S) + (size_t)bs * 1024 * 32;
  const u16* vTg = prompt ? (const u16*)(p.ws + WS_MVT_P) + (size_t)b * 512 * 2048 : (const u16*)(p.ws + WS_MVT_S) + (size_t)bs * 512 * 32;
  u16* qs = (u16*)(smem + ML_QS);
  u16* ksm = (u16*)(smem + ML_KS);
  u16* kTw = (u16*)(smem + ML_KT);
  u16* vT = (u16*)(smem + ML_VT);
  u16* Cbf = (u16*)(smem + ML_CB);
  float* hbuf = (float*)(smem + ML_HB);
  float* a_s = (float*)(smem + ML_SM);
  float* mx_s = a_s + 64;
  float* ws_s = a_s + 128;
  float* wi_s = a_s + 192;
  float* emt_s = a_s + 256;
  float* nq_s = a_s + 320;
  float* nvec = a_s + 384;
  float* scal = a_s + 512;

  const int vt = w & 3, kt0 = (w >> 2) * 2;
  f32x16 accC[2];
  float m_run = 0.f;
  if (prompt) {
    zero16(accC[0]); zero16(accC[1]);
    if (tid < 128) nvec[tid] = 0.f;
  } else {
    const float* Cs = p.in[6] + ((size_t)(l * 8 + bs) * 4 + head) * 128 * 128;
#pragma unroll
    for (int q = 0; q < 2; ++q)
#pragma unroll
      for (int g = 0; g < 4; ++g) {
        const float4 c4 = *(const float4*)(Cs + (size_t)(vt * 32 + r) * 128 + (kt0 + q) * 32 + 8 * g + 4 * h);
        accC[q][4 * g] = c4.x; accC[q][4 * g + 1] = c4.y; accC[q][4 * g + 2] = c4.z; accC[q][4 * g + 3] = c4.w;
      }
    if (tid < 128) nvec[tid] = p.in[7][((size_t)(l * 8 + bs) * 4 + head) * 128 + tid];
    m_run = p.in[8][(l * 8 + bs) * 4 + head];
  }
#pragma unroll
  for (int q = 0; q < 2; ++q)
#pragma unroll
    for (int g = 0; g < 4; ++g) {
      uint2 o; o.x = pack2(accC[q][4 * g], accC[q][4 * g + 1]); o.y = pack2(accC[q][4 * g + 2], accC[q][4 * g + 3]);
      *(uint2*)(Cbf + (vt * 32 + r) * 136 + (kt0 + q) * 32 + 8 * g + 4 * h) = o;
    }
  const float* gatesp = (const float*)(p.ws + WS_GATES);
  const int vi = w >> 1, ti = w & 1;

  float ig_n = -INFINITY, fg_n = 0.f;
  if (w == 0 && lane < L) {
    const float* gp = gatesp + (size_t)(tokbase + lane) * 8;
    ig_n = gp[head]; fg_n = gp[4 + head];
  }
  for (int c = 0; c < nch; ++c) {
    const int t0 = c * 64;
    if (w == 0) {
      const int t = lane;
      float ig = -INFINITY, lf = 0.f;
      if (t < L) {
        ig = ig_n;
        const float fg = fg_n;
        lf = fminf(fg, 0.f) - log1pf(__expf(-fabsf(fg)));
        if (c + 1 < nch) {
          const float* gp = gatesp + (size_t)(tokbase + t0 + 64 + t) * 8;
          ig_n = gp[head]; fg_n = gp[4 + head];
        }
      }
      float bc = lf;
#pragma unroll
      for (int off = 1; off < 64; off <<= 1) { const float v = shidx(bc, lane - off, lane); if (lane >= off) bc += v; }
      const float a = ig - bc;
      float M = a;
#pragma unroll
      for (int off = 1; off < 64; off <<= 1) { const float v = shidx(M, lane - off, lane); if (lane >= off) M = fmaxf(M, v); }
      const float mx = fmaxf(m_run, M);
      const float bL = shidx(bc, 63, lane);
      const float mxL = shidx(mx, 63, lane);
      a_s[t] = a; mx_s[t] = mx;
      ws_s[t] = __expf(a - mxL);
      wi_s[t] = __expf(m_run - mx);
      emt_s[t] = __expf(-(bc + mx));
      if (lane == 0) scal[1] = __expf(m_run - mxL);
      m_run = bL + mxL;
    }
    const int ch2 = tid >> 1, th = tid & 1;
    const bool isk = ch2 >= 128;
    const int dd = ch2 & 127;
    const int ch = (isk ? 512 : 0) + head * 128 + dd;
    const u16* rp = qkT + (size_t)ch * T + t0 + th * 32;
    float um3 = 0.f, um2 = 0.f, um1 = 0.f;
    const bool ldrow = prompt || th == 0;
    uint4 uu0 = make_uint4(0, 0, 0, 0), uu1 = uu0, uu2 = uu0, uu3 = uu0, vv0 = uu0, vv1 = uu0;
    if (ldrow) { uu0 = *(const uint4*)(rp); uu1 = *(const uint4*)(rp + 8); uu2 = *(const uint4*)(rp + 16); uu3 = *(const uint4*)(rp + 24); }
    {
      const int row = tid >> 3, cc = tid & 7;
      if (prompt || cc < 4) {
        vv0 = *(const uint4*)(vTg + (size_t)(head * 128 + row) * T + t0 + cc * 8);
        vv1 = *(const uint4*)(vTg + (size_t)(head * 128 + row + 64) * T + t0 + cc * 8);
      }
    }
    if (prompt) {
      if (th == 1 || c > 0) {
        const uint2 pv = *(const uint2*)(rp - 4);
        um3 = bfhi(pv.x); um2 = bflo(pv.y); um1 = bfhi(pv.y);
      }
    } else if (th == 0) {
      const float* cvp = p.in[9] + (size_t)(l * 8 + bs) * 3 * 1024 + ch;
      um3 = cvp[0]; um2 = cvp[1024]; um1 = cvp[2048];
    }
    const float cw0 = p.in[14][(l * 4 + 0) * 1024 + ch], cw1 = p.in[14][(l * 4 + 1) * 1024 + ch];
    const float cw2 = p.in[14][(l * 4 + 2) * 1024 + ch], cw3 = p.in[14][(l * 4 + 3) * 1024 + ch];
    const float cb = p.in[15][l * 1024 + ch];
    __syncthreads();
    {
      u16* dstrm = (isk ? ksm : qs) + (th * 32) * 136 + dd;
      const float oscale = isk ? 0.08838834764831845f : 1.f;
#pragma unroll
      for (int i = 0; i < 4; ++i) {
        const uint4 uu = (i == 0) ? uu0 : (i == 1 ? uu1 : (i == 2 ? uu2 : uu3));
        float u[8];
        u[0] = bflo(uu.x); u[1] = bfhi(uu.x); u[2] = bflo(uu.y); u[3] = bfhi(uu.y);
        u[4] = bflo(uu.z); u[5] = bfhi(uu.z); u[6] = bflo(uu.w); u[7] = bfhi(uu.w);
        float y[8];
#pragma unroll
        for (int e = 0; e < 8; ++e) {
          const float x3 = (e >= 3) ? u[e - 3] : (e == 0 ? um3 : (e == 1 ? um2 : um1));
          const float x2 = (e >= 2) ? u[e - 2] : (e == 0 ? um2 : um1);
          const float x1 = (e >= 1) ? u[e - 1] : um1;
          const float yy = cb + cw0 * x3 + cw1 * x2 + cw2 * x1 + cw3 * u[e];
          y[e] = siluf_(yy) * oscale;
        }
        um3 = u[5]; um2 = u[6]; um1 = u[7];
#pragma unroll
        for (int e = 0; e < 8; ++e) dstrm[(i * 8 + e) * 136] = f2bf(y[e]);
        if (isk) {
          const float4 w0 = *(const float4*)(ws_s + th * 32 + i * 8);
          const float4 w1 = *(const float4*)(ws_s + th * 32 + i * 8 + 4);
          uint4 o;
          o.x = pack2(y[0] * w0.x, y[1] * w0.y); o.y = pack2(y[2] * w0.z, y[3] * w0.w);
          o.z = pack2(y[4] * w1.x, y[5] * w1.y); o.w = pack2(y[6] * w1.z, y[7] * w1.w);
          *(uint4*)(kTw + dd * 72 + th * 32 + i * 8) = o;
        }
      }
      {
        const int row = tid >> 3, cc = tid & 7;
        *(uint4*)(vT + row * 72 + cc * 8) = vv0;
        *(uint4*)(vT + (row + 64) * 72 + cc * 8) = vv1;
      }
    }
    __syncthreads();
    {
      const int t = tid >> 3, part = tid & 7;
      const uint4 q0 = *(const uint4*)(qs + t * 136 + part * 16);
      const uint4 q1 = *(const uint4*)(qs + t * 136 + part * 16 + 8);
      const float* nv = nvec + part * 16;
      float s = bflo(q0.x) * nv[0] + bfhi(q0.x) * nv[1] + bflo(q0.y) * nv[2] + bfhi(q0.y) * nv[3]
              + bflo(q0.z) * nv[4] + bfhi(q0.z) * nv[5] + bflo(q0.w) * nv[6] + bfhi(q0.w) * nv[7]
              + bflo(q1.x) * nv[8] + bfhi(q1.x) * nv[9] + bflo(q1.y) * nv[10] + bfhi(q1.y) * nv[11]
              + bflo(q1.z) * nv[12] + bfhi(q1.z) * nv[13] + bflo(q1.w) * nv[14] + bfhi(q1.w) * nv[15];
      s += shx(s, 1, lane); s += shx(s, 2, lane); s += shx(s, 4, lane);
      if (part == 0) nq_s[t] = s;
    }
    f32x16 accS[2], accO;
    zero16(accS[0]); zero16(accS[1]); zero16(accO);
    {
#pragma unroll
      for (int ks = 0; ks < 8; ++ks) {
        const bf16x8 qfr = *(const bf16x8*)(qs + (ti * 32 + r) * 136 + ks * 16 + h * 8);
        const bf16x8 k0 = *(const bf16x8*)(ksm + r * 136 + ks * 16 + h * 8);
        accS[0] = MFMA(k0, qfr, accS[0]);
        if (ti == 1) {
          const bf16x8 k1 = *(const bf16x8*)(ksm + (32 + r) * 136 + ks * 16 + h * 8);
          accS[1] = MFMA(k1, qfr, accS[1]);
        }
        const bf16x8 cf = *(const bf16x8*)(Cbf + (vi * 32 + r) * 136 + ks * 16 + h * 8);
        accO = MFMA(cf, qfr, accO);
      }
    }
    const int tcol = ti * 32 + r;
    const float mxt = mx_s[tcol];
    const float wit = wi_s[tcol];
    float dsum = 0.f;
#pragma unroll
    for (int sub = 0; sub < 2; ++sub) {
      if (sub <= ti) {
#pragma unroll
        for (int g = 0; g < 4; ++g) {
          const float4 a4 = *(const float4*)(a_s + sub * 32 + 8 * g + 4 * h);
          const float av[4] = {a4.x, a4.y, a4.z, a4.w};
#pragma unroll
          for (int e = 0; e < 4; ++e) {
            const int s = sub * 32 + 8 * g + 4 * h + e;
            const float wgt = (s <= tcol) ? __expf(av[e] - mxt) : 0.f;
            const float pv = accS[sub][4 * g + e] * wgt;
            accS[sub][4 * g + e] = pv;
            dsum += pv;
          }
        }
      }
    }
    dsum += shx(dsum, 32, lane);
#pragma unroll
    for (int i = 0; i < 16; ++i) accO[i] *= wit;
#pragma unroll
    for (int sub = 0; sub < 2; ++sub) {
      if (sub <= ti) {
#pragma unroll
        for (int s2 = 0; s2 < 2; ++s2) {
          const bf16x8 pf = pack8(accS[sub], s2);
          const u16* va = vT + (vi * 32 + r) * 72 + sub * 32 + s2 * 16 + 4 * h;
          const uint2 lo = *(const uint2*)va;
          const uint2 hi = *(const uint2*)(va + 8);
          const uint4 vq = make_uint4(lo.x, lo.y, hi.x, hi.y);
          accO = MFMA(__builtin_bit_cast(bf16x8, vq), pf, accO);
        }
      }
    }
    __syncthreads();
    {
      const float den = dsum + wit * nq_s[tcol];
      const float dn = fmaxf(fabsf(den), emt_s[tcol]);
      const float rinv = 1.f / dn;
#pragma unroll
      for (int g = 0; g < 4; ++g)
        *(float4*)(hbuf + tcol * 132 + vi * 32 + 8 * g + 4 * h) =
            make_float4(accO[4 * g] * rinv, accO[4 * g + 1] * rinv, accO[4 * g + 2] * rinv, accO[4 * g + 3] * rinv);
    }
    {
      const float wc = scal[1];
#pragma unroll
      for (int q = 0; q < 2; ++q)
#pragma unroll
        for (int i = 0; i < 16; ++i) accC[q][i] *= wc;
#pragma unroll
      for (int k4 = 0; k4 < 4; ++k4) {
        const bf16x8 vf = *(const bf16x8*)(vT + (vt * 32 + r) * 72 + k4 * 16 + h * 8);
#pragma unroll
        for (int q = 0; q < 2; ++q) {
          const bf16x8 kf = *(const bf16x8*)(kTw + ((kt0 + q) * 32 + r) * 72 + k4 * 16 + h * 8);
          accC[q] = MFMA(kf, vf, accC[q]);
        }
      }
#pragma unroll
      for (int q = 0; q < 2; ++q)
#pragma unroll
        for (int g = 0; g < 4; ++g) {
          uint2 o; o.x = pack2(accC[q][4 * g], accC[q][4 * g + 1]); o.y = pack2(accC[q][4 * g + 2], accC[q][4 * g + 3]);
          *(uint2*)(Cbf + (vt * 32 + r) * 136 + (kt0 + q) * 32 + 8 * g + 4 * h) = o;
        }
      if (tid < 128) {
        float s = 0.f;
#pragma unroll
        for (int i = 0; i < 8; ++i) {
          const uint4 kk = *(const uint4*)(kTw + tid * 72 + i * 8);
          s += bflo(kk.x) + bfhi(kk.x) + bflo(kk.y) + bfhi(kk.y) + bflo(kk.z) + bfhi(kk.z) + bflo(kk.w) + bfhi(kk.w);
        }
        nvec[tid] = wc * nvec[tid] + s;
      }
    }
    __syncthreads();
    {
      const int t = tid >> 3, part = tid & 7;
      float x[16];
#pragma unroll
      for (int i = 0; i < 4; ++i) {
        const float4 f = *(const float4*)(hbuf + t * 132 + part * 16 + i * 4);
        x[i * 4] = f.x; x[i * 4 + 1] = f.y; x[i * 4 + 2] = f.z; x[i * 4 + 3] = f.w;
      }
      float s = 0.f;
#pragma unroll
      for (int i = 0; i < 16; ++i) s += x[i];
      s += shx(s, 1, lane); s += shx(s, 2, lane); s += shx(s, 4, lane);
      const float mean = s * (1.f / 128.f);
      float q = 0.f;
#pragma unroll
      for (int i = 0; i < 16; ++i) { x[i] -= mean; q += x[i] * x[i]; }
      q += shx(q, 1, lane); q += shx(q, 2, lane); q += shx(q, 4, lane);
      const float rstd = rsqrtf(q * (1.f / 128.f) + LN_EPS);
      if (t < L) {
        const size_t tok = (size_t)tokbase + t0 + t;
        const int cbase = head * 128 + part * 16;
        const float* gw = p.in[18] + l * 512 + cbase;
        const u16* mo = (const u16*)(p.ws + WS_MO) + tok * 512 + cbase;
        const uint4 m0 = *(const uint4*)mo;
        const uint4 m1 = *(const uint4*)(mo + 8);
        const float sg[16] = {bflo(m0.x), bfhi(m0.x), bflo(m0.y), bfhi(m0.y), bflo(m0.z), bfhi(m0.z), bflo(m0.w), bfhi(m0.w),
                              bflo(m1.x), bfhi(m1.x), bflo(m1.y), bfhi(m1.y), bflo(m1.z), bfhi(m1.z), bflo(m1.w), bfhi(m1.w)};
        float yv[16];
#pragma unroll
        for (int i = 0; i < 16; ++i) yv[i] = x[i] * rstd * gw[i] * sg[i];
        uint4 o0, o1;
        o0.x = pack2(yv[0], yv[1]); o0.y = pack2(yv[2], yv[3]); o0.z = pack2(yv[4], yv[5]); o0.w = pack2(yv[6], yv[7]);
        o1.x = pack2(yv[8], yv[9]); o1.y = pack2(yv[10], yv[11]); o1.z = pack2(yv[12], yv[13]); o1.w = pack2(yv[14], yv[15]);
        u16* mn = (u16*)(p.ws + WS_MN) + tok * 512 + cbase;
        *(uint4*)mn = o0;
        *(uint4*)(mn + 8) = o1;
      }
    }
  }
  {
    float* oc = p.out + (prompt ? O_CP + ((size_t)(l * 32 + b) * 4 + head) * 16384 : O_CS + ((size_t)(l * 8 + bs) * 4 + head) * 16384);
#pragma unroll
    for (int q = 0; q < 2; ++q)
#pragma unroll
      for (int g = 0; g < 4; ++g)
        *(float4*)(oc + (size_t)(vt * 32 + r) * 128 + (kt0 + q) * 32 + 8 * g + 4 * h) =
            make_float4(accC[q][4 * g], accC[q][4 * g + 1], accC[q][4 * g + 2], accC[q][4 * g + 3]);
    float* on = p.out + (prompt ? O_NP + ((size_t)(l * 32 + b) * 4 + head) * 128 : O_NS + ((size_t)(l * 8 + bs) * 4 + head) * 128);
    if (tid < 128) on[tid] = nvec[tid];
    if (tid == 0) {
      if (prompt) p.out[O_MP + (size_t)(l * 32 + b) * 4 + head] = m_run;
      else p.out[O_MS + (size_t)(l * 8 + bs) * 4 + head] = m_run;
    }
  }
}

DI void phase_mixers(const Params& p, int l, unsigned char* smem) {
  const int tid0 = otid();
  const int lane = tid0 & 63;
  const float* lp = p.in[16] + l * 256;
  float s1 = lp[lane] * lp[64 + lane], s2 = lp[128 + lane] * lp[192 + lane];
  s1 = wave_sum(s1, lane); s2 = wave_sum(s2, lane);
  const float lam_init = 0.8f - 0.6f * expf(-0.3f * (float)l);
  const float lam = expf(s1) - expf(s2) + lam_init;
  int* ctr = (int*)(p.ws + WS_CTR) + l;
  int* sitem = (int*)smem;
  const int N_ML = 160, N_AT = 2048 + 32;
  for (;;) {
    __syncthreads();
    if (tid0 == 0) *sitem = atomicAdd(ctr, 1);
    __syncthreads();
    const int item = *sitem;
    if (item >= N_ML + N_AT) break;
    if (item < N_ML) {
#ifndef NO_ML
      mlstm_item(p, l, item >> 2, item & 3, smem);
#endif
    } else {
#ifndef NO_AT
      const int a = item - N_ML;
      if (a < 2048) {
        const int qt = 15 - (a >> 7), rest = a & 127;
        attn_item(p, l, rest >> 2, rest & 3, qt, lam, lam_init, smem);
      } else {
        const int s = a - 2048;
        attn_item(p, l, 32 + (s >> 2), s & 3, 0, lam, lam_init, smem);
      }
#endif
    }
  }
}

DI void gbar(unsigned* bar, unsigned& epoch) {
  __syncthreads();
  epoch += gridDim.x;
  if (otid() == 0) {
    __threadfence();
    __hip_atomic_fetch_add(bar, 1u, __ATOMIC_RELAXED, __HIP_MEMORY_SCOPE_AGENT);
    while (__hip_atomic_load(bar, __ATOMIC_RELAXED, __HIP_MEMORY_SCOPE_AGENT) < epoch) __builtin_amdgcn_s_sleep(2);
    __threadfence();
  }
  __syncthreads();
}

__global__ void __launch_bounds__(NTHR) fwd_megakernel(Params p) {
  extern __shared__ __attribute__((aligned(16))) unsigned char smem[];
  cg::grid_group grid = cg::this_grid();
#ifndef PH
#define PH 0xffff
#endif
  unsigned* bar = (unsigned*)(p.ws + WS_CTR + 64);
  unsigned epoch = 0;
  if (PH & 1) prologue(p, smem);
  grid.sync();
  if (PH & 1) prologue(p, smem);
  grid.sync();
  if (PH & 2) ln_pass(p, 0, 0, smem);
  gbar(bar, epoch);
#pragma unroll 1
  for (int l = 0; l < 2; ++l) {
    if (PH & 4) phase_in_gate(p, l, smem);
    gbar(bar, epoch);
    if (PH & 8) phase_mixers(p, l, smem);
    gbar(bar, epoch);
    if (PH & 16) phase_mix(p, l, smem);
    gbar(bar, epoch);
    if (PH & 32) phase_res(p, l, 0, smem);
    gbar(bar, epoch);
    if (PH & 64) ln_pass(p, 1, l, smem);
    gbar(bar, epoch);
    if (PH & 128) phase_gu(p, l, smem);
    gbar(bar, epoch);
    if (PH & 256) phase_res(p, l, 1, smem);
    gbar(bar, epoch);
    if (PH & 512) ln_pass(p, 2, l, smem);
    if (l == 0) gbar(bar, epoch);
  }
}

extern "C" void kernel_launch(void* const* d_in, const int* in_sizes, int n_in, void* d_out, int out_size, void* d_ws,
                              size_t ws_size, hipStream_t stream) {
  static int grid_blocks = 0;
  if (!grid_blocks) {
    int dev = 0, cus = 0, per_cu = 0;
    hipGetDevice(&dev);
    hipDeviceGetAttribute(&cus, hipDeviceAttributeMultiprocessorCount, dev);
    if (hipFuncSetAttribute((const void*)fwd_megakernel, hipFuncAttributeMaxDynamicSharedMemorySize, LDS_BYTES) != hipSuccess)
      fprintf(stderr, "kernel_launch: hipFuncSetAttribute failed\n");
    if (hipOccupancyMaxActiveBlocksPerMultiprocessor(&per_cu, (const void*)fwd_megakernel, NTHR, LDS_BYTES) != hipSuccess || per_cu < 1) {
      fprintf(stderr, "kernel_launch: occupancy query gave %d\n", per_cu);
      per_cu = 1;
    }
    (void)hipGetLastError();
    grid_blocks = cus * per_cu;
    if (ws_size < WS_END) fprintf(stderr, "kernel_launch: workspace too small: %zu < %zu\n", ws_size, (size_t)WS_END);
  }
  if (hipMemsetAsync((char*)d_ws + WS_CTR, 0, 256, stream) != hipSuccess) fprintf(stderr, "kernel_launch: memset failed\n");
  Params p{};
  for (int i = 0; i < 30; ++i) p.in[i] = (const float*)d_in[i];
  p.out = (float*)d_out;
  p.ws = (unsigned char*)d_ws;
  void* args[] = {&p};
  hipError_t e = hipLaunchCooperativeKernel((const void*)fwd_megakernel, dim3(grid_blocks), dim3(NTHR), args, LDS_BYTES, stream);
  if (e != hipSuccess) fprintf(stderr, "cooperative launch failed: %s (grid %d)\n", hipGetErrorString(e), grid_blocks);
}
```

```cpp
#include <hip/hip_runtime.h>
#include <hip/hip_cooperative_groups.h>
#include <cstdio>
namespace cg = cooperative_groups;

#define DI __device__ __forceinline__
typedef unsigned short u16;
using bf16x8 = __attribute__((ext_vector_type(8))) short;
using f32x16 = __attribute__((ext_vector_type(16))) float;
#define MFMA(a, b, c) __builtin_amdgcn_mfma_f32_32x32x16_bf16((a), (b), (c), 0, 0, 0)

constexpr int TOKP = 65536, TOKS = 256, TOK = 65792;
constexpr int NTHR = 512;
constexpr float LN_EPS = 1e-5f;
constexpr float ALPHA = 1.41421356237f;
constexpr float LOG2E = 1.44269504089f;

constexpr size_t WS_WT_IN   = 0;
constexpr size_t WS_WT_GATE = WS_WT_IN + 2ull * 3584 * 1024 * 2;
constexpr size_t WS_WT_BRA  = WS_WT_GATE + 2ull * 2048 * 1024 * 2;
constexpr size_t WS_WT_BRB  = WS_WT_BRA + 2ull * 1024 * 512 * 2;
constexpr size_t WS_WT_O    = WS_WT_BRB + 2ull * 1024 * 512 * 2;
constexpr size_t WS_WT_GU   = WS_WT_O + 2ull * 1024 * 1024 * 2;
constexpr size_t WS_WT_DOWN = WS_WT_GU + 2ull * 5632 * 1024 * 2;
constexpr size_t WS_MOD     = WS_WT_DOWN + 2ull * 1024 * 2816 * 2;
constexpr size_t WS_GATES   = WS_MOD + 2ull * 40 * 6144 * 4;
constexpr size_t WS_CTR     = WS_GATES + (size_t)TOK * 8 * 4;
constexpr size_t WS_KS      = WS_CTR + 256;
constexpr size_t WS_VTS     = WS_KS + 2ull * 8 * 1056 * 512 * 2 + 65536;
constexpr size_t WS_MQKT_S  = WS_VTS + 2ull * 8 * 512 * 1056 * 2 + 65536;
constexpr size_t WS_MVT_S   = WS_MQKT_S + 8ull * 1024 * 32 * 2;
constexpr size_t WS_H       = WS_MVT_S + 8ull * 512 * 32 * 2;
constexpr size_t WS_AN      = WS_H;
constexpr size_t WS_MN      = WS_H + (size_t)TOK * 512 * 2;
constexpr size_t WS_ZQ      = WS_H + (size_t)TOK * 1024 * 2;
constexpr size_t WS_KB      = WS_ZQ + (size_t)TOK * 512 * 2;
constexpr size_t WS_VTP     = WS_KB + (size_t)TOKP * 512 * 2;
constexpr size_t WS_MQKT_P  = WS_VTP + 32ull * 512 * 2048 * 2;
constexpr size_t WS_MVT_P   = WS_MQKT_P + 32ull * 1024 * 2048 * 2;
constexpr size_t WS_MO      = WS_MVT_P + 32ull * 512 * 2048 * 2;
constexpr size_t WS_G       = WS_MO + (size_t)TOK * 512 * 2;
constexpr size_t WS_END     = WS_G + (size_t)TOK * 2048 * 2;
constexpr size_t WS_MIX     = WS_ZQ;
constexpr size_t WS_ACT     = WS_ZQ;

constexpr size_t O_YP  = 0;
constexpr size_t O_YS  = O_YP + (size_t)TOKP * 1024;
constexpr size_t O_KP  = O_YS + (size_t)TOKS * 1024;
constexpr size_t O_VP  = O_KP + 2ull * TOKP * 512;
constexpr size_t O_KSM = O_VP + 2ull * TOKP * 512;
constexpr size_t O_VSM = O_KSM + 2ull * TOKS * 512;
constexpr size_t O_CP  = O_VSM + 2ull * TOKS * 512;
constexpr size_t O_NP  = O_CP + 2ull * 32 * 4 * 128 * 128;
constexpr size_t O_MP  = O_NP + 2ull * 32 * 4 * 128;
constexpr size_t O_CVP = O_MP + 2ull * 32 * 4;
constexpr size_t O_CS  = O_CVP + 2ull * 32 * 3 * 1024;
constexpr size_t O_NS  = O_CS + 2ull * 8 * 4 * 128 * 128;
constexpr size_t O_MS  = O_NS + 2ull * 8 * 4 * 128;
constexpr size_t O_CVS = O_MS + 2ull * 8 * 4;

constexpr int LDS_BYTES = 148480;

struct Params {
  const float* in[30];
  float* out;
  unsigned char* ws;
};

DI u16 f2bf(float x) { unsigned u = __float_as_uint(x); u += 0x7fffu + ((u >> 16) & 1u); return (u16)(u >> 16); }
DI float bf2f(unsigned v) { return __uint_as_float(v << 16); }
typedef __bf16 bf16x2_t __attribute__((ext_vector_type(2)));
typedef float f32x2_t __attribute__((ext_vector_type(2)));
DI unsigned pack2(float a, float b) {
  f32x2_t v = {a, b};
  return __builtin_bit_cast(unsigned, __builtin_convertvector(v, bf16x2_t));
}
DI float bflo(unsigned v) { return __uint_as_float(v << 16); }
DI float bfhi(unsigned v) { return __uint_as_float(v & 0xffff0000u); }
DI float sigmoidf_(float x) { return 1.f / (1.f + __expf(-x)); }
DI float siluf_(float x) { return x / (1.f + __expf(-x)); }
DI float fexp2(float x) { return __builtin_amdgcn_exp2f(x); }
DI int otid() { int t = threadIdx.x; asm volatile("" : "+v"(t)); return t; }
DI float shx(float v, int mask, int lane) { return __int_as_float(__builtin_amdgcn_ds_bpermute(((lane ^ mask) & 63) << 2, __float_as_int(v))); }
DI float shidx(float v, int src, int lane) { (void)lane; return __int_as_float(__builtin_amdgcn_ds_bpermute((src & 63) << 2, __float_as_int(v))); }
DI int crow(int i, int h) { return (i & 3) + 8 * (i >> 2) + 4 * h; }
DI bf16x8 pack8(const f32x16& x, int s) {
  uint4 u;
  u.x = pack2(x[8 * s + 0], x[8 * s + 1]); u.y = pack2(x[8 * s + 2], x[8 * s + 3]);
  u.z = pack2(x[8 * s + 4], x[8 * s + 5]); u.w = pack2(x[8 * s + 6], x[8 * s + 7]);
  return __builtin_bit_cast(bf16x8, u);
}
DI void zero16(f32x16& a) {
#pragma unroll
  for (int i = 0; i < 16; ++i) a[i] = 0.f;
}
DI int batch_of_row(int row) { return row < TOKP ? (row >> 11) : 32 + ((row - TOKP) >> 5); }

constexpr int GS_STRIDE = 144;
constexpr int GS_STAGE = 512 * GS_STRIDE;
constexpr int GS_BASE = 64;

DI void gemm_mainloop(f32x16 (&acc)[4][2], const u16* __restrict__ A, int lda, const u16* __restrict__ Wt, int ldw, int K,
                      int m0, int n0, unsigned char* smem) {
  const int tid = otid(), lane = tid & 63, w = tid >> 6;
  const int wm = w >> 2, wn = w & 3, r = lane & 31, h = lane >> 5;
  const int lrow = tid >> 3, lcc = tid & 7;
  const u16* ap = A + (size_t)(m0 + lrow) * lda + lcc * 8;
  const int bn = n0 + 2 * (lrow & 31) + ((lrow >> 5) & 1);
  const u16* bp = Wt + (size_t)bn * ldw + lcc * 8;
  const size_t astep = (size_t)64 * lda, bstep = (size_t)64 * ldw;
  unsigned char* sbase = smem + GS_BASE;
  const int woff = lrow * GS_STRIDE + lcc * 16;
  const int nk = K >> 6;
  uint4 s0, s1, s2, s3, s4, s5, s6, s7, u0, u1, u2, u3, u4, u5, u6, u7;
  int kn = 1;
#define G_ADV() do { const int adv = (kn < nk) ? 64 : 0; ap += adv; bp += adv; ++kn; } while (0)
#define G_ISSUE_A() do { s0 = *(const uint4*)(ap); s1 = *(const uint4*)(ap + astep); s2 = *(const uint4*)(ap + 2 * astep); s3 = *(const uint4*)(ap + 3 * astep); \
    s4 = *(const uint4*)(bp); s5 = *(const uint4*)(bp + bstep); s6 = *(const uint4*)(bp + 2 * bstep); s7 = *(const uint4*)(bp + 3 * bstep); } while (0)
#define G_ISSUE_B() do { u0 = *(const uint4*)(ap); u1 = *(const uint4*)(ap + astep); u2 = *(const uint4*)(ap + 2 * astep); u3 = *(const uint4*)(ap + 3 * astep); \
    u4 = *(const uint4*)(bp); u5 = *(const uint4*)(bp + bstep); u6 = *(const uint4*)(bp + 2 * bstep); u7 = *(const uint4*)(bp + 3 * bstep); } while (0)
#define G_WRITE_A(sn) do { *(uint4*)((sn) + woff) = s0; *(uint4*)((sn) + woff + 64 * GS_STRIDE) = s1; *(uint4*)((sn) + woff + 128 * GS_STRIDE) = s2; \
    *(uint4*)((sn) + woff + 192 * GS_STRIDE) = s3; *(uint4*)((sn) + woff + 256 * GS_STRIDE) = s4; *(uint4*)((sn) + woff + 320 * GS_STRIDE) = s5; \
    *(uint4*)((sn) + woff + 384 * GS_STRIDE) = s6; *(uint4*)((sn) + woff + 448 * GS_STRIDE) = s7; } while (0)
#define G_WRITE_B(sn) do { *(uint4*)((sn) + woff) = u0; *(uint4*)((sn) + woff + 64 * GS_STRIDE) = u1; *(uint4*)((sn) + woff + 128 * GS_STRIDE) = u2; \
    *(uint4*)((sn) + woff + 192 * GS_STRIDE) = u3; *(uint4*)((sn) + woff + 256 * GS_STRIDE) = u4; *(uint4*)((sn) + woff + 320 * GS_STRIDE) = u5; \
    *(uint4*)((sn) + woff + 384 * GS_STRIDE) = u6; *(uint4*)((sn) + woff + 448 * GS_STRIDE) = u7; } while (0)
  const int aoff = (wm * 128 + r) * GS_STRIDE + h * 16;
  const int boff = (256 + wn * 64 + r) * GS_STRIDE + h * 16;
#define G_COMPUTE(st) do { _Pragma("unroll") for (int ks = 0; ks < 4; ++ks) {                                              \
      bf16x8 fa[4], fb[2];                                                                                               \
      _Pragma("unroll") for (int mi = 0; mi < 4; ++mi) fa[mi] = *(const bf16x8*)((st) + aoff + mi * 32 * GS_STRIDE + ks * 32); \
      fb[0] = *(const bf16x8*)((st) + boff + ks * 32);                                                                   \
      fb[1] = *(const bf16x8*)((st) + boff + 32 * GS_STRIDE + ks * 32);                                                  \
      _Pragma("unroll") for (int mi = 0; mi < 4; ++mi) {                                                                 \
        acc[mi][0] = MFMA(fa[mi], fb[0], acc[mi][0]);                                                                    \
        acc[mi][1] = MFMA(fa[mi], fb[1], acc[mi][1]);                                                                    \
      }                                                                                                                  \
      __builtin_amdgcn_sched_barrier(0);                                                                                 \
    } } while (0)
  G_ISSUE_A();
  G_WRITE_A(sbase);
  G_ADV(); G_ISSUE_A();
  G_ADV(); G_ISSUE_B();
  __syncthreads();
  for (int kt = 0; kt < nk; kt += 2) {
    G_WRITE_A(sbase + GS_STAGE);
    G_ADV(); G_ISSUE_A();
    __builtin_amdgcn_sched_barrier(0);
    G_COMPUTE(sbase);
    __syncthreads();
    G_WRITE_B(sbase);
    G_ADV(); G_ISSUE_B();
    __builtin_amdgcn_sched_barrier(0);
    G_COMPUTE(sbase + GS_STAGE);
    __syncthreads();
  }
#undef G_ADV
#undef G_ISSUE_A
#undef G_ISSUE_B
#undef G_WRITE_A
#undef G_WRITE_B
#undef G_COMPUTE
}

DI int rot_unused_(int) { return 0; }
DI bool tile_of(int i, int MT, int NT, int& mt, int& nt) {
  const int per = gridDim.x >> 3;
  const int L = i * (int)gridDim.x + (int)(blockIdx.x & 7) * per + (int)(blockIdx.x >> 3);
  if (L >= MT * NT) return false;
  const int nig = 8 * NT, gid = L / nig, fm = gid * 8, gsz = min(MT - fm, 8), rem = L - gid * nig;
  mt = fm + rem % gsz; nt = rem / gsz;
  return true;
}


template <class PF, class EF>
DI void gemm_stream(int lda, int ldw, int K, unsigned char* smem, PF ptrs, EF epi) {
  const int tid = otid(), lane = tid & 63, w = tid >> 6;
  const int wm = w >> 2, wn = w & 3, r = lane & 31, h = lane >> 5;
  unsigned char* sbase = smem + GS_BASE;
  constexpr int SLOT = 512 * 64;
  const int nh = K >> 5;
  const int c0 = (h ^ ((r >> 2) & 3)) * 16, c1 = c0 ^ 32;
  const int aoff = (wm * 128 + r) * 64, boff = (256 + wn * 64 + r) * 64;
  const int lr16 = lane >> 2, lchunk = (lane & 3) ^ ((lane >> 4) & 3);
  const bool isB = w >= 4;
  const unsigned goff = isB ? (unsigned)((((w - 4) * 64 + 2 * lr16) * ldw + lchunk * 8) * 2)
                            : (unsigned)(((w * 64 + lr16) * lda + lchunk * 8) * 2);
  const unsigned st1 = isB ? (unsigned)(32 * ldw * 2) : (unsigned)(16 * lda * 2);
  const unsigned st2 = isB ? (unsigned)(1 * ldw * 2) : (unsigned)(32 * lda * 2);
#define WAIT_V(n) asm volatile("s_waitcnt vmcnt(" #n ")" ::: "memory")
#define RAWBAR() do { asm volatile("s_waitcnt lgkmcnt(0)" ::: "memory"); __builtin_amdgcn_s_barrier(); asm volatile("" ::: "memory"); } while (0)
#define BAR0() do { asm volatile("" ::: "memory"); __builtin_amdgcn_s_barrier(); asm volatile("" ::: "memory"); } while (0)
#define H_DMA(slotp) do { const char* gsrc_ = (isB ? bp : ap) + goff; unsigned char* ld_ = (slotp) + w * 4096;            \
    __builtin_amdgcn_global_load_lds((const unsigned*)(gsrc_), (unsigned*)(ld_), 16, 0, 0);                                  \
    __builtin_amdgcn_global_load_lds((const unsigned*)(gsrc_ + st1), (unsigned*)(ld_ + 1024), 16, 0, 0);                     \
    __builtin_amdgcn_global_load_lds((const unsigned*)(gsrc_ + st2), (unsigned*)(ld_ + 2048), 16, 0, 0);                     \
    __builtin_amdgcn_global_load_lds((const unsigned*)(gsrc_ + st2 + st1), (unsigned*)(ld_ + 3072), 16, 0, 0); } while (0)
#define H_READ(sl) do { _Pragma("unroll") for (int mi = 0; mi < 4; ++mi) {                                                   \
      fa[0][mi] = *(const bf16x8*)((sl) + aoff + mi * 2048 + c0); fa[1][mi] = *(const bf16x8*)((sl) + aoff + mi * 2048 + c1); } \
    fb[0][0] = *(const bf16x8*)((sl) + boff + c0); fb[1][0] = *(const bf16x8*)((sl) + boff + c1);                            \
    fb[0][1] = *(const bf16x8*)((sl) + boff + 2048 + c0); fb[1][1] = *(const bf16x8*)((sl) + boff + 2048 + c1); } while (0)
#define H_MMA() do { _Pragma("unroll") for (int ks = 0; ks < 2; ++ks) { _Pragma("unroll") for (int mi = 0; mi < 4; ++mi) {  \
      acc[mi][0] = MFMA(fa[ks][mi], fb[ks][0], acc[mi][0]);                                                       \
      acc[mi][1] = MFMA(fa[ks][mi], fb[ks][1], acc[mi][1]); } } } while (0)
  for (int it = 0;; ++it) {
    const char *ap, *bp;
    {
      const u16 *ta, *tb;
      if (!ptrs(it, ta, tb)) break;
      ap = (const char*)ta; bp = (const char*)tb;
    }
    f32x16 acc[4][2];
#pragma unroll
    for (int a = 0; a < 4; ++a)
#pragma unroll
      for (int b = 0; b < 2; ++b) zero16(acc[a][b]);
    H_DMA(sbase); ap += 64; bp += 64;
    H_DMA(sbase + SLOT); ap += 64; bp += 64;
    H_DMA(sbase + 2 * SLOT); ap += 64; bp += 64;
    WAIT_V(8);
    BAR0();
    if (wm == 1) BAR0();
    int rs = 0;
#pragma unroll 1
    for (int hh = 0; hh < nh; ++hh) {
      bf16x8 fa[2][4], fb[2][2];
      const int rem = nh - 2 - hh;
      H_READ(sbase + rs * SLOT);
      if (hh + 3 < nh) { H_DMA(sbase + ((rs + 3) & 3) * SLOT); ap += 64; bp += 64; }
      if (wm == 1) {
        if (rem >= 2) WAIT_V(8); else if (rem == 1) WAIT_V(4); else WAIT_V(0);
      }
      __builtin_amdgcn_sched_barrier(0);
      RAWBAR();
      __builtin_amdgcn_sched_barrier(0);
      H_MMA();
      __builtin_amdgcn_sched_barrier(0);
      if (wm == 0) {
        if (rem >= 2) WAIT_V(8); else if (rem == 1) WAIT_V(4); else WAIT_V(0);
      }
      BAR0();
      rs = (rs + 1) & 3;
    }
    if (wm == 0) BAR0();
    epi(it, acc);
  }
#undef WAIT_V
#undef RAWBAR
#undef BAR0
#undef H_DMA
#undef H_READ
#undef H_MMA
}

DI int map_row(int maptype, int s) {
  if (maptype == 1) return s < 3072 ? s : (s < 3080 ? -1 : s - 8);
  if (maptype == 2) return s < 2816 ? 2 * s : 2 * (s - 2816) + 1;
  return s;
}
DI void transpose_task(const float* __restrict__ src, int Nsrc, u16* __restrict__ dst, int dld, int maptype, int kt, int nt,
                       unsigned char* smem) {
  float* tile = (float*)(smem + 64);
  const int tid = otid();
  const int k0 = kt * 64, s0 = nt * 64;
#pragma unroll
  for (int i = 0; i < 2; ++i) {
    const int kr = (tid >> 4) + 32 * i, nc = (tid & 15) * 4;
    float4 v = make_float4(0.f, 0.f, 0.f, 0.f);
    if (s0 + nc < Nsrc) v = *(const float4*)(src + (size_t)(k0 + kr) * Nsrc + s0 + nc);
    tile[kr * 65 + nc + 0] = v.x; tile[kr * 65 + nc + 1] = v.y; tile[kr * 65 + nc + 2] = v.z; tile[kr * 65 + nc + 3] = v.w;
  }
  __syncthreads();
  {
    const int n = tid >> 3, kc = (tid & 7) * 8;
    const int s = s0 + n;
    const int dr = (s < Nsrc) ? map_row(maptype, s) : -1;
    if (dr >= 0) {
      uint4 o;
      o.x = pack2(tile[(kc + 0) * 65 + n], tile[(kc + 1) * 65 + n]);
      o.y = pack2(tile[(kc + 2) * 65 + n], tile[(kc + 3) * 65 + n]);
      o.z = pack2(tile[(kc + 4) * 65 + n], tile[(kc + 5) * 65 + n]);
      o.w = pack2(tile[(kc + 6) * 65 + n], tile[(kc + 7) * 65 + n]);
      *(uint4*)(dst + (size_t)dr * dld + k0 + kc) = o;
    }
  }
  __syncthreads();
}

DI void adaln_task(const Params& p, int task, unsigned char* smem) {
  const int bhalf = task & 1, cg_ = (task >> 1) % 96, l = (task >> 1) / 96;
  float* cs = (float*)(smem + 64);
  float* red = (float*)(smem + 64 + 20 * 1024 * 4);
  const int tid = otid();
  const float* cp = p.in[2]; const float* csm = p.in[3];
  for (int idx = tid; idx < 20 * 1024; idx += NTHR) {
    const int bb = idx >> 10, d = idx & 1023, b = bhalf * 20 + bb;
    const float c = b < 32 ? cp[b * 1024 + d] : csm[(b - 32) * 1024 + d];
    cs[idx] = siluf_(c);
  }
  __syncthreads();
  const int dseg = tid >> 6, e = cg_ * 64 + (tid & 63);
  const float* wp = p.in[10] + ((size_t)l * 1024 + dseg * 128) * 6144 + e;
  float acc[20];
#pragma unroll
  for (int i = 0; i < 20; ++i) acc[i] = 0.f;
  for (int d = 0; d < 128; ++d) {
    const float wv = wp[(size_t)d * 6144];
    const float* c0 = cs + dseg * 128 + d;
#pragma unroll
    for (int i = 0; i < 20; ++i) acc[i] += c0[i * 1024] * wv;
  }
#pragma unroll
  for (int i = 0; i < 20; ++i) red[(dseg * 20 + i) * 64 + (tid & 63)] = acc[i];
  __syncthreads();
  float* mod = (float*)(p.ws + WS_MOD);
  for (int idx = tid; idx < 20 * 64; idx += NTHR) {
    const int bb = idx >> 6, ec = idx & 63;
    float s = 0.f;
#pragma unroll
    for (int q = 0; q < 8; ++q) s += red[(q * 20 + bb) * 64 + ec];
    const int ee = cg_ * 64 + ec;
    mod[((size_t)l * 40 + bhalf * 20 + bb) * 6144 + ee] = s + p.in[11][l * 6144 + ee];
  }
  __syncthreads();
}

DI void prologue(const Params& p, unsigned char* smem) {
  const int WT_TASKS_L = 912 + 512 + 128 + 128 + 256 + 1408 + 704;
  const int N_WT = 2 * WT_TASKS_L;
  const int N_ADA = 384, N_CK = 512, N_CV = 2048;
  const int total = N_WT + N_ADA + N_CK + N_CV;
  for (int task = blockIdx.x; task < total; task += gridDim.x) {
    if (task < N_WT) {
      const int l = task / WT_TASKS_L; int t = task % WT_TASKS_L;
      if (t < 912) { transpose_task(p.in[12] + (size_t)l * 1024 * 3592, 3592, (u16*)(p.ws + WS_WT_IN) + (size_t)l * 3584 * 1024, 1024, 1, t / 57, t % 57, smem); continue; }
      t -= 912;
      if (t < 512) { transpose_task(p.in[21] + (size_t)l * 1024 * 2048, 2048, (u16*)(p.ws + WS_WT_GATE) + (size_t)l * 2048 * 1024, 1024, 0, t / 32, t % 32, smem); continue; }
      t -= 512;
      if (t < 128) { transpose_task(p.in[19] + (size_t)l * 512 * 1024, 1024, (u16*)(p.ws + WS_WT_BRA) + (size_t)l * 1024 * 512, 512, 0, t / 16, t % 16, smem); continue; }
      t -= 128;
      if (t < 128) { transpose_task(p.in[20] + (size_t)l * 512 * 1024, 1024, (u16*)(p.ws + WS_WT_BRB) + (size_t)l * 1024 * 512, 512, 0, t / 16, t % 16, smem); continue; }
      t -= 128;
      if (t < 256) { transpose_task(p.in[23] + (size_t)l * 1024 * 1024, 1024, (u16*)(p.ws + WS_WT_O) + (size_t)l * 1024 * 1024, 1024, 0, t / 16, t % 16, smem); continue; }
      t -= 256;
      if (t < 1408) { transpose_task(p.in[26] + (size_t)l * 1024 * 5632, 5632, (u16*)(p.ws + WS_WT_GU) + (size_t)l * 5632 * 1024, 1024, 2, t / 88, t % 88, smem); continue; }
      t -= 1408;
      transpose_task(p.in[27] + (size_t)l * 2816 * 1024, 1024, (u16*)(p.ws + WS_WT_DOWN) + (size_t)l * 1024 * 2816, 2816, 0, t / 16, t % 16, smem);
    } else if (task < N_WT + N_ADA) {
      adaln_task(p, task - N_WT, smem);
    } else if (task < N_WT + N_ADA + N_CK) {
      const int t = task - N_WT - N_ADA;
      const float4* src = (const float4*)p.in[4];
      u16* dst = (u16*)(p.ws + WS_KS);
#pragma unroll
      for (int i = 0; i < 8; ++i) {
        const size_t f4 = (size_t)t * 4096 + i * 512 + otid();
        const float4 v = src[f4];
        const size_t e = f4 * 4;
        const size_t lb = e / (1024 * 512), rem = e % (1024 * 512);
        uint2 o; o.x = pack2(v.x, v.y); o.y = pack2(v.z, v.w);
        *(uint2*)(dst + lb * (1056 * 512) + rem) = o;
      }
    } else {
      const int t = task - N_WT - N_ADA - N_CK;
      const int lb = t >> 7, tt = t & 127;
      transpose_task(p.in[5] + (size_t)lb * 1024 * 512, 512, (u16*)(p.ws + WS_VTS) + (size_t)lb * 512 * 1056, 1056, 0, tt >> 3, tt & 7, smem);
    }
  }
}

DI float wave_sum(float v, int lane) {
#pragma unroll
  for (int off = 32; off >= 1; off >>= 1) v += shx(v, off, lane);
  return v;
}
DI void ln_pass(const Params& p, int mode, int l, unsigned char* smem) {
  const int tid = otid();
  const int lane = tid & 63, w = tid >> 6;
  const bool first = mode != 0;
  const bool second = (mode != 2) || (l + 1 < 2);
  const bool gates = (mode == 0) || (mode == 2 && l + 1 < 2);
  const int lm = (mode == 2) ? l + 1 : l;
  const int shi = (mode == 1) ? 3 : 0;
  const float* lng = (mode == 1) ? p.in[24] + l * 1024 : p.in[28] + l * 1024;
  const float* lnb = (mode == 1) ? p.in[25] + l * 1024 : p.in[29] + l * 1024;
  const float* mod = (const float*)(p.ws + WS_MOD);
  u16* H = (u16*)(p.ws + WS_H);
  float* gout = (float*)(p.ws + WS_GATES);
  float* wl = (float*)(smem + 64);
  float bif[8];
  if (gates) {
    const float* wi = p.in[12] + (size_t)lm * 1024 * 3592 + 3072;
    for (int idx = tid; idx < 8192; idx += NTHR) {
      const int c = idx >> 3, j = idx & 7;
      wl[j * 1024 + c] = wi[(size_t)c * 3592 + j];
    }
#pragma unroll
    for (int j = 0; j < 8; ++j) bif[j] = p.in[13][lm * 8 + j];
  }
  __syncthreads();
  float lg[16], lb[16];
  if (first) {
#pragma unroll
    for (int i = 0; i < 4; ++i) {
      const float4 g = *(const float4*)(lng + i * 256 + lane * 4);
      const float4 b = *(const float4*)(lnb + i * 256 + lane * 4);
      lg[i * 4] = g.x; lg[i * 4 + 1] = g.y; lg[i * 4 + 2] = g.z; lg[i * 4 + 3] = g.w;
      lb[i * 4] = b.x; lb[i * 4 + 1] = b.y; lb[i * 4 + 2] = b.z; lb[i * 4 + 3] = b.w;
    }
  }
  auto process = [&](int row, float (&v)[16], const float (&msh)[16], const float (&msc)[16]) {
    float* xr = p.out + (size_t)row * 1024;
    if (first) {
      float s = 0.f;
#pragma unroll
      for (int i = 0; i < 16; ++i) s += v[i];
      const float mean = wave_sum(s, lane) * (1.f / 1024.f);
      float q = 0.f;
#pragma unroll
      for (int i = 0; i < 16; ++i) { v[i] -= mean; q += v[i] * v[i]; }
      const float rstd = rsqrtf(wave_sum(q, lane) * (1.f / 1024.f) + LN_EPS);
#pragma unroll
      for (int i = 0; i < 4; ++i) {
#pragma unroll
        for (int e = 0; e < 4; ++e) v[i * 4 + e] = v[i * 4 + e] * rstd * lg[i * 4 + e] + lb[i * 4 + e];
        *(float4*)(xr + i * 256 + lane * 4) = make_float4(v[i * 4 + 0], v[i * 4 + 1], v[i * 4 + 2], v[i * 4 + 3]);
      }
    }
    if (second) {
      float s = 0.f;
#pragma unroll
      for (int i = 0; i < 16; ++i) s += v[i];
      const float mean = wave_sum(s, lane) * (1.f / 1024.f);
      float q = 0.f;
#pragma unroll
      for (int i = 0; i < 16; ++i) { v[i] -= mean; q += v[i] * v[i]; }
      const float rstd = rsqrtf(wave_sum(q, lane) * (1.f / 1024.f) + LN_EPS);
#pragma unroll
      for (int i = 0; i < 4; ++i) {
#pragma unroll
        for (int e = 0; e < 4; ++e) v[i * 4 + e] = v[i * 4 + e] * rstd * msc[i * 4 + e] + msh[i * 4 + e];
        uint2 o; o.x = pack2(v[i * 4 + 0], v[i * 4 + 1]); o.y = pack2(v[i * 4 + 2], v[i * 4 + 3]);
        *(uint2*)(H + (size_t)row * 1024 + i * 256 + lane * 4) = o;
      }
      if (gates) {
        float g8[8];
#pragma unroll
        for (int j = 0; j < 8; ++j) {
          float s2 = 0.f;
#pragma unroll
          for (int i = 0; i < 4; ++i) {
            const float4 wv = *(const float4*)(wl + j * 1024 + i * 256 + lane * 4);
            s2 += v[i * 4] * wv.x + v[i * 4 + 1] * wv.y + v[i * 4 + 2] * wv.z + v[i * 4 + 3] * wv.w;
          }
          g8[j] = wave_sum(s2, lane) + bif[j];
        }
        if (lane == 0) {
          *(float4*)(gout + (size_t)row * 8) = make_float4(g8[0], g8[1], g8[2], g8[3]);
          *(float4*)(gout + (size_t)row * 8 + 4) = make_float4(g8[4], g8[5], g8[6], g8[7]);
        }
      }
    }
  };
  auto load_mod = [&](int row, float (&msh)[16], float (&msc)[16]) {
    const float* mb = mod + ((size_t)lm * 40 + batch_of_row(row)) * 6144;
#pragma unroll
    for (int i = 0; i < 4; ++i) {
      const float4 sh = *(const float4*)(mb + shi * 1024 + i * 256 + lane * 4);
      const float4 sc = *(const float4*)(mb + (shi + 1) * 1024 + i * 256 + lane * 4);
      msh[i * 4] = sh.x; msh[i * 4 + 1] = sh.y; msh[i * 4 + 2] = sh.z; msh[i * 4 + 3] = sh.w;
      msc[i * 4] = 1.f + sc.x; msc[i * 4 + 1] = 1.f + sc.y; msc[i * 4 + 2] = 1.f + sc.z; msc[i * 4 + 3] = 1.f + sc.w;
    }
  };
  for (int chunk = blockIdx.x * 8 + w; chunk < TOKP / 32; chunk += gridDim.x * 8) {
    const int row0 = chunk * 32;
    float msh[16], msc[16];
    if (second) load_mod(row0, msh, msc);
    const float* src0 = (mode == 0) ? p.in[0] + (size_t)row0 * 1024 : p.out + (size_t)row0 * 1024;
    float4 nx0 = *(const float4*)(src0 + lane * 4), nx1 = *(const float4*)(src0 + 256 + lane * 4);
    float4 nx2 = *(const float4*)(src0 + 512 + lane * 4), nx3 = *(const float4*)(src0 + 768 + lane * 4);
    for (int ri = 0; ri < 32; ++ri) {
      float v[16];
      v[0] = nx0.x; v[1] = nx0.y; v[2] = nx0.z; v[3] = nx0.w; v[4] = nx1.x; v[5] = nx1.y; v[6] = nx1.z; v[7] = nx1.w;
      v[8] = nx2.x; v[9] = nx2.y; v[10] = nx2.z; v[11] = nx2.w; v[12] = nx3.x; v[13] = nx3.y; v[14] = nx3.z; v[15] = nx3.w;
      {
        const float* sn = src0 + (size_t)(ri < 31 ? ri + 1 : 31) * 1024;
        nx0 = *(const float4*)(sn + lane * 4); nx1 = *(const float4*)(sn + 256 + lane * 4);
        nx2 = *(const float4*)(sn + 512 + lane * 4); nx3 = *(const float4*)(sn + 768 + lane * 4);
      }
      __builtin_amdgcn_sched_barrier(0);
      process(row0 + ri, v, msh, msc);
    }
  }
  if (w == 0) {
    for (int row = TOKP + blockIdx.x; row < TOK; row += gridDim.x) {
      float msh[16], msc[16];
      if (second) load_mod(row, msh, msc);
      const float* src = (mode == 0) ? p.in[1] + (size_t)(row - TOKP) * 1024 : p.out + (size_t)row * 1024;
      float v[16];
#pragma unroll
      for (int i = 0; i < 4; ++i) {
        const float4 t = *(const float4*)(src + i * 256 + lane * 4);
        v[i * 4 + 0] = t.x; v[i * 4 + 1] = t.y; v[i * 4 + 2] = t.z; v[i * 4 + 3] = t.w;
      }
      process(row, v, msh, msc);
    }
  }
}


DI void micro_partial(f32x16& acc, const u16* A, int lda, const u16* Wt, int ldw, int K, int row0, int n0, int w, int r, int h) {
  const int kb = w * (K >> 3), n16 = K >> 7;
  const u16* ap = A + (size_t)(row0 + r) * lda + kb + h * 8;
  const u16* bp = Wt + (size_t)(n0 + r) * ldw + kb + h * 8;
#pragma unroll 4
  for (int k = 0; k < n16; ++k) {
    const bf16x8 a = *(const bf16x8*)(ap + k * 16);
    const bf16x8 b = *(const bf16x8*)(bp + k * 16);
    acc = MFMA(a, b, acc);
  }
}
DI void micro_reduce_store(const f32x16& acc, float* red, int w, int lane) {
#pragma unroll
  for (int i = 0; i < 16; ++i) red[(w * 16 + i) * 64 + lane] = acc[i];
}
DI float micro_sum(const float* red, int i, int lane) {
  float s = 0.f;
#pragma unroll
  for (int q = 0; q < 8; ++q) s += red[(q * 16 + i) * 64 + lane];
  return s;
}

constexpr int EP_LD = 264;
constexpr int EP_LDT = 68;
DI void zero_acc(f32x16 (&acc)[4][2]) {
#pragma unroll
  for (int a = 0; a < 4; ++a)
#pragma unroll
    for (int b = 0; b < 2; ++b) zero16(acc[a][b]);
}
DI void stage_rm(const f32x16& a0, const f32x16& a1, float* stg, int wm, int wn, int r, int h) {
#pragma unroll
  for (int i = 0; i < 16; ++i) *(float2*)(stg + (wm * 32 + crow(i, h)) * EP_LD + wn * 64 + 2 * r) = make_float2(a0[i], a1[i]);
}
DI void stage_tr(const f32x16& a0, const f32x16& a1, float* stg, int wm, int wn, int r, int h) {
#pragma unroll
  for (int g = 0; g < 4; ++g) {
    *(float4*)(stg + (wn * 64 + 2 * r) * EP_LDT + wm * 32 + 8 * g + 4 * h) = make_float4(a0[4 * g], a0[4 * g + 1], a0[4 * g + 2], a0[4 * g + 3]);
    *(float4*)(stg + (wn * 64 + 2 * r + 1) * EP_LDT + wm * 32 + 8 * g + 4 * h) = make_float4(a1[4 * g], a1[4 * g + 1], a1[4 * g + 2], a1[4 * g + 3]);
  }
}
DI int grow_of(int m0, int mi, int lr) { return m0 + (lr >> 5) * 128 + mi * 32 + (lr & 31); }
DI uint4 pack8f(const float4& a, const float4& b) {
  uint4 o; o.x = pack2(a.x, a.y); o.y = pack2(a.z, a.w); o.z = pack2(b.x, b.y); o.w = pack2(b.z, b.w); return o;
}

DI void write_tr(const Params& p, int l, int m0, int mi, const float* stg, int tid, int which, int chbase) {
  const bool prompt = m0 < TOKP;
#pragma unroll 1
  for (int q = 0; q < 4; ++q) {
    const int cid = q * NTHR + tid, ch = cid >> 3, tc = cid & 7;
    const float4 v0 = *(const float4*)(stg + ch * EP_LDT + tc * 8);
    const float4 v1 = *(const float4*)(stg + ch * EP_LDT + tc * 8 + 4);
    const int row0 = grow_of(m0, mi, tc * 8);
    const int chg = chbase + ch;
    u16* d;
    if (prompt) {
      const int b = row0 >> 11, t = row0 & 2047;
      if (which == 0) d = (u16*)(p.ws + WS_VTP) + ((size_t)b * 512 + chg) * 2048 + t;
      else if (which == 1) d = (u16*)(p.ws + WS_MQKT_P) + ((size_t)b * 1024 + chg) * 2048 + t;
      else d = (u16*)(p.ws + WS_MVT_P) + ((size_t)b * 512 + chg) * 2048 + t;
    } else {
      const int rs = row0 - TOKP, bs = rs >> 5, t = rs & 31;
      if (which == 0) d = (u16*)(p.ws + WS_VTS) + ((size_t)(l * 8 + bs) * 512 + chg) * 1056 + 1024 + t;
      else if (which == 1) d = (u16*)(p.ws + WS_MQKT_S) + ((size_t)bs * 1024 + chg) * 32 + t;
      else d = (u16*)(p.ws + WS_MVT_S) + ((size_t)bs * 512 + chg) * 32 + t;
    }
    *(uint4*)d = pack8f(v0, v1);
  }
}

DI void epi_in(const Params& p, int l, int m0, int n0, f32x16 (&acc)[4][2], unsigned char* smem) {
  const int tid = otid(), lane = tid & 63, w = tid >> 6;
  const int wm = w >> 2, wn = w & 3, r = lane & 31, h = lane >> 5;
  const bool prompt = m0 < TOKP;
  float* stg = (float*)(smem + GS_BASE + GS_STAGE);
  const int seg = n0 < 512 ? 0 : (n0 < 1024 ? 1 : (n0 < 1536 ? 2 : (n0 < 2560 ? 3 : (n0 < 3072 ? 4 : 5))));
  if (seg == 3) {
    const int ch = n0 - 1536 + wn * 64 + 2 * r;
#pragma unroll
    for (int mi = 0; mi < 4; ++mi) {
      const int rb = m0 + wm * 128 + mi * 32 + 4 * h;
#pragma unroll
      for (int i = 0; i < 16; ++i) {
        const int row = rb + (i & 3) + 8 * (i >> 2);
        if (prompt) {
          const int tt = row & 2047;
          if (tt >= 2045) *(float2*)(p.out + O_CVP + ((size_t)(l * 32 + (row >> 11)) * 3 + (tt - 2045)) * 1024 + ch) = make_float2(acc[mi][0][i], acc[mi][1][i]);
        } else {
          const int rs = row - TOKP, tt = rs & 31;
          if (tt >= 29) *(float2*)(p.out + O_CVS + ((size_t)(l * 8 + (rs >> 5)) * 3 + (tt - 29)) * 1024 + ch) = make_float2(acc[mi][0][i], acc[mi][1][i]);
        }
      }
    }
  }
#pragma unroll
  for (int mi = 0; mi < 4; ++mi) {
    if (seg == 0 || seg == 1 || seg == 2 || seg == 5) {
      __syncthreads();
      stage_rm(acc[mi][0], acc[mi][1], stg, wm, wn, r, h);
      __syncthreads();
#pragma unroll 1
      for (int q = 0; q < 4; ++q) {
        const int cid = q * NTHR + tid, lr = cid >> 5, c8 = (cid & 31) * 8;
        const float4 v0 = *(const float4*)(stg + lr * EP_LD + c8);
        const float4 v1 = *(const float4*)(stg + lr * EP_LD + c8 + 4);
        const int row = grow_of(m0, mi, lr);
        const int n = n0 + c8;
        if (seg == 0) {
          *(uint4*)((u16*)(p.ws + WS_ZQ) + (size_t)row * 512 + n) = pack8f(v0, v1);
        } else if (seg == 5) {
          const float4 s0 = make_float4(sigmoidf_(v0.x), sigmoidf_(v0.y), sigmoidf_(v0.z), sigmoidf_(v0.w));
          const float4 s1 = make_float4(sigmoidf_(v1.x), sigmoidf_(v1.y), sigmoidf_(v1.z), sigmoidf_(v1.w));
          *(uint4*)((u16*)(p.ws + WS_MO) + (size_t)row * 512 + (n - 3072)) = pack8f(s0, s1);
        } else {
          const bool isk = seg == 1;
          const int nn = n - (isk ? 512 : 1024);
          float* of = p.out + (isk ? (prompt ? O_KP : O_KSM) : (prompt ? O_VP : O_VSM));
          const size_t orow = prompt ? ((size_t)l * TOKP + row) : ((size_t)l * TOKS + (row - TOKP));
          *(float4*)(of + orow * 512 + nn) = v0;
          *(float4*)(of + orow * 512 + nn + 4) = v1;
          if (isk) {
            u16* kd;
            if (prompt) kd = (u16*)(p.ws + WS_KB) + (size_t)row * 512 + nn;
            else { const int rs = row - TOKP; kd = (u16*)(p.ws + WS_KS) + ((size_t)(l * 8 + (rs >> 5)) * 1056 + 1024 + (rs & 31)) * 512 + nn; }
            *(uint4*)kd = pack8f(v0, v1);
          }
        }
      }
    }
    if (seg == 2 || seg == 3 || seg == 4) {
      __syncthreads();
      stage_tr(acc[mi][0], acc[mi][1], stg, wm, wn, r, h);
      __syncthreads();
      write_tr(p, l, m0, mi, stg, tid, seg == 2 ? 0 : (seg == 3 ? 1 : 2), n0 - (seg == 2 ? 1024 : (seg == 3 ? 1536 : 2560)));
    }
  }
  __syncthreads();
}

DI void phase_in_gate(const Params& p, int l, unsigned char* smem) {
  const int tid = otid(), lane = tid & 63, w = tid >> 6;
  const int wm = w >> 2, wn = w & 3, r = lane & 31, h = lane >> 5;
  const u16* H = (const u16*)(p.ws + WS_H);
  const u16* Win = (const u16*)(p.ws + WS_WT_IN) + (size_t)l * 3584 * 1024;
  const u16* Wg = (const u16*)(p.ws + WS_WT_GATE) + (size_t)l * 2048 * 1024;
  float* stg = (float*)(smem + GS_BASE + GS_STAGE);
  const int NT = 14 + 8, MT = 257;
  auto ptrs = [&](int it, const u16*& ap, const u16*& bp) -> bool {
    int mt, nt;
    if (!tile_of(it, MT, NT, mt, nt)) return false;
    ap = H + (size_t)(mt * 256) * 1024;
    bp = (nt < 14 ? Win + (size_t)(nt * 256) * 1024 : Wg + (size_t)((nt - 14) * 256) * 1024);
    return true;
  };
  auto epi = [&](int it, f32x16 (&acc)[4][2]) {
    const int tid = otid(), lane = tid & 63, w = tid >> 6;
    const int wm = w >> 2, wn = w & 3, r = lane & 31, h = lane >> 5;
    int mt, nt;
    tile_of(it, MT, NT, mt, nt);
    const int m0 = mt * 256;
    if (nt < 14) {
      epi_in(p, l, m0, nt * 256, acc, smem);
    } else {
      const int n0 = (nt - 14) * 256;
      u16* G = (u16*)(p.ws + WS_G);
#pragma unroll
      for (int mi = 0; mi < 4; ++mi) {
        __syncthreads();
        stage_rm(acc[mi][0], acc[mi][1], stg, wm, wn, r, h);
        __syncthreads();
#pragma unroll 1
        for (int q = 0; q < 4; ++q) {
          const int cid = q * NTHR + tid, lr = cid >> 5, c8 = (cid & 31) * 8;
          float4 v0 = *(const float4*)(stg + lr * EP_LD + c8);
          float4 v1 = *(const float4*)(stg + lr * EP_LD + c8 + 4);
          const int row = grow_of(m0, mi, lr), n = n0 + c8;
          const float4 b0 = *(const float4*)(p.in[22] + l * 2048 + n);
          const float4 b1 = *(const float4*)(p.in[22] + l * 2048 + n + 4);
          v0 = make_float4(sigmoidf_(v0.x + b0.x), sigmoidf_(v0.y + b0.y), sigmoidf_(v0.z + b0.z), sigmoidf_(v0.w + b0.w));
          v1 = make_float4(sigmoidf_(v1.x + b1.x), sigmoidf_(v1.y + b1.y), sigmoidf_(v1.z + b1.z), sigmoidf_(v1.w + b1.w));
          *(uint4*)(G + (size_t)row * 2048 + n) = pack8f(v0, v1);
        }
      }
      __syncthreads();
    }
  };
  gemm_stream(1024, 1024, 1024, smem, ptrs, epi);
}

DI void phase_mix(const Params& p, int l, unsigned char* smem) {
  const int tid = otid(), lane = tid & 63, w = tid >> 6;
  const int wm = w >> 2, wn = w & 3, r = lane & 31, h = lane >> 5;
  const u16* G = (const u16*)(p.ws + WS_G);
  u16* MIX = (u16*)(p.ws + WS_MIX);
  float* stg = (float*)(smem + GS_BASE + GS_STAGE);
  const int NT = 4, MT = 256;
  auto ptrs = [&](int it, const u16*& ap, const u16*& bp) -> bool {
    int mt, nt;
    if (!tile_of(it >> 1, MT, NT, mt, nt)) return false;
    const int half = it & 1;
    ap = (const u16*)(p.ws + (half ? WS_MN : WS_AN)) + (size_t)(mt * 256) * 512;
    bp = (const u16*)(p.ws + (half ? WS_WT_BRB : WS_WT_BRA)) + (size_t)l * 1024 * 512 + (size_t)(nt * 256) * 512;
    return true;
  };
  auto epi = [&](int it, f32x16 (&acc)[4][2]) {
    const int tid = otid(), lane = tid & 63, w = tid >> 6;
    const int wm = w >> 2, wn = w & 3, r = lane & 31, h = lane >> 5;
    int mt, nt;
    tile_of(it >> 1, MT, NT, mt, nt);
    const int half = it & 1;
    const int m0 = mt * 256, n0 = nt * 256;
#pragma unroll
    for (int mi = 0; mi < 4; ++mi) {
      __syncthreads();
      stage_rm(acc[mi][0], acc[mi][1], stg, wm, wn, r, h);
      __syncthreads();
#pragma unroll 1
      for (int q = 0; q < 4; ++q) {
        const int cid = q * NTHR + tid, lr = cid >> 5, c8 = (cid & 31) * 8;
        const float4 v0 = *(const float4*)(stg + lr * EP_LD + c8);
        const float4 v1 = *(const float4*)(stg + lr * EP_LD + c8 + 4);
        const int row = grow_of(m0, mi, lr), n = n0 + c8;
        const uint4 g = *(const uint4*)(G + (size_t)row * 2048 + half * 1024 + n);
        float4 o0 = make_float4(bflo(g.x) * v0.x, bfhi(g.x) * v0.y, bflo(g.y) * v0.z, bfhi(g.y) * v0.w);
        float4 o1 = make_float4(bflo(g.z) * v1.x, bfhi(g.z) * v1.y, bflo(g.w) * v1.z, bfhi(g.w) * v1.w);
        uint4* mp = (uint4*)(MIX + (size_t)row * 1024 + n);
        if (half) {
          const uint4 pr = *mp;
          o0.x += bflo(pr.x); o0.y += bfhi(pr.x); o0.z += bflo(pr.y); o0.w += bfhi(pr.y);
          o1.x += bflo(pr.z); o1.y += bfhi(pr.z); o1.z += bflo(pr.w); o1.w += bfhi(pr.w);
        }
        *mp = pack8f(o0, o1);
      }
    }
    __syncthreads();
  };
  gemm_stream(512, 512, 512, smem, ptrs, epi);
  {
    const int tid2 = otid(), lane = tid2 & 63, w = tid2 >> 6, r = lane & 31, h = lane >> 5;
    float* red = (float*)(smem + 64);
    for (int mtile = blockIdx.x; mtile < 256; mtile += gridDim.x) {
      const int row0 = TOKP + (mtile >> 5) * 32, n0 = (mtile & 31) * 32;
      f32x16 pa, pb;
      zero16(pa); zero16(pb);
      micro_partial(pa, (const u16*)(p.ws + WS_AN), 512, (const u16*)(p.ws + WS_WT_BRA) + (size_t)l * 1024 * 512, 512, 512, row0, n0, w, r, h);
      micro_partial(pb, (const u16*)(p.ws + WS_MN), 512, (const u16*)(p.ws + WS_WT_BRB) + (size_t)l * 1024 * 512, 512, 512, row0, n0, w, r, h);
      __syncthreads();
      micro_reduce_store(pa, red, w, lane);
      micro_reduce_store(pb, red + 8192, w, lane);
      __syncthreads();
#pragma unroll
      for (int q = 0; q < 2; ++q) {
        const int i = w + 8 * q;
        const float sa = micro_sum(red, i, lane), sb = micro_sum(red + 8192, i, lane);
        const int row = row0 + crow(i, h), n = n0 + r;
        const float ga = bf2f(G[(size_t)row * 2048 + n]), gb = bf2f(G[(size_t)row * 2048 + 1024 + n]);
        MIX[(size_t)row * 1024 + n] = f2bf(ga * sa + gb * sb);
      }
    }
    __syncthreads();
  }
}

DI void phase_res(const Params& p, int l, int mode, unsigned char* smem) {
  const int tid = otid(), lane = tid & 63, w = tid >> 6;
  const int wm = w >> 2, wn = w & 3, r = lane & 31, h = lane >> 5;
  const float* mod = (const float*)(p.ws + WS_MOD);
  float* stg = (float*)(smem + GS_BASE + GS_STAGE);
  const int NT = 4, MT = 256;
  const int K = (mode == 0) ? 1024 : 2816;
  const u16* Ab = (const u16*)(p.ws + (mode == 0 ? WS_MIX : WS_ACT));
  const u16* Wb = (mode == 0) ? (const u16*)(p.ws + WS_WT_O) + (size_t)l * 1024 * 1024 : (const u16*)(p.ws + WS_WT_DOWN) + (size_t)l * 1024 * 2816;
  const int gi = (mode == 0) ? 2 : 5;
  auto ptrs = [&](int it, const u16*& ap, const u16*& bp) -> bool {
    int mt, nt;
    if (!tile_of(it, MT, NT, mt, nt)) return false;
    ap = Ab + (size_t)(mt * 256) * K;
    bp = Wb + (size_t)(nt * 256) * K;
    return true;
  };
  auto epi = [&](int it, f32x16 (&acc)[4][2]) {
    const int tid = otid(), lane = tid & 63, w = tid >> 6;
    const int wm = w >> 2, wn = w & 3, r = lane & 31, h = lane >> 5;
    int mt, nt;
    tile_of(it, MT, NT, mt, nt);
    const int m0 = mt * 256, n0 = nt * 256;
#pragma unroll
    for (int mi = 0; mi < 4; ++mi) {
      __syncthreads();
      stage_rm(acc[mi][0], acc[mi][1], stg, wm, wn, r, h);
      __syncthreads();
#pragma unroll 1
      for (int q = 0; q < 8; ++q) {
        const int cid = q * NTHR + tid, lr = cid >> 6, c4 = (cid & 63) * 4;
        const float4 v = *(const float4*)(stg + lr * EP_LD + c4);
        const int row = grow_of(m0, mi, lr), n = n0 + c4;
        const int b = batch_of_row(row);
        const float4 gg = *(const float4*)(mod + ((size_t)l * 40 + b) * 6144 + gi * 1024 + n);
        float* xr = p.out + (size_t)row * 1024 + n;
        const float* xs = (mode == 0 && l == 0) ? (row < TOKP ? p.in[0] + (size_t)row * 1024 + n : p.in[1] + (size_t)(row - TOKP) * 1024 + n) : xr;
        const float4 xv = *(const float4*)xs;
        *(float4*)xr = make_float4(ALPHA * xv.x + (1.f + gg.x) * v.x, ALPHA * xv.y + (1.f + gg.y) * v.y,
                                   ALPHA * xv.z + (1.f + gg.z) * v.z, ALPHA * xv.w + (1.f + gg.w) * v.w);
      }
    }
    __syncthreads();
  };
  gemm_stream(K, K, K, smem, ptrs, epi);
  {
    const int tid2 = otid(), lane = tid2 & 63, w = tid2 >> 6, r = lane & 31, h = lane >> 5;
    float* red = (float*)(smem + 64);
    for (int mtile = blockIdx.x; mtile < 256; mtile += gridDim.x) {
      const int row0 = TOKP + (mtile >> 5) * 32, n0 = (mtile & 31) * 32;
      f32x16 pa;
      zero16(pa);
      micro_partial(pa, Ab, K, Wb, K, K, row0, n0, w, r, h);
      __syncthreads();
      micro_reduce_store(pa, red, w, lane);
      __syncthreads();
#pragma unroll
      for (int q = 0; q < 2; ++q) {
        const int i = w + 8 * q;
        const float sa = micro_sum(red, i, lane);
        const int row = row0 + crow(i, h), n = n0 + r;
        const float gg = mod[((size_t)l * 40 + batch_of_row(row)) * 6144 + gi * 1024 + n];
        float* xr = p.out + (size_t)row * 1024 + n;
        const float xv = (mode == 0 && l == 0) ? p.in[1][(size_t)(row - TOKP) * 1024 + n] : *xr;
        *xr = ALPHA * xv + (1.f + gg) * sa;
      }
    }
    __syncthreads();
  }
}

DI void phase_gu(const Params& p, int l, unsigned char* smem) {
  const int tid = otid(), lane = tid & 63, w = tid >> 6;
  const int wm = w >> 2, wn = w & 3, r = lane & 31, h = lane >> 5;
  u16* ACT = (u16*)(p.ws + WS_ACT);
  const u16* Hh = (const u16*)(p.ws + WS_H);
  const u16* Wb = (const u16*)(p.ws + WS_WT_GU) + (size_t)l * 5632 * 1024;
  float* stg = (float*)(smem + GS_BASE + GS_STAGE);
  const int NT = 22, MT = 257;
  auto ptrs = [&](int it, const u16*& ap, const u16*& bp) -> bool {
    int mt, nt;
    if (!tile_of(it, MT, NT, mt, nt)) return false;
    ap = Hh + (size_t)(mt * 256) * 1024;
    bp = Wb + (size_t)(nt * 256) * 1024;
    return true;
  };
  auto epi = [&](int it, f32x16 (&acc)[4][2]) {
    const int tid = otid(), lane = tid & 63, w = tid >> 6;
    const int wm = w >> 2, wn = w & 3, r = lane & 31, h = lane >> 5;
    int mt, nt;
    tile_of(it, MT, NT, mt, nt);
    const int m0 = mt * 256, n0 = nt * 256;
#pragma unroll
    for (int mi = 0; mi < 4; ++mi) {
      __syncthreads();
      stage_rm(acc[mi][0], acc[mi][1], stg, wm, wn, r, h);
      __syncthreads();
#pragma unroll 1
      for (int q = 0; q < 2; ++q) {
        const int cid = q * NTHR + tid, lr = cid >> 4, c16 = (cid & 15) * 16;
        const float4 v0 = *(const float4*)(stg + lr * EP_LD + c16);
        const float4 v1 = *(const float4*)(stg + lr * EP_LD + c16 + 4);
        const float4 v2 = *(const float4*)(stg + lr * EP_LD + c16 + 8);
        const float4 v3 = *(const float4*)(stg + lr * EP_LD + c16 + 12);
        const int row = grow_of(m0, mi, lr);
        uint4 o;
        o.x = pack2(siluf_(v0.x) * v0.y, siluf_(v0.z) * v0.w);
        o.y = pack2(siluf_(v1.x) * v1.y, siluf_(v1.z) * v1.w);
        o.z = pack2(siluf_(v2.x) * v2.y, siluf_(v2.z) * v2.w);
        o.w = pack2(siluf_(v3.x) * v3.y, siluf_(v3.z) * v3.w);
        *(uint4*)(ACT + (size_t)row * 2816 + (n0 >> 1) + (c16 >> 1)) = o;
      }
    }
    __syncthreads();
  };
  gemm_stream(1024, 1024, 1024, smem, ptrs, epi);
}

constexpr int AT_BASE = 64;
constexpr int AT_KBYTES = 64 * 272;
constexpr int AT_VBYTES = 128 * 136;
constexpr int AT_STAGE = AT_KBYTES + AT_VBYTES;

DI void attn_item(const Params& p, int l, int b, int head, int qt, float lam, float lam_init, unsigned char* smem) {
  const int tid = otid(), lane = tid & 63, w = tid >> 6, r = lane & 31, h = lane >> 5;
  const int comp = w & 1, rg = w >> 1;
  const bool prompt = b < 32;
  const int bs = b - 32;
  const u16* Kg = prompt ? (const u16*)(p.ws + WS_KB) + (size_t)b * 2048 * 512 : (const u16*)(p.ws + WS_KS) + (size_t)(l * 8 + bs) * 1056 * 512;
  const u16* Vg = prompt ? (const u16*)(p.ws + WS_VTP) + (size_t)b * 512 * 2048 : (const u16*)(p.ws + WS_VTS) + (size_t)(l * 8 + bs) * 512 * 1056;
  const int ldT = prompt ? 2048 : 1056;
  const int nkt = prompt ? 2 * qt + 2 : 17;
  const int nkeys = prompt ? 2048 : 1056;
  const int qtok0 = prompt ? b * 2048 + qt * 128 : TOKP + bs * 32;
  const int qpos0 = prompt ? qt * 128 : 1024;
  const bool active = prompt || rg == 0;
  const int my_nkt = prompt ? (rg < 2 ? nkt - 1 : nkt) : nkt;
  const u16* ZQ = (const u16*)(p.ws + WS_ZQ);
  bf16x8 qf[4];
  {
    const int qrow = active ? qtok0 + rg * 32 + r : qtok0;
#pragma unroll
    for (int ks = 0; ks < 4; ++ks) {
      const uint4 qq = *(const uint4*)(ZQ + (size_t)qrow * 512 + head * 128 + comp * 64 + ks * 16 + h * 8);
      const float cq = 0.125f * LOG2E;
      uint4 qs_;
      qs_.x = pack2(bflo(qq.x) * cq, bfhi(qq.x) * cq); qs_.y = pack2(bflo(qq.y) * cq, bfhi(qq.y) * cq);
      qs_.z = pack2(bflo(qq.z) * cq, bfhi(qq.z) * cq); qs_.w = pack2(bflo(qq.w) * cq, bfhi(qq.w) * cq);
      qf[ks] = __builtin_bit_cast(bf16x8, qs_);
    }
  }
  const float slope2 = exp2f(-2.f * (head + 1)) * LOG2E;
  const float c1 = 0.125f * LOG2E;
  const int qpos = qpos0 + rg * 32 + r;
  f32x16 O[4];
#pragma unroll
  for (int i = 0; i < 4; ++i) zero16(O[i]);
  float m_run = -INFINITY, l_run = 0.f;

  const int krow = tid >> 4, kcc = tid & 15;
  const int vrow = tid >> 3, vcc = tid & 7;
  const u16* kp = Kg + (size_t)((nkt - 1) * 64 + krow) * 512 + head * 128 + kcc * 8;
  const u16* vp = Vg + (size_t)(head * 128 + vrow) * ldT + (nkt - 1) * 64 + vcc * 8;
  uint4 rk0, rk1, rv0, rv1;
  unsigned char* sb = smem + AT_BASE;
  rk0 = *(const uint4*)kp; rk1 = *(const uint4*)(kp + 32 * 512);
  rv0 = *(const uint4*)vp; rv1 = *(const uint4*)(vp + (size_t)64 * ldT);
  {
    *(uint4*)(sb + krow * 272 + kcc * 16) = rk0;
    *(uint4*)(sb + (krow + 32) * 272 + kcc * 16) = rk1;
    *(uint2*)(sb + AT_KBYTES + vrow * 136 + vcc * 16) = make_uint2(rv0.x, rv0.y);
    *(uint2*)(sb + AT_KBYTES + vrow * 136 + vcc * 16 + 8) = make_uint2(rv0.z, rv0.w);
    *(uint2*)(sb + AT_KBYTES + (vrow + 64) * 136 + vcc * 16) = make_uint2(rv1.x, rv1.y);
    *(uint2*)(sb + AT_KBYTES + (vrow + 64) * 136 + vcc * 16 + 8) = make_uint2(rv1.z, rv1.w);
  }
  __syncthreads();
  for (int j = 0; j < nkt; ++j) {
    const int kt = nkt - 1 - j;
    const bool more = j + 1 < nkt;
    if (more) {
      kp -= 64 * 512; vp -= 64;
      rk0 = *(const uint4*)kp; rk1 = *(const uint4*)(kp + 32 * 512);
      rv0 = *(const uint4*)vp; rv1 = *(const uint4*)(vp + (size_t)64 * ldT);
    }
    if (active && kt < my_nkt) {
      const unsigned char* Kt = sb + (j & 1) * AT_STAGE;
      const unsigned char* Vt = Kt + AT_KBYTES;
      f32x16 s[2];
      const bool past = (kt * 64 + 63) < (qpos0 + rg * 32);
      if (past) {
        const float kb0 = slope2 * (float)(kt * 64 + 4 * h);
#pragma unroll
        for (int sub = 0; sub < 2; ++sub)
#pragma unroll
          for (int i = 0; i < 16; ++i) s[sub][i] = __builtin_fmaf(slope2, (float)(sub * 32 + (i & 3) + 8 * (i >> 2)), kb0);
      } else {
        zero16(s[0]); zero16(s[1]);
      }
#pragma unroll
      for (int ks = 0; ks < 4; ++ks) {
#pragma unroll
        for (int sub = 0; sub < 2; ++sub) {
          const bf16x8 kf = *(const bf16x8*)(Kt + (sub * 32 + r) * 272 + (comp * 64 + ks * 16 + h * 8) * 2);
          s[sub] = MFMA(kf, qf[ks], s[sub]);
        }
      }
      float mx = -INFINITY;
      if (!past) {
        const float qk0 = (float)(qpos - kt * 64 - 4 * h);
        const float qb = slope2 * (float)qpos;
#pragma unroll
        for (int sub = 0; sub < 2; ++sub)
#pragma unroll
          for (int i = 0; i < 16; ++i) {
            const float d = qk0 - (float)(sub * 32 + (i & 3) + 8 * (i >> 2));
            s[sub][i] = s[sub][i] - slope2 * fabsf(d) + qb;
          }
      }
      if (!prompt) {
#pragma unroll
        for (int sub = 0; sub < 2; ++sub)
#pragma unroll
          for (int i = 0; i < 16; ++i) {
            const int key = kt * 64 + sub * 32 + crow(i, h);
            if (key >= nkeys) s[sub][i] = -INFINITY;
          }
      }
#pragma unroll
      for (int sub = 0; sub < 2; ++sub)
#pragma unroll
        for (int i = 0; i < 16; ++i) mx = fmaxf(mx, s[sub][i]);
      mx = fmaxf(mx, shx(mx, 32, lane));
      const bool livelane = !(mx - m_run < -150.f);
      if (__ballot(livelane) != 0ull) {
        const float m_new = fmaxf(m_run, mx);
        const float alpha = fexp2(m_run - m_new);
        m_run = m_new;
        float lsum = 0.f;
#pragma unroll
        for (int sub = 0; sub < 2; ++sub)
#pragma unroll
          for (int i = 0; i < 16; ++i) {
            const float pv = fexp2(s[sub][i] - m_new);
            lsum += pv;
            s[sub][i] = pv;
          }
        l_run = l_run * alpha + lsum;
        if (__ballot(alpha != 1.f) != 0ull) {
#pragma unroll
          for (int dt = 0; dt < 4; ++dt)
#pragma unroll
            for (int i = 0; i < 16; ++i) O[dt][i] *= alpha;
        }
#pragma unroll
        for (int sub = 0; sub < 2; ++sub)
#pragma unroll
          for (int s2 = 0; s2 < 2; ++s2) {
            const bf16x8 pf = pack8(s[sub], s2);
#pragma unroll
            for (int dt = 0; dt < 4; ++dt) {
              const unsigned char* va = Vt + (dt * 32 + r) * 136 + (sub * 32 + s2 * 16 + 4 * h) * 2;
              const uint2 lo = *(const uint2*)va;
              const uint2 hi = *(const uint2*)(va + 16);
              const uint4 vv = make_uint4(lo.x, lo.y, hi.x, hi.y);
              O[dt] = MFMA(__builtin_bit_cast(bf16x8, vv), pf, O[dt]);
            }
          }
      }
    }
    if (more) {
      unsigned char* sn = sb + ((j + 1) & 1) * AT_STAGE;
      *(uint4*)(sn + krow * 272 + kcc * 16) = rk0;
      *(uint4*)(sn + (krow + 32) * 272 + kcc * 16) = rk1;
      *(uint2*)(sn + AT_KBYTES + vrow * 136 + vcc * 16) = make_uint2(rv0.x, rv0.y);
      *(uint2*)(sn + AT_KBYTES + vrow * 136 + vcc * 16 + 8) = make_uint2(rv0.z, rv0.w);
      *(uint2*)(sn + AT_KBYTES + (vrow + 64) * 136 + vcc * 16) = make_uint2(rv1.x, rv1.y);
      *(uint2*)(sn + AT_KBYTES + (vrow + 64) * 136 + vcc * 16 + 8) = make_uint2(rv1.z, rv1.w);
    }
    __syncthreads();
  }
  float* exch = (float*)(smem + AT_BASE);
  float inv = 0.f;
  if (active) { const float lt = l_run + shx(l_run, 32, lane); inv = 1.f / lt; }
  if (active && comp == 1) {
    const float sc = inv * lam;
#pragma unroll
    for (int dt = 0; dt < 4; ++dt)
#pragma unroll
      for (int i = 0; i < 16; ++i) exch[(rg * 64 + dt * 16 + i) * 64 + lane] = O[dt][i] * sc;
  }
  __syncthreads();
  if (active && comp == 0) {
    float ss = 0.f;
#pragma unroll
    for (int dt = 0; dt < 4; ++dt)
#pragma unroll
      for (int i = 0; i < 16; ++i) {
        const float o = O[dt][i] * inv - exch[(rg * 64 + dt * 16 + i) * 64 + lane];
        O[dt][i] = o;
        ss += o * o;
      }
    ss += shx(ss, 32, lane);
    const float rs = rsqrtf(ss * (1.f / 128.f) + LN_EPS) * (1.f - lam_init);
    u16* AN = (u16*)(p.ws + WS_AN) + (size_t)(qtok0 + rg * 32 + r) * 512 + head * 128;
    const float* gw = p.in[17] + l * 512 + head * 128;
#pragma unroll
    for (int dt = 0; dt < 4; ++dt)
#pragma unroll
      for (int g = 0; g < 4; ++g) {
        const int dv = dt * 32 + 8 * g + 4 * h;
        const float4 g4 = *(const float4*)(gw + dv);
        uint2 o;
        o.x = pack2(O[dt][4 * g] * rs * g4.x, O[dt][4 * g + 1] * rs * g4.y);
        o.y = pack2(O[dt][4 * g + 2] * rs * g4.z, O[dt][4 * g + 3] * rs * g4.w);
        *(uint2*)(AN + dv) = o;
      }
  }
}

constexpr int ML_QS = 64;
constexpr int ML_KS = ML_QS + 64 * 272;
constexpr int ML_KT = ML_KS + 64 * 272;
constexpr int ML_VT = ML_KT + 128 * 144;
constexpr int ML_CB = ML_VT + 128 * 144;
constexpr int ML_HB = ML_CB + 128 * 272;
constexpr int ML_SM = ML_HB + 64 * 132 * 4;
static_assert(ML_SM + 528 * 4 <= LDS_BYTES, "lds");

DI void mlstm_item(const Params& p, int l, int b, int head, unsigned char* smem) {
  const int tid = otid(), lane = tid & 63, w = tid >> 6, r = lane & 31, h = lane >> 5;
  const bool prompt = b < 32;
  const int bs = b - 32;
  const int T = prompt ? 2048 : 32;
  const int nch = prompt ? 32 : 1;
  const int L = prompt ? 64 : 32;
  const int tokbase = prompt ? b * 2048 : TOKP + bs * 32;
  const u16* qkT = prompt ? (const u16*)(p.ws + WS_MQKT_P) + (size_t)b * 1024 * 2048 : (const u16*)(p.ws + WS_MQKT_S) + (size_t)bs * 1024 * 32;
  const u16* vTg = prompt ? (const u16*)(p.ws + WS_MVT_P) + (size_t)b * 512 * 2048 : (const u16*)(p.ws + WS_MVT_S) + (size_t)bs * 512 * 32;
  u16* qs = (u16*)(smem + ML_QS);
  u16* ksm = (u16*)(smem + ML_KS);
  u16* kTw = (u16*)(smem + ML_KT);
  u16* vT = (u16*)(smem + ML_VT);
  u16* Cbf = (u16*)(smem + ML_CB);
  float* hbuf = (float*)(smem + ML_HB);
  float* a_s = (float*)(smem + ML_SM);
  float* mx_s = a_s + 64;
  float* ws_s = a_s + 128;
  float* wi_s = a_s + 192;
  float* emt_s = a_s + 256;
  float* nq_s = a_s + 320;
  float* nvec = a_s + 384;
  float* scal = a_s + 512;

  const int vt = w & 3, kt0 = (w >> 2) * 2;
  f32x16 accC[2];
  float m_run = 0.f;
  if (prompt) {
    zero16(accC[0]); zero16(accC[1]);
    if (tid < 128) nvec[tid] = 0.f;
  } else {
    const float* Cs = p.in[6] + ((size_t)(l * 8 + bs) * 4 + head) * 128 * 128;
#pragma unroll
    for (int q = 0; q < 2; ++q)
#pragma unroll
      for (int g = 0; g < 4; ++g) {
        const float4 c4 = *(const float4*)(Cs + (size_t)(vt * 32 + r) * 128 + (kt0 + q) * 32 + 8 * g + 4 * h);
        accC[q][4 * g] = c4.x; accC[q][4 * g + 1] = c4.y; accC[q][4 * g + 2] = c4.z; accC[q][4 * g + 3] = c4.w;
      }
    if (tid < 128) nvec[tid] = p.in[7][((size_t)(l * 8 + bs) * 4 + head) * 128 + tid];
    m_run = p.in[8][(l * 8 + bs) * 4 + head];
  }
#pragma unroll
  for (int q = 0; q < 2; ++q)
#pragma unroll
    for (int g = 0; g < 4; ++g) {
      uint2 o; o.x = pack2(accC[q][4 * g], accC[q][4 * g + 1]); o.y = pack2(accC[q][4 * g + 2], accC[q][4 * g + 3]);
      *(uint2*)(Cbf + (vt * 32 + r) * 136 + (kt0 + q) * 32 + 8 * g + 4 * h) = o;
    }
  const float* gatesp = (const float*)(p.ws + WS_GATES);
  const int vi = w >> 1, ti = w & 1;

  float ig_n = -INFINITY, fg_n = 0.f;
  if (w == 0 && lane < L) {
    const float* gp = gatesp + (size_t)(tokbase + lane) * 8;
    ig_n = gp[head]; fg_n = gp[4 + head];
  }
  for (int c = 0; c < nch; ++c) {
    const int t0 = c * 64;
    if (w == 0) {
      const int t = lane;
      float ig = -INFINITY, lf = 0.f;
      if (t < L) {
        ig = ig_n;
        const float fg = fg_n;
        lf = fminf(fg, 0.f) - log1pf(__expf(-fabsf(fg)));
        if (c + 1 < nch) {
          const float* gp = gatesp + (size_t)(tokbase + t0 + 64 + t) * 8;
          ig_n = gp[head]; fg_n = gp[4 + head];
        }
      }
      float bc = lf;
#pragma unroll
      for (int off = 1; off < 64; off <<= 1) { const float v = shidx(bc, lane - off, lane); if (lane >= off) bc += v; }
      const float a = ig - bc;
      float M = a;
#pragma unroll
      for (int off = 1; off < 64; off <<= 1) { const float v = shidx(M, lane - off, lane); if (lane >= off) M = fmaxf(M, v); }
      const float mx = fmaxf(m_run, M);
      const float bL = shidx(bc, 63, lane);
      const float mxL = shidx(mx, 63, lane);
      a_s[t] = a; mx_s[t] = mx;
      ws_s[t] = __expf(a - mxL);
      wi_s[t] = __expf(m_run - mx);
      emt_s[t] = __expf(-(bc + mx));
      if (lane == 0) scal[1] = __expf(m_run - mxL);
      m_run = bL + mxL;
    }
    const int ch2 = tid >> 1, th = tid & 1;
    const bool isk = ch2 >= 128;
    const int dd = ch2 & 127;
    const int ch = (isk ? 512 : 0) + head * 128 + dd;
    const u16* rp = qkT + (size_t)ch * T + t0 + th * 32;
    float um3 = 0.f, um2 = 0.f, um1 = 0.f;
    const bool ldrow = prompt || th == 0;
    uint4 uu0 = make_uint4(0, 0, 0, 0), uu1 = uu0, uu2 = uu0, uu3 = uu0, vv0 = uu0, vv1 = uu0;
    if (ldrow) { uu0 = *(const uint4*)(rp); uu1 = *(const uint4*)(rp + 8); uu2 = *(const uint4*)(rp + 16); uu3 = *(const uint4*)(rp + 24); }
    {
      const int row = tid >> 3, cc = tid & 7;
      if (prompt || cc < 4) {
        vv0 = *(const uint4*)(vTg + (size_t)(head * 128 + row) * T + t0 + cc * 8);
        vv1 = *(const uint4*)(vTg + (size_t)(head * 128 + row + 64) * T + t0 + cc * 8);
      }
    }
    if (prompt) {
      if (th == 1 || c > 0) {
        const uint2 pv = *(const uint2*)(rp - 4);
        um3 = bfhi(pv.x); um2 = bflo(pv.y); um1 = bfhi(pv.y);
      }
    } else if (th == 0) {
      const float* cvp = p.in[9] + (size_t)(l * 8 + bs) * 3 * 1024 + ch;
      um3 = cvp[0]; um2 = cvp[1024]; um1 = cvp[2048];
    }
    const float cw0 = p.in[14][(l * 4 + 0) * 1024 + ch], cw1 = p.in[14][(l * 4 + 1) * 1024 + ch];
    const float cw2 = p.in[14][(l * 4 + 2) * 1024 + ch], cw3 = p.in[14][(l * 4 + 3) * 1024 + ch];
    const float cb = p.in[15][l * 1024 + ch];
    __syncthreads();
    {
      u16* dstrm = (isk ? ksm : qs) + (th * 32) * 136 + dd;
      const float oscale = isk ? 0.08838834764831845f : 1.f;
#pragma unroll
      for (int i = 0; i < 4; ++i) {
        const uint4 uu = (i == 0) ? uu0 : (i == 1 ? uu1 : (i == 2 ? uu2 : uu3));
        float u[8];
        u[0] = bflo(uu.x); u[1] = bfhi(uu.x); u[2] = bflo(uu.y); u[3] = bfhi(uu.y);
        u[4] = bflo(uu.z); u[5] = bfhi(uu.z); u[6] = bflo(uu.w); u[7] = bfhi(uu.w);
        float y[8];
#pragma unroll
        for (int e = 0; e < 8; ++e) {
          const float x3 = (e >= 3) ? u[e - 3] : (e == 0 ? um3 : (e == 1 ? um2 : um1));
          const float x2 = (e >= 2) ? u[e - 2] : (e == 0 ? um2 : um1);
          const float x1 = (e >= 1) ? u[e - 1] : um1;
          const float yy = cb + cw0 * x3 + cw1 * x2 + cw2 * x1 + cw3 * u[e];
          y[e] = siluf_(yy) * oscale;
        }
        um3 = u[5]; um2 = u[6]; um1 = u[7];
#pragma unroll
        for (int e = 0; e < 8; ++e) dstrm[(i * 8 + e) * 136] = f2bf(y[e]);
        if (isk) {
          const float4 w0 = *(const float4*)(ws_s + th * 32 + i * 8);
          const float4 w1 = *(const float4*)(ws_s + th * 32 + i * 8 + 4);
          uint4 o;
          o.x = pack2(y[0] * w0.x, y[1] * w0.y); o.y = pack2(y[2] * w0.z, y[3] * w0.w);
          o.z = pack2(y[4] * w1.x, y[5] * w1.y); o.w = pack2(y[6] * w1.z, y[7] * w1.w);
          *(uint4*)(kTw + dd * 72 + th * 32 + i * 8) = o;
        }
      }
      {
        const int row = tid >> 3, cc = tid & 7;
        *(uint4*)(vT + row * 72 + cc * 8) = vv0;
        *(uint4*)(vT + (row + 64) * 72 + cc * 8) = vv1;
      }
    }
    __syncthreads();
    {
      const int t = tid >> 3, part = tid & 7;
      const uint4 q0 = *(const uint4*)(qs + t * 136 + part * 16);
      const uint4 q1 = *(const uint4*)(qs + t * 136 + part * 16 + 8);
      const float* nv = nvec + part * 16;
      float s = bflo(q0.x) * nv[0] + bfhi(q0.x) * nv[1] + bflo(q0.y) * nv[2] + bfhi(q0.y) * nv[3]
              + bflo(q0.z) * nv[4] + bfhi(q0.z) * nv[5] + bflo(q0.w) * nv[6] + bfhi(q0.w) * nv[7]
              + bflo(q1.x) * nv[8] + bfhi(q1.x) * nv[9] + bflo(q1.y) * nv[10] + bfhi(q1.y) * nv[11]
              + bflo(q1.z) * nv[12] + bfhi(q1.z) * nv[13] + bflo(q1.w) * nv[14] + bfhi(q1.w) * nv[15];
      s += shx(s, 1, lane); s += shx(s, 2, lane); s += shx(s, 4, lane);
      if (part == 0) nq_s[t] = s;
    }
    f32x16 accS[2], accO;
    zero16(accS[0]); zero16(accS[1]); zero16(accO);
    {
#pragma unroll
      for (int ks = 0; ks < 8; ++ks) {
        const bf16x8 qfr = *(const bf16x8*)(qs + (ti * 32 + r) * 136 + ks * 16 + h * 8);
        const bf16x8 k0 = *(const bf16x8*)(ksm + r * 136 + ks * 16 + h * 8);
        accS[0] = MFMA(k0, qfr, accS[0]);
        if (ti == 1) {
          const bf16x8 k1 = *(const bf16x8*)(ksm + (32 + r) * 136 + ks * 16 + h * 8);
          accS[1] = MFMA(k1, qfr, accS[1]);
        }
        const bf16x8 cf = *(const bf16x8*)(Cbf + (vi * 32 + r) * 136 + ks * 16 + h * 8);
        accO = MFMA(cf, qfr, accO);
      }
    }
    const int tcol = ti * 32 + r;
    const float mxt = mx_s[tcol];
    const float wit = wi_s[tcol];
    float dsum = 0.f;
#pragma unroll
    for (int sub = 0; sub < 2; ++sub) {
      if (sub <= ti) {
#pragma unroll
        for (int g = 0; g < 4; ++g) {
          const float4 a4 = *(const float4*)(a_s + sub * 32 + 8 * g + 4 * h);
          const float av[4] = {a4.x, a4.y, a4.z, a4.w};
#pragma unroll
          for (int e = 0; e < 4; ++e) {
            const int s = sub * 32 + 8 * g + 4 * h + e;
            const float wgt = (s <= tcol) ? __expf(av[e] - mxt) : 0.f;
            const float pv = accS[sub][4 * g + e] * wgt;
            accS[sub][4 * g + e] = pv;
            dsum += pv;
          }
        }
      }
    }
    dsum += shx(dsum, 32, lane);
#pragma unroll
    for (int i = 0; i < 16; ++i) accO[i] *= wit;
#pragma unroll
    for (int sub = 0; sub < 2; ++sub) {
      if (sub <= ti) {
#pragma unroll
        for (int s2 = 0; s2 < 2; ++s2) {
          const bf16x8 pf = pack8(accS[sub], s2);
          const u16* va = vT + (vi * 32 + r) * 72 + sub * 32 + s2 * 16 + 4 * h;
          const uint2 lo = *(const uint2*)va;
          const uint2 hi = *(const uint2*)(va + 8);
          const uint4 vq = make_uint4(lo.x, lo.y, hi.x, hi.y);
          accO = MFMA(__builtin_bit_cast(bf16x8, vq), pf, accO);
        }
      }
    }
    __syncthreads();
    {
      const float den = dsum + wit * nq_s[tcol];
      const float dn = fmaxf(fabsf(den), emt_s[tcol]);
      const float rinv = 1.f / dn;
#pragma unroll
      for (int g = 0; g < 4; ++g)
        *(float4*)(hbuf + tcol * 132 + vi * 32 + 8 * g + 4 * h) =
            make_float4(accO[4 * g] * rinv, accO[4 * g + 1] * rinv, accO[4 * g + 2] * rinv, accO[4 * g + 3] * rinv);
    }
    {
      const float wc = scal[1];
#pragma unroll
      for (int q = 0; q < 2; ++q)
#pragma unroll
        for (int i = 0; i < 16; ++i) accC[q][i] *= wc;
#pragma unroll
      for (int k4 = 0; k4 < 4; ++k4) {
        const bf16x8 vf = *(const bf16x8*)(vT + (vt * 32 + r) * 72 + k4 * 16 + h * 8);
#pragma unroll
        for (int q = 0; q < 2; ++q) {
          const bf16x8 kf = *(const bf16x8*)(kTw + ((kt0 + q) * 32 + r) * 72 + k4 * 16 + h * 8);
          accC[q] = MFMA(kf, vf, accC[q]);
        }
      }
#pragma unroll
      for (int q = 0; q < 2; ++q)
#pragma unroll
        for (int g = 0; g < 4; ++g) {
          uint2 o; o.x = pack2(accC[q][4 * g], accC[q][4 * g + 1]); o.y = pack2(accC[q][4 * g + 2], accC[q][4 * g + 3]);
          *(uint2*)(Cbf + (vt * 32 + r) * 136 + (kt0 + q) * 32 + 8 * g + 4 * h) = o;
        }
      if (tid < 128) {
        float s = 0.f;
#pragma unroll
        for (int i = 0; i < 8; ++i) {
          const uint4 kk = *(const uint4*)(kTw + tid * 72 + i * 8);
          s += bflo(kk.x) + bfhi(kk.x) + bflo(kk.y) + bfhi(kk.y) + bflo(kk.z) + bfhi(kk.z) + bflo(kk.w) + bfhi(kk.w);
        }
        nvec[tid] = wc * nvec[tid] + s;
      }
    }
    __syncthreads();
    {
      const int t = tid >> 3, part = tid & 7;
      float x[16];
#pragma unroll
      for (int i = 0; i < 4; ++i) {
        const float4 f = *(const float4*)(hbuf + t * 132 + part * 16 + i * 4);
        x[i * 4] = f.x; x[i * 4 + 1] = f.y; x[i * 4 + 2] = f.z; x[i * 4 + 3] = f.w;
      }
      float s = 0.f;
#pragma unroll
      for (int i = 0; i < 16; ++i) s += x[i];
      s += shx(s, 1, lane); s += shx(s, 2, lane); s += shx(s, 4, lane);
      const float mean = s * (1.f / 128.f);
      float q = 0.f;
#pragma unroll
      for (int i = 0; i < 16; ++i) { x[i] -= mean; q += x[i] * x[i]; }
      q += shx(q, 1, lane); q += shx(q, 2, lane); q += shx(q, 4, lane);
      const float rstd = rsqrtf(q * (1.f / 128.f) + LN_EPS);
      if (t < L) {
        const size_t tok = (size_t)tokbase + t0 + t;
        const int cbase = head * 128 + part * 16;
        const float* gw = p.in[18] + l * 512 + cbase;
        const u16* mo = (const u16*)(p.ws + WS_MO) + tok * 512 + cbase;
        const uint4 m0 = *(const uint4*)mo;
        const uint4 m1 = *(const uint4*)(mo + 8);
        const float sg[16] = {bflo(m0.x), bfhi(m0.x), bflo(m0.y), bfhi(m0.y), bflo(m0.z), bfhi(m0.z), bflo(m0.w), bfhi(m0.w),
                              bflo(m1.x), bfhi(m1.x), bflo(m1.y), bfhi(m1.y), bflo(m1.z), bfhi(m1.z), bflo(m1.w), bfhi(m1.w)};
        float yv[16];
#pragma unroll
        for (int i = 0; i < 16; ++i) yv[i] = x[i] * rstd * gw[i] * sg[i];
        uint4 o0, o1;
        o0.x = pack2(yv[0], yv[1]); o0.y = pack2(yv[2], yv[3]); o0.z = pack2(yv[4], yv[5]); o0.w = pack2(yv[6], yv[7]);
        o1.x = pack2(yv[8], yv[9]); o1.y = pack2(yv[10], yv[11]); o1.z = pack2(yv[12], yv[13]); o1.w = pack2(yv[14], yv[15]);
        u16* mn = (u16*)(p.ws + WS_MN) + tok * 512 + cbase;
        *(uint4*)mn = o0;
        *(uint4*)(mn + 8) = o1;
      }
    }
  }
  {
    float* oc = p.out + (prompt ? O_CP + ((size_t)(l * 32 + b) * 4 + head) * 16384 : O_CS + ((size_t)(l * 8 + bs) * 4 + head) * 16384);
#pragma unroll
    for (int q = 0; q < 2; ++q)
#pragma unroll
      for (int g = 0; g < 4; ++g)
        *(float4*)(oc + (size_t)(vt * 32 + r) * 128 + (kt0 + q) * 32 + 8 * g + 4 * h) =
            make_float4(accC[q][4 * g], accC[q][4 * g + 1], accC[q][4 * g + 2], accC[q][4 * g + 3]);
    float* on = p.out + (prompt ? O_NP + ((size_t)(l * 32 + b) * 4 + head) * 128 : O_NS + ((size_t)(l * 8 + bs) * 4 + head) * 128);
    if (tid < 128) on[tid] = nvec[tid];
    if (tid == 0) {
      if (prompt) p.out[O_MP + (size_t)(l * 32 + b) * 4 + head] = m_run;
      else p.out[O_MS + (size_t)(l * 8 + bs) * 4 + head] = m_run;
    }
  }
}

DI void phase_mixers(const Params& p, int l, unsigned char* smem) {
  const int tid0 = otid();
  const int lane = tid0 & 63;
  const float* lp = p.in[16] + l * 256;
  float s1 = lp[lane] * lp[64 + lane], s2 = lp[128 + lane] * lp[192 + lane];
  s1 = wave_sum(s1, lane); s2 = wave_sum(s2, lane);
  const float lam_init = 0.8f - 0.6f * expf(-0.3f * (float)l);
  const float lam = expf(s1) - expf(s2) + lam_init;
  int* ctr = (int*)(p.ws + WS_CTR) + l;
  int* sitem = (int*)smem;
  const int N_ML = 160, N_AT = 2048 + 32;
  for (;;) {
    __syncthreads();
    if (tid0 == 0) *sitem = atomicAdd(ctr, 1);
    __syncthreads();
    const int item = *sitem;
    if (item >= N_ML + N_AT) break;
    if (item < N_ML) {
#ifndef NO_ML
      mlstm_item(p, l, item >> 2, item & 3, smem);
#endif
    } else {
#ifndef NO_AT
      const int a = item - N_ML;
      if (a < 2048) {
        const int qt = 15 - (a >> 7), rest = a & 127;
        attn_item(p, l, rest >> 2, rest & 3, qt, lam, lam_init, smem);
      } else {
        const int s = a - 2048;
        attn_item(p, l, 32 + (s >> 2), s & 3, 0, lam, lam_init, smem);
      }
#endif
    }
  }
}

DI void gbar(unsigned* bar, unsigned& epoch) {
  __syncthreads();
  epoch += gridDim.x;
  if (otid() == 0) {
    __threadfence();
    __hip_atomic_fetch_add(bar, 1u, __ATOMIC_RELAXED, __HIP_MEMORY_SCOPE_AGENT);
    while (__hip_atomic_load(bar, __ATOMIC_RELAXED, __HIP_MEMORY_SCOPE_AGENT) < epoch) __builtin_amdgcn_s_sleep(2);
    __threadfence();
  }
  __syncthreads();
}

__global__ void __launch_bounds__(NTHR) fwd_megakernel(Params p) {
  extern __shared__ __attribute__((aligned(16))) unsigned char smem[];
  cg::grid_group grid = cg::this_grid();
#ifndef PH
#define PH 0xffff
#endif
  unsigned* bar = (unsigned*)(p.ws + WS_CTR + 64);
  unsigned epoch = 0;
  if (PH & 1) prologue(p, smem);
  grid.sync();
  if (PH & 1) prologue(p, smem);
  grid.sync();
  if (PH & 2) ln_pass(p, 0, 0, smem);
  gbar(bar, epoch);
#pragma unroll 1
  for (int l = 0; l < 2; ++l) {
    if (PH & 4) phase_in_gate(p, l, smem);
    gbar(bar, epoch);
    if (PH & 8) phase_mixers(p, l, smem);
    gbar(bar, epoch);
    if (PH & 16) phase_mix(p, l, smem);
    gbar(bar, epoch);
    if (PH & 32) phase_res(p, l, 0, smem);
    gbar(bar, epoch);
    if (PH & 64) ln_pass(p, 1, l, smem);
    gbar(bar, epoch);
    if (PH & 128) phase_gu(p, l, smem);
    gbar(bar, epoch);
    if (PH & 256) phase_res(p, l, 1, smem);
    gbar(bar, epoch);
    if (PH & 512) ln_pass(p, 2, l, smem);
    if (l == 0) gbar(bar, epoch);
  }
}

extern "C" void kernel_launch(void* const* d_in, const int* in_sizes, int n_in, void* d_out, int out_size, void* d_ws,
                              size_t ws_size, hipStream_t stream) {
  static int grid_blocks = 0;
  if (!grid_blocks) {
    int dev = 0, cus = 0, per_cu = 0;
    hipGetDevice(&dev);
    hipDeviceGetAttribute(&cus, hipDeviceAttributeMultiprocessorCount, dev);
    if (hipFuncSetAttribute((const void*)fwd_megakernel, hipFuncAttributeMaxDynamicSharedMemorySize, LDS_BYTES) != hipSuccess)
      fprintf(stderr, "kernel_launch: hipFuncSetAttribute failed\n");
    if (hipOccupancyMaxActiveBlocksPerMultiprocessor(&per_cu, (const void*)fwd_megakernel, NTHR, LDS_BYTES) != hipSuccess || per_cu < 1) {
      fprintf(stderr, "kernel_launch: occupancy query gave %d\n", per_cu);
      per_cu = 1;
    }
    (void)hipGetLastError();
    grid_blocks = cus * per_cu;
    if (ws_size < WS_END) fprintf(stderr, "kernel_launch: workspace too small: %zu < %zu\n", ws_size, (size_t)WS_END);
  }
  if (hipMemsetAsync((char*)d_ws + WS_CTR, 0, 256, stream) != hipSuccess) fprintf(stderr, "kernel_launch: memset failed\n");
  Params p{};
  for (int i = 0; i < 30; ++i) p.in[i] = (const float*)d_in[i];
  p.out = (float*)d_out;
  p.ws = (unsigned char*)d_ws;
  void* args[] = {&p};
  hipError_t e = hipLaunchCooperativeKernel((const void*)fwd_megakernel, dim3(grid_blocks), dim3(NTHR), args, LDS_BYTES, stream);
  if (e != hipSuccess) fprintf(stderr, "cooperative launch failed: %s (grid %d)\n", hipGetErrorString(e), grid_blocks);
}
```

```cpp
#include <hip/hip_runtime.h>
#include <hip/hip_cooperative_groups.h>
#include <cstdio>
namespace cg = cooperative_groups;

#define DI __device__ __forceinline__
typedef unsigned short u16;
using bf16x8 = __attribute__((ext_vector_type(8))) short;
using f32x16 = __attribute__((ext_vector_type(16))) float;
#define MFMA(a, b, c) __builtin_amdgcn_mfma_f32_32x32x16_bf16((a), (b), (c), 0, 0, 0)

constexpr int TOKP = 65536, TOKS = 256, TOK = 65792;
constexpr int NTHR = 512;
constexpr float LN_EPS = 1e-5f;
constexpr float ALPHA = 1.41421356237f;
constexpr float LOG2E = 1.44269504089f;

constexpr size_t WS_WT_IN   = 0;
constexpr size_t WS_WT_GATE = WS_WT_IN + 2ull * 3584 * 1024 * 2;
constexpr size_t WS_WT_BRA  = WS_WT_GATE + 2ull * 2048 * 1024 * 2;
constexpr size_t WS_WT_BRB  = WS_WT_BRA + 2ull * 1024 * 512 * 2;
constexpr size_t WS_WT_O    = WS_WT_BRB + 2ull * 1024 * 512 * 2;
constexpr size_t WS_WT_GU   = WS_WT_O + 2ull * 1024 * 1024 * 2;
constexpr size_t WS_WT_DOWN = WS_WT_GU + 2ull * 5632 * 1024 * 2;
constexpr size_t WS_MOD     = WS_WT_DOWN + 2ull * 1024 * 2816 * 2;
constexpr size_t WS_GATES   = WS_MOD + 2ull * 40 * 6144 * 4;
constexpr size_t WS_CTR     = WS_GATES + (size_t)TOK * 8 * 4;
constexpr size_t WS_KS      = WS_CTR + 4096;
constexpr size_t WS_VTS     = WS_KS + 2ull * 8 * 1056 * 512 * 2 + 65536;
constexpr size_t WS_MQKT_S  = WS_VTS + 2ull * 8 * 512 * 1056 * 2 + 65536;
constexpr size_t WS_MVT_S   = WS_MQKT_S + 8ull * 1024 * 32 * 2;
constexpr size_t WS_H       = WS_MVT_S + 8ull * 512 * 32 * 2;
constexpr size_t WS_AN      = WS_H;
constexpr size_t WS_MN      = WS_H + (size_t)TOK * 512 * 2;
constexpr size_t WS_ZQ      = WS_H + (size_t)TOK * 1024 * 2;
constexpr size_t WS_KB      = WS_ZQ + (size_t)TOK * 512 * 2;
constexpr size_t WS_VTP     = WS_KB + (size_t)TOKP * 512 * 2;
constexpr size_t WS_MQKT_P  = WS_VTP + 32ull * 512 * 2048 * 2;
constexpr size_t WS_MVT_P   = WS_MQKT_P + 32ull * 1024 * 2048 * 2;
constexpr size_t WS_MO      = WS_MVT_P + 32ull * 512 * 2048 * 2;
constexpr size_t WS_G       = WS_MO + (size_t)TOK * 512 * 2;
constexpr size_t WS_END     = WS_G + (size_t)TOK * 2048 * 2;
constexpr size_t WS_MIX     = WS_ZQ;
constexpr size_t WS_ACT     = WS_ZQ;

constexpr size_t O_YP  = 0;
constexpr size_t O_YS  = O_YP + (size_t)TOKP * 1024;
constexpr size_t O_KP  = O_YS + (size_t)TOKS * 1024;
constexpr size_t O_VP  = O_KP + 2ull * TOKP * 512;
constexpr size_t O_KSM = O_VP + 2ull * TOKP * 512;
constexpr size_t O_VSM = O_KSM + 2ull * TOKS * 512;
constexpr size_t O_CP  = O_VSM + 2ull * TOKS * 512;
constexpr size_t O_NP  = O_CP + 2ull * 32 * 4 * 128 * 128;
constexpr size_t O_MP  = O_NP + 2ull * 32 * 4 * 128;
constexpr size_t O_CVP = O_MP + 2ull * 32 * 4;
constexpr size_t O_CS  = O_CVP + 2ull * 32 * 3 * 1024;
constexpr size_t O_NS  = O_CS + 2ull * 8 * 4 * 128 * 128;
constexpr size_t O_MS  = O_NS + 2ull * 8 * 4 * 128;
constexpr size_t O_CVS = O_MS + 2ull * 8 * 4;

constexpr int LDS_BYTES = 148480;

struct Params {
  const float* in[30];
  float* out;
  unsigned char* ws;
};

DI u16 f2bf(float x) { unsigned u = __float_as_uint(x); u += 0x7fffu + ((u >> 16) & 1u); return (u16)(u >> 16); }
DI float bf2f(unsigned v) { return __uint_as_float(v << 16); }
typedef __bf16 bf16x2_t __attribute__((ext_vector_type(2)));
typedef float f32x2_t __attribute__((ext_vector_type(2)));
DI unsigned pack2(float a, float b) {
  f32x2_t v = {a, b};
  return __builtin_bit_cast(unsigned, __builtin_convertvector(v, bf16x2_t));
}
DI float bflo(unsigned v) { return __uint_as_float(v << 16); }
DI float bfhi(unsigned v) { return __uint_as_float(v & 0xffff0000u); }
DI float sigmoidf_(float x) { return 1.f / (1.f + __expf(-x)); }
DI float siluf_(float x) { return x / (1.f + __expf(-x)); }
DI float fexp2(float x) { return __builtin_amdgcn_exp2f(x); }
DI int otid() { int t = threadIdx.x; asm volatile("" : "+v"(t)); return t; }
DI float shx(float v, int mask, int lane) { return __int_as_float(__builtin_amdgcn_ds_bpermute(((lane ^ mask) & 63) << 2, __float_as_int(v))); }
DI float shidx(float v, int src, int lane) { (void)lane; return __int_as_float(__builtin_amdgcn_ds_bpermute((src & 63) << 2, __float_as_int(v))); }
DI int crow(int i, int h) { return (i & 3) + 8 * (i >> 2) + 4 * h; }
DI bf16x8 pack8(const f32x16& x, int s) {
  uint4 u;
  u.x = pack2(x[8 * s + 0], x[8 * s + 1]); u.y = pack2(x[8 * s + 2], x[8 * s + 3]);
  u.z = pack2(x[8 * s + 4], x[8 * s + 5]); u.w = pack2(x[8 * s + 6], x[8 * s + 7]);
  return __builtin_bit_cast(bf16x8, u);
}
DI void zero16(f32x16& a) {
#pragma unroll
  for (int i = 0; i < 16; ++i) a[i] = 0.f;
}
DI int batch_of_row(int row) { return row < TOKP ? (row >> 11) : 32 + ((row - TOKP) >> 5); }

constexpr int GS_STRIDE = 144;
constexpr int GS_STAGE = 512 * GS_STRIDE;
constexpr int GS_BASE = 64;

DI void gemm_mainloop(f32x16 (&acc)[4][2], const u16* __restrict__ A, int lda, const u16* __restrict__ Wt, int ldw, int K,
                      int m0, int n0, unsigned char* smem) {
  const int tid = otid(), lane = tid & 63, w = tid >> 6;
  const int wm = w >> 2, wn = w & 3, r = lane & 31, h = lane >> 5;
  const int lrow = tid >> 3, lcc = tid & 7;
  const u16* ap = A + (size_t)(m0 + lrow) * lda + lcc * 8;
  const int bn = n0 + 2 * (lrow & 31) + ((lrow >> 5) & 1);
  const u16* bp = Wt + (size_t)bn * ldw + lcc * 8;
  const size_t astep = (size_t)64 * lda, bstep = (size_t)64 * ldw;
  unsigned char* sbase = smem + GS_BASE;
  const int woff = lrow * GS_STRIDE + lcc * 16;
  const int nk = K >> 6;
  uint4 s0, s1, s2, s3, s4, s5, s6, s7, u0, u1, u2, u3, u4, u5, u6, u7;
  int kn = 1;
#define G_ADV() do { const int adv = (kn < nk) ? 64 : 0; ap += adv; bp += adv; ++kn; } while (0)
#define G_ISSUE_A() do { s0 = *(const uint4*)(ap); s1 = *(const uint4*)(ap + astep); s2 = *(const uint4*)(ap + 2 * astep); s3 = *(const uint4*)(ap + 3 * astep); \
    s4 = *(const uint4*)(bp); s5 = *(const uint4*)(bp + bstep); s6 = *(const uint4*)(bp + 2 * bstep); s7 = *(const uint4*)(bp + 3 * bstep); } while (0)
#define G_ISSUE_B() do { u0 = *(const uint4*)(ap); u1 = *(const uint4*)(ap + astep); u2 = *(const uint4*)(ap + 2 * astep); u3 = *(const uint4*)(ap + 3 * astep); \
    u4 = *(const uint4*)(bp); u5 = *(const uint4*)(bp + bstep); u6 = *(const uint4*)(bp + 2 * bstep); u7 = *(const uint4*)(bp + 3 * bstep); } while (0)
#define G_WRITE_A(sn) do { *(uint4*)((sn) + woff) = s0; *(uint4*)((sn) + woff + 64 * GS_STRIDE) = s1; *(uint4*)((sn) + woff + 128 * GS_STRIDE) = s2; \
    *(uint4*)((sn) + woff + 192 * GS_STRIDE) = s3; *(uint4*)((sn) + woff + 256 * GS_STRIDE) = s4; *(uint4*)((sn) + woff + 320 * GS_STRIDE) = s5; \
    *(uint4*)((sn) + woff + 384 * GS_STRIDE) = s6; *(uint4*)((sn) + woff + 448 * GS_STRIDE) = s7; } while (0)
#define G_WRITE_B(sn) do { *(uint4*)((sn) + woff) = u0; *(uint4*)((sn) + woff + 64 * GS_STRIDE) = u1; *(uint4*)((sn) + woff + 128 * GS_STRIDE) = u2; \
    *(uint4*)((sn) + woff + 192 * GS_STRIDE) = u3; *(uint4*)((sn) + woff + 256 * GS_STRIDE) = u4; *(uint4*)((sn) + woff + 320 * GS_STRIDE) = u5; \
    *(uint4*)((sn) + woff + 384 * GS_STRIDE) = u6; *(uint4*)((sn) + woff + 448 * GS_STRIDE) = u7; } while (0)
  const int aoff = (wm * 128 + r) * GS_STRIDE + h * 16;
  const int boff = (256 + wn * 64 + r) * GS_STRIDE + h * 16;
#define G_COMPUTE(st) do { _Pragma("unroll") for (int ks = 0; ks < 4; ++ks) {                                              \
      bf16x8 fa[4], fb[2];                                                                                               \
      _Pragma("unroll") for (int mi = 0; mi < 4; ++mi) fa[mi] = *(const bf16x8*)((st) + aoff + mi * 32 * GS_STRIDE + ks * 32); \
      fb[0] = *(const bf16x8*)((st) + boff + ks * 32);                                                                   \
      fb[1] = *(const bf16x8*)((st) + boff + 32 * GS_STRIDE + ks * 32);                                                  \
      _Pragma("unroll") for (int mi = 0; mi < 4; ++mi) {                                                                 \
        acc[mi][0] = MFMA(fa[mi], fb[0], acc[mi][0]);                                                                    \
        acc[mi][1] = MFMA(fa[mi], fb[1], acc[mi][1]);                                                                    \
      }                                                                                                                  \
      __builtin_amdgcn_sched_barrier(0);                                                                                 \
    } } while (0)
  G_ISSUE_A();
  G_WRITE_A(sbase);
  G_ADV(); G_ISSUE_A();
  G_ADV(); G_ISSUE_B();
  __syncthreads();
  for (int kt = 0; kt < nk; kt += 2) {
    G_WRITE_A(sbase + GS_STAGE);
    G_ADV(); G_ISSUE_A();
    __builtin_amdgcn_sched_barrier(0);
    G_COMPUTE(sbase);
    __syncthreads();
    G_WRITE_B(sbase);
    G_ADV(); G_ISSUE_B();
    __builtin_amdgcn_sched_barrier(0);
    G_COMPUTE(sbase + GS_STAGE);
    __syncthreads();
  }
#undef G_ADV
#undef G_ISSUE_A
#undef G_ISSUE_B
#undef G_WRITE_A
#undef G_WRITE_B
#undef G_COMPUTE
}

DI int rot_unused_(int) { return 0; }
DI bool tile_of(int i, int MT, int NT, int& mt, int& nt) {
  const int per = gridDim.x >> 3;
  const int L = i * (int)gridDim.x + (int)(blockIdx.x & 7) * per + (int)(blockIdx.x >> 3);
  if (L >= MT * NT) return false;
  const int nig = 8 * NT, gid = L / nig, fm = gid * 8, gsz = min(MT - fm, 8), rem = L - gid * nig;
  mt = fm + rem % gsz; nt = rem / gsz;
  return true;
}


template <class PF, class EF>
DI void gemm_stream(int lda, int ldw, int K, unsigned char* smem, PF ptrs, EF epi) {
  const int tid = otid(), lane = tid & 63, w = tid >> 6;
  const int wm = w >> 2, wn = w & 3, r = lane & 31, h = lane >> 5;
  unsigned char* sbase = smem + GS_BASE;
  constexpr int SLOT = 512 * 64;
  const int nh = K >> 5;
  const int c0 = (h ^ ((r >> 2) & 3)) * 16, c1 = c0 ^ 32;
  const int aoff = (wm * 128 + r) * 64, boff = (256 + wn * 64 + r) * 64;
  const int lr16 = lane >> 2, lchunk = (lane & 3) ^ ((lane >> 4) & 3);
  const bool isB = w >= 4;
  const unsigned goff = isB ? (unsigned)((((w - 4) * 64 + 2 * lr16) * ldw + lchunk * 8) * 2)
                            : (unsigned)(((w * 64 + lr16) * lda + lchunk * 8) * 2);
  const unsigned st1 = isB ? (unsigned)(32 * ldw * 2) : (unsigned)(16 * lda * 2);
  const unsigned st2 = isB ? (unsigned)(1 * ldw * 2) : (unsigned)(32 * lda * 2);
#define WAIT_V(n) asm volatile("s_waitcnt vmcnt(" #n ")" ::: "memory")
#define RAWBAR() do { asm volatile("s_waitcnt lgkmcnt(0)" ::: "memory"); __builtin_amdgcn_s_barrier(); asm volatile("" ::: "memory"); } while (0)
#define BAR0() do { asm volatile("" ::: "memory"); __builtin_amdgcn_s_barrier(); asm volatile("" ::: "memory"); } while (0)
#define H_DMA(slotp) do { const char* gsrc_ = (isB ? bp : ap) + goff; unsigned char* ld_ = (slotp) + w * 4096;            \
    __builtin_amdgcn_global_load_lds((const unsigned*)(gsrc_), (unsigned*)(ld_), 16, 0, 0);                                  \
    __builtin_amdgcn_global_load_lds((const unsigned*)(gsrc_ + st1), (unsigned*)(ld_ + 1024), 16, 0, 0);                     \
    __builtin_amdgcn_global_load_lds((const unsigned*)(gsrc_ + st2), (unsigned*)(ld_ + 2048), 16, 0, 0);                     \
    __builtin_amdgcn_global_load_lds((const unsigned*)(gsrc_ + st2 + st1), (unsigned*)(ld_ + 3072), 16, 0, 0); } while (0)
#define H_READ(sl) do { _Pragma("unroll") for (int mi = 0; mi < 4; ++mi) {                                                   \
      fa[0][mi] = *(const bf16x8*)((sl) + aoff + mi * 2048 + c0); fa[1][mi] = *(const bf16x8*)((sl) + aoff + mi * 2048 + c1); } \
    fb[0][0] = *(const bf16x8*)((sl) + boff + c0); fb[1][0] = *(const bf16x8*)((sl) + boff + c1);                            \
    fb[0][1] = *(const bf16x8*)((sl) + boff + 2048 + c0); fb[1][1] = *(const bf16x8*)((sl) + boff + 2048 + c1); } while (0)
#define H_MMA() do { _Pragma("unroll") for (int ks = 0; ks < 2; ++ks) { _Pragma("unroll") for (int mi = 0; mi < 4; ++mi) {  \
      acc[mi][0] = MFMA(fa[ks][mi], fb[ks][0], acc[mi][0]);                                                       \
      acc[mi][1] = MFMA(fa[ks][mi], fb[ks][1], acc[mi][1]); } } } while (0)
  for (int it = 0;; ++it) {
    const char *ap, *bp;
    {
      const u16 *ta, *tb;
      if (!ptrs(it, ta, tb)) break;
      ap = (const char*)ta; bp = (const char*)tb;
    }
    f32x16 acc[4][2];
#pragma unroll
    for (int a = 0; a < 4; ++a)
#pragma unroll
      for (int b = 0; b < 2; ++b) zero16(acc[a][b]);
    H_DMA(sbase); ap += 64; bp += 64;
    H_DMA(sbase + SLOT); ap += 64; bp += 64;
    H_DMA(sbase + 2 * SLOT); ap += 64; bp += 64;
    WAIT_V(8);
    BAR0();
    if (wm == 1) BAR0();
    int rs = 0;
#pragma unroll 1
    for (int hh = 0; hh < nh; ++hh) {
      bf16x8 fa[2][4], fb[2][2];
      const int rem = nh - 2 - hh;
      H_READ(sbase + rs * SLOT);
      if (hh + 3 < nh) { H_DMA(sbase + ((rs + 3) & 3) * SLOT); ap += 64; bp += 64; }
      if (wm == 1) {
        if (rem >= 2) WAIT_V(8); else if (rem == 1) WAIT_V(4); else WAIT_V(0);
      }
      __builtin_amdgcn_sched_barrier(0);
      RAWBAR();
      __builtin_amdgcn_sched_barrier(0);
      H_MMA();
      __builtin_amdgcn_sched_barrier(0);
      if (wm == 0) {
        if (rem >= 2) WAIT_V(8); else if (rem == 1) WAIT_V(4); else WAIT_V(0);
      }
      BAR0();
      rs = (rs + 1) & 3;
    }
    if (wm == 0) BAR0();
    epi(it, acc);
  }
#undef WAIT_V
#undef RAWBAR
#undef BAR0
#undef H_DMA
#undef H_READ
#undef H_MMA
}

DI int map_row(int maptype, int s) {
  if (maptype == 1) return s < 3072 ? s : (s < 3080 ? -1 : s - 8);
  if (maptype == 2) return s < 2816 ? 2 * s : 2 * (s - 2816) + 1;
  return s;
}
DI void transpose_task(const float* __restrict__ src, int Nsrc, u16* __restrict__ dst, int dld, int maptype, int kt, int nt,
                       unsigned char* smem) {
  float* tile = (float*)(smem + 64);
  const int tid = otid();
  const int k0 = kt * 64, s0 = nt * 64;
#pragma unroll
  for (int i = 0; i < 2; ++i) {
    const int kr = (tid >> 4) + 32 * i, nc = (tid & 15) * 4;
    float4 v = make_float4(0.f, 0.f, 0.f, 0.f);
    if (s0 + nc < Nsrc) v = *(const float4*)(src + (size_t)(k0 + kr) * Nsrc + s0 + nc);
    tile[kr * 65 + nc + 0] = v.x; tile[kr * 65 + nc + 1] = v.y; tile[kr * 65 + nc + 2] = v.z; tile[kr * 65 + nc + 3] = v.w;
  }
  __syncthreads();
  {
    const int n = tid >> 3, kc = (tid & 7) * 8;
    const int s = s0 + n;
    const int dr = (s < Nsrc) ? map_row(maptype, s) : -1;
    if (dr >= 0) {
      uint4 o;
      o.x = pack2(tile[(kc + 0) * 65 + n], tile[(kc + 1) * 65 + n]);
      o.y = pack2(tile[(kc + 2) * 65 + n], tile[(kc + 3) * 65 + n]);
      o.z = pack2(tile[(kc + 4) * 65 + n], tile[(kc + 5) * 65 + n]);
      o.w = pack2(tile[(kc + 6) * 65 + n], tile[(kc + 7) * 65 + n]);
      *(uint4*)(dst + (size_t)dr * dld + k0 + kc) = o;
    }
  }
  __syncthreads();
}

DI void adaln_task(const Params& p, int task, unsigned char* smem) {
  const int bhalf = task & 1, cg_ = (task >> 1) % 96, l = (task >> 1) / 96;
  float* cs = (float*)(smem + 64);
  float* red = (float*)(smem + 64 + 20 * 1024 * 4);
  const int tid = otid();
  const float* cp = p.in[2]; const float* csm = p.in[3];
  for (int idx = tid; idx < 20 * 1024; idx += NTHR) {
    const int bb = idx >> 10, d = idx & 1023, b = bhalf * 20 + bb;
    const float c = b < 32 ? cp[b * 1024 + d] : csm[(b - 32) * 1024 + d];
    cs[idx] = siluf_(c);
  }
  __syncthreads();
  const int dseg = tid >> 6, e = cg_ * 64 + (tid & 63);
  const float* wp = p.in[10] + ((size_t)l * 1024 + dseg * 128) * 6144 + e;
  float acc[20];
#pragma unroll
  for (int i = 0; i < 20; ++i) acc[i] = 0.f;
  for (int d = 0; d < 128; ++d) {
    const float wv = wp[(size_t)d * 6144];
    const float* c0 = cs + dseg * 128 + d;
#pragma unroll
    for (int i = 0; i < 20; ++i) acc[i] += c0[i * 1024] * wv;
  }
#pragma unroll
  for (int i = 0; i < 20; ++i) red[(dseg * 20 + i) * 64 + (tid & 63)] = acc[i];
  __syncthreads();
  float* mod = (float*)(p.ws + WS_MOD);
  for (int idx = tid; idx < 20 * 64; idx += NTHR) {
    const int bb = idx >> 6, ec = idx & 63;
    float s = 0.f;
#pragma unroll
    for (int q = 0; q < 8; ++q) s += red[(q * 20 + bb) * 64 + ec];
    const int ee = cg_ * 64 + ec;
    mod[((size_t)l * 40 + bhalf * 20 + bb) * 6144 + ee] = s + p.in[11][l * 6144 + ee];
  }
  __syncthreads();
}

DI void prologue(const Params& p, unsigned char* smem) {
  const int WT_TASKS_L = 912 + 512 + 128 + 128 + 256 + 1408 + 704;
  const int N_WT = 2 * WT_TASKS_L;
  const int N_ADA = 384, N_CK = 512, N_CV = 2048;
  const int total = N_WT + N_ADA + N_CK + N_CV;
  for (int task = blockIdx.x; task < total; task += gridDim.x) {
    if (task < N_WT) {
      const int l = task / WT_TASKS_L; int t = task % WT_TASKS_L;
      if (t < 912) { transpose_task(p.in[12] + (size_t)l * 1024 * 3592, 3592, (u16*)(p.ws + WS_WT_IN) + (size_t)l * 3584 * 1024, 1024, 1, t / 57, t % 57, smem); continue; }
      t -= 912;
      if (t < 512) { transpose_task(p.in[21] + (size_t)l * 1024 * 2048, 2048, (u16*)(p.ws + WS_WT_GATE) + (size_t)l * 2048 * 1024, 1024, 0, t / 32, t % 32, smem); continue; }
      t -= 512;
      if (t < 128) { transpose_task(p.in[19] + (size_t)l * 512 * 1024, 1024, (u16*)(p.ws + WS_WT_BRA) + (size_t)l * 1024 * 512, 512, 0, t / 16, t % 16, smem); continue; }
      t -= 128;
      if (t < 128) { transpose_task(p.in[20] + (size_t)l * 512 * 1024, 1024, (u16*)(p.ws + WS_WT_BRB) + (size_t)l * 1024 * 512, 512, 0, t / 16, t % 16, smem); continue; }
      t -= 128;
      if (t < 256) { transpose_task(p.in[23] + (size_t)l * 1024 * 1024, 1024, (u16*)(p.ws + WS_WT_O) + (size_t)l * 1024 * 1024, 1024, 0, t / 16, t % 16, smem); continue; }
      t -= 256;
      if (t < 1408) { transpose_task(p.in[26] + (size_t)l * 1024 * 5632, 5632, (u16*)(p.ws + WS_WT_GU) + (size_t)l * 5632 * 1024, 1024, 2, t / 88, t % 88, smem); continue; }
      t -= 1408;
      transpose_task(p.in[27] + (size_t)l * 2816 * 1024, 1024, (u16*)(p.ws + WS_WT_DOWN) + (size_t)l * 1024 * 2816, 2816, 0, t / 16, t % 16, smem);
    } else if (task < N_WT + N_ADA) {
      adaln_task(p, task - N_WT, smem);
    } else if (task < N_WT + N_ADA + N_CK) {
      const int t = task - N_WT - N_ADA;
      const float4* src = (const float4*)p.in[4];
      u16* dst = (u16*)(p.ws + WS_KS);
#pragma unroll
      for (int i = 0; i < 8; ++i) {
        const size_t f4 = (size_t)t * 4096 + i * 512 + otid();
        const float4 v = src[f4];
        const size_t e = f4 * 4;
        const size_t lb = e / (1024 * 512), rem = e % (1024 * 512);
        uint2 o; o.x = pack2(v.x, v.y); o.y = pack2(v.z, v.w);
        *(uint2*)(dst + lb * (1056 * 512) + rem) = o;
      }
    } else {
      const int t = task - N_WT - N_ADA - N_CK;
      const int lb = t >> 7, tt = t & 127;
      transpose_task(p.in[5] + (size_t)lb * 1024 * 512, 512, (u16*)(p.ws + WS_VTS) + (size_t)lb * 512 * 1056, 1056, 0, tt >> 3, tt & 7, smem);
    }
  }
}

DI float wave_sum(float v, int lane) {
#pragma unroll
  for (int off = 32; off >= 1; off >>= 1) v += shx(v, off, lane);
  return v;
}
DI void ln_pass(const Params& p, int mode, int l, unsigned char* smem) {
  const int tid = otid();
  const int lane = tid & 63, w = tid >> 6;
  const bool first = mode != 0;
  const bool second = (mode != 2) || (l + 1 < 2);
  const bool gates = (mode == 0) || (mode == 2 && l + 1 < 2);
  const int lm = (mode == 2) ? l + 1 : l;
  const int shi = (mode == 1) ? 3 : 0;
  const float* lng = (mode == 1) ? p.in[24] + l * 1024 : p.in[28] + l * 1024;
  const float* lnb = (mode == 1) ? p.in[25] + l * 1024 : p.in[29] + l * 1024;
  const float* mod = (const float*)(p.ws + WS_MOD);
  u16* H = (u16*)(p.ws + WS_H);
  float* gout = (float*)(p.ws + WS_GATES);
  float* wl = (float*)(smem + 64);
  float bif[8];
  if (gates) {
    const float* wi = p.in[12] + (size_t)lm * 1024 * 3592 + 3072;
    for (int idx = tid; idx < 8192; idx += NTHR) {
      const int c = idx >> 3, j = idx & 7;
      wl[j * 1024 + c] = wi[(size_t)c * 3592 + j];
    }
#pragma unroll
    for (int j = 0; j < 8; ++j) bif[j] = p.in[13][lm * 8 + j];
  }
  __syncthreads();
  float lg[16], lb[16];
  if (first) {
#pragma unroll
    for (int i = 0; i < 4; ++i) {
      const float4 g = *(const float4*)(lng + i * 256 + lane * 4);
      const float4 b = *(const float4*)(lnb + i * 256 + lane * 4);
      lg[i * 4] = g.x; lg[i * 4 + 1] = g.y; lg[i * 4 + 2] = g.z; lg[i * 4 + 3] = g.w;
      lb[i * 4] = b.x; lb[i * 4 + 1] = b.y; lb[i * 4 + 2] = b.z; lb[i * 4 + 3] = b.w;
    }
  }
  auto process = [&](int row, float (&v)[16], const float (&msh)[16], const float (&msc)[16]) {
    float* xr = p.out + (size_t)row * 1024;
    if (first) {
      float s = 0.f;
#pragma unroll
      for (int i = 0; i < 16; ++i) s += v[i];
      const float mean = wave_sum(s, lane) * (1.f / 1024.f);
      float q = 0.f;
#pragma unroll
      for (int i = 0; i < 16; ++i) { v[i] -= mean; q += v[i] * v[i]; }
      const float rstd = rsqrtf(wave_sum(q, lane) * (1.f / 1024.f) + LN_EPS);
#pragma unroll
      for (int i = 0; i < 4; ++i) {
#pragma unroll
        for (int e = 0; e < 4; ++e) v[i * 4 + e] = v[i * 4 + e] * rstd * lg[i * 4 + e] + lb[i * 4 + e];
        *(float4*)(xr + i * 256 + lane * 4) = make_float4(v[i * 4 + 0], v[i * 4 + 1], v[i * 4 + 2], v[i * 4 + 3]);
      }
    }
    if (second) {
      float s = 0.f;
#pragma unroll
      for (int i = 0; i < 16; ++i) s += v[i];
      const float mean = wave_sum(s, lane) * (1.f / 1024.f);
      float q = 0.f;
#pragma unroll
      for (int i = 0; i < 16; ++i) { v[i] -= mean; q += v[i] * v[i]; }
      const float rstd = rsqrtf(wave_sum(q, lane) * (1.f / 1024.f) + LN_EPS);
#pragma unroll
      for (int i = 0; i < 4; ++i) {
#pragma unroll
        for (int e = 0; e < 4; ++e) v[i * 4 + e] = v[i * 4 + e] * rstd * msc[i * 4 + e] + msh[i * 4 + e];
        uint2 o; o.x = pack2(v[i * 4 + 0], v[i * 4 + 1]); o.y = pack2(v[i * 4 + 2], v[i * 4 + 3]);
        *(uint2*)(H + (size_t)row * 1024 + i * 256 + lane * 4) = o;
      }
      if (gates) {
        float g8[8];
#pragma unroll
        for (int j = 0; j < 8; ++j) {
          float s2 = 0.f;
#pragma unroll
          for (int i = 0; i < 4; ++i) {
            const float4 wv = *(const float4*)(wl + j * 1024 + i * 256 + lane * 4);
            s2 += v[i * 4] * wv.x + v[i * 4 + 1] * wv.y + v[i * 4 + 2] * wv.z + v[i * 4 + 3] * wv.w;
          }
          g8[j] = wave_sum(s2, lane) + bif[j];
        }
        if (lane == 0) {
          *(float4*)(gout + (size_t)row * 8) = make_float4(g8[0], g8[1], g8[2], g8[3]);
          *(float4*)(gout + (size_t)row * 8 + 4) = make_float4(g8[4], g8[5], g8[6], g8[7]);
        }
      }
    }
  };
  auto load_mod = [&](int row, float (&msh)[16], float (&msc)[16]) {
    const float* mb = mod + ((size_t)lm * 40 + batch_of_row(row)) * 6144;
#pragma unroll
    for (int i = 0; i < 4; ++i) {
      const float4 sh = *(const float4*)(mb + shi * 1024 + i * 256 + lane * 4);
      const float4 sc = *(const float4*)(mb + (shi + 1) * 1024 + i * 256 + lane * 4);
      msh[i * 4] = sh.x; msh[i * 4 + 1] = sh.y; msh[i * 4 + 2] = sh.z; msh[i * 4 + 3] = sh.w;
      msc[i * 4] = 1.f + sc.x; msc[i * 4 + 1] = 1.f + sc.y; msc[i * 4 + 2] = 1.f + sc.z; msc[i * 4 + 3] = 1.f + sc.w;
    }
  };
  for (int chunk = blockIdx.x * 8 + w; chunk < TOKP / 32; chunk += gridDim.x * 8) {
    const int row0 = chunk * 32;
    float msh[16], msc[16];
    if (second) load_mod(row0, msh, msc);
    const float* src0 = (mode == 0) ? p.in[0] + (size_t)row0 * 1024 : p.out + (size_t)row0 * 1024;
    float4 nx0 = *(const float4*)(src0 + lane * 4), nx1 = *(const float4*)(src0 + 256 + lane * 4);
    float4 nx2 = *(const float4*)(src0 + 512 + lane * 4), nx3 = *(const float4*)(src0 + 768 + lane * 4);
    for (int ri = 0; ri < 32; ++ri) {
      float v[16];
      v[0] = nx0.x; v[1] = nx0.y; v[2] = nx0.z; v[3] = nx0.w; v[4] = nx1.x; v[5] = nx1.y; v[6] = nx1.z; v[7] = nx1.w;
      v[8] = nx2.x; v[9] = nx2.y; v[10] = nx2.z; v[11] = nx2.w; v[12] = nx3.x; v[13] = nx3.y; v[14] = nx3.z; v[15] = nx3.w;
      {
        const float* sn = src0 + (size_t)(ri < 31 ? ri + 1 : 31) * 1024;
        nx0 = *(const float4*)(sn + lane * 4); nx1 = *(const float4*)(sn + 256 + lane * 4);
        nx2 = *(const float4*)(sn + 512 + lane * 4); nx3 = *(const float4*)(sn + 768 + lane * 4);
      }
      __builtin_amdgcn_sched_barrier(0);
      process(row0 + ri, v, msh, msc);
    }
  }
  if (w == 0) {
    for (int row = TOKP + blockIdx.x; row < TOK; row += gridDim.x) {
      float msh[16], msc[16];
      if (second) load_mod(row, msh, msc);
      const float* src = (mode == 0) ? p.in[1] + (size_t)(row - TOKP) * 1024 : p.out + (size_t)row * 1024;
      float v[16];
#pragma unroll
      for (int i = 0; i < 4; ++i) {
        const float4 t = *(const float4*)(src + i * 256 + lane * 4);
        v[i * 4 + 0] = t.x; v[i * 4 + 1] = t.y; v[i * 4 + 2] = t.z; v[i * 4 + 3] = t.w;
      }
      process(row, v, msh, msc);
    }
  }
}


DI void micro_partial(f32x16& acc, const u16* A, int lda, const u16* Wt, int ldw, int K, int row0, int n0, int w, int r, int h) {
  const int kb = w * (K >> 3), n16 = K >> 7;
  const u16* ap = A + (size_t)(row0 + r) * lda + kb + h * 8;
  const u16* bp = Wt + (size_t)(n0 + r) * ldw + kb + h * 8;
#pragma unroll 4
  for (int k = 0; k < n16; ++k) {
    const bf16x8 a = *(const bf16x8*)(ap + k * 16);
    const bf16x8 b = *(const bf16x8*)(bp + k * 16);
    acc = MFMA(a, b, acc);
  }
}
DI void micro_reduce_store(const f32x16& acc, float* red, int w, int lane) {
#pragma unroll
  for (int i = 0; i < 16; ++i) red[(w * 16 + i) * 64 + lane] = acc[i];
}
DI float micro_sum(const float* red, int i, int lane) {
  float s = 0.f;
#pragma unroll
  for (int q = 0; q < 8; ++q) s += red[(q * 16 + i) * 64 + lane];
  return s;
}

constexpr int EP_LD = 264;
constexpr int EP_LDT = 68;
DI void zero_acc(f32x16 (&acc)[4][2]) {
#pragma unroll
  for (int a = 0; a < 4; ++a)
#pragma unroll
    for (int b = 0; b < 2; ++b) zero16(acc[a][b]);
}
DI void stage_rm(const f32x16& a0, const f32x16& a1, float* stg, int wm, int wn, int r, int h) {
#pragma unroll
  for (int i = 0; i < 16; ++i) *(float2*)(stg + (wm * 32 + crow(i, h)) * EP_LD + wn * 64 + 2 * r) = make_float2(a0[i], a1[i]);
}
DI void stage_tr(const f32x16& a0, const f32x16& a1, float* stg, int wm, int wn, int r, int h) {
#pragma unroll
  for (int g = 0; g < 4; ++g) {
    *(float4*)(stg + (wn * 64 + 2 * r) * EP_LDT + wm * 32 + 8 * g + 4 * h) = make_float4(a0[4 * g], a0[4 * g + 1], a0[4 * g + 2], a0[4 * g + 3]);
    *(float4*)(stg + (wn * 64 + 2 * r + 1) * EP_LDT + wm * 32 + 8 * g + 4 * h) = make_float4(a1[4 * g], a1[4 * g + 1], a1[4 * g + 2], a1[4 * g + 3]);
  }
}
DI int grow_of(int m0, int mi, int lr) { return m0 + (lr >> 5) * 128 + mi * 32 + (lr & 31); }
DI uint4 pack8f(const float4& a, const float4& b) {
  uint4 o; o.x = pack2(a.x, a.y); o.y = pack2(a.z, a.w); o.z = pack2(b.x, b.y); o.w = pack2(b.z, b.w); return o;
}

DI void write_tr(const Params& p, int l, int m0, int mi, const float* stg, int tid, int which, int chbase) {
  const bool prompt = m0 < TOKP;
#pragma unroll 1
  for (int q = 0; q < 4; ++q) {
    const int cid = q * NTHR + tid, ch = cid >> 3, tc = cid & 7;
    const float4 v0 = *(const float4*)(stg + ch * EP_LDT + tc * 8);
    const float4 v1 = *(const float4*)(stg + ch * EP_LDT + tc * 8 + 4);
    const int row0 = grow_of(m0, mi, tc * 8);
    const int chg = chbase + ch;
    u16* d;
    if (prompt) {
      const int b = row0 >> 11, t = row0 & 2047;
      if (which == 0) d = (u16*)(p.ws + WS_VTP) + ((size_t)b * 512 + chg) * 2048 + t;
      else if (which == 1) d = (u16*)(p.ws + WS_MQKT_P) + ((size_t)b * 1024 + chg) * 2048 + t;
      else d = (u16*)(p.ws + WS_MVT_P) + ((size_t)b * 512 + chg) * 2048 + t;
    } else {
      const int rs = row0 - TOKP, bs = rs >> 5, t = rs & 31;
      if (which == 0) d = (u16*)(p.ws + WS_VTS) + ((size_t)(l * 8 + bs) * 512 + chg) * 1056 + 1024 + t;
      else if (which == 1) d = (u16*)(p.ws + WS_MQKT_S) + ((size_t)bs * 1024 + chg) * 32 + t;
      else d = (u16*)(p.ws + WS_MVT_S) + ((size_t)bs * 512 + chg) * 32 + t;
    }
    *(uint4*)d = pack8f(v0, v1);
  }
}

DI void epi_in(const Params& p, int l, int m0, int n0, f32x16 (&acc)[4][2], unsigned char* smem) {
  const int tid = otid(), lane = tid & 63, w = tid >> 6;
  const int wm = w >> 2, wn = w & 3, r = lane & 31, h = lane >> 5;
  const bool prompt = m0 < TOKP;
  float* stg = (float*)(smem + GS_BASE + GS_STAGE);
  const int seg = n0 < 512 ? 0 : (n0 < 1024 ? 1 : (n0 < 1536 ? 2 : (n0 < 2560 ? 3 : (n0 < 3072 ? 4 : 5))));
  if (seg == 3) {
    const int ch = n0 - 1536 + wn * 64 + 2 * r;
#pragma unroll
    for (int mi = 0; mi < 4; ++mi) {
      const int rb = m0 + wm * 128 + mi * 32 + 4 * h;
#pragma unroll
      for (int i = 0; i < 16; ++i) {
        const int row = rb + (i & 3) + 8 * (i >> 2);
        if (prompt) {
          const int tt = row & 2047;
          if (tt >= 2045) *(float2*)(p.out + O_CVP + ((size_t)(l * 32 + (row >> 11)) * 3 + (tt - 2045)) * 1024 + ch) = make_float2(acc[mi][0][i], acc[mi][1][i]);
        } else {
          const int rs = row - TOKP, tt = rs & 31;
          if (tt >= 29) *(float2*)(p.out + O_CVS + ((size_t)(l * 8 + (rs >> 5)) * 3 + (tt - 29)) * 1024 + ch) = make_float2(acc[mi][0][i], acc[mi][1][i]);
        }
      }
    }
  }
#pragma unroll
  for (int mi = 0; mi < 4; ++mi) {
    if (seg == 0 || seg == 1 || seg == 2 || seg == 5) {
      __syncthreads();
      stage_rm(acc[mi][0], acc[mi][1], stg, wm, wn, r, h);
      __syncthreads();
#pragma unroll 1
      for (int q = 0; q < 4; ++q) {
        const int cid = q * NTHR + tid, lr = cid >> 5, c8 = (cid & 31) * 8;
        const float4 v0 = *(const float4*)(stg + lr * EP_LD + c8);
        const float4 v1 = *(const float4*)(stg + lr * EP_LD + c8 + 4);
        const int row = grow_of(m0, mi, lr);
        const int n = n0 + c8;
        if (seg == 0) {
          *(uint4*)((u16*)(p.ws + WS_ZQ) + (size_t)row * 512 + n) = pack8f(v0, v1);
        } else if (seg == 5) {
          const float4 s0 = make_float4(sigmoidf_(v0.x), sigmoidf_(v0.y), sigmoidf_(v0.z), sigmoidf_(v0.w));
          const float4 s1 = make_float4(sigmoidf_(v1.x), sigmoidf_(v1.y), sigmoidf_(v1.z), sigmoidf_(v1.w));
          *(uint4*)((u16*)(p.ws + WS_MO) + (size_t)row * 512 + (n - 3072)) = pack8f(s0, s1);
        } else {
          const bool isk = seg == 1;
          const int nn = n - (isk ? 512 : 1024);
          float* of = p.out + (isk ? (prompt ? O_KP : O_KSM) : (prompt ? O_VP : O_VSM));
          const size_t orow = prompt ? ((size_t)l * TOKP + row) : ((size_t)l * TOKS + (row - TOKP));
          *(float4*)(of + orow * 512 + nn) = v0;
          *(float4*)(of + orow * 512 + nn + 4) = v1;
          if (isk) {
            u16* kd;
            if (prompt) kd = (u16*)(p.ws + WS_KB) + (size_t)row * 512 + nn;
            else { const int rs = row - TOKP; kd = (u16*)(p.ws + WS_KS) + ((size_t)(l * 8 + (rs >> 5)) * 1056 + 1024 + (rs & 31)) * 512 + nn; }
            *(uint4*)kd = pack8f(v0, v1);
          }
        }
      }
    }
    if (seg == 2 || seg == 3 || seg == 4) {
      __syncthreads();
      stage_tr(acc[mi][0], acc[mi][1], stg, wm, wn, r, h);
      __syncthreads();
      write_tr(p, l, m0, mi, stg, tid, seg == 2 ? 0 : (seg == 3 ? 1 : 2), n0 - (seg == 2 ? 1024 : (seg == 3 ? 1536 : 2560)));
    }
  }
  __syncthreads();
}

DI void phase_in_gate(const Params& p, int l, unsigned char* smem) {
  const int tid = otid(), lane = tid & 63, w = tid >> 6;
  const int wm = w >> 2, wn = w & 3, r = lane & 31, h = lane >> 5;
  const u16* H = (const u16*)(p.ws + WS_H);
  const u16* Win = (const u16*)(p.ws + WS_WT_IN) + (size_t)l * 3584 * 1024;
  const u16* Wg = (const u16*)(p.ws + WS_WT_GATE) + (size_t)l * 2048 * 1024;
  float* stg = (float*)(smem + GS_BASE + GS_STAGE);
  const int NT = 14 + 8, MT = 257;
  auto ptrs = [&](int it, const u16*& ap, const u16*& bp) -> bool {
    int mt, nt;
    if (!tile_of(it, MT, NT, mt, nt)) return false;
    ap = H + (size_t)(mt * 256) * 1024;
    bp = (nt < 14 ? Win + (size_t)(nt * 256) * 1024 : Wg + (size_t)((nt - 14) * 256) * 1024);
    return true;
  };
  auto epi = [&](int it, f32x16 (&acc)[4][2]) {
    const int tid = otid(), lane = tid & 63, w = tid >> 6;
    const int wm = w >> 2, wn = w & 3, r = lane & 31, h = lane >> 5;
    int mt, nt;
    tile_of(it, MT, NT, mt, nt);
    const int m0 = mt * 256;
    if (nt < 14) {
      epi_in(p, l, m0, nt * 256, acc, smem);
    } else {
      const int n0 = (nt - 14) * 256;
      u16* G = (u16*)(p.ws + WS_G);
#pragma unroll
      for (int mi = 0; mi < 4; ++mi) {
        __syncthreads();
        stage_rm(acc[mi][0], acc[mi][1], stg, wm, wn, r, h);
        __syncthreads();
#pragma unroll 1
        for (int q = 0; q < 4; ++q) {
          const int cid = q * NTHR + tid, lr = cid >> 5, c8 = (cid & 31) * 8;
          float4 v0 = *(const float4*)(stg + lr * EP_LD + c8);
          float4 v1 = *(const float4*)(stg + lr * EP_LD + c8 + 4);
          const int row = grow_of(m0, mi, lr), n = n0 + c8;
          const float4 b0 = *(const float4*)(p.in[22] + l * 2048 + n);
          const float4 b1 = *(const float4*)(p.in[22] + l * 2048 + n + 4);
          v0 = make_float4(sigmoidf_(v0.x + b0.x), sigmoidf_(v0.y + b0.y), sigmoidf_(v0.z + b0.z), sigmoidf_(v0.w + b0.w));
          v1 = make_float4(sigmoidf_(v1.x + b1.x), sigmoidf_(v1.y + b1.y), sigmoidf_(v1.z + b1.z), sigmoidf_(v1.w + b1.w));
          *(uint4*)(G + (size_t)row * 2048 + n) = pack8f(v0, v1);
        }
      }
      __syncthreads();
    }
  };
  gemm_stream(1024, 1024, 1024, smem, ptrs, epi);
}

DI void phase_mix(const Params& p, int l, unsigned char* smem) {
  const int tid = otid(), lane = tid & 63, w = tid >> 6;
  const int wm = w >> 2, wn = w & 3, r = lane & 31, h = lane >> 5;
  const u16* G = (const u16*)(p.ws + WS_G);
  u16* MIX = (u16*)(p.ws + WS_MIX);
  float* stg = (float*)(smem + GS_BASE + GS_STAGE);
  const int NT = 4, MT = 256;
  auto ptrs = [&](int it, const u16*& ap, const u16*& bp) -> bool {
    int mt, nt;
    if (!tile_of(it >> 1, MT, NT, mt, nt)) return false;
    const int half = it & 1;
    ap = (const u16*)(p.ws + (half ? WS_MN : WS_AN)) + (size_t)(mt * 256) * 512;
    bp = (const u16*)(p.ws + (half ? WS_WT_BRB : WS_WT_BRA)) + (size_t)l * 1024 * 512 + (size_t)(nt * 256) * 512;
    return true;
  };
  auto epi = [&](int it, f32x16 (&acc)[4][2]) {
    const int tid = otid(), lane = tid & 63, w = tid >> 6;
    const int wm = w >> 2, wn = w & 3, r = lane & 31, h = lane >> 5;
    int mt, nt;
    tile_of(it >> 1, MT, NT, mt, nt);
    const int half = it & 1;
    const int m0 = mt * 256, n0 = nt * 256;
#pragma unroll
    for (int mi = 0; mi < 4; ++mi) {
      __syncthreads();
      stage_rm(acc[mi][0], acc[mi][1], stg, wm, wn, r, h);
      __syncthreads();
#pragma unroll 1
      for (int q = 0; q < 4; ++q) {
        const int cid = q * NTHR + tid, lr = cid >> 5, c8 = (cid & 31) * 8;
        const float4 v0 = *(const float4*)(stg + lr * EP_LD + c8);
        const float4 v1 = *(const float4*)(stg + lr * EP_LD + c8 + 4);
        const int row = grow_of(m0, mi, lr), n = n0 + c8;
        const uint4 g = *(const uint4*)(G + (size_t)row * 2048 + half * 1024 + n);
        float4 o0 = make_float4(bflo(g.x) * v0.x, bfhi(g.x) * v0.y, bflo(g.y) * v0.z, bfhi(g.y) * v0.w);
        float4 o1 = make_float4(bflo(g.z) * v1.x, bfhi(g.z) * v1.y, bflo(g.w) * v1.z, bfhi(g.w) * v1.w);
        uint4* mp = (uint4*)(MIX + (size_t)row * 1024 + n);
        if (half) {
          const uint4 pr = *mp;
          o0.x += bflo(pr.x); o0.y += bfhi(pr.x); o0.z += bflo(pr.y); o0.w += bfhi(pr.y);
          o1.x += bflo(pr.z); o1.y += bfhi(pr.z); o1.z += bflo(pr.w); o1.w += bfhi(pr.w);
        }
        *mp = pack8f(o0, o1);
      }
    }
    __syncthreads();
  };
  gemm_stream(512, 512, 512, smem, ptrs, epi);
  {
    const int tid2 = otid(), lane = tid2 & 63, w = tid2 >> 6, r = lane & 31, h = lane >> 5;
    float* red = (float*)(smem + 64);
    for (int mtile = blockIdx.x; mtile < 256; mtile += gridDim.x) {
      const int row0 = TOKP + (mtile >> 5) * 32, n0 = (mtile & 31) * 32;
      f32x16 pa, pb;
      zero16(pa); zero16(pb);
      micro_partial(pa, (const u16*)(p.ws + WS_AN), 512, (const u16*)(p.ws + WS_WT_BRA) + (size_t)l * 1024 * 512, 512, 512, row0, n0, w, r, h);
      micro_partial(pb, (const u16*)(p.ws + WS_MN), 512, (const u16*)(p.ws + WS_WT_BRB) + (size_t)l * 1024 * 512, 512, 512, row0, n0, w, r, h);
      __syncthreads();
      micro_reduce_store(pa, red, w, lane);
      micro_reduce_store(pb, red + 8192, w, lane);
      __syncthreads();
#pragma unroll
      for (int q = 0; q < 2; ++q) {
        const int i = w + 8 * q;
        const float sa = micro_sum(red, i, lane), sb = micro_sum(red + 8192, i, lane);
        const int row = row0 + crow(i, h), n = n0 + r;
        const float ga = bf2f(G[(size_t)row * 2048 + n]), gb = bf2f(G[(size_t)row * 2048 + 1024 + n]);
        MIX[(size_t)row * 1024 + n] = f2bf(ga * sa + gb * sb);
      }
    }
    __syncthreads();
  }
}

DI void phase_res(const Params& p, int l, int mode, unsigned char* smem) {
  const int tid = otid(), lane = tid & 63, w = tid >> 6;
  const int wm = w >> 2, wn = w & 3, r = lane & 31, h = lane >> 5;
  const float* mod = (const float*)(p.ws + WS_MOD);
  float* stg = (float*)(smem + GS_BASE + GS_STAGE);
  const int NT = 4, MT = 256;
  const int K = (mode == 0) ? 1024 : 2816;
  const u16* Ab = (const u16*)(p.ws + (mode == 0 ? WS_MIX : WS_ACT));
  const u16* Wb = (mode == 0) ? (const u16*)(p.ws + WS_WT_O) + (size_t)l * 1024 * 1024 : (const u16*)(p.ws + WS_WT_DOWN) + (size_t)l * 1024 * 2816;
  const int gi = (mode == 0) ? 2 : 5;
  auto ptrs = [&](int it, const u16*& ap, const u16*& bp) -> bool {
    int mt, nt;
    if (!tile_of(it, MT, NT, mt, nt)) return false;
    ap = Ab + (size_t)(mt * 256) * K;
    bp = Wb + (size_t)(nt * 256) * K;
    return true;
  };
  auto epi = [&](int it, f32x16 (&acc)[4][2]) {
    const int tid = otid(), lane = tid & 63, w = tid >> 6;
    const int wm = w >> 2, wn = w & 3, r = lane & 31, h = lane >> 5;
    int mt, nt;
    tile_of(it, MT, NT, mt, nt);
    const int m0 = mt * 256, n0 = nt * 256;
#pragma unroll
    for (int mi = 0; mi < 4; ++mi) {
      __syncthreads();
      stage_rm(acc[mi][0], acc[mi][1], stg, wm, wn, r, h);
      __syncthreads();
#pragma unroll 1
      for (int q = 0; q < 8; ++q) {
        const int cid = q * NTHR + tid, lr = cid >> 6, c4 = (cid & 63) * 4;
        const float4 v = *(const float4*)(stg + lr * EP_LD + c4);
        const int row = grow_of(m0, mi, lr), n = n0 + c4;
        const int b = batch_of_row(row);
        const float4 gg = *(const float4*)(mod + ((size_t)l * 40 + b) * 6144 + gi * 1024 + n);
        float* xr = p.out + (size_t)row * 1024 + n;
        const float* xs = (mode == 0 && l == 0) ? (row < TOKP ? p.in[0] + (size_t)row * 1024 + n : p.in[1] + (size_t)(row - TOKP) * 1024 + n) : xr;
        const float4 xv = *(const float4*)xs;
        *(float4*)xr = make_float4(ALPHA * xv.x + (1.f + gg.x) * v.x, ALPHA * xv.y + (1.f + gg.y) * v.y,
                                   ALPHA * xv.z + (1.f + gg.z) * v.z, ALPHA * xv.w + (1.f + gg.w) * v.w);
      }
    }
    __syncthreads();
  };
  gemm_stream(K, K, K, smem, ptrs, epi);
  {
    const int tid2 = otid(), lane = tid2 & 63, w = tid2 >> 6, r = lane & 31, h = lane >> 5;
    float* red = (float*)(smem + 64);
    for (int mtile = blockIdx.x; mtile < 256; mtile += gridDim.x) {
      const int row0 = TOKP + (mtile >> 5) * 32, n0 = (mtile & 31) * 32;
      f32x16 pa;
      zero16(pa);
      micro_partial(pa, Ab, K, Wb, K, K, row0, n0, w, r, h);
      __syncthreads();
      micro_reduce_store(pa, red, w, lane);
      __syncthreads();
#pragma unroll
      for (int q = 0; q < 2; ++q) {
        const int i = w + 8 * q;
        const float sa = micro_sum(red, i, lane);
        const int row = row0 + crow(i, h), n = n0 + r;
        const float gg = mod[((size_t)l * 40 + batch_of_row(row)) * 6144 + gi * 1024 + n];
        float* xr = p.out + (size_t)row * 1024 + n;
        const float xv = (mode == 0 && l == 0) ? p.in[1][(size_t)(row - TOKP) * 1024 + n] : *xr;
        *xr = ALPHA * xv + (1.f + gg) * sa;
      }
    }
    __syncthreads();
  }
}

DI void phase_gu(const Params& p, int l, unsigned char* smem) {
  const int tid = otid(), lane = tid & 63, w = tid >> 6;
  const int wm = w >> 2, wn = w & 3, r = lane & 31, h = lane >> 5;
  u16* ACT = (u16*)(p.ws + WS_ACT);
  const u16* Hh = (const u16*)(p.ws + WS_H);
  const u16* Wb = (const u16*)(p.ws + WS_WT_GU) + (size_t)l * 5632 * 1024;
  float* stg = (float*)(smem + GS_BASE + GS_STAGE);
  const int NT = 22, MT = 257;
  auto ptrs = [&](int it, const u16*& ap, const u16*& bp) -> bool {
    int mt, nt;
    if (!tile_of(it, MT, NT, mt, nt)) return false;
    ap = Hh + (size_t)(mt * 256) * 1024;
    bp = Wb + (size_t)(nt * 256) * 1024;
    return true;
  };
  auto epi = [&](int it, f32x16 (&acc)[4][2]) {
    const int tid = otid(), lane = tid & 63, w = tid >> 6;
    const int wm = w >> 2, wn = w & 3, r = lane & 31, h = lane >> 5;
    int mt, nt;
    tile_of(it, MT, NT, mt, nt);
    const int m0 = mt * 256, n0 = nt * 256;
#pragma unroll
    for (int mi = 0; mi < 4; ++mi) {
      __syncthreads();
      stage_rm(acc[mi][0], acc[mi][1], stg, wm, wn, r, h);
      __syncthreads();
#pragma unroll 1
      for (int q = 0; q < 2; ++q) {
        const int cid = q * NTHR + tid, lr = cid >> 4, c16 = (cid & 15) * 16;
        const float4 v0 = *(const float4*)(stg + lr * EP_LD + c16);
        const float4 v1 = *(const float4*)(stg + lr * EP_LD + c16 + 4);
        const float4 v2 = *(const float4*)(stg + lr * EP_LD + c16 + 8);
        const float4 v3 = *(const float4*)(stg + lr * EP_LD + c16 + 12);
        const int row = grow_of(m0, mi, lr);
        uint4 o;
        o.x = pack2(siluf_(v0.x) * v0.y, siluf_(v0.z) * v0.w);
        o.y = pack2(siluf_(v1.x) * v1.y, siluf_(v1.z) * v1.w);
        o.z = pack2(siluf_(v2.x) * v2.y, siluf_(v2.z) * v2.w);
        o.w = pack2(siluf_(v3.x) * v3.y, siluf_(v3.z) * v3.w);
        *(uint4*)(ACT + (size_t)row * 2816 + (n0 >> 1) + (c16 >> 1)) = o;
      }
    }
    __syncthreads();
  };
  gemm_stream(1024, 1024, 1024, smem, ptrs, epi);
}

constexpr int AT_BASE = 64;
constexpr int AT_KBYTES = 64 * 272;
constexpr int AT_VBYTES = 128 * 136;
constexpr int AT_STAGE = AT_KBYTES + AT_VBYTES;

DI void attn_item(const Params& p, int l, int b, int head, int qt, float lam, float lam_init, unsigned char* smem) {
  const int tid = otid(), lane = tid & 63, w = tid >> 6, r = lane & 31, h = lane >> 5;
  const int comp = w & 1, rg = w >> 1;
  const bool prompt = b < 32;
  const int bs = b - 32;
  const u16* Kg = prompt ? (const u16*)(p.ws + WS_KB) + (size_t)b * 2048 * 512 : (const u16*)(p.ws + WS_KS) + (size_t)(l * 8 + bs) * 1056 * 512;
  const u16* Vg = prompt ? (const u16*)(p.ws + WS_VTP) + (size_t)b * 512 * 2048 : (const u16*)(p.ws + WS_VTS) + (size_t)(l * 8 + bs) * 512 * 1056;
  const int ldT = prompt ? 2048 : 1056;
  const int nkt = prompt ? 2 * qt + 2 : 17;
  const int nkeys = prompt ? 2048 : 1056;
  const int qtok0 = prompt ? b * 2048 + qt * 128 : TOKP + bs * 32;
  const int qpos0 = prompt ? qt * 128 : 1024;
  const bool active = prompt || rg == 0;
  const int my_nkt = prompt ? (rg < 2 ? nkt - 1 : nkt) : nkt;
  const u16* ZQ = (const u16*)(p.ws + WS_ZQ);
  bf16x8 qf[4];
  {
    const int qrow = active ? qtok0 + rg * 32 + r : qtok0;
#pragma unroll
    for (int ks = 0; ks < 4; ++ks) {
      const uint4 qq = *(const uint4*)(ZQ + (size_t)qrow * 512 + head * 128 + comp * 64 + ks * 16 + h * 8);
      const float cq = 0.125f * LOG2E;
      uint4 qs_;
      qs_.x = pack2(bflo(qq.x) * cq, bfhi(qq.x) * cq); qs_.y = pack2(bflo(qq.y) * cq, bfhi(qq.y) * cq);
      qs_.z = pack2(bflo(qq.z) * cq, bfhi(qq.z) * cq); qs_.w = pack2(bflo(qq.w) * cq, bfhi(qq.w) * cq);
      qf[ks] = __builtin_bit_cast(bf16x8, qs_);
    }
  }
  const float slope2 = exp2f(-2.f * (head + 1)) * LOG2E;
  const float c1 = 0.125f * LOG2E;
  const int qpos = qpos0 + rg * 32 + r;
  f32x16 O[4];
#pragma unroll
  for (int i = 0; i < 4; ++i) zero16(O[i]);
  float m_run = -INFINITY, l_run = 0.f;

  const int krow = tid >> 4, kcc = tid & 15;
  const int vrow = tid >> 3, vcc = tid & 7;
  const u16* kp = Kg + (size_t)((nkt - 1) * 64 + krow) * 512 + head * 128 + kcc * 8;
  const u16* vp = Vg + (size_t)(head * 128 + vrow) * ldT + (nkt - 1) * 64 + vcc * 8;
  uint4 rk0, rk1, rv0, rv1;
  unsigned char* sb = smem + AT_BASE;
  rk0 = *(const uint4*)kp; rk1 = *(const uint4*)(kp + 32 * 512);
  rv0 = *(const uint4*)vp; rv1 = *(const uint4*)(vp + (size_t)64 * ldT);
  {
    *(uint4*)(sb + krow * 272 + kcc * 16) = rk0;
    *(uint4*)(sb + (krow + 32) * 272 + kcc * 16) = rk1;
    *(uint2*)(sb + AT_KBYTES + vrow * 136 + vcc * 16) = make_uint2(rv0.x, rv0.y);
    *(uint2*)(sb + AT_KBYTES + vrow * 136 + vcc * 16 + 8) = make_uint2(rv0.z, rv0.w);
    *(uint2*)(sb + AT_KBYTES + (vrow + 64) * 136 + vcc * 16) = make_uint2(rv1.x, rv1.y);
    *(uint2*)(sb + AT_KBYTES + (vrow + 64) * 136 + vcc * 16 + 8) = make_uint2(rv1.z, rv1.w);
  }
  __syncthreads();
  for (int j = 0; j < nkt; ++j) {
    const int kt = nkt - 1 - j;
    const bool more = j + 1 < nkt;
    if (more) {
      kp -= 64 * 512; vp -= 64;
      rk0 = *(const uint4*)kp; rk1 = *(const uint4*)(kp + 32 * 512);
      rv0 = *(const uint4*)vp; rv1 = *(const uint4*)(vp + (size_t)64 * ldT);
    }
    if (active && kt < my_nkt) {
      const unsigned char* Kt = sb + (j & 1) * AT_STAGE;
      const unsigned char* Vt = Kt + AT_KBYTES;
      f32x16 s[2];
      const bool past = (kt * 64 + 63) < (qpos0 + rg * 32);
      if (past) {
        const float kb0 = slope2 * (float)(kt * 64 + 4 * h);
#pragma unroll
        for (int sub = 0; sub < 2; ++sub)
#pragma unroll
          for (int i = 0; i < 16; ++i) s[sub][i] = __builtin_fmaf(slope2, (float)(sub * 32 + (i & 3) + 8 * (i >> 2)), kb0);
      } else {
        zero16(s[0]); zero16(s[1]);
      }
#pragma unroll
      for (int ks = 0; ks < 4; ++ks) {
#pragma unroll
        for (int sub = 0; sub < 2; ++sub) {
          const bf16x8 kf = *(const bf16x8*)(Kt + (sub * 32 + r) * 272 + (comp * 64 + ks * 16 + h * 8) * 2);
          s[sub] = MFMA(kf, qf[ks], s[sub]);
        }
      }
      float mx = -INFINITY;
      if (!past) {
        const float qk0 = (float)(qpos - kt * 64 - 4 * h);
        const float qb = slope2 * (float)qpos;
#pragma unroll
        for (int sub = 0; sub < 2; ++sub)
#pragma unroll
          for (int i = 0; i < 16; ++i) {
            const float d = qk0 - (float)(sub * 32 + (i & 3) + 8 * (i >> 2));
            s[sub][i] = s[sub][i] - slope2 * fabsf(d) + qb;
          }
      }
      if (!prompt) {
#pragma unroll
        for (int sub = 0; sub < 2; ++sub)
#pragma unroll
          for (int i = 0; i < 16; ++i) {
            const int key = kt * 64 + sub * 32 + crow(i, h);
            if (key >= nkeys) s[sub][i] = -INFINITY;
          }
      }
#pragma unroll
      for (int sub = 0; sub < 2; ++sub)
#pragma unroll
        for (int i = 0; i < 16; ++i) mx = fmaxf(mx, s[sub][i]);
      mx = fmaxf(mx, shx(mx, 32, lane));
      const bool livelane = !(mx - m_run < -150.f);
      if (__ballot(livelane) != 0ull) {
        const float m_new = fmaxf(m_run, mx);
        const float alpha = fexp2(m_run - m_new);
        m_run = m_new;
        float lsum = 0.f;
#pragma unroll
        for (int sub = 0; sub < 2; ++sub)
#pragma unroll
          for (int i = 0; i < 16; ++i) {
            const float pv = fexp2(s[sub][i] - m_new);
            lsum += pv;
            s[sub][i] = pv;
          }
        l_run = l_run * alpha + lsum;
        if (__ballot(alpha != 1.f) != 0ull) {
#pragma unroll
          for (int dt = 0; dt < 4; ++dt)
#pragma unroll
            for (int i = 0; i < 16; ++i) O[dt][i] *= alpha;
        }
#pragma unroll
        for (int sub = 0; sub < 2; ++sub)
#pragma unroll
          for (int s2 = 0; s2 < 2; ++s2) {
            const bf16x8 pf = pack8(s[sub], s2);
#pragma unroll
            for (int dt = 0; dt < 4; ++dt) {
              const unsigned char* va = Vt + (dt * 32 + r) * 136 + (sub * 32 + s2 * 16 + 4 * h) * 2;
              const uint2 lo = *(const uint2*)va;
              const uint2 hi = *(const uint2*)(va + 16);
              const uint4 vv = make_uint4(lo.x, lo.y, hi.x, hi.y);
              O[dt] = MFMA(__builtin_bit_cast(bf16x8, vv), pf, O[dt]);
            }
          }
      }
    }
    if (more) {
      unsigned char* sn = sb + ((j + 1) & 1) * AT_STAGE;
      *(uint4*)(sn + krow * 272 + kcc * 16) = rk0;
      *(uint4*)(sn + (krow + 32) * 272 + kcc * 16) = rk1;
      *(uint2*)(sn + AT_KBYTES + vrow * 136 + vcc * 16) = make_uint2(rv0.x, rv0.y);
      *(uint2*)(sn + AT_KBYTES + vrow * 136 + vcc * 16 + 8) = make_uint2(rv0.z, rv0.w);
      *(uint2*)(sn + AT_KBYTES + (vrow + 64) * 136 + vcc * 16) = make_uint2(rv1.x, rv1.y);
      *(uint2*)(sn + AT_KBYTES + (vrow + 64) * 136 + vcc * 16 + 8) = make_uint2(rv1.z, rv1.w);
    }
    __syncthreads();
  }
  float* exch = (float*)(smem + AT_BASE);
  float inv = 0.f;
  if (active) { const float lt = l_run + shx(l_run, 32, lane); inv = 1.f / lt; }
  if (active && comp == 1) {
    const float sc = inv * lam;
#pragma unroll
    for (int dt = 0; dt < 4; ++dt)
#pragma unroll
      for (int i = 0; i < 16; ++i) exch[(rg * 64 + dt * 16 + i) * 64 + lane] = O[dt][i] * sc;
  }
  __syncthreads();
  if (active && comp == 0) {
    float ss = 0.f;
#pragma unroll
    for (int dt = 0; dt < 4; ++dt)
#pragma unroll
      for (int i = 0; i < 16; ++i) {
        const float o = O[dt][i] * inv - exch[(rg * 64 + dt * 16 + i) * 64 + lane];
        O[dt][i] = o;
        ss += o * o;
      }
    ss += shx(ss, 32, lane);
    const float rs = rsqrtf(ss * (1.f / 128.f) + LN_EPS) * (1.f - lam_init);
    u16* AN = (u16*)(p.ws + WS_AN) + (size_t)(qtok0 + rg * 32 + r) * 512 + head * 128;
    const float* gw = p.in[17] + l * 512 + head * 128;
#pragma unroll
    for (int dt = 0; dt < 4; ++dt)
#pragma unroll
      for (int g = 0; g < 4; ++g) {
        const int dv = dt * 32 + 8 * g + 4 * h;
        const float4 g4 = *(const float4*)(gw + dv);
        uint2 o;
        o.x = pack2(O[dt][4 * g] * rs * g4.x, O[dt][4 * g + 1] * rs * g4.y);
        o.y = pack2(O[dt][4 * g + 2] * rs * g4.z, O[dt][4 * g + 3] * rs * g4.w);
        *(uint2*)(AN + dv) = o;
      }
  }
}

constexpr int ML_QS = 64;
constexpr int ML_KS = ML_QS + 64 * 272;
constexpr int ML_KT = ML_KS + 64 * 272;
constexpr int ML_VT = ML_KT + 128 * 144;
constexpr int ML_CB = ML_VT + 128 * 144;
constexpr int ML_HB = ML_CB + 128 * 272;
constexpr int ML_SM = ML_HB + 64 * 132 * 4;
static_assert(ML_SM + 528 * 4 <= LDS_BYTES, "lds");

DI void mlstm_item(const Params& p, int l, int b, int head, unsigned char* smem) {
  const int tid = otid(), lane = tid & 63, w = tid >> 6, r = lane & 31, h = lane >> 5;
  const bool prompt = b < 32;
  const int bs = b - 32;
  const int T = prompt ? 2048 : 32;
  const int nch = prompt ? 32 : 1;
  const int L = prompt ? 64 : 32;
  const int tokbase = prompt ? b * 2048 : TOKP + bs * 32;
  const u16* qkT = prompt ? (const u16*)(p.ws + WS_MQKT_P) + (size_t)b * 1024 * 2048 : (const u16*)(p.ws + WS_MQKT_S) + (size_t)bs * 1024 * 32;
  const u16* vTg = prompt ? (const u16*)(p.ws + WS_MVT_P) + (size_t)b * 512 * 2048 : (const u16*)(p.ws + WS_MVT_S) + (size_t)bs * 512 * 32;
  u16* qs = (u16*)(smem + ML_QS);
  u16* ksm = (u16*)(smem + ML_KS);
  u16* kTw = (u16*)(smem + ML_KT);
  u16* vT = (u16*)(smem + ML_VT);
  u16* Cbf = (u16*)(smem + ML_CB);
  float* hbuf = (float*)(smem + ML_HB);
  float* a_s = (float*)(smem + ML_SM);
  float* mx_s = a_s + 64;
  float* ws_s = a_s + 128;
  float* wi_s = a_s + 192;
  float* emt_s = a_s + 256;
  float* nq_s = a_s + 320;
  float* nvec = a_s + 384;
  float* scal = a_s + 512;

  const int vt = w & 3, kt0 = (w >> 2) * 2;
  f32x16 accC[2];
  float m_run = 0.f;
  if (prompt) {
    zero16(accC[0]); zero16(accC[1]);
    if (tid < 128) nvec[tid] = 0.f;
  } else {
    const float* Cs = p.in[6] + ((size_t)(l * 8 + bs) * 4 + head) * 128 * 128;
#pragma unroll
    for (int q = 0; q < 2; ++q)
#pragma unroll
      for (int g = 0; g < 4; ++g) {
        const float4 c4 = *(const float4*)(Cs + (size_t)(vt * 32 + r) * 128 + (kt0 + q) * 32 + 8 * g + 4 * h);
        accC[q][4 * g] = c4.x; accC[q][4 * g + 1] = c4.y; accC[q][4 * g + 2] = c4.z; accC[q][4 * g + 3] = c4.w;
      }
    if (tid < 128) nvec[tid] = p.in[7][((size_t)(l * 8 + bs) * 4 + head) * 128 + tid];
    m_run = p.in[8][(l * 8 + bs) * 4 + head];
  }
#pragma unroll
  for (int q = 0; q < 2; ++q)
#pragma unroll
    for (int g = 0; g < 4; ++g) {
      uint2 o; o.x = pack2(accC[q][4 * g], accC[q][4 * g + 1]); o.y = pack2(accC[q][4 * g + 2], accC[q][4 * g + 3]);
      *(uint2*)(Cbf + (vt * 32 + r) * 136 + (kt0 + q) * 32 + 8 * g + 4 * h) = o;
    }
  const float* gatesp = (const float*)(p.ws + WS_GATES);
  const int vi = w >> 1, ti = w & 1;

  float ig_n = -INFINITY, fg_n = 0.f;
  if (w == 0 && lane < L) {
    const float* gp = gatesp + (size_t)(tokbase + lane) * 8;
    ig_n = gp[head]; fg_n = gp[4 + head];
  }
  for (int c = 0; c < nch; ++c) {
    const int t0 = c * 64;
    if (w == 0) {
      const int t = lane;
      float ig = -INFINITY, lf = 0.f;
      if (t < L) {
        ig = ig_n;
        const float fg = fg_n;
        lf = fminf(fg, 0.f) - log1pf(__expf(-fabsf(fg)));
        if (c + 1 < nch) {
          const float* gp = gatesp + (size_t)(tokbase + t0 + 64 + t) * 8;
          ig_n = gp[head]; fg_n = gp[4 + head];
        }
      }
      float bc = lf;
#pragma unroll
      for (int off = 1; off < 64; off <<= 1) { const float v = shidx(bc, lane - off, lane); if (lane >= off) bc += v; }
      const float a = ig - bc;
      float M = a;
#pragma unroll
      for (int off = 1; off < 64; off <<= 1) { const float v = shidx(M, lane - off, lane); if (lane >= off) M = fmaxf(M, v); }
      const float mx = fmaxf(m_run, M);
      const float bL = shidx(bc, 63, lane);
      const float mxL = shidx(mx, 63, lane);
      a_s[t] = a; mx_s[t] = mx;
      ws_s[t] = __expf(a - mxL);
      wi_s[t] = __expf(m_run - mx);
      emt_s[t] = __expf(-(bc + mx));
      if (lane == 0) scal[1] = __expf(m_run - mxL);
      m_run = bL + mxL;
    }
    const int ch2 = tid >> 1, th = tid & 1;
    const bool isk = ch2 >= 128;
    const int dd = ch2 & 127;
    const int ch = (isk ? 512 : 0) + head * 128 + dd;
    const u16* rp = qkT + (size_t)ch * T + t0 + th * 32;
    float um3 = 0.f, um2 = 0.f, um1 = 0.f;
    const bool ldrow = prompt || th == 0;
    uint4 uu0 = make_uint4(0, 0, 0, 0), uu1 = uu0, uu2 = uu0, uu3 = uu0, vv0 = uu0, vv1 = uu0;
    if (ldrow) { uu0 = *(const uint4*)(rp); uu1 = *(const uint4*)(rp + 8); uu2 = *(const uint4*)(rp + 16); uu3 = *(const uint4*)(rp + 24); }
    {
      const int row = tid >> 3, cc = tid & 7;
      if (prompt || cc < 4) {
        vv0 = *(const uint4*)(vTg + (size_t)(head * 128 + row) * T + t0 + cc * 8);
        vv1 = *(const uint4*)(vTg + (size_t)(head * 128 + row + 64) * T + t0 + cc * 8);
      }
    }
    if (prompt) {
      if (th == 1 || c > 0) {
        const uint2 pv = *(const uint2*)(rp - 4);
        um3 = bfhi(pv.x); um2 = bflo(pv.y); um1 = bfhi(pv.y);
      }
    } else if (th == 0) {
      const float* cvp = p.in[9] + (size_t)(l * 8 + bs) * 3 * 1024 + ch;
      um3 = cvp[0]; um2 = cvp[1024]; um1 = cvp[2048];
    }
    const float cw0 = p.in[14][(l * 4 + 0) * 1024 + ch], cw1 = p.in[14][(l * 4 + 1) * 1024 + ch];
    const float cw2 = p.in[14][(l * 4 + 2) * 1024 + ch], cw3 = p.in[14][(l * 4 + 3) * 1024 + ch];
    const float cb = p.in[15][l * 1024 + ch];
    __syncthreads();
    {
      u16* dstrm = (isk ? ksm : qs) + (th * 32) * 136 + dd;
      const float oscale = isk ? 0.08838834764831845f : 1.f;
#pragma unroll
      for (int i = 0; i < 4; ++i) {
        const uint4 uu = (i == 0) ? uu0 : (i == 1 ? uu1 : (i == 2 ? uu2 : uu3));
        float u[8];
        u[0] = bflo(uu.x); u[1] = bfhi(uu.x); u[2] = bflo(uu.y); u[3] = bfhi(uu.y);
        u[4] = bflo(uu.z); u[5] = bfhi(uu.z); u[6] = bflo(uu.w); u[7] = bfhi(uu.w);
        float y[8];
#pragma unroll
        for (int e = 0; e < 8; ++e) {
          const float x3 = (e >= 3) ? u[e - 3] : (e == 0 ? um3 : (e == 1 ? um2 : um1));
          const float x2 = (e >= 2) ? u[e - 2] : (e == 0 ? um2 : um1);
          const float x1 = (e >= 1) ? u[e - 1] : um1;
          const float yy = cb + cw0 * x3 + cw1 * x2 + cw2 * x1 + cw3 * u[e];
          y[e] = siluf_(yy) * oscale;
        }
        um3 = u[5]; um2 = u[6]; um1 = u[7];
#pragma unroll
        for (int e = 0; e < 8; ++e) dstrm[(i * 8 + e) * 136] = f2bf(y[e]);
        if (isk) {
          const float4 w0 = *(const float4*)(ws_s + th * 32 + i * 8);
          const float4 w1 = *(const float4*)(ws_s + th * 32 + i * 8 + 4);
          uint4 o;
          o.x = pack2(y[0] * w0.x, y[1] * w0.y); o.y = pack2(y[2] * w0.z, y[3] * w0.w);
          o.z = pack2(y[4] * w1.x, y[5] * w1.y); o.w = pack2(y[6] * w1.z, y[7] * w1.w);
          *(uint4*)(kTw + dd * 72 + th * 32 + i * 8) = o;
        }
      }
      {
        const int row = tid >> 3, cc = tid & 7;
        *(uint4*)(vT + row * 72 + cc * 8) = vv0;
        *(uint4*)(vT + (row + 64) * 72 + cc * 8) = vv1;
      }
    }
    __syncthreads();
    {
      const int t = tid >> 3, part = tid & 7;
      const uint4 q0 = *(const uint4*)(qs + t * 136 + part * 16);
      const uint4 q1 = *(const uint4*)(qs + t * 136 + part * 16 + 8);
      const float* nv = nvec + part * 16;
      float s = bflo(q0.x) * nv[0] + bfhi(q0.x) * nv[1] + bflo(q0.y) * nv[2] + bfhi(q0.y) * nv[3]
              + bflo(q0.z) * nv[4] + bfhi(q0.z) * nv[5] + bflo(q0.w) * nv[6] + bfhi(q0.w) * nv[7]
              + bflo(q1.x) * nv[8] + bfhi(q1.x) * nv[9] + bflo(q1.y) * nv[10] + bfhi(q1.y) * nv[11]
              + bflo(q1.z) * nv[12] + bfhi(q1.z) * nv[13] + bflo(q1.w) * nv[14] + bfhi(q1.w) * nv[15];
      s += shx(s, 1, lane); s += shx(s, 2, lane); s += shx(s, 4, lane);
      if (part == 0) nq_s[t] = s;
    }
    f32x16 accS[2], accO;
    zero16(accS[0]); zero16(accS[1]); zero16(accO);
    {
#pragma unroll
      for (int ks = 0; ks < 8; ++ks) {
        const bf16x8 qfr = *(const bf16x8*)(qs + (ti * 32 + r) * 136 + ks * 16 + h * 8);
        const bf16x8 k0 = *(const bf16x8*)(ksm + r * 136 + ks * 16 + h * 8);
        accS[0] = MFMA(k0, qfr, accS[0]);
        if (ti == 1) {
          const bf16x8 k1 = *(const bf16x8*)(ksm + (32 + r) * 136 + ks * 16 + h * 8);
          accS[1] = MFMA(k1, qfr, accS[1]);
        }
        const bf16x8 cf = *(const bf16x8*)(Cbf + (vi * 32 + r) * 136 + ks * 16 + h * 8);
        accO = MFMA(cf, qfr, accO);
      }
    }
    const int tcol = ti * 32 + r;
    const float mxt = mx_s[tcol];
    const float wit = wi_s[tcol];
    float dsum = 0.f;
#pragma unroll
    for (int sub = 0; sub < 2; ++sub) {
      if (sub <= ti) {
#pragma unroll
        for (int g = 0; g < 4; ++g) {
          const float4 a4 = *(const float4*)(a_s + sub * 32 + 8 * g + 4 * h);
          const float av[4] = {a4.x, a4.y, a4.z, a4.w};
#pragma unroll
          for (int e = 0; e < 4; ++e) {
            const int s = sub * 32 + 8 * g + 4 * h + e;
            const float wgt = (s <= tcol) ? __expf(av[e] - mxt) : 0.f;
            const float pv = accS[sub][4 * g + e] * wgt;
            accS[sub][4 * g + e] = pv;
            dsum += pv;
          }
        }
      }
    }
    dsum += shx(dsum, 32, lane);
#pragma unroll
    for (int i = 0; i < 16; ++i) accO[i] *= wit;
#pragma unroll
    for (int sub = 0; sub < 2; ++sub) {
      if (sub <= ti) {
#pragma unroll
        for (int s2 = 0; s2 < 2; ++s2) {
          const bf16x8 pf = pack8(accS[sub], s2);
          const u16* va = vT + (vi * 32 + r) * 72 + sub * 32 + s2 * 16 + 4 * h;
          const uint2 lo = *(const uint2*)va;
          const uint2 hi = *(const uint2*)(va + 8);
          const uint4 vq = make_uint4(lo.x, lo.y, hi.x, hi.y);
          accO = MFMA(__builtin_bit_cast(bf16x8, vq), pf, accO);
        }
      }
    }
    __syncthreads();
    {
      const float den = dsum + wit * nq_s[tcol];
      const float dn = fmaxf(fabsf(den), emt_s[tcol]);
      const float rinv = 1.f / dn;
#pragma unroll
      for (int g = 0; g < 4; ++g)
        *(float4*)(hbuf + tcol * 132 + vi * 32 + 8 * g + 4 * h) =
            make_float4(accO[4 * g] * rinv, accO[4 * g + 1] * rinv, accO[4 * g + 2] * rinv, accO[4 * g + 3] * rinv);
    }
    {
      const float wc = scal[1];
#pragma unroll
      for (int q = 0; q < 2; ++q)
#pragma unroll
        for (int i = 0; i < 16; ++i) accC[q][i] *= wc;
#pragma unroll
      for (int k4 = 0; k4 < 4; ++k4) {
        const bf16x8 vf = *(const bf16x8*)(vT + (vt * 32 + r) * 72 + k4 * 16 + h * 8);
#pragma unroll
        for (int q = 0; q < 2; ++q) {
          const bf16x8 kf = *(const bf16x8*)(kTw + ((kt0 + q) * 32 + r) * 72 + k4 * 16 + h * 8);
          accC[q] = MFMA(kf, vf, accC[q]);
        }
      }
#pragma unroll
      for (int q = 0; q < 2; ++q)
#pragma unroll
        for (int g = 0; g < 4; ++g) {
          uint2 o; o.x = pack2(accC[q][4 * g], accC[q][4 * g + 1]); o.y = pack2(accC[q][4 * g + 2], accC[q][4 * g + 3]);
          *(uint2*)(Cbf + (vt * 32 + r) * 136 + (kt0 + q) * 32 + 8 * g + 4 * h) = o;
        }
      if (tid < 128) {
        float s = 0.f;
#pragma unroll
        for (int i = 0; i < 8; ++i) {
          const uint4 kk = *(const uint4*)(kTw + tid * 72 + i * 8);
          s += bflo(kk.x) + bfhi(kk.x) + bflo(kk.y) + bfhi(kk.y) + bflo(kk.z) + bfhi(kk.z) + bflo(kk.w) + bfhi(kk.w);
        }
        nvec[tid] = wc * nvec[tid] + s;
      }
    }
    __syncthreads();
    {
      const int t = tid >> 3, part = tid & 7;
      float x[16];
#pragma unroll
      for (int i = 0; i < 4; ++i) {
        const float4 f = *(const float4*)(hbuf + t * 132 + part * 16 + i * 4);
        x[i * 4] = f.x; x[i * 4 + 1] = f.y; x[i * 4 + 2] = f.z; x[i * 4 + 3] = f.w;
      }
      float s = 0.f;
#pragma unroll
      for (int i = 0; i < 16; ++i) s += x[i];
      s += shx(s, 1, lane); s += shx(s, 2, lane); s += shx(s, 4, lane);
      const float mean = s * (1.f / 128.f);
      float q = 0.f;
#pragma unroll
      for (int i = 0; i < 16; ++i) { x[i] -= mean; q += x[i] * x[i]; }
      q += shx(q, 1, lane); q += shx(q, 2, lane); q += shx(q, 4, lane);
      const float rstd = rsqrtf(q * (1.f / 128.f) + LN_EPS);
      if (t < L) {
        const size_t tok = (size_t)tokbase + t0 + t;
        const int cbase = head * 128 + part * 16;
        const float* gw = p.in[18] + l * 512 + cbase;
        const u16* mo = (const u16*)(p.ws + WS_MO) + tok * 512 + cbase;
        const uint4 m0 = *(const uint4*)mo;
        const uint4 m1 = *(const uint4*)(mo + 8);
        const float sg[16] = {bflo(m0.x), bfhi(m0.x), bflo(m0.y), bfhi(m0.y), bflo(m0.z), bfhi(m0.z), bflo(m0.w), bfhi(m0.w),
                              bflo(m1.x), bfhi(m1.x), bflo(m1.y), bfhi(m1.y), bflo(m1.z), bfhi(m1.z), bflo(m1.w), bfhi(m1.w)};
        float yv[16];
#pragma unroll
        for (int i = 0; i < 16; ++i) yv[i] = x[i] * rstd * gw[i] * sg[i];
        uint4 o0, o1;
        o0.x = pack2(yv[0], yv[1]); o0.y = pack2(yv[2], yv[3]); o0.z = pack2(yv[4], yv[5]); o0.w = pack2(yv[6], yv[7]);
        o1.x = pack2(yv[8], yv[9]); o1.y = pack2(yv[10], yv[11]); o1.z = pack2(yv[12], yv[13]); o1.w = pack2(yv[14], yv[15]);
        u16* mn = (u16*)(p.ws + WS_MN) + tok * 512 + cbase;
        *(uint4*)mn = o0;
        *(uint4*)(mn + 8) = o1;
      }
    }
  }
  {
    float* oc = p.out + (prompt ? O_CP + ((size_t)(l * 32 + b) * 4 + head) * 16384 : O_CS + ((size_t)(l * 8 + bs) * 4 + head) * 16384);
#pragma unroll
    for (int q = 0; q < 2; ++q)
#pragma unroll
      for (int g = 0; g < 4; ++g)
        *(float4*)(oc + (size_t)(vt * 32 + r) * 128 + (kt0 + q) * 32 + 8 * g + 4 * h) =
            make_float4(accC[q][4 * g], accC[q][4 * g + 1], accC[q][4 * g + 2], accC[q][4 * g + 3]);
    float* on = p.out + (prompt ? O_NP + ((size_t)(l * 32 + b) * 4 + head) * 128 : O_NS + ((size_t)(l * 8 + bs) * 4 + head) * 128);
    if (tid < 128) on[tid] = nvec[tid];
    if (tid == 0) {
      if (prompt) p.out[O_MP + (size_t)(l * 32 + b) * 4 + head] = m_run;
      else p.out[O_MS + (size_t)(l * 8 + bs) * 4 + head] = m_run;
    }
  }
}

DI void phase_mixers(const Params& p, int l, unsigned char* smem) {
  const int tid0 = otid();
  const int lane = tid0 & 63;
  const float* lp = p.in[16] + l * 256;
  float s1 = lp[lane] * lp[64 + lane], s2 = lp[128 + lane] * lp[192 + lane];
  s1 = wave_sum(s1, lane); s2 = wave_sum(s2, lane);
  const float lam_init = 0.8f - 0.6f * expf(-0.3f * (float)l);
  const float lam = expf(s1) - expf(s2) + lam_init;
  int* ctr = (int*)(p.ws + WS_CTR) + l;
  int* sitem = (int*)smem;
  const int N_ML = 160, N_AT = 2048 + 32;
  for (;;) {
    __syncthreads();
    if (tid0 == 0) *sitem = atomicAdd(ctr, 1);
    __syncthreads();
    const int item = *sitem;
    if (item >= N_ML + N_AT) break;
    if (item < N_ML) {
#ifndef NO_ML
      mlstm_item(p, l, item >> 2, item & 3, smem);
#endif
    } else {
#ifndef NO_AT
      const int a = item - N_ML;
      if (a < 2048) {
        const int qt = 15 - (a >> 7), rest = a & 127;
        attn_item(p, l, rest >> 2, rest & 3, qt, lam, lam_init, smem);
      } else {
        const int s = a - 2048;
        attn_item(p, l, 32 + (s >> 2), s & 3, 0, lam, lam_init, smem);
      }
#endif
    }
  }
}

DI void gbar(unsigned* ctl, unsigned& k) {
  __syncthreads();
  ++k;
  if (otid() == 0) {
    __threadfence();
    const unsigned x = blockIdx.x & 7;
    const unsigned gsz = (gridDim.x + 7 - x) >> 3;
    const unsigned ngroups = gridDim.x < 8 ? gridDim.x : 8;
    unsigned* gc = ctl + 64 + x * 32;
    unsigned* gl = ctl + 32;
    const unsigned old = __hip_atomic_fetch_add(gc, 1u, __ATOMIC_RELAXED, __HIP_MEMORY_SCOPE_AGENT);
    if (old + 1 == k * gsz) {
      __threadfence();
      __hip_atomic_fetch_add(gl, 1u, __ATOMIC_RELAXED, __HIP_MEMORY_SCOPE_AGENT);
    }
    while (__hip_atomic_load(gl, __ATOMIC_RELAXED, __HIP_MEMORY_SCOPE_AGENT) < k * ngroups) __builtin_amdgcn_s_sleep(1);
    __threadfence();
  }
  __syncthreads();
}

__global__ void __launch_bounds__(NTHR) fwd_megakernel(Params p) {
  extern __shared__ __attribute__((aligned(16))) unsigned char smem[];
  cg::grid_group grid = cg::this_grid();
#ifndef PH
#define PH 0xffff
#endif
  unsigned* bar = (unsigned*)(p.ws + WS_CTR);
  unsigned epoch = 0;
  if (PH & 1) prologue(p, smem);
  grid.sync();
  if (PH & 1) prologue(p, smem);
  grid.sync();
  if (PH & 2) ln_pass(p, 0, 0, smem);
  gbar(bar, epoch);
#pragma unroll 1
  for (int l = 0; l < 2; ++l) {
    if (PH & 4) phase_in_gate(p, l, smem);
    gbar(bar, epoch);
    if (PH & 8) phase_mixers(p, l, smem);
    gbar(bar, epoch);
    if (PH & 16) phase_mix(p, l, smem);
    gbar(bar, epoch);
    if (PH & 32) phase_res(p, l, 0, smem);
    gbar(bar, epoch);
    if (PH & 64) ln_pass(p, 1, l, smem);
    gbar(bar, epoch);
    if (PH & 128) phase_gu(p, l, smem);
    gbar(bar, epoch);
    if (PH & 256) phase_res(p, l, 1, smem);
    gbar(bar, epoch);
    if (PH & 512) ln_pass(p, 2, l, smem);
    if (l == 0) gbar(bar, epoch);
  }
}

extern "C" void kernel_launch(void* const* d_in, const int* in_sizes, int n_in, void* d_out, int out_size, void* d_ws,
                              size_t ws_size, hipStream_t stream) {
  static int grid_blocks = 0;
  if (!grid_blocks) {
    int dev = 0, cus = 0, per_cu = 0;
    hipGetDevice(&dev);
    hipDeviceGetAttribute(&cus, hipDeviceAttributeMultiprocessorCount, dev);
    if (hipFuncSetAttribute((const void*)fwd_megakernel, hipFuncAttributeMaxDynamicSharedMemorySize, LDS_BYTES) != hipSuccess)
      fprintf(stderr, "kernel_launch: hipFuncSetAttribute failed\n");
    if (hipOccupancyMaxActiveBlocksPerMultiprocessor(&per_cu, (const void*)fwd_megakernel, NTHR, LDS_BYTES) != hipSuccess || per_cu < 1) {
      fprintf(stderr, "kernel_launch: occupancy query gave %d\n", per_cu);
      per_cu = 1;
    }
    (void)hipGetLastError();
    grid_blocks = cus * per_cu;
    if (ws_size < WS_END) fprintf(stderr, "kernel_launch: workspace too small: %zu < %zu\n", ws_size, (size_t)WS_END);
  }
  if (hipMemsetAsync((char*)d_ws + WS_CTR, 0, 4096, stream) != hipSuccess) fprintf(stderr, "kernel_launch: memset failed\n");
  Params p{};
  for (int i = 0; i < 30; ++i) p.in[i] = (const float*)d_in[i];
  p.out = (float*)d_out;
  p.ws = (unsigned char*)d_ws;
  void* args[] = {&p};
  hipError_t e = hipLaunchCooperativeKernel((const void*)fwd_megakernel, dim3(grid_blocks), dim3(NTHR), args, LDS_BYTES, stream);
  if (e != hipSuccess) fprintf(stderr, "cooperative launch failed: %s (grid %d)\n", hipGetErrorString(e), grid_blocks);
}
```

```cpp
#include <hip/hip_runtime.h>
#include <hip/hip_cooperative_groups.h>
#include <cstdio>
namespace cg = cooperative_groups;

#define DI __device__ __forceinline__
typedef unsigned short u16;
using bf16x8 = __attribute__((ext_vector_type(8))) short;
using f32x16 = __attribute__((ext_vector_type(16))) float;
#define MFMA(a, b, c) __builtin_amdgcn_mfma_f32_32x32x16_bf16((a), (b), (c), 0, 0, 0)

constexpr int TOKP = 65536, TOKS = 256, TOK = 65792;
constexpr int NTHR = 512;
constexpr float LN_EPS = 1e-5f;
constexpr float ALPHA = 1.41421356237f;
constexpr float LOG2E = 1.44269504089f;

constexpr size_t WS_WT_IN   = 0;
constexpr size_t WS_WT_GATE = WS_WT_IN + 2ull * 3584 * 1024 * 2;
constexpr size_t WS_WT_BRA  = WS_WT_GATE + 2ull * 2048 * 1024 * 2;
constexpr size_t WS_WT_BRB  = WS_WT_BRA + 2ull * 1024 * 512 * 2;
constexpr size_t WS_WT_O    = WS_WT_BRB + 2ull * 1024 * 512 * 2;
constexpr size_t WS_WT_GU   = WS_WT_O + 2ull * 1024 * 1024 * 2;
constexpr size_t WS_WT_DOWN = WS_WT_GU + 2ull * 5632 * 1024 * 2;
constexpr size_t WS_MOD     = WS_WT_DOWN + 2ull * 1024 * 2816 * 2;
constexpr size_t WS_GATES   = WS_MOD + 2ull * 40 * 6144 * 4;
constexpr size_t WS_CTR     = WS_GATES + (size_t)TOK * 8 * 4;
constexpr size_t WS_KS      = WS_CTR + 4096;
constexpr size_t WS_VTS     = WS_KS + 2ull * 8 * 1056 * 512 * 2 + 65536;
constexpr size_t WS_MQKT_S  = WS_VTS + 2ull * 8 * 512 * 1056 * 2 + 65536;
constexpr size_t WS_MVT_S   = WS_MQKT_S + 8ull * 1024 * 32 * 2;
constexpr size_t WS_H       = WS_MVT_S + 8ull * 512 * 32 * 2;
constexpr size_t WS_AN      = WS_H;
constexpr size_t WS_MN      = WS_H + (size_t)TOK * 512 * 2;
constexpr size_t WS_ZQ      = WS_H + (size_t)TOK * 1024 * 2;
constexpr size_t WS_KB      = WS_ZQ + (size_t)TOK * 512 * 2;
constexpr size_t WS_VTP     = WS_KB + (size_t)TOKP * 512 * 2;
constexpr size_t WS_MQKT_P  = WS_VTP + 32ull * 512 * 2048 * 2;
constexpr size_t WS_MVT_P   = WS_MQKT_P + 32ull * 1024 * 2048 * 2;
constexpr size_t WS_MO      = WS_MVT_P + 32ull * 512 * 2048 * 2;
constexpr size_t WS_G       = WS_MO + (size_t)TOK * 512 * 2;
constexpr size_t WS_END     = WS_G + (size_t)TOK * 2048 * 2;
constexpr size_t WS_MIX     = WS_ZQ;
constexpr size_t WS_ACT     = WS_ZQ;

constexpr size_t O_YP  = 0;
constexpr size_t O_YS  = O_YP + (size_t)TOKP * 1024;
constexpr size_t O_KP  = O_YS + (size_t)TOKS * 1024;
constexpr size_t O_VP  = O_KP + 2ull * TOKP * 512;
constexpr size_t O_KSM = O_VP + 2ull * TOKP * 512;
constexpr size_t O_VSM = O_KSM + 2ull * TOKS * 512;
constexpr size_t O_CP  = O_VSM + 2ull * TOKS * 512;
constexpr size_t O_NP  = O_CP + 2ull * 32 * 4 * 128 * 128;
constexpr size_t O_MP  = O_NP + 2ull * 32 * 4 * 128;
constexpr size_t O_CVP = O_MP + 2ull * 32 * 4;
constexpr size_t O_CS  = O_CVP + 2ull * 32 * 3 * 1024;
constexpr size_t O_NS  = O_CS + 2ull * 8 * 4 * 128 * 128;
constexpr size_t O_MS  = O_NS + 2ull * 8 * 4 * 128;
constexpr size_t O_CVS = O_MS + 2ull * 8 * 4;

constexpr int LDS_BYTES = 148480;

struct Params {
  const float* in[30];
  float* out;
  unsigned char* ws;
};

DI u16 f2bf(float x) { unsigned u = __float_as_uint(x); u += 0x7fffu + ((u >> 16) & 1u); return (u16)(u >> 16); }
DI float bf2f(unsigned v) { return __uint_as_float(v << 16); }
typedef __bf16 bf16x2_t __attribute__((ext_vector_type(2)));
typedef float f32x2_t __attribute__((ext_vector_type(2)));
DI unsigned pack2(float a, float b) {
  f32x2_t v = {a, b};
  return __builtin_bit_cast(unsigned, __builtin_convertvector(v, bf16x2_t));
}
DI float bflo(unsigned v) { return __uint_as_float(v << 16); }
DI float bfhi(unsigned v) { return __uint_as_float(v & 0xffff0000u); }
DI float sigmoidf_(float x) { return 1.f / (1.f + __expf(-x)); }
DI float siluf_(float x) { return x / (1.f + __expf(-x)); }
DI float fexp2(float x) { return __builtin_amdgcn_exp2f(x); }
DI int otid() { int t = threadIdx.x; asm volatile("" : "+v"(t)); return t; }
DI float shx(float v, int mask, int lane) { return __int_as_float(__builtin_amdgcn_ds_bpermute(((lane ^ mask) & 63) << 2, __float_as_int(v))); }
DI float shidx(float v, int src, int lane) { (void)lane; return __int_as_float(__builtin_amdgcn_ds_bpermute((src & 63) << 2, __float_as_int(v))); }
DI int crow(int i, int h) { return (i & 3) + 8 * (i >> 2) + 4 * h; }
DI bf16x8 pack8(const f32x16& x, int s) {
  uint4 u;
  u.x = pack2(x[8 * s + 0], x[8 * s + 1]); u.y = pack2(x[8 * s + 2], x[8 * s + 3]);
  u.z = pack2(x[8 * s + 4], x[8 * s + 5]); u.w = pack2(x[8 * s + 6], x[8 * s + 7]);
  return __builtin_bit_cast(bf16x8, u);
}
DI void zero16(f32x16& a) {
#pragma unroll
  for (int i = 0; i < 16; ++i) a[i] = 0.f;
}
DI int batch_of_row(int row) { return row < TOKP ? (row >> 11) : 32 + ((row - TOKP) >> 5); }

constexpr int GS_STRIDE = 144;
constexpr int GS_STAGE = 512 * GS_STRIDE;
constexpr int GS_BASE = 64;

DI void gemm_mainloop(f32x16 (&acc)[4][2], const u16* __restrict__ A, int lda, const u16* __restrict__ Wt, int ldw, int K,
                      int m0, int n0, unsigned char* smem) {
  const int tid = otid(), lane = tid & 63, w = tid >> 6;
  const int wm = w >> 2, wn = w & 3, r = lane & 31, h = lane >> 5;
  const int lrow = tid >> 3, lcc = tid & 7;
  const u16* ap = A + (size_t)(m0 + lrow) * lda + lcc * 8;
  const int bn = n0 + 2 * (lrow & 31) + ((lrow >> 5) & 1);
  const u16* bp = Wt + (size_t)bn * ldw + lcc * 8;
  const size_t astep = (size_t)64 * lda, bstep = (size_t)64 * ldw;
  unsigned char* sbase = smem + GS_BASE;
  const int woff = lrow * GS_STRIDE + lcc * 16;
  const int nk = K >> 6;
  uint4 s0, s1, s2, s3, s4, s5, s6, s7, u0, u1, u2, u3, u4, u5, u6, u7;
  int kn = 1;
#define G_ADV() do { const int adv = (kn < nk) ? 64 : 0; ap += adv; bp += adv; ++kn; } while (0)
#define G_ISSUE_A() do { s0 = *(const uint4*)(ap); s1 = *(const uint4*)(ap + astep); s2 = *(const uint4*)(ap + 2 * astep); s3 = *(const uint4*)(ap + 3 * astep); \
    s4 = *(const uint4*)(bp); s5 = *(const uint4*)(bp + bstep); s6 = *(const uint4*)(bp + 2 * bstep); s7 = *(const uint4*)(bp + 3 * bstep); } while (0)
#define G_ISSUE_B() do { u0 = *(const uint4*)(ap); u1 = *(const uint4*)(ap + astep); u2 = *(const uint4*)(ap + 2 * astep); u3 = *(const uint4*)(ap + 3 * astep); \
    u4 = *(const uint4*)(bp); u5 = *(const uint4*)(bp + bstep); u6 = *(const uint4*)(bp + 2 * bstep); u7 = *(const uint4*)(bp + 3 * bstep); } while (0)
#define G_WRITE_A(sn) do { *(uint4*)((sn) + woff) = s0; *(uint4*)((sn) + woff + 64 * GS_STRIDE) = s1; *(uint4*)((sn) + woff + 128 * GS_STRIDE) = s2; \
    *(uint4*)((sn) + woff + 192 * GS_STRIDE) = s3; *(uint4*)((sn) + woff + 256 * GS_STRIDE) = s4; *(uint4*)((sn) + woff + 320 * GS_STRIDE) = s5; \
    *(uint4*)((sn) + woff + 384 * GS_STRIDE) = s6; *(uint4*)((sn) + woff + 448 * GS_STRIDE) = s7; } while (0)
#define G_WRITE_B(sn) do { *(uint4*)((sn) + woff) = u0; *(uint4*)((sn) + woff + 64 * GS_STRIDE) = u1; *(uint4*)((sn) + woff + 128 * GS_STRIDE) = u2; \
    *(uint4*)((sn) + woff + 192 * GS_STRIDE) = u3; *(uint4*)((sn) + woff + 256 * GS_STRIDE) = u4; *(uint4*)((sn) + woff + 320 * GS_STRIDE) = u5; \
    *(uint4*)((sn) + woff + 384 * GS_STRIDE) = u6; *(uint4*)((sn) + woff + 448 * GS_STRIDE) = u7; } while (0)
  const int aoff = (wm * 128 + r) * GS_STRIDE + h * 16;
  const int boff = (256 + wn * 64 + r) * GS_STRIDE + h * 16;
#define G_COMPUTE(st) do { _Pragma("unroll") for (int ks = 0; ks < 4; ++ks) {                                              \
      bf16x8 fa[4], fb[2];                                                                                               \
      _Pragma("unroll") for (int mi = 0; mi < 4; ++mi) fa[mi] = *(const bf16x8*)((st) + aoff + mi * 32 * GS_STRIDE + ks * 32); \
      fb[0] = *(const bf16x8*)((st) + boff + ks * 32);                                                                   \
      fb[1] = *(const bf16x8*)((st) + boff + 32 * GS_STRIDE + ks * 32);                                                  \
      _Pragma("unroll") for (int mi = 0; mi < 4; ++mi) {                                                                 \
        acc[mi][0] = MFMA(fa[mi], fb[0], acc[mi][0]);                                                                    \
        acc[mi][1] = MFMA(fa[mi], fb[1], acc[mi][1]);                                                                    \
      }                                                                                                                  \
      __builtin_amdgcn_sched_barrier(0);                                                                                 \
    } } while (0)
  G_ISSUE_A();
  G_WRITE_A(sbase);
  G_ADV(); G_ISSUE_A();
  G_ADV(); G_ISSUE_B();
  __syncthreads();
  for (int kt = 0; kt < nk; kt += 2) {
    G_WRITE_A(sbase + GS_STAGE);
    G_ADV(); G_ISSUE_A();
    __builtin_amdgcn_sched_barrier(0);
    G_COMPUTE(sbase);
    __syncthreads();
    G_WRITE_B(sbase);
    G_ADV(); G_ISSUE_B();
    __builtin_amdgcn_sched_barrier(0);
    G_COMPUTE(sbase + GS_STAGE);
    __syncthreads();
  }
#undef G_ADV
#undef G_ISSUE_A
#undef G_ISSUE_B
#undef G_WRITE_A
#undef G_WRITE_B
#undef G_COMPUTE
}

DI int rot_unused_(int) { return 0; }
DI bool tile_of(int i, int MT, int NT, int& mt, int& nt) {
  const int per = gridDim.x >> 3;
  const int L = i * (int)gridDim.x + (int)(blockIdx.x & 7) * per + (int)(blockIdx.x >> 3);
  if (L >= MT * NT) return false;
  const int nig = 8 * NT, gid = L / nig, fm = gid * 8, gsz = min(MT - fm, 8), rem = L - gid * nig;
  mt = fm + rem % gsz; nt = rem / gsz;
  return true;
}


template <class PF, class EF>
DI void gemm_stream(int lda, int ldw, int K, unsigned char* smem, PF ptrs, EF epi) {
  const int tid = otid(), lane = tid & 63, w = tid >> 6;
  const int wm = w >> 2, wn = w & 3, r = lane & 31, h = lane >> 5;
  unsigned char* sbase = smem + GS_BASE;
  constexpr int SLOT = 512 * 64;
  const int nh = K >> 5;
  const int c0 = (h ^ ((r >> 2) & 3)) * 16, c1 = c0 ^ 32;
  const int aoff = (wm * 128 + r) * 64, boff = (256 + wn * 64 + r) * 64;
  const int lr16 = lane >> 2, lchunk = (lane & 3) ^ ((lane >> 4) & 3);
  const int wu = __builtin_amdgcn_readfirstlane(w);
  const bool isB = wu >= 4;
  const unsigned goff = isB ? (unsigned)((((wu - 4) * 64 + 2 * lr16) * ldw + lchunk * 8) * 2)
                            : (unsigned)(((wu * 64 + lr16) * lda + lchunk * 8) * 2);
  const unsigned st1 = isB ? (unsigned)(32 * ldw * 2) : (unsigned)(16 * lda * 2);
  const unsigned st2 = isB ? (unsigned)(1 * ldw * 2) : (unsigned)(32 * lda * 2);
#define WAIT_V(n) asm volatile("s_waitcnt vmcnt(" #n ")" ::: "memory")
#define RAWBAR() do { asm volatile("s_waitcnt lgkmcnt(0)" ::: "memory"); __builtin_amdgcn_s_barrier(); asm volatile("" ::: "memory"); } while (0)
#define BAR0() do { asm volatile("" ::: "memory"); __builtin_amdgcn_s_barrier(); asm volatile("" ::: "memory"); } while (0)
#define H_DMA(slotp) do { const char* gsrc_ = (isB ? bp : ap) + goff; unsigned char* ld_ = (slotp) + wu * 4096;            \
    __builtin_amdgcn_global_load_lds((const unsigned*)(gsrc_), (unsigned*)(ld_), 16, 0, 0);                                  \
    __builtin_amdgcn_global_load_lds((const unsigned*)(gsrc_ + st1), (unsigned*)(ld_ + 1024), 16, 0, 0);                     \
    __builtin_amdgcn_global_load_lds((const unsigned*)(gsrc_ + st2), (unsigned*)(ld_ + 2048), 16, 0, 0);                     \
    __builtin_amdgcn_global_load_lds((const unsigned*)(gsrc_ + st2 + st1), (unsigned*)(ld_ + 3072), 16, 0, 0); } while (0)
#define H_READ(sl) do { _Pragma("unroll") for (int mi = 0; mi < 4; ++mi) {                                                   \
      fa[0][mi] = *(const bf16x8*)((sl) + aoff + mi * 2048 + c0); fa[1][mi] = *(const bf16x8*)((sl) + aoff + mi * 2048 + c1); } \
    fb[0][0] = *(const bf16x8*)((sl) + boff + c0); fb[1][0] = *(const bf16x8*)((sl) + boff + c1);                            \
    fb[0][1] = *(const bf16x8*)((sl) + boff + 2048 + c0); fb[1][1] = *(const bf16x8*)((sl) + boff + 2048 + c1); } while (0)
#define H_MMA() do { _Pragma("unroll") for (int ks = 0; ks < 2; ++ks) { _Pragma("unroll") for (int mi = 0; mi < 4; ++mi) {  \
      acc[mi][0] = MFMA(fa[ks][mi], fb[ks][0], acc[mi][0]);                                                       \
      acc[mi][1] = MFMA(fa[ks][mi], fb[ks][1], acc[mi][1]); } } } while (0)
  const char *ap, *bp;
  {
    const u16 *ta, *tb;
    int it0 = 0;
    asm volatile("" : "+s"(it0));
    if (!ptrs(it0, ta, tb)) return;
    ap = (const char*)ta; bp = (const char*)tb;
  }
  H_DMA(sbase); ap += 64; bp += 64;
  H_DMA(sbase + SLOT); ap += 64; bp += 64;
  for (int it = 0;; ++it) {
    f32x16 acc[4][2];
#pragma unroll
    for (int a = 0; a < 4; ++a)
#pragma unroll
      for (int b = 0; b < 2; ++b) zero16(acc[a][b]);
    H_DMA(sbase + 2 * SLOT); ap += 64; bp += 64;
    WAIT_V(4);
    BAR0();
    if (wm == 1) BAR0();
    int rs = 0;
#pragma unroll 1
    for (int hh = 0; hh < nh; ++hh) {
      bf16x8 fa[2][4], fb[2][2];
      const int rem = nh - 2 - hh;
      H_READ(sbase + rs * SLOT);
      if (hh + 3 < nh) { H_DMA(sbase + ((rs + 3) & 3) * SLOT); ap += 64; bp += 64; }
      if (wm == 1) {
        if (rem >= 2) WAIT_V(8); else if (rem == 1) WAIT_V(4); else WAIT_V(0);
      }
      __builtin_amdgcn_sched_barrier(0);
      RAWBAR();
      __builtin_amdgcn_sched_barrier(0);
      H_MMA();
      __builtin_amdgcn_sched_barrier(0);
      if (wm == 0) {
        if (rem >= 2) WAIT_V(8); else if (rem == 1) WAIT_V(4); else WAIT_V(0);
      }
      BAR0();
      rs = (rs + 1) & 3;
    }
    if (wm == 0) BAR0();
    bool more;
    {
      const u16 *ta, *tb;
      more = ptrs(it + 1, ta, tb);
      if (more) {
        ap = (const char*)ta; bp = (const char*)tb;
        H_DMA(sbase); ap += 64; bp += 64;
        H_DMA(sbase + SLOT); ap += 64; bp += 64;
      }
    }
    epi(it, acc);
    if (!more) break;
  }
#undef WAIT_V
#undef RAWBAR
#undef BAR0
#undef H_DMA
#undef H_READ
#undef H_MMA
}

DI int map_row(int maptype, int s) {
  if (maptype == 1) return s < 3072 ? s : (s < 3080 ? -1 : s - 8);
  if (maptype == 2) return s < 2816 ? 2 * s : 2 * (s - 2816) + 1;
  return s;
}
DI void transpose_task(const float* __restrict__ src, int Nsrc, u16* __restrict__ dst, int dld, int maptype, int kt, int nt,
                       unsigned char* smem) {
  float* tile = (float*)(smem + 64);
  const int tid = otid();
  const int k0 = kt * 64, s0 = nt * 64;
#pragma unroll
  for (int i = 0; i < 2; ++i) {
    const int kr = (tid >> 4) + 32 * i, nc = (tid & 15) * 4;
    float4 v = make_float4(0.f, 0.f, 0.f, 0.f);
    if (s0 + nc < Nsrc) v = *(const float4*)(src + (size_t)(k0 + kr) * Nsrc + s0 + nc);
    tile[kr * 65 + nc + 0] = v.x; tile[kr * 65 + nc + 1] = v.y; tile[kr * 65 + nc + 2] = v.z; tile[kr * 65 + nc + 3] = v.w;
  }
  __syncthreads();
  {
    const int n = tid >> 3, kc = (tid & 7) * 8;
    const int s = s0 + n;
    const int dr = (s < Nsrc) ? map_row(maptype, s) : -1;
    if (dr >= 0) {
      uint4 o;
      o.x = pack2(tile[(kc + 0) * 65 + n], tile[(kc + 1) * 65 + n]);
      o.y = pack2(tile[(kc + 2) * 65 + n], tile[(kc + 3) * 65 + n]);
      o.z = pack2(tile[(kc + 4) * 65 + n], tile[(kc + 5) * 65 + n]);
      o.w = pack2(tile[(kc + 6) * 65 + n], tile[(kc + 7) * 65 + n]);
      *(uint4*)(dst + (size_t)dr * dld + k0 + kc) = o;
    }
  }
  __syncthreads();
}

DI void adaln_task(const Params& p, int task, unsigned char* smem) {
  const int bhalf = task & 1, cg_ = (task >> 1) % 96, l = (task >> 1) / 96;
  float* cs = (float*)(smem + 64);
  float* red = (float*)(smem + 64 + 20 * 1024 * 4);
  const int tid = otid();
  const float* cp = p.in[2]; const float* csm = p.in[3];
  for (int idx = tid; idx < 20 * 1024; idx += NTHR) {
    const int bb = idx >> 10, d = idx & 1023, b = bhalf * 20 + bb;
    const float c = b < 32 ? cp[b * 1024 + d] : csm[(b - 32) * 1024 + d];
    cs[idx] = siluf_(c);
  }
  __syncthreads();
  const int dseg = tid >> 6, e = cg_ * 64 + (tid & 63);
  const float* wp = p.in[10] + ((size_t)l * 1024 + dseg * 128) * 6144 + e;
  float acc[20];
#pragma unroll
  for (int i = 0; i < 20; ++i) acc[i] = 0.f;
  for (int d = 0; d < 128; ++d) {
    const float wv = wp[(size_t)d * 6144];
    const float* c0 = cs + dseg * 128 + d;
#pragma unroll
    for (int i = 0; i < 20; ++i) acc[i] += c0[i * 1024] * wv;
  }
#pragma unroll
  for (int i = 0; i < 20; ++i) red[(dseg * 20 + i) * 64 + (tid & 63)] = acc[i];
  __syncthreads();
  float* mod = (float*)(p.ws + WS_MOD);
  for (int idx = tid; idx < 20 * 64; idx += NTHR) {
    const int bb = idx >> 6, ec = idx & 63;
    float s = 0.f;
#pragma unroll
    for (int q = 0; q < 8; ++q) s += red[(q * 20 + bb) * 64 + ec];
    const int ee = cg_ * 64 + ec;
    mod[((size_t)l * 40 + bhalf * 20 + bb) * 6144 + ee] = s + p.in[11][l * 6144 + ee];
  }
  __syncthreads();
}

DI void prologue(const Params& p, unsigned char* smem) {
  const int WT_TASKS_L = 912 + 512 + 128 + 128 + 256 + 1408 + 704;
  const int N_WT = 2 * WT_TASKS_L;
  const int N_ADA = 384, N_CK = 512, N_CV = 2048;
  const int total = N_WT + N_ADA + N_CK + N_CV;
  for (int task = blockIdx.x; task < total; task += gridDim.x) {
    if (task < N_WT) {
      const int l = task / WT_TASKS_L; int t = task % WT_TASKS_L;
      if (t < 912) { transpose_task(p.in[12] + (size_t)l * 1024 * 3592, 3592, (u16*)(p.ws + WS_WT_IN) + (size_t)l * 3584 * 1024, 1024, 1, t / 57, t % 57, smem); continue; }
      t -= 912;
      if (t < 512) { transpose_task(p.in[21] + (size_t)l * 1024 * 2048, 2048, (u16*)(p.ws + WS_WT_GATE) + (size_t)l * 2048 * 1024, 1024, 0, t / 32, t % 32, smem); continue; }
      t -= 512;
      if (t < 128) { transpose_task(p.in[19] + (size_t)l * 512 * 1024, 1024, (u16*)(p.ws + WS_WT_BRA) + (size_t)l * 1024 * 512, 512, 0, t / 16, t % 16, smem); continue; }
      t -= 128;
      if (t < 128) { transpose_task(p.in[20] + (size_t)l * 512 * 1024, 1024, (u16*)(p.ws + WS_WT_BRB) + (size_t)l * 1024 * 512, 512, 0, t / 16, t % 16, smem); continue; }
      t -= 128;
      if (t < 256) { transpose_task(p.in[23] + (size_t)l * 1024 * 1024, 1024, (u16*)(p.ws + WS_WT_O) + (size_t)l * 1024 * 1024, 1024, 0, t / 16, t % 16, smem); continue; }
      t -= 256;
      if (t < 1408) { transpose_task(p.in[26] + (size_t)l * 1024 * 5632, 5632, (u16*)(p.ws + WS_WT_GU) + (size_t)l * 5632 * 1024, 1024, 2, t / 88, t % 88, smem); continue; }
      t -= 1408;
      transpose_task(p.in[27] + (size_t)l * 2816 * 1024, 1024, (u16*)(p.ws + WS_WT_DOWN) + (size_t)l * 1024 * 2816, 2816, 0, t / 16, t % 16, smem);
    } else if (task < N_WT + N_ADA) {
      adaln_task(p, task - N_WT, smem);
    } else if (task < N_WT + N_ADA + N_CK) {
      const int t = task - N_WT - N_ADA;
      const float4* src = (const float4*)p.in[4];
      u16* dst = (u16*)(p.ws + WS_KS);
#pragma unroll
      for (int i = 0; i < 8; ++i) {
        const size_t f4 = (size_t)t * 4096 + i * 512 + otid();
        const float4 v = src[f4];
        const size_t e = f4 * 4;
        const size_t lb = e / (1024 * 512), rem = e % (1024 * 512);
        uint2 o; o.x = pack2(v.x, v.y); o.y = pack2(v.z, v.w);
        *(uint2*)(dst + lb * (1056 * 512) + rem) = o;
      }
    } else {
      const int t = task - N_WT - N_ADA - N_CK;
      const int lb = t >> 7, tt = t & 127;
      transpose_task(p.in[5] + (size_t)lb * 1024 * 512, 512, (u16*)(p.ws + WS_VTS) + (size_t)lb * 512 * 1056, 1056, 0, tt >> 3, tt & 7, smem);
    }
  }
}

DI float wave_sum(float v, int lane) {
#pragma unroll
  for (int off = 32; off >= 1; off >>= 1) v += shx(v, off, lane);
  return v;
}
DI void ln_pass(const Params& p, int mode, int l, unsigned char* smem) {
  const int tid = otid();
  const int lane = tid & 63, w = tid >> 6;
  const bool first = mode != 0;
  const bool second = (mode != 2) || (l + 1 < 2);
  const bool gates = (mode == 0) || (mode == 2 && l + 1 < 2);
  const int lm = (mode == 2) ? l + 1 : l;
  const int shi = (mode == 1) ? 3 : 0;
  const float* lng = (mode == 1) ? p.in[24] + l * 1024 : p.in[28] + l * 1024;
  const float* lnb = (mode == 1) ? p.in[25] + l * 1024 : p.in[29] + l * 1024;
  const float* mod = (const float*)(p.ws + WS_MOD);
  u16* H = (u16*)(p.ws + WS_H);
  float* gout = (float*)(p.ws + WS_GATES);
  float* wl = (float*)(smem + 64);
  float bif[8];
  if (gates) {
    const float* wi = p.in[12] + (size_t)lm * 1024 * 3592 + 3072;
    for (int idx = tid; idx < 8192; idx += NTHR) {
      const int c = idx >> 3, j = idx & 7;
      wl[j * 1024 + c] = wi[(size_t)c * 3592 + j];
    }
#pragma unroll
    for (int j = 0; j < 8; ++j) bif[j] = p.in[13][lm * 8 + j];
  }
  __syncthreads();
  float lg[16], lb[16];
  if (first) {
#pragma unroll
    for (int i = 0; i < 4; ++i) {
      const float4 g = *(const float4*)(lng + i * 256 + lane * 4);
      const float4 b = *(const float4*)(lnb + i * 256 + lane * 4);
      lg[i * 4] = g.x; lg[i * 4 + 1] = g.y; lg[i * 4 + 2] = g.z; lg[i * 4 + 3] = g.w;
      lb[i * 4] = b.x; lb[i * 4 + 1] = b.y; lb[i * 4 + 2] = b.z; lb[i * 4 + 3] = b.w;
    }
  }
  auto process = [&](int row, float (&v)[16], const float (&msh)[16], const float (&msc)[16]) {
    float* xr = p.out + (size_t)row * 1024;
    if (first) {
      float s = 0.f;
#pragma unroll
      for (int i = 0; i < 16; ++i) s += v[i];
      const float mean = wave_sum(s, lane) * (1.f / 1024.f);
      float q = 0.f;
#pragma unroll
      for (int i = 0; i < 16; ++i) { v[i] -= mean; q += v[i] * v[i]; }
      const float rstd = rsqrtf(wave_sum(q, lane) * (1.f / 1024.f) + LN_EPS);
#pragma unroll
      for (int i = 0; i < 4; ++i) {
#pragma unroll
        for (int e = 0; e < 4; ++e) v[i * 4 + e] = v[i * 4 + e] * rstd * lg[i * 4 + e] + lb[i * 4 + e];
        *(float4*)(xr + i * 256 + lane * 4) = make_float4(v[i * 4 + 0], v[i * 4 + 1], v[i * 4 + 2], v[i * 4 + 3]);
      }
    }
    if (second) {
      float s = 0.f;
#pragma unroll
      for (int i = 0; i < 16; ++i) s += v[i];
      const float mean = wave_sum(s, lane) * (1.f / 1024.f);
      float q = 0.f;
#pragma unroll
      for (int i = 0; i < 16; ++i) { v[i] -= mean; q += v[i] * v[i]; }
      const float rstd = rsqrtf(wave_sum(q, lane) * (1.f / 1024.f) + LN_EPS);
#pragma unroll
      for (int i = 0; i < 4; ++i) {
#pragma unroll
        for (int e = 0; e < 4; ++e) v[i * 4 + e] = v[i * 4 + e] * rstd * msc[i * 4 + e] + msh[i * 4 + e];
        uint2 o; o.x = pack2(v[i * 4 + 0], v[i * 4 + 1]); o.y = pack2(v[i * 4 + 2], v[i * 4 + 3]);
        *(uint2*)(H + (size_t)row * 1024 + i * 256 + lane * 4) = o;
      }
      if (gates) {
        float g8[8];
#pragma unroll
        for (int j = 0; j < 8; ++j) {
          float s2 = 0.f;
#pragma unroll
          for (int i = 0; i < 4; ++i) {
            const float4 wv = *(const float4*)(wl + j * 1024 + i * 256 + lane * 4);
            s2 += v[i * 4] * wv.x + v[i * 4 + 1] * wv.y + v[i * 4 + 2] * wv.z + v[i * 4 + 3] * wv.w;
          }
          g8[j] = wave_sum(s2, lane) + bif[j];
        }
        if (lane == 0) {
          *(float4*)(gout + (size_t)row * 8) = make_float4(g8[0], g8[1], g8[2], g8[3]);
          *(float4*)(gout + (size_t)row * 8 + 4) = make_float4(g8[4], g8[5], g8[6], g8[7]);
        }
      }
    }
  };
  auto load_mod = [&](int row, float (&msh)[16], float (&msc)[16]) {
    const float* mb = mod + ((size_t)lm * 40 + batch_of_row(row)) * 6144;
#pragma unroll
    for (int i = 0; i < 4; ++i) {
      const float4 sh = *(const float4*)(mb + shi * 1024 + i * 256 + lane * 4);
      const float4 sc = *(const float4*)(mb + (shi + 1) * 1024 + i * 256 + lane * 4);
      msh[i * 4] = sh.x; msh[i * 4 + 1] = sh.y; msh[i * 4 + 2] = sh.z; msh[i * 4 + 3] = sh.w;
      msc[i * 4] = 1.f + sc.x; msc[i * 4 + 1] = 1.f + sc.y; msc[i * 4 + 2] = 1.f + sc.z; msc[i * 4 + 3] = 1.f + sc.w;
    }
  };
  for (int chunk = blockIdx.x * 8 + w; chunk < TOKP / 32; chunk += gridDim.x * 8) {
    const int row0 = chunk * 32;
    float msh[16], msc[16];
    if (second) load_mod(row0, msh, msc);
    const float* src0 = (mode == 0) ? p.in[0] + (size_t)row0 * 1024 : p.out + (size_t)row0 * 1024;
    float4 nx0 = *(const float4*)(src0 + lane * 4), nx1 = *(const float4*)(src0 + 256 + lane * 4);
    float4 nx2 = *(const float4*)(src0 + 512 + lane * 4), nx3 = *(const float4*)(src0 + 768 + lane * 4);
    for (int ri = 0; ri < 32; ++ri) {
      float v[16];
      v[0] = nx0.x; v[1] = nx0.y; v[2] = nx0.z; v[3] = nx0.w; v[4] = nx1.x; v[5] = nx1.y; v[6] = nx1.z; v[7] = nx1.w;
      v[8] = nx2.x; v[9] = nx2.y; v[10] = nx2.z; v[11] = nx2.w; v[12] = nx3.x; v[13] = nx3.y; v[14] = nx3.z; v[15] = nx3.w;
      {
        const float* sn = src0 + (size_t)(ri < 31 ? ri + 1 : 31) * 1024;
        nx0 = *(const float4*)(sn + lane * 4); nx1 = *(const float4*)(sn + 256 + lane * 4);
        nx2 = *(const float4*)(sn + 512 + lane * 4); nx3 = *(const float4*)(sn + 768 + lane * 4);
      }
      __builtin_amdgcn_sched_barrier(0);
      process(row0 + ri, v, msh, msc);
    }
  }
  if (w == 0) {
    for (int row = TOKP + blockIdx.x; row < TOK; row += gridDim.x) {
      float msh[16], msc[16];
      if (second) load_mod(row, msh, msc);
      const float* src = (mode == 0) ? p.in[1] + (size_t)(row - TOKP) * 1024 : p.out + (size_t)row * 1024;
      float v[16];
#pragma unroll
      for (int i = 0; i < 4; ++i) {
        const float4 t = *(const float4*)(src + i * 256 + lane * 4);
        v[i * 4 + 0] = t.x; v[i * 4 + 1] = t.y; v[i * 4 + 2] = t.z; v[i * 4 + 3] = t.w;
      }
      process(row, v, msh, msc);
    }
  }
}


DI void micro_partial(f32x16& acc, const u16* A, int lda, const u16* Wt, int ldw, int K, int row0, int n0, int w, int r, int h) {
  const int kb = w * (K >> 3), n16 = K >> 7;
  const u16* ap = A + (size_t)(row0 + r) * lda + kb + h * 8;
  const u16* bp = Wt + (size_t)(n0 + r) * ldw + kb + h * 8;
#pragma unroll 4
  for (int k = 0; k < n16; ++k) {
    const bf16x8 a = *(const bf16x8*)(ap + k * 16);
    const bf16x8 b = *(const bf16x8*)(bp + k * 16);
    acc = MFMA(a, b, acc);
  }
}
DI void micro_reduce_store(const f32x16& acc, float* red, int w, int lane) {
#pragma unroll
  for (int i = 0; i < 16; ++i) red[(w * 16 + i) * 64 + lane] = acc[i];
}
DI float micro_sum(const float* red, int i, int lane) {
  float s = 0.f;
#pragma unroll
  for (int q = 0; q < 8; ++q) s += red[(q * 16 + i) * 64 + lane];
  return s;
}

constexpr int EP_LD = 264;
constexpr int EP_LDT = 68;
DI void zero_acc(f32x16 (&acc)[4][2]) {
#pragma unroll
  for (int a = 0; a < 4; ++a)
#pragma unroll
    for (int b = 0; b < 2; ++b) zero16(acc[a][b]);
}
DI void stage_rm(const f32x16& a0, const f32x16& a1, float* stg, int wm, int wn, int r, int h) {
#pragma unroll
  for (int i = 0; i < 16; ++i) *(float2*)(stg + (wm * 32 + crow(i, h)) * EP_LD + wn * 64 + 2 * r) = make_float2(a0[i], a1[i]);
}
DI void stage_tr(const f32x16& a0, const f32x16& a1, float* stg, int wm, int wn, int r, int h) {
#pragma unroll
  for (int g = 0; g < 4; ++g) {
    *(float4*)(stg + (wn * 64 + 2 * r) * EP_LDT + wm * 32 + 8 * g + 4 * h) = make_float4(a0[4 * g], a0[4 * g + 1], a0[4 * g + 2], a0[4 * g + 3]);
    *(float4*)(stg + (wn * 64 + 2 * r + 1) * EP_LDT + wm * 32 + 8 * g + 4 * h) = make_float4(a1[4 * g], a1[4 * g + 1], a1[4 * g + 2], a1[4 * g + 3]);
  }
}
DI int grow_of(int m0, int mi, int lr) { return m0 + (lr >> 5) * 128 + mi * 32 + (lr & 31); }
DI uint4 pack8f(const float4& a, const float4& b) {
  uint4 o; o.x = pack2(a.x, a.y); o.y = pack2(a.z, a.w); o.z = pack2(b.x, b.y); o.w = pack2(b.z, b.w); return o;
}

DI void write_tr(const Params& p, int l, int m0, int mi, const float* stg, int tid, int which, int chbase) {
  const bool prompt = m0 < TOKP;
#pragma unroll 1
  for (int q = 0; q < 4; ++q) {
    const int cid = q * NTHR + tid, ch = cid >> 3, tc = cid & 7;
    const float4 v0 = *(const float4*)(stg + ch * EP_LDT + tc * 8);
    const float4 v1 = *(const float4*)(stg + ch * EP_LDT + tc * 8 + 4);
    const int row0 = grow_of(m0, mi, tc * 8);
    const int chg = chbase + ch;
    u16* d;
    if (prompt) {
      const int b = row0 >> 11, t = row0 & 2047;
      if (which == 0) d = (u16*)(p.ws + WS_VTP) + ((size_t)b * 512 + chg) * 2048 + t;
      else if (which == 1) d = (u16*)(p.ws + WS_MQKT_P) + ((size_t)b * 1024 + chg) * 2048 + t;
      else d = (u16*)(p.ws + WS_MVT_P) + ((size_t)b * 512 + chg) * 2048 + t;
    } else {
      const int rs = row0 - TOKP, bs = rs >> 5, t = rs & 31;
      if (which == 0) d = (u16*)(p.ws + WS_VTS) + ((size_t)(l * 8 + bs) * 512 + chg) * 1056 + 1024 + t;
      else if (which == 1) d = (u16*)(p.ws + WS_MQKT_S) + ((size_t)bs * 1024 + chg) * 32 + t;
      else d = (u16*)(p.ws + WS_MVT_S) + ((size_t)bs * 512 + chg) * 32 + t;
    }
    *(uint4*)d = pack8f(v0, v1);
  }
}

DI void epi_in(const Params& p, int l, int m0, int n0, f32x16 (&acc)[4][2], unsigned char* smem) {
  const int tid = otid(), lane = tid & 63, w = tid >> 6;
  const int wm = w >> 2, wn = w & 3, r = lane & 31, h = lane >> 5;
  const bool prompt = m0 < TOKP;
  float* stg = (float*)(smem + GS_BASE + GS_STAGE);
  const int seg = n0 < 512 ? 0 : (n0 < 1024 ? 1 : (n0 < 1536 ? 2 : (n0 < 2560 ? 3 : (n0 < 3072 ? 4 : 5))));
  if (seg == 3) {
    const int ch = n0 - 1536 + wn * 64 + 2 * r;
#pragma unroll
    for (int mi = 0; mi < 4; ++mi) {
      const int rb = m0 + wm * 128 + mi * 32 + 4 * h;
#pragma unroll
      for (int i = 0; i < 16; ++i) {
        const int row = rb + (i & 3) + 8 * (i >> 2);
        if (prompt) {
          const int tt = row & 2047;
          if (tt >= 2045) *(float2*)(p.out + O_CVP + ((size_t)(l * 32 + (row >> 11)) * 3 + (tt - 2045)) * 1024 + ch) = make_float2(acc[mi][0][i], acc[mi][1][i]);
        } else {
          const int rs = row - TOKP, tt = rs & 31;
          if (tt >= 29) *(float2*)(p.out + O_CVS + ((size_t)(l * 8 + (rs >> 5)) * 3 + (tt - 29)) * 1024 + ch) = make_float2(acc[mi][0][i], acc[mi][1][i]);
        }
      }
    }
  }
#pragma unroll
  for (int mi = 0; mi < 4; ++mi) {
    if (seg == 0 || seg == 1 || seg == 2 || seg == 5) {
      __syncthreads();
      stage_rm(acc[mi][0], acc[mi][1], stg, wm, wn, r, h);
      __syncthreads();
#pragma unroll 1
      for (int q = 0; q < 4; ++q) {
        const int cid = q * NTHR + tid, lr = cid >> 5, c8 = (cid & 31) * 8;
        const float4 v0 = *(const float4*)(stg + lr * EP_LD + c8);
        const float4 v1 = *(const float4*)(stg + lr * EP_LD + c8 + 4);
        const int row = grow_of(m0, mi, lr);
        const int n = n0 + c8;
        if (seg == 0) {
          *(uint4*)((u16*)(p.ws + WS_ZQ) + (size_t)row * 512 + n) = pack8f(v0, v1);
        } else if (seg == 5) {
          const float4 s0 = make_float4(sigmoidf_(v0.x), sigmoidf_(v0.y), sigmoidf_(v0.z), sigmoidf_(v0.w));
          const float4 s1 = make_float4(sigmoidf_(v1.x), sigmoidf_(v1.y), sigmoidf_(v1.z), sigmoidf_(v1.w));
          *(uint4*)((u16*)(p.ws + WS_MO) + (size_t)row * 512 + (n - 3072)) = pack8f(s0, s1);
        } else {
          const bool isk = seg == 1;
          const int nn = n - (isk ? 512 : 1024);
          float* of = p.out + (isk ? (prompt ? O_KP : O_KSM) : (prompt ? O_VP : O_VSM));
          const size_t orow = prompt ? ((size_t)l * TOKP + row) : ((size_t)l * TOKS + (row - TOKP));
          *(float4*)(of + orow * 512 + nn) = v0;
          *(float4*)(of + orow * 512 + nn + 4) = v1;
          if (isk) {
            u16* kd;
            if (prompt) kd = (u16*)(p.ws + WS_KB) + (size_t)row * 512 + nn;
            else { const int rs = row - TOKP; kd = (u16*)(p.ws + WS_KS) + ((size_t)(l * 8 + (rs >> 5)) * 1056 + 1024 + (rs & 31)) * 512 + nn; }
            *(uint4*)kd = pack8f(v0, v1);
          }
        }
      }
    }
    if (seg == 2 || seg == 3 || seg == 4) {
      __syncthreads();
      stage_tr(acc[mi][0], acc[mi][1], stg, wm, wn, r, h);
      __syncthreads();
      write_tr(p, l, m0, mi, stg, tid, seg == 2 ? 0 : (seg == 3 ? 1 : 2), n0 - (seg == 2 ? 1024 : (seg == 3 ? 1536 : 2560)));
    }
  }
  __syncthreads();
}

DI void phase_in_gate(const Params& p, int l, unsigned char* smem) {
  const int tid = otid(), lane = tid & 63, w = tid >> 6;
  const int wm = w >> 2, wn = w & 3, r = lane & 31, h = lane >> 5;
  const u16* H = (const u16*)(p.ws + WS_H);
  const u16* Win = (const u16*)(p.ws + WS_WT_IN) + (size_t)l * 3584 * 1024;
  const u16* Wg = (const u16*)(p.ws + WS_WT_GATE) + (size_t)l * 2048 * 1024;
  float* stg = (float*)(smem + GS_BASE + GS_STAGE);
  const int NT = 14 + 8, MT = 257;
  auto ptrs = [&](int it, const u16*& ap, const u16*& bp) -> bool {
    int mt, nt;
    if (!tile_of(it, MT, NT, mt, nt)) return false;
    ap = H + (size_t)(mt * 256) * 1024;
    bp = (nt < 14 ? Win + (size_t)(nt * 256) * 1024 : Wg + (size_t)((nt - 14) * 256) * 1024);
    return true;
  };
  auto epi = [&](int it, f32x16 (&acc)[4][2]) {
    const int tid = otid(), lane = tid & 63, w = tid >> 6;
    const int wm = w >> 2, wn = w & 3, r = lane & 31, h = lane >> 5;
    int mt, nt;
    tile_of(it, MT, NT, mt, nt);
    const int m0 = mt * 256;
    if (nt < 14) {
      epi_in(p, l, m0, nt * 256, acc, smem);
    } else {
      const int n0 = (nt - 14) * 256;
      u16* G = (u16*)(p.ws + WS_G);
#pragma unroll
      for (int mi = 0; mi < 4; ++mi) {
        __syncthreads();
        stage_rm(acc[mi][0], acc[mi][1], stg, wm, wn, r, h);
        __syncthreads();
#pragma unroll 1
        for (int q = 0; q < 4; ++q) {
          const int cid = q * NTHR + tid, lr = cid >> 5, c8 = (cid & 31) * 8;
          float4 v0 = *(const float4*)(stg + lr * EP_LD + c8);
          float4 v1 = *(const float4*)(stg + lr * EP_LD + c8 + 4);
          const int row = grow_of(m0, mi, lr), n = n0 + c8;
          const float4 b0 = *(const float4*)(p.in[22] + l * 2048 + n);
          const float4 b1 = *(const float4*)(p.in[22] + l * 2048 + n + 4);
          v0 = make_float4(sigmoidf_(v0.x + b0.x), sigmoidf_(v0.y + b0.y), sigmoidf_(v0.z + b0.z), sigmoidf_(v0.w + b0.w));
          v1 = make_float4(sigmoidf_(v1.x + b1.x), sigmoidf_(v1.y + b1.y), sigmoidf_(v1.z + b1.z), sigmoidf_(v1.w + b1.w));
          *(uint4*)(G + (size_t)row * 2048 + n) = pack8f(v0, v1);
        }
      }
      __syncthreads();
    }
  };
  gemm_stream(1024, 1024, 1024, smem, ptrs, epi);
}

DI void phase_mix(const Params& p, int l, unsigned char* smem) {
  const int tid = otid(), lane = tid & 63, w = tid >> 6;
  const int wm = w >> 2, wn = w & 3, r = lane & 31, h = lane >> 5;
  const u16* G = (const u16*)(p.ws + WS_G);
  u16* MIX = (u16*)(p.ws + WS_MIX);
  float* stg = (float*)(smem + GS_BASE + GS_STAGE);
  const int NT = 4, MT = 256;
  auto ptrs = [&](int it, const u16*& ap, const u16*& bp) -> bool {
    int mt, nt;
    if (!tile_of(it >> 1, MT, NT, mt, nt)) return false;
    const int half = it & 1;
    ap = (const u16*)(p.ws + (half ? WS_MN : WS_AN)) + (size_t)(mt * 256) * 512;
    bp = (const u16*)(p.ws + (half ? WS_WT_BRB : WS_WT_BRA)) + (size_t)l * 1024 * 512 + (size_t)(nt * 256) * 512;
    return true;
  };
  auto epi = [&](int it, f32x16 (&acc)[4][2]) {
    const int tid = otid(), lane = tid & 63, w = tid >> 6;
    const int wm = w >> 2, wn = w & 3, r = lane & 31, h = lane >> 5;
    int mt, nt;
    tile_of(it >> 1, MT, NT, mt, nt);
    const int half = it & 1;
    const int m0 = mt * 256, n0 = nt * 256;
#pragma unroll
    for (int mi = 0; mi < 4; ++mi) {
      __syncthreads();
      stage_rm(acc[mi][0], acc[mi][1], stg, wm, wn, r, h);
      __syncthreads();
#pragma unroll 1
      for (int q = 0; q < 4; ++q) {
        const int cid = q * NTHR + tid, lr = cid >> 5, c8 = (cid & 31) * 8;
        const float4 v0 = *(const float4*)(stg + lr * EP_LD + c8);
        const float4 v1 = *(const float4*)(stg + lr * EP_LD + c8 + 4);
        const int row = grow_of(m0, mi, lr), n = n0 + c8;
        const uint4 g = *(const uint4*)(G + (size_t)row * 2048 + half * 1024 + n);
        float4 o0 = make_float4(bflo(g.x) * v0.x, bfhi(g.x) * v0.y, bflo(g.y) * v0.z, bfhi(g.y) * v0.w);
        float4 o1 = make_float4(bflo(g.z) * v1.x, bfhi(g.z) * v1.y, bflo(g.w) * v1.z, bfhi(g.w) * v1.w);
        uint4* mp = (uint4*)(MIX + (size_t)row * 1024 + n);
        if (half) {
          const uint4 pr = *mp;
          o0.x += bflo(pr.x); o0.y += bfhi(pr.x); o0.z += bflo(pr.y); o0.w += bfhi(pr.y);
          o1.x += bflo(pr.z); o1.y += bfhi(pr.z); o1.z += bflo(pr.w); o1.w += bfhi(pr.w);
        }
        *mp = pack8f(o0, o1);
      }
    }
    __syncthreads();
  };
  gemm_stream(512, 512, 512, smem, ptrs, epi);
  {
    const int tid2 = otid(), lane = tid2 & 63, w = tid2 >> 6, r = lane & 31, h = lane >> 5;
    float* red = (float*)(smem + 64);
    for (int mtile = blockIdx.x; mtile < 256; mtile += gridDim.x) {
      const int row0 = TOKP + (mtile >> 5) * 32, n0 = (mtile & 31) * 32;
      f32x16 pa, pb;
      zero16(pa); zero16(pb);
      micro_partial(pa, (const u16*)(p.ws + WS_AN), 512, (const u16*)(p.ws + WS_WT_BRA) + (size_t)l * 1024 * 512, 512, 512, row0, n0, w, r, h);
      micro_partial(pb, (const u16*)(p.ws + WS_MN), 512, (const u16*)(p.ws + WS_WT_BRB) + (size_t)l * 1024 * 512, 512, 512, row0, n0, w, r, h);
      __syncthreads();
      micro_reduce_store(pa, red, w, lane);
      micro_reduce_store(pb, red + 8192, w, lane);
      __syncthreads();
#pragma unroll
      for (int q = 0; q < 2; ++q) {
        const int i = w + 8 * q;
        const float sa = micro_sum(red, i, lane), sb = micro_sum(red + 8192, i, lane);
        const int row = row0 + crow(i, h), n = n0 + r;
        const float ga = bf2f(G[(size_t)row * 2048 + n]), gb = bf2f(G[(size_t)row * 2048 + 1024 + n]);
        MIX[(size_t)row * 1024 + n] = f2bf(ga * sa + gb * sb);
      }
    }
    __syncthreads();
  }
}

DI void phase_res(const Params& p, int l, int mode, unsigned char* smem) {
  const int tid = otid(), lane = tid & 63, w = tid >> 6;
  const int wm = w >> 2, wn = w & 3, r = lane & 31, h = lane >> 5;
  const float* mod = (const float*)(p.ws + WS_MOD);
  float* stg = (float*)(smem + GS_BASE + GS_STAGE);
  const int NT = 4, MT = 256;
  const int K = (mode == 0) ? 1024 : 2816;
  const u16* Ab = (const u16*)(p.ws + (mode == 0 ? WS_MIX : WS_ACT));
  const u16* Wb = (mode == 0) ? (const u16*)(p.ws + WS_WT_O) + (size_t)l * 1024 * 1024 : (const u16*)(p.ws + WS_WT_DOWN) + (size_t)l * 1024 * 2816;
  const int gi = (mode == 0) ? 2 : 5;
  auto ptrs = [&](int it, const u16*& ap, const u16*& bp) -> bool {
    int mt, nt;
    if (!tile_of(it, MT, NT, mt, nt)) return false;
    ap = Ab + (size_t)(mt * 256) * K;
    bp = Wb + (size_t)(nt * 256) * K;
    return true;
  };
  auto epi = [&](int it, f32x16 (&acc)[4][2]) {
    const int tid = otid(), lane = tid & 63, w = tid >> 6;
    const int wm = w >> 2, wn = w & 3, r = lane & 31, h = lane >> 5;
    int mt, nt;
    tile_of(it, MT, NT, mt, nt);
    const int m0 = mt * 256, n0 = nt * 256;
#pragma unroll
    for (int mi = 0; mi < 4; ++mi) {
      __syncthreads();
      stage_rm(acc[mi][0], acc[mi][1], stg, wm, wn, r, h);
      __syncthreads();
#pragma unroll 1
      for (int q = 0; q < 8; ++q) {
        const int cid = q * NTHR + tid, lr = cid >> 6, c4 = (cid & 63) * 4;
        const float4 v = *(const float4*)(stg + lr * EP_LD + c4);
        const int row = grow_of(m0, mi, lr), n = n0 + c4;
        const int b = batch_of_row(row);
        const float4 gg = *(const float4*)(mod + ((size_t)l * 40 + b) * 6144 + gi * 1024 + n);
        float* xr = p.out + (size_t)row * 1024 + n;
        const float* xs = (mode == 0 && l == 0) ? (row < TOKP ? p.in[0] + (size_t)row * 1024 + n : p.in[1] + (size_t)(row - TOKP) * 1024 + n) : xr;
        const float4 xv = *(const float4*)xs;
        *(float4*)xr = make_float4(ALPHA * xv.x + (1.f + gg.x) * v.x, ALPHA * xv.y + (1.f + gg.y) * v.y,
                                   ALPHA * xv.z + (1.f + gg.z) * v.z, ALPHA * xv.w + (1.f + gg.w) * v.w);
      }
    }
    __syncthreads();
  };
  gemm_stream(K, K, K, smem, ptrs, epi);
  {
    const int tid2 = otid(), lane = tid2 & 63, w = tid2 >> 6, r = lane & 31, h = lane >> 5;
    float* red = (float*)(smem + 64);
    for (int mtile = blockIdx.x; mtile < 256; mtile += gridDim.x) {
      const int row0 = TOKP + (mtile >> 5) * 32, n0 = (mtile & 31) * 32;
      f32x16 pa;
      zero16(pa);
      micro_partial(pa, Ab, K, Wb, K, K, row0, n0, w, r, h);
      __syncthreads();
      micro_reduce_store(pa, red, w, lane);
      __syncthreads();
#pragma unroll
      for (int q = 0; q < 2; ++q) {
        const int i = w + 8 * q;
        const float sa = micro_sum(red, i, lane);
        const int row = row0 + crow(i, h), n = n0 + r;
        const float gg = mod[((size_t)l * 40 + batch_of_row(row)) * 6144 + gi * 1024 + n];
        float* xr = p.out + (size_t)row * 1024 + n;
        const float xv = (mode == 0 && l == 0) ? p.in[1][(size_t)(row - TOKP) * 1024 + n] : *xr;
        *xr = ALPHA * xv + (1.f + gg) * sa;
      }
    }
    __syncthreads();
  }
}

DI void phase_gu(const Params& p, int l, unsigned char* smem) {
  const int tid = otid(), lane = tid & 63, w = tid >> 6;
  const int wm = w >> 2, wn = w & 3, r = lane & 31, h = lane >> 5;
  u16* ACT = (u16*)(p.ws + WS_ACT);
  const u16* Hh = (const u16*)(p.ws + WS_H);
  const u16* Wb = (const u16*)(p.ws + WS_WT_GU) + (size_t)l * 5632 * 1024;
  float* stg = (float*)(smem + GS_BASE + GS_STAGE);
  const int NT = 22, MT = 257;
  auto ptrs = [&](int it, const u16*& ap, const u16*& bp) -> bool {
    int mt, nt;
    if (!tile_of(it, MT, NT, mt, nt)) return false;
    ap = Hh + (size_t)(mt * 256) * 1024;
    bp = Wb + (size_t)(nt * 256) * 1024;
    return true;
  };
  auto epi = [&](int it, f32x16 (&acc)[4][2]) {
    const int tid = otid(), lane = tid & 63, w = tid >> 6;
    const int wm = w >> 2, wn = w & 3, r = lane & 31, h = lane >> 5;
    int mt, nt;
    tile_of(it, MT, NT, mt, nt);
    const int m0 = mt * 256, n0 = nt * 256;
#pragma unroll
    for (int mi = 0; mi < 4; ++mi) {
      __syncthreads();
      stage_rm(acc[mi][0], acc[mi][1], stg, wm, wn, r, h);
      __syncthreads();
#pragma unroll 1
      for (int q = 0; q < 2; ++q) {
        const int cid = q * NTHR + tid, lr = cid >> 4, c16 = (cid & 15) * 16;
        const float4 v0 = *(const float4*)(stg + lr * EP_LD + c16);
        const float4 v1 = *(const float4*)(stg + lr * EP_LD + c16 + 4);
        const float4 v2 = *(const float4*)(stg + lr * EP_LD + c16 + 8);
        const float4 v3 = *(const float4*)(stg + lr * EP_LD + c16 + 12);
        const int row = grow_of(m0, mi, lr);
        uint4 o;
        o.x = pack2(siluf_(v0.x) * v0.y, siluf_(v0.z) * v0.w);
        o.y = pack2(siluf_(v1.x) * v1.y, siluf_(v1.z) * v1.w);
        o.z = pack2(siluf_(v2.x) * v2.y, siluf_(v2.z) * v2.w);
        o.w = pack2(siluf_(v3.x) * v3.y, siluf_(v3.z) * v3.w);
        *(uint4*)(ACT + (size_t)row * 2816 + (n0 >> 1) + (c16 >> 1)) = o;
      }
    }
    __syncthreads();
  };
  gemm_stream(1024, 1024, 1024, smem, ptrs, epi);
}

constexpr int AT_BASE = 64;
constexpr int AT_KBYTES = 64 * 272;
constexpr int AT_VBYTES = 128 * 136;
constexpr int AT_STAGE = AT_KBYTES + AT_VBYTES;

DI void attn_item(const Params& p, int l, int b, int head, int qt, float lam, float lam_init, unsigned char* smem) {
  const int tid = otid(), lane = tid & 63, w = tid >> 6, r = lane & 31, h = lane >> 5;
  const int comp = w & 1, rg = w >> 1;
  const bool prompt = b < 32;
  const int bs = b - 32;
  const u16* Kg = prompt ? (const u16*)(p.ws + WS_KB) + (size_t)b * 2048 * 512 : (const u16*)(p.ws + WS_KS) + (size_t)(l * 8 + bs) * 1056 * 512;
  const u16* Vg = prompt ? (const u16*)(p.ws + WS_VTP) + (size_t)b * 512 * 2048 : (const u16*)(p.ws + WS_VTS) + (size_t)(l * 8 + bs) * 512 * 1056;
  const int ldT = prompt ? 2048 : 1056;
  const int nkt = prompt ? 2 * qt + 2 : 17;
  const int nkeys = prompt ? 2048 : 1056;
  const int qtok0 = prompt ? b * 2048 + qt * 128 : TOKP + bs * 32;
  const int qpos0 = prompt ? qt * 128 : 1024;
  const bool active = prompt || rg == 0;
  const int my_nkt = prompt ? (rg < 2 ? nkt - 1 : nkt) : nkt;
  const u16* ZQ = (const u16*)(p.ws + WS_ZQ);
  bf16x8 qf[4];
  {
    const int qrow = active ? qtok0 + rg * 32 + r : qtok0;
#pragma unroll
    for (int ks = 0; ks < 4; ++ks) {
      const uint4 qq = *(const uint4*)(ZQ + (size_t)qrow * 512 + head * 128 + comp * 64 + ks * 16 + h * 8);
      const float cq = 0.125f * LOG2E;
      uint4 qs_;
      qs_.x = pack2(bflo(qq.x) * cq, bfhi(qq.x) * cq); qs_.y = pack2(bflo(qq.y) * cq, bfhi(qq.y) * cq);
      qs_.z = pack2(bflo(qq.z) * cq, bfhi(qq.z) * cq); qs_.w = pack2(bflo(qq.w) * cq, bfhi(qq.w) * cq);
      qf[ks] = __builtin_bit_cast(bf16x8, qs_);
    }
  }
  const float slope2 = exp2f(-2.f * (head + 1)) * LOG2E;
  const float c1 = 0.125f * LOG2E;
  const int qpos = qpos0 + rg * 32 + r;
  f32x16 O[4];
#pragma unroll
  for (int i = 0; i < 4; ++i) zero16(O[i]);
  float m_run = -INFINITY, l_run = 0.f;

  const int krow = tid >> 4, kcc = tid & 15;
  const int vrow = tid >> 3, vcc = tid & 7;
  const u16* kp = Kg + (size_t)((nkt - 1) * 64 + krow) * 512 + head * 128 + kcc * 8;
  const u16* vp = Vg + (size_t)(head * 128 + vrow) * ldT + (nkt - 1) * 64 + vcc * 8;
  uint4 rk0, rk1, rv0, rv1;
  unsigned char* sb = smem + AT_BASE;
  rk0 = *(const uint4*)kp; rk1 = *(const uint4*)(kp + 32 * 512);
  rv0 = *(const uint4*)vp; rv1 = *(const uint4*)(vp + (size_t)64 * ldT);
  {
    *(uint4*)(sb + krow * 272 + kcc * 16) = rk0;
    *(uint4*)(sb + (krow + 32) * 272 + kcc * 16) = rk1;
    *(uint2*)(sb + AT_KBYTES + vrow * 136 + vcc * 16) = make_uint2(rv0.x, rv0.y);
    *(uint2*)(sb + AT_KBYTES + vrow * 136 + vcc * 16 + 8) = make_uint2(rv0.z, rv0.w);
    *(uint2*)(sb + AT_KBYTES + (vrow + 64) * 136 + vcc * 16) = make_uint2(rv1.x, rv1.y);
    *(uint2*)(sb + AT_KBYTES + (vrow + 64) * 136 + vcc * 16 + 8) = make_uint2(rv1.z, rv1.w);
  }
  __syncthreads();
  for (int j = 0; j < nkt; ++j) {
    const int kt = nkt - 1 - j;
    const bool more = j + 1 < nkt;
    if (more) {
      kp -= 64 * 512; vp -= 64;
      rk0 = *(const uint4*)kp; rk1 = *(const uint4*)(kp + 32 * 512);
      rv0 = *(const uint4*)vp; rv1 = *(const uint4*)(vp + (size_t)64 * ldT);
    }
    if (active && kt < my_nkt) {
      const unsigned char* Kt = sb + (j & 1) * AT_STAGE;
      const unsigned char* Vt = Kt + AT_KBYTES;
      f32x16 s[2];
      const bool past = (kt * 64 + 63) < (qpos0 + rg * 32);
      if (past) {
        const float kb0 = slope2 * (float)(kt * 64 + 4 * h);
#pragma unroll
        for (int sub = 0; sub < 2; ++sub)
#pragma unroll
          for (int i = 0; i < 16; ++i) s[sub][i] = __builtin_fmaf(slope2, (float)(sub * 32 + (i & 3) + 8 * (i >> 2)), kb0);
      } else {
        zero16(s[0]); zero16(s[1]);
      }
#pragma unroll
      for (int ks = 0; ks < 4; ++ks) {
#pragma unroll
        for (int sub = 0; sub < 2; ++sub) {
          const bf16x8 kf = *(const bf16x8*)(Kt + (sub * 32 + r) * 272 + (comp * 64 + ks * 16 + h * 8) * 2);
          s[sub] = MFMA(kf, qf[ks], s[sub]);
        }
      }
      float mx = -INFINITY;
      if (!past) {
        const float qk0 = (float)(qpos - kt * 64 - 4 * h);
        const float qb = slope2 * (float)qpos;
#pragma unroll
        for (int sub = 0; sub < 2; ++sub)
#pragma unroll
          for (int i = 0; i < 16; ++i) {
            const float d = qk0 - (float)(sub * 32 + (i & 3) + 8 * (i >> 2));
            s[sub][i] = s[sub][i] - slope2 * fabsf(d) + qb;
          }
      }
      if (!prompt) {
#pragma unroll
        for (int sub = 0; sub < 2; ++sub)
#pragma unroll
          for (int i = 0; i < 16; ++i) {
            const int key = kt * 64 + sub * 32 + crow(i, h);
            if (key >= nkeys) s[sub][i] = -INFINITY;
          }
      }
#pragma unroll
      for (int sub = 0; sub < 2; ++sub)
#pragma unroll
        for (int i = 0; i < 16; ++i) mx = fmaxf(mx, s[sub][i]);
      mx = fmaxf(mx, shx(mx, 32, lane));
      const bool livelane = !(mx - m_run < -150.f);
      if (__ballot(livelane) != 0ull) {
        const float m_new = fmaxf(m_run, mx);
        const float alpha = fexp2(m_run - m_new);
        m_run = m_new;
        float lsum = 0.f;
#pragma unroll
        for (int sub = 0; sub < 2; ++sub)
#pragma unroll
          for (int i = 0; i < 16; ++i) {
            const float pv = fexp2(s[sub][i] - m_new);
            lsum += pv;
            s[sub][i] = pv;
          }
        l_run = l_run * alpha + lsum;
        if (__ballot(alpha != 1.f) != 0ull) {
#pragma unroll
          for (int dt = 0; dt < 4; ++dt)
#pragma unroll
            for (int i = 0; i < 16; ++i) O[dt][i] *= alpha;
        }
#pragma unroll
        for (int sub = 0; sub < 2; ++sub)
#pragma unroll
          for (int s2 = 0; s2 < 2; ++s2) {
            const bf16x8 pf = pack8(s[sub], s2);
#pragma unroll
            for (int dt = 0; dt < 4; ++dt) {
              const unsigned char* va = Vt + (dt * 32 + r) * 136 + (sub * 32 + s2 * 16 + 4 * h) * 2;
              const uint2 lo = *(const uint2*)va;
              const uint2 hi = *(const uint2*)(va + 16);
              const uint4 vv = make_uint4(lo.x, lo.y, hi.x, hi.y);
              O[dt] = MFMA(__builtin_bit_cast(bf16x8, vv), pf, O[dt]);
            }
          }
      }
    }
    if (more) {
      unsigned char* sn = sb + ((j + 1) & 1) * AT_STAGE;
      *(uint4*)(sn + krow * 272 + kcc * 16) = rk0;
      *(uint4*)(sn + (krow + 32) * 272 + kcc * 16) = rk1;
      *(uint2*)(sn + AT_KBYTES + vrow * 136 + vcc * 16) = make_uint2(rv0.x, rv0.y);
      *(uint2*)(sn + AT_KBYTES + vrow * 136 + vcc * 16 + 8) = make_uint2(rv0.z, rv0.w);
      *(uint2*)(sn + AT_KBYTES + (vrow + 64) * 136 + vcc * 16) = make_uint2(rv1.x, rv1.y);
      *(uint2*)(sn + AT_KBYTES + (vrow + 64) * 136 + vcc * 16 + 8) = make_uint2(rv1.z, rv1.w);
    }
    __syncthreads();
  }
  float* exch = (float*)(smem + AT_BASE);
  float inv = 0.f;
  if (active) { const float lt = l_run + shx(l_run, 32, lane); inv = 1.f / lt; }
  if (active && comp == 1) {
    const float sc = inv * lam;
#pragma unroll
    for (int dt = 0; dt < 4; ++dt)
#pragma unroll
      for (int i = 0; i < 16; ++i) exch[(rg * 64 + dt * 16 + i) * 64 + lane] = O[dt][i] * sc;
  }
  __syncthreads();
  if (active && comp == 0) {
    float ss = 0.f;
#pragma unroll
    for (int dt = 0; dt < 4; ++dt)
#pragma unroll
      for (int i = 0; i < 16; ++i) {
        const float o = O[dt][i] * inv - exch[(rg * 64 + dt * 16 + i) * 64 + lane];
        O[dt][i] = o;
        ss += o * o;
      }
    ss += shx(ss, 32, lane);
    const float rs = rsqrtf(ss * (1.f / 128.f) + LN_EPS) * (1.f - lam_init);
    u16* AN = (u16*)(p.ws + WS_AN) + (size_t)(qtok0 + rg * 32 + r) * 512 + head * 128;
    const float* gw = p.in[17] + l * 512 + head * 128;
#pragma unroll
    for (int dt = 0; dt < 4; ++dt)
#pragma unroll
      for (int g = 0; g < 4; ++g) {
        const int dv = dt * 32 + 8 * g + 4 * h;
        const float4 g4 = *(const float4*)(gw + dv);
        uint2 o;
        o.x = pack2(O[dt][4 * g] * rs * g4.x, O[dt][4 * g + 1] * rs * g4.y);
        o.y = pack2(O[dt][4 * g + 2] * rs * g4.z, O[dt][4 * g + 3] * rs * g4.w);
        *(uint2*)(AN + dv) = o;
      }
  }
}

constexpr int ML_QS = 64;
constexpr int ML_KS = ML_QS + 64 * 272;
constexpr int ML_KT = ML_KS + 64 * 272;
constexpr int ML_VT = ML_KT + 128 * 144;
constexpr int ML_CB = ML_VT + 128 * 144;
constexpr int ML_HB = ML_CB + 128 * 272;
constexpr int ML_SM = ML_HB + 64 * 132 * 4;
static_assert(ML_SM + 528 * 4 <= LDS_BYTES, "lds");

DI void mlstm_item(const Params& p, int l, int b, int head, unsigned char* smem) {
  const int tid = otid(), lane = tid & 63, w = tid >> 6, r = lane & 31, h = lane >> 5;
  const bool prompt = b < 32;
  const int bs = b - 32;
  const int T = prompt ? 2048 : 32;
  const int nch = prompt ? 32 : 1;
  const int L = prompt ? 64 : 32;
  const int tokbase = prompt ? b * 2048 : TOKP + bs * 32;
  const u16* qkT = prompt ? (const u16*)(p.ws + WS_MQKT_P) + (size_t)b * 1024 * 2048 : (const u16*)(p.ws + WS_MQKT_S) + (size_t)bs * 1024 * 32;
  const u16* vTg = prompt ? (const u16*)(p.ws + WS_MVT_P) + (size_t)b * 512 * 2048 : (const u16*)(p.ws + WS_MVT_S) + (size_t)bs * 512 * 32;
  u16* qs = (u16*)(smem + ML_QS);
  u16* ksm = (u16*)(smem + ML_KS);
  u16* kTw = (u16*)(smem + ML_KT);
  u16* vT = (u16*)(smem + ML_VT);
  u16* Cbf = (u16*)(smem + ML_CB);
  float* hbuf = (float*)(smem + ML_HB);
  float* a_s = (float*)(smem + ML_SM);
  float* mx_s = a_s + 64;
  float* ws_s = a_s + 128;
  float* wi_s = a_s + 192;
  float* emt_s = a_s + 256;
  float* nq_s = a_s + 320;
  float* nvec = a_s + 384;
  float* scal = a_s + 512;

  const int vt = w & 3, kt0 = (w >> 2) * 2;
  f32x16 accC[2];
  float m_run = 0.f;
  if (prompt) {
    zero16(accC[0]); zero16(accC[1]);
    if (tid < 128) nvec[tid] = 0.f;
  } else {
    const float* Cs = p.in[6] + ((size_t)(l * 8 + bs) * 4 + head) * 128 * 128;
#pragma unroll
    for (int q = 0; q < 2; ++q)
#pragma unroll
      for (int g = 0; g < 4; ++g) {
        const float4 c4 = *(const float4*)(Cs + (size_t)(vt * 32 + r) * 128 + (kt0 + q) * 32 + 8 * g + 4 * h);
        accC[q][4 * g] = c4.x; accC[q][4 * g + 1] = c4.y; accC[q][4 * g + 2] = c4.z; accC[q][4 * g + 3] = c4.w;
      }
    if (tid < 128) nvec[tid] = p.in[7][((size_t)(l * 8 + bs) * 4 + head) * 128 + tid];
    m_run = p.in[8][(l * 8 + bs) * 4 + head];
  }
#pragma unroll
  for (int q = 0; q < 2; ++q)
#pragma unroll
    for (int g = 0; g < 4; ++g) {
      uint2 o; o.x = pack2(accC[q][4 * g], accC[q][4 * g + 1]); o.y = pack2(accC[q][4 * g + 2], accC[q][4 * g + 3]);
      *(uint2*)(Cbf + (vt * 32 + r) * 136 + (kt0 + q) * 32 + 8 * g + 4 * h) = o;
    }
  const float* gatesp = (const float*)(p.ws + WS_GATES);
  const int vi = w >> 1, ti = w & 1;

  float ig_n = -INFINITY, fg_n = 0.f;
  if (w == 0 && lane < L) {
    const float* gp = gatesp + (size_t)(tokbase + lane) * 8;
    ig_n = gp[head]; fg_n = gp[4 + head];
  }
  for (int c = 0; c < nch; ++c) {
    const int t0 = c * 64;
    if (w == 0) {
      const int t = lane;
      float ig = -INFINITY, lf = 0.f;
      if (t < L) {
        ig = ig_n;
        const float fg = fg_n;
        lf = fminf(fg, 0.f) - log1pf(__expf(-fabsf(fg)));
        if (c + 1 < nch) {
          const float* gp = gatesp + (size_t)(tokbase + t0 + 64 + t) * 8;
          ig_n = gp[head]; fg_n = gp[4 + head];
        }
      }
      float bc = lf;
#pragma unroll
      for (int off = 1; off < 64; off <<= 1) { const float v = shidx(bc, lane - off, lane); if (lane >= off) bc += v; }
      const float a = ig - bc;
      float M = a;
#pragma unroll
      for (int off = 1; off < 64; off <<= 1) { const float v = shidx(M, lane - off, lane); if (lane >= off) M = fmaxf(M, v); }
      const float mx = fmaxf(m_run, M);
      const float bL = shidx(bc, 63, lane);
      const float mxL = shidx(mx, 63, lane);
      a_s[t] = a; mx_s[t] = mx;
      ws_s[t] = __expf(a - mxL);
      wi_s[t] = __expf(m_run - mx);
      emt_s[t] = __expf(-(bc + mx));
      if (lane == 0) scal[1] = __expf(m_run - mxL);
      m_run = bL + mxL;
    }
    const int ch2 = tid >> 1, th = tid & 1;
    const bool isk = ch2 >= 128;
    const int dd = ch2 & 127;
    const int ch = (isk ? 512 : 0) + head * 128 + dd;
    const u16* rp = qkT + (size_t)ch * T + t0 + th * 32;
    float um3 = 0.f, um2 = 0.f, um1 = 0.f;
    const bool ldrow = prompt || th == 0;
    uint4 uu0 = make_uint4(0, 0, 0, 0), uu1 = uu0, uu2 = uu0, uu3 = uu0, vv0 = uu0, vv1 = uu0;
    if (ldrow) { uu0 = *(const uint4*)(rp); uu1 = *(const uint4*)(rp + 8); uu2 = *(const uint4*)(rp + 16); uu3 = *(const uint4*)(rp + 24); }
    {
      const int row = tid >> 3, cc = tid & 7;
      if (prompt || cc < 4) {
        vv0 = *(const uint4*)(vTg + (size_t)(head * 128 + row) * T + t0 + cc * 8);
        vv1 = *(const uint4*)(vTg + (size_t)(head * 128 + row + 64) * T + t0 + cc * 8);
      }
    }
    if (prompt) {
      if (th == 1 || c > 0) {
        const uint2 pv = *(const uint2*)(rp - 4);
        um3 = bfhi(pv.x); um2 = bflo(pv.y); um1 = bfhi(pv.y);
      }
    } else if (th == 0) {
      const float* cvp = p.in[9] + (size_t)(l * 8 + bs) * 3 * 1024 + ch;
      um3 = cvp[0]; um2 = cvp[1024]; um1 = cvp[2048];
    }
    const float cw0 = p.in[14][(l * 4 + 0) * 1024 + ch], cw1 = p.in[14][(l * 4 + 1) * 1024 + ch];
    const float cw2 = p.in[14][(l * 4 + 2) * 1024 + ch], cw3 = p.in[14][(l * 4 + 3) * 1024 + ch];
    const float cb = p.in[15][l * 1024 + ch];
    __syncthreads();
    {
      u16* dstrm = (isk ? ksm : qs) + (th * 32) * 136 + dd;
      const float oscale = isk ? 0.08838834764831845f : 1.f;
#pragma unroll
      for (int i = 0; i < 4; ++i) {
        const uint4 uu = (i == 0) ? uu0 : (i == 1 ? uu1 : (i == 2 ? uu2 : uu3));
        float u[8];
        u[0] = bflo(uu.x); u[1] = bfhi(uu.x); u[2] = bflo(uu.y); u[3] = bfhi(uu.y);
        u[4] = bflo(uu.z); u[5] = bfhi(uu.z); u[6] = bflo(uu.w); u[7] = bfhi(uu.w);
        float y[8];
#pragma unroll
        for (int e = 0; e < 8; ++e) {
          const float x3 = (e >= 3) ? u[e - 3] : (e == 0 ? um3 : (e == 1 ? um2 : um1));
          const float x2 = (e >= 2) ? u[e - 2] : (e == 0 ? um2 : um1);
          const float x1 = (e >= 1) ? u[e - 1] : um1;
          const float yy = cb + cw0 * x3 + cw1 * x2 + cw2 * x1 + cw3 * u[e];
          y[e] = siluf_(yy) * oscale;
        }
        um3 = u[5]; um2 = u[6]; um1 = u[7];
#pragma unroll
        for (int e = 0; e < 8; ++e) dstrm[(i * 8 + e) * 136] = f2bf(y[e]);
        if (isk) {
          const float4 w0 = *(const float4*)(ws_s + th * 32 + i * 8);
          const float4 w1 = *(const float4*)(ws_s + th * 32 + i * 8 + 4);
          uint4 o;
          o.x = pack2(y[0] * w0.x, y[1] * w0.y); o.y = pack2(y[2] * w0.z, y[3] * w0.w);
          o.z = pack2(y[4] * w1.x, y[5] * w1.y); o.w = pack2(y[6] * w1.z, y[7] * w1.w);
          *(uint4*)(kTw + dd * 72 + th * 32 + i * 8) = o;
        }
      }
      {
        const int row = tid >> 3, cc = tid & 7;
        *(uint4*)(vT + row * 72 + cc * 8) = vv0;
        *(uint4*)(vT + (row + 64) * 72 + cc * 8) = vv1;
      }
    }
    __syncthreads();
    {
      const int t = tid >> 3, part = tid & 7;
      const uint4 q0 = *(const uint4*)(qs + t * 136 + part * 16);
      const uint4 q1 = *(const uint4*)(qs + t * 136 + part * 16 + 8);
      const float* nv = nvec + part * 16;
      float s = bflo(q0.x) * nv[0] + bfhi(q0.x) * nv[1] + bflo(q0.y) * nv[2] + bfhi(q0.y) * nv[3]
              + bflo(q0.z) * nv[4] + bfhi(q0.z) * nv[5] + bflo(q0.w) * nv[6] + bfhi(q0.w) * nv[7]
              + bflo(q1.x) * nv[8] + bfhi(q1.x) * nv[9] + bflo(q1.y) * nv[10] + bfhi(q1.y) * nv[11]
              + bflo(q1.z) * nv[12] + bfhi(q1.z) * nv[13] + bflo(q1.w) * nv[14] + bfhi(q1.w) * nv[15];
      s += shx(s, 1, lane); s += shx(s, 2, lane); s += shx(s, 4, lane);
      if (part == 0) nq_s[t] = s;
    }
    f32x16 accS[2], accO;
    zero16(accS[0]); zero16(accS[1]); zero16(accO);
    {
#pragma unroll
      for (int ks = 0; ks < 8; ++ks) {
        const bf16x8 qfr = *(const bf16x8*)(qs + (ti * 32 + r) * 136 + ks * 16 + h * 8);
        const bf16x8 k0 = *(const bf16x8*)(ksm + r * 136 + ks * 16 + h * 8);
        accS[0] = MFMA(k0, qfr, accS[0]);
        if (ti == 1) {
          const bf16x8 k1 = *(const bf16x8*)(ksm + (32 + r) * 136 + ks * 16 + h * 8);
          accS[1] = MFMA(k1, qfr, accS[1]);
        }
        const bf16x8 cf = *(const bf16x8*)(Cbf + (vi * 32 + r) * 136 + ks * 16 + h * 8);
        accO = MFMA(cf, qfr, accO);
      }
    }
    const int tcol = ti * 32 + r;
    const float mxt = mx_s[tcol];
    const float wit = wi_s[tcol];
    float dsum = 0.f;
#pragma unroll
    for (int sub = 0; sub < 2; ++sub) {
      if (sub <= ti) {
#pragma unroll
        for (int g = 0; g < 4; ++g) {
          const float4 a4 = *(const float4*)(a_s + sub * 32 + 8 * g + 4 * h);
          const float av[4] = {a4.x, a4.y, a4.z, a4.w};
#pragma unroll
          for (int e = 0; e < 4; ++e) {
            const int s = sub * 32 + 8 * g + 4 * h + e;
            const float wgt = (s <= tcol) ? __expf(av[e] - mxt) : 0.f;
            const float pv = accS[sub][4 * g + e] * wgt;
            accS[sub][4 * g + e] = pv;
            dsum += pv;
          }
        }
      }
    }
    dsum += shx(dsum, 32, lane);
#pragma unroll
    for (int i = 0; i < 16; ++i) accO[i] *= wit;
#pragma unroll
    for (int sub = 0; sub < 2; ++sub) {
      if (sub <= ti) {
#pragma unroll
        for (int s2 = 0; s2 < 2; ++s2) {
          const bf16x8 pf = pack8(accS[sub], s2);
          const u16* va = vT + (vi * 32 + r) * 72 + sub * 32 + s2 * 16 + 4 * h;
          const uint2 lo = *(const uint2*)va;
          const uint2 hi = *(const uint2*)(va + 8);
          const uint4 vq = make_uint4(lo.x, lo.y, hi.x, hi.y);
          accO = MFMA(__builtin_bit_cast(bf16x8, vq), pf, accO);
        }
      }
    }
    __syncthreads();
    {
      const float den = dsum + wit * nq_s[tcol];
      const float dn = fmaxf(fabsf(den), emt_s[tcol]);
      const float rinv = 1.f / dn;
#pragma unroll
      for (int g = 0; g < 4; ++g)
        *(float4*)(hbuf + tcol * 132 + vi * 32 + 8 * g + 4 * h) =
            make_float4(accO[4 * g] * rinv, accO[4 * g + 1] * rinv, accO[4 * g + 2] * rinv, accO[4 * g + 3] * rinv);
    }
    {
      const float wc = scal[1];
#pragma unroll
      for (int q = 0; q < 2; ++q)
#pragma unroll
        for (int i = 0; i < 16; ++i) accC[q][i] *= wc;
#pragma unroll
      for (int k4 = 0; k4 < 4; ++k4) {
        const bf16x8 vf = *(const bf16x8*)(vT + (vt * 32 + r) * 72 + k4 * 16 + h * 8);
#pragma unroll
        for (int q = 0; q < 2; ++q) {
          const bf16x8 kf = *(const bf16x8*)(kTw + ((kt0 + q) * 32 + r) * 72 + k4 * 16 + h * 8);
          accC[q] = MFMA(kf, vf, accC[q]);
        }
      }
#pragma unroll
      for (int q = 0; q < 2; ++q)
#pragma unroll
        for (int g = 0; g < 4; ++g) {
          uint2 o; o.x = pack2(accC[q][4 * g], accC[q][4 * g + 1]); o.y = pack2(accC[q][4 * g + 2], accC[q][4 * g + 3]);
          *(uint2*)(Cbf + (vt * 32 + r) * 136 + (kt0 + q) * 32 + 8 * g + 4 * h) = o;
        }
      if (tid < 128) {
        float s = 0.f;
#pragma unroll
        for (int i = 0; i < 8; ++i) {
          const uint4 kk = *(const uint4*)(kTw + tid * 72 + i * 8);
          s += bflo(kk.x) + bfhi(kk.x) + bflo(kk.y) + bfhi(kk.y) + bflo(kk.z) + bfhi(kk.z) + bflo(kk.w) + bfhi(kk.w);
        }
        nvec[tid] = wc * nvec[tid] + s;
      }
    }
    __syncthreads();
    {
      const int t = tid >> 3, part = tid & 7;
      float x[16];
#pragma unroll
      for (int i = 0; i < 4; ++i) {
        const float4 f = *(const float4*)(hbuf + t * 132 + part * 16 + i * 4);
        x[i * 4] = f.x; x[i * 4 + 1] = f.y; x[i * 4 + 2] = f.z; x[i * 4 + 3] = f.w;
      }
      float s = 0.f;
#pragma unroll
      for (int i = 0; i < 16; ++i) s += x[i];
      s += shx(s, 1, lane); s += shx(s, 2, lane); s += shx(s, 4, lane);
      const float mean = s * (1.f / 128.f);
      float q = 0.f;
#pragma unroll
      for (int i = 0; i < 16; ++i) { x[i] -= mean; q += x[i] * x[i]; }
      q += shx(q, 1, lane); q += shx(q, 2, lane); q += shx(q, 4, lane);
      const float rstd = rsqrtf(q * (1.f / 128.f) + LN_EPS);
      if (t < L) {
        const size_t tok = (size_t)tokbase + t0 + t;
        const int cbase = head * 128 + part * 16;
        const float* gw = p.in[18] + l * 512 + cbase;
        const u16* mo = (const u16*)(p.ws + WS_MO) + tok * 512 + cbase;
        const uint4 m0 = *(const uint4*)mo;
        const uint4 m1 = *(const uint4*)(mo + 8);
        const float sg[16] = {bflo(m0.x), bfhi(m0.x), bflo(m0.y), bfhi(m0.y), bflo(m0.z), bfhi(m0.z), bflo(m0.w), bfhi(m0.w),
                              bflo(m1.x), bfhi(m1.x), bflo(m1.y), bfhi(m1.y), bflo(m1.z), bfhi(m1.z), bflo(m1.w), bfhi(m1.w)};
        float yv[16];
#pragma unroll
        for (int i = 0; i < 16; ++i) yv[i] = x[i] * rstd * gw[i] * sg[i];
        uint4 o0, o1;
        o0.x = pack2(yv[0], yv[1]); o0.y = pack2(yv[2], yv[3]); o0.z = pack2(yv[4], yv[5]); o0.w = pack2(yv[6], yv[7]);
        o1.x = pack2(yv[8], yv[9]); o1.y = pack2(yv[10], yv[11]); o1.z = pack2(yv[12], yv[13]); o1.w = pack2(yv[14], yv[15]);
        u16* mn = (u16*)(p.ws + WS_MN) + tok * 512 + cbase;
        *(uint4*)mn = o0;
        *(uint4*)(mn + 8) = o1;
      }
    }
  }
  {
    float* oc = p.out + (prompt ? O_CP + ((size_t)(l * 32 + b) * 4 + head) * 16384 : O_CS + ((size_t)(l * 8 + bs) * 4 + head) * 16384);
#pragma unroll
    for (int q = 0; q < 2; ++q)
#pragma unroll
      for (int g = 0; g < 4; ++g)
        *(float4*)(oc + (size_t)(vt * 32 + r) * 128 + (kt0 + q) * 32 + 8 * g + 4 * h) =
            make_float4(accC[q][4 * g], accC[q][4 * g + 1], accC[q][4 * g + 2], accC[q][4 * g + 3]);
    float* on = p.out + (prompt ? O_NP + ((size_t)(l * 32 + b) * 4 + head) * 128 : O_NS + ((size_t)(l * 8 + bs) * 4 + head) * 128);
    if (tid < 128) on[tid] = nvec[tid];
    if (tid == 0) {
      if (prompt) p.out[O_MP + (size_t)(l * 32 + b) * 4 + head] = m_run;
      else p.out[O_MS + (size_t)(l * 8 + bs) * 4 + head] = m_run;
    }
  }
}

DI void phase_mixers(const Params& p, int l, unsigned char* smem) {
  const int tid0 = otid();
  const int lane = tid0 & 63;
  const float* lp = p.in[16] + l * 256;
  float s1 = lp[lane] * lp[64 + lane], s2 = lp[128 + lane] * lp[192 + lane];
  s1 = wave_sum(s1, lane); s2 = wave_sum(s2, lane);
  const float lam_init = 0.8f - 0.6f * expf(-0.3f * (float)l);
  const float lam = expf(s1) - expf(s2) + lam_init;
  int* ctr = (int*)(p.ws + WS_CTR) + l;
  int* sitem = (int*)smem;
  const int N_ML = 160, N_AT = 2048 + 32;
  for (;;) {
    __syncthreads();
    if (tid0 == 0) *sitem = atomicAdd(ctr, 1);
    __syncthreads();
    const int item = *sitem;
    if (item >= N_ML + N_AT) break;
    if (item < N_ML) {
#ifndef NO_ML
      mlstm_item(p, l, item >> 2, item & 3, smem);
#endif
    } else {
#ifndef NO_AT
      const int a = item - N_ML;
      if (a < 2048) {
        const int qt = 15 - (a >> 7), rest = a & 127;
        attn_item(p, l, rest >> 2, rest & 3, qt, lam, lam_init, smem);
      } else {
        const int s = a - 2048;
        attn_item(p, l, 32 + (s >> 2), s & 3, 0, lam, lam_init, smem);
      }
#endif
    }
  }
}

DI void gbar(unsigned* ctl, unsigned& k) {
  __syncthreads();
  ++k;
  if (otid() == 0) {
    __threadfence();
    const unsigned x = blockIdx.x & 7;
    const unsigned gsz = (gridDim.x + 7 - x) >> 3;
    const unsigned ngroups = gridDim.x < 8 ? gridDim.x : 8;
    unsigned* gc = ctl + 64 + x * 32;
    unsigned* gl = ctl + 32;
    const unsigned old = __hip_atomic_fetch_add(gc, 1u, __ATOMIC_RELAXED, __HIP_MEMORY_SCOPE_AGENT);
    if (old + 1 == k * gsz) {
      __threadfence();
      __hip_atomic_fetch_add(gl, 1u, __ATOMIC_RELAXED, __HIP_MEMORY_SCOPE_AGENT);
    }
    while (__hip_atomic_load(gl, __ATOMIC_RELAXED, __HIP_MEMORY_SCOPE_AGENT) < k * ngroups) __builtin_amdgcn_s_sleep(1);
    __threadfence();
  }
  __syncthreads();
}

__global__ void __launch_bounds__(NTHR) fwd_megakernel(Params p) {
  extern __shared__ __attribute__((aligned(16))) unsigned char smem[];
  cg::grid_group grid = cg::this_grid();
#ifndef PH
#define PH 0xffff
#endif
  unsigned* bar = (unsigned*)(p.ws + WS_CTR);
  unsigned epoch = 0;
  if (PH & 1) prologue(p, smem);
  grid.sync();
  if (PH & 1) prologue(p, smem);
  grid.sync();
  if (PH & 2) ln_pass(p, 0, 0, smem);
  gbar(bar, epoch);
#pragma unroll 1
  for (int l = 0; l < 2; ++l) {
    if (PH & 4) phase_in_gate(p, l, smem);
    gbar(bar, epoch);
    if (PH & 8) phase_mixers(p, l, smem);
    gbar(bar, epoch);
    if (PH & 16) phase_mix(p, l, smem);
    gbar(bar, epoch);
    if (PH & 32) phase_res(p, l, 0, smem);
    gbar(bar, epoch);
    if (PH & 64) ln_pass(p, 1, l, smem);
    gbar(bar, epoch);
    if (PH & 128) phase_gu(p, l, smem);
    gbar(bar, epoch);
    if (PH & 256) phase_res(p, l, 1, smem);
    gbar(bar, epoch);
    if (PH & 512) ln_pass(p, 2, l, smem);
    if (l == 0) gbar(bar, epoch);
  }
}

extern "C" void kernel_launch(void* const* d_in, const int* in_sizes, int n_in, void* d_out, int out_size, void* d_ws,
                              size_t ws_size, hipStream_t stream) {
  static int grid_blocks = 0;
  if (!grid_blocks) {
    int dev = 0, cus = 0, per_cu = 0;
    hipGetDevice(&dev);
    hipDeviceGetAttribute(&cus, hipDeviceAttributeMultiprocessorCount, dev);
    if (hipFuncSetAttribute((const void*)fwd_megakernel, hipFuncAttributeMaxDynamicSharedMemorySize, LDS_BYTES) != hipSuccess)
      fprintf(stderr, "kernel_launch: hipFuncSetAttribute failed\n");
    if (hipOccupancyMaxActiveBlocksPerMultiprocessor(&per_cu, (const void*)fwd_megakernel, NTHR, LDS_BYTES) != hipSuccess || per_cu < 1) {
      fprintf(stderr, "kernel_launch: occupancy query gave %d\n", per_cu);
      per_cu = 1;
    }
    (void)hipGetLastError();
    grid_blocks = cus * per_cu;
    if (ws_size < WS_END) fprintf(stderr, "kernel_launch: workspace too small: %zu < %zu\n", ws_size, (size_t)WS_END);
  }
  if (hipMemsetAsync((char*)d_ws + WS_CTR, 0, 4096, stream) != hipSuccess) fprintf(stderr, "kernel_launch: memset failed\n");
  Params p{};
  for (int i = 0; i < 30; ++i) p.in[i] = (const float*)d_in[i];
  p.out = (float*)d_out;
  p.ws = (unsigned char*)d_ws;
  void* args[] = {&p};
  hipError_t e = hipLaunchCooperativeKernel((const void*)fwd_megakernel, dim3(grid_blocks), dim3(NTHR), args, LDS_BYTES, stream);
  if (e != hipSuccess) fprintf(stderr, "cooperative launch failed: %s (grid %d)\n", hipGetErrorString(e), grid_blocks);
}
```

```cpp
#include <hip/hip_runtime.h>
#include <hip/hip_cooperative_groups.h>
#include <cstdio>
namespace cg = cooperative_groups;

#define DI __device__ __forceinline__
typedef unsigned short u16;
using bf16x8 = __attribute__((ext_vector_type(8))) short;
using f32x16 = __attribute__((ext_vector_type(16))) float;
#define MFMA(a, b, c) __builtin_amdgcn_mfma_f32_32x32x16_bf16((a), (b), (c), 0, 0, 0)

constexpr int TOKP = 65536, TOKS = 256, TOK = 65792;
constexpr int NTHR = 512;
constexpr float LN_EPS = 1e-5f;
constexpr float ALPHA = 1.41421356237f;
constexpr float LOG2E = 1.44269504089f;

constexpr size_t WS_WT_IN   = 0;
constexpr size_t WS_WT_GATE = WS_WT_IN + 2ull * 3584 * 1024 * 2;
constexpr size_t WS_WT_BRA  = WS_WT_GATE + 2ull * 2048 * 1024 * 2;
constexpr size_t WS_WT_BRB  = WS_WT_BRA + 2ull * 1024 * 512 * 2;
constexpr size_t WS_WT_O    = WS_WT_BRB + 2ull * 1024 * 512 * 2;
constexpr size_t WS_WT_GU   = WS_WT_O + 2ull * 1024 * 1024 * 2;
constexpr size_t WS_WT_DOWN = WS_WT_GU + 2ull * 5632 * 1024 * 2;
constexpr size_t WS_MOD     = WS_WT_DOWN + 2ull * 1024 * 2816 * 2;
constexpr size_t WS_GATES   = WS_MOD + 2ull * 40 * 6144 * 4;
constexpr size_t WS_CTR     = WS_GATES + (size_t)TOK * 8 * 4;
constexpr size_t WS_STAT    = WS_CTR + 4096;
constexpr size_t WS_KS      = WS_STAT + (size_t)TOK * 8;
constexpr size_t WS_VTS     = WS_KS + 2ull * 8 * 1056 * 512 * 2 + 65536;
constexpr size_t WS_MQKT_S  = WS_VTS + 2ull * 8 * 512 * 1056 * 2 + 65536;
constexpr size_t WS_MVT_S   = WS_MQKT_S + 8ull * 1024 * 32 * 2;
constexpr size_t WS_H       = WS_MVT_S + 8ull * 512 * 32 * 2;
constexpr size_t WS_AN      = WS_H;
constexpr size_t WS_MN      = WS_H + (size_t)TOK * 512 * 2;
constexpr size_t WS_ZQ      = WS_H + (size_t)TOK * 1024 * 2;
constexpr size_t WS_KB      = WS_ZQ + (size_t)TOK * 512 * 2;
constexpr size_t WS_VTP     = WS_KB + (size_t)TOKP * 512 * 2;
constexpr size_t WS_MQKT_P  = WS_VTP + 32ull * 512 * 2048 * 2;
constexpr size_t WS_MVT_P   = WS_MQKT_P + 32ull * 1024 * 2048 * 2;
constexpr size_t WS_MO      = WS_MVT_P + 32ull * 512 * 2048 * 2;
constexpr size_t WS_G       = WS_MO + (size_t)TOK * 512 * 2;
constexpr size_t WS_END     = WS_G + (size_t)TOK * 2048 * 2;
constexpr size_t WS_MIX     = WS_ZQ;
constexpr size_t WS_ACT     = WS_ZQ;

constexpr size_t O_YP  = 0;
constexpr size_t O_YS  = O_YP + (size_t)TOKP * 1024;
constexpr size_t O_KP  = O_YS + (size_t)TOKS * 1024;
constexpr size_t O_VP  = O_KP + 2ull * TOKP * 512;
constexpr size_t O_KSM = O_VP + 2ull * TOKP * 512;
constexpr size_t O_VSM = O_KSM + 2ull * TOKS * 512;
constexpr size_t O_CP  = O_VSM + 2ull * TOKS * 512;
constexpr size_t O_NP  = O_CP + 2ull * 32 * 4 * 128 * 128;
constexpr size_t O_MP  = O_NP + 2ull * 32 * 4 * 128;
constexpr size_t O_CVP = O_MP + 2ull * 32 * 4;
constexpr size_t O_CS  = O_CVP + 2ull * 32 * 3 * 1024;
constexpr size_t O_NS  = O_CS + 2ull * 8 * 4 * 128 * 128;
constexpr size_t O_MS  = O_NS + 2ull * 8 * 4 * 128;
constexpr size_t O_CVS = O_MS + 2ull * 8 * 4;

constexpr int LDS_BYTES = 148480;

struct Params {
  const float* in[30];
  float* out;
  unsigned char* ws;
};

DI u16 f2bf(float x) { unsigned u = __float_as_uint(x); u += 0x7fffu + ((u >> 16) & 1u); return (u16)(u >> 16); }
DI float bf2f(unsigned v) { return __uint_as_float(v << 16); }
typedef __bf16 bf16x2_t __attribute__((ext_vector_type(2)));
typedef float f32x2_t __attribute__((ext_vector_type(2)));
DI unsigned pack2(float a, float b) {
  f32x2_t v = {a, b};
  return __builtin_bit_cast(unsigned, __builtin_convertvector(v, bf16x2_t));
}
DI float bflo(unsigned v) { return __uint_as_float(v << 16); }
DI float bfhi(unsigned v) { return __uint_as_float(v & 0xffff0000u); }
DI float sigmoidf_(float x) { return 1.f / (1.f + __expf(-x)); }
DI float siluf_(float x) { return x / (1.f + __expf(-x)); }
DI float fexp2(float x) { return __builtin_amdgcn_exp2f(x); }
DI int otid() { int t = threadIdx.x; asm volatile("" : "+v"(t)); return t; }
DI float shx(float v, int mask, int lane) { return __int_as_float(__builtin_amdgcn_ds_bpermute(((lane ^ mask) & 63) << 2, __float_as_int(v))); }
DI float shidx(float v, int src, int lane) { (void)lane; return __int_as_float(__builtin_amdgcn_ds_bpermute((src & 63) << 2, __float_as_int(v))); }
DI int crow(int i, int h) { return (i & 3) + 8 * (i >> 2) + 4 * h; }
DI bf16x8 pack8(const f32x16& x, int s) {
  uint4 u;
  u.x = pack2(x[8 * s + 0], x[8 * s + 1]); u.y = pack2(x[8 * s + 2], x[8 * s + 3]);
  u.z = pack2(x[8 * s + 4], x[8 * s + 5]); u.w = pack2(x[8 * s + 6], x[8 * s + 7]);
  return __builtin_bit_cast(bf16x8, u);
}
DI void zero16(f32x16& a) {
#pragma unroll
  for (int i = 0; i < 16; ++i) a[i] = 0.f;
}
DI int batch_of_row(int row) { return row < TOKP ? (row >> 11) : 32 + ((row - TOKP) >> 5); }

constexpr int GS_STRIDE = 144;
constexpr int GS_STAGE = 512 * GS_STRIDE;
constexpr int GS_BASE = 64;

DI void gemm_mainloop(f32x16 (&acc)[4][2], const u16* __restrict__ A, int lda, const u16* __restrict__ Wt, int ldw, int K,
                      int m0, int n0, unsigned char* smem) {
  const int tid = otid(), lane = tid & 63, w = tid >> 6;
  const int wm = w >> 2, wn = w & 3, r = lane & 31, h = lane >> 5;
  const int lrow = tid >> 3, lcc = tid & 7;
  const u16* ap = A + (size_t)(m0 + lrow) * lda + lcc * 8;
  const int bn = n0 + 2 * (lrow & 31) + ((lrow >> 5) & 1);
  const u16* bp = Wt + (size_t)bn * ldw + lcc * 8;
  const size_t astep = (size_t)64 * lda, bstep = (size_t)64 * ldw;
  unsigned char* sbase = smem + GS_BASE;
  const int woff = lrow * GS_STRIDE + lcc * 16;
  const int nk = K >> 6;
  uint4 s0, s1, s2, s3, s4, s5, s6, s7, u0, u1, u2, u3, u4, u5, u6, u7;
  int kn = 1;
#define G_ADV() do { const int adv = (kn < nk) ? 64 : 0; ap += adv; bp += adv; ++kn; } while (0)
#define G_ISSUE_A() do { s0 = *(const uint4*)(ap); s1 = *(const uint4*)(ap + astep); s2 = *(const uint4*)(ap + 2 * astep); s3 = *(const uint4*)(ap + 3 * astep); \
    s4 = *(const uint4*)(bp); s5 = *(const uint4*)(bp + bstep); s6 = *(const uint4*)(bp + 2 * bstep); s7 = *(const uint4*)(bp + 3 * bstep); } while (0)
#define G_ISSUE_B() do { u0 = *(const uint4*)(ap); u1 = *(const uint4*)(ap + astep); u2 = *(const uint4*)(ap + 2 * astep); u3 = *(const uint4*)(ap + 3 * astep); \
    u4 = *(const uint4*)(bp); u5 = *(const uint4*)(bp + bstep); u6 = *(const uint4*)(bp + 2 * bstep); u7 = *(const uint4*)(bp + 3 * bstep); } while (0)
#define G_WRITE_A(sn) do { *(uint4*)((sn) + woff) = s0; *(uint4*)((sn) + woff + 64 * GS_STRIDE) = s1; *(uint4*)((sn) + woff + 128 * GS_STRIDE) = s2; \
    *(uint4*)((sn) + woff + 192 * GS_STRIDE) = s3; *(uint4*)((sn) + woff + 256 * GS_STRIDE) = s4; *(uint4*)((sn) + woff + 320 * GS_STRIDE) = s5; \
    *(uint4*)((sn) + woff + 384 * GS_STRIDE) = s6; *(uint4*)((sn) + woff + 448 * GS_STRIDE) = s7; } while (0)
#define G_WRITE_B(sn) do { *(uint4*)((sn) + woff) = u0; *(uint4*)((sn) + woff + 64 * GS_STRIDE) = u1; *(uint4*)((sn) + woff + 128 * GS_STRIDE) = u2; \
    *(uint4*)((sn) + woff + 192 * GS_STRIDE) = u3; *(uint4*)((sn) + woff + 256 * GS_STRIDE) = u4; *(uint4*)((sn) + woff + 320 * GS_STRIDE) = u5; \
    *(uint4*)((sn) + woff + 384 * GS_STRIDE) = u6; *(uint4*)((sn) + woff + 448 * GS_STRIDE) = u7; } while (0)
  const int aoff = (wm * 128 + r) * GS_STRIDE + h * 16;
  const int boff = (256 + wn * 64 + r) * GS_STRIDE + h * 16;
#define G_COMPUTE(st) do { _Pragma("unroll") for (int ks = 0; ks < 4; ++ks) {                                              \
      bf16x8 fa[4], fb[2];                                                                                               \
      _Pragma("unroll") for (int mi = 0; mi < 4; ++mi) fa[mi] = *(const bf16x8*)((st) + aoff + mi * 32 * GS_STRIDE + ks * 32); \
      fb[0] = *(const bf16x8*)((st) + boff + ks * 32);                                                                   \
      fb[1] = *(const bf16x8*)((st) + boff + 32 * GS_STRIDE + ks * 32);                                                  \
      _Pragma("unroll") for (int mi = 0; mi < 4; ++mi) {                                                                 \
        acc[mi][0] = MFMA(fa[mi], fb[0], acc[mi][0]);                                                                    \
        acc[mi][1] = MFMA(fa[mi], fb[1], acc[mi][1]);                                                                    \
      }                                                                                                                  \
      __builtin_amdgcn_sched_barrier(0);                                                                                 \
    } } while (0)
  G_ISSUE_A();
  G_WRITE_A(sbase);
  G_ADV(); G_ISSUE_A();
  G_ADV(); G_ISSUE_B();
  __syncthreads();
  for (int kt = 0; kt < nk; kt += 2) {
    G_WRITE_A(sbase + GS_STAGE);
    G_ADV(); G_ISSUE_A();
    __builtin_amdgcn_sched_barrier(0);
    G_COMPUTE(sbase);
    __syncthreads();
    G_WRITE_B(sbase);
    G_ADV(); G_ISSUE_B();
    __builtin_amdgcn_sched_barrier(0);
    G_COMPUTE(sbase + GS_STAGE);
    __syncthreads();
  }
#undef G_ADV
#undef G_ISSUE_A
#undef G_ISSUE_B
#undef G_WRITE_A
#undef G_WRITE_B
#undef G_COMPUTE
}

DI int rot_unused_(int) { return 0; }
DI bool tile_of(int i, int MT, int NT, int& mt, int& nt) {
  const int per = gridDim.x >> 3;
  const int L = i * (int)gridDim.x + (int)(blockIdx.x & 7) * per + (int)(blockIdx.x >> 3);
  if (L >= MT * NT) return false;
  const int nig = 8 * NT, gid = L / nig, fm = gid * 8, gsz = min(MT - fm, 8), rem = L - gid * nig;
  mt = fm + rem % gsz; nt = rem / gsz;
  return true;
}


template <class PF, class EF>
DI void gemm_stream(int lda, int ldw, int K, unsigned char* smem, PF ptrs, EF epi) {
  const int tid = otid(), lane = tid & 63, w = tid >> 6;
  const int wm = w >> 2, wn = w & 3, r = lane & 31, h = lane >> 5;
  unsigned char* sbase = smem + GS_BASE;
  constexpr int SLOT = 512 * 64;
  const int nh = K >> 5;
  const int c0 = (h ^ ((r >> 2) & 3)) * 16, c1 = c0 ^ 32;
  const int aoff = (wm * 128 + r) * 64, boff = (256 + wn * 64 + r) * 64;
  const int lr16 = lane >> 2, lchunk = (lane & 3) ^ ((lane >> 4) & 3);
  const int wu = __builtin_amdgcn_readfirstlane(w);
  const bool isB = wu >= 4;
  const unsigned goff = isB ? (unsigned)((((wu - 4) * 64 + 2 * lr16) * ldw + lchunk * 8) * 2)
                            : (unsigned)(((wu * 64 + lr16) * lda + lchunk * 8) * 2);
  const unsigned st1 = isB ? (unsigned)(32 * ldw * 2) : (unsigned)(16 * lda * 2);
  const unsigned st2 = isB ? (unsigned)(1 * ldw * 2) : (unsigned)(32 * lda * 2);
#define WAIT_V(n) asm volatile("s_waitcnt vmcnt(" #n ")" ::: "memory")
#define RAWBAR() do { asm volatile("s_waitcnt lgkmcnt(0)" ::: "memory"); __builtin_amdgcn_s_barrier(); asm volatile("" ::: "memory"); } while (0)
#define BAR0() do { asm volatile("" ::: "memory"); __builtin_amdgcn_s_barrier(); asm volatile("" ::: "memory"); } while (0)
#define H_DMA(slotp) do { const char* gsrc_ = (isB ? bp : ap) + goff; unsigned char* ld_ = (slotp) + wu * 4096;            \
    __builtin_amdgcn_global_load_lds((const unsigned*)(gsrc_), (unsigned*)(ld_), 16, 0, 0);                                  \
    __builtin_amdgcn_global_load_lds((const unsigned*)(gsrc_ + st1), (unsigned*)(ld_ + 1024), 16, 0, 0);                     \
    __builtin_amdgcn_global_load_lds((const unsigned*)(gsrc_ + st2), (unsigned*)(ld_ + 2048), 16, 0, 0);                     \
    __builtin_amdgcn_global_load_lds((const unsigned*)(gsrc_ + st2 + st1), (unsigned*)(ld_ + 3072), 16, 0, 0); } while (0)
#define H_READ(sl) do { _Pragma("unroll") for (int mi = 0; mi < 4; ++mi) {                                                   \
      fa[0][mi] = *(const bf16x8*)((sl) + aoff + mi * 2048 + c0); fa[1][mi] = *(const bf16x8*)((sl) + aoff + mi * 2048 + c1); } \
    fb[0][0] = *(const bf16x8*)((sl) + boff + c0); fb[1][0] = *(const bf16x8*)((sl) + boff + c1);                            \
    fb[0][1] = *(const bf16x8*)((sl) + boff + 2048 + c0); fb[1][1] = *(const bf16x8*)((sl) + boff + 2048 + c1); } while (0)
#define H_MMA() do { _Pragma("unroll") for (int ks = 0; ks < 2; ++ks) { _Pragma("unroll") for (int mi = 0; mi < 4; ++mi) {  \
      acc[mi][0] = MFMA(fa[ks][mi], fb[ks][0], acc[mi][0]);                                                       \
      acc[mi][1] = MFMA(fa[ks][mi], fb[ks][1], acc[mi][1]); } } } while (0)
  const char *ap, *bp;
  {
    const u16 *ta, *tb;
    int it0 = 0;
    asm volatile("" : "+s"(it0));
    if (!ptrs(it0, ta, tb)) return;
    ap = (const char*)ta; bp = (const char*)tb;
  }
  H_DMA(sbase); ap += 64; bp += 64;
  H_DMA(sbase + SLOT); ap += 64; bp += 64;
  for (int it = 0;; ++it) {
    f32x16 acc[4][2];
#pragma unroll
    for (int a = 0; a < 4; ++a)
#pragma unroll
      for (int b = 0; b < 2; ++b) zero16(acc[a][b]);
    H_DMA(sbase + 2 * SLOT); ap += 64; bp += 64;
    WAIT_V(4);
    BAR0();
    if (wm == 1) BAR0();
    int rs = 0;
#pragma unroll 1
    for (int hh = 0; hh < nh; ++hh) {
      bf16x8 fa[2][4], fb[2][2];
      const int rem = nh - 2 - hh;
      H_READ(sbase + rs * SLOT);
      if (hh + 3 < nh) { H_DMA(sbase + ((rs + 3) & 3) * SLOT); ap += 64; bp += 64; }
      if (wm == 1) {
        if (rem >= 2) WAIT_V(8); else if (rem == 1) WAIT_V(4); else WAIT_V(0);
      }
      __builtin_amdgcn_sched_barrier(0);
      RAWBAR();
      __builtin_amdgcn_sched_barrier(0);
      H_MMA();
      __builtin_amdgcn_sched_barrier(0);
      if (wm == 0) {
        if (rem >= 2) WAIT_V(8); else if (rem == 1) WAIT_V(4); else WAIT_V(0);
      }
      BAR0();
      rs = (rs + 1) & 3;
    }
    if (wm == 0) BAR0();
    bool more;
    {
      const u16 *ta, *tb;
      more = ptrs(it + 1, ta, tb);
      if (more) {
        ap = (const char*)ta; bp = (const char*)tb;
        H_DMA(sbase); ap += 64; bp += 64;
        H_DMA(sbase + SLOT); ap += 64; bp += 64;
      }
    }
    epi(it, acc);
    if (!more) break;
  }
#undef WAIT_V
#undef RAWBAR
#undef BAR0
#undef H_DMA
#undef H_READ
#undef H_MMA
}

DI int map_row(int maptype, int s) {
  if (maptype == 1) return s < 3072 ? s : (s < 3080 ? -1 : s - 8);
  if (maptype == 2) return s < 2816 ? 2 * s : 2 * (s - 2816) + 1;
  return s;
}
DI void transpose_task(const float* __restrict__ src, int Nsrc, u16* __restrict__ dst, int dld, int maptype, int kt2, int nt,
                       unsigned char* smem) {
  float* tile = (float*)(smem + 64);
  const int tid = otid();
  const int k0 = kt2 * 128, s0 = nt * 64;
  float4 v[4];
#pragma unroll
  for (int i = 0; i < 4; ++i) {
    const int kr = (tid >> 4) + 32 * i, nc = (tid & 15) * 4;
    v[i] = make_float4(0.f, 0.f, 0.f, 0.f);
    if (s0 + nc < Nsrc) v[i] = *(const float4*)(src + (size_t)(k0 + kr) * Nsrc + s0 + nc);
  }
#pragma unroll
  for (int i = 0; i < 4; ++i) {
    const int kr = (tid >> 4) + 32 * i, nc = (tid & 15) * 4;
    tile[kr * 65 + nc + 0] = v[i].x; tile[kr * 65 + nc + 1] = v[i].y; tile[kr * 65 + nc + 2] = v[i].z; tile[kr * 65 + nc + 3] = v[i].w;
  }
  __syncthreads();
  {
    const int n = tid >> 3;
    const int s = s0 + n;
    const int dr = (s < Nsrc) ? map_row(maptype, s) : -1;
    if (dr >= 0) {
#pragma unroll
      for (int j = 0; j < 2; ++j) {
        const int kc = (tid & 7) * 8 + 64 * j;
        uint4 o;
        o.x = pack2(tile[(kc + 0) * 65 + n], tile[(kc + 1) * 65 + n]);
        o.y = pack2(tile[(kc + 2) * 65 + n], tile[(kc + 3) * 65 + n]);
        o.z = pack2(tile[(kc + 4) * 65 + n], tile[(kc + 5) * 65 + n]);
        o.w = pack2(tile[(kc + 6) * 65 + n], tile[(kc + 7) * 65 + n]);
        *(uint4*)(dst + (size_t)dr * dld + k0 + kc) = o;
      }
    }
  }
  __syncthreads();
}

DI void adaln_task(const Params& p, int task, unsigned char* smem) {
  const int bhalf = task & 1, cg_ = (task >> 1) % 96, l = (task >> 1) / 96;
  float* cs = (float*)(smem + 64);
  float* red = (float*)(smem + 64 + 20 * 1024 * 4);
  const int tid = otid();
  const float* cp = p.in[2]; const float* csm = p.in[3];
  for (int idx = tid; idx < 20 * 1024; idx += NTHR) {
    const int bb = idx >> 10, d = idx & 1023, b = bhalf * 20 + bb;
    const float c = b < 32 ? cp[b * 1024 + d] : csm[(b - 32) * 1024 + d];
    cs[idx] = siluf_(c);
  }
  __syncthreads();
  const int dseg = tid >> 6, e = cg_ * 64 + (tid & 63);
  const float* wp = p.in[10] + ((size_t)l * 1024 + dseg * 128) * 6144 + e;
  float acc[20];
#pragma unroll
  for (int i = 0; i < 20; ++i) acc[i] = 0.f;
  for (int d = 0; d < 128; ++d) {
    const float wv = wp[(size_t)d * 6144];
    const float* c0 = cs + dseg * 128 + d;
#pragma unroll
    for (int i = 0; i < 20; ++i) acc[i] += c0[i * 1024] * wv;
  }
#pragma unroll
  for (int i = 0; i < 20; ++i) red[(dseg * 20 + i) * 64 + (tid & 63)] = acc[i];
  __syncthreads();
  float* mod = (float*)(p.ws + WS_MOD);
  for (int idx = tid; idx < 20 * 64; idx += NTHR) {
    const int bb = idx >> 6, ec = idx & 63;
    float s = 0.f;
#pragma unroll
    for (int q = 0; q < 8; ++q) s += red[(q * 20 + bb) * 64 + ec];
    const int ee = cg_ * 64 + ec;
    mod[((size_t)l * 40 + bhalf * 20 + bb) * 6144 + ee] = s + p.in[11][l * 6144 + ee];
  }
  __syncthreads();
}

DI void prologue(const Params& p, unsigned char* smem) {
  const int WT_TASKS_L = 456 + 256 + 64 + 64 + 128 + 704 + 352;
  const int N_WT = 2 * WT_TASKS_L;
  const int N_ADA = 384, N_CK = 512, N_CV = 1024;
  const int total = N_WT + N_ADA + N_CK + N_CV;
  for (int task = blockIdx.x; task < total; task += gridDim.x) {
    if (task < N_WT) {
      const int l = task / WT_TASKS_L; int t = task % WT_TASKS_L;
      if (t < 456) { transpose_task(p.in[12] + (size_t)l * 1024 * 3592, 3592, (u16*)(p.ws + WS_WT_IN) + (size_t)l * 3584 * 1024, 1024, 1, t / 57, t % 57, smem); continue; }
      t -= 456;
      if (t < 256) { transpose_task(p.in[21] + (size_t)l * 1024 * 2048, 2048, (u16*)(p.ws + WS_WT_GATE) + (size_t)l * 2048 * 1024, 1024, 0, t / 32, t % 32, smem); continue; }
      t -= 256;
      if (t < 64) { transpose_task(p.in[19] + (size_t)l * 512 * 1024, 1024, (u16*)(p.ws + WS_WT_BRA) + (size_t)l * 1024 * 512, 512, 0, t / 16, t % 16, smem); continue; }
      t -= 64;
      if (t < 64) { transpose_task(p.in[20] + (size_t)l * 512 * 1024, 1024, (u16*)(p.ws + WS_WT_BRB) + (size_t)l * 1024 * 512, 512, 0, t / 16, t % 16, smem); continue; }
      t -= 64;
      if (t < 128) { transpose_task(p.in[23] + (size_t)l * 1024 * 1024, 1024, (u16*)(p.ws + WS_WT_O) + (size_t)l * 1024 * 1024, 1024, 0, t / 16, t % 16, smem); continue; }
      t -= 128;
      if (t < 704) { transpose_task(p.in[26] + (size_t)l * 1024 * 5632, 5632, (u16*)(p.ws + WS_WT_GU) + (size_t)l * 5632 * 1024, 1024, 2, t / 88, t % 88, smem); continue; }
      t -= 704;
      transpose_task(p.in[27] + (size_t)l * 2816 * 1024, 1024, (u16*)(p.ws + WS_WT_DOWN) + (size_t)l * 1024 * 2816, 2816, 0, t / 16, t % 16, smem);
    } else if (task < N_WT + N_ADA) {
      adaln_task(p, task - N_WT, smem);
    } else if (task < N_WT + N_ADA + N_CK) {
      const int t = task - N_WT - N_ADA;
      const float4* src = (const float4*)p.in[4];
      u16* dst = (u16*)(p.ws + WS_KS);
#pragma unroll
      for (int i = 0; i < 8; ++i) {
        const size_t f4 = (size_t)t * 4096 + i * 512 + otid();
        const float4 v = src[f4];
        const size_t e = f4 * 4;
        const size_t lb = e / (1024 * 512), rem = e % (1024 * 512);
        uint2 o; o.x = pack2(v.x, v.y); o.y = pack2(v.z, v.w);
        *(uint2*)(dst + lb * (1056 * 512) + rem) = o;
      }
    } else {
      const int t = task - N_WT - N_ADA - N_CK;
      const int lb = t >> 6, tt = t & 63;
      transpose_task(p.in[5] + (size_t)lb * 1024 * 512, 512, (u16*)(p.ws + WS_VTS) + (size_t)lb * 512 * 1056, 1056, 0, tt >> 3, tt & 7, smem);
    }
  }
}

DI float wave_sum(float v, int lane) {
#pragma unroll
  for (int off = 32; off >= 1; off >>= 1) v += shx(v, off, lane);
  return v;
}
DI void ln_pass(const Params& p, int mode, int l, unsigned char* smem) {
  const int tid = otid();
  const int lane = tid & 63, w = tid >> 6;
  const bool first = mode != 0;
  const bool second = (mode != 2) || (l + 1 < 2);
  const bool gates = (mode == 0) || (mode == 2 && l + 1 < 2);
  const int lm = (mode == 2) ? l + 1 : l;
  const int shi = (mode == 1) ? 3 : 0;
  const float* lng = (mode == 1) ? p.in[24] + l * 1024 : p.in[28] + l * 1024;
  const float* lnb = (mode == 1) ? p.in[25] + l * 1024 : p.in[29] + l * 1024;
  const float* mod = (const float*)(p.ws + WS_MOD);
  u16* H = (u16*)(p.ws + WS_H);
  float* gout = (float*)(p.ws + WS_GATES);
  float* wl = (float*)(smem + 64);
  float bif[8];
  if (gates) {
    const float* wi = p.in[12] + (size_t)lm * 1024 * 3592 + 3072;
    for (int idx = tid; idx < 8192; idx += NTHR) {
      const int c = idx >> 3, j = idx & 7;
      wl[j * 1024 + c] = wi[(size_t)c * 3592 + j];
    }
#pragma unroll
    for (int j = 0; j < 8; ++j) bif[j] = p.in[13][lm * 8 + j];
  }
  __syncthreads();
  float lg[16], lb[16];
  if (first) {
#pragma unroll
    for (int i = 0; i < 4; ++i) {
      const float4 g = *(const float4*)(lng + i * 256 + lane * 4);
      const float4 b = *(const float4*)(lnb + i * 256 + lane * 4);
      lg[i * 4] = g.x; lg[i * 4 + 1] = g.y; lg[i * 4 + 2] = g.z; lg[i * 4 + 3] = g.w;
      lb[i * 4] = b.x; lb[i * 4 + 1] = b.y; lb[i * 4 + 2] = b.z; lb[i * 4 + 3] = b.w;
    }
  }
  const bool write_x = (mode == 2 && l == 1);
  float* stats = (float*)(p.ws + WS_STAT);
  auto process = [&](int row, float (&v)[16], const float (&msh)[16], const float (&msc)[16]) {
    float* xr = p.out + (size_t)row * 1024;
    if (first) {
      float s = 0.f;
#pragma unroll
      for (int i = 0; i < 16; ++i) s += v[i];
      const float mean = wave_sum(s, lane) * (1.f / 1024.f);
      float q = 0.f;
#pragma unroll
      for (int i = 0; i < 16; ++i) { v[i] -= mean; q += v[i] * v[i]; }
      const float rstd = rsqrtf(wave_sum(q, lane) * (1.f / 1024.f) + LN_EPS);
#pragma unroll
      for (int i = 0; i < 4; ++i) {
#pragma unroll
        for (int e = 0; e < 4; ++e) v[i * 4 + e] = v[i * 4 + e] * rstd * lg[i * 4 + e] + lb[i * 4 + e];
        if (write_x) *(float4*)(xr + i * 256 + lane * 4) = make_float4(v[i * 4 + 0], v[i * 4 + 1], v[i * 4 + 2], v[i * 4 + 3]);
      }
      if (!write_x && lane == 0) *(float2*)(stats + (size_t)row * 2) = make_float2(mean, rstd);
    }
    if (second) {
      float s = 0.f;
#pragma unroll
      for (int i = 0; i < 16; ++i) s += v[i];
      const float mean = wave_sum(s, lane) * (1.f / 1024.f);
      float q = 0.f;
#pragma unroll
      for (int i = 0; i < 16; ++i) { v[i] -= mean; q += v[i] * v[i]; }
      const float rstd = rsqrtf(wave_sum(q, lane) * (1.f / 1024.f) + LN_EPS);
#pragma unroll
      for (int i = 0; i < 4; ++i) {
#pragma unroll
        for (int e = 0; e < 4; ++e) v[i * 4 + e] = v[i * 4 + e] * rstd * msc[i * 4 + e] + msh[i * 4 + e];
        uint2 o; o.x = pack2(v[i * 4 + 0], v[i * 4 + 1]); o.y = pack2(v[i * 4 + 2], v[i * 4 + 3]);
        *(uint2*)(H + (size_t)row * 1024 + i * 256 + lane * 4) = o;
      }
      if (gates) {
        float g8[8];
#pragma unroll
        for (int j = 0; j < 8; ++j) {
          float s2 = 0.f;
#pragma unroll
          for (int i = 0; i < 4; ++i) {
            const float4 wv = *(const float4*)(wl + j * 1024 + i * 256 + lane * 4);
            s2 += v[i * 4] * wv.x + v[i * 4 + 1] * wv.y + v[i * 4 + 2] * wv.z + v[i * 4 + 3] * wv.w;
          }
          g8[j] = wave_sum(s2, lane) + bif[j];
        }
        if (lane == 0) {
          *(float4*)(gout + (size_t)row * 8) = make_float4(g8[0], g8[1], g8[2], g8[3]);
          *(float4*)(gout + (size_t)row * 8 + 4) = make_float4(g8[4], g8[5], g8[6], g8[7]);
        }
      }
    }
  };
  auto load_mod = [&](int row, float (&msh)[16], float (&msc)[16]) {
    const float* mb = mod + ((size_t)lm * 40 + batch_of_row(row)) * 6144;
#pragma unroll
    for (int i = 0; i < 4; ++i) {
      const float4 sh = *(const float4*)(mb + shi * 1024 + i * 256 + lane * 4);
      const float4 sc = *(const float4*)(mb + (shi + 1) * 1024 + i * 256 + lane * 4);
      msh[i * 4] = sh.x; msh[i * 4 + 1] = sh.y; msh[i * 4 + 2] = sh.z; msh[i * 4 + 3] = sh.w;
      msc[i * 4] = 1.f + sc.x; msc[i * 4 + 1] = 1.f + sc.y; msc[i * 4 + 2] = 1.f + sc.z; msc[i * 4 + 3] = 1.f + sc.w;
    }
  };
  for (int chunk = blockIdx.x * 8 + w; chunk < TOKP / 32; chunk += gridDim.x * 8) {
    const int row0 = chunk * 32;
    float msh[16], msc[16];
    if (second) load_mod(row0, msh, msc);
    const float* src0 = (mode == 0) ? p.in[0] + (size_t)row0 * 1024 : p.out + (size_t)row0 * 1024;
    float4 nx0 = *(const float4*)(src0 + lane * 4), nx1 = *(const float4*)(src0 + 256 + lane * 4);
    float4 nx2 = *(const float4*)(src0 + 512 + lane * 4), nx3 = *(const float4*)(src0 + 768 + lane * 4);
    for (int ri = 0; ri < 32; ++ri) {
      float v[16];
      v[0] = nx0.x; v[1] = nx0.y; v[2] = nx0.z; v[3] = nx0.w; v[4] = nx1.x; v[5] = nx1.y; v[6] = nx1.z; v[7] = nx1.w;
      v[8] = nx2.x; v[9] = nx2.y; v[10] = nx2.z; v[11] = nx2.w; v[12] = nx3.x; v[13] = nx3.y; v[14] = nx3.z; v[15] = nx3.w;
      {
        const float* sn = src0 + (size_t)(ri < 31 ? ri + 1 : 31) * 1024;
        nx0 = *(const float4*)(sn + lane * 4); nx1 = *(const float4*)(sn + 256 + lane * 4);
        nx2 = *(const float4*)(sn + 512 + lane * 4); nx3 = *(const float4*)(sn + 768 + lane * 4);
      }
      __builtin_amdgcn_sched_barrier(0);
      process(row0 + ri, v, msh, msc);
    }
  }
  if (w == 0) {
    for (int row = TOKP + blockIdx.x; row < TOK; row += gridDim.x) {
      float msh[16], msc[16];
      if (second) load_mod(row, msh, msc);
      const float* src = (mode == 0) ? p.in[1] + (size_t)(row - TOKP) * 1024 : p.out + (size_t)row * 1024;
      float v[16];
#pragma unroll
      for (int i = 0; i < 4; ++i) {
        const float4 t = *(const float4*)(src + i * 256 + lane * 4);
        v[i * 4 + 0] = t.x; v[i * 4 + 1] = t.y; v[i * 4 + 2] = t.z; v[i * 4 + 3] = t.w;
      }
      process(row, v, msh, msc);
    }
  }
}


DI void micro_partial(f32x16& acc, const u16* A, int lda, const u16* Wt, int ldw, int K, int row0, int n0, int w, int r, int h) {
  const int kb = w * (K >> 3), n16 = K >> 7;
  const u16* ap = A + (size_t)(row0 + r) * lda + kb + h * 8;
  const u16* bp = Wt + (size_t)(n0 + r) * ldw + kb + h * 8;
#pragma unroll 4
  for (int k = 0; k < n16; ++k) {
    const bf16x8 a = *(const bf16x8*)(ap + k * 16);
    const bf16x8 b = *(const bf16x8*)(bp + k * 16);
    acc = MFMA(a, b, acc);
  }
}
DI void micro_reduce_store(const f32x16& acc, float* red, int w, int lane) {
#pragma unroll
  for (int i = 0; i < 16; ++i) red[(w * 16 + i) * 64 + lane] = acc[i];
}
DI float micro_sum(const float* red, int i, int lane) {
  float s = 0.f;
#pragma unroll
  for (int q = 0; q < 8; ++q) s += red[(q * 16 + i) * 64 + lane];
  return s;
}

constexpr int EP_LD = 264;
constexpr int EP_LDT = 68;
DI void zero_acc(f32x16 (&acc)[4][2]) {
#pragma unroll
  for (int a = 0; a < 4; ++a)
#pragma unroll
    for (int b = 0; b < 2; ++b) zero16(acc[a][b]);
}
DI void stage_rm(const f32x16& a0, const f32x16& a1, float* stg, int wm, int wn, int r, int h) {
#pragma unroll
  for (int i = 0; i < 16; ++i) *(float2*)(stg + (wm * 32 + crow(i, h)) * EP_LD + wn * 64 + 2 * r) = make_float2(a0[i], a1[i]);
}
DI void stage_tr(const f32x16& a0, const f32x16& a1, float* stg, int wm, int wn, int r, int h) {
#pragma unroll
  for (int g = 0; g < 4; ++g) {
    *(float4*)(stg + (wn * 64 + 2 * r) * EP_LDT + wm * 32 + 8 * g + 4 * h) = make_float4(a0[4 * g], a0[4 * g + 1], a0[4 * g + 2], a0[4 * g + 3]);
    *(float4*)(stg + (wn * 64 + 2 * r + 1) * EP_LDT + wm * 32 + 8 * g + 4 * h) = make_float4(a1[4 * g], a1[4 * g + 1], a1[4 * g + 2], a1[4 * g + 3]);
  }
}
DI int grow_of(int m0, int mi, int lr) { return m0 + (lr >> 5) * 128 + mi * 32 + (lr & 31); }
DI uint4 pack8f(const float4& a, const float4& b) {
  uint4 o; o.x = pack2(a.x, a.y); o.y = pack2(a.z, a.w); o.z = pack2(b.x, b.y); o.w = pack2(b.z, b.w); return o;
}

DI void write_tr(const Params& p, int l, int m0, int mi, const float* stg, int tid, int which, int chbase) {
  const bool prompt = m0 < TOKP;
#pragma unroll 1
  for (int q = 0; q < 4; ++q) {
    const int cid = q * NTHR + tid, ch = cid >> 3, tc = cid & 7;
    const float4 v0 = *(const float4*)(stg + ch * EP_LDT + tc * 8);
    const float4 v1 = *(const float4*)(stg + ch * EP_LDT + tc * 8 + 4);
    const int row0 = grow_of(m0, mi, tc * 8);
    const int chg = chbase + ch;
    u16* d;
    if (prompt) {
      const int b = row0 >> 11, t = row0 & 2047;
      if (which == 0) d = (u16*)(p.ws + WS_VTP) + ((size_t)b * 512 + chg) * 2048 + t;
      else if (which == 1) d = (u16*)(p.ws + WS_MQKT_P) + ((size_t)b * 1024 + chg) * 2048 + t;
      else d = (u16*)(p.ws + WS_MVT_P) + ((size_t)b * 512 + chg) * 2048 + t;
    } else {
      const int rs = row0 - TOKP, bs = rs >> 5, t = rs & 31;
      if (which == 0) d = (u16*)(p.ws + WS_VTS) + ((size_t)(l * 8 + bs) * 512 + chg) * 1056 + 1024 + t;
      else if (which == 1) d = (u16*)(p.ws + WS_MQKT_S) + ((size_t)bs * 1024 + chg) * 32 + t;
      else d = (u16*)(p.ws + WS_MVT_S) + ((size_t)bs * 512 + chg) * 32 + t;
    }
    *(uint4*)d = pack8f(v0, v1);
  }
}

DI void epi_in(const Params& p, int l, int m0, int n0, f32x16 (&acc)[4][2], unsigned char* smem) {
  const int tid = otid(), lane = tid & 63, w = tid >> 6;
  const int wm = w >> 2, wn = w & 3, r = lane & 31, h = lane >> 5;
  const bool prompt = m0 < TOKP;
  float* stg = (float*)(smem + GS_BASE + GS_STAGE);
  const int seg = n0 < 512 ? 0 : (n0 < 1024 ? 1 : (n0 < 1536 ? 2 : (n0 < 2560 ? 3 : (n0 < 3072 ? 4 : 5))));
  if (seg == 3) {
    const int ch = n0 - 1536 + wn * 64 + 2 * r;
#pragma unroll
    for (int mi = 0; mi < 4; ++mi) {
      const int rb = m0 + wm * 128 + mi * 32 + 4 * h;
#pragma unroll
      for (int i = 0; i < 16; ++i) {
        const int row = rb + (i & 3) + 8 * (i >> 2);
        if (prompt) {
          const int tt = row & 2047;
          if (tt >= 2045) *(float2*)(p.out + O_CVP + ((size_t)(l * 32 + (row >> 11)) * 3 + (tt - 2045)) * 1024 + ch) = make_float2(acc[mi][0][i], acc[mi][1][i]);
        } else {
          const int rs = row - TOKP, tt = rs & 31;
          if (tt >= 29) *(float2*)(p.out + O_CVS + ((size_t)(l * 8 + (rs >> 5)) * 3 + (tt - 29)) * 1024 + ch) = make_float2(acc[mi][0][i], acc[mi][1][i]);
        }
      }
    }
  }
#pragma unroll
  for (int mi = 0; mi < 4; ++mi) {
    if (seg == 0 || seg == 1 || seg == 2 || seg == 5) {
      __syncthreads();
      stage_rm(acc[mi][0], acc[mi][1], stg, wm, wn, r, h);
      __syncthreads();
#pragma unroll 1
      for (int q = 0; q < 4; ++q) {
        const int cid = q * NTHR + tid, lr = cid >> 5, c8 = (cid & 31) * 8;
        const float4 v0 = *(const float4*)(stg + lr * EP_LD + c8);
        const float4 v1 = *(const float4*)(stg + lr * EP_LD + c8 + 4);
        const int row = grow_of(m0, mi, lr);
        const int n = n0 + c8;
        if (seg == 0) {
          *(uint4*)((u16*)(p.ws + WS_ZQ) + (size_t)row * 512 + n) = pack8f(v0, v1);
        } else if (seg == 5) {
          const float4 s0 = make_float4(sigmoidf_(v0.x), sigmoidf_(v0.y), sigmoidf_(v0.z), sigmoidf_(v0.w));
          const float4 s1 = make_float4(sigmoidf_(v1.x), sigmoidf_(v1.y), sigmoidf_(v1.z), sigmoidf_(v1.w));
          *(uint4*)((u16*)(p.ws + WS_MO) + (size_t)row * 512 + (n - 3072)) = pack8f(s0, s1);
        } else {
          const bool isk = seg == 1;
          const int nn = n - (isk ? 512 : 1024);
          float* of = p.out + (isk ? (prompt ? O_KP : O_KSM) : (prompt ? O_VP : O_VSM));
          const size_t orow = prompt ? ((size_t)l * TOKP + row) : ((size_t)l * TOKS + (row - TOKP));
          *(float4*)(of + orow * 512 + nn) = v0;
          *(float4*)(of + orow * 512 + nn + 4) = v1;
          if (isk) {
            u16* kd;
            if (prompt) kd = (u16*)(p.ws + WS_KB) + (size_t)row * 512 + nn;
            else { const int rs = row - TOKP; kd = (u16*)(p.ws + WS_KS) + ((size_t)(l * 8 + (rs >> 5)) * 1056 + 1024 + (rs & 31)) * 512 + nn; }
            *(uint4*)kd = pack8f(v0, v1);
          }
        }
      }
    }
    if (seg == 2 || seg == 3 || seg == 4) {
      __syncthreads();
      stage_tr(acc[mi][0], acc[mi][1], stg, wm, wn, r, h);
      __syncthreads();
      write_tr(p, l, m0, mi, stg, tid, seg == 2 ? 0 : (seg == 3 ? 1 : 2), n0 - (seg == 2 ? 1024 : (seg == 3 ? 1536 : 2560)));
    }
  }
  __syncthreads();
}

DI void phase_in_gate(const Params& p, int l, unsigned char* smem) {
  const int tid = otid(), lane = tid & 63, w = tid >> 6;
  const int wm = w >> 2, wn = w & 3, r = lane & 31, h = lane >> 5;
  const u16* H = (const u16*)(p.ws + WS_H);
  const u16* Win = (const u16*)(p.ws + WS_WT_IN) + (size_t)l * 3584 * 1024;
  const u16* Wg = (const u16*)(p.ws + WS_WT_GATE) + (size_t)l * 2048 * 1024;
  float* stg = (float*)(smem + GS_BASE + GS_STAGE);
  const int NT = 14 + 8, MT = 257;
  auto ptrs = [&](int it, const u16*& ap, const u16*& bp) -> bool {
    int mt, nt;
    if (!tile_of(it, MT, NT, mt, nt)) return false;
    ap = H + (size_t)(mt * 256) * 1024;
    bp = (nt < 14 ? Win + (size_t)(nt * 256) * 1024 : Wg + (size_t)((nt - 14) * 256) * 1024);
    return true;
  };
  auto epi = [&](int it, f32x16 (&acc)[4][2]) {
    const int tid = otid(), lane = tid & 63, w = tid >> 6;
    const int wm = w >> 2, wn = w & 3, r = lane & 31, h = lane >> 5;
    int mt, nt;
    tile_of(it, MT, NT, mt, nt);
    const int m0 = mt * 256;
    if (nt < 14) {
      epi_in(p, l, m0, nt * 256, acc, smem);
    } else {
      const int n0 = (nt - 14) * 256;
      u16* G = (u16*)(p.ws + WS_G);
#pragma unroll
      for (int mi = 0; mi < 4; ++mi) {
        __syncthreads();
        stage_rm(acc[mi][0], acc[mi][1], stg, wm, wn, r, h);
        __syncthreads();
#pragma unroll 1
        for (int q = 0; q < 4; ++q) {
          const int cid = q * NTHR + tid, lr = cid >> 5, c8 = (cid & 31) * 8;
          float4 v0 = *(const float4*)(stg + lr * EP_LD + c8);
          float4 v1 = *(const float4*)(stg + lr * EP_LD + c8 + 4);
          const int row = grow_of(m0, mi, lr), n = n0 + c8;
          const float4 b0 = *(const float4*)(p.in[22] + l * 2048 + n);
          const float4 b1 = *(const float4*)(p.in[22] + l * 2048 + n + 4);
          v0 = make_float4(sigmoidf_(v0.x + b0.x), sigmoidf_(v0.y + b0.y), sigmoidf_(v0.z + b0.z), sigmoidf_(v0.w + b0.w));
          v1 = make_float4(sigmoidf_(v1.x + b1.x), sigmoidf_(v1.y + b1.y), sigmoidf_(v1.z + b1.z), sigmoidf_(v1.w + b1.w));
          *(uint4*)(G + (size_t)row * 2048 + n) = pack8f(v0, v1);
        }
      }
      __syncthreads();
    }
  };
  gemm_stream(1024, 1024, 1024, smem, ptrs, epi);
}

DI void phase_mix(const Params& p, int l, unsigned char* smem) {
  const int tid = otid(), lane = tid & 63, w = tid >> 6;
  const int wm = w >> 2, wn = w & 3, r = lane & 31, h = lane >> 5;
  const u16* G = (const u16*)(p.ws + WS_G);
  u16* MIX = (u16*)(p.ws + WS_MIX);
  float* stg = (float*)(smem + GS_BASE + GS_STAGE);
  const int NT = 4, MT = 256;
  auto ptrs = [&](int it, const u16*& ap, const u16*& bp) -> bool {
    int mt, nt;
    if (!tile_of(it >> 1, MT, NT, mt, nt)) return false;
    const int half = it & 1;
    ap = (const u16*)(p.ws + (half ? WS_MN : WS_AN)) + (size_t)(mt * 256) * 512;
    bp = (const u16*)(p.ws + (half ? WS_WT_BRB : WS_WT_BRA)) + (size_t)l * 1024 * 512 + (size_t)(nt * 256) * 512;
    return true;
  };
  auto epi = [&](int it, f32x16 (&acc)[4][2]) {
    const int tid = otid(), lane = tid & 63, w = tid >> 6;
    const int wm = w >> 2, wn = w & 3, r = lane & 31, h = lane >> 5;
    int mt, nt;
    tile_of(it >> 1, MT, NT, mt, nt);
    const int half = it & 1;
    const int m0 = mt * 256, n0 = nt * 256;
#pragma unroll
    for (int mi = 0; mi < 4; ++mi) {
      __syncthreads();
      stage_rm(acc[mi][0], acc[mi][1], stg, wm, wn, r, h);
      __syncthreads();
#pragma unroll 1
      for (int q = 0; q < 4; ++q) {
        const int cid = q * NTHR + tid, lr = cid >> 5, c8 = (cid & 31) * 8;
        const float4 v0 = *(const float4*)(stg + lr * EP_LD + c8);
        const float4 v1 = *(const float4*)(stg + lr * EP_LD + c8 + 4);
        const int row = grow_of(m0, mi, lr), n = n0 + c8;
        const uint4 g = *(const uint4*)(G + (size_t)row * 2048 + half * 1024 + n);
        float4 o0 = make_float4(bflo(g.x) * v0.x, bfhi(g.x) * v0.y, bflo(g.y) * v0.z, bfhi(g.y) * v0.w);
        float4 o1 = make_float4(bflo(g.z) * v1.x, bfhi(g.z) * v1.y, bflo(g.w) * v1.z, bfhi(g.w) * v1.w);
        uint4* mp = (uint4*)(MIX + (size_t)row * 1024 + n);
        if (half) {
          const uint4 pr = *mp;
          o0.x += bflo(pr.x); o0.y += bfhi(pr.x); o0.z += bflo(pr.y); o0.w += bfhi(pr.y);
          o1.x += bflo(pr.z); o1.y += bfhi(pr.z); o1.z += bflo(pr.w); o1.w += bfhi(pr.w);
        }
        *mp = pack8f(o0, o1);
      }
    }
    __syncthreads();
  };
  gemm_stream(512, 512, 512, smem, ptrs, epi);
  {
    const int tid2 = otid(), lane = tid2 & 63, w = tid2 >> 6, r = lane & 31, h = lane >> 5;
    float* red = (float*)(smem + 64);
    for (int mtile = blockIdx.x; mtile < 256; mtile += gridDim.x) {
      const int row0 = TOKP + (mtile >> 5) * 32, n0 = (mtile & 31) * 32;
      f32x16 pa, pb;
      zero16(pa); zero16(pb);
      micro_partial(pa, (const u16*)(p.ws + WS_AN), 512, (const u16*)(p.ws + WS_WT_BRA) + (size_t)l * 1024 * 512, 512, 512, row0, n0, w, r, h);
      micro_partial(pb, (const u16*)(p.ws + WS_MN), 512, (const u16*)(p.ws + WS_WT_BRB) + (size_t)l * 1024 * 512, 512, 512, row0, n0, w, r, h);
      __syncthreads();
      micro_reduce_store(pa, red, w, lane);
      micro_reduce_store(pb, red + 8192, w, lane);
      __syncthreads();
#pragma unroll
      for (int q = 0; q < 2; ++q) {
        const int i = w + 8 * q;
        const float sa = micro_sum(red, i, lane), sb = micro_sum(red + 8192, i, lane);
        const int row = row0 + crow(i, h), n = n0 + r;
        const float ga = bf2f(G[(size_t)row * 2048 + n]), gb = bf2f(G[(size_t)row * 2048 + 1024 + n]);
        MIX[(size_t)row * 1024 + n] = f2bf(ga * sa + gb * sb);
      }
    }
    __syncthreads();
  }
}

DI void phase_res(const Params& p, int l, int mode, unsigned char* smem) {
  const int tid = otid(), lane = tid & 63, w = tid >> 6;
  const int wm = w >> 2, wn = w & 3, r = lane & 31, h = lane >> 5;
  const float* mod = (const float*)(p.ws + WS_MOD);
  float* stg = (float*)(smem + GS_BASE + GS_STAGE);
  const int NT = 4, MT = 256;
  const int K = (mode == 0) ? 1024 : 2816;
  const u16* Ab = (const u16*)(p.ws + (mode == 0 ? WS_MIX : WS_ACT));
  const u16* Wb = (mode == 0) ? (const u16*)(p.ws + WS_WT_O) + (size_t)l * 1024 * 1024 : (const u16*)(p.ws + WS_WT_DOWN) + (size_t)l * 1024 * 2816;
  const int gi = (mode == 0) ? 2 : 5;
  const float* stats = (const float*)(p.ws + WS_STAT);
  const float* rlg = (mode == 1) ? p.in[24] + l * 1024 : p.in[28] + (l > 0 ? l - 1 : 0) * 1024;
  const float* rlb = (mode == 1) ? p.in[25] + l * 1024 : p.in[29] + (l > 0 ? l - 1 : 0) * 1024;
  auto ptrs = [&](int it, const u16*& ap, const u16*& bp) -> bool {
    int mt, nt;
    if (!tile_of(it, MT, NT, mt, nt)) return false;
    ap = Ab + (size_t)(mt * 256) * K;
    bp = Wb + (size_t)(nt * 256) * K;
    return true;
  };
  auto epi = [&](int it, f32x16 (&acc)[4][2]) {
    const int tid = otid(), lane = tid & 63, w = tid >> 6;
    const int wm = w >> 2, wn = w & 3, r = lane & 31, h = lane >> 5;
    int mt, nt;
    tile_of(it, MT, NT, mt, nt);
    const int m0 = mt * 256, n0 = nt * 256;
#pragma unroll
    for (int mi = 0; mi < 4; ++mi) {
      __syncthreads();
      stage_rm(acc[mi][0], acc[mi][1], stg, wm, wn, r, h);
      __syncthreads();
#pragma unroll 1
      for (int q = 0; q < 8; ++q) {
        const int cid = q * NTHR + tid, lr = cid >> 6, c4 = (cid & 63) * 4;
        const float4 v = *(const float4*)(stg + lr * EP_LD + c4);
        const int row = grow_of(m0, mi, lr), n = n0 + c4;
        const int b = batch_of_row(row);
        const float4 gg = *(const float4*)(mod + ((size_t)l * 40 + b) * 6144 + gi * 1024 + n);
        float* xr = p.out + (size_t)row * 1024 + n;
        const float* xs = (mode == 0 && l == 0) ? (row < TOKP ? p.in[0] + (size_t)row * 1024 + n : p.in[1] + (size_t)(row - TOKP) * 1024 + n) : xr;
        float4 xv = *(const float4*)xs;
        if (!(mode == 0 && l == 0)) {
          const float2 st = *(const float2*)(stats + (size_t)row * 2);
          const float4 g4 = *(const float4*)(rlg + n), b4 = *(const float4*)(rlb + n);
          xv.x = (xv.x - st.x) * st.y * g4.x + b4.x; xv.y = (xv.y - st.x) * st.y * g4.y + b4.y;
          xv.z = (xv.z - st.x) * st.y * g4.z + b4.z; xv.w = (xv.w - st.x) * st.y * g4.w + b4.w;
        }
        *(float4*)xr = make_float4(ALPHA * xv.x + (1.f + gg.x) * v.x, ALPHA * xv.y + (1.f + gg.y) * v.y,
                                   ALPHA * xv.z + (1.f + gg.z) * v.z, ALPHA * xv.w + (1.f + gg.w) * v.w);
      }
    }
    __syncthreads();
  };
  gemm_stream(K, K, K, smem, ptrs, epi);
  {
    const int tid2 = otid(), lane = tid2 & 63, w = tid2 >> 6, r = lane & 31, h = lane >> 5;
    float* red = (float*)(smem + 64);
    for (int mtile = blockIdx.x; mtile < 256; mtile += gridDim.x) {
      const int row0 = TOKP + (mtile >> 5) * 32, n0 = (mtile & 31) * 32;
      f32x16 pa;
      zero16(pa);
      micro_partial(pa, Ab, K, Wb, K, K, row0, n0, w, r, h);
      __syncthreads();
      micro_reduce_store(pa, red, w, lane);
      __syncthreads();
#pragma unroll
      for (int q = 0; q < 2; ++q) {
        const int i = w + 8 * q;
        const float sa = micro_sum(red, i, lane);
        const int row = row0 + crow(i, h), n = n0 + r;
        const float gg = mod[((size_t)l * 40 + batch_of_row(row)) * 6144 + gi * 1024 + n];
        float* xr = p.out + (size_t)row * 1024 + n;
        float xv = (mode == 0 && l == 0) ? p.in[1][(size_t)(row - TOKP) * 1024 + n] : *xr;
        if (!(mode == 0 && l == 0)) {
          const float2 st = *(const float2*)(stats + (size_t)row * 2);
          xv = (xv - st.x) * st.y * rlg[n] + rlb[n];
        }
        *xr = ALPHA * xv + (1.f + gg) * sa;
      }
    }
    __syncthreads();
  }
}

DI void phase_gu(const Params& p, int l, unsigned char* smem) {
  const int tid = otid(), lane = tid & 63, w = tid >> 6;
  const int wm = w >> 2, wn = w & 3, r = lane & 31, h = lane >> 5;
  u16* ACT = (u16*)(p.ws + WS_ACT);
  const u16* Hh = (const u16*)(p.ws + WS_H);
  const u16* Wb = (const u16*)(p.ws + WS_WT_GU) + (size_t)l * 5632 * 1024;
  float* stg = (float*)(smem + GS_BASE + GS_STAGE);
  const int NT = 22, MT = 257;
  auto ptrs = [&](int it, const u16*& ap, const u16*& bp) -> bool {
    int mt, nt;
    if (!tile_of(it, MT, NT, mt, nt)) return false;
    ap = Hh + (size_t)(mt * 256) * 1024;
    bp = Wb + (size_t)(nt * 256) * 1024;
    return true;
  };
  auto epi = [&](int it, f32x16 (&acc)[4][2]) {
    const int tid = otid(), lane = tid & 63, w = tid >> 6;
    const int wm = w >> 2, wn = w & 3, r = lane & 31, h = lane >> 5;
    int mt, nt;
    tile_of(it, MT, NT, mt, nt);
    const int m0 = mt * 256, n0 = nt * 256;
#pragma unroll
    for (int mi = 0; mi < 4; ++mi) {
      __syncthreads();
      stage_rm(acc[mi][0], acc[mi][1], stg, wm, wn, r, h);
      __syncthreads();
#pragma unroll 1
      for (int q = 0; q < 2; ++q) {
        const int cid = q * NTHR + tid, lr = cid >> 4, c16 = (cid & 15) * 16;
        const float4 v0 = *(const float4*)(stg + lr * EP_LD + c16);
        const float4 v1 = *(const float4*)(stg + lr * EP_LD + c16 + 4);
        const float4 v2 = *(const float4*)(stg + lr * EP_LD + c16 + 8);
        const float4 v3 = *(const float4*)(stg + lr * EP_LD + c16 + 12);
        const int row = grow_of(m0, mi, lr);
        uint4 o;
        o.x = pack2(siluf_(v0.x) * v0.y, siluf_(v0.z) * v0.w);
        o.y = pack2(siluf_(v1.x) * v1.y, siluf_(v1.z) * v1.w);
        o.z = pack2(siluf_(v2.x) * v2.y, siluf_(v2.z) * v2.w);
        o.w = pack2(siluf_(v3.x) * v3.y, siluf_(v3.z) * v3.w);
        *(uint4*)(ACT + (size_t)row * 2816 + (n0 >> 1) + (c16 >> 1)) = o;
      }
    }
    __syncthreads();
  };
  gemm_stream(1024, 1024, 1024, smem, ptrs, epi);
}

constexpr int AT_BASE = 64;
constexpr int AT_KBYTES = 64 * 272;
constexpr int AT_VBYTES = 128 * 136;
constexpr int AT_STAGE = AT_KBYTES + AT_VBYTES;

DI void attn_item(const Params& p, int l, int b, int head, int qt, float lam, float lam_init, unsigned char* smem) {
  const int tid = otid(), lane = tid & 63, w = tid >> 6, r = lane & 31, h = lane >> 5;
  const int comp = w & 1, rg = w >> 1;
  const bool prompt = b < 32;
  const int bs = b - 32;
  const u16* Kg = prompt ? (const u16*)(p.ws + WS_KB) + (size_t)b * 2048 * 512 : (const u16*)(p.ws + WS_KS) + (size_t)(l * 8 + bs) * 1056 * 512;
  const u16* Vg = prompt ? (const u16*)(p.ws + WS_VTP) + (size_t)b * 512 * 2048 : (const u16*)(p.ws + WS_VTS) + (size_t)(l * 8 + bs) * 512 * 1056;
  const int ldT = prompt ? 2048 : 1056;
  const int nkt = prompt ? 2 * qt + 2 : 17;
  const int nkeys = prompt ? 2048 : 1056;
  const int qtok0 = prompt ? b * 2048 + qt * 128 : TOKP + bs * 32;
  const int qpos0 = prompt ? qt * 128 : 1024;
  const bool active = prompt || rg == 0;
  const int my_nkt = prompt ? (rg < 2 ? nkt - 1 : nkt) : nkt;
  const u16* ZQ = (const u16*)(p.ws + WS_ZQ);
  bf16x8 qf[4];
  {
    const int qrow = active ? qtok0 + rg * 32 + r : qtok0;
#pragma unroll
    for (int ks = 0; ks < 4; ++ks) {
      const uint4 qq = *(const uint4*)(ZQ + (size_t)qrow * 512 + head * 128 + comp * 64 + ks * 16 + h * 8);
      const float cq = 0.125f * LOG2E;
      uint4 qs_;
      qs_.x = pack2(bflo(qq.x) * cq, bfhi(qq.x) * cq); qs_.y = pack2(bflo(qq.y) * cq, bfhi(qq.y) * cq);
      qs_.z = pack2(bflo(qq.z) * cq, bfhi(qq.z) * cq); qs_.w = pack2(bflo(qq.w) * cq, bfhi(qq.w) * cq);
      qf[ks] = __builtin_bit_cast(bf16x8, qs_);
    }
  }
  const float slope2 = exp2f(-2.f * (head + 1)) * LOG2E;
  const float c1 = 0.125f * LOG2E;
  const int qpos = qpos0 + rg * 32 + r;
  f32x16 O[4];
#pragma unroll
  for (int i = 0; i < 4; ++i) zero16(O[i]);
  float m_run = -INFINITY, l_run = 0.f;

  const int krow = tid >> 4, kcc = tid & 15;
  const int vrow = tid >> 3, vcc = tid & 7;
  const u16* kp = Kg + (size_t)((nkt - 1) * 64 + krow) * 512 + head * 128 + kcc * 8;
  const u16* vp = Vg + (size_t)(head * 128 + vrow) * ldT + (nkt - 1) * 64 + vcc * 8;
  uint4 rk0, rk1, rv0, rv1;
  unsigned char* sb = smem + AT_BASE;
  rk0 = *(const uint4*)kp; rk1 = *(const uint4*)(kp + 32 * 512);
  rv0 = *(const uint4*)vp; rv1 = *(const uint4*)(vp + (size_t)64 * ldT);
  {
    *(uint4*)(sb + krow * 272 + kcc * 16) = rk0;
    *(uint4*)(sb + (krow + 32) * 272 + kcc * 16) = rk1;
    *(uint2*)(sb + AT_KBYTES + vrow * 136 + vcc * 16) = make_uint2(rv0.x, rv0.y);
    *(uint2*)(sb + AT_KBYTES + vrow * 136 + vcc * 16 + 8) = make_uint2(rv0.z, rv0.w);
    *(uint2*)(sb + AT_KBYTES + (vrow + 64) * 136 + vcc * 16) = make_uint2(rv1.x, rv1.y);
    *(uint2*)(sb + AT_KBYTES + (vrow + 64) * 136 + vcc * 16 + 8) = make_uint2(rv1.z, rv1.w);
  }
  __syncthreads();
  for (int j = 0; j < nkt; ++j) {
    const int kt = nkt - 1 - j;
    const bool more = j + 1 < nkt;
    if (more) {
      kp -= 64 * 512; vp -= 64;
      rk0 = *(const uint4*)kp; rk1 = *(const uint4*)(kp + 32 * 512);
      rv0 = *(const uint4*)vp; rv1 = *(const uint4*)(vp + (size_t)64 * ldT);
    }
    if (active && kt < my_nkt) {
      const unsigned char* Kt = sb + (j & 1) * AT_STAGE;
      const unsigned char* Vt = Kt + AT_KBYTES;
      f32x16 s[2];
      const bool past = (kt * 64 + 63) < (qpos0 + rg * 32);
      if (past) {
        const float kb0 = slope2 * (float)(kt * 64 + 4 * h);
#pragma unroll
        for (int sub = 0; sub < 2; ++sub)
#pragma unroll
          for (int i = 0; i < 16; ++i) s[sub][i] = __builtin_fmaf(slope2, (float)(sub * 32 + (i & 3) + 8 * (i >> 2)), kb0);
      } else {
        zero16(s[0]); zero16(s[1]);
      }
#pragma unroll
      for (int ks = 0; ks < 4; ++ks) {
#pragma unroll
        for (int sub = 0; sub < 2; ++sub) {
          const bf16x8 kf = *(const bf16x8*)(Kt + (sub * 32 + r) * 272 + (comp * 64 + ks * 16 + h * 8) * 2);
          s[sub] = MFMA(kf, qf[ks], s[sub]);
        }
      }
      float mx = -INFINITY;
      if (!past) {
        const float qk0 = (float)(qpos - kt * 64 - 4 * h);
        const float qb = slope2 * (float)qpos;
#pragma unroll
        for (int sub = 0; sub < 2; ++sub)
#pragma unroll
          for (int i = 0; i < 16; ++i) {
            const float d = qk0 - (float)(sub * 32 + (i & 3) + 8 * (i >> 2));
            s[sub][i] = s[sub][i] - slope2 * fabsf(d) + qb;
          }
      }
      if (!prompt) {
#pragma unroll
        for (int sub = 0; sub < 2; ++sub)
#pragma unroll
          for (int i = 0; i < 16; ++i) {
            const int key = kt * 64 + sub * 32 + crow(i, h);
            if (key >= nkeys) s[sub][i] = -INFINITY;
          }
      }
#pragma unroll
      for (int sub = 0; sub < 2; ++sub)
#pragma unroll
        for (int i = 0; i < 16; ++i) mx = fmaxf(mx, s[sub][i]);
      mx = fmaxf(mx, shx(mx, 32, lane));
      const bool livelane = !(mx - m_run < -150.f);
      if (__ballot(livelane) != 0ull) {
        const float m_new = fmaxf(m_run, mx);
        const float alpha = fexp2(m_run - m_new);
        m_run = m_new;
        float lsum = 0.f;
#pragma unroll
        for (int sub = 0; sub < 2; ++sub)
#pragma unroll
          for (int i = 0; i < 16; ++i) {
            const float pv = fexp2(s[sub][i] - m_new);
            lsum += pv;
            s[sub][i] = pv;
          }
        l_run = l_run * alpha + lsum;
        if (__ballot(alpha != 1.f) != 0ull) {
#pragma unroll
          for (int dt = 0; dt < 4; ++dt)
#pragma unroll
            for (int i = 0; i < 16; ++i) O[dt][i] *= alpha;
        }
#pragma unroll
        for (int sub = 0; sub < 2; ++sub)
#pragma unroll
          for (int s2 = 0; s2 < 2; ++s2) {
            const bf16x8 pf = pack8(s[sub], s2);
#pragma unroll
            for (int dt = 0; dt < 4; ++dt) {
              const unsigned char* va = Vt + (dt * 32 + r) * 136 + (sub * 32 + s2 * 16 + 4 * h) * 2;
              const uint2 lo = *(const uint2*)va;
              const uint2 hi = *(const uint2*)(va + 16);
              const uint4 vv = make_uint4(lo.x, lo.y, hi.x, hi.y);
              O[dt] = MFMA(__builtin_bit_cast(bf16x8, vv), pf, O[dt]);
            }
          }
      }
    }
    if (more) {
      unsigned char* sn = sb + ((j + 1) & 1) * AT_STAGE;
      *(uint4*)(sn + krow * 272 + kcc * 16) = rk0;
      *(uint4*)(sn + (krow + 32) * 272 + kcc * 16) = rk1;
      *(uint2*)(sn + AT_KBYTES + vrow * 136 + vcc * 16) = make_uint2(rv0.x, rv0.y);
      *(uint2*)(sn + AT_KBYTES + vrow * 136 + vcc * 16 + 8) = make_uint2(rv0.z, rv0.w);
      *(uint2*)(sn + AT_KBYTES + (vrow + 64) * 136 + vcc * 16) = make_uint2(rv1.x, rv1.y);
      *(uint2*)(sn + AT_KBYTES + (vrow + 64) * 136 + vcc * 16 + 8) = make_uint2(rv1.z, rv1.w);
    }
    __syncthreads();
  }
  float* exch = (float*)(smem + AT_BASE);
  float inv = 0.f;
  if (active) { const float lt = l_run + shx(l_run, 32, lane); inv = 1.f / lt; }
  if (active && comp == 1) {
    const float sc = inv * lam;
#pragma unroll
    for (int dt = 0; dt < 4; ++dt)
#pragma unroll
      for (int i = 0; i < 16; ++i) exch[(rg * 64 + dt * 16 + i) * 64 + lane] = O[dt][i] * sc;
  }
  __syncthreads();
  if (active && comp == 0) {
    float ss = 0.f;
#pragma unroll
    for (int dt = 0; dt < 4; ++dt)
#pragma unroll
      for (int i = 0; i < 16; ++i) {
        const float o = O[dt][i] * inv - exch[(rg * 64 + dt * 16 + i) * 64 + lane];
        O[dt][i] = o;
        ss += o * o;
      }
    ss += shx(ss, 32, lane);
    const float rs = rsqrtf(ss * (1.f / 128.f) + LN_EPS) * (1.f - lam_init);
    u16* AN = (u16*)(p.ws + WS_AN) + (size_t)(qtok0 + rg * 32 + r) * 512 + head * 128;
    const float* gw = p.in[17] + l * 512 + head * 128;
#pragma unroll
    for (int dt = 0; dt < 4; ++dt)
#pragma unroll
      for (int g = 0; g < 4; ++g) {
        const int dv = dt * 32 + 8 * g + 4 * h;
        const float4 g4 = *(const float4*)(gw + dv);
        uint2 o;
        o.x = pack2(O[dt][4 * g] * rs * g4.x, O[dt][4 * g + 1] * rs * g4.y);
        o.y = pack2(O[dt][4 * g + 2] * rs * g4.z, O[dt][4 * g + 3] * rs * g4.w);
        *(uint2*)(AN + dv) = o;
      }
  }
}

constexpr int ML_QS = 64;
constexpr int ML_KS = ML_QS + 64 * 272;
constexpr int ML_KT = ML_KS + 64 * 272;
constexpr int ML_VT = ML_KT + 128 * 144;
constexpr int ML_CB = ML_VT + 128 * 144;
constexpr int ML_HB = ML_CB + 128 * 272;
constexpr int ML_SM = ML_HB + 64 * 132 * 4;
static_assert(ML_SM + 528 * 4 <= LDS_BYTES, "lds");

DI void mlstm_item(const Params& p, int l, int b, int head, unsigned char* smem) {
  const int tid = otid(), lane = tid & 63, w = tid >> 6, r = lane & 31, h = lane >> 5;
  const bool prompt = b < 32;
  const int bs = b - 32;
  const int T = prompt ? 2048 : 32;
  const int nch = prompt ? 32 : 1;
  const int L = prompt ? 64 : 32;
  const int tokbase = prompt ? b * 2048 : TOKP + bs * 32;
  const u16* qkT = prompt ? (const u16*)(p.ws + WS_MQKT_P) + (size_t)b * 1024 * 2048 : (const u16*)(p.ws + WS_MQKT_S) + (size_t)bs * 1024 * 32;
  const u16* vTg = prompt ? (const u16*)(p.ws + WS_MVT_P) + (size_t)b * 512 * 2048 : (const u16*)(p.ws + WS_MVT_S) + (size_t)bs * 512 * 32;
  u16* qs = (u16*)(smem + ML_QS);
  u16* ksm = (u16*)(smem + ML_KS);
  u16* kTw = (u16*)(smem + ML_KT);
  u16* vT = (u16*)(smem + ML_VT);
  u16* Cbf = (u16*)(smem + ML_CB);
  float* hbuf = (float*)(smem + ML_HB);
  float* a_s = (float*)(smem + ML_SM);
  float* mx_s = a_s + 64;
  float* ws_s = a_s + 128;
  float* wi_s = a_s + 192;
  float* emt_s = a_s + 256;
  float* nq_s = a_s + 320;
  float* nvec = a_s + 384;
  float* scal = a_s + 512;

  const int vt = w & 3, kt0 = (w >> 2) * 2;
  f32x16 accC[2];
  float m_run = 0.f;
  if (prompt) {
    zero16(accC[0]); zero16(accC[1]);
    if (tid < 128) nvec[tid] = 0.f;
  } else {
    const float* Cs = p.in[6] + ((size_t)(l * 8 + bs) * 4 + head) * 128 * 128;
#pragma unroll
    for (int q = 0; q < 2; ++q)
#pragma unroll
      for (int g = 0; g < 4; ++g) {
        const float4 c4 = *(const float4*)(Cs + (size_t)(vt * 32 + r) * 128 + (kt0 + q) * 32 + 8 * g + 4 * h);
        accC[q][4 * g] = c4.x; accC[q][4 * g + 1] = c4.y; accC[q][4 * g + 2] = c4.z; accC[q][4 * g + 3] = c4.w;
      }
    if (tid < 128) nvec[tid] = p.in[7][((size_t)(l * 8 + bs) * 4 + head) * 128 + tid];
    m_run = p.in[8][(l * 8 + bs) * 4 + head];
  }
#pragma unroll
  for (int q = 0; q < 2; ++q)
#pragma unroll
    for (int g = 0; g < 4; ++g) {
      uint2 o; o.x = pack2(accC[q][4 * g], accC[q][4 * g + 1]); o.y = pack2(accC[q][4 * g + 2], accC[q][4 * g + 3]);
      *(uint2*)(Cbf + (vt * 32 + r) * 136 + (kt0 + q) * 32 + 8 * g + 4 * h) = o;
    }
  const float* gatesp = (const float*)(p.ws + WS_GATES);
  const int vi = w >> 1, ti = w & 1;

  float ig_n = -INFINITY, fg_n = 0.f;
  if (w == 0 && lane < L) {
    const float* gp = gatesp + (size_t)(tokbase + lane) * 8;
    ig_n = gp[head]; fg_n = gp[4 + head];
  }
  for (int c = 0; c < nch; ++c) {
    const int t0 = c * 64;
    if (w == 0) {
      const int t = lane;
      float ig = -INFINITY, lf = 0.f;
      if (t < L) {
        ig = ig_n;
        const float fg = fg_n;
        lf = fminf(fg, 0.f) - log1pf(__expf(-fabsf(fg)));
        if (c + 1 < nch) {
          const float* gp = gatesp + (size_t)(tokbase + t0 + 64 + t) * 8;
          ig_n = gp[head]; fg_n = gp[4 + head];
        }
      }
      float bc = lf;
#pragma unroll
      for (int off = 1; off < 64; off <<= 1) { const float v = shidx(bc, lane - off, lane); if (lane >= off) bc += v; }
      const float a = ig - bc;
      float M = a;
#pragma unroll
      for (int off = 1; off < 64; off <<= 1) { const float v = shidx(M, lane - off, lane); if (lane >= off) M = fmaxf(M, v); }
      const float mx = fmaxf(m_run, M);
      const float bL = shidx(bc, 63, lane);
      const float mxL = shidx(mx, 63, lane);
      a_s[t] = a; mx_s[t] = mx;
      ws_s[t] = __expf(a - mxL);
      wi_s[t] = __expf(m_run - mx);
      emt_s[t] = __expf(-(bc + mx));
      if (lane == 0) scal[1] = __expf(m_run - mxL);
      m_run = bL + mxL;
    }
    const int ch2 = tid >> 1, th = tid & 1;
    const bool isk = ch2 >= 128;
    const int dd = ch2 & 127;
    const int ch = (isk ? 512 : 0) + head * 128 + dd;
    const u16* rp = qkT + (size_t)ch * T + t0 + th * 32;
    float um3 = 0.f, um2 = 0.f, um1 = 0.f;
    const bool ldrow = prompt || th == 0;
    uint4 uu0 = make_uint4(0, 0, 0, 0), uu1 = uu0, uu2 = uu0, uu3 = uu0, vv0 = uu0, vv1 = uu0;
    if (ldrow) { uu0 = *(const uint4*)(rp); uu1 = *(const uint4*)(rp + 8); uu2 = *(const uint4*)(rp + 16); uu3 = *(const uint4*)(rp + 24); }
    {
      const int row = tid >> 3, cc = tid & 7;
      if (prompt || cc < 4) {
        vv0 = *(const uint4*)(vTg + (size_t)(head * 128 + row) * T + t0 + cc * 8);
        vv1 = *(const uint4*)(vTg + (size_t)(head * 128 + row + 64) * T + t0 + cc * 8);
      }
    }
    if (prompt) {
      if (th == 1 || c > 0) {
        const uint2 pv = *(const uint2*)(rp - 4);
        um3 = bfhi(pv.x); um2 = bflo(pv.y); um1 = bfhi(pv.y);
      }
    } else if (th == 0) {
      const float* cvp = p.in[9] + (size_t)(l * 8 + bs) * 3 * 1024 + ch;
      um3 = cvp[0]; um2 = cvp[1024]; um1 = cvp[2048];
    }
    const float cw0 = p.in[14][(l * 4 + 0) * 1024 + ch], cw1 = p.in[14][(l * 4 + 1) * 1024 + ch];
    const float cw2 = p.in[14][(l * 4 + 2) * 1024 + ch], cw3 = p.in[14][(l * 4 + 3) * 1024 + ch];
    const float cb = p.in[15][l * 1024 + ch];
    __syncthreads();
    {
      u16* dstrm = (isk ? ksm : qs) + (th * 32) * 136 + dd;
      const float oscale = isk ? 0.08838834764831845f : 1.f;
#pragma unroll
      for (int i = 0; i < 4; ++i) {
        const uint4 uu = (i == 0) ? uu0 : (i == 1 ? uu1 : (i == 2 ? uu2 : uu3));
        float u[8];
        u[0] = bflo(uu.x); u[1] = bfhi(uu.x); u[2] = bflo(uu.y); u[3] = bfhi(uu.y);
        u[4] = bflo(uu.z); u[5] = bfhi(uu.z); u[6] = bflo(uu.w); u[7] = bfhi(uu.w);
        float y[8];
#pragma unroll
        for (int e = 0; e < 8; ++e) {
          const float x3 = (e >= 3) ? u[e - 3] : (e == 0 ? um3 : (e == 1 ? um2 : um1));
          const float x2 = (e >= 2) ? u[e - 2] : (e == 0 ? um2 : um1);
          const float x1 = (e >= 1) ? u[e - 1] : um1;
          const float yy = cb + cw0 * x3 + cw1 * x2 + cw2 * x1 + cw3 * u[e];
          y[e] = siluf_(yy) * oscale;
        }
        um3 = u[5]; um2 = u[6]; um1 = u[7];
#pragma unroll
        for (int e = 0; e < 8; ++e) dstrm[(i * 8 + e) * 136] = f2bf(y[e]);
        if (isk) {
          const float4 w0 = *(const float4*)(ws_s + th * 32 + i * 8);
          const float4 w1 = *(const float4*)(ws_s + th * 32 + i * 8 + 4);
          uint4 o;
          o.x = pack2(y[0] * w0.x, y[1] * w0.y); o.y = pack2(y[2] * w0.z, y[3] * w0.w);
          o.z = pack2(y[4] * w1.x, y[5] * w1.y); o.w = pack2(y[6] * w1.z, y[7] * w1.w);
          *(uint4*)(kTw + dd * 72 + th * 32 + i * 8) = o;
        }
      }
      {
        const int row = tid >> 3, cc = tid & 7;
        *(uint4*)(vT + row * 72 + cc * 8) = vv0;
        *(uint4*)(vT + (row + 64) * 72 + cc * 8) = vv1;
      }
    }
    __syncthreads();
    {
      const int t = tid >> 3, part = tid & 7;
      const uint4 q0 = *(const uint4*)(qs + t * 136 + part * 16);
      const uint4 q1 = *(const uint4*)(qs + t * 136 + part * 16 + 8);
      const float* nv = nvec + part * 16;
      float s = bflo(q0.x) * nv[0] + bfhi(q0.x) * nv[1] + bflo(q0.y) * nv[2] + bfhi(q0.y) * nv[3]
              + bflo(q0.z) * nv[4] + bfhi(q0.z) * nv[5] + bflo(q0.w) * nv[6] + bfhi(q0.w) * nv[7]
              + bflo(q1.x) * nv[8] + bfhi(q1.x) * nv[9] + bflo(q1.y) * nv[10] + bfhi(q1.y) * nv[11]
              + bflo(q1.z) * nv[12] + bfhi(q1.z) * nv[13] + bflo(q1.w) * nv[14] + bfhi(q1.w) * nv[15];
      s += shx(s, 1, lane); s += shx(s, 2, lane); s += shx(s, 4, lane);
      if (part == 0) nq_s[t] = s;
    }
    f32x16 accS[2], accO;
    zero16(accS[0]); zero16(accS[1]); zero16(accO);
    {
#pragma unroll
      for (int ks = 0; ks < 8; ++ks) {
        const bf16x8 qfr = *(const bf16x8*)(qs + (ti * 32 + r) * 136 + ks * 16 + h * 8);
        const bf16x8 k0 = *(const bf16x8*)(ksm + r * 136 + ks * 16 + h * 8);
        accS[0] = MFMA(k0, qfr, accS[0]);
        if (ti == 1) {
          const bf16x8 k1 = *(const bf16x8*)(ksm + (32 + r) * 136 + ks * 16 + h * 8);
          accS[1] = MFMA(k1, qfr, accS[1]);
        }
        const bf16x8 cf = *(const bf16x8*)(Cbf + (vi * 32 + r) * 136 + ks * 16 + h * 8);
        accO = MFMA(cf, qfr, accO);
      }
    }
    const int tcol = ti * 32 + r;
    const float mxt = mx_s[tcol];
    const float wit = wi_s[tcol];
    float dsum = 0.f;
#pragma unroll
    for (int sub = 0; sub < 2; ++sub) {
      if (sub <= ti) {
#pragma unroll
        for (int g = 0; g < 4; ++g) {
          const float4 a4 = *(const float4*)(a_s + sub * 32 + 8 * g + 4 * h);
          const float av[4] = {a4.x, a4.y, a4.z, a4.w};
#pragma unroll
          for (int e = 0; e < 4; ++e) {
            const int s = sub * 32 + 8 * g + 4 * h + e;
            const float wgt = (s <= tcol) ? __expf(av[e] - mxt) : 0.f;
            const float pv = accS[sub][4 * g + e] * wgt;
            accS[sub][4 * g + e] = pv;
            dsum += pv;
          }
        }
      }
    }
    dsum += shx(dsum, 32, lane);
#pragma unroll
    for (int i = 0; i < 16; ++i) accO[i] *= wit;
#pragma unroll
    for (int sub = 0; sub < 2; ++sub) {
      if (sub <= ti) {
#pragma unroll
        for (int s2 = 0; s2 < 2; ++s2) {
          const bf16x8 pf = pack8(accS[sub], s2);
          const u16* va = vT + (vi * 32 + r) * 72 + sub * 32 + s2 * 16 + 4 * h;
          const uint2 lo = *(const uint2*)va;
          const uint2 hi = *(const uint2*)(va + 8);
          const uint4 vq = make_uint4(lo.x, lo.y, hi.x, hi.y);
          accO = MFMA(__builtin_bit_cast(bf16x8, vq), pf, accO);
        }
      }
    }
    __syncthreads();
    {
      const float den = dsum + wit * nq_s[tcol];
      const float dn = fmaxf(fabsf(den), emt_s[tcol]);
      const float rinv = 1.f / dn;
#pragma unroll
      for (int g = 0; g < 4; ++g)
        *(float4*)(hbuf + tcol * 132 + vi * 32 + 8 * g + 4 * h) =
            make_float4(accO[4 * g] * rinv, accO[4 * g + 1] * rinv, accO[4 * g + 2] * rinv, accO[4 * g + 3] * rinv);
    }
    {
      const float wc = scal[1];
#pragma unroll
      for (int q = 0; q < 2; ++q)
#pragma unroll
        for (int i = 0; i < 16; ++i) accC[q][i] *= wc;
#pragma unroll
      for (int k4 = 0; k4 < 4; ++k4) {
        const bf16x8 vf = *(const bf16x8*)(vT + (vt * 32 + r) * 72 + k4 * 16 + h * 8);
#pragma unroll
        for (int q = 0; q < 2; ++q) {
          const bf16x8 kf = *(const bf16x8*)(kTw + ((kt0 + q) * 32 + r) * 72 + k4 * 16 + h * 8);
          accC[q] = MFMA(kf, vf, accC[q]);
        }
      }
#pragma unroll
      for (int q = 0; q < 2; ++q)
#pragma unroll
        for (int g = 0; g < 4; ++g) {
          uint2 o; o.x = pack2(accC[q][4 * g], accC[q][4 * g + 1]); o.y = pack2(accC[q][4 * g + 2], accC[q][4 * g + 3]);
          *(uint2*)(Cbf + (vt * 32 + r) * 136 + (kt0 + q) * 32 + 8 * g + 4 * h) = o;
        }
      if (tid < 128) {
        float s = 0.f;
#pragma unroll
        for (int i = 0; i < 8; ++i) {
          const uint4 kk = *(const uint4*)(kTw + tid * 72 + i * 8);
          s += bflo(kk.x) + bfhi(kk.x) + bflo(kk.y) + bfhi(kk.y) + bflo(kk.z) + bfhi(kk.z) + bflo(kk.w) + bfhi(kk.w);
        }
        nvec[tid] = wc * nvec[tid] + s;
      }
    }
    __syncthreads();
    {
      const int t = tid >> 3, part = tid & 7;
      float x[16];
#pragma unroll
      for (int i = 0; i < 4; ++i) {
        const float4 f = *(const float4*)(hbuf + t * 132 + part * 16 + i * 4);
        x[i * 4] = f.x; x[i * 4 + 1] = f.y; x[i * 4 + 2] = f.z; x[i * 4 + 3] = f.w;
      }
      float s = 0.f;
#pragma unroll
      for (int i = 0; i < 16; ++i) s += x[i];
      s += shx(s, 1, lane); s += shx(s, 2, lane); s += shx(s, 4, lane);
      const float mean = s * (1.f / 128.f);
      float q = 0.f;
#pragma unroll
      for (int i = 0; i < 16; ++i) { x[i] -= mean; q += x[i] * x[i]; }
      q += shx(q, 1, lane); q += shx(q, 2, lane); q += shx(q, 4, lane);
      const float rstd = rsqrtf(q * (1.f / 128.f) + LN_EPS);
      if (t < L) {
        const size_t tok = (size_t)tokbase + t0 + t;
        const int cbase = head * 128 + part * 16;
        const float* gw = p.in[18] + l * 512 + cbase;
        const u16* mo = (const u16*)(p.ws + WS_MO) + tok * 512 + cbase;
        const uint4 m0 = *(const uint4*)mo;
        const uint4 m1 = *(const uint4*)(mo + 8);
        const float sg[16] = {bflo(m0.x), bfhi(m0.x), bflo(m0.y), bfhi(m0.y), bflo(m0.z), bfhi(m0.z), bflo(m0.w), bfhi(m0.w),
                              bflo(m1.x), bfhi(m1.x), bflo(m1.y), bfhi(m1.y), bflo(m1.z), bfhi(m1.z), bflo(m1.w), bfhi(m1.w)};
        float yv[16];
#pragma unroll
        for (int i = 0; i < 16; ++i) yv[i] = x[i] * rstd * gw[i] * sg[i];
        uint4 o0, o1;
        o0.x = pack2(yv[0], yv[1]); o0.y = pack2(yv[2], yv[3]); o0.z = pack2(yv[4], yv[5]); o0.w = pack2(yv[6], yv[7]);
        o1.x = pack2(yv[8], yv[9]); o1.y = pack2(yv[10], yv[11]); o1.z = pack2(yv[12], yv[13]); o1.w = pack2(yv[14], yv[15]);
        u16* mn = (u16*)(p.ws + WS_MN) + tok * 512 + cbase;
        *(uint4*)mn = o0;
        *(uint4*)(mn + 8) = o1;
      }
    }
  }
  {
    float* oc = p.out + (prompt ? O_CP + ((size_t)(l * 32 + b) * 4 + head) * 16384 : O_CS + ((size_t)(l * 8 + bs) * 4 + head) * 16384);
#pragma unroll
    for (int q = 0; q < 2; ++q)
#pragma unroll
      for (int g = 0; g < 4; ++g)
        *(float4*)(oc + (size_t)(vt * 32 + r) * 128 + (kt0 + q) * 32 + 8 * g + 4 * h) =
            make_float4(accC[q][4 * g], accC[q][4 * g + 1], accC[q][4 * g + 2], accC[q][4 * g + 3]);
    float* on = p.out + (prompt ? O_NP + ((size_t)(l * 32 + b) * 4 + head) * 128 : O_NS + ((size_t)(l * 8 + bs) * 4 + head) * 128);
    if (tid < 128) on[tid] = nvec[tid];
    if (tid == 0) {
      if (prompt) p.out[O_MP + (size_t)(l * 32 + b) * 4 + head] = m_run;
      else p.out[O_MS + (size_t)(l * 8 + bs) * 4 + head] = m_run;
    }
  }
}

DI void phase_mixers(const Params& p, int l, unsigned char* smem) {
  const int tid0 = otid();
  const int lane = tid0 & 63;
  const float* lp = p.in[16] + l * 256;
  float s1 = lp[lane] * lp[64 + lane], s2 = lp[128 + lane] * lp[192 + lane];
  s1 = wave_sum(s1, lane); s2 = wave_sum(s2, lane);
  const float lam_init = 0.8f - 0.6f * expf(-0.3f * (float)l);
  const float lam = expf(s1) - expf(s2) + lam_init;
  int* ctr = (int*)(p.ws + WS_CTR) + l;
  int* sitem = (int*)smem;
  const int N_ML = 160, N_AT = 2048 + 32;
  for (;;) {
    __syncthreads();
    if (tid0 == 0) *sitem = atomicAdd(ctr, 1);
    __syncthreads();
    const int item = *sitem;
    if (item >= N_ML + N_AT) break;
    if (item < N_ML) {
#ifndef NO_ML
      mlstm_item(p, l, item >> 2, item & 3, smem);
#endif
    } else {
#ifndef NO_AT
      const int a = item - N_ML;
      if (a < 2048) {
        const int qt = 15 - (a >> 7), rest = a & 127;
        attn_item(p, l, rest >> 2, rest & 3, qt, lam, lam_init, smem);
      } else {
        const int s = a - 2048;
        attn_item(p, l, 32 + (s >> 2), s & 3, 0, lam, lam_init, smem);
      }
#endif
    }
  }
}

DI void gbar(unsigned* ctl, unsigned& k) {
  __syncthreads();
  ++k;
  if (otid() == 0) {
    __threadfence();
    const unsigned x = blockIdx.x & 7;
    const unsigned gsz = (gridDim.x + 7 - x) >> 3;
    const unsigned ngroups = gridDim.x < 8 ? gridDim.x : 8;
    unsigned* gc = ctl + 64 + x * 32;
    unsigned* gl = ctl + 32;
    const unsigned old = __hip_atomic_fetch_add(gc, 1u, __ATOMIC_RELAXED, __HIP_MEMORY_SCOPE_AGENT);
    if (old + 1 == k * gsz) {
      __threadfence();
      __hip_atomic_fetch_add(gl, 1u, __ATOMIC_RELAXED, __HIP_MEMORY_SCOPE_AGENT);
    }
    while (__hip_atomic_load(gl, __ATOMIC_RELAXED, __HIP_MEMORY_SCOPE_AGENT) < k * ngroups) __builtin_amdgcn_s_sleep(1);
    __threadfence();
  }
  __syncthreads();
}

__global__ void __launch_bounds__(NTHR) fwd_megakernel(Params p) {
  extern __shared__ __attribute__((aligned(16))) unsigned char smem[];
  cg::grid_group grid = cg::this_grid();
#ifndef PH
#define PH 0xffff
#endif
  unsigned* bar = (unsigned*)(p.ws + WS_CTR);
  unsigned epoch = 0;
  if (PH & 1) prologue(p, smem);
  grid.sync();
  if (PH & 1) prologue(p, smem);
  grid.sync();
  if (PH & 2) ln_pass(p, 0, 0, smem);
  gbar(bar, epoch);
#pragma unroll 1
  for (int l = 0; l < 2; ++l) {
    if (PH & 4) phase_in_gate(p, l, smem);
    gbar(bar, epoch);
    if (PH & 8) phase_mixers(p, l, smem);
    gbar(bar, epoch);
    if (PH & 16) phase_mix(p, l, smem);
    gbar(bar, epoch);
    if (PH & 32) phase_res(p, l, 0, smem);
    gbar(bar, epoch);
    if (PH & 64) ln_pass(p, 1, l, smem);
    gbar(bar, epoch);
    if (PH & 128) phase_gu(p, l, smem);
    gbar(bar, epoch);
    if (PH & 256) phase_res(p, l, 1, smem);
    gbar(bar, epoch);
    if (PH & 512) ln_pass(p, 2, l, smem);
    if (l == 0) gbar(bar, epoch);
  }
}

extern "C" void kernel_launch(void* const* d_in, const int* in_sizes, int n_in, void* d_out, int out_size, void* d_ws,
                              size_t ws_size, hipStream_t stream) {
  static int grid_blocks = 0;
  if (!grid_blocks) {
    int dev = 0, cus = 0, per_cu = 0;
    hipGetDevice(&dev);
    hipDeviceGetAttribute(&cus, hipDeviceAttributeMultiprocessorCount, dev);
    if (hipFuncSetAttribute((const void*)fwd_megakernel, hipFuncAttributeMaxDynamicSharedMemorySize, LDS_BYTES) != hipSuccess)
      fprintf(stderr, "kernel_launch: hipFuncSetAttribute failed\n");
    if (hipOccupancyMaxActiveBlocksPerMultiprocessor(&per_cu, (const void*)fwd_megakernel, NTHR, LDS_BYTES) != hipSuccess || per_cu < 1) {
      fprintf(stderr, "kernel_launch: occupancy query gave %d\n", per_cu);
      per_cu = 1;
    }
    (void)hipGetLastError();
    grid_blocks = cus * per_cu;
    if (ws_size < WS_END) fprintf(stderr, "kernel_launch: workspace too small: %zu < %zu\n", ws_size, (size_t)WS_END);
  }
  if (hipMemsetAsync((char*)d_ws + WS_CTR, 0, 4096, stream) != hipSuccess) fprintf(stderr, "kernel_launch: memset failed\n");
  Params p{};
  for (int i = 0; i < 30; ++i) p.in[i] = (const float*)d_in[i];
  p.out = (float*)d_out;
  p.ws = (unsigned char*)d_ws;
  void* args[] = {&p};
  hipError_t e = hipLaunchCooperativeKernel((const void*)fwd_megakernel, dim3(grid_blocks), dim3(NTHR), args, LDS_BYTES, stream);
  if (e != hipSuccess) fprintf(stderr, "cooperative launch failed: %s (grid %d)\n", hipGetErrorString(e), grid_blocks);
}
```

```cpp
#include <hip/hip_runtime.h>
#include <hip/hip_cooperative_groups.h>
#include <cstdio>
namespace cg = cooperative_groups;

#define DI __device__ __forceinline__
typedef unsigned short u16;
using bf16x8 = __attribute__((ext_vector_type(8))) short;
using f32x16 = __attribute__((ext_vector_type(16))) float;
#define MFMA(a, b, c) __builtin_amdgcn_mfma_f32_32x32x16_bf16((a), (b), (c), 0, 0, 0)

constexpr int TOKP = 65536, TOKS = 256, TOK = 65792;
constexpr int NTHR = 512;
constexpr float LN_EPS = 1e-5f;
constexpr float ALPHA = 1.41421356237f;
constexpr float LOG2E = 1.44269504089f;

constexpr size_t WS_WT_IN   = 0;
constexpr size_t WS_WT_GATE = WS_WT_IN + 2ull * 3584 * 1024 * 2;
constexpr size_t WS_WT_BRA  = WS_WT_GATE + 2ull * 2048 * 1024 * 2;
constexpr size_t WS_WT_BRB  = WS_WT_BRA + 2ull * 1024 * 512 * 2;
constexpr size_t WS_WT_O    = WS_WT_BRB + 2ull * 1024 * 512 * 2;
constexpr size_t WS_WT_GU   = WS_WT_O + 2ull * 1024 * 1024 * 2;
constexpr size_t WS_WT_DOWN = WS_WT_GU + 2ull * 5632 * 1024 * 2;
constexpr size_t WS_MOD     = WS_WT_DOWN + 2ull * 1024 * 2816 * 2;
constexpr size_t WS_GATES   = WS_MOD + 2ull * 40 * 6144 * 4;
constexpr size_t WS_CTR     = WS_GATES + (size_t)TOK * 8 * 4;
constexpr size_t WS_STAT    = WS_CTR + 4096;
constexpr size_t WS_KS      = WS_STAT + (size_t)TOK * 8;
constexpr size_t WS_VTS     = WS_KS + 2ull * 8 * 1056 * 512 * 2 + 65536;
constexpr size_t WS_MQKT_S  = WS_VTS + 2ull * 8 * 512 * 1056 * 2 + 65536;
constexpr size_t WS_MVT_S   = WS_MQKT_S + 8ull * 1024 * 32 * 2;
constexpr size_t WS_H       = WS_MVT_S + 8ull * 512 * 32 * 2;
constexpr size_t WS_AN      = WS_H;
constexpr size_t WS_MN      = WS_H + (size_t)TOK * 512 * 2;
constexpr size_t WS_ZQ      = WS_H + (size_t)TOK * 1024 * 2;
constexpr size_t WS_KB      = WS_ZQ + (size_t)TOK * 512 * 2;
constexpr size_t WS_VTP     = WS_KB + (size_t)TOKP * 512 * 2;
constexpr size_t WS_MQKT_P  = WS_VTP + 32ull * 512 * 2048 * 2;
constexpr size_t WS_MVT_P   = WS_MQKT_P + 32ull * 1024 * 2048 * 2;
constexpr size_t WS_MO      = WS_MVT_P + 32ull * 512 * 2048 * 2;
constexpr size_t WS_G       = WS_MO + (size_t)TOK * 512 * 2;
constexpr size_t WS_END     = WS_G + (size_t)TOK * 2048 * 2;
constexpr size_t WS_MIX     = WS_ZQ;
constexpr size_t WS_ACT     = WS_ZQ;

constexpr size_t O_YP  = 0;
constexpr size_t O_YS  = O_YP + (size_t)TOKP * 1024;
constexpr size_t O_KP  = O_YS + (size_t)TOKS * 1024;
constexpr size_t O_VP  = O_KP + 2ull * TOKP * 512;
constexpr size_t O_KSM = O_VP + 2ull * TOKP * 512;
constexpr size_t O_VSM = O_KSM + 2ull * TOKS * 512;
constexpr size_t O_CP  = O_VSM + 2ull * TOKS * 512;
constexpr size_t O_NP  = O_CP + 2ull * 32 * 4 * 128 * 128;
constexpr size_t O_MP  = O_NP + 2ull * 32 * 4 * 128;
constexpr size_t O_CVP = O_MP + 2ull * 32 * 4;
constexpr size_t O_CS  = O_CVP + 2ull * 32 * 3 * 1024;
constexpr size_t O_NS  = O_CS + 2ull * 8 * 4 * 128 * 128;
constexpr size_t O_MS  = O_NS + 2ull * 8 * 4 * 128;
constexpr size_t O_CVS = O_MS + 2ull * 8 * 4;

constexpr int LDS_BYTES = 148480;

struct Params {
  const float* in[30];
  float* out;
  unsigned char* ws;
};

DI u16 f2bf(float x) { unsigned u = __float_as_uint(x); u += 0x7fffu + ((u >> 16) & 1u); return (u16)(u >> 16); }
DI float bf2f(unsigned v) { return __uint_as_float(v << 16); }
typedef __bf16 bf16x2_t __attribute__((ext_vector_type(2)));
typedef float f32x2_t __attribute__((ext_vector_type(2)));
DI unsigned pack2(float a, float b) {
  f32x2_t v = {a, b};
  return __builtin_bit_cast(unsigned, __builtin_convertvector(v, bf16x2_t));
}
DI float bflo(unsigned v) { return __uint_as_float(v << 16); }
DI float bfhi(unsigned v) { return __uint_as_float(v & 0xffff0000u); }
DI float sigmoidf_(float x) { return 1.f / (1.f + __expf(-x)); }
DI float siluf_(float x) { return x / (1.f + __expf(-x)); }
DI float fexp2(float x) { return __builtin_amdgcn_exp2f(x); }
DI int otid() { int t = threadIdx.x; asm volatile("" : "+v"(t)); return t; }
DI float shx(float v, int mask, int lane) { return __int_as_float(__builtin_amdgcn_ds_bpermute(((lane ^ mask) & 63) << 2, __float_as_int(v))); }
DI float shidx(float v, int src, int lane) { (void)lane; return __int_as_float(__builtin_amdgcn_ds_bpermute((src & 63) << 2, __float_as_int(v))); }
DI int crow(int i, int h) { return (i & 3) + 8 * (i >> 2) + 4 * h; }
DI bf16x8 pack8(const f32x16& x, int s) {
  uint4 u;
  u.x = pack2(x[8 * s + 0], x[8 * s + 1]); u.y = pack2(x[8 * s + 2], x[8 * s + 3]);
  u.z = pack2(x[8 * s + 4], x[8 * s + 5]); u.w = pack2(x[8 * s + 6], x[8 * s + 7]);
  return __builtin_bit_cast(bf16x8, u);
}
DI void zero16(f32x16& a) {
#pragma unroll
  for (int i = 0; i < 16; ++i) a[i] = 0.f;
}
DI int batch_of_row(int row) { return row < TOKP ? (row >> 11) : 32 + ((row - TOKP) >> 5); }

constexpr int GS_STRIDE = 144;
constexpr int GS_STAGE = 512 * GS_STRIDE;
constexpr int GS_BASE = 64;

DI void gemm_mainloop(f32x16 (&acc)[4][2], const u16* __restrict__ A, int lda, const u16* __restrict__ Wt, int ldw, int K,
                      int m0, int n0, unsigned char* smem) {
  const int tid = otid(), lane = tid & 63, w = tid >> 6;
  const int wm = w >> 2, wn = w & 3, r = lane & 31, h = lane >> 5;
  const int lrow = tid >> 3, lcc = tid & 7;
  const u16* ap = A + (size_t)(m0 + lrow) * lda + lcc * 8;
  const int bn = n0 + 2 * (lrow & 31) + ((lrow >> 5) & 1);
  const u16* bp = Wt + (size_t)bn * ldw + lcc * 8;
  const size_t astep = (size_t)64 * lda, bstep = (size_t)64 * ldw;
  unsigned char* sbase = smem + GS_BASE;
  const int woff = lrow * GS_STRIDE + lcc * 16;
  const int nk = K >> 6;
  uint4 s0, s1, s2, s3, s4, s5, s6, s7, u0, u1, u2, u3, u4, u5, u6, u7;
  int kn = 1;
#define G_ADV() do { const int adv = (kn < nk) ? 64 : 0; ap += adv; bp += adv; ++kn; } while (0)
#define G_ISSUE_A() do { s0 = *(const uint4*)(ap); s1 = *(const uint4*)(ap + astep); s2 = *(const uint4*)(ap + 2 * astep); s3 = *(const uint4*)(ap + 3 * astep); \
    s4 = *(const uint4*)(bp); s5 = *(const uint4*)(bp + bstep); s6 = *(const uint4*)(bp + 2 * bstep); s7 = *(const uint4*)(bp + 3 * bstep); } while (0)
#define G_ISSUE_B() do { u0 = *(const uint4*)(ap); u1 = *(const uint4*)(ap + astep); u2 = *(const uint4*)(ap + 2 * astep); u3 = *(const uint4*)(ap + 3 * astep); \
    u4 = *(const uint4*)(bp); u5 = *(const uint4*)(bp + bstep); u6 = *(const uint4*)(bp + 2 * bstep); u7 = *(const uint4*)(bp + 3 * bstep); } while (0)
#define G_WRITE_A(sn) do { *(uint4*)((sn) + woff) = s0; *(uint4*)((sn) + woff + 64 * GS_STRIDE) = s1; *(uint4*)((sn) + woff + 128 * GS_STRIDE) = s2; \
    *(uint4*)((sn) + woff + 192 * GS_STRIDE) = s3; *(uint4*)((sn) + woff + 256 * GS_STRIDE) = s4; *(uint4*)((sn) + woff + 320 * GS_STRIDE) = s5; \
    *(uint4*)((sn) + woff + 384 * GS_STRIDE) = s6; *(uint4*)((sn) + woff + 448 * GS_STRIDE) = s7; } while (0)
#define G_WRITE_B(sn) do { *(uint4*)((sn) + woff) = u0; *(uint4*)((sn) + woff + 64 * GS_STRIDE) = u1; *(uint4*)((sn) + woff + 128 * GS_STRIDE) = u2; \
    *(uint4*)((sn) + woff + 192 * GS_STRIDE) = u3; *(uint4*)((sn) + woff + 256 * GS_STRIDE) = u4; *(uint4*)((sn) + woff + 320 * GS_STRIDE) = u5; \
    *(uint4*)((sn) + woff + 384 * GS_STRIDE) = u6; *(uint4*)((sn) + woff + 448 * GS_STRIDE) = u7; } while (0)
  const int aoff = (wm * 128 + r) * GS_STRIDE + h * 16;
  const int boff = (256 + wn * 64 + r) * GS_STRIDE + h * 16;
#define G_COMPUTE(st) do { _Pragma("unroll") for (int ks = 0; ks < 4; ++ks) {                                              \
      bf16x8 fa[4], fb[2];                                                                                               \
      _Pragma("unroll") for (int mi = 0; mi < 4; ++mi) fa[mi] = *(const bf16x8*)((st) + aoff + mi * 32 * GS_STRIDE + ks * 32); \
      fb[0] = *(const bf16x8*)((st) + boff + ks * 32);                                                                   \
      fb[1] = *(const bf16x8*)((st) + boff + 32 * GS_STRIDE + ks * 32);                                                  \
      _Pragma("unroll") for (int mi = 0; mi < 4; ++mi) {                                                                 \
        acc[mi][0] = MFMA(fa[mi], fb[0], acc[mi][0]);                                                                    \
        acc[mi][1] = MFMA(fa[mi], fb[1], acc[mi][1]);                                                                    \
      }                                                                                                                  \
      __builtin_amdgcn_sched_barrier(0);                                                                                 \
    } } while (0)
  G_ISSUE_A();
  G_WRITE_A(sbase);
  G_ADV(); G_ISSUE_A();
  G_ADV(); G_ISSUE_B();
  __syncthreads();
  for (int kt = 0; kt < nk; kt += 2) {
    G_WRITE_A(sbase + GS_STAGE);
    G_ADV(); G_ISSUE_A();
    __builtin_amdgcn_sched_barrier(0);
    G_COMPUTE(sbase);
    __syncthreads();
    G_WRITE_B(sbase);
    G_ADV(); G_ISSUE_B();
    __builtin_amdgcn_sched_barrier(0);
    G_COMPUTE(sbase + GS_STAGE);
    __syncthreads();
  }
#undef G_ADV
#undef G_ISSUE_A
#undef G_ISSUE_B
#undef G_WRITE_A
#undef G_WRITE_B
#undef G_COMPUTE
}

DI int rot_unused_(int) { return 0; }
DI bool tile_of(int i, int MT, int NT, int& mt, int& nt) {
  const int per = gridDim.x >> 3;
  const int L = i * (int)gridDim.x + (int)(blockIdx.x & 7) * per + (int)(blockIdx.x >> 3);
  if (L >= MT * NT) return false;
  const int nig = 8 * NT, gid = L / nig, fm = gid * 8, gsz = min(MT - fm, 8), rem = L - gid * nig;
  mt = fm + rem % gsz; nt = rem / gsz;
  return true;
}


template <class PF, class EF>
DI void gemm_stream(int lda, int ldw, int K, unsigned char* smem, PF ptrs, EF epi) {
  const int tid = otid(), lane = tid & 63, w = tid >> 6;
  const int wm = w >> 2, wn = w & 3, r = lane & 31, h = lane >> 5;
  unsigned char* sbase = smem + GS_BASE;
  constexpr int SLOT = 512 * 64;
  const int nh = K >> 5;
  const int c0 = (h ^ ((r >> 2) & 3)) * 16, c1 = c0 ^ 32;
  const int aoff = (wm * 128 + r) * 64, boff = (256 + wn * 64 + r) * 64;
  const int lr16 = lane >> 2, lchunk = (lane & 3) ^ ((lane >> 4) & 3);
  const int wu = __builtin_amdgcn_readfirstlane(w);
  const bool isB = wu >= 4;
  const unsigned goff = isB ? (unsigned)((((wu - 4) * 64 + 2 * lr16) * ldw + lchunk * 8) * 2)
                            : (unsigned)(((wu * 64 + lr16) * lda + lchunk * 8) * 2);
  const unsigned st1 = isB ? (unsigned)(32 * ldw * 2) : (unsigned)(16 * lda * 2);
  const unsigned st2 = isB ? (unsigned)(1 * ldw * 2) : (unsigned)(32 * lda * 2);
#define WAIT_V(n) asm volatile("s_waitcnt vmcnt(" #n ")" ::: "memory")
#define RAWBAR() do { asm volatile("s_waitcnt lgkmcnt(0)" ::: "memory"); __builtin_amdgcn_s_barrier(); asm volatile("" ::: "memory"); } while (0)
#define BAR0() do { asm volatile("" ::: "memory"); __builtin_amdgcn_s_barrier(); asm volatile("" ::: "memory"); } while (0)
#define H_DMA(slotp) do { const char* gsrc_ = (isB ? bp : ap) + goff; unsigned char* ld_ = (slotp) + wu * 4096;            \
    __builtin_amdgcn_global_load_lds((const unsigned*)(gsrc_), (unsigned*)(ld_), 16, 0, 0);                                  \
    __builtin_amdgcn_global_load_lds((const unsigned*)(gsrc_ + st1), (unsigned*)(ld_ + 1024), 16, 0, 0);                     \
    __builtin_amdgcn_global_load_lds((const unsigned*)(gsrc_ + st2), (unsigned*)(ld_ + 2048), 16, 0, 0);                     \
    __builtin_amdgcn_global_load_lds((const unsigned*)(gsrc_ + st2 + st1), (unsigned*)(ld_ + 3072), 16, 0, 0); } while (0)
#define H_READ(sl) do { _Pragma("unroll") for (int mi = 0; mi < 4; ++mi) {                                                   \
      fa[0][mi] = *(const bf16x8*)((sl) + aoff + mi * 2048 + c0); fa[1][mi] = *(const bf16x8*)((sl) + aoff + mi * 2048 + c1); } \
    fb[0][0] = *(const bf16x8*)((sl) + boff + c0); fb[1][0] = *(const bf16x8*)((sl) + boff + c1);                            \
    fb[0][1] = *(const bf16x8*)((sl) + boff + 2048 + c0); fb[1][1] = *(const bf16x8*)((sl) + boff + 2048 + c1); } while (0)
#define H_MMA() do { _Pragma("unroll") for (int ks = 0; ks < 2; ++ks) { _Pragma("unroll") for (int mi = 0; mi < 4; ++mi) {  \
      acc[mi][0] = MFMA(fa[ks][mi], fb[ks][0], acc[mi][0]);                                                       \
      acc[mi][1] = MFMA(fa[ks][mi], fb[ks][1], acc[mi][1]); } } } while (0)
  const char *ap, *bp;
  {
    const u16 *ta, *tb;
    int it0 = 0;
    asm volatile("" : "+s"(it0));
    if (!ptrs(it0, ta, tb)) return;
    ap = (const char*)ta; bp = (const char*)tb;
  }
  H_DMA(sbase); ap += 64; bp += 64;
  H_DMA(sbase + SLOT); ap += 64; bp += 64;
  for (int it = 0;; ++it) {
    f32x16 acc[4][2];
#pragma unroll
    for (int a = 0; a < 4; ++a)
#pragma unroll
      for (int b = 0; b < 2; ++b) zero16(acc[a][b]);
    H_DMA(sbase + 2 * SLOT); ap += 64; bp += 64;
    WAIT_V(4);
    BAR0();
    if (wm == 1) BAR0();
    int rs = 0;
#pragma unroll 1
    for (int hh = 0; hh < nh; ++hh) {
      bf16x8 fa[2][4], fb[2][2];
      const int rem = nh - 2 - hh;
      H_READ(sbase + rs * SLOT);
      if (hh + 3 < nh) { H_DMA(sbase + ((rs + 3) & 3) * SLOT); ap += 64; bp += 64; }
      if (wm == 1) {
        if (rem >= 2) WAIT_V(8); else if (rem == 1) WAIT_V(4); else WAIT_V(0);
      }
      __builtin_amdgcn_sched_barrier(0);
      RAWBAR();
      __builtin_amdgcn_sched_barrier(0);
      H_MMA();
      __builtin_amdgcn_sched_barrier(0);
      if (wm == 0) {
        if (rem >= 2) WAIT_V(8); else if (rem == 1) WAIT_V(4); else WAIT_V(0);
      }
      BAR0();
      rs = (rs + 1) & 3;
    }
    if (wm == 0) BAR0();
    bool more;
    {
      const u16 *ta, *tb;
      more = ptrs(it + 1, ta, tb);
      if (more) {
        ap = (const char*)ta; bp = (const char*)tb;
        H_DMA(sbase); ap += 64; bp += 64;
        H_DMA(sbase + SLOT); ap += 64; bp += 64;
      }
    }
    epi(it, acc);
    if (!more) break;
  }
#undef WAIT_V
#undef RAWBAR
#undef BAR0
#undef H_DMA
#undef H_READ
#undef H_MMA
}

DI int map_row(int maptype, int s) {
  if (maptype == 1) return s < 3072 ? s : (s < 3080 ? -1 : s - 8);
  if (maptype == 2) return s < 2816 ? 2 * s : 2 * (s - 2816) + 1;
  return s;
}
DI void transpose_task(const float* __restrict__ src, int Nsrc, u16* __restrict__ dst, int dld, int maptype, int kt2, int nt,
                       unsigned char* smem) {
  float* tile = (float*)(smem + 64);
  const int tid = otid();
  const int k0 = kt2 * 128, s0 = nt * 64;
  float4 v[4];
#pragma unroll
  for (int i = 0; i < 4; ++i) {
    const int kr = (tid >> 4) + 32 * i, nc = (tid & 15) * 4;
    v[i] = make_float4(0.f, 0.f, 0.f, 0.f);
    if (s0 + nc < Nsrc) v[i] = *(const float4*)(src + (size_t)(k0 + kr) * Nsrc + s0 + nc);
  }
#pragma unroll
  for (int i = 0; i < 4; ++i) {
    const int kr = (tid >> 4) + 32 * i, nc = (tid & 15) * 4;
    tile[kr * 65 + nc + 0] = v[i].x; tile[kr * 65 + nc + 1] = v[i].y; tile[kr * 65 + nc + 2] = v[i].z; tile[kr * 65 + nc + 3] = v[i].w;
  }
  __syncthreads();
  {
    const int n = tid >> 3;
    const int s = s0 + n;
    const int dr = (s < Nsrc) ? map_row(maptype, s) : -1;
    if (dr >= 0) {
#pragma unroll
      for (int j = 0; j < 2; ++j) {
        const int kc = (tid & 7) * 8 + 64 * j;
        uint4 o;
        o.x = pack2(tile[(kc + 0) * 65 + n], tile[(kc + 1) * 65 + n]);
        o.y = pack2(tile[(kc + 2) * 65 + n], tile[(kc + 3) * 65 + n]);
        o.z = pack2(tile[(kc + 4) * 65 + n], tile[(kc + 5) * 65 + n]);
        o.w = pack2(tile[(kc + 6) * 65 + n], tile[(kc + 7) * 65 + n]);
        *(uint4*)(dst + (size_t)dr * dld + k0 + kc) = o;
      }
    }
  }
  __syncthreads();
}

DI void adaln_task(const Params& p, int task, unsigned char* smem) {
  const int bhalf = task & 1, cg_ = (task >> 1) % 96, l = (task >> 1) / 96;
  float* cs = (float*)(smem + 64);
  float* red = (float*)(smem + 64 + 20 * 1024 * 4);
  const int tid = otid();
  const float* cp = p.in[2]; const float* csm = p.in[3];
  for (int idx = tid; idx < 20 * 1024; idx += NTHR) {
    const int bb = idx >> 10, d = idx & 1023, b = bhalf * 20 + bb;
    const float c = b < 32 ? cp[b * 1024 + d] : csm[(b - 32) * 1024 + d];
    cs[idx] = siluf_(c);
  }
  __syncthreads();
  const int dseg = tid >> 6, e = cg_ * 64 + (tid & 63);
  const float* wp = p.in[10] + ((size_t)l * 1024 + dseg * 128) * 6144 + e;
  float acc[20];
#pragma unroll
  for (int i = 0; i < 20; ++i) acc[i] = 0.f;
  for (int d = 0; d < 128; ++d) {
    const float wv = wp[(size_t)d * 6144];
    const float* c0 = cs + dseg * 128 + d;
#pragma unroll
    for (int i = 0; i < 20; ++i) acc[i] += c0[i * 1024] * wv;
  }
#pragma unroll
  for (int i = 0; i < 20; ++i) red[(dseg * 20 + i) * 64 + (tid & 63)] = acc[i];
  __syncthreads();
  float* mod = (float*)(p.ws + WS_MOD);
  for (int idx = tid; idx < 20 * 64; idx += NTHR) {
    const int bb = idx >> 6, ec = idx & 63;
    float s = 0.f;
#pragma unroll
    for (int q = 0; q < 8; ++q) s += red[(q * 20 + bb) * 64 + ec];
    const int ee = cg_ * 64 + ec;
    mod[((size_t)l * 40 + bhalf * 20 + bb) * 6144 + ee] = s + p.in[11][l * 6144 + ee];
  }
  __syncthreads();
}

DI void prologue(const Params& p, unsigned char* smem) {
  const int WT_TASKS_L = 456 + 256 + 64 + 64 + 128 + 704 + 352;
  const int N_WT = 2 * WT_TASKS_L;
  const int N_ADA = 384, N_CK = 512, N_CV = 1024;
  const int total = N_WT + N_ADA + N_CK + N_CV;
  for (int task = blockIdx.x; task < total; task += gridDim.x) {
    if (task < N_WT) {
      const int l = task / WT_TASKS_L; int t = task % WT_TASKS_L;
      if (t < 456) { transpose_task(p.in[12] + (size_t)l * 1024 * 3592, 3592, (u16*)(p.ws + WS_WT_IN) + (size_t)l * 3584 * 1024, 1024, 1, t / 57, t % 57, smem); continue; }
      t -= 456;
      if (t < 256) { transpose_task(p.in[21] + (size_t)l * 1024 * 2048, 2048, (u16*)(p.ws + WS_WT_GATE) + (size_t)l * 2048 * 1024, 1024, 0, t / 32, t % 32, smem); continue; }
      t -= 256;
      if (t < 64) { transpose_task(p.in[19] + (size_t)l * 512 * 1024, 1024, (u16*)(p.ws + WS_WT_BRA) + (size_t)l * 1024 * 512, 512, 0, t / 16, t % 16, smem); continue; }
      t -= 64;
      if (t < 64) { transpose_task(p.in[20] + (size_t)l * 512 * 1024, 1024, (u16*)(p.ws + WS_WT_BRB) + (size_t)l * 1024 * 512, 512, 0, t / 16, t % 16, smem); continue; }
      t -= 64;
      if (t < 128) { transpose_task(p.in[23] + (size_t)l * 1024 * 1024, 1024, (u16*)(p.ws + WS_WT_O) + (size_t)l * 1024 * 1024, 1024, 0, t / 16, t % 16, smem); continue; }
      t -= 128;
      if (t < 704) { transpose_task(p.in[26] + (size_t)l * 1024 * 5632, 5632, (u16*)(p.ws + WS_WT_GU) + (size_t)l * 5632 * 1024, 1024, 2, t / 88, t % 88, smem); continue; }
      t -= 704;
      transpose_task(p.in[27] + (size_t)l * 2816 * 1024, 1024, (u16*)(p.ws + WS_WT_DOWN) + (size_t)l * 1024 * 2816, 2816, 0, t / 16, t % 16, smem);
    } else if (task < N_WT + N_ADA) {
      adaln_task(p, task - N_WT, smem);
    } else if (task < N_WT + N_ADA + N_CK) {
      const int t = task - N_WT - N_ADA;
      const float4* src = (const float4*)p.in[4];
      u16* dst = (u16*)(p.ws + WS_KS);
#pragma unroll
      for (int i = 0; i < 8; ++i) {
        const size_t f4 = (size_t)t * 4096 + i * 512 + otid();
        const float4 v = src[f4];
        const size_t e = f4 * 4;
        const size_t lb = e / (1024 * 512), rem = e % (1024 * 512);
        uint2 o; o.x = pack2(v.x, v.y); o.y = pack2(v.z, v.w);
        *(uint2*)(dst + lb * (1056 * 512) + rem) = o;
      }
    } else {
      const int t = task - N_WT - N_ADA - N_CK;
      const int lb = t >> 6, tt = t & 63;
      transpose_task(p.in[5] + (size_t)lb * 1024 * 512, 512, (u16*)(p.ws + WS_VTS) + (size_t)lb * 512 * 1056, 1056, 0, tt >> 3, tt & 7, smem);
    }
  }
}

DI float wave_sum(float v, int lane) {
  (void)lane;
  int x = __float_as_int(v);
  v += __int_as_float(__builtin_amdgcn_update_dpp(0, x, 0xB1, 0xF, 0xF, true));
  x = __float_as_int(v);
  v += __int_as_float(__builtin_amdgcn_update_dpp(0, x, 0x4E, 0xF, 0xF, true));
  x = __float_as_int(v);
  v += __int_as_float(__builtin_amdgcn_update_dpp(0, x, 0x141, 0xF, 0xF, true));
  x = __float_as_int(v);
  v += __int_as_float(__builtin_amdgcn_update_dpp(0, x, 0x140, 0xF, 0xF, true));
  x = __float_as_int(v);
  const float r0 = __int_as_float(__builtin_amdgcn_readlane(x, 0)), r1 = __int_as_float(__builtin_amdgcn_readlane(x, 16));
  const float r2 = __int_as_float(__builtin_amdgcn_readlane(x, 32)), r3 = __int_as_float(__builtin_amdgcn_readlane(x, 48));
  return (r0 + r1) + (r2 + r3);
}
DI void ln_pass(const Params& p, int mode, int l, unsigned char* smem) {
  const int tid = otid();
  const int lane = tid & 63, w = tid >> 6;
  const bool first = mode != 0;
  const bool second = (mode != 2) || (l + 1 < 2);
  const bool gates = (mode == 0) || (mode == 2 && l + 1 < 2);
  const int lm = (mode == 2) ? l + 1 : l;
  const int shi = (mode == 1) ? 3 : 0;
  const float* lng = (mode == 1) ? p.in[24] + l * 1024 : p.in[28] + l * 1024;
  const float* lnb = (mode == 1) ? p.in[25] + l * 1024 : p.in[29] + l * 1024;
  const float* mod = (const float*)(p.ws + WS_MOD);
  u16* H = (u16*)(p.ws + WS_H);
  float* gout = (float*)(p.ws + WS_GATES);
  float* wl = (float*)(smem + 64);
  float bif[8];
  if (gates) {
    const float* wi = p.in[12] + (size_t)lm * 1024 * 3592 + 3072;
    for (int idx = tid; idx < 8192; idx += NTHR) {
      const int c = idx >> 3, j = idx & 7;
      wl[j * 1024 + c] = wi[(size_t)c * 3592 + j];
    }
#pragma unroll
    for (int j = 0; j < 8; ++j) bif[j] = p.in[13][lm * 8 + j];
  }
  __syncthreads();
  float lg[16], lb[16];
  if (first) {
#pragma unroll
    for (int i = 0; i < 4; ++i) {
      const float4 g = *(const float4*)(lng + i * 256 + lane * 4);
      const float4 b = *(const float4*)(lnb + i * 256 + lane * 4);
      lg[i * 4] = g.x; lg[i * 4 + 1] = g.y; lg[i * 4 + 2] = g.z; lg[i * 4 + 3] = g.w;
      lb[i * 4] = b.x; lb[i * 4 + 1] = b.y; lb[i * 4 + 2] = b.z; lb[i * 4 + 3] = b.w;
    }
  }
  const bool write_x = (mode == 2 && l == 1);
  float* stats = (float*)(p.ws + WS_STAT);
  auto process = [&](int row, float (&v)[16], const float (&msh)[16], const float (&msc)[16]) {
    float* xr = p.out + (size_t)row * 1024;
    if (first) {
      float s = 0.f;
#pragma unroll
      for (int i = 0; i < 16; ++i) s += v[i];
      const float mean = wave_sum(s, lane) * (1.f / 1024.f);
      float q = 0.f;
#pragma unroll
      for (int i = 0; i < 16; ++i) { v[i] -= mean; q += v[i] * v[i]; }
      const float rstd = rsqrtf(wave_sum(q, lane) * (1.f / 1024.f) + LN_EPS);
#pragma unroll
      for (int i = 0; i < 4; ++i) {
#pragma unroll
        for (int e = 0; e < 4; ++e) v[i * 4 + e] = v[i * 4 + e] * rstd * lg[i * 4 + e] + lb[i * 4 + e];
        if (write_x) *(float4*)(xr + i * 256 + lane * 4) = make_float4(v[i * 4 + 0], v[i * 4 + 1], v[i * 4 + 2], v[i * 4 + 3]);
      }
      if (!write_x && lane == 0) *(float2*)(stats + (size_t)row * 2) = make_float2(mean, rstd);
    }
    if (second) {
      float s = 0.f;
#pragma unroll
      for (int i = 0; i < 16; ++i) s += v[i];
      const float mean = wave_sum(s, lane) * (1.f / 1024.f);
      float q = 0.f;
#pragma unroll
      for (int i = 0; i < 16; ++i) { v[i] -= mean; q += v[i] * v[i]; }
      const float rstd = rsqrtf(wave_sum(q, lane) * (1.f / 1024.f) + LN_EPS);
#pragma unroll
      for (int i = 0; i < 4; ++i) {
#pragma unroll
        for (int e = 0; e < 4; ++e) v[i * 4 + e] = v[i * 4 + e] * rstd * msc[i * 4 + e] + msh[i * 4 + e];
        uint2 o; o.x = pack2(v[i * 4 + 0], v[i * 4 + 1]); o.y = pack2(v[i * 4 + 2], v[i * 4 + 3]);
        *(uint2*)(H + (size_t)row * 1024 + i * 256 + lane * 4) = o;
      }
      if (gates) {
        float g8[8];
#pragma unroll
        for (int j = 0; j < 8; ++j) {
          float s2 = 0.f;
#pragma unroll
          for (int i = 0; i < 4; ++i) {
            const float4 wv = *(const float4*)(wl + j * 1024 + i * 256 + lane * 4);
            s2 += v[i * 4] * wv.x + v[i * 4 + 1] * wv.y + v[i * 4 + 2] * wv.z + v[i * 4 + 3] * wv.w;
          }
          g8[j] = wave_sum(s2, lane) + bif[j];
        }
        if (lane == 0) {
          *(float4*)(gout + (size_t)row * 8) = make_float4(g8[0], g8[1], g8[2], g8[3]);
          *(float4*)(gout + (size_t)row * 8 + 4) = make_float4(g8[4], g8[5], g8[6], g8[7]);
        }
      }
    }
  };
  auto load_mod = [&](int row, float (&msh)[16], float (&msc)[16]) {
    const float* mb = mod + ((size_t)lm * 40 + batch_of_row(row)) * 6144;
#pragma unroll
    for (int i = 0; i < 4; ++i) {
      const float4 sh = *(const float4*)(mb + shi * 1024 + i * 256 + lane * 4);
      const float4 sc = *(const float4*)(mb + (shi + 1) * 1024 + i * 256 + lane * 4);
      msh[i * 4] = sh.x; msh[i * 4 + 1] = sh.y; msh[i * 4 + 2] = sh.z; msh[i * 4 + 3] = sh.w;
      msc[i * 4] = 1.f + sc.x; msc[i * 4 + 1] = 1.f + sc.y; msc[i * 4 + 2] = 1.f + sc.z; msc[i * 4 + 3] = 1.f + sc.w;
    }
  };
  for (int chunk = blockIdx.x * 8 + w; chunk < TOKP / 32; chunk += gridDim.x * 8) {
    const int row0 = chunk * 32;
    float msh[16], msc[16];
    if (second) load_mod(row0, msh, msc);
    const float* src0 = (mode == 0) ? p.in[0] + (size_t)row0 * 1024 : p.out + (size_t)row0 * 1024;
    float4 nx0 = *(const float4*)(src0 + lane * 4), nx1 = *(const float4*)(src0 + 256 + lane * 4);
    float4 nx2 = *(const float4*)(src0 + 512 + lane * 4), nx3 = *(const float4*)(src0 + 768 + lane * 4);
    for (int ri = 0; ri < 32; ++ri) {
      float v[16];
      v[0] = nx0.x; v[1] = nx0.y; v[2] = nx0.z; v[3] = nx0.w; v[4] = nx1.x; v[5] = nx1.y; v[6] = nx1.z; v[7] = nx1.w;
      v[8] = nx2.x; v[9] = nx2.y; v[10] = nx2.z; v[11] = nx2.w; v[12] = nx3.x; v[13] = nx3.y; v[14] = nx3.z; v[15] = nx3.w;
      {
        const float* sn = src0 + (size_t)(ri < 31 ? ri + 1 : 31) * 1024;
        nx0 = *(const float4*)(sn + lane * 4); nx1 = *(const float4*)(sn + 256 + lane * 4);
        nx2 = *(const float4*)(sn + 512 + lane * 4); nx3 = *(const float4*)(sn + 768 + lane * 4);
      }
      __builtin_amdgcn_sched_barrier(0);
      process(row0 + ri, v, msh, msc);
    }
  }
  if (w == 0) {
    for (int row = TOKP + blockIdx.x; row < TOK; row += gridDim.x) {
      float msh[16], msc[16];
      if (second) load_mod(row, msh, msc);
      const float* src = (mode == 0) ? p.in[1] + (size_t)(row - TOKP) * 1024 : p.out + (size_t)row * 1024;
      float v[16];
#pragma unroll
      for (int i = 0; i < 4; ++i) {
        const float4 t = *(const float4*)(src + i * 256 + lane * 4);
        v[i * 4 + 0] = t.x; v[i * 4 + 1] = t.y; v[i * 4 + 2] = t.z; v[i * 4 + 3] = t.w;
      }
      process(row, v, msh, msc);
    }
  }
}


DI void micro_partial(f32x16& acc, const u16* A, int lda, const u16* Wt, int ldw, int K, int row0, int n0, int w, int r, int h) {
  const int kb = w * (K >> 3), n16 = K >> 7;
  const u16* ap = A + (size_t)(row0 + r) * lda + kb + h * 8;
  const u16* bp = Wt + (size_t)(n0 + r) * ldw + kb + h * 8;
#pragma unroll 4
  for (int k = 0; k < n16; ++k) {
    const bf16x8 a = *(const bf16x8*)(ap + k * 16);
    const bf16x8 b = *(const bf16x8*)(bp + k * 16);
    acc = MFMA(a, b, acc);
  }
}
DI void micro_reduce_store(const f32x16& acc, float* red, int w, int lane) {
#pragma unroll
  for (int i = 0; i < 16; ++i) red[(w * 16 + i) * 64 + lane] = acc[i];
}
DI float micro_sum(const float* red, int i, int lane) {
  float s = 0.f;
#pragma unroll
  for (int q = 0; q < 8; ++q) s += red[(q * 16 + i) * 64 + lane];
  return s;
}

constexpr int EP_LD = 264;
constexpr int EP_LDT = 68;
DI void zero_acc(f32x16 (&acc)[4][2]) {
#pragma unroll
  for (int a = 0; a < 4; ++a)
#pragma unroll
    for (int b = 0; b < 2; ++b) zero16(acc[a][b]);
}
DI void stage_rm(const f32x16& a0, const f32x16& a1, float* stg, int wm, int wn, int r, int h) {
#pragma unroll
  for (int i = 0; i < 16; ++i) *(float2*)(stg + (wm * 32 + crow(i, h)) * EP_LD + wn * 64 + 2 * r) = make_float2(a0[i], a1[i]);
}
DI void stage_tr(const f32x16& a0, const f32x16& a1, float* stg, int wm, int wn, int r, int h) {
#pragma unroll
  for (int g = 0; g < 4; ++g) {
    *(float4*)(stg + (wn * 64 + 2 * r) * EP_LDT + wm * 32 + 8 * g + 4 * h) = make_float4(a0[4 * g], a0[4 * g + 1], a0[4 * g + 2], a0[4 * g + 3]);
    *(float4*)(stg + (wn * 64 + 2 * r + 1) * EP_LDT + wm * 32 + 8 * g + 4 * h) = make_float4(a1[4 * g], a1[4 * g + 1], a1[4 * g + 2], a1[4 * g + 3]);
  }
}
DI int grow_of(int m0, int mi, int lr) { return m0 + (lr >> 5) * 128 + mi * 32 + (lr & 31); }
DI uint4 pack8f(const float4& a, const float4& b) {
  uint4 o; o.x = pack2(a.x, a.y); o.y = pack2(a.z, a.w); o.z = pack2(b.x, b.y); o.w = pack2(b.z, b.w); return o;
}

DI void write_tr(const Params& p, int l, int m0, int mi, const float* stg, int tid, int which, int chbase) {
  const bool prompt = m0 < TOKP;
#pragma unroll 1
  for (int q = 0; q < 4; ++q) {
    const int cid = q * NTHR + tid, ch = cid >> 3, tc = cid & 7;
    const float4 v0 = *(const float4*)(stg + ch * EP_LDT + tc * 8);
    const float4 v1 = *(const float4*)(stg + ch * EP_LDT + tc * 8 + 4);
    const int row0 = grow_of(m0, mi, tc * 8);
    const int chg = chbase + ch;
    u16* d;
    if (prompt) {
      const int b = row0 >> 11, t = row0 & 2047;
      if (which == 0) d = (u16*)(p.ws + WS_VTP) + ((size_t)b * 512 + chg) * 2048 + t;
      else if (which == 1) d = (u16*)(p.ws + WS_MQKT_P) + ((size_t)b * 1024 + chg) * 2048 + t;
      else d = (u16*)(p.ws + WS_MVT_P) + ((size_t)b * 512 + chg) * 2048 + t;
    } else {
      const int rs = row0 - TOKP, bs = rs >> 5, t = rs & 31;
      if (which == 0) d = (u16*)(p.ws + WS_VTS) + ((size_t)(l * 8 + bs) * 512 + chg) * 1056 + 1024 + t;
      else if (which == 1) d = (u16*)(p.ws + WS_MQKT_S) + ((size_t)bs * 1024 + chg) * 32 + t;
      else d = (u16*)(p.ws + WS_MVT_S) + ((size_t)bs * 512 + chg) * 32 + t;
    }
    *(uint4*)d = pack8f(v0, v1);
  }
}

DI void epi_in(const Params& p, int l, int m0, int n0, f32x16 (&acc)[4][2], unsigned char* smem) {
  const int tid = otid(), lane = tid & 63, w = tid >> 6;
  const int wm = w >> 2, wn = w & 3, r = lane & 31, h = lane >> 5;
  const bool prompt = m0 < TOKP;
  float* stg = (float*)(smem + GS_BASE + GS_STAGE);
  const int seg = n0 < 512 ? 0 : (n0 < 1024 ? 1 : (n0 < 1536 ? 2 : (n0 < 2560 ? 3 : (n0 < 3072 ? 4 : 5))));
  if (seg == 3) {
    const int ch = n0 - 1536 + wn * 64 + 2 * r;
#pragma unroll
    for (int mi = 0; mi < 4; ++mi) {
      const int rb = m0 + wm * 128 + mi * 32 + 4 * h;
#pragma unroll
      for (int i = 0; i < 16; ++i) {
        const int row = rb + (i & 3) + 8 * (i >> 2);
        if (prompt) {
          const int tt = row & 2047;
          if (tt >= 2045) *(float2*)(p.out + O_CVP + ((size_t)(l * 32 + (row >> 11)) * 3 + (tt - 2045)) * 1024 + ch) = make_float2(acc[mi][0][i], acc[mi][1][i]);
        } else {
          const int rs = row - TOKP, tt = rs & 31;
          if (tt >= 29) *(float2*)(p.out + O_CVS + ((size_t)(l * 8 + (rs >> 5)) * 3 + (tt - 29)) * 1024 + ch) = make_float2(acc[mi][0][i], acc[mi][1][i]);
        }
      }
    }
  }
#pragma unroll
  for (int mi = 0; mi < 4; ++mi) {
    if (seg == 0 || seg == 1 || seg == 2 || seg == 5) {
      __syncthreads();
      stage_rm(acc[mi][0], acc[mi][1], stg, wm, wn, r, h);
      __syncthreads();
#pragma unroll 1
      for (int q = 0; q < 4; ++q) {
        const int cid = q * NTHR + tid, lr = cid >> 5, c8 = (cid & 31) * 8;
        const float4 v0 = *(const float4*)(stg + lr * EP_LD + c8);
        const float4 v1 = *(const float4*)(stg + lr * EP_LD + c8 + 4);
        const int row = grow_of(m0, mi, lr);
        const int n = n0 + c8;
        if (seg == 0) {
          *(uint4*)((u16*)(p.ws + WS_ZQ) + (size_t)row * 512 + n) = pack8f(v0, v1);
        } else if (seg == 5) {
          const float4 s0 = make_float4(sigmoidf_(v0.x), sigmoidf_(v0.y), sigmoidf_(v0.z), sigmoidf_(v0.w));
          const float4 s1 = make_float4(sigmoidf_(v1.x), sigmoidf_(v1.y), sigmoidf_(v1.z), sigmoidf_(v1.w));
          *(uint4*)((u16*)(p.ws + WS_MO) + (size_t)row * 512 + (n - 3072)) = pack8f(s0, s1);
        } else {
          const bool isk = seg == 1;
          const int nn = n - (isk ? 512 : 1024);
          float* of = p.out + (isk ? (prompt ? O_KP : O_KSM) : (prompt ? O_VP : O_VSM));
          const size_t orow = prompt ? ((size_t)l * TOKP + row) : ((size_t)l * TOKS + (row - TOKP));
          *(float4*)(of + orow * 512 + nn) = v0;
          *(float4*)(of + orow * 512 + nn + 4) = v1;
          if (isk) {
            u16* kd;
            if (prompt) kd = (u16*)(p.ws + WS_KB) + (size_t)row * 512 + nn;
            else { const int rs = row - TOKP; kd = (u16*)(p.ws + WS_KS) + ((size_t)(l * 8 + (rs >> 5)) * 1056 + 1024 + (rs & 31)) * 512 + nn; }
            *(uint4*)kd = pack8f(v0, v1);
          }
        }
      }
    }
    if (seg == 2 || seg == 3 || seg == 4) {
      __syncthreads();
      stage_tr(acc[mi][0], acc[mi][1], stg, wm, wn, r, h);
      __syncthreads();
      write_tr(p, l, m0, mi, stg, tid, seg == 2 ? 0 : (seg == 3 ? 1 : 2), n0 - (seg == 2 ? 1024 : (seg == 3 ? 1536 : 2560)));
    }
  }
  __syncthreads();
}

DI void phase_in_gate(const Params& p, int l, unsigned char* smem) {
  const int tid = otid(), lane = tid & 63, w = tid >> 6;
  const int wm = w >> 2, wn = w & 3, r = lane & 31, h = lane >> 5;
  const u16* H = (const u16*)(p.ws + WS_H);
  const u16* Win = (const u16*)(p.ws + WS_WT_IN) + (size_t)l * 3584 * 1024;
  const u16* Wg = (const u16*)(p.ws + WS_WT_GATE) + (size_t)l * 2048 * 1024;
  float* stg = (float*)(smem + GS_BASE + GS_STAGE);
  const int NT = 14 + 8, MT = 257;
  auto ptrs = [&](int it, const u16*& ap, const u16*& bp) -> bool {
    int mt, nt;
    if (!tile_of(it, MT, NT, mt, nt)) return false;
    ap = H + (size_t)(mt * 256) * 1024;
    bp = (nt < 14 ? Win + (size_t)(nt * 256) * 1024 : Wg + (size_t)((nt - 14) * 256) * 1024);
    return true;
  };
  auto epi = [&](int it, f32x16 (&acc)[4][2]) {
    const int tid = otid(), lane = tid & 63, w = tid >> 6;
    const int wm = w >> 2, wn = w & 3, r = lane & 31, h = lane >> 5;
    int mt, nt;
    tile_of(it, MT, NT, mt, nt);
    const int m0 = mt * 256;
    if (nt < 14) {
      epi_in(p, l, m0, nt * 256, acc, smem);
    } else {
      const int n0 = (nt - 14) * 256;
      u16* G = (u16*)(p.ws + WS_G);
#pragma unroll
      for (int mi = 0; mi < 4; ++mi) {
        __syncthreads();
        stage_rm(acc[mi][0], acc[mi][1], stg, wm, wn, r, h);
        __syncthreads();
#pragma unroll 1
        for (int q = 0; q < 4; ++q) {
          const int cid = q * NTHR + tid, lr = cid >> 5, c8 = (cid & 31) * 8;
          float4 v0 = *(const float4*)(stg + lr * EP_LD + c8);
          float4 v1 = *(const float4*)(stg + lr * EP_LD + c8 + 4);
          const int row = grow_of(m0, mi, lr), n = n0 + c8;
          const float4 b0 = *(const float4*)(p.in[22] + l * 2048 + n);
          const float4 b1 = *(const float4*)(p.in[22] + l * 2048 + n + 4);
          v0 = make_float4(sigmoidf_(v0.x + b0.x), sigmoidf_(v0.y + b0.y), sigmoidf_(v0.z + b0.z), sigmoidf_(v0.w + b0.w));
          v1 = make_float4(sigmoidf_(v1.x + b1.x), sigmoidf_(v1.y + b1.y), sigmoidf_(v1.z + b1.z), sigmoidf_(v1.w + b1.w));
          *(uint4*)(G + (size_t)row * 2048 + n) = pack8f(v0, v1);
        }
      }
      __syncthreads();
    }
  };
  gemm_stream(1024, 1024, 1024, smem, ptrs, epi);
}

DI void phase_mix(const Params& p, int l, unsigned char* smem) {
  const int tid = otid(), lane = tid & 63, w = tid >> 6;
  const int wm = w >> 2, wn = w & 3, r = lane & 31, h = lane >> 5;
  const u16* G = (const u16*)(p.ws + WS_G);
  u16* MIX = (u16*)(p.ws + WS_MIX);
  float* stg = (float*)(smem + GS_BASE + GS_STAGE);
  const int NT = 4, MT = 256;
  auto ptrs = [&](int it, const u16*& ap, const u16*& bp) -> bool {
    int mt, nt;
    if (!tile_of(it >> 1, MT, NT, mt, nt)) return false;
    const int half = it & 1;
    ap = (const u16*)(p.ws + (half ? WS_MN : WS_AN)) + (size_t)(mt * 256) * 512;
    bp = (const u16*)(p.ws + (half ? WS_WT_BRB : WS_WT_BRA)) + (size_t)l * 1024 * 512 + (size_t)(nt * 256) * 512;
    return true;
  };
  auto epi = [&](int it, f32x16 (&acc)[4][2]) {
    const int tid = otid(), lane = tid & 63, w = tid >> 6;
    const int wm = w >> 2, wn = w & 3, r = lane & 31, h = lane >> 5;
    int mt, nt;
    tile_of(it >> 1, MT, NT, mt, nt);
    const int half = it & 1;
    const int m0 = mt * 256, n0 = nt * 256;
#pragma unroll
    for (int mi = 0; mi < 4; ++mi) {
      __syncthreads();
      stage_rm(acc[mi][0], acc[mi][1], stg, wm, wn, r, h);
      __syncthreads();
#pragma unroll 1
      for (int q = 0; q < 4; ++q) {
        const int cid = q * NTHR + tid, lr = cid >> 5, c8 = (cid & 31) * 8;
        const float4 v0 = *(const float4*)(stg + lr * EP_LD + c8);
        const float4 v1 = *(const float4*)(stg + lr * EP_LD + c8 + 4);
        const int row = grow_of(m0, mi, lr), n = n0 + c8;
        const uint4 g = *(const uint4*)(G + (size_t)row * 2048 + half * 1024 + n);
        float4 o0 = make_float4(bflo(g.x) * v0.x, bfhi(g.x) * v0.y, bflo(g.y) * v0.z, bfhi(g.y) * v0.w);
        float4 o1 = make_float4(bflo(g.z) * v1.x, bfhi(g.z) * v1.y, bflo(g.w) * v1.z, bfhi(g.w) * v1.w);
        uint4* mp = (uint4*)(MIX + (size_t)row * 1024 + n);
        if (half) {
          const uint4 pr = *mp;
          o0.x += bflo(pr.x); o0.y += bfhi(pr.x); o0.z += bflo(pr.y); o0.w += bfhi(pr.y);
          o1.x += bflo(pr.z); o1.y += bfhi(pr.z); o1.z += bflo(pr.w); o1.w += bfhi(pr.w);
        }
        *mp = pack8f(o0, o1);
      }
    }
    __syncthreads();
  };
  gemm_stream(512, 512, 512, smem, ptrs, epi);
  {
    const int tid2 = otid(), lane = tid2 & 63, w = tid2 >> 6, r = lane & 31, h = lane >> 5;
    float* red = (float*)(smem + 64);
    for (int mtile = blockIdx.x; mtile < 256; mtile += gridDim.x) {
      const int row0 = TOKP + (mtile >> 5) * 32, n0 = (mtile & 31) * 32;
      f32x16 pa, pb;
      zero16(pa); zero16(pb);
      micro_partial(pa, (const u16*)(p.ws + WS_AN), 512, (const u16*)(p.ws + WS_WT_BRA) + (size_t)l * 1024 * 512, 512, 512, row0, n0, w, r, h);
      micro_partial(pb, (const u16*)(p.ws + WS_MN), 512, (const u16*)(p.ws + WS_WT_BRB) + (size_t)l * 1024 * 512, 512, 512, row0, n0, w, r, h);
      __syncthreads();
      micro_reduce_store(pa, red, w, lane);
      micro_reduce_store(pb, red + 8192, w, lane);
      __syncthreads();
#pragma unroll
      for (int q = 0; q < 2; ++q) {
        const int i = w + 8 * q;
        const float sa = micro_sum(red, i, lane), sb = micro_sum(red + 8192, i, lane);
        const int row = row0 + crow(i, h), n = n0 + r;
        const float ga = bf2f(G[(size_t)row * 2048 + n]), gb = bf2f(G[(size_t)row * 2048 + 1024 + n]);
        MIX[(size_t)row * 1024 + n] = f2bf(ga * sa + gb * sb);
      }
    }
    __syncthreads();
  }
}

DI void phase_res(const Params& p, int l, int mode, unsigned char* smem) {
  const int tid = otid(), lane = tid & 63, w = tid >> 6;
  const int wm = w >> 2, wn = w & 3, r = lane & 31, h = lane >> 5;
  const float* mod = (const float*)(p.ws + WS_MOD);
  float* stg = (float*)(smem + GS_BASE + GS_STAGE);
  const int NT = 4, MT = 256;
  const int K = (mode == 0) ? 1024 : 2816;
  const u16* Ab = (const u16*)(p.ws + (mode == 0 ? WS_MIX : WS_ACT));
  const u16* Wb = (mode == 0) ? (const u16*)(p.ws + WS_WT_O) + (size_t)l * 1024 * 1024 : (const u16*)(p.ws + WS_WT_DOWN) + (size_t)l * 1024 * 2816;
  const int gi = (mode == 0) ? 2 : 5;
  const float* stats = (const float*)(p.ws + WS_STAT);
  const float* rlg = (mode == 1) ? p.in[24] + l * 1024 : p.in[28] + (l > 0 ? l - 1 : 0) * 1024;
  const float* rlb = (mode == 1) ? p.in[25] + l * 1024 : p.in[29] + (l > 0 ? l - 1 : 0) * 1024;
  auto ptrs = [&](int it, const u16*& ap, const u16*& bp) -> bool {
    int mt, nt;
    if (!tile_of(it, MT, NT, mt, nt)) return false;
    ap = Ab + (size_t)(mt * 256) * K;
    bp = Wb + (size_t)(nt * 256) * K;
    return true;
  };
  auto epi = [&](int it, f32x16 (&acc)[4][2]) {
    const int tid = otid(), lane = tid & 63, w = tid >> 6;
    const int wm = w >> 2, wn = w & 3, r = lane & 31, h = lane >> 5;
    int mt, nt;
    tile_of(it, MT, NT, mt, nt);
    const int m0 = mt * 256, n0 = nt * 256;
#pragma unroll
    for (int mi = 0; mi < 4; ++mi) {
      __syncthreads();
      stage_rm(acc[mi][0], acc[mi][1], stg, wm, wn, r, h);
      __syncthreads();
#pragma unroll 1
      for (int q = 0; q < 8; ++q) {
        const int cid = q * NTHR + tid, lr = cid >> 6, c4 = (cid & 63) * 4;
        const float4 v = *(const float4*)(stg + lr * EP_LD + c4);
        const int row = grow_of(m0, mi, lr), n = n0 + c4;
        const int b = batch_of_row(row);
        const float4 gg = *(const float4*)(mod + ((size_t)l * 40 + b) * 6144 + gi * 1024 + n);
        float* xr = p.out + (size_t)row * 1024 + n;
        const float* xs = (mode == 0 && l == 0) ? (row < TOKP ? p.in[0] + (size_t)row * 1024 + n : p.in[1] + (size_t)(row - TOKP) * 1024 + n) : xr;
        float4 xv = *(const float4*)xs;
        if (!(mode == 0 && l == 0)) {
          const float2 st = *(const float2*)(stats + (size_t)row * 2);
          const float4 g4 = *(const float4*)(rlg + n), b4 = *(const float4*)(rlb + n);
          xv.x = (xv.x - st.x) * st.y * g4.x + b4.x; xv.y = (xv.y - st.x) * st.y * g4.y + b4.y;
          xv.z = (xv.z - st.x) * st.y * g4.z + b4.z; xv.w = (xv.w - st.x) * st.y * g4.w + b4.w;
        }
        *(float4*)xr = make_float4(ALPHA * xv.x + (1.f + gg.x) * v.x, ALPHA * xv.y + (1.f + gg.y) * v.y,
                                   ALPHA * xv.z + (1.f + gg.z) * v.z, ALPHA * xv.w + (1.f + gg.w) * v.w);
      }
    }
    __syncthreads();
  };
  gemm_stream(K, K, K, smem, ptrs, epi);
  {
    const int tid2 = otid(), lane = tid2 & 63, w = tid2 >> 6, r = lane & 31, h = lane >> 5;
    float* red = (float*)(smem + 64);
    for (int mtile = blockIdx.x; mtile < 256; mtile += gridDim.x) {
      const int row0 = TOKP + (mtile >> 5) * 32, n0 = (mtile & 31) * 32;
      f32x16 pa;
      zero16(pa);
      micro_partial(pa, Ab, K, Wb, K, K, row0, n0, w, r, h);
      __syncthreads();
      micro_reduce_store(pa, red, w, lane);
      __syncthreads();
#pragma unroll
      for (int q = 0; q < 2; ++q) {
        const int i = w + 8 * q;
        const float sa = micro_sum(red, i, lane);
        const int row = row0 + crow(i, h), n = n0 + r;
        const float gg = mod[((size_t)l * 40 + batch_of_row(row)) * 6144 + gi * 1024 + n];
        float* xr = p.out + (size_t)row * 1024 + n;
        float xv = (mode == 0 && l == 0) ? p.in[1][(size_t)(row - TOKP) * 1024 + n] : *xr;
        if (!(mode == 0 && l == 0)) {
          const float2 st = *(const float2*)(stats + (size_t)row * 2);
          xv = (xv - st.x) * st.y * rlg[n] + rlb[n];
        }
        *xr = ALPHA * xv + (1.f + gg) * sa;
      }
    }
    __syncthreads();
  }
}

DI void phase_gu(const Params& p, int l, unsigned char* smem) {
  const int tid = otid(), lane = tid & 63, w = tid >> 6;
  const int wm = w >> 2, wn = w & 3, r = lane & 31, h = lane >> 5;
  u16* ACT = (u16*)(p.ws + WS_ACT);
  const u16* Hh = (const u16*)(p.ws + WS_H);
  const u16* Wb = (const u16*)(p.ws + WS_WT_GU) + (size_t)l * 5632 * 1024;
  float* stg = (float*)(smem + GS_BASE + GS_STAGE);
  const int NT = 22, MT = 257;
  auto ptrs = [&](int it, const u16*& ap, const u16*& bp) -> bool {
    int mt, nt;
    if (!tile_of(it, MT, NT, mt, nt)) return false;
    ap = Hh + (size_t)(mt * 256) * 1024;
    bp = Wb + (size_t)(nt * 256) * 1024;
    return true;
  };
  auto epi = [&](int it, f32x16 (&acc)[4][2]) {
    const int tid = otid(), lane = tid & 63, w = tid >> 6;
    const int wm = w >> 2, wn = w & 3, r = lane & 31, h = lane >> 5;
    int mt, nt;
    tile_of(it, MT, NT, mt, nt);
    const int m0 = mt * 256, n0 = nt * 256;
#pragma unroll
    for (int mi = 0; mi < 4; ++mi) {
      __syncthreads();
      stage_rm(acc[mi][0], acc[mi][1], stg, wm, wn, r, h);
      __syncthreads();
#pragma unroll 1
      for (int q = 0; q < 2; ++q) {
        const int cid = q * NTHR + tid, lr = cid >> 4, c16 = (cid & 15) * 16;
        const float4 v0 = *(const float4*)(stg + lr * EP_LD + c16);
        const float4 v1 = *(const float4*)(stg + lr * EP_LD + c16 + 4);
        const float4 v2 = *(const float4*)(stg + lr * EP_LD + c16 + 8);
        const float4 v3 = *(const float4*)(stg + lr * EP_LD + c16 + 12);
        const int row = grow_of(m0, mi, lr);
        uint4 o;
        o.x = pack2(siluf_(v0.x) * v0.y, siluf_(v0.z) * v0.w);
        o.y = pack2(siluf_(v1.x) * v1.y, siluf_(v1.z) * v1.w);
        o.z = pack2(siluf_(v2.x) * v2.y, siluf_(v2.z) * v2.w);
        o.w = pack2(siluf_(v3.x) * v3.y, siluf_(v3.z) * v3.w);
        *(uint4*)(ACT + (size_t)row * 2816 + (n0 >> 1) + (c16 >> 1)) = o;
      }
    }
    __syncthreads();
  };
  gemm_stream(1024, 1024, 1024, smem, ptrs, epi);
}

constexpr int AT_BASE = 64;
constexpr int AT_KBYTES = 64 * 272;
constexpr int AT_VBYTES = 128 * 136;
constexpr int AT_STAGE = AT_KBYTES + AT_VBYTES;

DI void attn_item(const Params& p, int l, int b, int head, int qt, float lam, float lam_init, unsigned char* smem) {
  const int tid = otid(), lane = tid & 63, w = tid >> 6, r = lane & 31, h = lane >> 5;
  const int comp = w & 1, rg = w >> 1;
  const bool prompt = b < 32;
  const int bs = b - 32;
  const u16* Kg = prompt ? (const u16*)(p.ws + WS_KB) + (size_t)b * 2048 * 512 : (const u16*)(p.ws + WS_KS) + (size_t)(l * 8 + bs) * 1056 * 512;
  const u16* Vg = prompt ? (const u16*)(p.ws + WS_VTP) + (size_t)b * 512 * 2048 : (const u16*)(p.ws + WS_VTS) + (size_t)(l * 8 + bs) * 512 * 1056;
  const int ldT = prompt ? 2048 : 1056;
  const int nkt = prompt ? 2 * qt + 2 : 17;
  const int nkeys = prompt ? 2048 : 1056;
  const int qtok0 = prompt ? b * 2048 + qt * 128 : TOKP + bs * 32;
  const int qpos0 = prompt ? qt * 128 : 1024;
  const bool active = prompt || rg == 0;
  const int my_nkt = prompt ? (rg < 2 ? nkt - 1 : nkt) : nkt;
  const u16* ZQ = (const u16*)(p.ws + WS_ZQ);
  bf16x8 qf[4];
  {
    const int qrow = active ? qtok0 + rg * 32 + r : qtok0;
#pragma unroll
    for (int ks = 0; ks < 4; ++ks) {
      const uint4 qq = *(const uint4*)(ZQ + (size_t)qrow * 512 + head * 128 + comp * 64 + ks * 16 + h * 8);
      const float cq = 0.125f * LOG2E;
      uint4 qs_;
      qs_.x = pack2(bflo(qq.x) * cq, bfhi(qq.x) * cq); qs_.y = pack2(bflo(qq.y) * cq, bfhi(qq.y) * cq);
      qs_.z = pack2(bflo(qq.z) * cq, bfhi(qq.z) * cq); qs_.w = pack2(bflo(qq.w) * cq, bfhi(qq.w) * cq);
      qf[ks] = __builtin_bit_cast(bf16x8, qs_);
    }
  }
  const float slope2 = exp2f(-2.f * (head + 1)) * LOG2E;
  const float c1 = 0.125f * LOG2E;
  const int qpos = qpos0 + rg * 32 + r;
  f32x16 O[4];
#pragma unroll
  for (int i = 0; i < 4; ++i) zero16(O[i]);
  float m_run = -INFINITY, l_run = 0.f;

  const int krow = tid >> 4, kcc = tid & 15;
  const int vrow = tid >> 3, vcc = tid & 7;
  const u16* kp = Kg + (size_t)((nkt - 1) * 64 + krow) * 512 + head * 128 + kcc * 8;
  const u16* vp = Vg + (size_t)(head * 128 + vrow) * ldT + (nkt - 1) * 64 + vcc * 8;
  uint4 rk0, rk1, rv0, rv1;
  unsigned char* sb = smem + AT_BASE;
  rk0 = *(const uint4*)kp; rk1 = *(const uint4*)(kp + 32 * 512);
  rv0 = *(const uint4*)vp; rv1 = *(const uint4*)(vp + (size_t)64 * ldT);
  {
    *(uint4*)(sb + krow * 272 + kcc * 16) = rk0;
    *(uint4*)(sb + (krow + 32) * 272 + kcc * 16) = rk1;
    *(uint2*)(sb + AT_KBYTES + vrow * 136 + vcc * 16) = make_uint2(rv0.x, rv0.y);
    *(uint2*)(sb + AT_KBYTES + vrow * 136 + vcc * 16 + 8) = make_uint2(rv0.z, rv0.w);
    *(uint2*)(sb + AT_KBYTES + (vrow + 64) * 136 + vcc * 16) = make_uint2(rv1.x, rv1.y);
    *(uint2*)(sb + AT_KBYTES + (vrow + 64) * 136 + vcc * 16 + 8) = make_uint2(rv1.z, rv1.w);
  }
  __syncthreads();
  for (int j = 0; j < nkt; ++j) {
    const int kt = nkt - 1 - j;
    const bool more = j + 1 < nkt;
    if (more) {
      kp -= 64 * 512; vp -= 64;
      rk0 = *(const uint4*)kp; rk1 = *(const uint4*)(kp + 32 * 512);
      rv0 = *(const uint4*)vp; rv1 = *(const uint4*)(vp + (size_t)64 * ldT);
    }
    if (active && kt < my_nkt) {
      const unsigned char* Kt = sb + (j & 1) * AT_STAGE;
      const unsigned char* Vt = Kt + AT_KBYTES;
      f32x16 s[2];
      const bool past = (kt * 64 + 63) < (qpos0 + rg * 32);
      if (past) {
        const float kb0 = slope2 * (float)(kt * 64 + 4 * h);
#pragma unroll
        for (int sub = 0; sub < 2; ++sub)
#pragma unroll
          for (int i = 0; i < 16; ++i) s[sub][i] = __builtin_fmaf(slope2, (float)(sub * 32 + (i & 3) + 8 * (i >> 2)), kb0);
      } else {
        zero16(s[0]); zero16(s[1]);
      }
#pragma unroll
      for (int ks = 0; ks < 4; ++ks) {
#pragma unroll
        for (int sub = 0; sub < 2; ++sub) {
          const bf16x8 kf = *(const bf16x8*)(Kt + (sub * 32 + r) * 272 + (comp * 64 + ks * 16 + h * 8) * 2);
          s[sub] = MFMA(kf, qf[ks], s[sub]);
        }
      }
      float mx = -INFINITY;
      if (!past) {
        const float qk0 = (float)(qpos - kt * 64 - 4 * h);
        const float qb = slope2 * (float)qpos;
#pragma unroll
        for (int sub = 0; sub < 2; ++sub)
#pragma unroll
          for (int i = 0; i < 16; ++i) {
            const float d = qk0 - (float)(sub * 32 + (i & 3) + 8 * (i >> 2));
            s[sub][i] = s[sub][i] - slope2 * fabsf(d) + qb;
          }
      }
      if (!prompt) {
#pragma unroll
        for (int sub = 0; sub < 2; ++sub)
#pragma unroll
          for (int i = 0; i < 16; ++i) {
            const int key = kt * 64 + sub * 32 + crow(i, h);
            if (key >= nkeys) s[sub][i] = -INFINITY;
          }
      }
#pragma unroll
      for (int sub = 0; sub < 2; ++sub)
#pragma unroll
        for (int i = 0; i < 16; ++i) mx = fmaxf(mx, s[sub][i]);
      mx = fmaxf(mx, shx(mx, 32, lane));
      const bool livelane = !(mx - m_run < -150.f);
      if (__ballot(livelane) != 0ull) {
        const float m_new = fmaxf(m_run, mx);
        const float alpha = fexp2(m_run - m_new);
        m_run = m_new;
        float lsum = 0.f;
#pragma unroll
        for (int sub = 0; sub < 2; ++sub)
#pragma unroll
          for (int i = 0; i < 16; ++i) {
            const float pv = fexp2(s[sub][i] - m_new);
            lsum += pv;
            s[sub][i] = pv;
          }
        l_run = l_run * alpha + lsum;
        if (__ballot(alpha != 1.f) != 0ull) {
#pragma unroll
          for (int dt = 0; dt < 4; ++dt)
#pragma unroll
            for (int i = 0; i < 16; ++i) O[dt][i] *= alpha;
        }
#pragma unroll
        for (int sub = 0; sub < 2; ++sub)
#pragma unroll
          for (int s2 = 0; s2 < 2; ++s2) {
            const bf16x8 pf = pack8(s[sub], s2);
#pragma unroll
            for (int dt = 0; dt < 4; ++dt) {
              const unsigned char* va = Vt + (dt * 32 + r) * 136 + (sub * 32 + s2 * 16 + 4 * h) * 2;
              const uint2 lo = *(const uint2*)va;
              const uint2 hi = *(const uint2*)(va + 16);
              const uint4 vv = make_uint4(lo.x, lo.y, hi.x, hi.y);
              O[dt] = MFMA(__builtin_bit_cast(bf16x8, vv), pf, O[dt]);
            }
          }
      }
    }
    if (more) {
      unsigned char* sn = sb + ((j + 1) & 1) * AT_STAGE;
      *(uint4*)(sn + krow * 272 + kcc * 16) = rk0;
      *(uint4*)(sn + (krow + 32) * 272 + kcc * 16) = rk1;
      *(uint2*)(sn + AT_KBYTES + vrow * 136 + vcc * 16) = make_uint2(rv0.x, rv0.y);
      *(uint2*)(sn + AT_KBYTES + vrow * 136 + vcc * 16 + 8) = make_uint2(rv0.z, rv0.w);
      *(uint2*)(sn + AT_KBYTES + (vrow + 64) * 136 + vcc * 16) = make_uint2(rv1.x, rv1.y);
      *(uint2*)(sn + AT_KBYTES + (vrow + 64) * 136 + vcc * 16 + 8) = make_uint2(rv1.z, rv1.w);
    }
    __syncthreads();
  }
  float* exch = (float*)(smem + AT_BASE);
  float inv = 0.f;
  if (active) { const float lt = l_run + shx(l_run, 32, lane); inv = 1.f / lt; }
  if (active && comp == 1) {
    const float sc = inv * lam;
#pragma unroll
    for (int dt = 0; dt < 4; ++dt)
#pragma unroll
      for (int i = 0; i < 16; ++i) exch[(rg * 64 + dt * 16 + i) * 64 + lane] = O[dt][i] * sc;
  }
  __syncthreads();
  if (active && comp == 0) {
    float ss = 0.f;
#pragma unroll
    for (int dt = 0; dt < 4; ++dt)
#pragma unroll
      for (int i = 0; i < 16; ++i) {
        const float o = O[dt][i] * inv - exch[(rg * 64 + dt * 16 + i) * 64 + lane];
        O[dt][i] = o;
        ss += o * o;
      }
    ss += shx(ss, 32, lane);
    const float rs = rsqrtf(ss * (1.f / 128.f) + LN_EPS) * (1.f - lam_init);
    u16* AN = (u16*)(p.ws + WS_AN) + (size_t)(qtok0 + rg * 32 + r) * 512 + head * 128;
    const float* gw = p.in[17] + l * 512 + head * 128;
#pragma unroll
    for (int dt = 0; dt < 4; ++dt)
#pragma unroll
      for (int g = 0; g < 4; ++g) {
        const int dv = dt * 32 + 8 * g + 4 * h;
        const float4 g4 = *(const float4*)(gw + dv);
        uint2 o;
        o.x = pack2(O[dt][4 * g] * rs * g4.x, O[dt][4 * g + 1] * rs * g4.y);
        o.y = pack2(O[dt][4 * g + 2] * rs * g4.z, O[dt][4 * g + 3] * rs * g4.w);
        *(uint2*)(AN + dv) = o;
      }
  }
}

constexpr int ML_QS = 64;
constexpr int ML_KS = ML_QS + 64 * 272;
constexpr int ML_KT = ML_KS + 64 * 272;
constexpr int ML_VT = ML_KT + 128 * 144;
constexpr int ML_CB = ML_VT + 128 * 144;
constexpr int ML_HB = ML_CB + 128 * 272;
constexpr int ML_SM = ML_HB + 64 * 132 * 4;
static_assert(ML_SM + 528 * 4 <= LDS_BYTES, "lds");

DI void mlstm_item(const Params& p, int l, int b, int head, unsigned char* smem) {
  const int tid = otid(), lane = tid & 63, w = tid >> 6, r = lane & 31, h = lane >> 5;
  const bool prompt = b < 32;
  const int bs = b - 32;
  const int T = prompt ? 2048 : 32;
  const int nch = prompt ? 32 : 1;
  const int L = prompt ? 64 : 32;
  const int tokbase = prompt ? b * 2048 : TOKP + bs * 32;
  const u16* qkT = prompt ? (const u16*)(p.ws + WS_MQKT_P) + (size_t)b * 1024 * 2048 : (const u16*)(p.ws + WS_MQKT_S) + (size_t)bs * 1024 * 32;
  const u16* vTg = prompt ? (const u16*)(p.ws + WS_MVT_P) + (size_t)b * 512 * 2048 : (const u16*)(p.ws + WS_MVT_S) + (size_t)bs * 512 * 32;
  u16* qs = (u16*)(smem + ML_QS);
  u16* ksm = (u16*)(smem + ML_KS);
  u16* kTw = (u16*)(smem + ML_KT);
  u16* vT = (u16*)(smem + ML_VT);
  u16* Cbf = (u16*)(smem + ML_CB);
  float* hbuf = (float*)(smem + ML_HB);
  float* a_s = (float*)(smem + ML_SM);
  float* mx_s = a_s + 64;
  float* ws_s = a_s + 128;
  float* wi_s = a_s + 192;
  float* emt_s = a_s + 256;
  float* nq_s = a_s + 320;
  float* nvec = a_s + 384;
  float* scal = a_s + 512;

  const int vt = w & 3, kt0 = (w >> 2) * 2;
  f32x16 accC[2];
  float m_run = 0.f;
  if (prompt) {
    zero16(accC[0]); zero16(accC[1]);
    if (tid < 128) nvec[tid] = 0.f;
  } else {
    const float* Cs = p.in[6] + ((size_t)(l * 8 + bs) * 4 + head) * 128 * 128;
#pragma unroll
    for (int q = 0; q < 2; ++q)
#pragma unroll
      for (int g = 0; g < 4; ++g) {
        const float4 c4 = *(const float4*)(Cs + (size_t)(vt * 32 + r) * 128 + (kt0 + q) * 32 + 8 * g + 4 * h);
        accC[q][4 * g] = c4.x; accC[q][4 * g + 1] = c4.y; accC[q][4 * g + 2] = c4.z; accC[q][4 * g + 3] = c4.w;
      }
    if (tid < 128) nvec[tid] = p.in[7][((size_t)(l * 8 + bs) * 4 + head) * 128 + tid];
    m_run = p.in[8][(l * 8 + bs) * 4 + head];
  }
#pragma unroll
  for (int q = 0; q < 2; ++q)
#pragma unroll
    for (int g = 0; g < 4; ++g) {
      uint2 o; o.x = pack2(accC[q][4 * g], accC[q][4 * g + 1]); o.y = pack2(accC[q][4 * g + 2], accC[q][4 * g + 3]);
      *(uint2*)(Cbf + (vt * 32 + r) * 136 + (kt0 + q) * 32 + 8 * g + 4 * h) = o;
    }
  const float* gatesp = (const float*)(p.ws + WS_GATES);
  const int vi = w >> 1, ti = w & 1;

  float ig_n = -INFINITY, fg_n = 0.f;
  if (w == 0 && lane < L) {
    const float* gp = gatesp + (size_t)(tokbase + lane) * 8;
    ig_n = gp[head]; fg_n = gp[4 + head];
  }
  for (int c = 0; c < nch; ++c) {
    const int t0 = c * 64;
    if (w == 0) {
      const int t = lane;
      float ig = -INFINITY, lf = 0.f;
      if (t < L) {
        ig = ig_n;
        const float fg = fg_n;
        lf = fminf(fg, 0.f) - log1pf(__expf(-fabsf(fg)));
        if (c + 1 < nch) {
          const float* gp = gatesp + (size_t)(tokbase + t0 + 64 + t) * 8;
          ig_n = gp[head]; fg_n = gp[4 + head];
        }
      }
      float bc = lf;
#pragma unroll
      for (int off = 1; off < 64; off <<= 1) { const float v = shidx(bc, lane - off, lane); if (lane >= off) bc += v; }
      const float a = ig - bc;
      float M = a;
#pragma unroll
      for (int off = 1; off < 64; off <<= 1) { const float v = shidx(M, lane - off, lane); if (lane >= off) M = fmaxf(M, v); }
      const float mx = fmaxf(m_run, M);
      const float bL = shidx(bc, 63, lane);
      const float mxL = shidx(mx, 63, lane);
      a_s[t] = a; mx_s[t] = mx;
      ws_s[t] = __expf(a - mxL);
      wi_s[t] = __expf(m_run - mx);
      emt_s[t] = __expf(-(bc + mx));
      if (lane == 0) scal[1] = __expf(m_run - mxL);
      m_run = bL + mxL;
    }
    const int ch2 = tid >> 1, th = tid & 1;
    const bool isk = ch2 >= 128;
    const int dd = ch2 & 127;
    const int ch = (isk ? 512 : 0) + head * 128 + dd;
    const u16* rp = qkT + (size_t)ch * T + t0 + th * 32;
    float um3 = 0.f, um2 = 0.f, um1 = 0.f;
    const bool ldrow = prompt || th == 0;
    uint4 uu0 = make_uint4(0, 0, 0, 0), uu1 = uu0, uu2 = uu0, uu3 = uu0, vv0 = uu0, vv1 = uu0;
    if (ldrow) { uu0 = *(const uint4*)(rp); uu1 = *(const uint4*)(rp + 8); uu2 = *(const uint4*)(rp + 16); uu3 = *(const uint4*)(rp + 24); }
    {
      const int row = tid >> 3, cc = tid & 7;
      if (prompt || cc < 4) {
        vv0 = *(const uint4*)(vTg + (size_t)(head * 128 + row) * T + t0 + cc * 8);
        vv1 = *(const uint4*)(vTg + (size_t)(head * 128 + row + 64) * T + t0 + cc * 8);
      }
    }
    if (prompt) {
      if (th == 1 || c > 0) {
        const uint2 pv = *(const uint2*)(rp - 4);
        um3 = bfhi(pv.x); um2 = bflo(pv.y); um1 = bfhi(pv.y);
      }
    } else if (th == 0) {
      const float* cvp = p.in[9] + (size_t)(l * 8 + bs) * 3 * 1024 + ch;
      um3 = cvp[0]; um2 = cvp[1024]; um1 = cvp[2048];
    }
    const float cw0 = p.in[14][(l * 4 + 0) * 1024 + ch], cw1 = p.in[14][(l * 4 + 1) * 1024 + ch];
    const float cw2 = p.in[14][(l * 4 + 2) * 1024 + ch], cw3 = p.in[14][(l * 4 + 3) * 1024 + ch];
    const float cb = p.in[15][l * 1024 + ch];
    __syncthreads();
    {
      u16* dstrm = (isk ? ksm : qs) + (th * 32) * 136 + dd;
      const float oscale = isk ? 0.08838834764831845f : 1.f;
#pragma unroll
      for (int i = 0; i < 4; ++i) {
        const uint4 uu = (i == 0) ? uu0 : (i == 1 ? uu1 : (i == 2 ? uu2 : uu3));
        float u[8];
        u[0] = bflo(uu.x); u[1] = bfhi(uu.x); u[2] = bflo(uu.y); u[3] = bfhi(uu.y);
        u[4] = bflo(uu.z); u[5] = bfhi(uu.z); u[6] = bflo(uu.w); u[7] = bfhi(uu.w);
        float y[8];
#pragma unroll
        for (int e = 0; e < 8; ++e) {
          const float x3 = (e >= 3) ? u[e - 3] : (e == 0 ? um3 : (e == 1 ? um2 : um1));
          const float x2 = (e >= 2) ? u[e - 2] : (e == 0 ? um2 : um1);
          const float x1 = (e >= 1) ? u[e - 1] : um1;
          const float yy = cb + cw0 * x3 + cw1 * x2 + cw2 * x1 + cw3 * u[e];
          y[e] = siluf_(yy) * oscale;
        }
        um3 = u[5]; um2 = u[6]; um1 = u[7];
#pragma unroll
        for (int e = 0; e < 8; ++e) dstrm[(i * 8 + e) * 136] = f2bf(y[e]);
        if (isk) {
          const float4 w0 = *(const float4*)(ws_s + th * 32 + i * 8);
          const float4 w1 = *(const float4*)(ws_s + th * 32 + i * 8 + 4);
          uint4 o;
          o.x = pack2(y[0] * w0.x, y[1] * w0.y); o.y = pack2(y[2] * w0.z, y[3] * w0.w);
          o.z = pack2(y[4] * w1.x, y[5] * w1.y); o.w = pack2(y[6] * w1.z, y[7] * w1.w);
          *(uint4*)(kTw + dd * 72 + th * 32 + i * 8) = o;
        }
      }
      {
        const int row = tid >> 3, cc = tid & 7;
        *(uint4*)(vT + row * 72 + cc * 8) = vv0;
        *(uint4*)(vT + (row + 64) * 72 + cc * 8) = vv1;
      }
    }
    __syncthreads();
    {
      const int t = tid >> 3, part = tid & 7;
      const uint4 q0 = *(const uint4*)(qs + t * 136 + part * 16);
      const uint4 q1 = *(const uint4*)(qs + t * 136 + part * 16 + 8);
      const float* nv = nvec + part * 16;
      float s = bflo(q0.x) * nv[0] + bfhi(q0.x) * nv[1] + bflo(q0.y) * nv[2] + bfhi(q0.y) * nv[3]
              + bflo(q0.z) * nv[4] + bfhi(q0.z) * nv[5] + bflo(q0.w) * nv[6] + bfhi(q0.w) * nv[7]
              + bflo(q1.x) * nv[8] + bfhi(q1.x) * nv[9] + bflo(q1.y) * nv[10] + bfhi(q1.y) * nv[11]
              + bflo(q1.z) * nv[12] + bfhi(q1.z) * nv[13] + bflo(q1.w) * nv[14] + bfhi(q1.w) * nv[15];
      s += shx(s, 1, lane); s += shx(s, 2, lane); s += shx(s, 4, lane);
      if (part == 0) nq_s[t] = s;
    }
    f32x16 accS[2], accO;
    zero16(accS[0]); zero16(accS[1]); zero16(accO);
    {
#pragma unroll
      for (int ks = 0; ks < 8; ++ks) {
        const bf16x8 qfr = *(const bf16x8*)(qs + (ti * 32 + r) * 136 + ks * 16 + h * 8);
        const bf16x8 k0 = *(const bf16x8*)(ksm + r * 136 + ks * 16 + h * 8);
        accS[0] = MFMA(k0, qfr, accS[0]);
        if (ti == 1) {
          const bf16x8 k1 = *(const bf16x8*)(ksm + (32 + r) * 136 + ks * 16 + h * 8);
          accS[1] = MFMA(k1, qfr, accS[1]);
        }
        const bf16x8 cf = *(const bf16x8*)(Cbf + (vi * 32 + r) * 136 + ks * 16 + h * 8);
        accO = MFMA(cf, qfr, accO);
      }
    }
    const int tcol = ti * 32 + r;
    const float mxt = mx_s[tcol];
    const float wit = wi_s[tcol];
    float dsum = 0.f;
#pragma unroll
    for (int sub = 0; sub < 2; ++sub) {
      if (sub <= ti) {
#pragma unroll
        for (int g = 0; g < 4; ++g) {
          const float4 a4 = *(const float4*)(a_s + sub * 32 + 8 * g + 4 * h);
          const float av[4] = {a4.x, a4.y, a4.z, a4.w};
#pragma unroll
          for (int e = 0; e < 4; ++e) {
            const int s = sub * 32 + 8 * g + 4 * h + e;
            const float wgt = (s <= tcol) ? __expf(av[e] - mxt) : 0.f;
            const float pv = accS[sub][4 * g + e] * wgt;
            accS[sub][4 * g + e] = pv;
            dsum += pv;
          }
        }
      }
    }
    dsum += shx(dsum, 32, lane);
#pragma unroll
    for (int i = 0; i < 16; ++i) accO[i] *= wit;
#pragma unroll
    for (int sub = 0; sub < 2; ++sub) {
      if (sub <= ti) {
#pragma unroll
        for (int s2 = 0; s2 < 2; ++s2) {
          const bf16x8 pf = pack8(accS[sub], s2);
          const u16* va = vT + (vi * 32 + r) * 72 + sub * 32 + s2 * 16 + 4 * h;
          const uint2 lo = *(const uint2*)va;
          const uint2 hi = *(const uint2*)(va + 8);
          const uint4 vq = make_uint4(lo.x, lo.y, hi.x, hi.y);
          accO = MFMA(__builtin_bit_cast(bf16x8, vq), pf, accO);
        }
      }
    }
    __syncthreads();
    {
      const float den = dsum + wit * nq_s[tcol];
      const float dn = fmaxf(fabsf(den), emt_s[tcol]);
      const float rinv = 1.f / dn;
#pragma unroll
      for (int g = 0; g < 4; ++g)
        *(float4*)(hbuf + tcol * 132 + vi * 32 + 8 * g + 4 * h) =
            make_float4(accO[4 * g] * rinv, accO[4 * g + 1] * rinv, accO[4 * g + 2] * rinv, accO[4 * g + 3] * rinv);
    }
    {
      const float wc = scal[1];
#pragma unroll
      for (int q = 0; q < 2; ++q)
#pragma unroll
        for (int i = 0; i < 16; ++i) accC[q][i] *= wc;
#pragma unroll
      for (int k4 = 0; k4 < 4; ++k4) {
        const bf16x8 vf = *(const bf16x8*)(vT + (vt * 32 + r) * 72 + k4 * 16 + h * 8);
#pragma unroll
        for (int q = 0; q < 2; ++q) {
          const bf16x8 kf = *(const bf16x8*)(kTw + ((kt0 + q) * 32 + r) * 72 + k4 * 16 + h * 8);
          accC[q] = MFMA(kf, vf, accC[q]);
        }
      }
#pragma unroll
      for (int q = 0; q < 2; ++q)
#pragma unroll
        for (int g = 0; g < 4; ++g) {
          uint2 o; o.x = pack2(accC[q][4 * g], accC[q][4 * g + 1]); o.y = pack2(accC[q][4 * g + 2], accC[q][4 * g + 3]);
          *(uint2*)(Cbf + (vt * 32 + r) * 136 + (kt0 + q) * 32 + 8 * g + 4 * h) = o;
        }
      if (tid < 128) {
        float s = 0.f;
#pragma unroll
        for (int i = 0; i < 8; ++i) {
          const uint4 kk = *(const uint4*)(kTw + tid * 72 + i * 8);
          s += bflo(kk.x) + bfhi(kk.x) + bflo(kk.y) + bfhi(kk.y) + bflo(kk.z) + bfhi(kk.z) + bflo(kk.w) + bfhi(kk.w);
        }
        nvec[tid] = wc * nvec[tid] + s;
      }
    }
    __syncthreads();
    {
      const int t = tid >> 3, part = tid & 7;
      float x[16];
#pragma unroll
      for (int i = 0; i < 4; ++i) {
        const float4 f = *(const float4*)(hbuf + t * 132 + part * 16 + i * 4);
        x[i * 4] = f.x; x[i * 4 + 1] = f.y; x[i * 4 + 2] = f.z; x[i * 4 + 3] = f.w;
      }
      float s = 0.f;
#pragma unroll
      for (int i = 0; i < 16; ++i) s += x[i];
      s += shx(s, 1, lane); s += shx(s, 2, lane); s += shx(s, 4, lane);
      const float mean = s * (1.f / 128.f);
      float q = 0.f;
#pragma unroll
      for (int i = 0; i < 16; ++i) { x[i] -= mean; q += x[i] * x[i]; }
      q += shx(q, 1, lane); q += shx(q, 2, lane); q += shx(q, 4, lane);
      const float rstd = rsqrtf(q * (1.f / 128.f) + LN_EPS);
      if (t < L) {
        const size_t tok = (size_t)tokbase + t0 + t;
        const int cbase = head * 128 + part * 16;
        const float* gw = p.in[18] + l * 512 + cbase;
        const u16* mo = (const u16*)(p.ws + WS_MO) + tok * 512 + cbase;
        const uint4 m0 = *(const uint4*)mo;
        const uint4 m1 = *(const uint4*)(mo + 8);
        const float sg[16] = {bflo(m0.x), bfhi(m0.x), bflo(m0.y), bfhi(m0.y), bflo(m0.z), bfhi(m0.z), bflo(m0.w), bfhi(m0.w),
                              bflo(m1.x), bfhi(m1.x), bflo(m1.y), bfhi(m1.y), bflo(m1.z), bfhi(m1.z), bflo(m1.w), bfhi(m1.w)};
        float yv[16];
#pragma unroll
        for (int i = 0; i < 16; ++i) yv[i] = x[i] * rstd * gw[i] * sg[i];
        uint4 o0, o1;
        o0.x = pack2(yv[0], yv[1]); o0.y = pack2(yv[2], yv[3]); o0.z = pack2(yv[4], yv[5]); o0.w = pack2(yv[6], yv[7]);
        o1.x = pack2(yv[8], yv[9]); o1.y = pack2(yv[10], yv[11]); o1.z = pack2(yv[12], yv[13]); o1.w = pack2(yv[14], yv[15]);
        u16* mn = (u16*)(p.ws + WS_MN) + tok * 512 + cbase;
        *(uint4*)mn = o0;
        *(uint4*)(mn + 8) = o1;
      }
    }
  }
  {
    float* oc = p.out + (prompt ? O_CP + ((size_t)(l * 32 + b) * 4 + head) * 16384 : O_CS + ((size_t)(l * 8 + bs) * 4 + head) * 16384);
#pragma unroll
    for (int q = 0; q < 2; ++q)
#pragma unroll
      for (int g = 0; g < 4; ++g)
        *(float4*)(oc + (size_t)(vt * 32 + r) * 128 + (kt0 + q) * 32 + 8 * g + 4 * h) =
            make_float4(accC[q][4 * g], accC[q][4 * g + 1], accC[q][4 * g + 2], accC[q][4 * g + 3]);
    float* on = p.out + (prompt ? O_NP + ((size_t)(l * 32 + b) * 4 + head) * 128 : O_NS + ((size_t)(l * 8 + bs) * 4 + head) * 128);
    if (tid < 128) on[tid] = nvec[tid];
    if (tid == 0) {
      if (prompt) p.out[O_MP + (size_t)(l * 32 + b) * 4 + head] = m_run;
      else p.out[O_MS + (size_t)(l * 8 + bs) * 4 + head] = m_run;
    }
  }
}

DI void phase_mixers(const Params& p, int l, unsigned char* smem) {
  const int tid0 = otid();
  const int lane = tid0 & 63;
  const float* lp = p.in[16] + l * 256;
  float s1 = lp[lane] * lp[64 + lane], s2 = lp[128 + lane] * lp[192 + lane];
  s1 = wave_sum(s1, lane); s2 = wave_sum(s2, lane);
  const float lam_init = 0.8f - 0.6f * expf(-0.3f * (float)l);
  const float lam = expf(s1) - expf(s2) + lam_init;
  int* ctr = (int*)(p.ws + WS_CTR) + l;
  int* sitem = (int*)smem;
  const int N_ML = 160, N_AT = 2048 + 32;
  for (;;) {
    __syncthreads();
    if (tid0 == 0) *sitem = atomicAdd(ctr, 1);
    __syncthreads();
    const int item = *sitem;
    if (item >= N_ML + N_AT) break;
    if (item < N_ML) {
#ifndef NO_ML
      mlstm_item(p, l, item >> 2, item & 3, smem);
#endif
    } else {
#ifndef NO_AT
      const int a = item - N_ML;
      if (a < 2048) {
        const int qt = 15 - (a >> 7), rest = a & 127;
        attn_item(p, l, rest >> 2, rest & 3, qt, lam, lam_init, smem);
      } else {
        const int s = a - 2048;
        attn_item(p, l, 32 + (s >> 2), s & 3, 0, lam, lam_init, smem);
      }
#endif
    }
  }
}

DI void gbar(unsigned* ctl, unsigned& k) {
  __syncthreads();
  ++k;
  if (otid() == 0) {
    __threadfence();
    const unsigned x = blockIdx.x & 7;
    const unsigned gsz = (gridDim.x + 7 - x) >> 3;
    const unsigned ngroups = gridDim.x < 8 ? gridDim.x : 8;
    unsigned* gc = ctl + 64 + x * 32;
    unsigned* gl = ctl + 32;
    const unsigned old = __hip_atomic_fetch_add(gc, 1u, __ATOMIC_RELAXED, __HIP_MEMORY_SCOPE_AGENT);
    if (old + 1 == k * gsz) {
      __threadfence();
      __hip_atomic_fetch_add(gl, 1u, __ATOMIC_RELAXED, __HIP_MEMORY_SCOPE_AGENT);
    }
    while (__hip_atomic_load(gl, __ATOMIC_RELAXED, __HIP_MEMORY_SCOPE_AGENT) < k * ngroups) __builtin_amdgcn_s_sleep(1);
    __threadfence();
  }
  __syncthreads();
}

__global__ void __launch_bounds__(NTHR) fwd_megakernel(Params p) {
  extern __shared__ __attribute__((aligned(16))) unsigned char smem[];
  cg::grid_group grid = cg::this_grid();
#ifndef PH
#define PH 0xffff
#endif
  unsigned* bar = (unsigned*)(p.ws + WS_CTR);
  unsigned epoch = 0;
  if (PH & 1) prologue(p, smem);
  grid.sync();
  if (PH & 1) prologue(p, smem);
  grid.sync();
  if (PH & 2) ln_pass(p, 0, 0, smem);
  gbar(bar, epoch);
#pragma unroll 1
  for (int l = 0; l < 2; ++l) {
    if (PH & 4) phase_in_gate(p, l, smem);
    gbar(bar, epoch);
    if (PH & 8) phase_mixers(p, l, smem);
    gbar(bar, epoch);
    if (PH & 16) phase_mix(p, l, smem);
    gbar(bar, epoch);
    if (PH & 32) phase_res(p, l, 0, smem);
    gbar(bar, epoch);
    if (PH & 64) ln_pass(p, 1, l, smem);
    gbar(bar, epoch);
    if (PH & 128) phase_gu(p, l, smem);
    gbar(bar, epoch);
    if (PH & 256) phase_res(p, l, 1, smem);
    gbar(bar, epoch);
    if (PH & 512) ln_pass(p, 2, l, smem);
    if (l == 0) gbar(bar, epoch);
  }
}

extern "C" void kernel_launch(void* const* d_in, const int* in_sizes, int n_in, void* d_out, int out_size, void* d_ws,
                              size_t ws_size, hipStream_t stream) {
  static int grid_blocks = 0;
  if (!grid_blocks) {
    int dev = 0, cus = 0, per_cu = 0;
    hipGetDevice(&dev);
    hipDeviceGetAttribute(&cus, hipDeviceAttributeMultiprocessorCount, dev);
    if (hipFuncSetAttribute((const void*)fwd_megakernel, hipFuncAttributeMaxDynamicSharedMemorySize, LDS_BYTES) != hipSuccess)
      fprintf(stderr, "kernel_launch: hipFuncSetAttribute failed\n");
    if (hipOccupancyMaxActiveBlocksPerMultiprocessor(&per_cu, (const void*)fwd_megakernel, NTHR, LDS_BYTES) != hipSuccess || per_cu < 1) {
      fprintf(stderr, "kernel_launch: occupancy query gave %d\n", per_cu);
      per_cu = 1;
    }
    (void)hipGetLastError();
    grid_blocks = cus * per_cu;
    if (ws_size < WS_END) fprintf(stderr, "kernel_launch: workspace too small: %zu < %zu\n", ws_size, (size_t)WS_END);
  }
  if (hipMemsetAsync((char*)d_ws + WS_CTR, 0, 4096, stream) != hipSuccess) fprintf(stderr, "kernel_launch: memset failed\n");
  Params p{};
  for (int i = 0; i < 30; ++i) p.in[i] = (const float*)d_in[i];
  p.out = (float*)d_out;
  p.ws = (unsigned char*)d_ws;
  void* args[] = {&p};
  hipError_t e = hipLaunchCooperativeKernel((const void*)fwd_megakernel, dim3(grid_blocks), dim3(NTHR), args, LDS_BYTES, stream);
  if (e != hipSuccess) fprintf(stderr, "cooperative launch failed: %s (grid %d)\n", hipGetErrorString(e), grid_blocks);
}
```

```cpp
#include <hip/hip_runtime.h>
#include <hip/hip_cooperative_groups.h>
#include <cstdio>
namespace cg = cooperative_groups;

#define DI __device__ __forceinline__
typedef unsigned short u16;
using bf16x8 = __attribute__((ext_vector_type(8))) short;
using f32x16 = __attribute__((ext_vector_type(16))) float;
#define MFMA(a, b, c) __builtin_amdgcn_mfma_f32_32x32x16_bf16((a), (b), (c), 0, 0, 0)

constexpr int TOKP = 65536, TOKS = 256, TOK = 65792;
constexpr int NTHR = 512;
constexpr float LN_EPS = 1e-5f;
constexpr float ALPHA = 1.41421356237f;
constexpr float LOG2E = 1.44269504089f;

constexpr size_t WS_WT_IN   = 0;
constexpr size_t WS_WT_GATE = WS_WT_IN + 2ull * 3584 * 1024 * 2;
constexpr size_t WS_WT_BRA  = WS_WT_GATE + 2ull * 2048 * 1024 * 2;
constexpr size_t WS_WT_BRB  = WS_WT_BRA + 2ull * 1024 * 512 * 2;
constexpr size_t WS_WT_O    = WS_WT_BRB + 2ull * 1024 * 512 * 2;
constexpr size_t WS_WT_GU   = WS_WT_O + 2ull * 1024 * 1024 * 2;
constexpr size_t WS_WT_DOWN = WS_WT_GU + 2ull * 5632 * 1024 * 2;
constexpr size_t WS_MOD     = WS_WT_DOWN + 2ull * 1024 * 2816 * 2;
constexpr size_t WS_GATES   = WS_MOD + 2ull * 40 * 6144 * 4;
constexpr size_t WS_CTR     = WS_GATES + (size_t)TOK * 8 * 4;
constexpr size_t WS_STAT    = WS_CTR + 4096;
constexpr size_t WS_KS      = WS_STAT + (size_t)TOK * 8;
constexpr size_t WS_VTS     = WS_KS + 2ull * 8 * 1056 * 512 * 2 + 65536;
constexpr size_t WS_MQKT_S  = WS_VTS + 2ull * 8 * 512 * 1056 * 2 + 65536;
constexpr size_t WS_MVT_S   = WS_MQKT_S + 8ull * 1024 * 32 * 2;
constexpr size_t WS_H       = WS_MVT_S + 8ull * 512 * 32 * 2;
constexpr size_t WS_AN      = WS_H;
constexpr size_t WS_MN      = WS_H + (size_t)TOK * 512 * 2;
constexpr size_t WS_ZQ      = WS_H + (size_t)TOK * 1024 * 2;
constexpr size_t WS_KB      = WS_ZQ + (size_t)TOK * 512 * 2;
constexpr size_t WS_VTP     = WS_KB + (size_t)TOKP * 512 * 2;
constexpr size_t WS_MQKT_P  = WS_VTP + 32ull * 512 * 2048 * 2;
constexpr size_t WS_MVT_P   = WS_MQKT_P + 32ull * 1024 * 2048 * 2;
constexpr size_t WS_MO      = WS_MVT_P + 32ull * 512 * 2048 * 2;
constexpr size_t WS_G       = WS_MO + (size_t)TOK * 512 * 2;
constexpr size_t WS_END     = WS_G + (size_t)TOK * 2048 * 2;
constexpr size_t WS_MIX     = WS_ZQ;
constexpr size_t WS_ACT     = WS_ZQ;

constexpr size_t O_YP  = 0;
constexpr size_t O_YS  = O_YP + (size_t)TOKP * 1024;
constexpr size_t O_KP  = O_YS + (size_t)TOKS * 1024;
constexpr size_t O_VP  = O_KP + 2ull * TOKP * 512;
constexpr size_t O_KSM = O_VP + 2ull * TOKP * 512;
constexpr size_t O_VSM = O_KSM + 2ull * TOKS * 512;
constexpr size_t O_CP  = O_VSM + 2ull * TOKS * 512;
constexpr size_t O_NP  = O_CP + 2ull * 32 * 4 * 128 * 128;
constexpr size_t O_MP  = O_NP + 2ull * 32 * 4 * 128;
constexpr size_t O_CVP = O_MP + 2ull * 32 * 4;
constexpr size_t O_CS  = O_CVP + 2ull * 32 * 3 * 1024;
constexpr size_t O_NS  = O_CS + 2ull * 8 * 4 * 128 * 128;
constexpr size_t O_MS  = O_NS + 2ull * 8 * 4 * 128;
constexpr size_t O_CVS = O_MS + 2ull * 8 * 4;

constexpr int LDS_BYTES = 148480;

struct Params {
  const float* in[30];
  float* out;
  unsigned char* ws;
};

DI u16 f2bf(float x) { unsigned u = __float_as_uint(x); u += 0x7fffu + ((u >> 16) & 1u); return (u16)(u >> 16); }
DI float bf2f(unsigned v) { return __uint_as_float(v << 16); }
typedef __bf16 bf16x2_t __attribute__((ext_vector_type(2)));
typedef float f32x2_t __attribute__((ext_vector_type(2)));
DI unsigned pack2(float a, float b) {
  f32x2_t v = {a, b};
  return __builtin_bit_cast(unsigned, __builtin_convertvector(v, bf16x2_t));
}
DI float bflo(unsigned v) { return __uint_as_float(v << 16); }
DI float bfhi(unsigned v) { return __uint_as_float(v & 0xffff0000u); }
DI float sigmoidf_(float x) { return __builtin_amdgcn_rcpf(1.f + __expf(-x)); }
DI float siluf_(float x) { return x * __builtin_amdgcn_rcpf(1.f + __expf(-x)); }
DI float fexp2(float x) { return __builtin_amdgcn_exp2f(x); }
DI int otid() { int t = threadIdx.x; asm volatile("" : "+v"(t)); return t; }
DI float shx(float v, int mask, int lane) { return __int_as_float(__builtin_amdgcn_ds_bpermute(((lane ^ mask) & 63) << 2, __float_as_int(v))); }
DI float shidx(float v, int src, int lane) { (void)lane; return __int_as_float(__builtin_amdgcn_ds_bpermute((src & 63) << 2, __float_as_int(v))); }
DI int crow(int i, int h) { return (i & 3) + 8 * (i >> 2) + 4 * h; }
DI bf16x8 pack8(const f32x16& x, int s) {
  uint4 u;
  u.x = pack2(x[8 * s + 0], x[8 * s + 1]); u.y = pack2(x[8 * s + 2], x[8 * s + 3]);
  u.z = pack2(x[8 * s + 4], x[8 * s + 5]); u.w = pack2(x[8 * s + 6], x[8 * s + 7]);
  return __builtin_bit_cast(bf16x8, u);
}
DI void zero16(f32x16& a) {
#pragma unroll
  for (int i = 0; i < 16; ++i) a[i] = 0.f;
}
DI int batch_of_row(int row) { return row < TOKP ? (row >> 11) : 32 + ((row - TOKP) >> 5); }

constexpr int GS_STRIDE = 144;
constexpr int GS_STAGE = 512 * GS_STRIDE;
constexpr int GS_BASE = 64;

DI void gemm_mainloop(f32x16 (&acc)[4][2], const u16* __restrict__ A, int lda, const u16* __restrict__ Wt, int ldw, int K,
                      int m0, int n0, unsigned char* smem) {
  const int tid = otid(), lane = tid & 63, w = tid >> 6;
  const int wm = w >> 2, wn = w & 3, r = lane & 31, h = lane >> 5;
  const int lrow = tid >> 3, lcc = tid & 7;
  const u16* ap = A + (size_t)(m0 + lrow) * lda + lcc * 8;
  const int bn = n0 + 2 * (lrow & 31) + ((lrow >> 5) & 1);
  const u16* bp = Wt + (size_t)bn * ldw + lcc * 8;
  const size_t astep = (size_t)64 * lda, bstep = (size_t)64 * ldw;
  unsigned char* sbase = smem + GS_BASE;
  const int woff = lrow * GS_STRIDE + lcc * 16;
  const int nk = K >> 6;
  uint4 s0, s1, s2, s3, s4, s5, s6, s7, u0, u1, u2, u3, u4, u5, u6, u7;
  int kn = 1;
#define G_ADV() do { const int adv = (kn < nk) ? 64 : 0; ap += adv; bp += adv; ++kn; } while (0)
#define G_ISSUE_A() do { s0 = *(const uint4*)(ap); s1 = *(const uint4*)(ap + astep); s2 = *(const uint4*)(ap + 2 * astep); s3 = *(const uint4*)(ap + 3 * astep); \
    s4 = *(const uint4*)(bp); s5 = *(const uint4*)(bp + bstep); s6 = *(const uint4*)(bp + 2 * bstep); s7 = *(const uint4*)(bp + 3 * bstep); } while (0)
#define G_ISSUE_B() do { u0 = *(const uint4*)(ap); u1 = *(const uint4*)(ap + astep); u2 = *(const uint4*)(ap + 2 * astep); u3 = *(const uint4*)(ap + 3 * astep); \
    u4 = *(const uint4*)(bp); u5 = *(const uint4*)(bp + bstep); u6 = *(const uint4*)(bp + 2 * bstep); u7 = *(const uint4*)(bp + 3 * bstep); } while (0)
#define G_WRITE_A(sn) do { *(uint4*)((sn) + woff) = s0; *(uint4*)((sn) + woff + 64 * GS_STRIDE) = s1; *(uint4*)((sn) + woff + 128 * GS_STRIDE) = s2; \
    *(uint4*)((sn) + woff + 192 * GS_STRIDE) = s3; *(uint4*)((sn) + woff + 256 * GS_STRIDE) = s4; *(uint4*)((sn) + woff + 320 * GS_STRIDE) = s5; \
    *(uint4*)((sn) + woff + 384 * GS_STRIDE) = s6; *(uint4*)((sn) + woff + 448 * GS_STRIDE) = s7; } while (0)
#define G_WRITE_B(sn) do { *(uint4*)((sn) + woff) = u0; *(uint4*)((sn) + woff + 64 * GS_STRIDE) = u1; *(uint4*)((sn) + woff + 128 * GS_STRIDE) = u2; \
    *(uint4*)((sn) + woff + 192 * GS_STRIDE) = u3; *(uint4*)((sn) + woff + 256 * GS_STRIDE) = u4; *(uint4*)((sn) + woff + 320 * GS_STRIDE) = u5; \
    *(uint4*)((sn) + woff + 384 * GS_STRIDE) = u6; *(uint4*)((sn) + woff + 448 * GS_STRIDE) = u7; } while (0)
  const int aoff = (wm * 128 + r) * GS_STRIDE + h * 16;
  const int boff = (256 + wn * 64 + r) * GS_STRIDE + h * 16;
#define G_COMPUTE(st) do { _Pragma("unroll") for (int ks = 0; ks < 4; ++ks) {                                              \
      bf16x8 fa[4], fb[2];                                                                                               \
      _Pragma("unroll") for (int mi = 0; mi < 4; ++mi) fa[mi] = *(const bf16x8*)((st) + aoff + mi * 32 * GS_STRIDE + ks * 32); \
      fb[0] = *(const bf16x8*)((st) + boff + ks * 32);                                                                   \
      fb[1] = *(const bf16x8*)((st) + boff + 32 * GS_STRIDE + ks * 32);                                                  \
      _Pragma("unroll") for (int mi = 0; mi < 4; ++mi) {                                                                 \
        acc[mi][0] = MFMA(fa[mi], fb[0], acc[mi][0]);                                                                    \
        acc[mi][1] = MFMA(fa[mi], fb[1], acc[mi][1]);                                                                    \
      }                                                                                                                  \
      __builtin_amdgcn_sched_barrier(0);                                                                                 \
    } } while (0)
  G_ISSUE_A();
  G_WRITE_A(sbase);
  G_ADV(); G_ISSUE_A();
  G_ADV(); G_ISSUE_B();
  __syncthreads();
  for (int kt = 0; kt < nk; kt += 2) {
    G_WRITE_A(sbase + GS_STAGE);
    G_ADV(); G_ISSUE_A();
    __builtin_amdgcn_sched_barrier(0);
    G_COMPUTE(sbase);
    __syncthreads();
    G_WRITE_B(sbase);
    G_ADV(); G_ISSUE_B();
    __builtin_amdgcn_sched_barrier(0);
    G_COMPUTE(sbase + GS_STAGE);
    __syncthreads();
  }
#undef G_ADV
#undef G_ISSUE_A
#undef G_ISSUE_B
#undef G_WRITE_A
#undef G_WRITE_B
#undef G_COMPUTE
}

DI int rot_unused_(int) { return 0; }
DI bool tile_of(int i, int MT, int NT, int& mt, int& nt) {
  const int per = gridDim.x >> 3;
  const int L = i * (int)gridDim.x + (int)(blockIdx.x & 7) * per + (int)(blockIdx.x >> 3);
  if (L >= MT * NT) return false;
  const int nig = 8 * NT, gid = L / nig, fm = gid * 8, gsz = min(MT - fm, 8), rem = L - gid * nig;
  mt = fm + rem % gsz; nt = rem / gsz;
  return true;
}


template <class PF, class EF>
DI void gemm_stream(int lda, int ldw, int K, unsigned char* smem, PF ptrs, EF epi) {
  const int tid = otid(), lane = tid & 63, w = tid >> 6;
  const int wm = w >> 2, wn = w & 3, r = lane & 31, h = lane >> 5;
  unsigned char* sbase = smem + GS_BASE;
  constexpr int SLOT = 512 * 64;
  const int nh = K >> 5;
  const int c0 = (h ^ ((r >> 2) & 3)) * 16, c1 = c0 ^ 32;
  const int aoff = (wm * 128 + r) * 64, boff = (256 + wn * 64 + r) * 64;
  const int lr16 = lane >> 2, lchunk = (lane & 3) ^ ((lane >> 4) & 3);
  const int wu = __builtin_amdgcn_readfirstlane(w);
  const bool isB = wu >= 4;
  const unsigned goff = isB ? (unsigned)((((wu - 4) * 64 + 2 * lr16) * ldw + lchunk * 8) * 2)
                            : (unsigned)(((wu * 64 + lr16) * lda + lchunk * 8) * 2);
  const unsigned st1 = isB ? (unsigned)(32 * ldw * 2) : (unsigned)(16 * lda * 2);
  const unsigned st2 = isB ? (unsigned)(1 * ldw * 2) : (unsigned)(32 * lda * 2);
#define WAIT_V(n) asm volatile("s_waitcnt vmcnt(" #n ")" ::: "memory")
#define RAWBAR() do { asm volatile("s_waitcnt lgkmcnt(0)" ::: "memory"); __builtin_amdgcn_s_barrier(); asm volatile("" ::: "memory"); } while (0)
#define BAR0() do { asm volatile("" ::: "memory"); __builtin_amdgcn_s_barrier(); asm volatile("" ::: "memory"); } while (0)
#define H_DMA(slotp) do { const char* gsrc_ = (isB ? bp : ap) + goff; unsigned char* ld_ = (slotp) + wu * 4096;            \
    __builtin_amdgcn_global_load_lds((const unsigned*)(gsrc_), (unsigned*)(ld_), 16, 0, 0);                                  \
    __builtin_amdgcn_global_load_lds((const unsigned*)(gsrc_ + st1), (unsigned*)(ld_ + 1024), 16, 0, 0);                     \
    __builtin_amdgcn_global_load_lds((const unsigned*)(gsrc_ + st2), (unsigned*)(ld_ + 2048), 16, 0, 0);                     \
    __builtin_amdgcn_global_load_lds((const unsigned*)(gsrc_ + st2 + st1), (unsigned*)(ld_ + 3072), 16, 0, 0); } while (0)
#define H_READ(sl) do { _Pragma("unroll") for (int mi = 0; mi < 4; ++mi) {                                                   \
      fa[0][mi] = *(const bf16x8*)((sl) + aoff + mi * 2048 + c0); fa[1][mi] = *(const bf16x8*)((sl) + aoff + mi * 2048 + c1); } \
    fb[0][0] = *(const bf16x8*)((sl) + boff + c0); fb[1][0] = *(const bf16x8*)((sl) + boff + c1);                            \
    fb[0][1] = *(const bf16x8*)((sl) + boff + 2048 + c0); fb[1][1] = *(const bf16x8*)((sl) + boff + 2048 + c1); } while (0)
#define H_MMA() do { _Pragma("unroll") for (int ks = 0; ks < 2; ++ks) { _Pragma("unroll") for (int mi = 0; mi < 4; ++mi) {  \
      acc[mi][0] = MFMA(fa[ks][mi], fb[ks][0], acc[mi][0]);                                                       \
      acc[mi][1] = MFMA(fa[ks][mi], fb[ks][1], acc[mi][1]); } } } while (0)
  const char *ap, *bp;
  {
    const u16 *ta, *tb;
    int it0 = 0;
    asm volatile("" : "+s"(it0));
    if (!ptrs(it0, ta, tb)) return;
    ap = (const char*)ta; bp = (const char*)tb;
  }
  H_DMA(sbase); ap += 64; bp += 64;
  H_DMA(sbase + SLOT); ap += 64; bp += 64;
  for (int it = 0;; ++it) {
    f32x16 acc[4][2];
#pragma unroll
    for (int a = 0; a < 4; ++a)
#pragma unroll
      for (int b = 0; b < 2; ++b) zero16(acc[a][b]);
    H_DMA(sbase + 2 * SLOT); ap += 64; bp += 64;
    WAIT_V(4);
    BAR0();
    if (wm == 1) BAR0();
    int rs = 0;
#pragma unroll 1
    for (int hh = 0; hh < nh; ++hh) {
      bf16x8 fa[2][4], fb[2][2];
      const int rem = nh - 2 - hh;
      H_READ(sbase + rs * SLOT);
      if (hh + 3 < nh) { H_DMA(sbase + ((rs + 3) & 3) * SLOT); ap += 64; bp += 64; }
      if (wm == 1) {
        if (rem >= 2) WAIT_V(8); else if (rem == 1) WAIT_V(4); else WAIT_V(0);
      }
      __builtin_amdgcn_sched_barrier(0);
      RAWBAR();
      __builtin_amdgcn_sched_barrier(0);
      H_MMA();
      __builtin_amdgcn_sched_barrier(0);
      if (wm == 0) {
        if (rem >= 2) WAIT_V(8); else if (rem == 1) WAIT_V(4); else WAIT_V(0);
      }
      BAR0();
      rs = (rs + 1) & 3;
    }
    if (wm == 0) BAR0();
    bool more;
    {
      const u16 *ta, *tb;
      more = ptrs(it + 1, ta, tb);
      if (more) {
        ap = (const char*)ta; bp = (const char*)tb;
        H_DMA(sbase); ap += 64; bp += 64;
        H_DMA(sbase + SLOT); ap += 64; bp += 64;
      }
    }
    epi(it, acc);
    if (!more) break;
  }
#undef WAIT_V
#undef RAWBAR
#undef BAR0
#undef H_DMA
#undef H_READ
#undef H_MMA
}

DI int map_row(int maptype, int s) {
  if (maptype == 1) return s < 3072 ? s : (s < 3080 ? -1 : s - 8);
  if (maptype == 2) return s < 2816 ? 2 * s : 2 * (s - 2816) + 1;
  return s;
}
DI void transpose_task(const float* __restrict__ src, int Nsrc, u16* __restrict__ dst, int dld, int maptype, int kt2, int nt,
                       unsigned char* smem) {
  float* tile = (float*)(smem + 64);
  const int tid = otid();
  const int k0 = kt2 * 128, s0 = nt * 64;
  float4 v[4];
#pragma unroll
  for (int i = 0; i < 4; ++i) {
    const int kr = (tid >> 4) + 32 * i, nc = (tid & 15) * 4;
    v[i] = make_float4(0.f, 0.f, 0.f, 0.f);
    if (s0 + nc < Nsrc) v[i] = *(const float4*)(src + (size_t)(k0 + kr) * Nsrc + s0 + nc);
  }
#pragma unroll
  for (int i = 0; i < 4; ++i) {
    const int kr = (tid >> 4) + 32 * i, nc = (tid & 15) * 4;
    tile[kr * 65 + nc + 0] = v[i].x; tile[kr * 65 + nc + 1] = v[i].y; tile[kr * 65 + nc + 2] = v[i].z; tile[kr * 65 + nc + 3] = v[i].w;
  }
  __syncthreads();
  {
    const int n = tid >> 3;
    const int s = s0 + n;
    const int dr = (s < Nsrc) ? map_row(maptype, s) : -1;
    if (dr >= 0) {
#pragma unroll
      for (int j = 0; j < 2; ++j) {
        const int kc = (tid & 7) * 8 + 64 * j;
        uint4 o;
        o.x = pack2(tile[(kc + 0) * 65 + n], tile[(kc + 1) * 65 + n]);
        o.y = pack2(tile[(kc + 2) * 65 + n], tile[(kc + 3) * 65 + n]);
        o.z = pack2(tile[(kc + 4) * 65 + n], tile[(kc + 5) * 65 + n]);
        o.w = pack2(tile[(kc + 6) * 65 + n], tile[(kc + 7) * 65 + n]);
        *(uint4*)(dst + (size_t)dr * dld + k0 + kc) = o;
      }
    }
  }
  __syncthreads();
}

DI void adaln_task(const Params& p, int task, unsigned char* smem) {
  const int bhalf = task & 1, cg_ = (task >> 1) % 96, l = (task >> 1) / 96;
  float* cs = (float*)(smem + 64);
  float* red = (float*)(smem + 64 + 20 * 1024 * 4);
  const int tid = otid();
  const float* cp = p.in[2]; const float* csm = p.in[3];
  for (int idx = tid; idx < 20 * 1024; idx += NTHR) {
    const int bb = idx >> 10, d = idx & 1023, b = bhalf * 20 + bb;
    const float c = b < 32 ? cp[b * 1024 + d] : csm[(b - 32) * 1024 + d];
    cs[idx] = siluf_(c);
  }
  __syncthreads();
  const int dseg = tid >> 6, e = cg_ * 64 + (tid & 63);
  const float* wp = p.in[10] + ((size_t)l * 1024 + dseg * 128) * 6144 + e;
  float acc[20];
#pragma unroll
  for (int i = 0; i < 20; ++i) acc[i] = 0.f;
  for (int d = 0; d < 128; ++d) {
    const float wv = wp[(size_t)d * 6144];
    const float* c0 = cs + dseg * 128 + d;
#pragma unroll
    for (int i = 0; i < 20; ++i) acc[i] += c0[i * 1024] * wv;
  }
#pragma unroll
  for (int i = 0; i < 20; ++i) red[(dseg * 20 + i) * 64 + (tid & 63)] = acc[i];
  __syncthreads();
  float* mod = (float*)(p.ws + WS_MOD);
  for (int idx = tid; idx < 20 * 64; idx += NTHR) {
    const int bb = idx >> 6, ec = idx & 63;
    float s = 0.f;
#pragma unroll
    for (int q = 0; q < 8; ++q) s += red[(q * 20 + bb) * 64 + ec];
    const int ee = cg_ * 64 + ec;
    mod[((size_t)l * 40 + bhalf * 20 + bb) * 6144 + ee] = s + p.in[11][l * 6144 + ee];
  }
  __syncthreads();
}

DI void prologue(const Params& p, unsigned char* smem) {
  const int WT_TASKS_L = 456 + 256 + 64 + 64 + 128 + 704 + 352;
  const int N_WT = 2 * WT_TASKS_L;
  const int N_ADA = 384, N_CK = 512, N_CV = 1024;
  const int total = N_WT + N_ADA + N_CK + N_CV;
  for (int task = blockIdx.x; task < total; task += gridDim.x) {
    if (task < N_WT) {
      const int l = task / WT_TASKS_L; int t = task % WT_TASKS_L;
      if (t < 456) { transpose_task(p.in[12] + (size_t)l * 1024 * 3592, 3592, (u16*)(p.ws + WS_WT_IN) + (size_t)l * 3584 * 1024, 1024, 1, t / 57, t % 57, smem); continue; }
      t -= 456;
      if (t < 256) { transpose_task(p.in[21] + (size_t)l * 1024 * 2048, 2048, (u16*)(p.ws + WS_WT_GATE) + (size_t)l * 2048 * 1024, 1024, 0, t / 32, t % 32, smem); continue; }
      t -= 256;
      if (t < 64) { transpose_task(p.in[19] + (size_t)l * 512 * 1024, 1024, (u16*)(p.ws + WS_WT_BRA) + (size_t)l * 1024 * 512, 512, 0, t / 16, t % 16, smem); continue; }
      t -= 64;
      if (t < 64) { transpose_task(p.in[20] + (size_t)l * 512 * 1024, 1024, (u16*)(p.ws + WS_WT_BRB) + (size_t)l * 1024 * 512, 512, 0, t / 16, t % 16, smem); continue; }
      t -= 64;
      if (t < 128) { transpose_task(p.in[23] + (size_t)l * 1024 * 1024, 1024, (u16*)(p.ws + WS_WT_O) + (size_t)l * 1024 * 1024, 1024, 0, t / 16, t % 16, smem); continue; }
      t -= 128;
      if (t < 704) { transpose_task(p.in[26] + (size_t)l * 1024 * 5632, 5632, (u16*)(p.ws + WS_WT_GU) + (size_t)l * 5632 * 1024, 1024, 2, t / 88, t % 88, smem); continue; }
      t -= 704;
      transpose_task(p.in[27] + (size_t)l * 2816 * 1024, 1024, (u16*)(p.ws + WS_WT_DOWN) + (size_t)l * 1024 * 2816, 2816, 0, t / 16, t % 16, smem);
    } else if (task < N_WT + N_ADA) {
      adaln_task(p, task - N_WT, smem);
    } else if (task < N_WT + N_ADA + N_CK) {
      const int t = task - N_WT - N_ADA;
      const float4* src = (const float4*)p.in[4];
      u16* dst = (u16*)(p.ws + WS_KS);
#pragma unroll
      for (int i = 0; i < 8; ++i) {
        const size_t f4 = (size_t)t * 4096 + i * 512 + otid();
        const float4 v = src[f4];
        const size_t e = f4 * 4;
        const size_t lb = e / (1024 * 512), rem = e % (1024 * 512);
        uint2 o; o.x = pack2(v.x, v.y); o.y = pack2(v.z, v.w);
        *(uint2*)(dst + lb * (1056 * 512) + rem) = o;
      }
    } else {
      const int t = task - N_WT - N_ADA - N_CK;
      const int lb = t >> 6, tt = t & 63;
      transpose_task(p.in[5] + (size_t)lb * 1024 * 512, 512, (u16*)(p.ws + WS_VTS) + (size_t)lb * 512 * 1056, 1056, 0, tt >> 3, tt & 7, smem);
    }
  }
}

DI float wave_sum(float v, int lane) {
  (void)lane;
  int x = __float_as_int(v);
  v += __int_as_float(__builtin_amdgcn_update_dpp(0, x, 0xB1, 0xF, 0xF, true));
  x = __float_as_int(v);
  v += __int_as_float(__builtin_amdgcn_update_dpp(0, x, 0x4E, 0xF, 0xF, true));
  x = __float_as_int(v);
  v += __int_as_float(__builtin_amdgcn_update_dpp(0, x, 0x141, 0xF, 0xF, true));
  x = __float_as_int(v);
  v += __int_as_float(__builtin_amdgcn_update_dpp(0, x, 0x140, 0xF, 0xF, true));
  x = __float_as_int(v);
  const float r0 = __int_as_float(__builtin_amdgcn_readlane(x, 0)), r1 = __int_as_float(__builtin_amdgcn_readlane(x, 16));
  const float r2 = __int_as_float(__builtin_amdgcn_readlane(x, 32)), r3 = __int_as_float(__builtin_amdgcn_readlane(x, 48));
  return (r0 + r1) + (r2 + r3);
}
DI void ln_pass(const Params& p, int mode, int l, unsigned char* smem) {
  const int tid = otid();
  const int lane = tid & 63, w = tid >> 6;
  const bool first = mode != 0;
  const bool second = (mode != 2) || (l + 1 < 2);
  const bool gates = (mode == 0) || (mode == 2 && l + 1 < 2);
  const int lm = (mode == 2) ? l + 1 : l;
  const int shi = (mode == 1) ? 3 : 0;
  const float* lng = (mode == 1) ? p.in[24] + l * 1024 : p.in[28] + l * 1024;
  const float* lnb = (mode == 1) ? p.in[25] + l * 1024 : p.in[29] + l * 1024;
  const float* mod = (const float*)(p.ws + WS_MOD);
  u16* H = (u16*)(p.ws + WS_H);
  float* gout = (float*)(p.ws + WS_GATES);
  float* wl = (float*)(smem + 64);
  float bif[8];
  if (gates) {
    const float* wi = p.in[12] + (size_t)lm * 1024 * 3592 + 3072;
    for (int idx = tid; idx < 8192; idx += NTHR) {
      const int c = idx >> 3, j = idx & 7;
      wl[j * 1024 + c] = wi[(size_t)c * 3592 + j];
    }
#pragma unroll
    for (int j = 0; j < 8; ++j) bif[j] = p.in[13][lm * 8 + j];
  }
  __syncthreads();
  float lg[16], lb[16];
  if (first) {
#pragma unroll
    for (int i = 0; i < 4; ++i) {
      const float4 g = *(const float4*)(lng + i * 256 + lane * 4);
      const float4 b = *(const float4*)(lnb + i * 256 + lane * 4);
      lg[i * 4] = g.x; lg[i * 4 + 1] = g.y; lg[i * 4 + 2] = g.z; lg[i * 4 + 3] = g.w;
      lb[i * 4] = b.x; lb[i * 4 + 1] = b.y; lb[i * 4 + 2] = b.z; lb[i * 4 + 3] = b.w;
    }
  }
  const bool write_x = (mode == 2 && l == 1);
  float* stats = (float*)(p.ws + WS_STAT);
  auto process = [&](int row, float (&v)[16], const float (&msh)[16], const float (&msc)[16]) {
    float* xr = p.out + (size_t)row * 1024;
    if (first) {
      float s = 0.f;
#pragma unroll
      for (int i = 0; i < 16; ++i) s += v[i];
      const float mean = wave_sum(s, lane) * (1.f / 1024.f);
      float q = 0.f;
#pragma unroll
      for (int i = 0; i < 16; ++i) { v[i] -= mean; q += v[i] * v[i]; }
      const float rstd = rsqrtf(wave_sum(q, lane) * (1.f / 1024.f) + LN_EPS);
#pragma unroll
      for (int i = 0; i < 4; ++i) {
#pragma unroll
        for (int e = 0; e < 4; ++e) v[i * 4 + e] = v[i * 4 + e] * rstd * lg[i * 4 + e] + lb[i * 4 + e];
        if (write_x) *(float4*)(xr + i * 256 + lane * 4) = make_float4(v[i * 4 + 0], v[i * 4 + 1], v[i * 4 + 2], v[i * 4 + 3]);
      }
      if (!write_x && lane == 0) *(float2*)(stats + (size_t)row * 2) = make_float2(mean, rstd);
    }
    if (second) {
      float s = 0.f;
#pragma unroll
      for (int i = 0; i < 16; ++i) s += v[i];
      const float mean = wave_sum(s, lane) * (1.f / 1024.f);
      float q = 0.f;
#pragma unroll
      for (int i = 0; i < 16; ++i) { v[i] -= mean; q += v[i] * v[i]; }
      const float rstd = rsqrtf(wave_sum(q, lane) * (1.f / 1024.f) + LN_EPS);
#pragma unroll
      for (int i = 0; i < 4; ++i) {
#pragma unroll
        for (int e = 0; e < 4; ++e) v[i * 4 + e] = v[i * 4 + e] * rstd * msc[i * 4 + e] + msh[i * 4 + e];
        uint2 o; o.x = pack2(v[i * 4 + 0], v[i * 4 + 1]); o.y = pack2(v[i * 4 + 2], v[i * 4 + 3]);
        *(uint2*)(H + (size_t)row * 1024 + i * 256 + lane * 4) = o;
      }
      if (gates) {
        float g8[8];
#pragma unroll
        for (int j = 0; j < 8; ++j) {
          float s2 = 0.f;
#pragma unroll
          for (int i = 0; i < 4; ++i) {
            const float4 wv = *(const float4*)(wl + j * 1024 + i * 256 + lane * 4);
            s2 += v[i * 4] * wv.x + v[i * 4 + 1] * wv.y + v[i * 4 + 2] * wv.z + v[i * 4 + 3] * wv.w;
          }
          g8[j] = wave_sum(s2, lane) + bif[j];
        }
        if (lane == 0) {
          *(float4*)(gout + (size_t)row * 8) = make_float4(g8[0], g8[1], g8[2], g8[3]);
          *(float4*)(gout + (size_t)row * 8 + 4) = make_float4(g8[4], g8[5], g8[6], g8[7]);
        }
      }
    }
  };
  auto load_mod = [&](int row, float (&msh)[16], float (&msc)[16]) {
    const float* mb = mod + ((size_t)lm * 40 + batch_of_row(row)) * 6144;
#pragma unroll
    for (int i = 0; i < 4; ++i) {
      const float4 sh = *(const float4*)(mb + shi * 1024 + i * 256 + lane * 4);
      const float4 sc = *(const float4*)(mb + (shi + 1) * 1024 + i * 256 + lane * 4);
      msh[i * 4] = sh.x; msh[i * 4 + 1] = sh.y; msh[i * 4 + 2] = sh.z; msh[i * 4 + 3] = sh.w;
      msc[i * 4] = 1.f + sc.x; msc[i * 4 + 1] = 1.f + sc.y; msc[i * 4 + 2] = 1.f + sc.z; msc[i * 4 + 3] = 1.f + sc.w;
    }
  };
  for (int chunk = blockIdx.x * 8 + w; chunk < TOKP / 32; chunk += gridDim.x * 8) {
    const int row0 = chunk * 32;
    float msh[16], msc[16];
    if (second) load_mod(row0, msh, msc);
    const float* src0 = (mode == 0) ? p.in[0] + (size_t)row0 * 1024 : p.out + (size_t)row0 * 1024;
    float4 nx0 = *(const float4*)(src0 + lane * 4), nx1 = *(const float4*)(src0 + 256 + lane * 4);
    float4 nx2 = *(const float4*)(src0 + 512 + lane * 4), nx3 = *(const float4*)(src0 + 768 + lane * 4);
    for (int ri = 0; ri < 32; ++ri) {
      float v[16];
      v[0] = nx0.x; v[1] = nx0.y; v[2] = nx0.z; v[3] = nx0.w; v[4] = nx1.x; v[5] = nx1.y; v[6] = nx1.z; v[7] = nx1.w;
      v[8] = nx2.x; v[9] = nx2.y; v[10] = nx2.z; v[11] = nx2.w; v[12] = nx3.x; v[13] = nx3.y; v[14] = nx3.z; v[15] = nx3.w;
      {
        const float* sn = src0 + (size_t)(ri < 31 ? ri + 1 : 31) * 1024;
        nx0 = *(const float4*)(sn + lane * 4); nx1 = *(const float4*)(sn + 256 + lane * 4);
        nx2 = *(const float4*)(sn + 512 + lane * 4); nx3 = *(const float4*)(sn + 768 + lane * 4);
      }
      __builtin_amdgcn_sched_barrier(0);
      process(row0 + ri, v, msh, msc);
    }
  }
  if (w == 0) {
    for (int row = TOKP + blockIdx.x; row < TOK; row += gridDim.x) {
      float msh[16], msc[16];
      if (second) load_mod(row, msh, msc);
      const float* src = (mode == 0) ? p.in[1] + (size_t)(row - TOKP) * 1024 : p.out + (size_t)row * 1024;
      float v[16];
#pragma unroll
      for (int i = 0; i < 4; ++i) {
        const float4 t = *(const float4*)(src + i * 256 + lane * 4);
        v[i * 4 + 0] = t.x; v[i * 4 + 1] = t.y; v[i * 4 + 2] = t.z; v[i * 4 + 3] = t.w;
      }
      process(row, v, msh, msc);
    }
  }
}


DI void micro_partial(f32x16& acc, const u16* A, int lda, const u16* Wt, int ldw, int K, int row0, int n0, int w, int r, int h) {
  const int kb = w * (K >> 3), n16 = K >> 7;
  const u16* ap = A + (size_t)(row0 + r) * lda + kb + h * 8;
  const u16* bp = Wt + (size_t)(n0 + r) * ldw + kb + h * 8;
#pragma unroll 4
  for (int k = 0; k < n16; ++k) {
    const bf16x8 a = *(const bf16x8*)(ap + k * 16);
    const bf16x8 b = *(const bf16x8*)(bp + k * 16);
    acc = MFMA(a, b, acc);
  }
}
DI void micro_reduce_store(const f32x16& acc, float* red, int w, int lane) {
#pragma unroll
  for (int i = 0; i < 16; ++i) red[(w * 16 + i) * 64 + lane] = acc[i];
}
DI float micro_sum(const float* red, int i, int lane) {
  float s = 0.f;
#pragma unroll
  for (int q = 0; q < 8; ++q) s += red[(q * 16 + i) * 64 + lane];
  return s;
}

constexpr int EP_LD = 264;
constexpr int EP_LDT = 68;
DI void zero_acc(f32x16 (&acc)[4][2]) {
#pragma unroll
  for (int a = 0; a < 4; ++a)
#pragma unroll
    for (int b = 0; b < 2; ++b) zero16(acc[a][b]);
}
DI void stage_rm(const f32x16& a0, const f32x16& a1, float* stg, int wm, int wn, int r, int h) {
#pragma unroll
  for (int i = 0; i < 16; ++i) *(float2*)(stg + (wm * 32 + crow(i, h)) * EP_LD + wn * 64 + 2 * r) = make_float2(a0[i], a1[i]);
}
DI void stage_tr(const f32x16& a0, const f32x16& a1, float* stg, int wm, int wn, int r, int h) {
#pragma unroll
  for (int g = 0; g < 4; ++g) {
    *(float4*)(stg + (wn * 64 + 2 * r) * EP_LDT + wm * 32 + 8 * g + 4 * h) = make_float4(a0[4 * g], a0[4 * g + 1], a0[4 * g + 2], a0[4 * g + 3]);
    *(float4*)(stg + (wn * 64 + 2 * r + 1) * EP_LDT + wm * 32 + 8 * g + 4 * h) = make_float4(a1[4 * g], a1[4 * g + 1], a1[4 * g + 2], a1[4 * g + 3]);
  }
}
DI int grow_of(int m0, int mi, int lr) { return m0 + (lr >> 5) * 128 + mi * 32 + (lr & 31); }
DI uint4 pack8f(const float4& a, const float4& b) {
  uint4 o; o.x = pack2(a.x, a.y); o.y = pack2(a.z, a.w); o.z = pack2(b.x, b.y); o.w = pack2(b.z, b.w); return o;
}

DI void write_tr(const Params& p, int l, int m0, int mi, const float* stg, int tid, int which, int chbase) {
  const bool prompt = m0 < TOKP;
#pragma unroll 1
  for (int q = 0; q < 4; ++q) {
    const int cid = q * NTHR + tid, ch = cid >> 3, tc = cid & 7;
    const float4 v0 = *(const float4*)(stg + ch * EP_LDT + tc * 8);
    const float4 v1 = *(const float4*)(stg + ch * EP_LDT + tc * 8 + 4);
    const int row0 = grow_of(m0, mi, tc * 8);
    const int chg = chbase + ch;
    u16* d;
    if (prompt) {
      const int b = row0 >> 11, t = row0 & 2047;
      if (which == 0) d = (u16*)(p.ws + WS_VTP) + ((size_t)b * 512 + chg) * 2048 + t;
      else if (which == 1) d = (u16*)(p.ws + WS_MQKT_P) + ((size_t)b * 1024 + chg) * 2048 + t;
      else d = (u16*)(p.ws + WS_MVT_P) + ((size_t)b * 512 + chg) * 2048 + t;
    } else {
      const int rs = row0 - TOKP, bs = rs >> 5, t = rs & 31;
      if (which == 0) d = (u16*)(p.ws + WS_VTS) + ((size_t)(l * 8 + bs) * 512 + chg) * 1056 + 1024 + t;
      else if (which == 1) d = (u16*)(p.ws + WS_MQKT_S) + ((size_t)bs * 1024 + chg) * 32 + t;
      else d = (u16*)(p.ws + WS_MVT_S) + ((size_t)bs * 512 + chg) * 32 + t;
    }
    *(uint4*)d = pack8f(v0, v1);
  }
}

DI void epi_in(const Params& p, int l, int m0, int n0, f32x16 (&acc)[4][2], unsigned char* smem) {
  const int tid = otid(), lane = tid & 63, w = tid >> 6;
  const int wm = w >> 2, wn = w & 3, r = lane & 31, h = lane >> 5;
  const bool prompt = m0 < TOKP;
  float* stg = (float*)(smem + GS_BASE + GS_STAGE);
  const int seg = n0 < 512 ? 0 : (n0 < 1024 ? 1 : (n0 < 1536 ? 2 : (n0 < 2560 ? 3 : (n0 < 3072 ? 4 : 5))));
  if (seg == 3) {
    const int ch = n0 - 1536 + wn * 64 + 2 * r;
#pragma unroll
    for (int mi = 0; mi < 4; ++mi) {
      const int rb = m0 + wm * 128 + mi * 32 + 4 * h;
#pragma unroll
      for (int i = 0; i < 16; ++i) {
        const int row = rb + (i & 3) + 8 * (i >> 2);
        if (prompt) {
          const int tt = row & 2047;
          if (tt >= 2045) *(float2*)(p.out + O_CVP + ((size_t)(l * 32 + (row >> 11)) * 3 + (tt - 2045)) * 1024 + ch) = make_float2(acc[mi][0][i], acc[mi][1][i]);
        } else {
          const int rs = row - TOKP, tt = rs & 31;
          if (tt >= 29) *(float2*)(p.out + O_CVS + ((size_t)(l * 8 + (rs >> 5)) * 3 + (tt - 29)) * 1024 + ch) = make_float2(acc[mi][0][i], acc[mi][1][i]);
        }
      }
    }
  }
#pragma unroll
  for (int mi = 0; mi < 4; ++mi) {
    if (seg == 0 || seg == 1 || seg == 2 || seg == 5) {
      __syncthreads();
      stage_rm(acc[mi][0], acc[mi][1], stg, wm, wn, r, h);
      __syncthreads();
#pragma unroll 1
      for (int q = 0; q < 4; ++q) {
        const int cid = q * NTHR + tid, lr = cid >> 5, c8 = (cid & 31) * 8;
        const float4 v0 = *(const float4*)(stg + lr * EP_LD + c8);
        const float4 v1 = *(const float4*)(stg + lr * EP_LD + c8 + 4);
        const int row = grow_of(m0, mi, lr);
        const int n = n0 + c8;
        if (seg == 0) {
          *(uint4*)((u16*)(p.ws + WS_ZQ) + (size_t)row * 512 + n) = pack8f(v0, v1);
        } else if (seg == 5) {
          const float4 s0 = make_float4(sigmoidf_(v0.x), sigmoidf_(v0.y), sigmoidf_(v0.z), sigmoidf_(v0.w));
          const float4 s1 = make_float4(sigmoidf_(v1.x), sigmoidf_(v1.y), sigmoidf_(v1.z), sigmoidf_(v1.w));
          *(uint4*)((u16*)(p.ws + WS_MO) + (size_t)row * 512 + (n - 3072)) = pack8f(s0, s1);
        } else {
          const bool isk = seg == 1;
          const int nn = n - (isk ? 512 : 1024);
          float* of = p.out + (isk ? (prompt ? O_KP : O_KSM) : (prompt ? O_VP : O_VSM));
          const size_t orow = prompt ? ((size_t)l * TOKP + row) : ((size_t)l * TOKS + (row - TOKP));
          *(float4*)(of + orow * 512 + nn) = v0;
          *(float4*)(of + orow * 512 + nn + 4) = v1;
          if (isk) {
            u16* kd;
            if (prompt) kd = (u16*)(p.ws + WS_KB) + (size_t)row * 512 + nn;
            else { const int rs = row - TOKP; kd = (u16*)(p.ws + WS_KS) + ((size_t)(l * 8 + (rs >> 5)) * 1056 + 1024 + (rs & 31)) * 512 + nn; }
            *(uint4*)kd = pack8f(v0, v1);
          }
        }
      }
    }
    if (seg == 2 || seg == 3 || seg == 4) {
      __syncthreads();
      stage_tr(acc[mi][0], acc[mi][1], stg, wm, wn, r, h);
      __syncthreads();
      write_tr(p, l, m0, mi, stg, tid, seg == 2 ? 0 : (seg == 3 ? 1 : 2), n0 - (seg == 2 ? 1024 : (seg == 3 ? 1536 : 2560)));
    }
  }
  __syncthreads();
}

DI void phase_in_gate(const Params& p, int l, unsigned char* smem) {
  const int tid = otid(), lane = tid & 63, w = tid >> 6;
  const int wm = w >> 2, wn = w & 3, r = lane & 31, h = lane >> 5;
  const u16* H = (const u16*)(p.ws + WS_H);
  const u16* Win = (const u16*)(p.ws + WS_WT_IN) + (size_t)l * 3584 * 1024;
  const u16* Wg = (const u16*)(p.ws + WS_WT_GATE) + (size_t)l * 2048 * 1024;
  float* stg = (float*)(smem + GS_BASE + GS_STAGE);
  const int NT = 14 + 8, MT = 257;
  auto ptrs = [&](int it, const u16*& ap, const u16*& bp) -> bool {
    int mt, nt;
    if (!tile_of(it, MT, NT, mt, nt)) return false;
    ap = H + (size_t)(mt * 256) * 1024;
    bp = (nt < 14 ? Win + (size_t)(nt * 256) * 1024 : Wg + (size_t)((nt - 14) * 256) * 1024);
    return true;
  };
  auto epi = [&](int it, f32x16 (&acc)[4][2]) {
    const int tid = otid(), lane = tid & 63, w = tid >> 6;
    const int wm = w >> 2, wn = w & 3, r = lane & 31, h = lane >> 5;
    int mt, nt;
    tile_of(it, MT, NT, mt, nt);
    const int m0 = mt * 256;
    if (nt < 14) {
      epi_in(p, l, m0, nt * 256, acc, smem);
    } else {
      const int n0 = (nt - 14) * 256;
      u16* G = (u16*)(p.ws + WS_G);
#pragma unroll
      for (int mi = 0; mi < 4; ++mi) {
        __syncthreads();
        stage_rm(acc[mi][0], acc[mi][1], stg, wm, wn, r, h);
        __syncthreads();
#pragma unroll 1
        for (int q = 0; q < 4; ++q) {
          const int cid = q * NTHR + tid, lr = cid >> 5, c8 = (cid & 31) * 8;
          float4 v0 = *(const float4*)(stg + lr * EP_LD + c8);
          float4 v1 = *(const float4*)(stg + lr * EP_LD + c8 + 4);
          const int row = grow_of(m0, mi, lr), n = n0 + c8;
          const float4 b0 = *(const float4*)(p.in[22] + l * 2048 + n);
          const float4 b1 = *(const float4*)(p.in[22] + l * 2048 + n + 4);
          v0 = make_float4(sigmoidf_(v0.x + b0.x), sigmoidf_(v0.y + b0.y), sigmoidf_(v0.z + b0.z), sigmoidf_(v0.w + b0.w));
          v1 = make_float4(sigmoidf_(v1.x + b1.x), sigmoidf_(v1.y + b1.y), sigmoidf_(v1.z + b1.z), sigmoidf_(v1.w + b1.w));
          *(uint4*)(G + (size_t)row * 2048 + n) = pack8f(v0, v1);
        }
      }
      __syncthreads();
    }
  };
  gemm_stream(1024, 1024, 1024, smem, ptrs, epi);
}

DI void phase_mix(const Params& p, int l, unsigned char* smem) {
  const int tid = otid(), lane = tid & 63, w = tid >> 6;
  const int wm = w >> 2, wn = w & 3, r = lane & 31, h = lane >> 5;
  const u16* G = (const u16*)(p.ws + WS_G);
  u16* MIX = (u16*)(p.ws + WS_MIX);
  float* stg = (float*)(smem + GS_BASE + GS_STAGE);
  const int NT = 4, MT = 256;
  auto ptrs = [&](int it, const u16*& ap, const u16*& bp) -> bool {
    int mt, nt;
    if (!tile_of(it >> 1, MT, NT, mt, nt)) return false;
    const int half = it & 1;
    ap = (const u16*)(p.ws + (half ? WS_MN : WS_AN)) + (size_t)(mt * 256) * 512;
    bp = (const u16*)(p.ws + (half ? WS_WT_BRB : WS_WT_BRA)) + (size_t)l * 1024 * 512 + (size_t)(nt * 256) * 512;
    return true;
  };
  auto epi = [&](int it, f32x16 (&acc)[4][2]) {
    const int tid = otid(), lane = tid & 63, w = tid >> 6;
    const int wm = w >> 2, wn = w & 3, r = lane & 31, h = lane >> 5;
    int mt, nt;
    tile_of(it >> 1, MT, NT, mt, nt);
    const int half = it & 1;
    const int m0 = mt * 256, n0 = nt * 256;
#pragma unroll
    for (int mi = 0; mi < 4; ++mi) {
      __syncthreads();
      stage_rm(acc[mi][0], acc[mi][1], stg, wm, wn, r, h);
      __syncthreads();
#pragma unroll 1
      for (int q = 0; q < 4; ++q) {
        const int cid = q * NTHR + tid, lr = cid >> 5, c8 = (cid & 31) * 8;
        const float4 v0 = *(const float4*)(stg + lr * EP_LD + c8);
        const float4 v1 = *(const float4*)(stg + lr * EP_LD + c8 + 4);
        const int row = grow_of(m0, mi, lr), n = n0 + c8;
        const uint4 g = *(const uint4*)(G + (size_t)row * 2048 + half * 1024 + n);
        float4 o0 = make_float4(bflo(g.x) * v0.x, bfhi(g.x) * v0.y, bflo(g.y) * v0.z, bfhi(g.y) * v0.w);
        float4 o1 = make_float4(bflo(g.z) * v1.x, bfhi(g.z) * v1.y, bflo(g.w) * v1.z, bfhi(g.w) * v1.w);
        uint4* mp = (uint4*)(MIX + (size_t)row * 1024 + n);
        if (half) {
          const uint4 pr = *mp;
          o0.x += bflo(pr.x); o0.y += bfhi(pr.x); o0.z += bflo(pr.y); o0.w += bfhi(pr.y);
          o1.x += bflo(pr.z); o1.y += bfhi(pr.z); o1.z += bflo(pr.w); o1.w += bfhi(pr.w);
        }
        *mp = pack8f(o0, o1);
      }
    }
    __syncthreads();
  };
  gemm_stream(512, 512, 512, smem, ptrs, epi);
  {
    const int tid2 = otid(), lane = tid2 & 63, w = tid2 >> 6, r = lane & 31, h = lane >> 5;
    float* red = (float*)(smem + 64);
    for (int mtile = blockIdx.x; mtile < 256; mtile += gridDim.x) {
      const int row0 = TOKP + (mtile >> 5) * 32, n0 = (mtile & 31) * 32;
      f32x16 pa, pb;
      zero16(pa); zero16(pb);
      micro_partial(pa, (const u16*)(p.ws + WS_AN), 512, (const u16*)(p.ws + WS_WT_BRA) + (size_t)l * 1024 * 512, 512, 512, row0, n0, w, r, h);
      micro_partial(pb, (const u16*)(p.ws + WS_MN), 512, (const u16*)(p.ws + WS_WT_BRB) + (size_t)l * 1024 * 512, 512, 512, row0, n0, w, r, h);
      __syncthreads();
      micro_reduce_store(pa, red, w, lane);
      micro_reduce_store(pb, red + 8192, w, lane);
      __syncthreads();
#pragma unroll
      for (int q = 0; q < 2; ++q) {
        const int i = w + 8 * q;
        const float sa = micro_sum(red, i, lane), sb = micro_sum(red + 8192, i, lane);
        const int row = row0 + crow(i, h), n = n0 + r;
        const float ga = bf2f(G[(size_t)row * 2048 + n]), gb = bf2f(G[(size_t)row * 2048 + 1024 + n]);
        MIX[(size_t)row * 1024 + n] = f2bf(ga * sa + gb * sb);
      }
    }
    __syncthreads();
  }
}

DI void phase_res(const Params& p, int l, int mode, unsigned char* smem) {
  const int tid = otid(), lane = tid & 63, w = tid >> 6;
  const int wm = w >> 2, wn = w & 3, r = lane & 31, h = lane >> 5;
  const float* mod = (const float*)(p.ws + WS_MOD);
  float* stg = (float*)(smem + GS_BASE + GS_STAGE);
  const int NT = 4, MT = 256;
  const int K = (mode == 0) ? 1024 : 2816;
  const u16* Ab = (const u16*)(p.ws + (mode == 0 ? WS_MIX : WS_ACT));
  const u16* Wb = (mode == 0) ? (const u16*)(p.ws + WS_WT_O) + (size_t)l * 1024 * 1024 : (const u16*)(p.ws + WS_WT_DOWN) + (size_t)l * 1024 * 2816;
  const int gi = (mode == 0) ? 2 : 5;
  const float* stats = (const float*)(p.ws + WS_STAT);
  const float* rlg = (mode == 1) ? p.in[24] + l * 1024 : p.in[28] + (l > 0 ? l - 1 : 0) * 1024;
  const float* rlb = (mode == 1) ? p.in[25] + l * 1024 : p.in[29] + (l > 0 ? l - 1 : 0) * 1024;
  auto ptrs = [&](int it, const u16*& ap, const u16*& bp) -> bool {
    int mt, nt;
    if (!tile_of(it, MT, NT, mt, nt)) return false;
    ap = Ab + (size_t)(mt * 256) * K;
    bp = Wb + (size_t)(nt * 256) * K;
    return true;
  };
  auto epi = [&](int it, f32x16 (&acc)[4][2]) {
    const int tid = otid(), lane = tid & 63, w = tid >> 6;
    const int wm = w >> 2, wn = w & 3, r = lane & 31, h = lane >> 5;
    int mt, nt;
    tile_of(it, MT, NT, mt, nt);
    const int m0 = mt * 256, n0 = nt * 256;
#pragma unroll
    for (int mi = 0; mi < 4; ++mi) {
      __syncthreads();
      stage_rm(acc[mi][0], acc[mi][1], stg, wm, wn, r, h);
      __syncthreads();
#pragma unroll 1
      for (int q = 0; q < 8; ++q) {
        const int cid = q * NTHR + tid, lr = cid >> 6, c4 = (cid & 63) * 4;
        const float4 v = *(const float4*)(stg + lr * EP_LD + c4);
        const int row = grow_of(m0, mi, lr), n = n0 + c4;
        const int b = batch_of_row(row);
        const float4 gg = *(const float4*)(mod + ((size_t)l * 40 + b) * 6144 + gi * 1024 + n);
        float* xr = p.out + (size_t)row * 1024 + n;
        const float* xs = (mode == 0 && l == 0) ? (row < TOKP ? p.in[0] + (size_t)row * 1024 + n : p.in[1] + (size_t)(row - TOKP) * 1024 + n) : xr;
        float4 xv = *(const float4*)xs;
        if (!(mode == 0 && l == 0)) {
          const float2 st = *(const float2*)(stats + (size_t)row * 2);
          const float4 g4 = *(const float4*)(rlg + n), b4 = *(const float4*)(rlb + n);
          xv.x = (xv.x - st.x) * st.y * g4.x + b4.x; xv.y = (xv.y - st.x) * st.y * g4.y + b4.y;
          xv.z = (xv.z - st.x) * st.y * g4.z + b4.z; xv.w = (xv.w - st.x) * st.y * g4.w + b4.w;
        }
        *(float4*)xr = make_float4(ALPHA * xv.x + (1.f + gg.x) * v.x, ALPHA * xv.y + (1.f + gg.y) * v.y,
                                   ALPHA * xv.z + (1.f + gg.z) * v.z, ALPHA * xv.w + (1.f + gg.w) * v.w);
      }
    }
    __syncthreads();
  };
  gemm_stream(K, K, K, smem, ptrs, epi);
  {
    const int tid2 = otid(), lane = tid2 & 63, w = tid2 >> 6, r = lane & 31, h = lane >> 5;
    float* red = (float*)(smem + 64);
    for (int mtile = blockIdx.x; mtile < 256; mtile += gridDim.x) {
      const int row0 = TOKP + (mtile >> 5) * 32, n0 = (mtile & 31) * 32;
      f32x16 pa;
      zero16(pa);
      micro_partial(pa, Ab, K, Wb, K, K, row0, n0, w, r, h);
      __syncthreads();
      micro_reduce_store(pa, red, w, lane);
      __syncthreads();
#pragma unroll
      for (int q = 0; q < 2; ++q) {
        const int i = w + 8 * q;
        const float sa = micro_sum(red, i, lane);
        const int row = row0 + crow(i, h), n = n0 + r;
        const float gg = mod[((size_t)l * 40 + batch_of_row(row)) * 6144 + gi * 1024 + n];
        float* xr = p.out + (size_t)row * 1024 + n;
        float xv = (mode == 0 && l == 0) ? p.in[1][(size_t)(row - TOKP) * 1024 + n] : *xr;
        if (!(mode == 0 && l == 0)) {
          const float2 st = *(const float2*)(stats + (size_t)row * 2);
          xv = (xv - st.x) * st.y * rlg[n] + rlb[n];
        }
        *xr = ALPHA * xv + (1.f + gg) * sa;
      }
    }
    __syncthreads();
  }
}

DI void phase_gu(const Params& p, int l, unsigned char* smem) {
  const int tid = otid(), lane = tid & 63, w = tid >> 6;
  const int wm = w >> 2, wn = w & 3, r = lane & 31, h = lane >> 5;
  u16* ACT = (u16*)(p.ws + WS_ACT);
  const u16* Hh = (const u16*)(p.ws + WS_H);
  const u16* Wb = (const u16*)(p.ws + WS_WT_GU) + (size_t)l * 5632 * 1024;
  float* stg = (float*)(smem + GS_BASE + GS_STAGE);
  const int NT = 22, MT = 257;
  auto ptrs = [&](int it, const u16*& ap, const u16*& bp) -> bool {
    int mt, nt;
    if (!tile_of(it, MT, NT, mt, nt)) return false;
    ap = Hh + (size_t)(mt * 256) * 1024;
    bp = Wb + (size_t)(nt * 256) * 1024;
    return true;
  };
  auto epi = [&](int it, f32x16 (&acc)[4][2]) {
    const int tid = otid(), lane = tid & 63, w = tid >> 6;
    const int wm = w >> 2, wn = w & 3, r = lane & 31, h = lane >> 5;
    int mt, nt;
    tile_of(it, MT, NT, mt, nt);
    const int m0 = mt * 256, n0 = nt * 256;
#pragma unroll
    for (int mi = 0; mi < 4; ++mi) {
      __syncthreads();
      stage_rm(acc[mi][0], acc[mi][1], stg, wm, wn, r, h);
      __syncthreads();
#pragma unroll 1
      for (int q = 0; q < 2; ++q) {
        const int cid = q * NTHR + tid, lr = cid >> 4, c16 = (cid & 15) * 16;
        const float4 v0 = *(const float4*)(stg + lr * EP_LD + c16);
        const float4 v1 = *(const float4*)(stg + lr * EP_LD + c16 + 4);
        const float4 v2 = *(const float4*)(stg + lr * EP_LD + c16 + 8);
        const float4 v3 = *(const float4*)(stg + lr * EP_LD + c16 + 12);
        const int row = grow_of(m0, mi, lr);
        uint4 o;
        o.x = pack2(siluf_(v0.x) * v0.y, siluf_(v0.z) * v0.w);
        o.y = pack2(siluf_(v1.x) * v1.y, siluf_(v1.z) * v1.w);
        o.z = pack2(siluf_(v2.x) * v2.y, siluf_(v2.z) * v2.w);
        o.w = pack2(siluf_(v3.x) * v3.y, siluf_(v3.z) * v3.w);
        *(uint4*)(ACT + (size_t)row * 2816 + (n0 >> 1) + (c16 >> 1)) = o;
      }
    }
    __syncthreads();
  };
  gemm_stream(1024, 1024, 1024, smem, ptrs, epi);
}

constexpr int AT_BASE = 64;
constexpr int AT_KBYTES = 64 * 272;
constexpr int AT_VBYTES = 128 * 136;
constexpr int AT_STAGE = AT_KBYTES + AT_VBYTES;

DI void attn_item(const Params& p, int l, int b, int head, int qt, float lam, float lam_init, unsigned char* smem) {
  const int tid = otid(), lane = tid & 63, w = tid >> 6, r = lane & 31, h = lane >> 5;
  const int comp = w & 1, rg = w >> 1;
  const bool prompt = b < 32;
  const int bs = b - 32;
  const u16* Kg = prompt ? (const u16*)(p.ws + WS_KB) + (size_t)b * 2048 * 512 : (const u16*)(p.ws + WS_KS) + (size_t)(l * 8 + bs) * 1056 * 512;
  const u16* Vg = prompt ? (const u16*)(p.ws + WS_VTP) + (size_t)b * 512 * 2048 : (const u16*)(p.ws + WS_VTS) + (size_t)(l * 8 + bs) * 512 * 1056;
  const int ldT = prompt ? 2048 : 1056;
  const int nkt = prompt ? 2 * qt + 2 : 17;
  const int nkeys = prompt ? 2048 : 1056;
  const int qtok0 = prompt ? b * 2048 + qt * 128 : TOKP + bs * 32;
  const int qpos0 = prompt ? qt * 128 : 1024;
  const bool active = prompt || rg == 0;
  const int my_nkt = prompt ? (rg < 2 ? nkt - 1 : nkt) : nkt;
  const u16* ZQ = (const u16*)(p.ws + WS_ZQ);
  bf16x8 qf[4];
  {
    const int qrow = active ? qtok0 + rg * 32 + r : qtok0;
#pragma unroll
    for (int ks = 0; ks < 4; ++ks) {
      const uint4 qq = *(const uint4*)(ZQ + (size_t)qrow * 512 + head * 128 + comp * 64 + ks * 16 + h * 8);
      const float cq = 0.125f * LOG2E;
      uint4 qs_;
      qs_.x = pack2(bflo(qq.x) * cq, bfhi(qq.x) * cq); qs_.y = pack2(bflo(qq.y) * cq, bfhi(qq.y) * cq);
      qs_.z = pack2(bflo(qq.z) * cq, bfhi(qq.z) * cq); qs_.w = pack2(bflo(qq.w) * cq, bfhi(qq.w) * cq);
      qf[ks] = __builtin_bit_cast(bf16x8, qs_);
    }
  }
  const float slope2 = exp2f(-2.f * (head + 1)) * LOG2E;
  const float c1 = 0.125f * LOG2E;
  const int qpos = qpos0 + rg * 32 + r;
  f32x16 O[4];
#pragma unroll
  for (int i = 0; i < 4; ++i) zero16(O[i]);
  float m_run = -INFINITY, l_run = 0.f;

  const int krow = tid >> 4, kcc = tid & 15;
  const int vrow = tid >> 3, vcc = tid & 7;
  const u16* kp = Kg + (size_t)((nkt - 1) * 64 + krow) * 512 + head * 128 + kcc * 8;
  const u16* vp = Vg + (size_t)(head * 128 + vrow) * ldT + (nkt - 1) * 64 + vcc * 8;
  uint4 rk0, rk1, rv0, rv1;
  unsigned char* sb = smem + AT_BASE;
  rk0 = *(const uint4*)kp; rk1 = *(const uint4*)(kp + 32 * 512);
  rv0 = *(const uint4*)vp; rv1 = *(const uint4*)(vp + (size_t)64 * ldT);
  {
    *(uint4*)(sb + krow * 272 + kcc * 16) = rk0;
    *(uint4*)(sb + (krow + 32) * 272 + kcc * 16) = rk1;
    *(uint2*)(sb + AT_KBYTES + vrow * 136 + vcc * 16) = make_uint2(rv0.x, rv0.y);
    *(uint2*)(sb + AT_KBYTES + vrow * 136 + vcc * 16 + 8) = make_uint2(rv0.z, rv0.w);
    *(uint2*)(sb + AT_KBYTES + (vrow + 64) * 136 + vcc * 16) = make_uint2(rv1.x, rv1.y);
    *(uint2*)(sb + AT_KBYTES + (vrow + 64) * 136 + vcc * 16 + 8) = make_uint2(rv1.z, rv1.w);
  }
  __syncthreads();
  for (int j = 0; j < nkt; ++j) {
    const int kt = nkt - 1 - j;
    const bool more = j + 1 < nkt;
    if (more) {
      kp -= 64 * 512; vp -= 64;
      rk0 = *(const uint4*)kp; rk1 = *(const uint4*)(kp + 32 * 512);
      rv0 = *(const uint4*)vp; rv1 = *(const uint4*)(vp + (size_t)64 * ldT);
    }
    if (active && kt < my_nkt) {
      const unsigned char* Kt = sb + (j & 1) * AT_STAGE;
      const unsigned char* Vt = Kt + AT_KBYTES;
      f32x16 s[2];
      const bool past = (kt * 64 + 63) < (qpos0 + rg * 32);
      if (past) {
        const float kb0 = slope2 * (float)(kt * 64 + 4 * h);
#pragma unroll
        for (int sub = 0; sub < 2; ++sub)
#pragma unroll
          for (int i = 0; i < 16; ++i) s[sub][i] = __builtin_fmaf(slope2, (float)(sub * 32 + (i & 3) + 8 * (i >> 2)), kb0);
      } else {
        zero16(s[0]); zero16(s[1]);
      }
#pragma unroll
      for (int ks = 0; ks < 4; ++ks) {
#pragma unroll
        for (int sub = 0; sub < 2; ++sub) {
          const bf16x8 kf = *(const bf16x8*)(Kt + (sub * 32 + r) * 272 + (comp * 64 + ks * 16 + h * 8) * 2);
          s[sub] = MFMA(kf, qf[ks], s[sub]);
        }
      }
      float mx = -INFINITY;
      if (!past) {
        const float qk0 = (float)(qpos - kt * 64 - 4 * h);
        const float qb = slope2 * (float)qpos;
#pragma unroll
        for (int sub = 0; sub < 2; ++sub)
#pragma unroll
          for (int i = 0; i < 16; ++i) {
            const float d = qk0 - (float)(sub * 32 + (i & 3) + 8 * (i >> 2));
            s[sub][i] = s[sub][i] - slope2 * fabsf(d) + qb;
          }
      }
      if (!prompt) {
#pragma unroll
        for (int sub = 0; sub < 2; ++sub)
#pragma unroll
          for (int i = 0; i < 16; ++i) {
            const int key = kt * 64 + sub * 32 + crow(i, h);
            if (key >= nkeys) s[sub][i] = -INFINITY;
          }
      }
#pragma unroll
      for (int sub = 0; sub < 2; ++sub)
#pragma unroll
        for (int i = 0; i < 16; ++i) mx = fmaxf(mx, s[sub][i]);
      mx = fmaxf(mx, shx(mx, 32, lane));
      const bool livelane = !(mx - m_run < -150.f);
      if (__ballot(livelane) != 0ull) {
        const float m_new = fmaxf(m_run, mx);
        const float alpha = fexp2(m_run - m_new);
        m_run = m_new;
        float lsum = 0.f;
#pragma unroll
        for (int sub = 0; sub < 2; ++sub)
#pragma unroll
          for (int i = 0; i < 16; ++i) {
            const float pv = fexp2(s[sub][i] - m_new);
            lsum += pv;
            s[sub][i] = pv;
          }
        l_run = l_run * alpha + lsum;
        if (__ballot(alpha != 1.f) != 0ull) {
#pragma unroll
          for (int dt = 0; dt < 4; ++dt)
#pragma unroll
            for (int i = 0; i < 16; ++i) O[dt][i] *= alpha;
        }
#pragma unroll
        for (int sub = 0; sub < 2; ++sub)
#pragma unroll
          for (int s2 = 0; s2 < 2; ++s2) {
            const bf16x8 pf = pack8(s[sub], s2);
#pragma unroll
            for (int dt = 0; dt < 4; ++dt) {
              const unsigned char* va = Vt + (dt * 32 + r) * 136 + (sub * 32 + s2 * 16 + 4 * h) * 2;
              const uint2 lo = *(const uint2*)va;
              const uint2 hi = *(const uint2*)(va + 16);
              const uint4 vv = make_uint4(lo.x, lo.y, hi.x, hi.y);
              O[dt] = MFMA(__builtin_bit_cast(bf16x8, vv), pf, O[dt]);
            }
          }
      }
    }
    if (more) {
      unsigned char* sn = sb + ((j + 1) & 1) * AT_STAGE;
      *(uint4*)(sn + krow * 272 + kcc * 16) = rk0;
      *(uint4*)(sn + (krow + 32) * 272 + kcc * 16) = rk1;
      *(uint2*)(sn + AT_KBYTES + vrow * 136 + vcc * 16) = make_uint2(rv0.x, rv0.y);
      *(uint2*)(sn + AT_KBYTES + vrow * 136 + vcc * 16 + 8) = make_uint2(rv0.z, rv0.w);
      *(uint2*)(sn + AT_KBYTES + (vrow + 64) * 136 + vcc * 16) = make_uint2(rv1.x, rv1.y);
      *(uint2*)(sn + AT_KBYTES + (vrow + 64) * 136 + vcc * 16 + 8) = make_uint2(rv1.z, rv1.w);
    }
    __syncthreads();
  }
  float* exch = (float*)(smem + AT_BASE);
  float inv = 0.f;
  if (active) { const float lt = l_run + shx(l_run, 32, lane); inv = 1.f / lt; }
  if (active && comp == 1) {
    const float sc = inv * lam;
#pragma unroll
    for (int dt = 0; dt < 4; ++dt)
#pragma unroll
      for (int i = 0; i < 16; ++i) exch[(rg * 64 + dt * 16 + i) * 64 + lane] = O[dt][i] * sc;
  }
  __syncthreads();
  if (active && comp == 0) {
    float ss = 0.f;
#pragma unroll
    for (int dt = 0; dt < 4; ++dt)
#pragma unroll
      for (int i = 0; i < 16; ++i) {
        const float o = O[dt][i] * inv - exch[(rg * 64 + dt * 16 + i) * 64 + lane];
        O[dt][i] = o;
        ss += o * o;
      }
    ss += shx(ss, 32, lane);
    const float rs = rsqrtf(ss * (1.f / 128.f) + LN_EPS) * (1.f - lam_init);
    u16* AN = (u16*)(p.ws + WS_AN) + (size_t)(qtok0 + rg * 32 + r) * 512 + head * 128;
    const float* gw = p.in[17] + l * 512 + head * 128;
#pragma unroll
    for (int dt = 0; dt < 4; ++dt)
#pragma unroll
      for (int g = 0; g < 4; ++g) {
        const int dv = dt * 32 + 8 * g + 4 * h;
        const float4 g4 = *(const float4*)(gw + dv);
        uint2 o;
        o.x = pack2(O[dt][4 * g] * rs * g4.x, O[dt][4 * g + 1] * rs * g4.y);
        o.y = pack2(O[dt][4 * g + 2] * rs * g4.z, O[dt][4 * g + 3] * rs * g4.w);
        *(uint2*)(AN + dv) = o;
      }
  }
}

constexpr int ML_QS = 64;
constexpr int ML_KS = ML_QS + 64 * 272;
constexpr int ML_KT = ML_KS + 64 * 272;
constexpr int ML_VT = ML_KT + 128 * 144;
constexpr int ML_CB = ML_VT + 128 * 144;
constexpr int ML_HB = ML_CB + 128 * 272;
constexpr int ML_SM = ML_HB + 64 * 132 * 4;
static_assert(ML_SM + 528 * 4 <= LDS_BYTES, "lds");

DI void mlstm_item(const Params& p, int l, int b, int head, unsigned char* smem) {
  const int tid = otid(), lane = tid & 63, w = tid >> 6, r = lane & 31, h = lane >> 5;
  const bool prompt = b < 32;
  const int bs = b - 32;
  const int T = prompt ? 2048 : 32;
  const int nch = prompt ? 32 : 1;
  const int L = prompt ? 64 : 32;
  const int tokbase = prompt ? b * 2048 : TOKP + bs * 32;
  const u16* qkT = prompt ? (const u16*)(p.ws + WS_MQKT_P) + (size_t)b * 1024 * 2048 : (const u16*)(p.ws + WS_MQKT_S) + (size_t)bs * 1024 * 32;
  const u16* vTg = prompt ? (const u16*)(p.ws + WS_MVT_P) + (size_t)b * 512 * 2048 : (const u16*)(p.ws + WS_MVT_S) + (size_t)bs * 512 * 32;
  u16* qs = (u16*)(smem + ML_QS);
  u16* ksm = (u16*)(smem + ML_KS);
  u16* kTw = (u16*)(smem + ML_KT);
  u16* vT = (u16*)(smem + ML_VT);
  u16* Cbf = (u16*)(smem + ML_CB);
  float* hbuf = (float*)(smem + ML_HB);
  float* a_s = (float*)(smem + ML_SM);
  float* mx_s = a_s + 64;
  float* ws_s = a_s + 128;
  float* wi_s = a_s + 192;
  float* emt_s = a_s + 256;
  float* nq_s = a_s + 320;
  float* nvec = a_s + 384;
  float* scal = a_s + 512;

  const int vt = w & 3, kt0 = (w >> 2) * 2;
  f32x16 accC[2];
  float m_run = 0.f;
  if (prompt) {
    zero16(accC[0]); zero16(accC[1]);
    if (tid < 128) nvec[tid] = 0.f;
  } else {
    const float* Cs = p.in[6] + ((size_t)(l * 8 + bs) * 4 + head) * 128 * 128;
#pragma unroll
    for (int q = 0; q < 2; ++q)
#pragma unroll
      for (int g = 0; g < 4; ++g) {
        const float4 c4 = *(const float4*)(Cs + (size_t)(vt * 32 + r) * 128 + (kt0 + q) * 32 + 8 * g + 4 * h);
        accC[q][4 * g] = c4.x; accC[q][4 * g + 1] = c4.y; accC[q][4 * g + 2] = c4.z; accC[q][4 * g + 3] = c4.w;
      }
    if (tid < 128) nvec[tid] = p.in[7][((size_t)(l * 8 + bs) * 4 + head) * 128 + tid];
    m_run = p.in[8][(l * 8 + bs) * 4 + head];
  }
#pragma unroll
  for (int q = 0; q < 2; ++q)
#pragma unroll
    for (int g = 0; g < 4; ++g) {
      uint2 o; o.x = pack2(accC[q][4 * g], accC[q][4 * g + 1]); o.y = pack2(accC[q][4 * g + 2], accC[q][4 * g + 3]);
      *(uint2*)(Cbf + (vt * 32 + r) * 136 + (kt0 + q) * 32 + 8 * g + 4 * h) = o;
    }
  const float* gatesp = (const float*)(p.ws + WS_GATES);
  const int vi = w >> 1, ti = w & 1;

  float ig_n = -INFINITY, fg_n = 0.f;
  if (w == 0 && lane < L) {
    const float* gp = gatesp + (size_t)(tokbase + lane) * 8;
    ig_n = gp[head]; fg_n = gp[4 + head];
  }
  for (int c = 0; c < nch; ++c) {
    const int t0 = c * 64;
    if (w == 0) {
      const int t = lane;
      float ig = -INFINITY, lf = 0.f;
      if (t < L) {
        ig = ig_n;
        const float fg = fg_n;
        lf = fminf(fg, 0.f) - log1pf(__expf(-fabsf(fg)));
        if (c + 1 < nch) {
          const float* gp = gatesp + (size_t)(tokbase + t0 + 64 + t) * 8;
          ig_n = gp[head]; fg_n = gp[4 + head];
        }
      }
      float bc = lf;
#pragma unroll
      for (int off = 1; off < 64; off <<= 1) { const float v = shidx(bc, lane - off, lane); if (lane >= off) bc += v; }
      const float a = ig - bc;
      float M = a;
#pragma unroll
      for (int off = 1; off < 64; off <<= 1) { const float v = shidx(M, lane - off, lane); if (lane >= off) M = fmaxf(M, v); }
      const float mx = fmaxf(m_run, M);
      const float bL = shidx(bc, 63, lane);
      const float mxL = shidx(mx, 63, lane);
      a_s[t] = a; mx_s[t] = mx;
      ws_s[t] = __expf(a - mxL);
      wi_s[t] = __expf(m_run - mx);
      emt_s[t] = __expf(-(bc + mx));
      if (lane == 0) scal[1] = __expf(m_run - mxL);
      m_run = bL + mxL;
    }
    const int ch2 = tid >> 1, th = tid & 1;
    const bool isk = ch2 >= 128;
    const int dd = ch2 & 127;
    const int ch = (isk ? 512 : 0) + head * 128 + dd;
    const u16* rp = qkT + (size_t)ch * T + t0 + th * 32;
    float um3 = 0.f, um2 = 0.f, um1 = 0.f;
    const bool ldrow = prompt || th == 0;
    uint4 uu0 = make_uint4(0, 0, 0, 0), uu1 = uu0, uu2 = uu0, uu3 = uu0, vv0 = uu0, vv1 = uu0;
    if (ldrow) { uu0 = *(const uint4*)(rp); uu1 = *(const uint4*)(rp + 8); uu2 = *(const uint4*)(rp + 16); uu3 = *(const uint4*)(rp + 24); }
    {
      const int row = tid >> 3, cc = tid & 7;
      if (prompt || cc < 4) {
        vv0 = *(const uint4*)(vTg + (size_t)(head * 128 + row) * T + t0 + cc * 8);
        vv1 = *(const uint4*)(vTg + (size_t)(head * 128 + row + 64) * T + t0 + cc * 8);
      }
    }
    if (prompt) {
      if (th == 1 || c > 0) {
        const uint2 pv = *(const uint2*)(rp - 4);
        um3 = bfhi(pv.x); um2 = bflo(pv.y); um1 = bfhi(pv.y);
      }
    } else if (th == 0) {
      const float* cvp = p.in[9] + (size_t)(l * 8 + bs) * 3 * 1024 + ch;
      um3 = cvp[0]; um2 = cvp[1024]; um1 = cvp[2048];
    }
    const float cw0 = p.in[14][(l * 4 + 0) * 1024 + ch], cw1 = p.in[14][(l * 4 + 1) * 1024 + ch];
    const float cw2 = p.in[14][(l * 4 + 2) * 1024 + ch], cw3 = p.in[14][(l * 4 + 3) * 1024 + ch];
    const float cb = p.in[15][l * 1024 + ch];
    __syncthreads();
    {
      u16* dstrm = (isk ? ksm : qs) + (th * 32) * 136 + dd;
      const float oscale = isk ? 0.08838834764831845f : 1.f;
#pragma unroll
      for (int i = 0; i < 4; ++i) {
        const uint4 uu = (i == 0) ? uu0 : (i == 1 ? uu1 : (i == 2 ? uu2 : uu3));
        float u[8];
        u[0] = bflo(uu.x); u[1] = bfhi(uu.x); u[2] = bflo(uu.y); u[3] = bfhi(uu.y);
        u[4] = bflo(uu.z); u[5] = bfhi(uu.z); u[6] = bflo(uu.w); u[7] = bfhi(uu.w);
        float y[8];
#pragma unroll
        for (int e = 0; e < 8; ++e) {
          const float x3 = (e >= 3) ? u[e - 3] : (e == 0 ? um3 : (e == 1 ? um2 : um1));
          const float x2 = (e >= 2) ? u[e - 2] : (e == 0 ? um2 : um1);
          const float x1 = (e >= 1) ? u[e - 1] : um1;
          const float yy = cb + cw0 * x3 + cw1 * x2 + cw2 * x1 + cw3 * u[e];
          y[e] = siluf_(yy) * oscale;
        }
        um3 = u[5]; um2 = u[6]; um1 = u[7];
#pragma unroll
        for (int e = 0; e < 8; ++e) dstrm[(i * 8 + e) * 136] = f2bf(y[e]);
        if (isk) {
          const float4 w0 = *(const float4*)(ws_s + th * 32 + i * 8);
          const float4 w1 = *(const float4*)(ws_s + th * 32 + i * 8 + 4);
          uint4 o;
          o.x = pack2(y[0] * w0.x, y[1] * w0.y); o.y = pack2(y[2] * w0.z, y[3] * w0.w);
          o.z = pack2(y[4] * w1.x, y[5] * w1.y); o.w = pack2(y[6] * w1.z, y[7] * w1.w);
          *(uint4*)(kTw + dd * 72 + th * 32 + i * 8) = o;
        }
      }
      {
        const int row = tid >> 3, cc = tid & 7;
        *(uint4*)(vT + row * 72 + cc * 8) = vv0;
        *(uint4*)(vT + (row + 64) * 72 + cc * 8) = vv1;
      }
    }
    __syncthreads();
    {
      const int t = tid >> 3, part = tid & 7;
      const uint4 q0 = *(const uint4*)(qs + t * 136 + part * 16);
      const uint4 q1 = *(const uint4*)(qs + t * 136 + part * 16 + 8);
      const float* nv = nvec + part * 16;
      float s = bflo(q0.x) * nv[0] + bfhi(q0.x) * nv[1] + bflo(q0.y) * nv[2] + bfhi(q0.y) * nv[3]
              + bflo(q0.z) * nv[4] + bfhi(q0.z) * nv[5] + bflo(q0.w) * nv[6] + bfhi(q0.w) * nv[7]
              + bflo(q1.x) * nv[8] + bfhi(q1.x) * nv[9] + bflo(q1.y) * nv[10] + bfhi(q1.y) * nv[11]
              + bflo(q1.z) * nv[12] + bfhi(q1.z) * nv[13] + bflo(q1.w) * nv[14] + bfhi(q1.w) * nv[15];
      s += shx(s, 1, lane); s += shx(s, 2, lane); s += shx(s, 4, lane);
      if (part == 0) nq_s[t] = s;
    }
    f32x16 accS[2], accO;
    zero16(accS[0]); zero16(accS[1]); zero16(accO);
    {
#pragma unroll
      for (int ks = 0; ks < 8; ++ks) {
        const bf16x8 qfr = *(const bf16x8*)(qs + (ti * 32 + r) * 136 + ks * 16 + h * 8);
        const bf16x8 k0 = *(const bf16x8*)(ksm + r * 136 + ks * 16 + h * 8);
        accS[0] = MFMA(k0, qfr, accS[0]);
        if (ti == 1) {
          const bf16x8 k1 = *(const bf16x8*)(ksm + (32 + r) * 136 + ks * 16 + h * 8);
          accS[1] = MFMA(k1, qfr, accS[1]);
        }
        const bf16x8 cf = *(const bf16x8*)(Cbf + (vi * 32 + r) * 136 + ks * 16 + h * 8);
        accO = MFMA(cf, qfr, accO);
      }
    }
    const int tcol = ti * 32 + r;
    const float mxt = mx_s[tcol];
    const float wit = wi_s[tcol];
    float dsum = 0.f;
#pragma unroll
    for (int sub = 0; sub < 2; ++sub) {
      if (sub <= ti) {
#pragma unroll
        for (int g = 0; g < 4; ++g) {
          const float4 a4 = *(const float4*)(a_s + sub * 32 + 8 * g + 4 * h);
          const float av[4] = {a4.x, a4.y, a4.z, a4.w};
#pragma unroll
          for (int e = 0; e < 4; ++e) {
            const int s = sub * 32 + 8 * g + 4 * h + e;
            const float wgt = (s <= tcol) ? __expf(av[e] - mxt) : 0.f;
            const float pv = accS[sub][4 * g + e] * wgt;
            accS[sub][4 * g + e] = pv;
            dsum += pv;
          }
        }
      }
    }
    dsum += shx(dsum, 32, lane);
#pragma unroll
    for (int i = 0; i < 16; ++i) accO[i] *= wit;
#pragma unroll
    for (int sub = 0; sub < 2; ++sub) {
      if (sub <= ti) {
#pragma unroll
        for (int s2 = 0; s2 < 2; ++s2) {
          const bf16x8 pf = pack8(accS[sub], s2);
          const u16* va = vT + (vi * 32 + r) * 72 + sub * 32 + s2 * 16 + 4 * h;
          const uint2 lo = *(const uint2*)va;
          const uint2 hi = *(const uint2*)(va + 8);
          const uint4 vq = make_uint4(lo.x, lo.y, hi.x, hi.y);
          accO = MFMA(__builtin_bit_cast(bf16x8, vq), pf, accO);
        }
      }
    }
    __syncthreads();
    {
      const float den = dsum + wit * nq_s[tcol];
      const float dn = fmaxf(fabsf(den), emt_s[tcol]);
      const float rinv = 1.f / dn;
#pragma unroll
      for (int g = 0; g < 4; ++g)
        *(float4*)(hbuf + tcol * 132 + vi * 32 + 8 * g + 4 * h) =
            make_float4(accO[4 * g] * rinv, accO[4 * g + 1] * rinv, accO[4 * g + 2] * rinv, accO[4 * g + 3] * rinv);
    }
    {
      const float wc = scal[1];
#pragma unroll
      for (int q = 0; q < 2; ++q)
#pragma unroll
        for (int i = 0; i < 16; ++i) accC[q][i] *= wc;
#pragma unroll
      for (int k4 = 0; k4 < 4; ++k4) {
        const bf16x8 vf = *(const bf16x8*)(vT + (vt * 32 + r) * 72 + k4 * 16 + h * 8);
#pragma unroll
        for (int q = 0; q < 2; ++q) {
          const bf16x8 kf = *(const bf16x8*)(kTw + ((kt0 + q) * 32 + r) * 72 + k4 * 16 + h * 8);
          accC[q] = MFMA(kf, vf, accC[q]);
        }
      }
#pragma unroll
      for (int q = 0; q < 2; ++q)
#pragma unroll
        for (int g = 0; g < 4; ++g) {
          uint2 o; o.x = pack2(accC[q][4 * g], accC[q][4 * g + 1]); o.y = pack2(accC[q][4 * g + 2], accC[q][4 * g + 3]);
          *(uint2*)(Cbf + (vt * 32 + r) * 136 + (kt0 + q) * 32 + 8 * g + 4 * h) = o;
        }
      if (tid < 128) {
        float s = 0.f;
#pragma unroll
        for (int i = 0; i < 8; ++i) {
          const uint4 kk = *(const uint4*)(kTw + tid * 72 + i * 8);
          s += bflo(kk.x) + bfhi(kk.x) + bflo(kk.y) + bfhi(kk.y) + bflo(kk.z) + bfhi(kk.z) + bflo(kk.w) + bfhi(kk.w);
        }
        nvec[tid] = wc * nvec[tid] + s;
      }
    }
    __syncthreads();
    {
      const int t = tid >> 3, part = tid & 7;
      float x[16];
#pragma unroll
      for (int i = 0; i < 4; ++i) {
        const float4 f = *(const float4*)(hbuf + t * 132 + part * 16 + i * 4);
        x[i * 4] = f.x; x[i * 4 + 1] = f.y; x[i * 4 + 2] = f.z; x[i * 4 + 3] = f.w;
      }
      float s = 0.f;
#pragma unroll
      for (int i = 0; i < 16; ++i) s += x[i];
      s += shx(s, 1, lane); s += shx(s, 2, lane); s += shx(s, 4, lane);
      const float mean = s * (1.f / 128.f);
      float q = 0.f;
#pragma unroll
      for (int i = 0; i < 16; ++i) { x[i] -= mean; q += x[i] * x[i]; }
      q += shx(q, 1, lane); q += shx(q, 2, lane); q += shx(q, 4, lane);
      const float rstd = rsqrtf(q * (1.f / 128.f) + LN_EPS);
      if (t < L) {
        const size_t tok = (size_t)tokbase + t0 + t;
        const int cbase = head * 128 + part * 16;
        const float* gw = p.in[18] + l * 512 + cbase;
        const u16* mo = (const u16*)(p.ws + WS_MO) + tok * 512 + cbase;
        const uint4 m0 = *(const uint4*)mo;
        const uint4 m1 = *(const uint4*)(mo + 8);
        const float sg[16] = {bflo(m0.x), bfhi(m0.x), bflo(m0.y), bfhi(m0.y), bflo(m0.z), bfhi(m0.z), bflo(m0.w), bfhi(m0.w),
                              bflo(m1.x), bfhi(m1.x), bflo(m1.y), bfhi(m1.y), bflo(m1.z), bfhi(m1.z), bflo(m1.w), bfhi(m1.w)};
        float yv[16];
#pragma unroll
        for (int i = 0; i < 16; ++i) yv[i] = x[i] * rstd * gw[i] * sg[i];
        uint4 o0, o1;
        o0.x = pack2(yv[0], yv[1]); o0.y = pack2(yv[2], yv[3]); o0.z = pack2(yv[4], yv[5]); o0.w = pack2(yv[6], yv[7]);
        o1.x = pack2(yv[8], yv[9]); o1.y = pack2(yv[10], yv[11]); o1.z = pack2(yv[12], yv[13]); o1.w = pack2(yv[14], yv[15]);
        u16* mn = (u16*)(p.ws + WS_MN) + tok * 512 + cbase;
        *(uint4*)mn = o0;
        *(uint4*)(mn + 8) = o1;
      }
    }
  }
  {
    float* oc = p.out + (prompt ? O_CP + ((size_t)(l * 32 + b) * 4 + head) * 16384 : O_CS + ((size_t)(l * 8 + bs) * 4 + head) * 16384);
#pragma unroll
    for (int q = 0; q < 2; ++q)
#pragma unroll
      for (int g = 0; g < 4; ++g)
        *(float4*)(oc + (size_t)(vt * 32 + r) * 128 + (kt0 + q) * 32 + 8 * g + 4 * h) =
            make_float4(accC[q][4 * g], accC[q][4 * g + 1], accC[q][4 * g + 2], accC[q][4 * g + 3]);
    float* on = p.out + (prompt ? O_NP + ((size_t)(l * 32 + b) * 4 + head) * 128 : O_NS + ((size_t)(l * 8 + bs) * 4 + head) * 128);
    if (tid < 128) on[tid] = nvec[tid];
    if (tid == 0) {
      if (prompt) p.out[O_MP + (size_t)(l * 32 + b) * 4 + head] = m_run;
      else p.out[O_MS + (size_t)(l * 8 + bs) * 4 + head] = m_run;
    }
  }
}

DI void phase_mixers(const Params& p, int l, unsigned char* smem) {
  const int tid0 = otid();
  const int lane = tid0 & 63;
  const float* lp = p.in[16] + l * 256;
  float s1 = lp[lane] * lp[64 + lane], s2 = lp[128 + lane] * lp[192 + lane];
  s1 = wave_sum(s1, lane); s2 = wave_sum(s2, lane);
  const float lam_init = 0.8f - 0.6f * expf(-0.3f * (float)l);
  const float lam = expf(s1) - expf(s2) + lam_init;
  int* ctr = (int*)(p.ws + WS_CTR) + l;
  int* sitem = (int*)smem;
  const int N_ML = 160, N_AT = 2048 + 32;
  for (;;) {
    __syncthreads();
    if (tid0 == 0) *sitem = atomicAdd(ctr, 1);
    __syncthreads();
    const int item = *sitem;
    if (item >= N_ML + N_AT) break;
    if (item < N_ML) {
#ifndef NO_ML
      mlstm_item(p, l, item >> 2, item & 3, smem);
#endif
    } else {
#ifndef NO_AT
      const int a = item - N_ML;
      if (a < 2048) {
        const int qt = 15 - (a >> 7), rest = a & 127;
        attn_item(p, l, rest >> 2, rest & 3, qt, lam, lam_init, smem);
      } else {
        const int s = a - 2048;
        attn_item(p, l, 32 + (s >> 2), s & 3, 0, lam, lam_init, smem);
      }
#endif
    }
  }
}

DI void gbar(unsigned* ctl, unsigned& k) {
  __syncthreads();
  ++k;
  if (otid() == 0) {
    __threadfence();
    const unsigned x = blockIdx.x & 7;
    const unsigned gsz = (gridDim.x + 7 - x) >> 3;
    const unsigned ngroups = gridDim.x < 8 ? gridDim.x : 8;
    unsigned* gc = ctl + 64 + x * 32;
    unsigned* gl = ctl + 32;
    const unsigned old = __hip_atomic_fetch_add(gc, 1u, __ATOMIC_RELAXED, __HIP_MEMORY_SCOPE_AGENT);
    if (old + 1 == k * gsz) {
      __threadfence();
      __hip_atomic_fetch_add(gl, 1u, __ATOMIC_RELAXED, __HIP_MEMORY_SCOPE_AGENT);
    }
    while (__hip_atomic_load(gl, __ATOMIC_RELAXED, __HIP_MEMORY_SCOPE_AGENT) < k * ngroups) __builtin_amdgcn_s_sleep(1);
    __threadfence();
  }
  __syncthreads();
}

__global__ void __launch_bounds__(NTHR) fwd_megakernel(Params p) {
  extern __shared__ __attribute__((aligned(16))) unsigned char smem[];
  cg::grid_group grid = cg::this_grid();
#ifndef PH
#define PH 0xffff
#endif
  unsigned* bar = (unsigned*)(p.ws + WS_CTR);
  unsigned epoch = 0;
  if (PH & 1) prologue(p, smem);
  grid.sync();
  if (PH & 1) prologue(p, smem);
  grid.sync();
  if (PH & 2) ln_pass(p, 0, 0, smem);
  gbar(bar, epoch);
#pragma unroll 1
  for (int l = 0; l < 2; ++l) {
    if (PH & 4) phase_in_gate(p, l, smem);
    gbar(bar, epoch);
    if (PH & 8) phase_mixers(p, l, smem);
    gbar(bar, epoch);
    if (PH & 16) phase_mix(p, l, smem);
    gbar(bar, epoch);
    if (PH & 32) phase_res(p, l, 0, smem);
    gbar(bar, epoch);
    if (PH & 64) ln_pass(p, 1, l, smem);
    gbar(bar, epoch);
    if (PH & 128) phase_gu(p, l, smem);
    gbar(bar, epoch);
    if (PH & 256) phase_res(p, l, 1, smem);
    gbar(bar, epoch);
    if (PH & 512) ln_pass(p, 2, l, smem);
    if (l == 0) gbar(bar, epoch);
  }
}

extern "C" void kernel_launch(void* const* d_in, const int* in_sizes, int n_in, void* d_out, int out_size, void* d_ws,
                              size_t ws_size, hipStream_t stream) {
  static int grid_blocks = 0;
  if (!grid_blocks) {
    int dev = 0, cus = 0, per_cu = 0;
    hipGetDevice(&dev);
    hipDeviceGetAttribute(&cus, hipDeviceAttributeMultiprocessorCount, dev);
    if (hipFuncSetAttribute((const void*)fwd_megakernel, hipFuncAttributeMaxDynamicSharedMemorySize, LDS_BYTES) != hipSuccess)
      fprintf(stderr, "kernel_launch: hipFuncSetAttribute failed\n");
    if (hipOccupancyMaxActiveBlocksPerMultiprocessor(&per_cu, (const void*)fwd_megakernel, NTHR, LDS_BYTES) != hipSuccess || per_cu < 1) {
      fprintf(stderr, "kernel_launch: occupancy query gave %d\n", per_cu);
      per_cu = 1;
    }
    (void)hipGetLastError();
    grid_blocks = cus * per_cu;
    if (ws_size < WS_END) fprintf(stderr, "kernel_launch: workspace too small: %zu < %zu\n", ws_size, (size_t)WS_END);
  }
  if (hipMemsetAsync((char*)d_ws + WS_CTR, 0, 4096, stream) != hipSuccess) fprintf(stderr, "kernel_launch: memset failed\n");
  Params p{};
  for (int i = 0; i < 30; ++i) p.in[i] = (const float*)d_in[i];
  p.out = (float*)d_out;
  p.ws = (unsigned char*)d_ws;
  void* args[] = {&p};
  hipError_t e = hipLaunchCooperativeKernel((const void*)fwd_megakernel, dim3(grid_blocks), dim3(NTHR), args, LDS_BYTES, stream);
  if (e != hipSuccess) fprintf(stderr, "cooperative launch failed: %s (grid %d)\n", hipGetErrorString(e), grid_blocks);
}
```

```cpp
#include <hip/hip_runtime.h>
#include <hip/hip_cooperative_groups.h>
#include <cstdio>
namespace cg = cooperative_groups;

#define DI __device__ __forceinline__
typedef unsigned short u16;
using bf16x8 = __attribute__((ext_vector_type(8))) short;
using f32x16 = __attribute__((ext_vector_type(16))) float;
#define MFMA(a, b, c) __builtin_amdgcn_mfma_f32_32x32x16_bf16((a), (b), (c), 0, 0, 0)

constexpr int TOKP = 65536, TOKS = 256, TOK = 65792;
constexpr int NTHR = 512;
constexpr float LN_EPS = 1e-5f;
constexpr float ALPHA = 1.41421356237f;
constexpr float LOG2E = 1.44269504089f;

constexpr size_t WS_WT_IN   = 0;
constexpr size_t WS_WT_GATE = WS_WT_IN + 2ull * 3584 * 1024 * 2;
constexpr size_t WS_WT_BRA  = WS_WT_GATE + 2ull * 2048 * 1024 * 2;
constexpr size_t WS_WT_BRB  = WS_WT_BRA + 2ull * 1024 * 512 * 2;
constexpr size_t WS_WT_O    = WS_WT_BRB + 2ull * 1024 * 512 * 2;
constexpr size_t WS_WT_GU   = WS_WT_O + 2ull * 1024 * 1024 * 2;
constexpr size_t WS_WT_DOWN = WS_WT_GU + 2ull * 5632 * 1024 * 2;
constexpr size_t WS_MOD     = WS_WT_DOWN + 2ull * 1024 * 2816 * 2;
constexpr size_t WS_GATES   = WS_MOD + 2ull * 40 * 6144 * 4;
constexpr size_t WS_CTR     = WS_GATES + (size_t)TOK * 8 * 4;
constexpr size_t WS_STAT    = WS_CTR + 4096;
constexpr size_t WS_KS      = WS_STAT + (size_t)TOK * 8;
constexpr size_t WS_VTS     = WS_KS + 2ull * 8 * 1056 * 512 * 2 + 65536;
constexpr size_t WS_MQKT_S  = WS_VTS + 2ull * 8 * 512 * 1056 * 2 + 65536;
constexpr size_t WS_MVT_S   = WS_MQKT_S + 8ull * 1024 * 32 * 2;
constexpr size_t WS_H       = WS_MVT_S + 8ull * 512 * 32 * 2;
constexpr size_t WS_AN      = WS_H;
constexpr size_t WS_MN      = WS_H + (size_t)TOK * 512 * 2;
constexpr size_t WS_ZQ      = WS_H + (size_t)TOK * 1024 * 2;
constexpr size_t WS_KB      = WS_ZQ + (size_t)TOK * 512 * 2;
constexpr size_t WS_VTP     = WS_KB + (size_t)TOKP * 512 * 2;
constexpr size_t WS_MQKT_P  = WS_VTP + 32ull * 512 * 2048 * 2;
constexpr size_t WS_MVT_P   = WS_MQKT_P + 32ull * 1024 * 2048 * 2;
constexpr size_t WS_MO      = WS_MVT_P + 32ull * 512 * 2048 * 2;
constexpr size_t WS_G       = WS_MO + (size_t)TOK * 512 * 2;
constexpr size_t WS_END     = WS_G + (size_t)TOK * 2048 * 2;
constexpr size_t WS_MIX     = WS_ZQ;
constexpr size_t WS_ACT     = WS_ZQ;

constexpr size_t O_YP  = 0;
constexpr size_t O_YS  = O_YP + (size_t)TOKP * 1024;
constexpr size_t O_KP  = O_YS + (size_t)TOKS * 1024;
constexpr size_t O_VP  = O_KP + 2ull * TOKP * 512;
constexpr size_t O_KSM = O_VP + 2ull * TOKP * 512;
constexpr size_t O_VSM = O_KSM + 2ull * TOKS * 512;
constexpr size_t O_CP  = O_VSM + 2ull * TOKS * 512;
constexpr size_t O_NP  = O_CP + 2ull * 32 * 4 * 128 * 128;
constexpr size_t O_MP  = O_NP + 2ull * 32 * 4 * 128;
constexpr size_t O_CVP = O_MP + 2ull * 32 * 4;
constexpr size_t O_CS  = O_CVP + 2ull * 32 * 3 * 1024;
constexpr size_t O_NS  = O_CS + 2ull * 8 * 4 * 128 * 128;
constexpr size_t O_MS  = O_NS + 2ull * 8 * 4 * 128;
constexpr size_t O_CVS = O_MS + 2ull * 8 * 4;

constexpr int LDS_BYTES = 148480;

struct Params {
  const float* in[30];
  float* out;
  unsigned char* ws;
};


DI float bf2f(unsigned v) { return __uint_as_float(v << 16); }
typedef __bf16 bf16x2_t __attribute__((ext_vector_type(2)));
typedef float f32x2_t __attribute__((ext_vector_type(2)));
DI unsigned pack2(float a, float b) {
  f32x2_t v = {a, b};
  return __builtin_bit_cast(unsigned, __builtin_convertvector(v, bf16x2_t));
}
DI u16 f2bf(float x) { return (u16)(pack2(x, 0.f) & 0xffffu); }
DI float bflo(unsigned v) { return __uint_as_float(v << 16); }
DI float bfhi(unsigned v) { return __uint_as_float(v & 0xffff0000u); }
DI float sigmoidf_(float x) { return __builtin_amdgcn_rcpf(1.f + __expf(-x)); }
DI float siluf_(float x) { return x * __builtin_amdgcn_rcpf(1.f + __expf(-x)); }
DI float fexp2(float x) { return __builtin_amdgcn_exp2f(x); }
DI int otid() { int t = threadIdx.x; asm volatile("" : "+v"(t)); return t; }
DI float shx(float v, int mask, int lane) { return __int_as_float(__builtin_amdgcn_ds_bpermute(((lane ^ mask) & 63) << 2, __float_as_int(v))); }
DI float shidx(float v, int src, int lane) { (void)lane; return __int_as_float(__builtin_amdgcn_ds_bpermute((src & 63) << 2, __float_as_int(v))); }
DI int crow(int i, int h) { return (i & 3) + 8 * (i >> 2) + 4 * h; }
DI bf16x8 pack8(const f32x16& x, int s) {
  uint4 u;
  u.x = pack2(x[8 * s + 0], x[8 * s + 1]); u.y = pack2(x[8 * s + 2], x[8 * s + 3]);
  u.z = pack2(x[8 * s + 4], x[8 * s + 5]); u.w = pack2(x[8 * s + 6], x[8 * s + 7]);
  return __builtin_bit_cast(bf16x8, u);
}
DI void zero16(f32x16& a) {
#pragma unroll
  for (int i = 0; i < 16; ++i) a[i] = 0.f;
}
DI int batch_of_row(int row) { return row < TOKP ? (row >> 11) : 32 + ((row - TOKP) >> 5); }

constexpr int GS_STRIDE = 144;
constexpr int GS_STAGE = 512 * GS_STRIDE;
constexpr int GS_BASE = 64;

DI void gemm_mainloop(f32x16 (&acc)[4][2], const u16* __restrict__ A, int lda, const u16* __restrict__ Wt, int ldw, int K,
                      int m0, int n0, unsigned char* smem) {
  const int tid = otid(), lane = tid & 63, w = tid >> 6;
  const int wm = w >> 2, wn = w & 3, r = lane & 31, h = lane >> 5;
  const int lrow = tid >> 3, lcc = tid & 7;
  const u16* ap = A + (size_t)(m0 + lrow) * lda + lcc * 8;
  const int bn = n0 + 2 * (lrow & 31) + ((lrow >> 5) & 1);
  const u16* bp = Wt + (size_t)bn * ldw + lcc * 8;
  const size_t astep = (size_t)64 * lda, bstep = (size_t)64 * ldw;
  unsigned char* sbase = smem + GS_BASE;
  const int woff = lrow * GS_STRIDE + lcc * 16;
  const int nk = K >> 6;
  uint4 s0, s1, s2, s3, s4, s5, s6, s7, u0, u1, u2, u3, u4, u5, u6, u7;
  int kn = 1;
#define G_ADV() do { const int adv = (kn < nk) ? 64 : 0; ap += adv; bp += adv; ++kn; } while (0)
#define G_ISSUE_A() do { s0 = *(const uint4*)(ap); s1 = *(const uint4*)(ap + astep); s2 = *(const uint4*)(ap + 2 * astep); s3 = *(const uint4*)(ap + 3 * astep); \
    s4 = *(const uint4*)(bp); s5 = *(const uint4*)(bp + bstep); s6 = *(const uint4*)(bp + 2 * bstep); s7 = *(const uint4*)(bp + 3 * bstep); } while (0)
#define G_ISSUE_B() do { u0 = *(const uint4*)(ap); u1 = *(const uint4*)(ap + astep); u2 = *(const uint4*)(ap + 2 * astep); u3 = *(const uint4*)(ap + 3 * astep); \
    u4 = *(const uint4*)(bp); u5 = *(const uint4*)(bp + bstep); u6 = *(const uint4*)(bp + 2 * bstep); u7 = *(const uint4*)(bp + 3 * bstep); } while (0)
#define G_WRITE_A(sn) do { *(uint4*)((sn) + woff) = s0; *(uint4*)((sn) + woff + 64 * GS_STRIDE) = s1; *(uint4*)((sn) + woff + 128 * GS_STRIDE) = s2; \
    *(uint4*)((sn) + woff + 192 * GS_STRIDE) = s3; *(uint4*)((sn) + woff + 256 * GS_STRIDE) = s4; *(uint4*)((sn) + woff + 320 * GS_STRIDE) = s5; \
    *(uint4*)((sn) + woff + 384 * GS_STRIDE) = s6; *(uint4*)((sn) + woff + 448 * GS_STRIDE) = s7; } while (0)
#define G_WRITE_B(sn) do { *(uint4*)((sn) + woff) = u0; *(uint4*)((sn) + woff + 64 * GS_STRIDE) = u1; *(uint4*)((sn) + woff + 128 * GS_STRIDE) = u2; \
    *(uint4*)((sn) + woff + 192 * GS_STRIDE) = u3; *(uint4*)((sn) + woff + 256 * GS_STRIDE) = u4; *(uint4*)((sn) + woff + 320 * GS_STRIDE) = u5; \
    *(uint4*)((sn) + woff + 384 * GS_STRIDE) = u6; *(uint4*)((sn) + woff + 448 * GS_STRIDE) = u7; } while (0)
  const int aoff = (wm * 128 + r) * GS_STRIDE + h * 16;
  const int boff = (256 + wn * 64 + r) * GS_STRIDE + h * 16;
#define G_COMPUTE(st) do { _Pragma("unroll") for (int ks = 0; ks < 4; ++ks) {                                              \
      bf16x8 fa[4], fb[2];                                                                                               \
      _Pragma("unroll") for (int mi = 0; mi < 4; ++mi) fa[mi] = *(const bf16x8*)((st) + aoff + mi * 32 * GS_STRIDE + ks * 32); \
      fb[0] = *(const bf16x8*)((st) + boff + ks * 32);                                                                   \
      fb[1] = *(const bf16x8*)((st) + boff + 32 * GS_STRIDE + ks * 32);                                                  \
      _Pragma("unroll") for (int mi = 0; mi < 4; ++mi) {                                                                 \
        acc[mi][0] = MFMA(fa[mi], fb[0], acc[mi][0]);                                                                    \
        acc[mi][1] = MFMA(fa[mi], fb[1], acc[mi][1]);                                                                    \
      }                                                                                                                  \
      __builtin_amdgcn_sched_barrier(0);                                                                                 \
    } } while (0)
  G_ISSUE_A();
  G_WRITE_A(sbase);
  G_ADV(); G_ISSUE_A();
  G_ADV(); G_ISSUE_B();
  __syncthreads();
  for (int kt = 0; kt < nk; kt += 2) {
    G_WRITE_A(sbase + GS_STAGE);
    G_ADV(); G_ISSUE_A();
    __builtin_amdgcn_sched_barrier(0);
    G_COMPUTE(sbase);
    __syncthreads();
    G_WRITE_B(sbase);
    G_ADV(); G_ISSUE_B();
    __builtin_amdgcn_sched_barrier(0);
    G_COMPUTE(sbase + GS_STAGE);
    __syncthreads();
  }
#undef G_ADV
#undef G_ISSUE_A
#undef G_ISSUE_B
#undef G_WRITE_A
#undef G_WRITE_B
#undef G_COMPUTE
}

DI int rot_unused_(int) { return 0; }
DI bool tile_of(int i, int MT, int NT, int& mt, int& nt) {
  const int per = gridDim.x >> 3;
  const int L = i * (int)gridDim.x + (int)(blockIdx.x & 7) * per + (int)(blockIdx.x >> 3);
  if (L >= MT * NT) return false;
  const int nig = 8 * NT, gid = L / nig, fm = gid * 8, gsz = min(MT - fm, 8), rem = L - gid * nig;
  mt = fm + rem % gsz; nt = rem / gsz;
  return true;
}


template <class PF, class EF>
DI void gemm_stream(int lda, int ldw, int K, unsigned char* smem, PF ptrs, EF epi) {
  const int tid = otid(), lane = tid & 63, w = tid >> 6;
  const int wm = w >> 2, wn = w & 3, r = lane & 31, h = lane >> 5;
  unsigned char* sbase = smem + GS_BASE;
  constexpr int SLOT = 512 * 64;
  const int nh = K >> 5;
  const int c0 = (h ^ ((r >> 2) & 3)) * 16, c1 = c0 ^ 32;
  const int aoff = (wm * 128 + r) * 64, boff = (256 + wn * 64 + r) * 64;
  const int lr16 = lane >> 2, lchunk = (lane & 3) ^ ((lane >> 4) & 3);
  const int wu = __builtin_amdgcn_readfirstlane(w);
  const bool isB = wu >= 4;
  const unsigned goff = isB ? (unsigned)((((wu - 4) * 64 + 2 * lr16) * ldw + lchunk * 8) * 2)
                            : (unsigned)(((wu * 64 + lr16) * lda + lchunk * 8) * 2);
  const unsigned st1 = isB ? (unsigned)(32 * ldw * 2) : (unsigned)(16 * lda * 2);
  const unsigned st2 = isB ? (unsigned)(1 * ldw * 2) : (unsigned)(32 * lda * 2);
#define WAIT_V(n) asm volatile("s_waitcnt vmcnt(" #n ")" ::: "memory")
#define RAWBAR() do { asm volatile("s_waitcnt lgkmcnt(0)" ::: "memory"); __builtin_amdgcn_s_barrier(); asm volatile("" ::: "memory"); } while (0)
#define BAR0() do { asm volatile("" ::: "memory"); __builtin_amdgcn_s_barrier(); asm volatile("" ::: "memory"); } while (0)
#define H_DMA(slotp) do { const char* gsrc_ = (isB ? bp : ap) + goff; unsigned char* ld_ = (slotp) + wu * 4096;            \
    __builtin_amdgcn_global_load_lds((const unsigned*)(gsrc_), (unsigned*)(ld_), 16, 0, 0);                                  \
    __builtin_amdgcn_global_load_lds((const unsigned*)(gsrc_ + st1), (unsigned*)(ld_ + 1024), 16, 0, 0);                     \
    __builtin_amdgcn_global_load_lds((const unsigned*)(gsrc_ + st2), (unsigned*)(ld_ + 2048), 16, 0, 0);                     \
    __builtin_amdgcn_global_load_lds((const unsigned*)(gsrc_ + st2 + st1), (unsigned*)(ld_ + 3072), 16, 0, 0); } while (0)
#define H_READ(sl) do { _Pragma("unroll") for (int mi = 0; mi < 4; ++mi) {                                                   \
      fa[0][mi] = *(const bf16x8*)((sl) + aoff + mi * 2048 + c0); fa[1][mi] = *(const bf16x8*)((sl) + aoff + mi * 2048 + c1); } \
    fb[0][0] = *(const bf16x8*)((sl) + boff + c0); fb[1][0] = *(const bf16x8*)((sl) + boff + c1);                            \
    fb[0][1] = *(const bf16x8*)((sl) + boff + 2048 + c0); fb[1][1] = *(const bf16x8*)((sl) + boff + 2048 + c1); } while (0)
#define H_MMA() do { _Pragma("unroll") for (int ks = 0; ks < 2; ++ks) { _Pragma("unroll") for (int mi = 0; mi < 4; ++mi) {  \
      acc[mi][0] = MFMA(fa[ks][mi], fb[ks][0], acc[mi][0]);                                                       \
      acc[mi][1] = MFMA(fa[ks][mi], fb[ks][1], acc[mi][1]); } } } while (0)
  const char *ap, *bp;
  {
    const u16 *ta, *tb;
    int it0 = 0;
    asm volatile("" : "+s"(it0));
    if (!ptrs(it0, ta, tb)) return;
    ap = (const char*)ta; bp = (const char*)tb;
  }
  H_DMA(sbase); ap += 64; bp += 64;
  H_DMA(sbase + SLOT); ap += 64; bp += 64;
  for (int it = 0;; ++it) {
    f32x16 acc[4][2];
#pragma unroll
    for (int a = 0; a < 4; ++a)
#pragma unroll
      for (int b = 0; b < 2; ++b) zero16(acc[a][b]);
    H_DMA(sbase + 2 * SLOT); ap += 64; bp += 64;
    WAIT_V(4);
    BAR0();
    if (wm == 1) BAR0();
    int rs = 0;
#pragma unroll 1
    for (int hh = 0; hh < nh; ++hh) {
      bf16x8 fa[2][4], fb[2][2];
      const int rem = nh - 2 - hh;
      H_READ(sbase + rs * SLOT);
      if (hh + 3 < nh) { H_DMA(sbase + ((rs + 3) & 3) * SLOT); ap += 64; bp += 64; }
      if (wm == 1) {
        if (rem >= 2) WAIT_V(8); else if (rem == 1) WAIT_V(4); else WAIT_V(0);
      }
      __builtin_amdgcn_sched_barrier(0);
      RAWBAR();
      __builtin_amdgcn_sched_barrier(0);
      H_MMA();
      __builtin_amdgcn_sched_barrier(0);
      if (wm == 0) {
        if (rem >= 2) WAIT_V(8); else if (rem == 1) WAIT_V(4); else WAIT_V(0);
      }
      BAR0();
      rs = (rs + 1) & 3;
    }
    if (wm == 0) BAR0();
    bool more;
    {
      const u16 *ta, *tb;
      more = ptrs(it + 1, ta, tb);
      if (more) {
        ap = (const char*)ta; bp = (const char*)tb;
        H_DMA(sbase); ap += 64; bp += 64;
        H_DMA(sbase + SLOT); ap += 64; bp += 64;
      }
    }
    epi(it, acc);
    if (!more) break;
  }
#undef WAIT_V
#undef RAWBAR
#undef BAR0
#undef H_DMA
#undef H_READ
#undef H_MMA
}

DI int map_row(int maptype, int s) {
  if (maptype == 1) return s < 3072 ? s : (s < 3080 ? -1 : s - 8);
  if (maptype == 2) return s < 2816 ? 2 * s : 2 * (s - 2816) + 1;
  return s;
}
DI void transpose_task(const float* __restrict__ src, int Nsrc, u16* __restrict__ dst, int dld, int maptype, int kt2, int nt,
                       unsigned char* smem) {
  float* tile = (float*)(smem + 64);
  const int tid = otid();
  const int k0 = kt2 * 128, s0 = nt * 64;
  float4 v[4];
#pragma unroll
  for (int i = 0; i < 4; ++i) {
    const int kr = (tid >> 4) + 32 * i, nc = (tid & 15) * 4;
    v[i] = make_float4(0.f, 0.f, 0.f, 0.f);
    if (s0 + nc < Nsrc) v[i] = *(const float4*)(src + (size_t)(k0 + kr) * Nsrc + s0 + nc);
  }
#pragma unroll
  for (int i = 0; i < 4; ++i) {
    const int kr = (tid >> 4) + 32 * i, nc = (tid & 15) * 4;
    tile[kr * 65 + nc + 0] = v[i].x; tile[kr * 65 + nc + 1] = v[i].y; tile[kr * 65 + nc + 2] = v[i].z; tile[kr * 65 + nc + 3] = v[i].w;
  }
  __syncthreads();
  {
    const int n = tid >> 3;
    const int s = s0 + n;
    const int dr = (s < Nsrc) ? map_row(maptype, s) : -1;
    if (dr >= 0) {
#pragma unroll
      for (int j = 0; j < 2; ++j) {
        const int kc = (tid & 7) * 8 + 64 * j;
        uint4 o;
        o.x = pack2(tile[(kc + 0) * 65 + n], tile[(kc + 1) * 65 + n]);
        o.y = pack2(tile[(kc + 2) * 65 + n], tile[(kc + 3) * 65 + n]);
        o.z = pack2(tile[(kc + 4) * 65 + n], tile[(kc + 5) * 65 + n]);
        o.w = pack2(tile[(kc + 6) * 65 + n], tile[(kc + 7) * 65 + n]);
        *(uint4*)(dst + (size_t)dr * dld + k0 + kc) = o;
      }
    }
  }
  __syncthreads();
}

DI void adaln_task(const Params& p, int task, unsigned char* smem) {
  const int bhalf = task & 1, cg_ = (task >> 1) % 96, l = (task >> 1) / 96;
  float* cs = (float*)(smem + 64);
  float* red = (float*)(smem + 64 + 20 * 1024 * 4);
  const int tid = otid();
  const float* cp = p.in[2]; const float* csm = p.in[3];
  for (int idx = tid; idx < 20 * 1024; idx += NTHR) {
    const int bb = idx >> 10, d = idx & 1023, b = bhalf * 20 + bb;
    const float c = b < 32 ? cp[b * 1024 + d] : csm[(b - 32) * 1024 + d];
    cs[idx] = siluf_(c);
  }
  __syncthreads();
  const int dseg = tid >> 6, e = cg_ * 64 + (tid & 63);
  const float* wp = p.in[10] + ((size_t)l * 1024 + dseg * 128) * 6144 + e;
  float acc[20];
#pragma unroll
  for (int i = 0; i < 20; ++i) acc[i] = 0.f;
  for (int d = 0; d < 128; ++d) {
    const float wv = wp[(size_t)d * 6144];
    const float* c0 = cs + dseg * 128 + d;
#pragma unroll
    for (int i = 0; i < 20; ++i) acc[i] += c0[i * 1024] * wv;
  }
#pragma unroll
  for (int i = 0; i < 20; ++i) red[(dseg * 20 + i) * 64 + (tid & 63)] = acc[i];
  __syncthreads();
  float* mod = (float*)(p.ws + WS_MOD);
  for (int idx = tid; idx < 20 * 64; idx += NTHR) {
    const int bb = idx >> 6, ec = idx & 63;
    float s = 0.f;
#pragma unroll
    for (int q = 0; q < 8; ++q) s += red[(q * 20 + bb) * 64 + ec];
    const int ee = cg_ * 64 + ec;
    mod[((size_t)l * 40 + bhalf * 20 + bb) * 6144 + ee] = s + p.in[11][l * 6144 + ee];
  }
  __syncthreads();
}

DI void prologue(const Params& p, unsigned char* smem) {
  const int WT_TASKS_L = 456 + 256 + 64 + 64 + 128 + 704 + 352;
  const int N_WT = 2 * WT_TASKS_L;
  const int N_ADA = 384, N_CK = 512, N_CV = 1024;
  const int total = N_WT + N_ADA + N_CK + N_CV;
  for (int task = blockIdx.x; task < total; task += gridDim.x) {
    if (task < N_WT) {
      const int l = task / WT_TASKS_L; int t = task % WT_TASKS_L;
      if (t < 456) { transpose_task(p.in[12] + (size_t)l * 1024 * 3592, 3592, (u16*)(p.ws + WS_WT_IN) + (size_t)l * 3584 * 1024, 1024, 1, t / 57, t % 57, smem); continue; }
      t -= 456;
      if (t < 256) { transpose_task(p.in[21] + (size_t)l * 1024 * 2048, 2048, (u16*)(p.ws + WS_WT_GATE) + (size_t)l * 2048 * 1024, 1024, 0, t / 32, t % 32, smem); continue; }
      t -= 256;
      if (t < 64) { transpose_task(p.in[19] + (size_t)l * 512 * 1024, 1024, (u16*)(p.ws + WS_WT_BRA) + (size_t)l * 1024 * 512, 512, 0, t / 16, t % 16, smem); continue; }
      t -= 64;
      if (t < 64) { transpose_task(p.in[20] + (size_t)l * 512 * 1024, 1024, (u16*)(p.ws + WS_WT_BRB) + (size_t)l * 1024 * 512, 512, 0, t / 16, t % 16, smem); continue; }
      t -= 64;
      if (t < 128) { transpose_task(p.in[23] + (size_t)l * 1024 * 1024, 1024, (u16*)(p.ws + WS_WT_O) + (size_t)l * 1024 * 1024, 1024, 0, t / 16, t % 16, smem); continue; }
      t -= 128;
      if (t < 704) { transpose_task(p.in[26] + (size_t)l * 1024 * 5632, 5632, (u16*)(p.ws + WS_WT_GU) + (size_t)l * 5632 * 1024, 1024, 2, t / 88, t % 88, smem); continue; }
      t -= 704;
      transpose_task(p.in[27] + (size_t)l * 2816 * 1024, 1024, (u16*)(p.ws + WS_WT_DOWN) + (size_t)l * 1024 * 2816, 2816, 0, t / 16, t % 16, smem);
    } else if (task < N_WT + N_ADA) {
      adaln_task(p, task - N_WT, smem);
    } else if (task < N_WT + N_ADA + N_CK) {
      const int t = task - N_WT - N_ADA;
      const float4* src = (const float4*)p.in[4];
      u16* dst = (u16*)(p.ws + WS_KS);
#pragma unroll
      for (int i = 0; i < 8; ++i) {
        const size_t f4 = (size_t)t * 4096 + i * 512 + otid();
        const float4 v = src[f4];
        const size_t e = f4 * 4;
        const size_t lb = e / (1024 * 512), rem = e % (1024 * 512);
        uint2 o; o.x = pack2(v.x, v.y); o.y = pack2(v.z, v.w);
        *(uint2*)(dst + lb * (1056 * 512) + rem) = o;
      }
    } else {
      const int t = task - N_WT - N_ADA - N_CK;
      const int lb = t >> 6, tt = t & 63;
      transpose_task(p.in[5] + (size_t)lb * 1024 * 512, 512, (u16*)(p.ws + WS_VTS) + (size_t)lb * 512 * 1056, 1056, 0, tt >> 3, tt & 7, smem);
    }
  }
}

DI float wave_sum(float v, int lane) {
  (void)lane;
  int x = __float_as_int(v);
  v += __int_as_float(__builtin_amdgcn_update_dpp(0, x, 0xB1, 0xF, 0xF, true));
  x = __float_as_int(v);
  v += __int_as_float(__builtin_amdgcn_update_dpp(0, x, 0x4E, 0xF, 0xF, true));
  x = __float_as_int(v);
  v += __int_as_float(__builtin_amdgcn_update_dpp(0, x, 0x141, 0xF, 0xF, true));
  x = __float_as_int(v);
  v += __int_as_float(__builtin_amdgcn_update_dpp(0, x, 0x140, 0xF, 0xF, true));
  x = __float_as_int(v);
  const float r0 = __int_as_float(__builtin_amdgcn_readlane(x, 0)), r1 = __int_as_float(__builtin_amdgcn_readlane(x, 16));
  const float r2 = __int_as_float(__builtin_amdgcn_readlane(x, 32)), r3 = __int_as_float(__builtin_amdgcn_readlane(x, 48));
  return (r0 + r1) + (r2 + r3);
}
DI void ln_pass(const Params& p, int mode, int l, unsigned char* smem) {
  const int tid = otid();
  const int lane = tid & 63, w = tid >> 6;
  const bool first = mode != 0;
  const bool second = (mode != 2) || (l + 1 < 2);
  const bool gates = (mode == 0) || (mode == 2 && l + 1 < 2);
  const int lm = (mode == 2) ? l + 1 : l;
  const int shi = (mode == 1) ? 3 : 0;
  const float* lng = (mode == 1) ? p.in[24] + l * 1024 : p.in[28] + l * 1024;
  const float* lnb = (mode == 1) ? p.in[25] + l * 1024 : p.in[29] + l * 1024;
  const float* mod = (const float*)(p.ws + WS_MOD);
  u16* H = (u16*)(p.ws + WS_H);
  float* gout = (float*)(p.ws + WS_GATES);
  float* wl = (float*)(smem + 64);
  float bif[8];
  if (gates) {
    const float* wi = p.in[12] + (size_t)lm * 1024 * 3592 + 3072;
    for (int idx = tid; idx < 8192; idx += NTHR) {
      const int c = idx >> 3, j = idx & 7;
      wl[j * 1024 + c] = wi[(size_t)c * 3592 + j];
    }
#pragma unroll
    for (int j = 0; j < 8; ++j) bif[j] = p.in[13][lm * 8 + j];
  }
  __syncthreads();
  float lg[16], lb[16];
  if (first) {
#pragma unroll
    for (int i = 0; i < 4; ++i) {
      const float4 g = *(const float4*)(lng + i * 256 + lane * 4);
      const float4 b = *(const float4*)(lnb + i * 256 + lane * 4);
      lg[i * 4] = g.x; lg[i * 4 + 1] = g.y; lg[i * 4 + 2] = g.z; lg[i * 4 + 3] = g.w;
      lb[i * 4] = b.x; lb[i * 4 + 1] = b.y; lb[i * 4 + 2] = b.z; lb[i * 4 + 3] = b.w;
    }
  }
  const bool write_x = (mode == 2 && l == 1);
  float* stats = (float*)(p.ws + WS_STAT);
  auto process = [&](int row, float (&v)[16], const float (&msh)[16], const float (&msc)[16]) {
    float* xr = p.out + (size_t)row * 1024;
    if (first) {
      float s = 0.f;
#pragma unroll
      for (int i = 0; i < 16; ++i) s += v[i];
      const float mean = wave_sum(s, lane) * (1.f / 1024.f);
      float q = 0.f;
#pragma unroll
      for (int i = 0; i < 16; ++i) { v[i] -= mean; q += v[i] * v[i]; }
      const float rstd = rsqrtf(wave_sum(q, lane) * (1.f / 1024.f) + LN_EPS);
#pragma unroll
      for (int i = 0; i < 4; ++i) {
#pragma unroll
        for (int e = 0; e < 4; ++e) v[i * 4 + e] = v[i * 4 + e] * rstd * lg[i * 4 + e] + lb[i * 4 + e];
        if (write_x) *(float4*)(xr + i * 256 + lane * 4) = make_float4(v[i * 4 + 0], v[i * 4 + 1], v[i * 4 + 2], v[i * 4 + 3]);
      }
      if (!write_x && lane == 0) *(float2*)(stats + (size_t)row * 2) = make_float2(mean, rstd);
    }
    if (second) {
      float s = 0.f;
#pragma unroll
      for (int i = 0; i < 16; ++i) s += v[i];
      const float mean = wave_sum(s, lane) * (1.f / 1024.f);
      float q = 0.f;
#pragma unroll
      for (int i = 0; i < 16; ++i) { v[i] -= mean; q += v[i] * v[i]; }
      const float rstd = rsqrtf(wave_sum(q, lane) * (1.f / 1024.f) + LN_EPS);
#pragma unroll
      for (int i = 0; i < 4; ++i) {
#pragma unroll
        for (int e = 0; e < 4; ++e) v[i * 4 + e] = v[i * 4 + e] * rstd * msc[i * 4 + e] + msh[i * 4 + e];
        uint2 o; o.x = pack2(v[i * 4 + 0], v[i * 4 + 1]); o.y = pack2(v[i * 4 + 2], v[i * 4 + 3]);
        *(uint2*)(H + (size_t)row * 1024 + i * 256 + lane * 4) = o;
      }
      if (gates) {
        float g8[8];
#pragma unroll
        for (int j = 0; j < 8; ++j) {
          float s2 = 0.f;
#pragma unroll
          for (int i = 0; i < 4; ++i) {
            const float4 wv = *(const float4*)(wl + j * 1024 + i * 256 + lane * 4);
            s2 += v[i * 4] * wv.x + v[i * 4 + 1] * wv.y + v[i * 4 + 2] * wv.z + v[i * 4 + 3] * wv.w;
          }
          g8[j] = wave_sum(s2, lane) + bif[j];
        }
        if (lane == 0) {
          *(float4*)(gout + (size_t)row * 8) = make_float4(g8[0], g8[1], g8[2], g8[3]);
          *(float4*)(gout + (size_t)row * 8 + 4) = make_float4(g8[4], g8[5], g8[6], g8[7]);
        }
      }
    }
  };
  auto load_mod = [&](int row, float (&msh)[16], float (&msc)[16]) {
    const float* mb = mod + ((size_t)lm * 40 + batch_of_row(row)) * 6144;
#pragma unroll
    for (int i = 0; i < 4; ++i) {
      const float4 sh = *(const float4*)(mb + shi * 1024 + i * 256 + lane * 4);
      const float4 sc = *(const float4*)(mb + (shi + 1) * 1024 + i * 256 + lane * 4);
      msh[i * 4] = sh.x; msh[i * 4 + 1] = sh.y; msh[i * 4 + 2] = sh.z; msh[i * 4 + 3] = sh.w;
      msc[i * 4] = 1.f + sc.x; msc[i * 4 + 1] = 1.f + sc.y; msc[i * 4 + 2] = 1.f + sc.z; msc[i * 4 + 3] = 1.f + sc.w;
    }
  };
  for (int chunk = blockIdx.x * 8 + w; chunk < TOKP / 32; chunk += gridDim.x * 8) {
    const int row0 = chunk * 32;
    float msh[16], msc[16];
    if (second) load_mod(row0, msh, msc);
    const float* src0 = (mode == 0) ? p.in[0] + (size_t)row0 * 1024 : p.out + (size_t)row0 * 1024;
    float4 nx0 = *(const float4*)(src0 + lane * 4), nx1 = *(const float4*)(src0 + 256 + lane * 4);
    float4 nx2 = *(const float4*)(src0 + 512 + lane * 4), nx3 = *(const float4*)(src0 + 768 + lane * 4);
    for (int ri = 0; ri < 32; ++ri) {
      float v[16];
      v[0] = nx0.x; v[1] = nx0.y; v[2] = nx0.z; v[3] = nx0.w; v[4] = nx1.x; v[5] = nx1.y; v[6] = nx1.z; v[7] = nx1.w;
      v[8] = nx2.x; v[9] = nx2.y; v[10] = nx2.z; v[11] = nx2.w; v[12] = nx3.x; v[13] = nx3.y; v[14] = nx3.z; v[15] = nx3.w;
      {
        const float* sn = src0 + (size_t)(ri < 31 ? ri + 1 : 31) * 1024;
        nx0 = *(const float4*)(sn + lane * 4); nx1 = *(const float4*)(sn + 256 + lane * 4);
        nx2 = *(const float4*)(sn + 512 + lane * 4); nx3 = *(const float4*)(sn + 768 + lane * 4);
      }
      __builtin_amdgcn_sched_barrier(0);
      process(row0 + ri, v, msh, msc);
    }
  }
  if (w == 0) {
    for (int row = TOKP + blockIdx.x; row < TOK; row += gridDim.x) {
      float msh[16], msc[16];
      if (second) load_mod(row, msh, msc);
      const float* src = (mode == 0) ? p.in[1] + (size_t)(row - TOKP) * 1024 : p.out + (size_t)row * 1024;
      float v[16];
#pragma unroll
      for (int i = 0; i < 4; ++i) {
        const float4 t = *(const float4*)(src + i * 256 + lane * 4);
        v[i * 4 + 0] = t.x; v[i * 4 + 1] = t.y; v[i * 4 + 2] = t.z; v[i * 4 + 3] = t.w;
      }
      process(row, v, msh, msc);
    }
  }
}


DI void micro_partial(f32x16& acc, const u16* A, int lda, const u16* Wt, int ldw, int K, int row0, int n0, int w, int r, int h) {
  const int kb = w * (K >> 3), n16 = K >> 7;
  const u16* ap = A + (size_t)(row0 + r) * lda + kb + h * 8;
  const u16* bp = Wt + (size_t)(n0 + r) * ldw + kb + h * 8;
#pragma unroll 4
  for (int k = 0; k < n16; ++k) {
    const bf16x8 a = *(const bf16x8*)(ap + k * 16);
    const bf16x8 b = *(const bf16x8*)(bp + k * 16);
    acc = MFMA(a, b, acc);
  }
}
DI void micro_reduce_store(const f32x16& acc, float* red, int w, int lane) {
#pragma unroll
  for (int i = 0; i < 16; ++i) red[(w * 16 + i) * 64 + lane] = acc[i];
}
DI float micro_sum(const float* red, int i, int lane) {
  float s = 0.f;
#pragma unroll
  for (int q = 0; q < 8; ++q) s += red[(q * 16 + i) * 64 + lane];
  return s;
}

constexpr int EP_LD = 264;
constexpr int EP_LDT = 68;
DI void zero_acc(f32x16 (&acc)[4][2]) {
#pragma unroll
  for (int a = 0; a < 4; ++a)
#pragma unroll
    for (int b = 0; b < 2; ++b) zero16(acc[a][b]);
}
DI void stage_rm(const f32x16& a0, const f32x16& a1, float* stg, int wm, int wn, int r, int h) {
#pragma unroll
  for (int i = 0; i < 16; ++i) *(float2*)(stg + (wm * 32 + crow(i, h)) * EP_LD + wn * 64 + 2 * r) = make_float2(a0[i], a1[i]);
}
DI void stage_tr(const f32x16& a0, const f32x16& a1, float* stg, int wm, int wn, int r, int h) {
#pragma unroll
  for (int g = 0; g < 4; ++g) {
    *(float4*)(stg + (wn * 64 + 2 * r) * EP_LDT + wm * 32 + 8 * g + 4 * h) = make_float4(a0[4 * g], a0[4 * g + 1], a0[4 * g + 2], a0[4 * g + 3]);
    *(float4*)(stg + (wn * 64 + 2 * r + 1) * EP_LDT + wm * 32 + 8 * g + 4 * h) = make_float4(a1[4 * g], a1[4 * g + 1], a1[4 * g + 2], a1[4 * g + 3]);
  }
}
DI int grow_of(int m0, int mi, int lr) { return m0 + (lr >> 5) * 128 + mi * 32 + (lr & 31); }
DI uint4 pack8f(const float4& a, const float4& b) {
  uint4 o; o.x = pack2(a.x, a.y); o.y = pack2(a.z, a.w); o.z = pack2(b.x, b.y); o.w = pack2(b.z, b.w); return o;
}

DI void write_tr(const Params& p, int l, int m0, int mi, const float* stg, int tid, int which, int chbase) {
  const bool prompt = m0 < TOKP;
#pragma unroll 1
  for (int q = 0; q < 4; ++q) {
    const int cid = q * NTHR + tid, ch = cid >> 3, tc = cid & 7;
    const float4 v0 = *(const float4*)(stg + ch * EP_LDT + tc * 8);
    const float4 v1 = *(const float4*)(stg + ch * EP_LDT + tc * 8 + 4);
    const int row0 = grow_of(m0, mi, tc * 8);
    const int chg = chbase + ch;
    u16* d;
    if (prompt) {
      const int b = row0 >> 11, t = row0 & 2047;
      if (which == 0) d = (u16*)(p.ws + WS_VTP) + ((size_t)b * 512 + chg) * 2048 + t;
      else if (which == 1) d = (u16*)(p.ws + WS_MQKT_P) + ((size_t)b * 1024 + chg) * 2048 + t;
      else d = (u16*)(p.ws + WS_MVT_P) + ((size_t)b * 512 + chg) * 2048 + t;
    } else {
      const int rs = row0 - TOKP, bs = rs >> 5, t = rs & 31;
      if (which == 0) d = (u16*)(p.ws + WS_VTS) + ((size_t)(l * 8 + bs) * 512 + chg) * 1056 + 1024 + t;
      else if (which == 1) d = (u16*)(p.ws + WS_MQKT_S) + ((size_t)bs * 1024 + chg) * 32 + t;
      else d = (u16*)(p.ws + WS_MVT_S) + ((size_t)bs * 512 + chg) * 32 + t;
    }
    *(uint4*)d = pack8f(v0, v1);
  }
}

DI void epi_in(const Params& p, int l, int m0, int n0, f32x16 (&acc)[4][2], unsigned char* smem) {
  const int tid = otid(), lane = tid & 63, w = tid >> 6;
  const int wm = w >> 2, wn = w & 3, r = lane & 31, h = lane >> 5;
  const bool prompt = m0 < TOKP;
  float* stg = (float*)(smem + GS_BASE + GS_STAGE);
  const int seg = n0 < 512 ? 0 : (n0 < 1024 ? 1 : (n0 < 1536 ? 2 : (n0 < 2560 ? 3 : (n0 < 3072 ? 4 : 5))));
  if (seg == 3) {
    const int ch = n0 - 1536 + wn * 64 + 2 * r;
#pragma unroll
    for (int mi = 0; mi < 4; ++mi) {
      const int rb = m0 + wm * 128 + mi * 32 + 4 * h;
#pragma unroll
      for (int i = 0; i < 16; ++i) {
        const int row = rb + (i & 3) + 8 * (i >> 2);
        if (prompt) {
          const int tt = row & 2047;
          if (tt >= 2045) *(float2*)(p.out + O_CVP + ((size_t)(l * 32 + (row >> 11)) * 3 + (tt - 2045)) * 1024 + ch) = make_float2(acc[mi][0][i], acc[mi][1][i]);
        } else {
          const int rs = row - TOKP, tt = rs & 31;
          if (tt >= 29) *(float2*)(p.out + O_CVS + ((size_t)(l * 8 + (rs >> 5)) * 3 + (tt - 29)) * 1024 + ch) = make_float2(acc[mi][0][i], acc[mi][1][i]);
        }
      }
    }
  }
#pragma unroll
  for (int mi = 0; mi < 4; ++mi) {
    if (seg == 0 || seg == 1 || seg == 2 || seg == 5) {
      __syncthreads();
      stage_rm(acc[mi][0], acc[mi][1], stg, wm, wn, r, h);
      __syncthreads();
#pragma unroll 1
      for (int q = 0; q < 4; ++q) {
        const int cid = q * NTHR + tid, lr = cid >> 5, c8 = (cid & 31) * 8;
        const float4 v0 = *(const float4*)(stg + lr * EP_LD + c8);
        const float4 v1 = *(const float4*)(stg + lr * EP_LD + c8 + 4);
        const int row = grow_of(m0, mi, lr);
        const int n = n0 + c8;
        if (seg == 0) {
          *(uint4*)((u16*)(p.ws + WS_ZQ) + (size_t)row * 512 + n) = pack8f(v0, v1);
        } else if (seg == 5) {
          const float4 s0 = make_float4(sigmoidf_(v0.x), sigmoidf_(v0.y), sigmoidf_(v0.z), sigmoidf_(v0.w));
          const float4 s1 = make_float4(sigmoidf_(v1.x), sigmoidf_(v1.y), sigmoidf_(v1.z), sigmoidf_(v1.w));
          *(uint4*)((u16*)(p.ws + WS_MO) + (size_t)row * 512 + (n - 3072)) = pack8f(s0, s1);
        } else {
          const bool isk = seg == 1;
          const int nn = n - (isk ? 512 : 1024);
          float* of = p.out + (isk ? (prompt ? O_KP : O_KSM) : (prompt ? O_VP : O_VSM));
          const size_t orow = prompt ? ((size_t)l * TOKP + row) : ((size_t)l * TOKS + (row - TOKP));
          *(float4*)(of + orow * 512 + nn) = v0;
          *(float4*)(of + orow * 512 + nn + 4) = v1;
          if (isk) {
            u16* kd;
            if (prompt) kd = (u16*)(p.ws + WS_KB) + (size_t)row * 512 + nn;
            else { const int rs = row - TOKP; kd = (u16*)(p.ws + WS_KS) + ((size_t)(l * 8 + (rs >> 5)) * 1056 + 1024 + (rs & 31)) * 512 + nn; }
            *(uint4*)kd = pack8f(v0, v1);
          }
        }
      }
    }
    if (seg == 2 || seg == 3 || seg == 4) {
      __syncthreads();
      stage_tr(acc[mi][0], acc[mi][1], stg, wm, wn, r, h);
      __syncthreads();
      write_tr(p, l, m0, mi, stg, tid, seg == 2 ? 0 : (seg == 3 ? 1 : 2), n0 - (seg == 2 ? 1024 : (seg == 3 ? 1536 : 2560)));
    }
  }
  __syncthreads();
}

DI void phase_in_gate(const Params& p, int l, unsigned char* smem) {
  const int tid = otid(), lane = tid & 63, w = tid >> 6;
  const int wm = w >> 2, wn = w & 3, r = lane & 31, h = lane >> 5;
  const u16* H = (const u16*)(p.ws + WS_H);
  const u16* Win = (const u16*)(p.ws + WS_WT_IN) + (size_t)l * 3584 * 1024;
  const u16* Wg = (const u16*)(p.ws + WS_WT_GATE) + (size_t)l * 2048 * 1024;
  float* stg = (float*)(smem + GS_BASE + GS_STAGE);
  const int NT = 14 + 8, MT = 257;
  auto ptrs = [&](int it, const u16*& ap, const u16*& bp) -> bool {
    int mt, nt;
    if (!tile_of(it, MT, NT, mt, nt)) return false;
    ap = H + (size_t)(mt * 256) * 1024;
    bp = (nt < 14 ? Win + (size_t)(nt * 256) * 1024 : Wg + (size_t)((nt - 14) * 256) * 1024);
    return true;
  };
  auto epi = [&](int it, f32x16 (&acc)[4][2]) {
    const int tid = otid(), lane = tid & 63, w = tid >> 6;
    const int wm = w >> 2, wn = w & 3, r = lane & 31, h = lane >> 5;
    int mt, nt;
    tile_of(it, MT, NT, mt, nt);
    const int m0 = mt * 256;
    if (nt < 14) {
      epi_in(p, l, m0, nt * 256, acc, smem);
    } else {
      const int n0 = (nt - 14) * 256;
      u16* G = (u16*)(p.ws + WS_G);
#pragma unroll
      for (int mi = 0; mi < 4; ++mi) {
        __syncthreads();
        stage_rm(acc[mi][0], acc[mi][1], stg, wm, wn, r, h);
        __syncthreads();
#pragma unroll 1
        for (int q = 0; q < 4; ++q) {
          const int cid = q * NTHR + tid, lr = cid >> 5, c8 = (cid & 31) * 8;
          float4 v0 = *(const float4*)(stg + lr * EP_LD + c8);
          float4 v1 = *(const float4*)(stg + lr * EP_LD + c8 + 4);
          const int row = grow_of(m0, mi, lr), n = n0 + c8;
          const float4 b0 = *(const float4*)(p.in[22] + l * 2048 + n);
          const float4 b1 = *(const float4*)(p.in[22] + l * 2048 + n + 4);
          v0 = make_float4(sigmoidf_(v0.x + b0.x), sigmoidf_(v0.y + b0.y), sigmoidf_(v0.z + b0.z), sigmoidf_(v0.w + b0.w));
          v1 = make_float4(sigmoidf_(v1.x + b1.x), sigmoidf_(v1.y + b1.y), sigmoidf_(v1.z + b1.z), sigmoidf_(v1.w + b1.w));
          *(uint4*)(G + (size_t)row * 2048 + n) = pack8f(v0, v1);
        }
      }
      __syncthreads();
    }
  };
  gemm_stream(1024, 1024, 1024, smem, ptrs, epi);
}

DI void phase_mix(const Params& p, int l, unsigned char* smem) {
  const int tid = otid(), lane = tid & 63, w = tid >> 6;
  const int wm = w >> 2, wn = w & 3, r = lane & 31, h = lane >> 5;
  const u16* G = (const u16*)(p.ws + WS_G);
  u16* MIX = (u16*)(p.ws + WS_MIX);
  float* stg = (float*)(smem + GS_BASE + GS_STAGE);
  const int NT = 4, MT = 256;
  auto ptrs = [&](int it, const u16*& ap, const u16*& bp) -> bool {
    int mt, nt;
    if (!tile_of(it >> 1, MT, NT, mt, nt)) return false;
    const int half = it & 1;
    ap = (const u16*)(p.ws + (half ? WS_MN : WS_AN)) + (size_t)(mt * 256) * 512;
    bp = (const u16*)(p.ws + (half ? WS_WT_BRB : WS_WT_BRA)) + (size_t)l * 1024 * 512 + (size_t)(nt * 256) * 512;
    return true;
  };
  auto epi = [&](int it, f32x16 (&acc)[4][2]) {
    const int tid = otid(), lane = tid & 63, w = tid >> 6;
    const int wm = w >> 2, wn = w & 3, r = lane & 31, h = lane >> 5;
    int mt, nt;
    tile_of(it >> 1, MT, NT, mt, nt);
    const int half = it & 1;
    const int m0 = mt * 256, n0 = nt * 256;
#pragma unroll
    for (int mi = 0; mi < 4; ++mi) {
      __syncthreads();
      stage_rm(acc[mi][0], acc[mi][1], stg, wm, wn, r, h);
      __syncthreads();
#pragma unroll 1
      for (int q = 0; q < 4; ++q) {
        const int cid = q * NTHR + tid, lr = cid >> 5, c8 = (cid & 31) * 8;
        const float4 v0 = *(const float4*)(stg + lr * EP_LD + c8);
        const float4 v1 = *(const float4*)(stg + lr * EP_LD + c8 + 4);
        const int row = grow_of(m0, mi, lr), n = n0 + c8;
        const uint4 g = *(const uint4*)(G + (size_t)row * 2048 + half * 1024 + n);
        float4 o0 = make_float4(bflo(g.x) * v0.x, bfhi(g.x) * v0.y, bflo(g.y) * v0.z, bfhi(g.y) * v0.w);
        float4 o1 = make_float4(bflo(g.z) * v1.x, bfhi(g.z) * v1.y, bflo(g.w) * v1.z, bfhi(g.w) * v1.w);
        uint4* mp = (uint4*)(MIX + (size_t)row * 1024 + n);
        if (half) {
          const uint4 pr = *mp;
          o0.x += bflo(pr.x); o0.y += bfhi(pr.x); o0.z += bflo(pr.y); o0.w += bfhi(pr.y);
          o1.x += bflo(pr.z); o1.y += bfhi(pr.z); o1.z += bflo(pr.w); o1.w += bfhi(pr.w);
        }
        *mp = pack8f(o0, o1);
      }
    }
    __syncthreads();
  };
  gemm_stream(512, 512, 512, smem, ptrs, epi);
  {
    const int tid2 = otid(), lane = tid2 & 63, w = tid2 >> 6, r = lane & 31, h = lane >> 5;
    float* red = (float*)(smem + 64);
    for (int mtile = blockIdx.x; mtile < 256; mtile += gridDim.x) {
      const int row0 = TOKP + (mtile >> 5) * 32, n0 = (mtile & 31) * 32;
      f32x16 pa, pb;
      zero16(pa); zero16(pb);
      micro_partial(pa, (const u16*)(p.ws + WS_AN), 512, (const u16*)(p.ws + WS_WT_BRA) + (size_t)l * 1024 * 512, 512, 512, row0, n0, w, r, h);
      micro_partial(pb, (const u16*)(p.ws + WS_MN), 512, (const u16*)(p.ws + WS_WT_BRB) + (size_t)l * 1024 * 512, 512, 512, row0, n0, w, r, h);
      __syncthreads();
      micro_reduce_store(pa, red, w, lane);
      micro_reduce_store(pb, red + 8192, w, lane);
      __syncthreads();
#pragma unroll
      for (int q = 0; q < 2; ++q) {
        const int i = w + 8 * q;
        const float sa = micro_sum(red, i, lane), sb = micro_sum(red + 8192, i, lane);
        const int row = row0 + crow(i, h), n = n0 + r;
        const float ga = bf2f(G[(size_t)row * 2048 + n]), gb = bf2f(G[(size_t)row * 2048 + 1024 + n]);
        MIX[(size_t)row * 1024 + n] = f2bf(ga * sa + gb * sb);
      }
    }
    __syncthreads();
  }
}

DI void phase_res(const Params& p, int l, int mode, unsigned char* smem) {
  const int tid = otid(), lane = tid & 63, w = tid >> 6;
  const int wm = w >> 2, wn = w & 3, r = lane & 31, h = lane >> 5;
  const float* mod = (const float*)(p.ws + WS_MOD);
  float* stg = (float*)(smem + GS_BASE + GS_STAGE);
  const int NT = 4, MT = 256;
  const int K = (mode == 0) ? 1024 : 2816;
  const u16* Ab = (const u16*)(p.ws + (mode == 0 ? WS_MIX : WS_ACT));
  const u16* Wb = (mode == 0) ? (const u16*)(p.ws + WS_WT_O) + (size_t)l * 1024 * 1024 : (const u16*)(p.ws + WS_WT_DOWN) + (size_t)l * 1024 * 2816;
  const int gi = (mode == 0) ? 2 : 5;
  const float* stats = (const float*)(p.ws + WS_STAT);
  const float* rlg = (mode == 1) ? p.in[24] + l * 1024 : p.in[28] + (l > 0 ? l - 1 : 0) * 1024;
  const float* rlb = (mode == 1) ? p.in[25] + l * 1024 : p.in[29] + (l > 0 ? l - 1 : 0) * 1024;
  auto ptrs = [&](int it, const u16*& ap, const u16*& bp) -> bool {
    int mt, nt;
    if (!tile_of(it, MT, NT, mt, nt)) return false;
    ap = Ab + (size_t)(mt * 256) * K;
    bp = Wb + (size_t)(nt * 256) * K;
    return true;
  };
  auto epi = [&](int it, f32x16 (&acc)[4][2]) {
    const int tid = otid(), lane = tid & 63, w = tid >> 6;
    const int wm = w >> 2, wn = w & 3, r = lane & 31, h = lane >> 5;
    int mt, nt;
    tile_of(it, MT, NT, mt, nt);
    const int m0 = mt * 256, n0 = nt * 256;
#pragma unroll
    for (int mi = 0; mi < 4; ++mi) {
      __syncthreads();
      stage_rm(acc[mi][0], acc[mi][1], stg, wm, wn, r, h);
      __syncthreads();
#pragma unroll 1
      for (int q = 0; q < 8; ++q) {
        const int cid = q * NTHR + tid, lr = cid >> 6, c4 = (cid & 63) * 4;
        const float4 v = *(const float4*)(stg + lr * EP_LD + c4);
        const int row = grow_of(m0, mi, lr), n = n0 + c4;
        const int b = batch_of_row(row);
        const float4 gg = *(const float4*)(mod + ((size_t)l * 40 + b) * 6144 + gi * 1024 + n);
        float* xr = p.out + (size_t)row * 1024 + n;
        const float* xs = (mode == 0 && l == 0) ? (row < TOKP ? p.in[0] + (size_t)row * 1024 + n : p.in[1] + (size_t)(row - TOKP) * 1024 + n) : xr;
        float4 xv = *(const float4*)xs;
        if (!(mode == 0 && l == 0)) {
          const float2 st = *(const float2*)(stats + (size_t)row * 2);
          const float4 g4 = *(const float4*)(rlg + n), b4 = *(const float4*)(rlb + n);
          xv.x = (xv.x - st.x) * st.y * g4.x + b4.x; xv.y = (xv.y - st.x) * st.y * g4.y + b4.y;
          xv.z = (xv.z - st.x) * st.y * g4.z + b4.z; xv.w = (xv.w - st.x) * st.y * g4.w + b4.w;
        }
        *(float4*)xr = make_float4(ALPHA * xv.x + (1.f + gg.x) * v.x, ALPHA * xv.y + (1.f + gg.y) * v.y,
                                   ALPHA * xv.z + (1.f + gg.z) * v.z, ALPHA * xv.w + (1.f + gg.w) * v.w);
      }
    }
    __syncthreads();
  };
  gemm_stream(K, K, K, smem, ptrs, epi);
  {
    const int tid2 = otid(), lane = tid2 & 63, w = tid2 >> 6, r = lane & 31, h = lane >> 5;
    float* red = (float*)(smem + 64);
    for (int mtile = blockIdx.x; mtile < 256; mtile += gridDim.x) {
      const int row0 = TOKP + (mtile >> 5) * 32, n0 = (mtile & 31) * 32;
      f32x16 pa;
      zero16(pa);
      micro_partial(pa, Ab, K, Wb, K, K, row0, n0, w, r, h);
      __syncthreads();
      micro_reduce_store(pa, red, w, lane);
      __syncthreads();
#pragma unroll
      for (int q = 0; q < 2; ++q) {
        const int i = w + 8 * q;
        const float sa = micro_sum(red, i, lane);
        const int row = row0 + crow(i, h), n = n0 + r;
        const float gg = mod[((size_t)l * 40 + batch_of_row(row)) * 6144 + gi * 1024 + n];
        float* xr = p.out + (size_t)row * 1024 + n;
        float xv = (mode == 0 && l == 0) ? p.in[1][(size_t)(row - TOKP) * 1024 + n] : *xr;
        if (!(mode == 0 && l == 0)) {
          const float2 st = *(const float2*)(stats + (size_t)row * 2);
          xv = (xv - st.x) * st.y * rlg[n] + rlb[n];
        }
        *xr = ALPHA * xv + (1.f + gg) * sa;
      }
    }
    __syncthreads();
  }
}

DI void phase_gu(const Params& p, int l, unsigned char* smem) {
  const int tid = otid(), lane = tid & 63, w = tid >> 6;
  const int wm = w >> 2, wn = w & 3, r = lane & 31, h = lane >> 5;
  u16* ACT = (u16*)(p.ws + WS_ACT);
  const u16* Hh = (const u16*)(p.ws + WS_H);
  const u16* Wb = (const u16*)(p.ws + WS_WT_GU) + (size_t)l * 5632 * 1024;
  float* stg = (float*)(smem + GS_BASE + GS_STAGE);
  const int NT = 22, MT = 257;
  auto ptrs = [&](int it, const u16*& ap, const u16*& bp) -> bool {
    int mt, nt;
    if (!tile_of(it, MT, NT, mt, nt)) return false;
    ap = Hh + (size_t)(mt * 256) * 1024;
    bp = Wb + (size_t)(nt * 256) * 1024;
    return true;
  };
  auto epi = [&](int it, f32x16 (&acc)[4][2]) {
    const int tid = otid(), lane = tid & 63, w = tid >> 6;
    const int wm = w >> 2, wn = w & 3, r = lane & 31, h = lane >> 5;
    int mt, nt;
    tile_of(it, MT, NT, mt, nt);
    const int m0 = mt * 256, n0 = nt * 256;
#pragma unroll
    for (int mi = 0; mi < 4; ++mi) {
      __syncthreads();
      stage_rm(acc[mi][0], acc[mi][1], stg, wm, wn, r, h);
      __syncthreads();
#pragma unroll 1
      for (int q = 0; q < 2; ++q) {
        const int cid = q * NTHR + tid, lr = cid >> 4, c16 = (cid & 15) * 16;
        const float4 v0 = *(const float4*)(stg + lr * EP_LD + c16);
        const float4 v1 = *(const float4*)(stg + lr * EP_LD + c16 + 4);
        const float4 v2 = *(const float4*)(stg + lr * EP_LD + c16 + 8);
        const float4 v3 = *(const float4*)(stg + lr * EP_LD + c16 + 12);
        const int row = grow_of(m0, mi, lr);
        uint4 o;
        o.x = pack2(siluf_(v0.x) * v0.y, siluf_(v0.z) * v0.w);
        o.y = pack2(siluf_(v1.x) * v1.y, siluf_(v1.z) * v1.w);
        o.z = pack2(siluf_(v2.x) * v2.y, siluf_(v2.z) * v2.w);
        o.w = pack2(siluf_(v3.x) * v3.y, siluf_(v3.z) * v3.w);
        *(uint4*)(ACT + (size_t)row * 2816 + (n0 >> 1) + (c16 >> 1)) = o;
      }
    }
    __syncthreads();
  };
  gemm_stream(1024, 1024, 1024, smem, ptrs, epi);
}

constexpr int AT_BASE = 64;
constexpr int AT_KBYTES = 64 * 272;
constexpr int AT_VBYTES = 128 * 136;
constexpr int AT_STAGE = AT_KBYTES + AT_VBYTES;

DI void attn_item(const Params& p, int l, int b, int head, int qt, float lam, float lam_init, unsigned char* smem) {
  const int tid = otid(), lane = tid & 63, w = tid >> 6, r = lane & 31, h = lane >> 5;
  const int comp = w & 1, rg = w >> 1;
  const bool prompt = b < 32;
  const int bs = b - 32;
  const u16* Kg = prompt ? (const u16*)(p.ws + WS_KB) + (size_t)b * 2048 * 512 : (const u16*)(p.ws + WS_KS) + (size_t)(l * 8 + bs) * 1056 * 512;
  const u16* Vg = prompt ? (const u16*)(p.ws + WS_VTP) + (size_t)b * 512 * 2048 : (const u16*)(p.ws + WS_VTS) + (size_t)(l * 8 + bs) * 512 * 1056;
  const int ldT = prompt ? 2048 : 1056;
  const int nkt = prompt ? 2 * qt + 2 : 17;
  const int nkeys = prompt ? 2048 : 1056;
  const int qtok0 = prompt ? b * 2048 + qt * 128 : TOKP + bs * 32;
  const int qpos0 = prompt ? qt * 128 : 1024;
  const bool active = prompt || rg == 0;
  const int my_nkt = prompt ? (rg < 2 ? nkt - 1 : nkt) : nkt;
  const u16* ZQ = (const u16*)(p.ws + WS_ZQ);
  bf16x8 qf[4];
  {
    const int qrow = active ? qtok0 + rg * 32 + r : qtok0;
#pragma unroll
    for (int ks = 0; ks < 4; ++ks) {
      const uint4 qq = *(const uint4*)(ZQ + (size_t)qrow * 512 + head * 128 + comp * 64 + ks * 16 + h * 8);
      const float cq = 0.125f * LOG2E;
      uint4 qs_;
      qs_.x = pack2(bflo(qq.x) * cq, bfhi(qq.x) * cq); qs_.y = pack2(bflo(qq.y) * cq, bfhi(qq.y) * cq);
      qs_.z = pack2(bflo(qq.z) * cq, bfhi(qq.z) * cq); qs_.w = pack2(bflo(qq.w) * cq, bfhi(qq.w) * cq);
      qf[ks] = __builtin_bit_cast(bf16x8, qs_);
    }
  }
  const float slope2 = exp2f(-2.f * (head + 1)) * LOG2E;
  const float c1 = 0.125f * LOG2E;
  const int qpos = qpos0 + rg * 32 + r;
  f32x16 O[4];
#pragma unroll
  for (int i = 0; i < 4; ++i) zero16(O[i]);
  float m_run = -INFINITY, l_run = 0.f;

  const int krow = tid >> 4, kcc = tid & 15;
  const int vrow = tid >> 3, vcc = tid & 7;
  const u16* kp = Kg + (size_t)((nkt - 1) * 64 + krow) * 512 + head * 128 + kcc * 8;
  const u16* vp = Vg + (size_t)(head * 128 + vrow) * ldT + (nkt - 1) * 64 + vcc * 8;
  uint4 rk0, rk1, rv0, rv1;
  unsigned char* sb = smem + AT_BASE;
  rk0 = *(const uint4*)kp; rk1 = *(const uint4*)(kp + 32 * 512);
  rv0 = *(const uint4*)vp; rv1 = *(const uint4*)(vp + (size_t)64 * ldT);
  {
    *(uint4*)(sb + krow * 272 + kcc * 16) = rk0;
    *(uint4*)(sb + (krow + 32) * 272 + kcc * 16) = rk1;
    *(uint2*)(sb + AT_KBYTES + vrow * 136 + vcc * 16) = make_uint2(rv0.x, rv0.y);
    *(uint2*)(sb + AT_KBYTES + vrow * 136 + vcc * 16 + 8) = make_uint2(rv0.z, rv0.w);
    *(uint2*)(sb + AT_KBYTES + (vrow + 64) * 136 + vcc * 16) = make_uint2(rv1.x, rv1.y);
    *(uint2*)(sb + AT_KBYTES + (vrow + 64) * 136 + vcc * 16 + 8) = make_uint2(rv1.z, rv1.w);
  }
  __syncthreads();
  for (int j = 0; j < nkt; ++j) {
    const int kt = nkt - 1 - j;
    const bool more = j + 1 < nkt;
    if (more) {
      kp -= 64 * 512; vp -= 64;
      rk0 = *(const uint4*)kp; rk1 = *(const uint4*)(kp + 32 * 512);
      rv0 = *(const uint4*)vp; rv1 = *(const uint4*)(vp + (size_t)64 * ldT);
    }
    if (active && kt < my_nkt) {
      const unsigned char* Kt = sb + (j & 1) * AT_STAGE;
      const unsigned char* Vt = Kt + AT_KBYTES;
      f32x16 s[2];
      const bool past = (kt * 64 + 63) < (qpos0 + rg * 32);
      if (past) {
        const float kb0 = slope2 * (float)(kt * 64 + 4 * h);
#pragma unroll
        for (int sub = 0; sub < 2; ++sub)
#pragma unroll
          for (int i = 0; i < 16; ++i) s[sub][i] = __builtin_fmaf(slope2, (float)(sub * 32 + (i & 3) + 8 * (i >> 2)), kb0);
      } else {
        zero16(s[0]); zero16(s[1]);
      }
#pragma unroll
      for (int ks = 0; ks < 4; ++ks) {
#pragma unroll
        for (int sub = 0; sub < 2; ++sub) {
          const bf16x8 kf = *(const bf16x8*)(Kt + (sub * 32 + r) * 272 + (comp * 64 + ks * 16 + h * 8) * 2);
          s[sub] = MFMA(kf, qf[ks], s[sub]);
        }
      }
      float mx = -INFINITY;
      if (!past) {
        const float qk0 = (float)(qpos - kt * 64 - 4 * h);
        const float qb = slope2 * (float)qpos;
#pragma unroll
        for (int sub = 0; sub < 2; ++sub)
#pragma unroll
          for (int i = 0; i < 16; ++i) {
            const float d = qk0 - (float)(sub * 32 + (i & 3) + 8 * (i >> 2));
            s[sub][i] = s[sub][i] - slope2 * fabsf(d) + qb;
          }
      }
      if (!prompt) {
#pragma unroll
        for (int sub = 0; sub < 2; ++sub)
#pragma unroll
          for (int i = 0; i < 16; ++i) {
            const int key = kt * 64 + sub * 32 + crow(i, h);
            if (key >= nkeys) s[sub][i] = -INFINITY;
          }
      }
#pragma unroll
      for (int sub = 0; sub < 2; ++sub)
#pragma unroll
        for (int i = 0; i < 16; ++i) mx = fmaxf(mx, s[sub][i]);
      mx = fmaxf(mx, shx(mx, 32, lane));
      const bool livelane = !(mx - m_run < -150.f);
      if (__ballot(livelane) != 0ull) {
        const float m_new = fmaxf(m_run, mx);
        const float alpha = fexp2(m_run - m_new);
        m_run = m_new;
        float lsum = 0.f;
#pragma unroll
        for (int sub = 0; sub < 2; ++sub)
#pragma unroll
          for (int i = 0; i < 16; ++i) {
            const float pv = fexp2(s[sub][i] - m_new);
            lsum += pv;
            s[sub][i] = pv;
          }
        l_run = l_run * alpha + lsum;
        if (__ballot(alpha != 1.f) != 0ull) {
#pragma unroll
          for (int dt = 0; dt < 4; ++dt)
#pragma unroll
            for (int i = 0; i < 16; ++i) O[dt][i] *= alpha;
        }
#pragma unroll
        for (int sub = 0; sub < 2; ++sub)
#pragma unroll
          for (int s2 = 0; s2 < 2; ++s2) {
            const bf16x8 pf = pack8(s[sub], s2);
#pragma unroll
            for (int dt = 0; dt < 4; ++dt) {
              const unsigned char* va = Vt + (dt * 32 + r) * 136 + (sub * 32 + s2 * 16 + 4 * h) * 2;
              const uint2 lo = *(const uint2*)va;
              const uint2 hi = *(const uint2*)(va + 16);
              const uint4 vv = make_uint4(lo.x, lo.y, hi.x, hi.y);
              O[dt] = MFMA(__builtin_bit_cast(bf16x8, vv), pf, O[dt]);
            }
          }
      }
    }
    if (more) {
      unsigned char* sn = sb + ((j + 1) & 1) * AT_STAGE;
      *(uint4*)(sn + krow * 272 + kcc * 16) = rk0;
      *(uint4*)(sn + (krow + 32) * 272 + kcc * 16) = rk1;
      *(uint2*)(sn + AT_KBYTES + vrow * 136 + vcc * 16) = make_uint2(rv0.x, rv0.y);
      *(uint2*)(sn + AT_KBYTES + vrow * 136 + vcc * 16 + 8) = make_uint2(rv0.z, rv0.w);
      *(uint2*)(sn + AT_KBYTES + (vrow + 64) * 136 + vcc * 16) = make_uint2(rv1.x, rv1.y);
      *(uint2*)(sn + AT_KBYTES + (vrow + 64) * 136 + vcc * 16 + 8) = make_uint2(rv1.z, rv1.w);
    }
    __syncthreads();
  }
  float* exch = (float*)(smem + AT_BASE);
  float inv = 0.f;
  if (active) { const float lt = l_run + shx(l_run, 32, lane); inv = __builtin_amdgcn_rcpf(lt); }
  if (active && comp == 1) {
    const float sc = inv * lam;
#pragma unroll
    for (int dt = 0; dt < 4; ++dt)
#pragma unroll
      for (int i = 0; i < 16; ++i) exch[(rg * 64 + dt * 16 + i) * 64 + lane] = O[dt][i] * sc;
  }
  __syncthreads();
  if (active && comp == 0) {
    float ss = 0.f;
#pragma unroll
    for (int dt = 0; dt < 4; ++dt)
#pragma unroll
      for (int i = 0; i < 16; ++i) {
        const float o = O[dt][i] * inv - exch[(rg * 64 + dt * 16 + i) * 64 + lane];
        O[dt][i] = o;
        ss += o * o;
      }
    ss += shx(ss, 32, lane);
    const float rs = rsqrtf(ss * (1.f / 128.f) + LN_EPS) * (1.f - lam_init);
    u16* AN = (u16*)(p.ws + WS_AN) + (size_t)(qtok0 + rg * 32 + r) * 512 + head * 128;
    const float* gw = p.in[17] + l * 512 + head * 128;
#pragma unroll
    for (int dt = 0; dt < 4; ++dt)
#pragma unroll
      for (int g = 0; g < 4; ++g) {
        const int dv = dt * 32 + 8 * g + 4 * h;
        const float4 g4 = *(const float4*)(gw + dv);
        uint2 o;
        o.x = pack2(O[dt][4 * g] * rs * g4.x, O[dt][4 * g + 1] * rs * g4.y);
        o.y = pack2(O[dt][4 * g + 2] * rs * g4.z, O[dt][4 * g + 3] * rs * g4.w);
        *(uint2*)(AN + dv) = o;
      }
  }
}

constexpr int ML_QS = 64;
constexpr int ML_KS = ML_QS + 64 * 272;
constexpr int ML_KT = ML_KS + 64 * 272;
constexpr int ML_VT = ML_KT + 128 * 144;
constexpr int ML_CB = ML_VT + 128 * 144;
constexpr int ML_HB = ML_CB + 128 * 272;
constexpr int ML_SM = ML_HB + 64 * 132 * 4;
static_assert(ML_SM + 528 * 4 <= LDS_BYTES, "lds");

DI void mlstm_item(const Params& p, int l, int b, int head, unsigned char* smem) {
  const int tid = otid(), lane = tid & 63, w = tid >> 6, r = lane & 31, h = lane >> 5;
  const bool prompt = b < 32;
  const int bs = b - 32;
  const int T = prompt ? 2048 : 32;
  const int nch = prompt ? 32 : 1;
  const int L = prompt ? 64 : 32;
  const int tokbase = prompt ? b * 2048 : TOKP + bs * 32;
  const u16* qkT = prompt ? (const u16*)(p.ws + WS_MQKT_P) + (size_t)b * 1024 * 2048 : (const u16*)(p.ws + WS_MQKT_S) + (size_t)bs * 1024 * 32;
  const u16* vTg = prompt ? (const u16*)(p.ws + WS_MVT_P) + (size_t)b * 512 * 2048 : (const u16*)(p.ws + WS_MVT_S) + (size_t)bs * 512 * 32;
  u16* qs = (u16*)(smem + ML_QS);
  u16* ksm = (u16*)(smem + ML_KS);
  u16* kTw = (u16*)(smem + ML_KT);
  u16* vT = (u16*)(smem + ML_VT);
  u16* Cbf = (u16*)(smem + ML_CB);
  float* hbuf = (float*)(smem + ML_HB);
  float* a_s = (float*)(smem + ML_SM);
  float* mx_s = a_s + 64;
  float* ws_s = a_s + 128;
  float* wi_s = a_s + 192;
  float* emt_s = a_s + 256;
  float* nq_s = a_s + 320;
  float* nvec = a_s + 384;
  float* scal = a_s + 512;

  const int vt = w & 3, kt0 = (w >> 2) * 2;
  f32x16 accC[2];
  float m_run = 0.f;
  if (prompt) {
    zero16(accC[0]); zero16(accC[1]);
    if (tid < 128) nvec[tid] = 0.f;
  } else {
    const float* Cs = p.in[6] + ((size_t)(l * 8 + bs) * 4 + head) * 128 * 128;
#pragma unroll
    for (int q = 0; q < 2; ++q)
#pragma unroll
      for (int g = 0; g < 4; ++g) {
        const float4 c4 = *(const float4*)(Cs + (size_t)(vt * 32 + r) * 128 + (kt0 + q) * 32 + 8 * g + 4 * h);
        accC[q][4 * g] = c4.x; accC[q][4 * g + 1] = c4.y; accC[q][4 * g + 2] = c4.z; accC[q][4 * g + 3] = c4.w;
      }
    if (tid < 128) nvec[tid] = p.in[7][((size_t)(l * 8 + bs) * 4 + head) * 128 + tid];
    m_run = p.in[8][(l * 8 + bs) * 4 + head];
  }
#pragma unroll
  for (int q = 0; q < 2; ++q)
#pragma unroll
    for (int g = 0; g < 4; ++g) {
      uint2 o; o.x = pack2(accC[q][4 * g], accC[q][4 * g + 1]); o.y = pack2(accC[q][4 * g + 2], accC[q][4 * g + 3]);
      *(uint2*)(Cbf + (vt * 32 + r) * 136 + (kt0 + q) * 32 + 8 * g + 4 * h) = o;
    }
  const float* gatesp = (const float*)(p.ws + WS_GATES);
  const int vi = w >> 1, ti = w & 1;

  float ig_n = -INFINITY, fg_n = 0.f;
  if (w == 0 && lane < L) {
    const float* gp = gatesp + (size_t)(tokbase + lane) * 8;
    ig_n = gp[head]; fg_n = gp[4 + head];
  }
  for (int c = 0; c < nch; ++c) {
    const int t0 = c * 64;
    if (w == 0) {
      const int t = lane;
      float ig = -INFINITY, lf = 0.f;
      if (t < L) {
        ig = ig_n;
        const float fg = fg_n;
        lf = fminf(fg, 0.f) - log1pf(__expf(-fabsf(fg)));
        if (c + 1 < nch) {
          const float* gp = gatesp + (size_t)(tokbase + t0 + 64 + t) * 8;
          ig_n = gp[head]; fg_n = gp[4 + head];
        }
      }
      float bc = lf;
#pragma unroll
      for (int off = 1; off < 64; off <<= 1) { const float v = shidx(bc, lane - off, lane); if (lane >= off) bc += v; }
      const float a = ig - bc;
      float M = a;
#pragma unroll
      for (int off = 1; off < 64; off <<= 1) { const float v = shidx(M, lane - off, lane); if (lane >= off) M = fmaxf(M, v); }
      const float mx = fmaxf(m_run, M);
      const float bL = shidx(bc, 63, lane);
      const float mxL = shidx(mx, 63, lane);
      a_s[t] = a; mx_s[t] = mx;
      ws_s[t] = __expf(a - mxL);
      wi_s[t] = __expf(m_run - mx);
      emt_s[t] = __expf(-(bc + mx));
      if (lane == 0) scal[1] = __expf(m_run - mxL);
      m_run = bL + mxL;
    }
    const int ch2 = tid >> 1, th = tid & 1;
    const bool isk = ch2 >= 128;
    const int dd = ch2 & 127;
    const int ch = (isk ? 512 : 0) + head * 128 + dd;
    const u16* rp = qkT + (size_t)ch * T + t0 + th * 32;
    float um3 = 0.f, um2 = 0.f, um1 = 0.f;
    const bool ldrow = prompt || th == 0;
    uint4 uu0 = make_uint4(0, 0, 0, 0), uu1 = uu0, uu2 = uu0, uu3 = uu0, vv0 = uu0, vv1 = uu0;
    if (ldrow) { uu0 = *(const uint4*)(rp); uu1 = *(const uint4*)(rp + 8); uu2 = *(const uint4*)(rp + 16); uu3 = *(const uint4*)(rp + 24); }
    {
      const int row = tid >> 3, cc = tid & 7;
      if (prompt || cc < 4) {
        vv0 = *(const uint4*)(vTg + (size_t)(head * 128 + row) * T + t0 + cc * 8);
        vv1 = *(const uint4*)(vTg + (size_t)(head * 128 + row + 64) * T + t0 + cc * 8);
      }
    }
    if (prompt) {
      if (th == 1 || c > 0) {
        const uint2 pv = *(const uint2*)(rp - 4);
        um3 = bfhi(pv.x); um2 = bflo(pv.y); um1 = bfhi(pv.y);
      }
    } else if (th == 0) {
      const float* cvp = p.in[9] + (size_t)(l * 8 + bs) * 3 * 1024 + ch;
      um3 = cvp[0]; um2 = cvp[1024]; um1 = cvp[2048];
    }
    const float cw0 = p.in[14][(l * 4 + 0) * 1024 + ch], cw1 = p.in[14][(l * 4 + 1) * 1024 + ch];
    const float cw2 = p.in[14][(l * 4 + 2) * 1024 + ch], cw3 = p.in[14][(l * 4 + 3) * 1024 + ch];
    const float cb = p.in[15][l * 1024 + ch];
    __syncthreads();
    {
      u16* dstrm = (isk ? ksm : qs) + (th * 32) * 136 + dd;
      const float oscale = isk ? 0.08838834764831845f : 1.f;
#pragma unroll
      for (int i = 0; i < 4; ++i) {
        const uint4 uu = (i == 0) ? uu0 : (i == 1 ? uu1 : (i == 2 ? uu2 : uu3));
        float u[8];
        u[0] = bflo(uu.x); u[1] = bfhi(uu.x); u[2] = bflo(uu.y); u[3] = bfhi(uu.y);
        u[4] = bflo(uu.z); u[5] = bfhi(uu.z); u[6] = bflo(uu.w); u[7] = bfhi(uu.w);
        float y[8];
#pragma unroll
        for (int e = 0; e < 8; ++e) {
          const float x3 = (e >= 3) ? u[e - 3] : (e == 0 ? um3 : (e == 1 ? um2 : um1));
          const float x2 = (e >= 2) ? u[e - 2] : (e == 0 ? um2 : um1);
          const float x1 = (e >= 1) ? u[e - 1] : um1;
          const float yy = cb + cw0 * x3 + cw1 * x2 + cw2 * x1 + cw3 * u[e];
          y[e] = siluf_(yy) * oscale;
        }
        um3 = u[5]; um2 = u[6]; um1 = u[7];
#pragma unroll
        for (int e = 0; e < 8; ++e) dstrm[(i * 8 + e) * 136] = f2bf(y[e]);
        if (isk) {
          const float4 w0 = *(const float4*)(ws_s + th * 32 + i * 8);
          const float4 w1 = *(const float4*)(ws_s + th * 32 + i * 8 + 4);
          uint4 o;
          o.x = pack2(y[0] * w0.x, y[1] * w0.y); o.y = pack2(y[2] * w0.z, y[3] * w0.w);
          o.z = pack2(y[4] * w1.x, y[5] * w1.y); o.w = pack2(y[6] * w1.z, y[7] * w1.w);
          *(uint4*)(kTw + dd * 72 + th * 32 + i * 8) = o;
        }
      }
      {
        const int row = tid >> 3, cc = tid & 7;
        *(uint4*)(vT + row * 72 + cc * 8) = vv0;
        *(uint4*)(vT + (row + 64) * 72 + cc * 8) = vv1;
      }
    }
    __syncthreads();
    {
      const int t = tid >> 3, part = tid & 7;
      const uint4 q0 = *(const uint4*)(qs + t * 136 + part * 16);
      const uint4 q1 = *(const uint4*)(qs + t * 136 + part * 16 + 8);
      const float* nv = nvec + part * 16;
      float s = bflo(q0.x) * nv[0] + bfhi(q0.x) * nv[1] + bflo(q0.y) * nv[2] + bfhi(q0.y) * nv[3]
              + bflo(q0.z) * nv[4] + bfhi(q0.z) * nv[5] + bflo(q0.w) * nv[6] + bfhi(q0.w) * nv[7]
              + bflo(q1.x) * nv[8] + bfhi(q1.x) * nv[9] + bflo(q1.y) * nv[10] + bfhi(q1.y) * nv[11]
              + bflo(q1.z) * nv[12] + bfhi(q1.z) * nv[13] + bflo(q1.w) * nv[14] + bfhi(q1.w) * nv[15];
      s += shx(s, 1, lane); s += shx(s, 2, lane); s += shx(s, 4, lane);
      if (part == 0) nq_s[t] = s;
    }
    f32x16 accS[2], accO;
    zero16(accS[0]); zero16(accS[1]); zero16(accO);
    {
#pragma unroll
      for (int ks = 0; ks < 8; ++ks) {
        const bf16x8 qfr = *(const bf16x8*)(qs + (ti * 32 + r) * 136 + ks * 16 + h * 8);
        const bf16x8 k0 = *(const bf16x8*)(ksm + r * 136 + ks * 16 + h * 8);
        accS[0] = MFMA(k0, qfr, accS[0]);
        if (ti == 1) {
          const bf16x8 k1 = *(const bf16x8*)(ksm + (32 + r) * 136 + ks * 16 + h * 8);
          accS[1] = MFMA(k1, qfr, accS[1]);
        }
        const bf16x8 cf = *(const bf16x8*)(Cbf + (vi * 32 + r) * 136 + ks * 16 + h * 8);
        accO = MFMA(cf, qfr, accO);
      }
    }
    const int tcol = ti * 32 + r;
    const float mxt = mx_s[tcol];
    const float wit = wi_s[tcol];
    float dsum = 0.f;
#pragma unroll
    for (int sub = 0; sub < 2; ++sub) {
      if (sub <= ti) {
#pragma unroll
        for (int g = 0; g < 4; ++g) {
          const float4 a4 = *(const float4*)(a_s + sub * 32 + 8 * g + 4 * h);
          const float av[4] = {a4.x, a4.y, a4.z, a4.w};
#pragma unroll
          for (int e = 0; e < 4; ++e) {
            const int s = sub * 32 + 8 * g + 4 * h + e;
            const float wgt = (s <= tcol) ? __expf(av[e] - mxt) : 0.f;
            const float pv = accS[sub][4 * g + e] * wgt;
            accS[sub][4 * g + e] = pv;
            dsum += pv;
          }
        }
      }
    }
    dsum += shx(dsum, 32, lane);
#pragma unroll
    for (int i = 0; i < 16; ++i) accO[i] *= wit;
#pragma unroll
    for (int sub = 0; sub < 2; ++sub) {
      if (sub <= ti) {
#pragma unroll
        for (int s2 = 0; s2 < 2; ++s2) {
          const bf16x8 pf = pack8(accS[sub], s2);
          const u16* va = vT + (vi * 32 + r) * 72 + sub * 32 + s2 * 16 + 4 * h;
          const uint2 lo = *(const uint2*)va;
          const uint2 hi = *(const uint2*)(va + 8);
          const uint4 vq = make_uint4(lo.x, lo.y, hi.x, hi.y);
          accO = MFMA(__builtin_bit_cast(bf16x8, vq), pf, accO);
        }
      }
    }
    __syncthreads();
    {
      const float den = dsum + wit * nq_s[tcol];
      const float dn = fmaxf(fabsf(den), emt_s[tcol]);
      const float rinv = __builtin_amdgcn_rcpf(dn);
#pragma unroll
      for (int g = 0; g < 4; ++g)
        *(float4*)(hbuf + tcol * 132 + vi * 32 + 8 * g + 4 * h) =
            make_float4(accO[4 * g] * rinv, accO[4 * g + 1] * rinv, accO[4 * g + 2] * rinv, accO[4 * g + 3] * rinv);
    }
    {
      const float wc = scal[1];
#pragma unroll
      for (int q = 0; q < 2; ++q)
#pragma unroll
        for (int i = 0; i < 16; ++i) accC[q][i] *= wc;
#pragma unroll
      for (int k4 = 0; k4 < 4; ++k4) {
        const bf16x8 vf = *(const bf16x8*)(vT + (vt * 32 + r) * 72 + k4 * 16 + h * 8);
#pragma unroll
        for (int q = 0; q < 2; ++q) {
          const bf16x8 kf = *(const bf16x8*)(kTw + ((kt0 + q) * 32 + r) * 72 + k4 * 16 + h * 8);
          accC[q] = MFMA(kf, vf, accC[q]);
        }
      }
#pragma unroll
      for (int q = 0; q < 2; ++q)
#pragma unroll
        for (int g = 0; g < 4; ++g) {
          uint2 o; o.x = pack2(accC[q][4 * g], accC[q][4 * g + 1]); o.y = pack2(accC[q][4 * g + 2], accC[q][4 * g + 3]);
          *(uint2*)(Cbf + (vt * 32 + r) * 136 + (kt0 + q) * 32 + 8 * g + 4 * h) = o;
        }
      if (tid < 128) {
        float s = 0.f;
#pragma unroll
        for (int i = 0; i < 8; ++i) {
          const uint4 kk = *(const uint4*)(kTw + tid * 72 + i * 8);
          s += bflo(kk.x) + bfhi(kk.x) + bflo(kk.y) + bfhi(kk.y) + bflo(kk.z) + bfhi(kk.z) + bflo(kk.w) + bfhi(kk.w);
        }
        nvec[tid] = wc * nvec[tid] + s;
      }
    }
    __syncthreads();
    {
      const int t = tid >> 3, part = tid & 7;
      float x[16];
#pragma unroll
      for (int i = 0; i < 4; ++i) {
        const float4 f = *(const float4*)(hbuf + t * 132 + part * 16 + i * 4);
        x[i * 4] = f.x; x[i * 4 + 1] = f.y; x[i * 4 + 2] = f.z; x[i * 4 + 3] = f.w;
      }
      float s = 0.f;
#pragma unroll
      for (int i = 0; i < 16; ++i) s += x[i];
      s += shx(s, 1, lane); s += shx(s, 2, lane); s += shx(s, 4, lane);
      const float mean = s * (1.f / 128.f);
      float q = 0.f;
#pragma unroll
      for (int i = 0; i < 16; ++i) { x[i] -= mean; q += x[i] * x[i]; }
      q += shx(q, 1, lane); q += shx(q, 2, lane); q += shx(q, 4, lane);
      const float rstd = rsqrtf(q * (1.f / 128.f) + LN_EPS);
      if (t < L) {
        const size_t tok = (size_t)tokbase + t0 + t;
        const int cbase = head * 128 + part * 16;
        const float* gw = p.in[18] + l * 512 + cbase;
        const u16* mo = (const u16*)(p.ws + WS_MO) + tok * 512 + cbase;
        const uint4 m0 = *(const uint4*)mo;
        const uint4 m1 = *(const uint4*)(mo + 8);
        const float sg[16] = {bflo(m0.x), bfhi(m0.x), bflo(m0.y), bfhi(m0.y), bflo(m0.z), bfhi(m0.z), bflo(m0.w), bfhi(m0.w),
                              bflo(m1.x), bfhi(m1.x), bflo(m1.y), bfhi(m1.y), bflo(m1.z), bfhi(m1.z), bflo(m1.w), bfhi(m1.w)};
        float yv[16];
#pragma unroll
        for (int i = 0; i < 16; ++i) yv[i] = x[i] * rstd * gw[i] * sg[i];
        uint4 o0, o1;
        o0.x = pack2(yv[0], yv[1]); o0.y = pack2(yv[2], yv[3]); o0.z = pack2(yv[4], yv[5]); o0.w = pack2(yv[6], yv[7]);
        o1.x = pack2(yv[8], yv[9]); o1.y = pack2(yv[10], yv[11]); o1.z = pack2(yv[12], yv[13]); o1.w = pack2(yv[14], yv[15]);
        u16* mn = (u16*)(p.ws + WS_MN) + tok * 512 + cbase;
        *(uint4*)mn = o0;
        *(uint4*)(mn + 8) = o1;
      }
    }
  }
  {
    float* oc = p.out + (prompt ? O_CP + ((size_t)(l * 32 + b) * 4 + head) * 16384 : O_CS + ((size_t)(l * 8 + bs) * 4 + head) * 16384);
#pragma unroll
    for (int q = 0; q < 2; ++q)
#pragma unroll
      for (int g = 0; g < 4; ++g)
        *(float4*)(oc + (size_t)(vt * 32 + r) * 128 + (kt0 + q) * 32 + 8 * g + 4 * h) =
            make_float4(accC[q][4 * g], accC[q][4 * g + 1], accC[q][4 * g + 2], accC[q][4 * g + 3]);
    float* on = p.out + (prompt ? O_NP + ((size_t)(l * 32 + b) * 4 + head) * 128 : O_NS + ((size_t)(l * 8 + bs) * 4 + head) * 128);
    if (tid < 128) on[tid] = nvec[tid];
    if (tid == 0) {
      if (prompt) p.out[O_MP + (size_t)(l * 32 + b) * 4 + head] = m_run;
      else p.out[O_MS + (size_t)(l * 8 + bs) * 4 + head] = m_run;
    }
  }
}

DI void phase_mixers(const Params& p, int l, unsigned char* smem) {
  const int tid0 = otid();
  const int lane = tid0 & 63;
  const float* lp = p.in[16] + l * 256;
  float s1 = lp[lane] * lp[64 + lane], s2 = lp[128 + lane] * lp[192 + lane];
  s1 = wave_sum(s1, lane); s2 = wave_sum(s2, lane);
  const float lam_init = 0.8f - 0.6f * expf(-0.3f * (float)l);
  const float lam = expf(s1) - expf(s2) + lam_init;
  int* ctr = (int*)(p.ws + WS_CTR) + l;
  int* sitem = (int*)smem;
  const int N_ML = 160, N_AT = 2048 + 32;
  for (;;) {
    __syncthreads();
    if (tid0 == 0) *sitem = atomicAdd(ctr, 1);
    __syncthreads();
    const int item = *sitem;
    if (item >= N_ML + N_AT) break;
    if (item < N_ML) {
#ifndef NO_ML
      mlstm_item(p, l, item >> 2, item & 3, smem);
#endif
    } else {
#ifndef NO_AT
      const int a = item - N_ML;
      if (a < 2048) {
        const int qt = 15 - (a >> 7), rest = a & 127;
        attn_item(p, l, rest >> 2, rest & 3, qt, lam, lam_init, smem);
      } else {
        const int s = a - 2048;
        attn_item(p, l, 32 + (s >> 2), s & 3, 0, lam, lam_init, smem);
      }
#endif
    }
  }
}

DI void gbar(unsigned* ctl, unsigned& k) {
  __syncthreads();
  ++k;
  if (otid() == 0) {
    __threadfence();
    const unsigned x = blockIdx.x & 7;
    const unsigned gsz = (gridDim.x + 7 - x) >> 3;
    const unsigned ngroups = gridDim.x < 8 ? gridDim.x : 8;
    unsigned* gc = ctl + 64 + x * 32;
    unsigned* gl = ctl + 32;
    const unsigned old = __hip_atomic_fetch_add(gc, 1u, __ATOMIC_RELAXED, __HIP_MEMORY_SCOPE_AGENT);
    if (old + 1 == k * gsz) {
      __threadfence();
      __hip_atomic_fetch_add(gl, 1u, __ATOMIC_RELAXED, __HIP_MEMORY_SCOPE_AGENT);
    }
    while (__hip_atomic_load(gl, __ATOMIC_RELAXED, __HIP_MEMORY_SCOPE_AGENT) < k * ngroups) __builtin_amdgcn_s_sleep(1);
    __threadfence();
  }
  __syncthreads();
}

__global__ void __launch_bounds__(NTHR) fwd_megakernel(Params p) {
  extern __shared__ __attribute__((aligned(16))) unsigned char smem[];
  cg::grid_group grid = cg::this_grid();
#ifndef PH
#define PH 0xffff
#endif
  unsigned* bar = (unsigned*)(p.ws + WS_CTR);
  unsigned epoch = 0;
  if (PH & 1) prologue(p, smem);
  grid.sync();
  if (PH & 1) prologue(p, smem);
  grid.sync();
  if (PH & 2) ln_pass(p, 0, 0, smem);
  gbar(bar, epoch);
#pragma unroll 1
  for (int l = 0; l < 2; ++l) {
    if (PH & 4) phase_in_gate(p, l, smem);
    gbar(bar, epoch);
    if (PH & 8) phase_mixers(p, l, smem);
    gbar(bar, epoch);
    if (PH & 16) phase_mix(p, l, smem);
    gbar(bar, epoch);
    if (PH & 32) phase_res(p, l, 0, smem);
    gbar(bar, epoch);
    if (PH & 64) ln_pass(p, 1, l, smem);
    gbar(bar, epoch);
    if (PH & 128) phase_gu(p, l, smem);
    gbar(bar, epoch);
    if (PH & 256) phase_res(p, l, 1, smem);
    gbar(bar, epoch);
    if (PH & 512) ln_pass(p, 2, l, smem);
    if (l == 0) gbar(bar, epoch);
  }
}

extern "C" void kernel_launch(void* const* d_in, const int* in_sizes, int n_in, void* d_out, int out_size, void* d_ws,
                              size_t ws_size, hipStream_t stream) {
  static int grid_blocks = 0;
  if (!grid_blocks) {
    int dev = 0, cus = 0, per_cu = 0;
    hipGetDevice(&dev);
    hipDeviceGetAttribute(&cus, hipDeviceAttributeMultiprocessorCount, dev);
    if (hipFuncSetAttribute((const void*)fwd_megakernel, hipFuncAttributeMaxDynamicSharedMemorySize, LDS_BYTES) != hipSuccess)
      fprintf(stderr, "kernel_launch: hipFuncSetAttribute failed\n");
    if (hipOccupancyMaxActiveBlocksPerMultiprocessor(&per_cu, (const void*)fwd_megakernel, NTHR, LDS_BYTES) != hipSuccess || per_cu < 1) {
      fprintf(stderr, "kernel_launch: occupancy query gave %d\n", per_cu);
      per_cu = 1;
    }
    (void)hipGetLastError();
    grid_blocks = cus * per_cu;
    if (ws_size < WS_END) fprintf(stderr, "kernel_launch: workspace too small: %zu < %zu\n", ws_size, (size_t)WS_END);
  }
  if (hipMemsetAsync((char*)d_ws + WS_CTR, 0, 4096, stream) != hipSuccess) fprintf(stderr, "kernel_launch: memset failed\n");
  Params p{};
  for (int i = 0; i < 30; ++i) p.in[i] = (const float*)d_in[i];
  p.out = (float*)d_out;
  p.ws = (unsigned char*)d_ws;
  void* args[] = {&p};
  hipError_t e = hipLaunchCooperativeKernel((const void*)fwd_megakernel, dim3(grid_blocks), dim3(NTHR), args, LDS_BYTES, stream);
  if (e != hipSuccess) fprintf(stderr, "cooperative launch failed: %s (grid %d)\n", hipGetErrorString(e), grid_blocks);
}
```

```cpp
#include <hip/hip_runtime.h>
#include <hip/hip_cooperative_groups.h>
#include <cstdio>
namespace cg = cooperative_groups;

#define DI __device__ __forceinline__
typedef unsigned short u16;
using bf16x8 = __attribute__((ext_vector_type(8))) short;
using f32x16 = __attribute__((ext_vector_type(16))) float;
#define MFMA(a, b, c) __builtin_amdgcn_mfma_f32_32x32x16_bf16((a), (b), (c), 0, 0, 0)

constexpr int TOKP = 65536, TOKS = 256, TOK = 65792;
constexpr int NTHR = 512;
constexpr float LN_EPS = 1e-5f;
constexpr float ALPHA = 1.41421356237f;
constexpr float LOG2E = 1.44269504089f;

constexpr size_t WS_WT_IN   = 0;
constexpr size_t WS_WT_GATE = WS_WT_IN + 2ull * 3584 * 1024 * 2;
constexpr size_t WS_WT_BRA  = WS_WT_GATE + 2ull * 2048 * 1024 * 2;
constexpr size_t WS_WT_BRB  = WS_WT_BRA + 2ull * 1024 * 512 * 2;
constexpr size_t WS_WT_O    = WS_WT_BRB + 2ull * 1024 * 512 * 2;
constexpr size_t WS_WT_GU   = WS_WT_O + 2ull * 1024 * 1024 * 2;
constexpr size_t WS_WT_DOWN = WS_WT_GU + 2ull * 5632 * 1024 * 2;
constexpr size_t WS_MOD     = WS_WT_DOWN + 2ull * 1024 * 2816 * 2;
constexpr size_t WS_GATES   = WS_MOD + 2ull * 40 * 6144 * 4;
constexpr size_t WS_CTR     = WS_GATES + (size_t)TOK * 8 * 4;
constexpr size_t WS_STAT    = WS_CTR + 4096;
constexpr size_t WS_KS      = WS_STAT + (size_t)TOK * 8;
constexpr size_t WS_VTS     = WS_KS + 2ull * 8 * 1056 * 512 * 2 + 65536;
constexpr size_t WS_MQKT_S  = WS_VTS + 2ull * 8 * 512 * 1056 * 2 + 65536;
constexpr size_t WS_MVT_S   = WS_MQKT_S + 8ull * 1024 * 32 * 2;
constexpr size_t WS_H       = WS_MVT_S + 8ull * 512 * 32 * 2;
constexpr size_t WS_AN      = WS_H;
constexpr size_t WS_MN      = WS_H + (size_t)TOK * 512 * 2;
constexpr size_t WS_ZQ      = WS_H + (size_t)TOK * 1024 * 2;
constexpr size_t WS_KB      = WS_ZQ + (size_t)TOK * 512 * 2;
constexpr size_t WS_VTP     = WS_KB + (size_t)TOKP * 512 * 2;
constexpr size_t WS_MQKT_P  = WS_VTP + 32ull * 512 * 2048 * 2;
constexpr size_t WS_MVT_P   = WS_MQKT_P + 32ull * 1024 * 2048 * 2;
constexpr size_t WS_MO      = WS_MVT_P + 32ull * 512 * 2048 * 2;
constexpr size_t WS_G       = WS_MO + (size_t)TOK * 512 * 2;
constexpr size_t WS_END     = WS_G + (size_t)TOK * 2048 * 2;
constexpr size_t WS_MIX     = WS_ZQ;
constexpr size_t WS_ACT     = WS_ZQ;

constexpr size_t O_YP  = 0;
constexpr size_t O_YS  = O_YP + (size_t)TOKP * 1024;
constexpr size_t O_KP  = O_YS + (size_t)TOKS * 1024;
constexpr size_t O_VP  = O_KP + 2ull * TOKP * 512;
constexpr size_t O_KSM = O_VP + 2ull * TOKP * 512;
constexpr size_t O_VSM = O_KSM + 2ull * TOKS * 512;
constexpr size_t O_CP  = O_VSM + 2ull * TOKS * 512;
constexpr size_t O_NP  = O_CP + 2ull * 32 * 4 * 128 * 128;
constexpr size_t O_MP  = O_NP + 2ull * 32 * 4 * 128;
constexpr size_t O_CVP = O_MP + 2ull * 32 * 4;
constexpr size_t O_CS  = O_CVP + 2ull * 32 * 3 * 1024;
constexpr size_t O_NS  = O_CS + 2ull * 8 * 4 * 128 * 128;
constexpr size_t O_MS  = O_NS + 2ull * 8 * 4 * 128;
constexpr size_t O_CVS = O_MS + 2ull * 8 * 4;

constexpr int LDS_BYTES = 148480;

struct Params {
  const float* in[30];
  float* out;
  unsigned char* ws;
};


DI float bf2f(unsigned v) { return __uint_as_float(v << 16); }
typedef __bf16 bf16x2_t __attribute__((ext_vector_type(2)));
typedef float f32x2_t __attribute__((ext_vector_type(2)));
DI unsigned pack2(float a, float b) {
  f32x2_t v = {a, b};
  return __builtin_bit_cast(unsigned, __builtin_convertvector(v, bf16x2_t));
}
DI u16 f2bf(float x) { return (u16)(pack2(x, 0.f) & 0xffffu); }
DI float bflo(unsigned v) { return __uint_as_float(v << 16); }
DI float bfhi(unsigned v) { return __uint_as_float(v & 0xffff0000u); }
DI float sigmoidf_(float x) { return __builtin_amdgcn_rcpf(1.f + __expf(-x)); }
DI float siluf_(float x) { return x * __builtin_amdgcn_rcpf(1.f + __expf(-x)); }
DI float fexp2(float x) { return __builtin_amdgcn_exp2f(x); }
DI int otid() { int t = threadIdx.x; asm volatile("" : "+v"(t)); return t; }
DI float shx(float v, int mask, int lane) { return __int_as_float(__builtin_amdgcn_ds_bpermute(((lane ^ mask) & 63) << 2, __float_as_int(v))); }
DI float shidx(float v, int src, int lane) { (void)lane; return __int_as_float(__builtin_amdgcn_ds_bpermute((src & 63) << 2, __float_as_int(v))); }
DI int crow(int i, int h) { return (i & 3) + 8 * (i >> 2) + 4 * h; }
DI bf16x8 pack8(const f32x16& x, int s) {
  uint4 u;
  u.x = pack2(x[8 * s + 0], x[8 * s + 1]); u.y = pack2(x[8 * s + 2], x[8 * s + 3]);
  u.z = pack2(x[8 * s + 4], x[8 * s + 5]); u.w = pack2(x[8 * s + 6], x[8 * s + 7]);
  return __builtin_bit_cast(bf16x8, u);
}
DI void zero16(f32x16& a) {
#pragma unroll
  for (int i = 0; i < 16; ++i) a[i] = 0.f;
}
DI int batch_of_row(int row) { return row < TOKP ? (row >> 11) : 32 + ((row - TOKP) >> 5); }

constexpr int GS_STRIDE = 144;
constexpr int GS_STAGE = 512 * GS_STRIDE;
constexpr int GS_BASE = 64;

DI void gemm_mainloop(f32x16 (&acc)[4][2], const u16* __restrict__ A, int lda, const u16* __restrict__ Wt, int ldw, int K,
                      int m0, int n0, unsigned char* smem) {
  const int tid = otid(), lane = tid & 63, w = tid >> 6;
  const int wm = w >> 2, wn = w & 3, r = lane & 31, h = lane >> 5;
  const int lrow = tid >> 3, lcc = tid & 7;
  const u16* ap = A + (size_t)(m0 + lrow) * lda + lcc * 8;
  const int bn = n0 + 2 * (lrow & 31) + ((lrow >> 5) & 1);
  const u16* bp = Wt + (size_t)bn * ldw + lcc * 8;
  const size_t astep = (size_t)64 * lda, bstep = (size_t)64 * ldw;
  unsigned char* sbase = smem + GS_BASE;
  const int woff = lrow * GS_STRIDE + lcc * 16;
  const int nk = K >> 6;
  uint4 s0, s1, s2, s3, s4, s5, s6, s7, u0, u1, u2, u3, u4, u5, u6, u7;
  int kn = 1;
#define G_ADV() do { const int adv = (kn < nk) ? 64 : 0; ap += adv; bp += adv; ++kn; } while (0)
#define G_ISSUE_A() do { s0 = *(const uint4*)(ap); s1 = *(const uint4*)(ap + astep); s2 = *(const uint4*)(ap + 2 * astep); s3 = *(const uint4*)(ap + 3 * astep); \
    s4 = *(const uint4*)(bp); s5 = *(const uint4*)(bp + bstep); s6 = *(const uint4*)(bp + 2 * bstep); s7 = *(const uint4*)(bp + 3 * bstep); } while (0)
#define G_ISSUE_B() do { u0 = *(const uint4*)(ap); u1 = *(const uint4*)(ap + astep); u2 = *(const uint4*)(ap + 2 * astep); u3 = *(const uint4*)(ap + 3 * astep); \
    u4 = *(const uint4*)(bp); u5 = *(const uint4*)(bp + bstep); u6 = *(const uint4*)(bp + 2 * bstep); u7 = *(const uint4*)(bp + 3 * bstep); } while (0)
#define G_WRITE_A(sn) do { *(uint4*)((sn) + woff) = s0; *(uint4*)((sn) + woff + 64 * GS_STRIDE) = s1; *(uint4*)((sn) + woff + 128 * GS_STRIDE) = s2; \
    *(uint4*)((sn) + woff + 192 * GS_STRIDE) = s3; *(uint4*)((sn) + woff + 256 * GS_STRIDE) = s4; *(uint4*)((sn) + woff + 320 * GS_STRIDE) = s5; \
    *(uint4*)((sn) + woff + 384 * GS_STRIDE) = s6; *(uint4*)((sn) + woff + 448 * GS_STRIDE) = s7; } while (0)
#define G_WRITE_B(sn) do { *(uint4*)((sn) + woff) = u0; *(uint4*)((sn) + woff + 64 * GS_STRIDE) = u1; *(uint4*)((sn) + woff + 128 * GS_STRIDE) = u2; \
    *(uint4*)((sn) + woff + 192 * GS_STRIDE) = u3; *(uint4*)((sn) + woff + 256 * GS_STRIDE) = u4; *(uint4*)((sn) + woff + 320 * GS_STRIDE) = u5; \
    *(uint4*)((sn) + woff + 384 * GS_STRIDE) = u6; *(uint4*)((sn) + woff + 448 * GS_STRIDE) = u7; } while (0)
  const int aoff = (wm * 128 + r) * GS_STRIDE + h * 16;
  const int boff = (256 + wn * 64 + r) * GS_STRIDE + h * 16;
#define G_COMPUTE(st) do { _Pragma("unroll") for (int ks = 0; ks < 4; ++ks) {                                              \
      bf16x8 fa[4], fb[2];                                                                                               \
      _Pragma("unroll") for (int mi = 0; mi < 4; ++mi) fa[mi] = *(const bf16x8*)((st) + aoff + mi * 32 * GS_STRIDE + ks * 32); \
      fb[0] = *(const bf16x8*)((st) + boff + ks * 32);                                                                   \
      fb[1] = *(const bf16x8*)((st) + boff + 32 * GS_STRIDE + ks * 32);                                                  \
      _Pragma("unroll") for (int mi = 0; mi < 4; ++mi) {                                                                 \
        acc[mi][0] = MFMA(fa[mi], fb[0], acc[mi][0]);                                                                    \
        acc[mi][1] = MFMA(fa[mi], fb[1], acc[mi][1]);                                                                    \
      }                                                                                                                  \
      __builtin_amdgcn_sched_barrier(0);                                                                                 \
    } } while (0)
  G_ISSUE_A();
  G_WRITE_A(sbase);
  G_ADV(); G_ISSUE_A();
  G_ADV(); G_ISSUE_B();
  __syncthreads();
  for (int kt = 0; kt < nk; kt += 2) {
    G_WRITE_A(sbase + GS_STAGE);
    G_ADV(); G_ISSUE_A();
    __builtin_amdgcn_sched_barrier(0);
    G_COMPUTE(sbase);
    __syncthreads();
    G_WRITE_B(sbase);
    G_ADV(); G_ISSUE_B();
    __builtin_amdgcn_sched_barrier(0);
    G_COMPUTE(sbase + GS_STAGE);
    __syncthreads();
  }
#undef G_ADV
#undef G_ISSUE_A
#undef G_ISSUE_B
#undef G_WRITE_A
#undef G_WRITE_B
#undef G_COMPUTE
}

DI int rot_unused_(int) { return 0; }
DI bool tile_of(int i, int MT, int NT, int& mt, int& nt) {
  const int per = gridDim.x >> 3;
  const int L = i * (int)gridDim.x + (int)(blockIdx.x & 7) * per + (int)(blockIdx.x >> 3);
  if (L >= MT * NT) return false;
  const int nig = 8 * NT, gid = L / nig, fm = gid * 8, gsz = min(MT - fm, 8), rem = L - gid * nig;
  mt = fm + rem % gsz; nt = rem / gsz;
  return true;
}


template <class PF, class EF>
DI void gemm_stream(int lda, int ldw, int K, unsigned char* smem, PF ptrs, EF epi) {
  const int tid = otid(), lane = tid & 63, w = tid >> 6;
  const int wm = w >> 2, wn = w & 3, r = lane & 31, h = lane >> 5;
  unsigned char* sbase = smem + GS_BASE;
  constexpr int SLOT = 512 * 64;
  const int nh = K >> 5;
  const int c0 = (h ^ ((r >> 2) & 3)) * 16, c1 = c0 ^ 32;
  const int aoff = (wm * 128 + r) * 64, boff = (256 + wn * 64 + r) * 64;
  const int lr16 = lane >> 2, lchunk = (lane & 3) ^ ((lane >> 4) & 3);
  const int wu = __builtin_amdgcn_readfirstlane(w);
  const bool isB = wu >= 4;
  const unsigned goff = isB ? (unsigned)((((wu - 4) * 64 + 2 * lr16) * ldw + lchunk * 8) * 2)
                            : (unsigned)(((wu * 64 + lr16) * lda + lchunk * 8) * 2);
  const unsigned st1 = isB ? (unsigned)(32 * ldw * 2) : (unsigned)(16 * lda * 2);
  const unsigned st2 = isB ? (unsigned)(1 * ldw * 2) : (unsigned)(32 * lda * 2);
#define WAIT_V(n) asm volatile("s_waitcnt vmcnt(" #n ")" ::: "memory")
#define RAWBAR() do { asm volatile("s_waitcnt lgkmcnt(0)" ::: "memory"); __builtin_amdgcn_s_barrier(); asm volatile("" ::: "memory"); } while (0)
#define BAR0() do { asm volatile("" ::: "memory"); __builtin_amdgcn_s_barrier(); asm volatile("" ::: "memory"); } while (0)
#define H_DMA(slotp) do { const char* gsrc_ = (isB ? bp : ap) + goff; unsigned char* ld_ = (slotp) + wu * 4096;            \
    __builtin_amdgcn_global_load_lds((const unsigned*)(gsrc_), (unsigned*)(ld_), 16, 0, 0);                                  \
    __builtin_amdgcn_global_load_lds((const unsigned*)(gsrc_ + st1), (unsigned*)(ld_ + 1024), 16, 0, 0);                     \
    __builtin_amdgcn_global_load_lds((const unsigned*)(gsrc_ + st2), (unsigned*)(ld_ + 2048), 16, 0, 0);                     \
    __builtin_amdgcn_global_load_lds((const unsigned*)(gsrc_ + st2 + st1), (unsigned*)(ld_ + 3072), 16, 0, 0); } while (0)
#define H_READ(sl) do { _Pragma("unroll") for (int mi = 0; mi < 4; ++mi) {                                                   \
      fa[0][mi] = *(const bf16x8*)((sl) + aoff + mi * 2048 + c0); fa[1][mi] = *(const bf16x8*)((sl) + aoff + mi * 2048 + c1); } \
    fb[0][0] = *(const bf16x8*)((sl) + boff + c0); fb[1][0] = *(const bf16x8*)((sl) + boff + c1);                            \
    fb[0][1] = *(const bf16x8*)((sl) + boff + 2048 + c0); fb[1][1] = *(const bf16x8*)((sl) + boff + 2048 + c1); } while (0)
#define H_MMA() do { _Pragma("unroll") for (int ks = 0; ks < 2; ++ks) { _Pragma("unroll") for (int mi = 0; mi < 4; ++mi) {  \
      acc[mi][0] = MFMA(fa[ks][mi], fb[ks][0], acc[mi][0]);                                                       \
      acc[mi][1] = MFMA(fa[ks][mi], fb[ks][1], acc[mi][1]); } } } while (0)
  const char *ap, *bp;
  {
    const u16 *ta, *tb;
    int it0 = 0;
    asm volatile("" : "+s"(it0));
    if (!ptrs(it0, ta, tb)) return;
    ap = (const char*)ta; bp = (const char*)tb;
  }
  H_DMA(sbase); ap += 64; bp += 64;
  H_DMA(sbase + SLOT); ap += 64; bp += 64;
  for (int it = 0;; ++it) {
    f32x16 acc[4][2];
#pragma unroll
    for (int a = 0; a < 4; ++a)
#pragma unroll
      for (int b = 0; b < 2; ++b) zero16(acc[a][b]);
    H_DMA(sbase + 2 * SLOT); ap += 64; bp += 64;
    WAIT_V(4);
    BAR0();
    if (wm == 1) BAR0();
    int rs = 0;
#pragma unroll 1
    for (int hh = 0; hh < nh; ++hh) {
      bf16x8 fa[2][4], fb[2][2];
      const int rem = nh - 2 - hh;
      H_READ(sbase + rs * SLOT);
      if (hh + 3 < nh) { H_DMA(sbase + ((rs + 3) & 3) * SLOT); ap += 64; bp += 64; }
      if (wm == 1) {
        if (rem >= 2) WAIT_V(8); else if (rem == 1) WAIT_V(4); else WAIT_V(0);
      }
      __builtin_amdgcn_sched_barrier(0);
      RAWBAR();
      __builtin_amdgcn_sched_barrier(0);
      H_MMA();
      __builtin_amdgcn_sched_barrier(0);
      if (wm == 0) {
        if (rem >= 2) WAIT_V(8); else if (rem == 1) WAIT_V(4); else WAIT_V(0);
      }
      BAR0();
      rs = (rs + 1) & 3;
    }
    if (wm == 0) BAR0();
    bool more;
    {
      const u16 *ta, *tb;
      more = ptrs(it + 1, ta, tb);
      if (more) {
        ap = (const char*)ta; bp = (const char*)tb;
        H_DMA(sbase); ap += 64; bp += 64;
        H_DMA(sbase + SLOT); ap += 64; bp += 64;
      }
    }
    epi(it, acc);
    if (!more) break;
  }
#undef WAIT_V
#undef RAWBAR
#undef BAR0
#undef H_DMA
#undef H_READ
#undef H_MMA
}

DI int map_row(int maptype, int s) {
  if (maptype == 1) return s < 3072 ? s : (s < 3080 ? -1 : s - 8);
  if (maptype == 2) return s < 2816 ? 2 * s : 2 * (s - 2816) + 1;
  return s;
}
DI void transpose_task(const float* __restrict__ src, int Nsrc, u16* __restrict__ dst, int dld, int maptype, int kt2, int nt,
                       unsigned char* smem) {
  float* tile = (float*)(smem + 64);
  const int tid = otid();
  const int k0 = kt2 * 128, s0 = nt * 64;
  float4 v[4];
#pragma unroll
  for (int i = 0; i < 4; ++i) {
    const int kr = (tid >> 4) + 32 * i, nc = (tid & 15) * 4;
    v[i] = make_float4(0.f, 0.f, 0.f, 0.f);
    if (s0 + nc < Nsrc) v[i] = *(const float4*)(src + (size_t)(k0 + kr) * Nsrc + s0 + nc);
  }
#pragma unroll
  for (int i = 0; i < 4; ++i) {
    const int kr = (tid >> 4) + 32 * i, nc = (tid & 15) * 4;
    tile[kr * 65 + nc + 0] = v[i].x; tile[kr * 65 + nc + 1] = v[i].y; tile[kr * 65 + nc + 2] = v[i].z; tile[kr * 65 + nc + 3] = v[i].w;
  }
  __syncthreads();
  {
    const int n = tid >> 3;
    const int s = s0 + n;
    const int dr = (s < Nsrc) ? map_row(maptype, s) : -1;
    if (dr >= 0) {
#pragma unroll
      for (int j = 0; j < 2; ++j) {
        const int kc = (tid & 7) * 8 + 64 * j;
        uint4 o;
        o.x = pack2(tile[(kc + 0) * 65 + n], tile[(kc + 1) * 65 + n]);
        o.y = pack2(tile[(kc + 2) * 65 + n], tile[(kc + 3) * 65 + n]);
        o.z = pack2(tile[(kc + 4) * 65 + n], tile[(kc + 5) * 65 + n]);
        o.w = pack2(tile[(kc + 6) * 65 + n], tile[(kc + 7) * 65 + n]);
        *(uint4*)(dst + (size_t)dr * dld + k0 + kc) = o;
      }
    }
  }
  __syncthreads();
}

DI void adaln_task(const Params& p, int task, unsigned char* smem) {
  const int bhalf = task & 1, cg_ = (task >> 1) % 96, l = (task >> 1) / 96;
  float* cs = (float*)(smem + 64);
  float* red = (float*)(smem + 64 + 20 * 1024 * 4);
  const int tid = otid();
  const float* cp = p.in[2]; const float* csm = p.in[3];
  for (int idx = tid; idx < 20 * 1024; idx += NTHR) {
    const int bb = idx >> 10, d = idx & 1023, b = bhalf * 20 + bb;
    const float c = b < 32 ? cp[b * 1024 + d] : csm[(b - 32) * 1024 + d];
    cs[idx] = siluf_(c);
  }
  __syncthreads();
  const int dseg = tid >> 6, e = cg_ * 64 + (tid & 63);
  const float* wp = p.in[10] + ((size_t)l * 1024 + dseg * 128) * 6144 + e;
  float acc[20];
#pragma unroll
  for (int i = 0; i < 20; ++i) acc[i] = 0.f;
  for (int d = 0; d < 128; ++d) {
    const float wv = wp[(size_t)d * 6144];
    const float* c0 = cs + dseg * 128 + d;
#pragma unroll
    for (int i = 0; i < 20; ++i) acc[i] += c0[i * 1024] * wv;
  }
#pragma unroll
  for (int i = 0; i < 20; ++i) red[(dseg * 20 + i) * 64 + (tid & 63)] = acc[i];
  __syncthreads();
  float* mod = (float*)(p.ws + WS_MOD);
  for (int idx = tid; idx < 20 * 64; idx += NTHR) {
    const int bb = idx >> 6, ec = idx & 63;
    float s = 0.f;
#pragma unroll
    for (int q = 0; q < 8; ++q) s += red[(q * 20 + bb) * 64 + ec];
    const int ee = cg_ * 64 + ec;
    mod[((size_t)l * 40 + bhalf * 20 + bb) * 6144 + ee] = s + p.in[11][l * 6144 + ee];
  }
  __syncthreads();
}

DI void prologue(const Params& p, unsigned char* smem) {
  const int WT_TASKS_L = 456 + 256 + 64 + 64 + 128 + 704 + 352;
  const int N_WT = 2 * WT_TASKS_L;
  const int N_ADA = 384, N_CK = 512, N_CV = 1024;
  const int total = N_WT + N_ADA + N_CK + N_CV;
  for (int task = blockIdx.x; task < total; task += gridDim.x) {
    if (task < N_WT) {
      const int l = task / WT_TASKS_L; int t = task % WT_TASKS_L;
      if (t < 456) { transpose_task(p.in[12] + (size_t)l * 1024 * 3592, 3592, (u16*)(p.ws + WS_WT_IN) + (size_t)l * 3584 * 1024, 1024, 1, t / 57, t % 57, smem); continue; }
      t -= 456;
      if (t < 256) { transpose_task(p.in[21] + (size_t)l * 1024 * 2048, 2048, (u16*)(p.ws + WS_WT_GATE) + (size_t)l * 2048 * 1024, 1024, 0, t / 32, t % 32, smem); continue; }
      t -= 256;
      if (t < 64) { transpose_task(p.in[19] + (size_t)l * 512 * 1024, 1024, (u16*)(p.ws + WS_WT_BRA) + (size_t)l * 1024 * 512, 512, 0, t / 16, t % 16, smem); continue; }
      t -= 64;
      if (t < 64) { transpose_task(p.in[20] + (size_t)l * 512 * 1024, 1024, (u16*)(p.ws + WS_WT_BRB) + (size_t)l * 1024 * 512, 512, 0, t / 16, t % 16, smem); continue; }
      t -= 64;
      if (t < 128) { transpose_task(p.in[23] + (size_t)l * 1024 * 1024, 1024, (u16*)(p.ws + WS_WT_O) + (size_t)l * 1024 * 1024, 1024, 0, t / 16, t % 16, smem); continue; }
      t -= 128;
      if (t < 704) { transpose_task(p.in[26] + (size_t)l * 1024 * 5632, 5632, (u16*)(p.ws + WS_WT_GU) + (size_t)l * 5632 * 1024, 1024, 2, t / 88, t % 88, smem); continue; }
      t -= 704;
      transpose_task(p.in[27] + (size_t)l * 2816 * 1024, 1024, (u16*)(p.ws + WS_WT_DOWN) + (size_t)l * 1024 * 2816, 2816, 0, t / 16, t % 16, smem);
    } else if (task < N_WT + N_ADA) {
      adaln_task(p, task - N_WT, smem);
    } else if (task < N_WT + N_ADA + N_CK) {
      const int t = task - N_WT - N_ADA;
      const float4* src = (const float4*)p.in[4];
      u16* dst = (u16*)(p.ws + WS_KS);
#pragma unroll
      for (int i = 0; i < 8; ++i) {
        const size_t f4 = (size_t)t * 4096 + i * 512 + otid();
        const float4 v = src[f4];
        const size_t e = f4 * 4;
        const size_t lb = e / (1024 * 512), rem = e % (1024 * 512);
        uint2 o; o.x = pack2(v.x, v.y); o.y = pack2(v.z, v.w);
        *(uint2*)(dst + lb * (1056 * 512) + rem) = o;
      }
    } else {
      const int t = task - N_WT - N_ADA - N_CK;
      const int lb = t >> 6, tt = t & 63;
      transpose_task(p.in[5] + (size_t)lb * 1024 * 512, 512, (u16*)(p.ws + WS_VTS) + (size_t)lb * 512 * 1056, 1056, 0, tt >> 3, tt & 7, smem);
    }
  }
}

DI float wave_sum(float v, int lane) {
  (void)lane;
  int x = __float_as_int(v);
  v += __int_as_float(__builtin_amdgcn_update_dpp(0, x, 0xB1, 0xF, 0xF, true));
  x = __float_as_int(v);
  v += __int_as_float(__builtin_amdgcn_update_dpp(0, x, 0x4E, 0xF, 0xF, true));
  x = __float_as_int(v);
  v += __int_as_float(__builtin_amdgcn_update_dpp(0, x, 0x141, 0xF, 0xF, true));
  x = __float_as_int(v);
  v += __int_as_float(__builtin_amdgcn_update_dpp(0, x, 0x140, 0xF, 0xF, true));
  x = __float_as_int(v);
  const float r0 = __int_as_float(__builtin_amdgcn_readlane(x, 0)), r1 = __int_as_float(__builtin_amdgcn_readlane(x, 16));
  const float r2 = __int_as_float(__builtin_amdgcn_readlane(x, 32)), r3 = __int_as_float(__builtin_amdgcn_readlane(x, 48));
  return (r0 + r1) + (r2 + r3);
}
DI void ln_pass(const Params& p, int mode, int l, unsigned char* smem) {
  const int tid = otid();
  const int lane = tid & 63, w = tid >> 6;
  const bool first = mode != 0;
  const bool second = (mode != 2) || (l + 1 < 2);
  const bool gates = (mode == 0) || (mode == 2 && l + 1 < 2);
  const int lm = (mode == 2) ? l + 1 : l;
  const int shi = (mode == 1) ? 3 : 0;
  const float* lng = (mode == 1) ? p.in[24] + l * 1024 : p.in[28] + l * 1024;
  const float* lnb = (mode == 1) ? p.in[25] + l * 1024 : p.in[29] + l * 1024;
  const float* mod = (const float*)(p.ws + WS_MOD);
  u16* H = (u16*)(p.ws + WS_H);
  float* gout = (float*)(p.ws + WS_GATES);
  float* wl = (float*)(smem + 64);
  float bif[8];
  if (gates) {
    const float* wi = p.in[12] + (size_t)lm * 1024 * 3592 + 3072;
    for (int idx = tid; idx < 8192; idx += NTHR) {
      const int c = idx >> 3, j = idx & 7;
      wl[j * 1024 + c] = wi[(size_t)c * 3592 + j];
    }
#pragma unroll
    for (int j = 0; j < 8; ++j) bif[j] = p.in[13][lm * 8 + j];
  }
  __syncthreads();
  float lg[16], lb[16];
  if (first) {
#pragma unroll
    for (int i = 0; i < 4; ++i) {
      const float4 g = *(const float4*)(lng + i * 256 + lane * 4);
      const float4 b = *(const float4*)(lnb + i * 256 + lane * 4);
      lg[i * 4] = g.x; lg[i * 4 + 1] = g.y; lg[i * 4 + 2] = g.z; lg[i * 4 + 3] = g.w;
      lb[i * 4] = b.x; lb[i * 4 + 1] = b.y; lb[i * 4 + 2] = b.z; lb[i * 4 + 3] = b.w;
    }
  }
  const bool write_x = (mode == 2 && l == 1);
  float* stats = (float*)(p.ws + WS_STAT);
  auto process = [&](int row, float (&v)[16], const float (&msh)[16], const float (&msc)[16]) {
    float* xr = p.out + (size_t)row * 1024;
    if (first) {
      float s = 0.f;
#pragma unroll
      for (int i = 0; i < 16; ++i) s += v[i];
      const float mean = wave_sum(s, lane) * (1.f / 1024.f);
      float q = 0.f;
#pragma unroll
      for (int i = 0; i < 16; ++i) { v[i] -= mean; q += v[i] * v[i]; }
      const float rstd = rsqrtf(wave_sum(q, lane) * (1.f / 1024.f) + LN_EPS);
#pragma unroll
      for (int i = 0; i < 4; ++i) {
#pragma unroll
        for (int e = 0; e < 4; ++e) v[i * 4 + e] = v[i * 4 + e] * rstd * lg[i * 4 + e] + lb[i * 4 + e];
        if (write_x) *(float4*)(xr + i * 256 + lane * 4) = make_float4(v[i * 4 + 0], v[i * 4 + 1], v[i * 4 + 2], v[i * 4 + 3]);
      }
      if (!write_x && lane == 0) *(float2*)(stats + (size_t)row * 2) = make_float2(mean, rstd);
    }
    if (second) {
      float s = 0.f;
#pragma unroll
      for (int i = 0; i < 16; ++i) s += v[i];
      const float mean = wave_sum(s, lane) * (1.f / 1024.f);
      float q = 0.f;
#pragma unroll
      for (int i = 0; i < 16; ++i) { v[i] -= mean; q += v[i] * v[i]; }
      const float rstd = rsqrtf(wave_sum(q, lane) * (1.f / 1024.f) + LN_EPS);
#pragma unroll
      for (int i = 0; i < 4; ++i) {
#pragma unroll
        for (int e = 0; e < 4; ++e) v[i * 4 + e] = v[i * 4 + e] * rstd * msc[i * 4 + e] + msh[i * 4 + e];
        uint2 o; o.x = pack2(v[i * 4 + 0], v[i * 4 + 1]); o.y = pack2(v[i * 4 + 2], v[i * 4 + 3]);
        *(uint2*)(H + (size_t)row * 1024 + i * 256 + lane * 4) = o;
      }
      if (gates) {
        float g8[8];
#pragma unroll
        for (int j = 0; j < 8; ++j) {
          float s2 = 0.f;
#pragma unroll
          for (int i = 0; i < 4; ++i) {
            const float4 wv = *(const float4*)(wl + j * 1024 + i * 256 + lane * 4);
            s2 += v[i * 4] * wv.x + v[i * 4 + 1] * wv.y + v[i * 4 + 2] * wv.z + v[i * 4 + 3] * wv.w;
          }
          g8[j] = wave_sum(s2, lane) + bif[j];
        }
        if (lane == 0) {
          *(float4*)(gout + (size_t)row * 8) = make_float4(g8[0], g8[1], g8[2], g8[3]);
          *(float4*)(gout + (size_t)row * 8 + 4) = make_float4(g8[4], g8[5], g8[6], g8[7]);
        }
      }
    }
  };
  auto load_mod = [&](int row, float (&msh)[16], float (&msc)[16]) {
    const float* mb = mod + ((size_t)lm * 40 + batch_of_row(row)) * 6144;
#pragma unroll
    for (int i = 0; i < 4; ++i) {
      const float4 sh = *(const float4*)(mb + shi * 1024 + i * 256 + lane * 4);
      const float4 sc = *(const float4*)(mb + (shi + 1) * 1024 + i * 256 + lane * 4);
      msh[i * 4] = sh.x; msh[i * 4 + 1] = sh.y; msh[i * 4 + 2] = sh.z; msh[i * 4 + 3] = sh.w;
      msc[i * 4] = 1.f + sc.x; msc[i * 4 + 1] = 1.f + sc.y; msc[i * 4 + 2] = 1.f + sc.z; msc[i * 4 + 3] = 1.f + sc.w;
    }
  };
  for (int chunk = blockIdx.x * 8 + w; chunk < TOKP / 32; chunk += gridDim.x * 8) {
    const int row0 = chunk * 32;
    float msh[16], msc[16];
    if (second) load_mod(row0, msh, msc);
    const float* src0 = (mode == 0) ? p.in[0] + (size_t)row0 * 1024 : p.out + (size_t)row0 * 1024;
    float4 nx0 = *(const float4*)(src0 + lane * 4), nx1 = *(const float4*)(src0 + 256 + lane * 4);
    float4 nx2 = *(const float4*)(src0 + 512 + lane * 4), nx3 = *(const float4*)(src0 + 768 + lane * 4);
    for (int ri = 0; ri < 32; ++ri) {
      float v[16];
      v[0] = nx0.x; v[1] = nx0.y; v[2] = nx0.z; v[3] = nx0.w; v[4] = nx1.x; v[5] = nx1.y; v[6] = nx1.z; v[7] = nx1.w;
      v[8] = nx2.x; v[9] = nx2.y; v[10] = nx2.z; v[11] = nx2.w; v[12] = nx3.x; v[13] = nx3.y; v[14] = nx3.z; v[15] = nx3.w;
      {
        const float* sn = src0 + (size_t)(ri < 31 ? ri + 1 : 31) * 1024;
        nx0 = *(const float4*)(sn + lane * 4); nx1 = *(const float4*)(sn + 256 + lane * 4);
        nx2 = *(const float4*)(sn + 512 + lane * 4); nx3 = *(const float4*)(sn + 768 + lane * 4);
      }
      __builtin_amdgcn_sched_barrier(0);
      process(row0 + ri, v, msh, msc);
    }
  }
  if (w == 0) {
    for (int row = TOKP + blockIdx.x; row < TOK; row += gridDim.x) {
      float msh[16], msc[16];
      if (second) load_mod(row, msh, msc);
      const float* src = (mode == 0) ? p.in[1] + (size_t)(row - TOKP) * 1024 : p.out + (size_t)row * 1024;
      float v[16];
#pragma unroll
      for (int i = 0; i < 4; ++i) {
        const float4 t = *(const float4*)(src + i * 256 + lane * 4);
        v[i * 4 + 0] = t.x; v[i * 4 + 1] = t.y; v[i * 4 + 2] = t.z; v[i * 4 + 3] = t.w;
      }
      process(row, v, msh, msc);
    }
  }
}


DI void micro_partial(f32x16& acc, const u16* A, int lda, const u16* Wt, int ldw, int K, int row0, int n0, int w, int r, int h) {
  const int kb = w * (K >> 3), n16 = K >> 7;
  const u16* ap = A + (size_t)(row0 + r) * lda + kb + h * 8;
  const u16* bp = Wt + (size_t)(n0 + r) * ldw + kb + h * 8;
#pragma unroll 4
  for (int k = 0; k < n16; ++k) {
    const bf16x8 a = *(const bf16x8*)(ap + k * 16);
    const bf16x8 b = *(const bf16x8*)(bp + k * 16);
    acc = MFMA(a, b, acc);
  }
}
DI void micro_reduce_store(const f32x16& acc, float* red, int w, int lane) {
#pragma unroll
  for (int i = 0; i < 16; ++i) red[(w * 16 + i) * 64 + lane] = acc[i];
}
DI float micro_sum(const float* red, int i, int lane) {
  float s = 0.f;
#pragma unroll
  for (int q = 0; q < 8; ++q) s += red[(q * 16 + i) * 64 + lane];
  return s;
}

constexpr int EP_LD = 264;
constexpr int EP_LDT = 68;
DI void zero_acc(f32x16 (&acc)[4][2]) {
#pragma unroll
  for (int a = 0; a < 4; ++a)
#pragma unroll
    for (int b = 0; b < 2; ++b) zero16(acc[a][b]);
}
DI void stage_rm(const f32x16& a0, const f32x16& a1, float* stg, int wm, int wn, int r, int h) {
#pragma unroll
  for (int i = 0; i < 16; ++i) *(float2*)(stg + (wm * 32 + crow(i, h)) * EP_LD + wn * 64 + 2 * r) = make_float2(a0[i], a1[i]);
}
DI void stage_tr(const f32x16& a0, const f32x16& a1, float* stg, int wm, int wn, int r, int h) {
#pragma unroll
  for (int g = 0; g < 4; ++g) {
    *(float4*)(stg + (wn * 64 + 2 * r) * EP_LDT + wm * 32 + 8 * g + 4 * h) = make_float4(a0[4 * g], a0[4 * g + 1], a0[4 * g + 2], a0[4 * g + 3]);
    *(float4*)(stg + (wn * 64 + 2 * r + 1) * EP_LDT + wm * 32 + 8 * g + 4 * h) = make_float4(a1[4 * g], a1[4 * g + 1], a1[4 * g + 2], a1[4 * g + 3]);
  }
}
DI int grow_of(int m0, int mi, int lr) { return m0 + (lr >> 5) * 128 + mi * 32 + (lr & 31); }
DI uint4 pack8f(const float4& a, const float4& b) {
  uint4 o; o.x = pack2(a.x, a.y); o.y = pack2(a.z, a.w); o.z = pack2(b.x, b.y); o.w = pack2(b.z, b.w); return o;
}

DI void write_tr(const Params& p, int l, int m0, int mi, const float* stg, int tid, int which, int chbase) {
  const bool prompt = m0 < TOKP;
#pragma unroll 1
  for (int q = 0; q < 4; ++q) {
    const int cid = q * NTHR + tid, ch = cid >> 3, tc = cid & 7;
    const float4 v0 = *(const float4*)(stg + ch * EP_LDT + tc * 8);
    const float4 v1 = *(const float4*)(stg + ch * EP_LDT + tc * 8 + 4);
    const int row0 = grow_of(m0, mi, tc * 8);
    const int chg = chbase + ch;
    u16* d;
    if (prompt) {
      const int b = row0 >> 11, t = row0 & 2047;
      if (which == 0) d = (u16*)(p.ws + WS_VTP) + ((size_t)b * 512 + chg) * 2048 + t;
      else if (which == 1) d = (u16*)(p.ws + WS_MQKT_P) + ((size_t)b * 1024 + chg) * 2048 + t;
      else d = (u16*)(p.ws + WS_MVT_P) + ((size_t)b * 512 + chg) * 2048 + t;
    } else {
      const int rs = row0 - TOKP, bs = rs >> 5, t = rs & 31;
      if (which == 0) d = (u16*)(p.ws + WS_VTS) + ((size_t)(l * 8 + bs) * 512 + chg) * 1056 + 1024 + t;
      else if (which == 1) d = (u16*)(p.ws + WS_MQKT_S) + ((size_t)bs * 1024 + chg) * 32 + t;
      else d = (u16*)(p.ws + WS_MVT_S) + ((size_t)bs * 512 + chg) * 32 + t;
    }
    *(uint4*)d = pack8f(v0, v1);
  }
}

DI void epi_in(const Params& p, int l, int m0, int n0, f32x16 (&acc)[4][2], unsigned char* smem) {
  const int tid = otid(), lane = tid & 63, w = tid >> 6;
  const int wm = w >> 2, wn = w & 3, r = lane & 31, h = lane >> 5;
  const bool prompt = m0 < TOKP;
  float* stg = (float*)(smem + GS_BASE + GS_STAGE);
  const int seg = n0 < 512 ? 0 : (n0 < 1024 ? 1 : (n0 < 1536 ? 2 : (n0 < 2560 ? 3 : (n0 < 3072 ? 4 : 5))));
  if (seg == 3) {
    const int ch = n0 - 1536 + wn * 64 + 2 * r;
#pragma unroll
    for (int mi = 0; mi < 4; ++mi) {
      const int rb = m0 + wm * 128 + mi * 32 + 4 * h;
#pragma unroll
      for (int i = 0; i < 16; ++i) {
        const int row = rb + (i & 3) + 8 * (i >> 2);
        if (prompt) {
          const int tt = row & 2047;
          if (tt >= 2045) *(float2*)(p.out + O_CVP + ((size_t)(l * 32 + (row >> 11)) * 3 + (tt - 2045)) * 1024 + ch) = make_float2(acc[mi][0][i], acc[mi][1][i]);
        } else {
          const int rs = row - TOKP, tt = rs & 31;
          if (tt >= 29) *(float2*)(p.out + O_CVS + ((size_t)(l * 8 + (rs >> 5)) * 3 + (tt - 29)) * 1024 + ch) = make_float2(acc[mi][0][i], acc[mi][1][i]);
        }
      }
    }
  }
#pragma unroll
  for (int mi = 0; mi < 4; ++mi) {
    if (seg == 0 || seg == 1 || seg == 2 || seg == 5) {
      __syncthreads();
      stage_rm(acc[mi][0], acc[mi][1], stg, wm, wn, r, h);
      __syncthreads();
#pragma unroll 1
      for (int q = 0; q < 4; ++q) {
        const int cid = q * NTHR + tid, lr = cid >> 5, c8 = (cid & 31) * 8;
        const float4 v0 = *(const float4*)(stg + lr * EP_LD + c8);
        const float4 v1 = *(const float4*)(stg + lr * EP_LD + c8 + 4);
        const int row = grow_of(m0, mi, lr);
        const int n = n0 + c8;
        if (seg == 0) {
          *(uint4*)((u16*)(p.ws + WS_ZQ) + (size_t)row * 512 + n) = pack8f(v0, v1);
        } else if (seg == 5) {
          const float4 s0 = make_float4(sigmoidf_(v0.x), sigmoidf_(v0.y), sigmoidf_(v0.z), sigmoidf_(v0.w));
          const float4 s1 = make_float4(sigmoidf_(v1.x), sigmoidf_(v1.y), sigmoidf_(v1.z), sigmoidf_(v1.w));
          *(uint4*)((u16*)(p.ws + WS_MO) + (size_t)row * 512 + (n - 3072)) = pack8f(s0, s1);
        } else {
          const bool isk = seg == 1;
          const int nn = n - (isk ? 512 : 1024);
          float* of = p.out + (isk ? (prompt ? O_KP : O_KSM) : (prompt ? O_VP : O_VSM));
          const size_t orow = prompt ? ((size_t)l * TOKP + row) : ((size_t)l * TOKS + (row - TOKP));
          *(float4*)(of + orow * 512 + nn) = v0;
          *(float4*)(of + orow * 512 + nn + 4) = v1;
          if (isk) {
            u16* kd;
            if (prompt) kd = (u16*)(p.ws + WS_KB) + (size_t)row * 512 + nn;
            else { const int rs = row - TOKP; kd = (u16*)(p.ws + WS_KS) + ((size_t)(l * 8 + (rs >> 5)) * 1056 + 1024 + (rs & 31)) * 512 + nn; }
            *(uint4*)kd = pack8f(v0, v1);
          }
        }
      }
    }
    if (seg == 2 || seg == 3 || seg == 4) {
      __syncthreads();
      stage_tr(acc[mi][0], acc[mi][1], stg, wm, wn, r, h);
      __syncthreads();
      write_tr(p, l, m0, mi, stg, tid, seg == 2 ? 0 : (seg == 3 ? 1 : 2), n0 - (seg == 2 ? 1024 : (seg == 3 ? 1536 : 2560)));
    }
  }
  __syncthreads();
}

DI void phase_in_gate(const Params& p, int l, unsigned char* smem) {
  const int tid = otid(), lane = tid & 63, w = tid >> 6;
  const int wm = w >> 2, wn = w & 3, r = lane & 31, h = lane >> 5;
  const u16* H = (const u16*)(p.ws + WS_H);
  const u16* Win = (const u16*)(p.ws + WS_WT_IN) + (size_t)l * 3584 * 1024;
  const u16* Wg = (const u16*)(p.ws + WS_WT_GATE) + (size_t)l * 2048 * 1024;
  float* stg = (float*)(smem + GS_BASE + GS_STAGE);
  const int NT = 14 + 8, MT = 257;
  auto ptrs = [&](int it, const u16*& ap, const u16*& bp) -> bool {
    int mt, nt;
    if (!tile_of(it, MT, NT, mt, nt)) return false;
    ap = H + (size_t)(mt * 256) * 1024;
    bp = (nt < 14 ? Win + (size_t)(nt * 256) * 1024 : Wg + (size_t)((nt - 14) * 256) * 1024);
    return true;
  };
  auto epi = [&](int it, f32x16 (&acc)[4][2]) {
    const int tid = otid(), lane = tid & 63, w = tid >> 6;
    const int wm = w >> 2, wn = w & 3, r = lane & 31, h = lane >> 5;
    int mt, nt;
    tile_of(it, MT, NT, mt, nt);
    const int m0 = mt * 256;
    if (nt < 14) {
      epi_in(p, l, m0, nt * 256, acc, smem);
    } else {
      const int n0 = (nt - 14) * 256;
      u16* G = (u16*)(p.ws + WS_G);
#pragma unroll
      for (int mi = 0; mi < 4; ++mi) {
        __syncthreads();
        stage_rm(acc[mi][0], acc[mi][1], stg, wm, wn, r, h);
        __syncthreads();
#pragma unroll 1
        for (int q = 0; q < 4; ++q) {
          const int cid = q * NTHR + tid, lr = cid >> 5, c8 = (cid & 31) * 8;
          float4 v0 = *(const float4*)(stg + lr * EP_LD + c8);
          float4 v1 = *(const float4*)(stg + lr * EP_LD + c8 + 4);
          const int row = grow_of(m0, mi, lr), n = n0 + c8;
          const float4 b0 = *(const float4*)(p.in[22] + l * 2048 + n);
          const float4 b1 = *(const float4*)(p.in[22] + l * 2048 + n + 4);
          v0 = make_float4(sigmoidf_(v0.x + b0.x), sigmoidf_(v0.y + b0.y), sigmoidf_(v0.z + b0.z), sigmoidf_(v0.w + b0.w));
          v1 = make_float4(sigmoidf_(v1.x + b1.x), sigmoidf_(v1.y + b1.y), sigmoidf_(v1.z + b1.z), sigmoidf_(v1.w + b1.w));
          *(uint4*)(G + (size_t)row * 2048 + n) = pack8f(v0, v1);
        }
      }
      __syncthreads();
    }
  };
  gemm_stream(1024, 1024, 1024, smem, ptrs, epi);
}

DI void phase_mix(const Params& p, int l, unsigned char* smem) {
  const int tid = otid(), lane = tid & 63, w = tid >> 6;
  const int wm = w >> 2, wn = w & 3, r = lane & 31, h = lane >> 5;
  const u16* G = (const u16*)(p.ws + WS_G);
  u16* MIX = (u16*)(p.ws + WS_MIX);
  float* stg = (float*)(smem + GS_BASE + GS_STAGE);
  const int NT = 4, MT = 256;
  auto ptrs = [&](int it, const u16*& ap, const u16*& bp) -> bool {
    int mt, nt;
    if (!tile_of(it >> 1, MT, NT, mt, nt)) return false;
    const int half = it & 1;
    ap = (const u16*)(p.ws + (half ? WS_MN : WS_AN)) + (size_t)(mt * 256) * 512;
    bp = (const u16*)(p.ws + (half ? WS_WT_BRB : WS_WT_BRA)) + (size_t)l * 1024 * 512 + (size_t)(nt * 256) * 512;
    return true;
  };
  auto epi = [&](int it, f32x16 (&acc)[4][2]) {
    const int tid = otid(), lane = tid & 63, w = tid >> 6;
    const int wm = w >> 2, wn = w & 3, r = lane & 31, h = lane >> 5;
    int mt, nt;
    tile_of(it >> 1, MT, NT, mt, nt);
    const int half = it & 1;
    const int m0 = mt * 256, n0 = nt * 256;
#pragma unroll
    for (int mi = 0; mi < 4; ++mi) {
      __syncthreads();
      stage_rm(acc[mi][0], acc[mi][1], stg, wm, wn, r, h);
      __syncthreads();
#pragma unroll 1
      for (int q = 0; q < 4; ++q) {
        const int cid = q * NTHR + tid, lr = cid >> 5, c8 = (cid & 31) * 8;
        const float4 v0 = *(const float4*)(stg + lr * EP_LD + c8);
        const float4 v1 = *(const float4*)(stg + lr * EP_LD + c8 + 4);
        const int row = grow_of(m0, mi, lr), n = n0 + c8;
        const uint4 g = *(const uint4*)(G + (size_t)row * 2048 + half * 1024 + n);
        float4 o0 = make_float4(bflo(g.x) * v0.x, bfhi(g.x) * v0.y, bflo(g.y) * v0.z, bfhi(g.y) * v0.w);
        float4 o1 = make_float4(bflo(g.z) * v1.x, bfhi(g.z) * v1.y, bflo(g.w) * v1.z, bfhi(g.w) * v1.w);
        uint4* mp = (uint4*)(MIX + (size_t)row * 1024 + n);
        if (half) {
          const uint4 pr = *mp;
          o0.x += bflo(pr.x); o0.y += bfhi(pr.x); o0.z += bflo(pr.y); o0.w += bfhi(pr.y);
          o1.x += bflo(pr.z); o1.y += bfhi(pr.z); o1.z += bflo(pr.w); o1.w += bfhi(pr.w);
        }
        *mp = pack8f(o0, o1);
      }
    }
    __syncthreads();
  };
  gemm_stream(512, 512, 512, smem, ptrs, epi);
  {
    const int tid2 = otid(), lane = tid2 & 63, w = tid2 >> 6, r = lane & 31, h = lane >> 5;
    float* red = (float*)(smem + 64);
    for (int mtile = blockIdx.x; mtile < 256; mtile += gridDim.x) {
      const int row0 = TOKP + (mtile >> 5) * 32, n0 = (mtile & 31) * 32;
      f32x16 pa, pb;
      zero16(pa); zero16(pb);
      micro_partial(pa, (const u16*)(p.ws + WS_AN), 512, (const u16*)(p.ws + WS_WT_BRA) + (size_t)l * 1024 * 512, 512, 512, row0, n0, w, r, h);
      micro_partial(pb, (const u16*)(p.ws + WS_MN), 512, (const u16*)(p.ws + WS_WT_BRB) + (size_t)l * 1024 * 512, 512, 512, row0, n0, w, r, h);
      __syncthreads();
      micro_reduce_store(pa, red, w, lane);
      micro_reduce_store(pb, red + 8192, w, lane);
      __syncthreads();
#pragma unroll
      for (int q = 0; q < 2; ++q) {
        const int i = w + 8 * q;
        const float sa = micro_sum(red, i, lane), sb = micro_sum(red + 8192, i, lane);
        const int row = row0 + crow(i, h), n = n0 + r;
        const float ga = bf2f(G[(size_t)row * 2048 + n]), gb = bf2f(G[(size_t)row * 2048 + 1024 + n]);
        MIX[(size_t)row * 1024 + n] = f2bf(ga * sa + gb * sb);
      }
    }
    __syncthreads();
  }
}

DI void phase_res(const Params& p, int l, int mode, unsigned char* smem) {
  const int tid = otid(), lane = tid & 63, w = tid >> 6;
  const int wm = w >> 2, wn = w & 3, r = lane & 31, h = lane >> 5;
  const float* mod = (const float*)(p.ws + WS_MOD);
  float* stg = (float*)(smem + GS_BASE + GS_STAGE);
  const int NT = 4, MT = 256;
  const int K = (mode == 0) ? 1024 : 2816;
  const u16* Ab = (const u16*)(p.ws + (mode == 0 ? WS_MIX : WS_ACT));
  const u16* Wb = (mode == 0) ? (const u16*)(p.ws + WS_WT_O) + (size_t)l * 1024 * 1024 : (const u16*)(p.ws + WS_WT_DOWN) + (size_t)l * 1024 * 2816;
  const int gi = (mode == 0) ? 2 : 5;
  const float* stats = (const float*)(p.ws + WS_STAT);
  const float* rlg = (mode == 1) ? p.in[24] + l * 1024 : p.in[28] + (l > 0 ? l - 1 : 0) * 1024;
  const float* rlb = (mode == 1) ? p.in[25] + l * 1024 : p.in[29] + (l > 0 ? l - 1 : 0) * 1024;
  auto ptrs = [&](int it, const u16*& ap, const u16*& bp) -> bool {
    int mt, nt;
    if (!tile_of(it, MT, NT, mt, nt)) return false;
    ap = Ab + (size_t)(mt * 256) * K;
    bp = Wb + (size_t)(nt * 256) * K;
    return true;
  };
  auto epi = [&](int it, f32x16 (&acc)[4][2]) {
    const int tid = otid(), lane = tid & 63, w = tid >> 6;
    const int wm = w >> 2, wn = w & 3, r = lane & 31, h = lane >> 5;
    int mt, nt;
    tile_of(it, MT, NT, mt, nt);
    const int m0 = mt * 256, n0 = nt * 256;
#pragma unroll
    for (int mi = 0; mi < 4; ++mi) {
      __syncthreads();
      stage_rm(acc[mi][0], acc[mi][1], stg, wm, wn, r, h);
      __syncthreads();
#pragma unroll 1
      for (int q = 0; q < 8; ++q) {
        const int cid = q * NTHR + tid, lr = cid >> 6, c4 = (cid & 63) * 4;
        const float4 v = *(const float4*)(stg + lr * EP_LD + c4);
        const int row = grow_of(m0, mi, lr), n = n0 + c4;
        const int b = batch_of_row(row);
        const float4 gg = *(const float4*)(mod + ((size_t)l * 40 + b) * 6144 + gi * 1024 + n);
        float* xr = p.out + (size_t)row * 1024 + n;
        const float* xs = (mode == 0 && l == 0) ? (row < TOKP ? p.in[0] + (size_t)row * 1024 + n : p.in[1] + (size_t)(row - TOKP) * 1024 + n) : xr;
        float4 xv = *(const float4*)xs;
        if (!(mode == 0 && l == 0)) {
          const float2 st = *(const float2*)(stats + (size_t)row * 2);
          const float4 g4 = *(const float4*)(rlg + n), b4 = *(const float4*)(rlb + n);
          xv.x = (xv.x - st.x) * st.y * g4.x + b4.x; xv.y = (xv.y - st.x) * st.y * g4.y + b4.y;
          xv.z = (xv.z - st.x) * st.y * g4.z + b4.z; xv.w = (xv.w - st.x) * st.y * g4.w + b4.w;
        }
        *(float4*)xr = make_float4(ALPHA * xv.x + (1.f + gg.x) * v.x, ALPHA * xv.y + (1.f + gg.y) * v.y,
                                   ALPHA * xv.z + (1.f + gg.z) * v.z, ALPHA * xv.w + (1.f + gg.w) * v.w);
      }
    }
    __syncthreads();
  };
  gemm_stream(K, K, K, smem, ptrs, epi);
  {
    const int tid2 = otid(), lane = tid2 & 63, w = tid2 >> 6, r = lane & 31, h = lane >> 5;
    float* red = (float*)(smem + 64);
    for (int mtile = blockIdx.x; mtile < 256; mtile += gridDim.x) {
      const int row0 = TOKP + (mtile >> 5) * 32, n0 = (mtile & 31) * 32;
      f32x16 pa;
      zero16(pa);
      micro_partial(pa, Ab, K, Wb, K, K, row0, n0, w, r, h);
      __syncthreads();
      micro_reduce_store(pa, red, w, lane);
      __syncthreads();
#pragma unroll
      for (int q = 0; q < 2; ++q) {
        const int i = w + 8 * q;
        const float sa = micro_sum(red, i, lane);
        const int row = row0 + crow(i, h), n = n0 + r;
        const float gg = mod[((size_t)l * 40 + batch_of_row(row)) * 6144 + gi * 1024 + n];
        float* xr = p.out + (size_t)row * 1024 + n;
        float xv = (mode == 0 && l == 0) ? p.in[1][(size_t)(row - TOKP) * 1024 + n] : *xr;
        if (!(mode == 0 && l == 0)) {
          const float2 st = *(const float2*)(stats + (size_t)row * 2);
          xv = (xv - st.x) * st.y * rlg[n] + rlb[n];
        }
        *xr = ALPHA * xv + (1.f + gg) * sa;
      }
    }
    __syncthreads();
  }
}

DI void phase_gu(const Params& p, int l, unsigned char* smem) {
  const int tid = otid(), lane = tid & 63, w = tid >> 6;
  const int wm = w >> 2, wn = w & 3, r = lane & 31, h = lane >> 5;
  u16* ACT = (u16*)(p.ws + WS_ACT);
  const u16* Hh = (const u16*)(p.ws + WS_H);
  const u16* Wb = (const u16*)(p.ws + WS_WT_GU) + (size_t)l * 5632 * 1024;
  float* stg = (float*)(smem + GS_BASE + GS_STAGE);
  const int NT = 22, MT = 257;
  auto ptrs = [&](int it, const u16*& ap, const u16*& bp) -> bool {
    int mt, nt;
    if (!tile_of(it, MT, NT, mt, nt)) return false;
    ap = Hh + (size_t)(mt * 256) * 1024;
    bp = Wb + (size_t)(nt * 256) * 1024;
    return true;
  };
  auto epi = [&](int it, f32x16 (&acc)[4][2]) {
    const int tid = otid(), lane = tid & 63, w = tid >> 6;
    const int wm = w >> 2, wn = w & 3, r = lane & 31, h = lane >> 5;
    int mt, nt;
    tile_of(it, MT, NT, mt, nt);
    const int m0 = mt * 256, n0 = nt * 256;
#pragma unroll
    for (int ps = 0; ps < 2; ++ps) {
      __syncthreads();
#pragma unroll
      for (int q = 0; q < 2; ++q) {
        const int mi = 2 * ps + q;
#pragma unroll
        for (int i = 0; i < 16; ++i)
          stg[(q * 64 + wm * 32 + crow(i, h)) * 132 + wn * 32 + r] = siluf_(acc[mi][0][i]) * acc[mi][1][i];
      }
      __syncthreads();
#pragma unroll
      for (int q = 0; q < 4; ++q) {
        const int cid = q * NTHR + tid, lr = cid >> 4, c8 = (cid & 15) * 8;
        const float4 v0 = *(const float4*)(stg + lr * 132 + c8);
        const float4 v1 = *(const float4*)(stg + lr * 132 + c8 + 4);
        const int row = m0 + ((lr >> 5) & 1) * 128 + (2 * ps + (lr >> 6)) * 32 + (lr & 31);
        *(uint4*)(ACT + (size_t)row * 2816 + (n0 >> 1) + c8) = pack8f(v0, v1);
      }
    }
    __syncthreads();
  };
  gemm_stream(1024, 1024, 1024, smem, ptrs, epi);
}

constexpr int AT_BASE = 64;
constexpr int AT_KBYTES = 64 * 272;
constexpr int AT_VBYTES = 128 * 136;
constexpr int AT_STAGE = AT_KBYTES + AT_VBYTES;

DI void attn_item(const Params& p, int l, int b, int head, int qt, float lam, float lam_init, unsigned char* smem) {
  const int tid = otid(), lane = tid & 63, w = tid >> 6, r = lane & 31, h = lane >> 5;
  const int comp = w & 1, rg = w >> 1;
  const bool prompt = b < 32;
  const int bs = b - 32;
  const u16* Kg = prompt ? (const u16*)(p.ws + WS_KB) + (size_t)b * 2048 * 512 : (const u16*)(p.ws + WS_KS) + (size_t)(l * 8 + bs) * 1056 * 512;
  const u16* Vg = prompt ? (const u16*)(p.ws + WS_VTP) + (size_t)b * 512 * 2048 : (const u16*)(p.ws + WS_VTS) + (size_t)(l * 8 + bs) * 512 * 1056;
  const int ldT = prompt ? 2048 : 1056;
  const int nkt = prompt ? 2 * qt + 2 : 17;
  const int nkeys = prompt ? 2048 : 1056;
  const int qtok0 = prompt ? b * 2048 + qt * 128 : TOKP + bs * 32;
  const int qpos0 = prompt ? qt * 128 : 1024;
  const bool active = prompt || rg == 0;
  const int my_nkt = prompt ? (rg < 2 ? nkt - 1 : nkt) : nkt;
  const u16* ZQ = (const u16*)(p.ws + WS_ZQ);
  bf16x8 qf[4];
  {
    const int qrow = active ? qtok0 + rg * 32 + r : qtok0;
#pragma unroll
    for (int ks = 0; ks < 4; ++ks) {
      const uint4 qq = *(const uint4*)(ZQ + (size_t)qrow * 512 + head * 128 + comp * 64 + ks * 16 + h * 8);
      const float cq = 0.125f * LOG2E;
      uint4 qs_;
      qs_.x = pack2(bflo(qq.x) * cq, bfhi(qq.x) * cq); qs_.y = pack2(bflo(qq.y) * cq, bfhi(qq.y) * cq);
      qs_.z = pack2(bflo(qq.z) * cq, bfhi(qq.z) * cq); qs_.w = pack2(bflo(qq.w) * cq, bfhi(qq.w) * cq);
      qf[ks] = __builtin_bit_cast(bf16x8, qs_);
    }
  }
  const float slope2 = exp2f(-2.f * (head + 1)) * LOG2E;
  const float c1 = 0.125f * LOG2E;
  const int qpos = qpos0 + rg * 32 + r;
  f32x16 O[4];
#pragma unroll
  for (int i = 0; i < 4; ++i) zero16(O[i]);
  float m_run = -INFINITY, l_run = 0.f;

  const int krow = tid >> 4, kcc = tid & 15;
  const int vrow = tid >> 3, vcc = tid & 7;
  const u16* kp = Kg + (size_t)((nkt - 1) * 64 + krow) * 512 + head * 128 + kcc * 8;
  const u16* vp = Vg + (size_t)(head * 128 + vrow) * ldT + (nkt - 1) * 64 + vcc * 8;
  uint4 rk0, rk1, rv0, rv1;
  unsigned char* sb = smem + AT_BASE;
  rk0 = *(const uint4*)kp; rk1 = *(const uint4*)(kp + 32 * 512);
  rv0 = *(const uint4*)vp; rv1 = *(const uint4*)(vp + (size_t)64 * ldT);
  {
    *(uint4*)(sb + krow * 272 + kcc * 16) = rk0;
    *(uint4*)(sb + (krow + 32) * 272 + kcc * 16) = rk1;
    *(uint2*)(sb + AT_KBYTES + vrow * 136 + vcc * 16) = make_uint2(rv0.x, rv0.y);
    *(uint2*)(sb + AT_KBYTES + vrow * 136 + vcc * 16 + 8) = make_uint2(rv0.z, rv0.w);
    *(uint2*)(sb + AT_KBYTES + (vrow + 64) * 136 + vcc * 16) = make_uint2(rv1.x, rv1.y);
    *(uint2*)(sb + AT_KBYTES + (vrow + 64) * 136 + vcc * 16 + 8) = make_uint2(rv1.z, rv1.w);
  }
  __syncthreads();
  for (int j = 0; j < nkt; ++j) {
    const int kt = nkt - 1 - j;
    const bool more = j + 1 < nkt;
    if (more) {
      kp -= 64 * 512; vp -= 64;
      rk0 = *(const uint4*)kp; rk1 = *(const uint4*)(kp + 32 * 512);
      rv0 = *(const uint4*)vp; rv1 = *(const uint4*)(vp + (size_t)64 * ldT);
    }
    if (active && kt < my_nkt) {
      const unsigned char* Kt = sb + (j & 1) * AT_STAGE;
      const unsigned char* Vt = Kt + AT_KBYTES;
      f32x16 s[2];
      const bool past = (kt * 64 + 63) < (qpos0 + rg * 32);
      if (past) {
        const float kb0 = slope2 * (float)(kt * 64 + 4 * h);
#pragma unroll
        for (int sub = 0; sub < 2; ++sub)
#pragma unroll
          for (int i = 0; i < 16; ++i) s[sub][i] = __builtin_fmaf(slope2, (float)(sub * 32 + (i & 3) + 8 * (i >> 2)), kb0);
      } else {
        zero16(s[0]); zero16(s[1]);
      }
#pragma unroll
      for (int ks = 0; ks < 4; ++ks) {
#pragma unroll
        for (int sub = 0; sub < 2; ++sub) {
          const bf16x8 kf = *(const bf16x8*)(Kt + (sub * 32 + r) * 272 + (comp * 64 + ks * 16 + h * 8) * 2);
          s[sub] = MFMA(kf, qf[ks], s[sub]);
        }
      }
      float mx = -INFINITY;
      if (!past) {
        const float qk0 = (float)(qpos - kt * 64 - 4 * h);
        const float qb = slope2 * (float)qpos;
#pragma unroll
        for (int sub = 0; sub < 2; ++sub)
#pragma unroll
          for (int i = 0; i < 16; ++i) {
            const float d = qk0 - (float)(sub * 32 + (i & 3) + 8 * (i >> 2));
            s[sub][i] = s[sub][i] - slope2 * fabsf(d) + qb;
          }
      }
      if (!prompt) {
#pragma unroll
        for (int sub = 0; sub < 2; ++sub)
#pragma unroll
          for (int i = 0; i < 16; ++i) {
            const int key = kt * 64 + sub * 32 + crow(i, h);
            if (key >= nkeys) s[sub][i] = -INFINITY;
          }
      }
#pragma unroll
      for (int sub = 0; sub < 2; ++sub)
#pragma unroll
        for (int i = 0; i < 16; ++i) mx = fmaxf(mx, s[sub][i]);
      mx = fmaxf(mx, shx(mx, 32, lane));
      const bool livelane = !(mx - m_run < -150.f);
      if (__ballot(livelane) != 0ull) {
        const float m_new = fmaxf(m_run, mx);
        const float alpha = fexp2(m_run - m_new);
        m_run = m_new;
        float lsum = 0.f;
#pragma unroll
        for (int sub = 0; sub < 2; ++sub)
#pragma unroll
          for (int i = 0; i < 16; ++i) {
            const float pv = fexp2(s[sub][i] - m_new);
            lsum += pv;
            s[sub][i] = pv;
          }
        l_run = l_run * alpha + lsum;
        if (__ballot(alpha != 1.f) != 0ull) {
#pragma unroll
          for (int dt = 0; dt < 4; ++dt)
#pragma unroll
            for (int i = 0; i < 16; ++i) O[dt][i] *= alpha;
        }
#pragma unroll
        for (int sub = 0; sub < 2; ++sub)
#pragma unroll
          for (int s2 = 0; s2 < 2; ++s2) {
            const bf16x8 pf = pack8(s[sub], s2);
#pragma unroll
            for (int dt = 0; dt < 4; ++dt) {
              const unsigned char* va = Vt + (dt * 32 + r) * 136 + (sub * 32 + s2 * 16 + 4 * h) * 2;
              const uint2 lo = *(const uint2*)va;
              const uint2 hi = *(const uint2*)(va + 16);
              const uint4 vv = make_uint4(lo.x, lo.y, hi.x, hi.y);
              O[dt] = MFMA(__builtin_bit_cast(bf16x8, vv), pf, O[dt]);
            }
          }
      }
    }
    if (more) {
      unsigned char* sn = sb + ((j + 1) & 1) * AT_STAGE;
      *(uint4*)(sn + krow * 272 + kcc * 16) = rk0;
      *(uint4*)(sn + (krow + 32) * 272 + kcc * 16) = rk1;
      *(uint2*)(sn + AT_KBYTES + vrow * 136 + vcc * 16) = make_uint2(rv0.x, rv0.y);
      *(uint2*)(sn + AT_KBYTES + vrow * 136 + vcc * 16 + 8) = make_uint2(rv0.z, rv0.w);
      *(uint2*)(sn + AT_KBYTES + (vrow + 64) * 136 + vcc * 16) = make_uint2(rv1.x, rv1.y);
      *(uint2*)(sn + AT_KBYTES + (vrow + 64) * 136 + vcc * 16 + 8) = make_uint2(rv1.z, rv1.w);
    }
    __syncthreads();
  }
  float* exch = (float*)(smem + AT_BASE);
  float inv = 0.f;
  if (active) { const float lt = l_run + shx(l_run, 32, lane); inv = __builtin_amdgcn_rcpf(lt); }
  if (active && comp == 1) {
    const float sc = inv * lam;
#pragma unroll
    for (int dt = 0; dt < 4; ++dt)
#pragma unroll
      for (int i = 0; i < 16; ++i) exch[(rg * 64 + dt * 16 + i) * 64 + lane] = O[dt][i] * sc;
  }
  __syncthreads();
  if (active && comp == 0) {
    float ss = 0.f;
#pragma unroll
    for (int dt = 0; dt < 4; ++dt)
#pragma unroll
      for (int i = 0; i < 16; ++i) {
        const float o = O[dt][i] * inv - exch[(rg * 64 + dt * 16 + i) * 64 + lane];
        O[dt][i] = o;
        ss += o * o;
      }
    ss += shx(ss, 32, lane);
    const float rs = rsqrtf(ss * (1.f / 128.f) + LN_EPS) * (1.f - lam_init);
    u16* AN = (u16*)(p.ws + WS_AN) + (size_t)(qtok0 + rg * 32 + r) * 512 + head * 128;
    const float* gw = p.in[17] + l * 512 + head * 128;
#pragma unroll
    for (int dt = 0; dt < 4; ++dt)
#pragma unroll
      for (int g = 0; g < 4; ++g) {
        const int dv = dt * 32 + 8 * g + 4 * h;
        const float4 g4 = *(const float4*)(gw + dv);
        uint2 o;
        o.x = pack2(O[dt][4 * g] * rs * g4.x, O[dt][4 * g + 1] * rs * g4.y);
        o.y = pack2(O[dt][4 * g + 2] * rs * g4.z, O[dt][4 * g + 3] * rs * g4.w);
        *(uint2*)(AN + dv) = o;
      }
  }
}

constexpr int ML_QS = 64;
constexpr int ML_KS = ML_QS + 64 * 272;
constexpr int ML_KT = ML_KS + 64 * 272;
constexpr int ML_VT = ML_KT + 128 * 144;
constexpr int ML_CB = ML_VT + 128 * 144;
constexpr int ML_HB = ML_CB + 128 * 272;
constexpr int ML_SM = ML_HB + 64 * 132 * 4;
static_assert(ML_SM + 528 * 4 <= LDS_BYTES, "lds");

DI void mlstm_item(const Params& p, int l, int b, int head, unsigned char* smem) {
  const int tid = otid(), lane = tid & 63, w = tid >> 6, r = lane & 31, h = lane >> 5;
  const bool prompt = b < 32;
  const int bs = b - 32;
  const int T = prompt ? 2048 : 32;
  const int nch = prompt ? 32 : 1;
  const int L = prompt ? 64 : 32;
  const int tokbase = prompt ? b * 2048 : TOKP + bs * 32;
  const u16* qkT = prompt ? (const u16*)(p.ws + WS_MQKT_P) + (size_t)b * 1024 * 2048 : (const u16*)(p.ws + WS_MQKT_S) + (size_t)bs * 1024 * 32;
  const u16* vTg = prompt ? (const u16*)(p.ws + WS_MVT_P) + (size_t)b * 512 * 2048 : (const u16*)(p.ws + WS_MVT_S) + (size_t)bs * 512 * 32;
  u16* qs = (u16*)(smem + ML_QS);
  u16* ksm = (u16*)(smem + ML_KS);
  u16* kTw = (u16*)(smem + ML_KT);
  u16* vT = (u16*)(smem + ML_VT);
  u16* Cbf = (u16*)(smem + ML_CB);
  float* hbuf = (float*)(smem + ML_HB);
  float* a_s = (float*)(smem + ML_SM);
  float* mx_s = a_s + 64;
  float* ws_s = a_s + 128;
  float* wi_s = a_s + 192;
  float* emt_s = a_s + 256;
  float* nq_s = a_s + 320;
  float* nvec = a_s + 384;
  float* scal = a_s + 512;

  const int vt = w & 3, kt0 = (w >> 2) * 2;
  f32x16 accC[2];
  float m_run = 0.f;
  if (prompt) {
    zero16(accC[0]); zero16(accC[1]);
    if (tid < 128) nvec[tid] = 0.f;
  } else {
    const float* Cs = p.in[6] + ((size_t)(l * 8 + bs) * 4 + head) * 128 * 128;
#pragma unroll
    for (int q = 0; q < 2; ++q)
#pragma unroll
      for (int g = 0; g < 4; ++g) {
        const float4 c4 = *(const float4*)(Cs + (size_t)(vt * 32 + r) * 128 + (kt0 + q) * 32 + 8 * g + 4 * h);
        accC[q][4 * g] = c4.x; accC[q][4 * g + 1] = c4.y; accC[q][4 * g + 2] = c4.z; accC[q][4 * g + 3] = c4.w;
      }
    if (tid < 128) nvec[tid] = p.in[7][((size_t)(l * 8 + bs) * 4 + head) * 128 + tid];
    m_run = p.in[8][(l * 8 + bs) * 4 + head];
  }
#pragma unroll
  for (int q = 0; q < 2; ++q)
#pragma unroll
    for (int g = 0; g < 4; ++g) {
      uint2 o; o.x = pack2(accC[q][4 * g], accC[q][4 * g + 1]); o.y = pack2(accC[q][4 * g + 2], accC[q][4 * g + 3]);
      *(uint2*)(Cbf + (vt * 32 + r) * 136 + (kt0 + q) * 32 + 8 * g + 4 * h) = o;
    }
  const float* gatesp = (const float*)(p.ws + WS_GATES);
  const int vi = w >> 1, ti = w & 1;

  float ig_n = -INFINITY, fg_n = 0.f;
  if (w == 0 && lane < L) {
    const float* gp = gatesp + (size_t)(tokbase + lane) * 8;
    ig_n = gp[head]; fg_n = gp[4 + head];
  }
  for (int c = 0; c < nch; ++c) {
    const int t0 = c * 64;
    if (w == 0) {
      const int t = lane;
      float ig = -INFINITY, lf = 0.f;
      if (t < L) {
        ig = ig_n;
        const float fg = fg_n;
        lf = fminf(fg, 0.f) - log1pf(__expf(-fabsf(fg)));
        if (c + 1 < nch) {
          const float* gp = gatesp + (size_t)(tokbase + t0 + 64 + t) * 8;
          ig_n = gp[head]; fg_n = gp[4 + head];
        }
      }
      float bc = lf;
#pragma unroll
      for (int off = 1; off < 64; off <<= 1) { const float v = shidx(bc, lane - off, lane); if (lane >= off) bc += v; }
      const float a = ig - bc;
      float M = a;
#pragma unroll
      for (int off = 1; off < 64; off <<= 1) { const float v = shidx(M, lane - off, lane); if (lane >= off) M = fmaxf(M, v); }
      const float mx = fmaxf(m_run, M);
      const float bL = shidx(bc, 63, lane);
      const float mxL = shidx(mx, 63, lane);
      a_s[t] = a; mx_s[t] = mx;
      ws_s[t] = __expf(a - mxL);
      wi_s[t] = __expf(m_run - mx);
      emt_s[t] = __expf(-(bc + mx));
      if (lane == 0) scal[1] = __expf(m_run - mxL);
      m_run = bL + mxL;
    }
    const int ch2 = tid >> 1, th = tid & 1;
    const bool isk = ch2 >= 128;
    const int dd = ch2 & 127;
    const int ch = (isk ? 512 : 0) + head * 128 + dd;
    const u16* rp = qkT + (size_t)ch * T + t0 + th * 32;
    float um3 = 0.f, um2 = 0.f, um1 = 0.f;
    const bool ldrow = prompt || th == 0;
    uint4 uu0 = make_uint4(0, 0, 0, 0), uu1 = uu0, uu2 = uu0, uu3 = uu0, vv0 = uu0, vv1 = uu0;
    if (ldrow) { uu0 = *(const uint4*)(rp); uu1 = *(const uint4*)(rp + 8); uu2 = *(const uint4*)(rp + 16); uu3 = *(const uint4*)(rp + 24); }
    {
      const int row = tid >> 3, cc = tid & 7;
      if (prompt || cc < 4) {
        vv0 = *(const uint4*)(vTg + (size_t)(head * 128 + row) * T + t0 + cc * 8);
        vv1 = *(const uint4*)(vTg + (size_t)(head * 128 + row + 64) * T + t0 + cc * 8);
      }
    }
    if (prompt) {
      if (th == 1 || c > 0) {
        const uint2 pv = *(const uint2*)(rp - 4);
        um3 = bfhi(pv.x); um2 = bflo(pv.y); um1 = bfhi(pv.y);
      }
    } else if (th == 0) {
      const float* cvp = p.in[9] + (size_t)(l * 8 + bs) * 3 * 1024 + ch;
      um3 = cvp[0]; um2 = cvp[1024]; um1 = cvp[2048];
    }
    const float cw0 = p.in[14][(l * 4 + 0) * 1024 + ch], cw1 = p.in[14][(l * 4 + 1) * 1024 + ch];
    const float cw2 = p.in[14][(l * 4 + 2) * 1024 + ch], cw3 = p.in[14][(l * 4 + 3) * 1024 + ch];
    const float cb = p.in[15][l * 1024 + ch];
    __syncthreads();
    {
      u16* dstrm = (isk ? ksm : qs) + (th * 32) * 136 + dd;
      const float oscale = isk ? 0.08838834764831845f : 1.f;
#pragma unroll
      for (int i = 0; i < 4; ++i) {
        const uint4 uu = (i == 0) ? uu0 : (i == 1 ? uu1 : (i == 2 ? uu2 : uu3));
        float u[8];
        u[0] = bflo(uu.x); u[1] = bfhi(uu.x); u[2] = bflo(uu.y); u[3] = bfhi(uu.y);
        u[4] = bflo(uu.z); u[5] = bfhi(uu.z); u[6] = bflo(uu.w); u[7] = bfhi(uu.w);
        float y[8];
#pragma unroll
        for (int e = 0; e < 8; ++e) {
          const float x3 = (e >= 3) ? u[e - 3] : (e == 0 ? um3 : (e == 1 ? um2 : um1));
          const float x2 = (e >= 2) ? u[e - 2] : (e == 0 ? um2 : um1);
          const float x1 = (e >= 1) ? u[e - 1] : um1;
          const float yy = cb + cw0 * x3 + cw1 * x2 + cw2 * x1 + cw3 * u[e];
          y[e] = siluf_(yy) * oscale;
        }
        um3 = u[5]; um2 = u[6]; um1 = u[7];
#pragma unroll
        for (int e = 0; e < 8; ++e) dstrm[(i * 8 + e) * 136] = f2bf(y[e]);
        if (isk) {
          const float4 w0 = *(const float4*)(ws_s + th * 32 + i * 8);
          const float4 w1 = *(const float4*)(ws_s + th * 32 + i * 8 + 4);
          uint4 o;
          o.x = pack2(y[0] * w0.x, y[1] * w0.y); o.y = pack2(y[2] * w0.z, y[3] * w0.w);
          o.z = pack2(y[4] * w1.x, y[5] * w1.y); o.w = pack2(y[6] * w1.z, y[7] * w1.w);
          *(uint4*)(kTw + dd * 72 + th * 32 + i * 8) = o;
        }
      }
      {
        const int row = tid >> 3, cc = tid & 7;
        *(uint4*)(vT + row * 72 + cc * 8) = vv0;
        *(uint4*)(vT + (row + 64) * 72 + cc * 8) = vv1;
      }
    }
    __syncthreads();
    {
      const int t = tid >> 3, part = tid & 7;
      const uint4 q0 = *(const uint4*)(qs + t * 136 + part * 16);
      const uint4 q1 = *(const uint4*)(qs + t * 136 + part * 16 + 8);
      const float* nv = nvec + part * 16;
      float s = bflo(q0.x) * nv[0] + bfhi(q0.x) * nv[1] + bflo(q0.y) * nv[2] + bfhi(q0.y) * nv[3]
              + bflo(q0.z) * nv[4] + bfhi(q0.z) * nv[5] + bflo(q0.w) * nv[6] + bfhi(q0.w) * nv[7]
              + bflo(q1.x) * nv[8] + bfhi(q1.x) * nv[9] + bflo(q1.y) * nv[10] + bfhi(q1.y) * nv[11]
              + bflo(q1.z) * nv[12] + bfhi(q1.z) * nv[13] + bflo(q1.w) * nv[14] + bfhi(q1.w) * nv[15];
      s += shx(s, 1, lane); s += shx(s, 2, lane); s += shx(s, 4, lane);
      if (part == 0) nq_s[t] = s;
    }
    f32x16 accS[2], accO;
    zero16(accS[0]); zero16(accS[1]); zero16(accO);
    {
#pragma unroll
      for (int ks = 0; ks < 8; ++ks) {
        const bf16x8 qfr = *(const bf16x8*)(qs + (ti * 32 + r) * 136 + ks * 16 + h * 8);
        const bf16x8 k0 = *(const bf16x8*)(ksm + r * 136 + ks * 16 + h * 8);
        accS[0] = MFMA(k0, qfr, accS[0]);
        if (ti == 1) {
          const bf16x8 k1 = *(const bf16x8*)(ksm + (32 + r) * 136 + ks * 16 + h * 8);
          accS[1] = MFMA(k1, qfr, accS[1]);
        }
        const bf16x8 cf = *(const bf16x8*)(Cbf + (vi * 32 + r) * 136 + ks * 16 + h * 8);
        accO = MFMA(cf, qfr, accO);
      }
    }
    const int tcol = ti * 32 + r;
    const float mxt = mx_s[tcol];
    const float wit = wi_s[tcol];
    float dsum = 0.f;
#pragma unroll
    for (int sub = 0; sub < 2; ++sub) {
      if (sub <= ti) {
#pragma unroll
        for (int g = 0; g < 4; ++g) {
          const float4 a4 = *(const float4*)(a_s + sub * 32 + 8 * g + 4 * h);
          const float av[4] = {a4.x, a4.y, a4.z, a4.w};
#pragma unroll
          for (int e = 0; e < 4; ++e) {
            const int s = sub * 32 + 8 * g + 4 * h + e;
            const float wgt = (s <= tcol) ? __expf(av[e] - mxt) : 0.f;
            const float pv = accS[sub][4 * g + e] * wgt;
            accS[sub][4 * g + e] = pv;
            dsum += pv;
          }
        }
      }
    }
    dsum += shx(dsum, 32, lane);
#pragma unroll
    for (int i = 0; i < 16; ++i) accO[i] *= wit;
#pragma unroll
    for (int sub = 0; sub < 2; ++sub) {
      if (sub <= ti) {
#pragma unroll
        for (int s2 = 0; s2 < 2; ++s2) {
          const bf16x8 pf = pack8(accS[sub], s2);
          const u16* va = vT + (vi * 32 + r) * 72 + sub * 32 + s2 * 16 + 4 * h;
          const uint2 lo = *(const uint2*)va;
          const uint2 hi = *(const uint2*)(va + 8);
          const uint4 vq = make_uint4(lo.x, lo.y, hi.x, hi.y);
          accO = MFMA(__builtin_bit_cast(bf16x8, vq), pf, accO);
        }
      }
    }
    __syncthreads();
    {
      const float den = dsum + wit * nq_s[tcol];
      const float dn = fmaxf(fabsf(den), emt_s[tcol]);
      const float rinv = __builtin_amdgcn_rcpf(dn);
#pragma unroll
      for (int g = 0; g < 4; ++g)
        *(float4*)(hbuf + tcol * 132 + vi * 32 + 8 * g + 4 * h) =
            make_float4(accO[4 * g] * rinv, accO[4 * g + 1] * rinv, accO[4 * g + 2] * rinv, accO[4 * g + 3] * rinv);
    }
    {
      const float wc = scal[1];
#pragma unroll
      for (int q = 0; q < 2; ++q)
#pragma unroll
        for (int i = 0; i < 16; ++i) accC[q][i] *= wc;
#pragma unroll
      for (int k4 = 0; k4 < 4; ++k4) {
        const bf16x8 vf = *(const bf16x8*)(vT + (vt * 32 + r) * 72 + k4 * 16 + h * 8);
#pragma unroll
        for (int q = 0; q < 2; ++q) {
          const bf16x8 kf = *(const bf16x8*)(kTw + ((kt0 + q) * 32 + r) * 72 + k4 * 16 + h * 8);
          accC[q] = MFMA(kf, vf, accC[q]);
        }
      }
#pragma unroll
      for (int q = 0; q < 2; ++q)
#pragma unroll
        for (int g = 0; g < 4; ++g) {
          uint2 o; o.x = pack2(accC[q][4 * g], accC[q][4 * g + 1]); o.y = pack2(accC[q][4 * g + 2], accC[q][4 * g + 3]);
          *(uint2*)(Cbf + (vt * 32 + r) * 136 + (kt0 + q) * 32 + 8 * g + 4 * h) = o;
        }
      if (tid < 128) {
        float s = 0.f;
#pragma unroll
        for (int i = 0; i < 8; ++i) {
          const uint4 kk = *(const uint4*)(kTw + tid * 72 + i * 8);
          s += bflo(kk.x) + bfhi(kk.x) + bflo(kk.y) + bfhi(kk.y) + bflo(kk.z) + bfhi(kk.z) + bflo(kk.w) + bfhi(kk.w);
        }
        nvec[tid] = wc * nvec[tid] + s;
      }
    }
    __syncthreads();
    {
      const int t = tid >> 3, part = tid & 7;
      float x[16];
#pragma unroll
      for (int i = 0; i < 4; ++i) {
        const float4 f = *(const float4*)(hbuf + t * 132 + part * 16 + i * 4);
        x[i * 4] = f.x; x[i * 4 + 1] = f.y; x[i * 4 + 2] = f.z; x[i * 4 + 3] = f.w;
      }
      float s = 0.f;
#pragma unroll
      for (int i = 0; i < 16; ++i) s += x[i];
      s += shx(s, 1, lane); s += shx(s, 2, lane); s += shx(s, 4, lane);
      const float mean = s * (1.f / 128.f);
      float q = 0.f;
#pragma unroll
      for (int i = 0; i < 16; ++i) { x[i] -= mean; q += x[i] * x[i]; }
      q += shx(q, 1, lane); q += shx(q, 2, lane); q += shx(q, 4, lane);
      const float rstd = rsqrtf(q * (1.f / 128.f) + LN_EPS);
      if (t < L) {
        const size_t tok = (size_t)tokbase + t0 + t;
        const int cbase = head * 128 + part * 16;
        const float* gw = p.in[18] + l * 512 + cbase;
        const u16* mo = (const u16*)(p.ws + WS_MO) + tok * 512 + cbase;
        const uint4 m0 = *(const uint4*)mo;
        const uint4 m1 = *(const uint4*)(mo + 8);
        const float sg[16] = {bflo(m0.x), bfhi(m0.x), bflo(m0.y), bfhi(m0.y), bflo(m0.z), bfhi(m0.z), bflo(m0.w), bfhi(m0.w),
                              bflo(m1.x), bfhi(m1.x), bflo(m1.y), bfhi(m1.y), bflo(m1.z), bfhi(m1.z), bflo(m1.w), bfhi(m1.w)};
        float yv[16];
#pragma unroll
        for (int i = 0; i < 16; ++i) yv[i] = x[i] * rstd * gw[i] * sg[i];
        uint4 o0, o1;
        o0.x = pack2(yv[0], yv[1]); o0.y = pack2(yv[2], yv[3]); o0.z = pack2(yv[4], yv[5]); o0.w = pack2(yv[6], yv[7]);
        o1.x = pack2(yv[8], yv[9]); o1.y = pack2(yv[10], yv[11]); o1.z = pack2(yv[12], yv[13]); o1.w = pack2(yv[14], yv[15]);
        u16* mn = (u16*)(p.ws + WS_MN) + tok * 512 + cbase;
        *(uint4*)mn = o0;
        *(uint4*)(mn + 8) = o1;
      }
    }
  }
  {
    float* oc = p.out + (prompt ? O_CP + ((size_t)(l * 32 + b) * 4 + head) * 16384 : O_CS + ((size_t)(l * 8 + bs) * 4 + head) * 16384);
#pragma unroll
    for (int q = 0; q < 2; ++q)
#pragma unroll
      for (int g = 0; g < 4; ++g)
        *(float4*)(oc + (size_t)(vt * 32 + r) * 128 + (kt0 + q) * 32 + 8 * g + 4 * h) =
            make_float4(accC[q][4 * g], accC[q][4 * g + 1], accC[q][4 * g + 2], accC[q][4 * g + 3]);
    float* on = p.out + (prompt ? O_NP + ((size_t)(l * 32 + b) * 4 + head) * 128 : O_NS + ((size_t)(l * 8 + bs) * 4 + head) * 128);
    if (tid < 128) on[tid] = nvec[tid];
    if (tid == 0) {
      if (prompt) p.out[O_MP + (size_t)(l * 32 + b) * 4 + head] = m_run;
      else p.out[O_MS + (size_t)(l * 8 + bs) * 4 + head] = m_run;
    }
  }
}

DI void phase_mixers(const Params& p, int l, unsigned char* smem) {
  const int tid0 = otid();
  const int lane = tid0 & 63;
  const float* lp = p.in[16] + l * 256;
  float s1 = lp[lane] * lp[64 + lane], s2 = lp[128 + lane] * lp[192 + lane];
  s1 = wave_sum(s1, lane); s2 = wave_sum(s2, lane);
  const float lam_init = 0.8f - 0.6f * expf(-0.3f * (float)l);
  const float lam = expf(s1) - expf(s2) + lam_init;
  int* ctr = (int*)(p.ws + WS_CTR) + l;
  int* sitem = (int*)smem;
  const int N_ML = 160, N_AT = 2048 + 32;
  for (;;) {
    __syncthreads();
    if (tid0 == 0) *sitem = atomicAdd(ctr, 1);
    __syncthreads();
    const int item = *sitem;
    if (item >= N_ML + N_AT) break;
    if (item < N_ML) {
#ifndef NO_ML
      mlstm_item(p, l, item >> 2, item & 3, smem);
#endif
    } else {
#ifndef NO_AT
      const int a = item - N_ML;
      if (a < 2048) {
        const int qt = 15 - (a >> 7), rest = a & 127;
        attn_item(p, l, rest >> 2, rest & 3, qt, lam, lam_init, smem);
      } else {
        const int s = a - 2048;
        attn_item(p, l, 32 + (s >> 2), s & 3, 0, lam, lam_init, smem);
      }
#endif
    }
  }
}

DI void gbar(unsigned* ctl, unsigned& k) {
  __syncthreads();
  ++k;
  if (otid() == 0) {
    __threadfence();
    const unsigned x = blockIdx.x & 7;
    const unsigned gsz = (gridDim.x + 7 - x) >> 3;
    const unsigned ngroups = gridDim.x < 8 ? gridDim.x : 8;
    unsigned* gc = ctl + 64 + x * 32;
    unsigned* gl = ctl + 32;
    const unsigned old = __hip_atomic_fetch_add(gc, 1u, __ATOMIC_RELAXED, __HIP_MEMORY_SCOPE_AGENT);
    if (old + 1 == k * gsz) {
      __threadfence();
      __hip_atomic_fetch_add(gl, 1u, __ATOMIC_RELAXED, __HIP_MEMORY_SCOPE_AGENT);
    }
    while (__hip_atomic_load(gl, __ATOMIC_RELAXED, __HIP_MEMORY_SCOPE_AGENT) < k * ngroups) __builtin_amdgcn_s_sleep(1);
    __threadfence();
  }
  __syncthreads();
}

__global__ void __launch_bounds__(NTHR) fwd_megakernel(Params p) {
  extern __shared__ __attribute__((aligned(16))) unsigned char smem[];
  cg::grid_group grid = cg::this_grid();
#ifndef PH
#define PH 0xffff
#endif
  unsigned* bar = (unsigned*)(p.ws + WS_CTR);
  unsigned epoch = 0;
  if (PH & 1) prologue(p, smem);
  grid.sync();
  if (PH & 1) prologue(p, smem);
  grid.sync();
  if (PH & 2) ln_pass(p, 0, 0, smem);
  gbar(bar, epoch);
#pragma unroll 1
  for (int l = 0; l < 2; ++l) {
    if (PH & 4) phase_in_gate(p, l, smem);
    gbar(bar, epoch);
    if (PH & 8) phase_mixers(p, l, smem);
    gbar(bar, epoch);
    if (PH & 16) phase_mix(p, l, smem);
    gbar(bar, epoch);
    if (PH & 32) phase_res(p, l, 0, smem);
    gbar(bar, epoch);
    if (PH & 64) ln_pass(p, 1, l, smem);
    gbar(bar, epoch);
    if (PH & 128) phase_gu(p, l, smem);
    gbar(bar, epoch);
    if (PH & 256) phase_res(p, l, 1, smem);
    gbar(bar, epoch);
    if (PH & 512) ln_pass(p, 2, l, smem);
    if (l == 0) gbar(bar, epoch);
  }
}

extern "C" void kernel_launch(void* const* d_in, const int* in_sizes, int n_in, void* d_out, int out_size, void* d_ws,
                              size_t ws_size, hipStream_t stream) {
  static int grid_blocks = 0;
  if (!grid_blocks) {
    int dev = 0, cus = 0, per_cu = 0;
    hipGetDevice(&dev);
    hipDeviceGetAttribute(&cus, hipDeviceAttributeMultiprocessorCount, dev);
    if (hipFuncSetAttribute((const void*)fwd_megakernel, hipFuncAttributeMaxDynamicSharedMemorySize, LDS_BYTES) != hipSuccess)
      fprintf(stderr, "kernel_launch: hipFuncSetAttribute failed\n");
    if (hipOccupancyMaxActiveBlocksPerMultiprocessor(&per_cu, (const void*)fwd_megakernel, NTHR, LDS_BYTES) != hipSuccess || per_cu < 1) {
      fprintf(stderr, "kernel_launch: occupancy query gave %d\n", per_cu);
      per_cu = 1;
    }
    (void)hipGetLastError();
    grid_blocks = cus * per_cu;
    if (ws_size < WS_END) fprintf(stderr, "kernel_launch: workspace too small: %zu < %zu\n", ws_size, (size_t)WS_END);
  }
  if (hipMemsetAsync((char*)d_ws + WS_CTR, 0, 4096, stream) != hipSuccess) fprintf(stderr, "kernel_launch: memset failed\n");
  Params p{};
  for (int i = 0; i < 30; ++i) p.in[i] = (const float*)d_in[i];
  p.out = (float*)d_out;
  p.ws = (unsigned char*)d_ws;
  void* args[] = {&p};
  hipError_t e = hipLaunchCooperativeKernel((const void*)fwd_megakernel, dim3(grid_blocks), dim3(NTHR), args, LDS_BYTES, stream);
  if (e != hipSuccess) fprintf(stderr, "cooperative launch failed: %s (grid %d)\n", hipGetErrorString(e), grid_blocks);
}
```

```cpp
#include <hip/hip_runtime.h>
#include <hip/hip_cooperative_groups.h>
#include <cstdio>
namespace cg = cooperative_groups;

#define DI __device__ __forceinline__
typedef unsigned short u16;
using bf16x8 = __attribute__((ext_vector_type(8))) short;
using f32x16 = __attribute__((ext_vector_type(16))) float;
#define MFMA(a, b, c) __builtin_amdgcn_mfma_f32_32x32x16_bf16((a), (b), (c), 0, 0, 0)

constexpr int TOKP = 65536, TOKS = 256, TOK = 65792;
constexpr int NTHR = 512;
constexpr float LN_EPS = 1e-5f;
constexpr float ALPHA = 1.41421356237f;
constexpr float LOG2E = 1.44269504089f;

constexpr size_t WS_WT_IN   = 0;
constexpr size_t WS_WT_GATE = WS_WT_IN + 2ull * 3584 * 1024 * 2;
constexpr size_t WS_WT_BRA  = WS_WT_GATE + 2ull * 2048 * 1024 * 2;
constexpr size_t WS_WT_BRB  = WS_WT_BRA + 2ull * 1024 * 512 * 2;
constexpr size_t WS_WT_O    = WS_WT_BRB + 2ull * 1024 * 512 * 2;
constexpr size_t WS_WT_GU   = WS_WT_O + 2ull * 1024 * 1024 * 2;
constexpr size_t WS_WT_DOWN = WS_WT_GU + 2ull * 5632 * 1024 * 2;
constexpr size_t WS_MOD     = WS_WT_DOWN + 2ull * 1024 * 2816 * 2;
constexpr size_t WS_GATES   = WS_MOD + 2ull * 40 * 6144 * 4;
constexpr size_t WS_CTR     = WS_GATES + (size_t)TOK * 8 * 4;
constexpr size_t WS_STAT    = WS_CTR + 4096;
constexpr size_t WS_KS      = WS_STAT + (size_t)TOK * 8;
constexpr size_t WS_VTS     = WS_KS + 2ull * 8 * 1056 * 512 * 2 + 65536;
constexpr size_t WS_MQKT_S  = WS_VTS + 2ull * 8 * 512 * 1056 * 2 + 65536;
constexpr size_t WS_MVT_S   = WS_MQKT_S + 8ull * 1024 * 32 * 2;
constexpr size_t WS_H       = WS_MVT_S + 8ull * 512 * 32 * 2;
constexpr size_t WS_AN      = WS_H;
constexpr size_t WS_MN      = WS_H + (size_t)TOK * 512 * 2;
constexpr size_t WS_ZQ      = WS_H + (size_t)TOK * 1024 * 2;
constexpr size_t WS_KB      = WS_ZQ + (size_t)TOK * 512 * 2;
constexpr size_t WS_VTP     = WS_KB + (size_t)TOKP * 512 * 2;
constexpr size_t WS_MQKT_P  = WS_VTP + 32ull * 512 * 2048 * 2;
constexpr size_t WS_MVT_P   = WS_MQKT_P + 32ull * 1024 * 2048 * 2;
constexpr size_t WS_MO      = WS_MVT_P + 32ull * 512 * 2048 * 2;
constexpr size_t WS_G       = WS_MO + (size_t)TOK * 512 * 2;
constexpr size_t WS_END     = WS_G + (size_t)TOK * 2048 * 2;
constexpr size_t WS_MIX     = WS_ZQ;
constexpr size_t WS_ACT     = WS_ZQ;

constexpr size_t O_YP  = 0;
constexpr size_t O_YS  = O_YP + (size_t)TOKP * 1024;
constexpr size_t O_KP  = O_YS + (size_t)TOKS * 1024;
constexpr size_t O_VP  = O_KP + 2ull * TOKP * 512;
constexpr size_t O_KSM = O_VP + 2ull * TOKP * 512;
constexpr size_t O_VSM = O_KSM + 2ull * TOKS * 512;
constexpr size_t O_CP  = O_VSM + 2ull * TOKS * 512;
constexpr size_t O_NP  = O_CP + 2ull * 32 * 4 * 128 * 128;
constexpr size_t O_MP  = O_NP + 2ull * 32 * 4 * 128;
constexpr size_t O_CVP = O_MP + 2ull * 32 * 4;
constexpr size_t O_CS  = O_CVP + 2ull * 32 * 3 * 1024;
constexpr size_t O_NS  = O_CS + 2ull * 8 * 4 * 128 * 128;
constexpr size_t O_MS  = O_NS + 2ull * 8 * 4 * 128;
constexpr size_t O_CVS = O_MS + 2ull * 8 * 4;

constexpr int LDS_BYTES = 148480;

struct Params {
  const float* in[30];
  float* out;
  unsigned char* ws;
};


DI float bf2f(unsigned v) { return __uint_as_float(v << 16); }
typedef __bf16 bf16x2_t __attribute__((ext_vector_type(2)));
typedef float f32x2_t __attribute__((ext_vector_type(2)));
DI unsigned pack2(float a, float b) {
  f32x2_t v = {a, b};
  return __builtin_bit_cast(unsigned, __builtin_convertvector(v, bf16x2_t));
}
DI u16 f2bf(float x) { return (u16)(pack2(x, 0.f) & 0xffffu); }
DI float bflo(unsigned v) { return __uint_as_float(v << 16); }
DI float bfhi(unsigned v) { return __uint_as_float(v & 0xffff0000u); }
DI float sigmoidf_(float x) { return __builtin_amdgcn_rcpf(1.f + __expf(-x)); }
DI float siluf_(float x) { return x * __builtin_amdgcn_rcpf(1.f + __expf(-x)); }
DI float fexp2(float x) { return __builtin_amdgcn_exp2f(x); }
DI int otid() { int t = threadIdx.x; asm volatile("" : "+v"(t)); return t; }
DI float shx(float v, int mask, int lane) { return __int_as_float(__builtin_amdgcn_ds_bpermute(((lane ^ mask) & 63) << 2, __float_as_int(v))); }
DI float shidx(float v, int src, int lane) { (void)lane; return __int_as_float(__builtin_amdgcn_ds_bpermute((src & 63) << 2, __float_as_int(v))); }
DI int crow(int i, int h) { return (i & 3) + 8 * (i >> 2) + 4 * h; }
DI bf16x8 pack8(const f32x16& x, int s) {
  uint4 u;
  u.x = pack2(x[8 * s + 0], x[8 * s + 1]); u.y = pack2(x[8 * s + 2], x[8 * s + 3]);
  u.z = pack2(x[8 * s + 4], x[8 * s + 5]); u.w = pack2(x[8 * s + 6], x[8 * s + 7]);
  return __builtin_bit_cast(bf16x8, u);
}
DI void zero16(f32x16& a) {
#pragma unroll
  for (int i = 0; i < 16; ++i) a[i] = 0.f;
}
DI int batch_of_row(int row) { return row < TOKP ? (row >> 11) : 32 + ((row - TOKP) >> 5); }

constexpr int GS_STRIDE = 144;
constexpr int GS_STAGE = 512 * GS_STRIDE;
constexpr int GS_BASE = 64;

DI void gemm_mainloop(f32x16 (&acc)[4][2], const u16* __restrict__ A, int lda, const u16* __restrict__ Wt, int ldw, int K,
                      int m0, int n0, unsigned char* smem) {
  const int tid = otid(), lane = tid & 63, w = tid >> 6;
  const int wm = w >> 2, wn = w & 3, r = lane & 31, h = lane >> 5;
  const int lrow = tid >> 3, lcc = tid & 7;
  const u16* ap = A + (size_t)(m0 + lrow) * lda + lcc * 8;
  const int bn = n0 + 2 * (lrow & 31) + ((lrow >> 5) & 1);
  const u16* bp = Wt + (size_t)bn * ldw + lcc * 8;
  const size_t astep = (size_t)64 * lda, bstep = (size_t)64 * ldw;
  unsigned char* sbase = smem + GS_BASE;
  const int woff = lrow * GS_STRIDE + lcc * 16;
  const int nk = K >> 6;
  uint4 s0, s1, s2, s3, s4, s5, s6, s7, u0, u1, u2, u3, u4, u5, u6, u7;
  int kn = 1;
#define G_ADV() do { const int adv = (kn < nk) ? 64 : 0; ap += adv; bp += adv; ++kn; } while (0)
#define G_ISSUE_A() do { s0 = *(const uint4*)(ap); s1 = *(const uint4*)(ap + astep); s2 = *(const uint4*)(ap + 2 * astep); s3 = *(const uint4*)(ap + 3 * astep); \
    s4 = *(const uint4*)(bp); s5 = *(const uint4*)(bp + bstep); s6 = *(const uint4*)(bp + 2 * bstep); s7 = *(const uint4*)(bp + 3 * bstep); } while (0)
#define G_ISSUE_B() do { u0 = *(const uint4*)(ap); u1 = *(const uint4*)(ap + astep); u2 = *(const uint4*)(ap + 2 * astep); u3 = *(const uint4*)(ap + 3 * astep); \
    u4 = *(const uint4*)(bp); u5 = *(const uint4*)(bp + bstep); u6 = *(const uint4*)(bp + 2 * bstep); u7 = *(const uint4*)(bp + 3 * bstep); } while (0)
#define G_WRITE_A(sn) do { *(uint4*)((sn) + woff) = s0; *(uint4*)((sn) + woff + 64 * GS_STRIDE) = s1; *(uint4*)((sn) + woff + 128 * GS_STRIDE) = s2; \
    *(uint4*)((sn) + woff + 192 * GS_STRIDE) = s3; *(uint4*)((sn) + woff + 256 * GS_STRIDE) = s4; *(uint4*)((sn) + woff + 320 * GS_STRIDE) = s5; \
    *(uint4*)((sn) + woff + 384 * GS_STRIDE) = s6; *(uint4*)((sn) + woff + 448 * GS_STRIDE) = s7; } while (0)
#define G_WRITE_B(sn) do { *(uint4*)((sn) + woff) = u0; *(uint4*)((sn) + woff + 64 * GS_STRIDE) = u1; *(uint4*)((sn) + woff + 128 * GS_STRIDE) = u2; \
    *(uint4*)((sn) + woff + 192 * GS_STRIDE) = u3; *(uint4*)((sn) + woff + 256 * GS_STRIDE) = u4; *(uint4*)((sn) + woff + 320 * GS_STRIDE) = u5; \
    *(uint4*)((sn) + woff + 384 * GS_STRIDE) = u6; *(uint4*)((sn) + woff + 448 * GS_STRIDE) = u7; } while (0)
  const int aoff = (wm * 128 + r) * GS_STRIDE + h * 16;
  const int boff = (256 + wn * 64 + r) * GS_STRIDE + h * 16;
#define G_COMPUTE(st) do { _Pragma("unroll") for (int ks = 0; ks < 4; ++ks) {                                              \
      bf16x8 fa[4], fb[2];                                                                                               \
      _Pragma("unroll") for (int mi = 0; mi < 4; ++mi) fa[mi] = *(const bf16x8*)((st) + aoff + mi * 32 * GS_STRIDE + ks * 32); \
      fb[0] = *(const bf16x8*)((st) + boff + ks * 32);                                                                   \
      fb[1] = *(const bf16x8*)((st) + boff + 32 * GS_STRIDE + ks * 32);                                                  \
      _Pragma("unroll") for (int mi = 0; mi < 4; ++mi) {                                                                 \
        acc[mi][0] = MFMA(fa[mi], fb[0], acc[mi][0]);                                                                    \
        acc[mi][1] = MFMA(fa[mi], fb[1], acc[mi][1]);                                                                    \
      }                                                                                                                  \
      __builtin_amdgcn_sched_barrier(0);                                                                                 \
    } } while (0)
  G_ISSUE_A();
  G_WRITE_A(sbase);
  G_ADV(); G_ISSUE_A();
  G_ADV(); G_ISSUE_B();
  __syncthreads();
  for (int kt = 0; kt < nk; kt += 2) {
    G_WRITE_A(sbase + GS_STAGE);
    G_ADV(); G_ISSUE_A();
    __builtin_amdgcn_sched_barrier(0);
    G_COMPUTE(sbase);
    __syncthreads();
    G_WRITE_B(sbase);
    G_ADV(); G_ISSUE_B();
    __builtin_amdgcn_sched_barrier(0);
    G_COMPUTE(sbase + GS_STAGE);
    __syncthreads();
  }
#undef G_ADV
#undef G_ISSUE_A
#undef G_ISSUE_B
#undef G_WRITE_A
#undef G_WRITE_B
#undef G_COMPUTE
}

DI int rot_unused_(int) { return 0; }
DI bool tile_of(int i, int MT, int NT, int& mt, int& nt) {
  const int per = gridDim.x >> 3;
  const int L = i * (int)gridDim.x + (int)(blockIdx.x & 7) * per + (int)(blockIdx.x >> 3);
  if (L >= MT * NT) return false;
  const int nig = 8 * NT, gid = L / nig, fm = gid * 8, gsz = min(MT - fm, 8), rem = L - gid * nig;
  mt = fm + rem % gsz; nt = rem / gsz;
  return true;
}


template <class PF, class EF>
DI void gemm_stream(int lda, int ldw, int K, unsigned char* smem, PF ptrs, EF epi) {
  const int tid = otid(), lane = tid & 63, w = tid >> 6;
  const int wm = w >> 2, wn = w & 3, r = lane & 31, h = lane >> 5;
  unsigned char* sbase = smem + GS_BASE;
  constexpr int SLOT = 512 * 64;
  const int nh = K >> 5;
  const int c0 = (h ^ ((r >> 2) & 3)) * 16, c1 = c0 ^ 32;
  const int aoff = (wm * 128 + r) * 64, boff = (256 + wn * 64 + r) * 64;
  const int lr16 = lane >> 2, lchunk = (lane & 3) ^ ((lane >> 4) & 3);
  const int wu = __builtin_amdgcn_readfirstlane(w);
  const bool isB = wu >= 4;
  const unsigned goff = isB ? (unsigned)((((wu - 4) * 64 + 2 * lr16) * ldw + lchunk * 8) * 2)
                            : (unsigned)(((wu * 64 + lr16) * lda + lchunk * 8) * 2);
  const unsigned st1 = isB ? (unsigned)(32 * ldw * 2) : (unsigned)(16 * lda * 2);
  const unsigned st2 = isB ? (unsigned)(1 * ldw * 2) : (unsigned)(32 * lda * 2);
#define WAIT_V(n) asm volatile("s_waitcnt vmcnt(" #n ")" ::: "memory")
#define RAWBAR() do { asm volatile("s_waitcnt lgkmcnt(0)" ::: "memory"); __builtin_amdgcn_s_barrier(); asm volatile("" ::: "memory"); } while (0)
#define BAR0() do { asm volatile("" ::: "memory"); __builtin_amdgcn_s_barrier(); asm volatile("" ::: "memory"); } while (0)
#define H_DMA(slotp) do { const char* gsrc_ = (isB ? bp : ap) + goff; unsigned char* ld_ = (slotp) + wu * 4096;            \
    __builtin_amdgcn_global_load_lds((const unsigned*)(gsrc_), (unsigned*)(ld_), 16, 0, 0);                                  \
    __builtin_amdgcn_global_load_lds((const unsigned*)(gsrc_ + st1), (unsigned*)(ld_ + 1024), 16, 0, 0);                     \
    __builtin_amdgcn_global_load_lds((const unsigned*)(gsrc_ + st2), (unsigned*)(ld_ + 2048), 16, 0, 0);                     \
    __builtin_amdgcn_global_load_lds((const unsigned*)(gsrc_ + st2 + st1), (unsigned*)(ld_ + 3072), 16, 0, 0); } while (0)
#define H_READ(sl) do { _Pragma("unroll") for (int mi = 0; mi < 4; ++mi) {                                                   \
      fa[0][mi] = *(const bf16x8*)((sl) + aoff + mi * 2048 + c0); fa[1][mi] = *(const bf16x8*)((sl) + aoff + mi * 2048 + c1); } \
    fb[0][0] = *(const bf16x8*)((sl) + boff + c0); fb[1][0] = *(const bf16x8*)((sl) + boff + c1);                            \
    fb[0][1] = *(const bf16x8*)((sl) + boff + 2048 + c0); fb[1][1] = *(const bf16x8*)((sl) + boff + 2048 + c1); } while (0)
#define H_MMA() do { _Pragma("unroll") for (int ks = 0; ks < 2; ++ks) { _Pragma("unroll") for (int mi = 0; mi < 4; ++mi) {  \
      acc[mi][0] = MFMA(fa[ks][mi], fb[ks][0], acc[mi][0]);                                                       \
      acc[mi][1] = MFMA(fa[ks][mi], fb[ks][1], acc[mi][1]); } } } while (0)
  const char *ap, *bp;
  {
    const u16 *ta, *tb;
    int it0 = 0;
    asm volatile("" : "+s"(it0));
    if (!ptrs(it0, ta, tb)) return;
    ap = (const char*)ta; bp = (const char*)tb;
  }
  H_DMA(sbase); ap += 64; bp += 64;
  H_DMA(sbase + SLOT); ap += 64; bp += 64;
  for (int it = 0;; ++it) {
    f32x16 acc[4][2];
#pragma unroll
    for (int a = 0; a < 4; ++a)
#pragma unroll
      for (int b = 0; b < 2; ++b) zero16(acc[a][b]);
    H_DMA(sbase + 2 * SLOT); ap += 64; bp += 64;
    WAIT_V(4);
    BAR0();
    if (wm == 1) BAR0();
    int rs = 0;
#pragma unroll 1
    for (int hh = 0; hh < nh; ++hh) {
      bf16x8 fa[2][4], fb[2][2];
      const int rem = nh - 2 - hh;
      H_READ(sbase + rs * SLOT);
      if (hh + 3 < nh) { H_DMA(sbase + ((rs + 3) & 3) * SLOT); ap += 64; bp += 64; }
      if (wm == 1) {
        if (rem >= 2) WAIT_V(8); else if (rem == 1) WAIT_V(4); else WAIT_V(0);
      }
      __builtin_amdgcn_sched_barrier(0);
      RAWBAR();
      __builtin_amdgcn_sched_barrier(0);
      H_MMA();
      __builtin_amdgcn_sched_barrier(0);
      if (wm == 0) {
        if (rem >= 2) WAIT_V(8); else if (rem == 1) WAIT_V(4); else WAIT_V(0);
      }
      BAR0();
      rs = (rs + 1) & 3;
    }
    if (wm == 0) BAR0();
    bool more;
    {
      const u16 *ta, *tb;
      more = ptrs(it + 1, ta, tb);
      if (more) {
        ap = (const char*)ta; bp = (const char*)tb;
        H_DMA(sbase); ap += 64; bp += 64;
        H_DMA(sbase + SLOT); ap += 64; bp += 64;
      }
    }
    epi(it, acc);
    if (!more) break;
  }
#undef WAIT_V
#undef RAWBAR
#undef BAR0
#undef H_DMA
#undef H_READ
#undef H_MMA
}

DI int map_row(int maptype, int s) {
  if (maptype == 1) return s < 3072 ? s : (s < 3080 ? -1 : s - 8);
  if (maptype == 2) return s < 2816 ? 2 * s : 2 * (s - 2816) + 1;
  return s;
}
DI void transpose_task(const float* __restrict__ src, int Nsrc, u16* __restrict__ dst, int dld, int maptype, int kt2, int nt,
                       unsigned char* smem) {
  float* tile = (float*)(smem + 64);
  const int tid = otid();
  const int k0 = kt2 * 128, s0 = nt * 64;
  float4 v[4];
#pragma unroll
  for (int i = 0; i < 4; ++i) {
    const int kr = (tid >> 4) + 32 * i, nc = (tid & 15) * 4;
    v[i] = make_float4(0.f, 0.f, 0.f, 0.f);
    if (s0 + nc < Nsrc) v[i] = *(const float4*)(src + (size_t)(k0 + kr) * Nsrc + s0 + nc);
  }
#pragma unroll
  for (int i = 0; i < 4; ++i) {
    const int kr = (tid >> 4) + 32 * i, nc = (tid & 15) * 4;
    tile[kr * 65 + nc + 0] = v[i].x; tile[kr * 65 + nc + 1] = v[i].y; tile[kr * 65 + nc + 2] = v[i].z; tile[kr * 65 + nc + 3] = v[i].w;
  }
  __syncthreads();
  {
    const int n = tid >> 3;
    const int s = s0 + n;
    const int dr = (s < Nsrc) ? map_row(maptype, s) : -1;
    if (dr >= 0) {
#pragma unroll
      for (int j = 0; j < 2; ++j) {
        const int kc = (tid & 7) * 8 + 64 * j;
        uint4 o;
        o.x = pack2(tile[(kc + 0) * 65 + n], tile[(kc + 1) * 65 + n]);
        o.y = pack2(tile[(kc + 2) * 65 + n], tile[(kc + 3) * 65 + n]);
        o.z = pack2(tile[(kc + 4) * 65 + n], tile[(kc + 5) * 65 + n]);
        o.w = pack2(tile[(kc + 6) * 65 + n], tile[(kc + 7) * 65 + n]);
        *(uint4*)(dst + (size_t)dr * dld + k0 + kc) = o;
      }
    }
  }
  __syncthreads();
}

DI void adaln_task(const Params& p, int task, unsigned char* smem) {
  const int bhalf = task & 1, cg_ = (task >> 1) % 96, l = (task >> 1) / 96;
  float* cs = (float*)(smem + 64);
  float* red = (float*)(smem + 64 + 20 * 1024 * 4);
  const int tid = otid();
  const float* cp = p.in[2]; const float* csm = p.in[3];
  for (int idx = tid; idx < 20 * 1024; idx += NTHR) {
    const int bb = idx >> 10, d = idx & 1023, b = bhalf * 20 + bb;
    const float c = b < 32 ? cp[b * 1024 + d] : csm[(b - 32) * 1024 + d];
    cs[idx] = siluf_(c);
  }
  __syncthreads();
  const int dseg = tid >> 6, e = cg_ * 64 + (tid & 63);
  const float* wp = p.in[10] + ((size_t)l * 1024 + dseg * 128) * 6144 + e;
  float acc[20];
#pragma unroll
  for (int i = 0; i < 20; ++i) acc[i] = 0.f;
  for (int d = 0; d < 128; ++d) {
    const float wv = wp[(size_t)d * 6144];
    const float* c0 = cs + dseg * 128 + d;
#pragma unroll
    for (int i = 0; i < 20; ++i) acc[i] += c0[i * 1024] * wv;
  }
#pragma unroll
  for (int i = 0; i < 20; ++i) red[(dseg * 20 + i) * 64 + (tid & 63)] = acc[i];
  __syncthreads();
  float* mod = (float*)(p.ws + WS_MOD);
  for (int idx = tid; idx < 20 * 64; idx += NTHR) {
    const int bb = idx >> 6, ec = idx & 63;
    float s = 0.f;
#pragma unroll
    for (int q = 0; q < 8; ++q) s += red[(q * 20 + bb) * 64 + ec];
    const int ee = cg_ * 64 + ec;
    mod[((size_t)l * 40 + bhalf * 20 + bb) * 6144 + ee] = s + p.in[11][l * 6144 + ee];
  }
  __syncthreads();
}

DI void prologue(const Params& p, unsigned char* smem) {
  const int WT_TASKS_L = 456 + 256 + 64 + 64 + 128 + 704 + 352;
  const int N_WT = 2 * WT_TASKS_L;
  const int N_ADA = 384, N_CK = 512, N_CV = 1024;
  const int total = N_WT + N_ADA + N_CK + N_CV;
  for (int task = blockIdx.x; task < total; task += gridDim.x) {
    if (task < N_WT) {
      const int l = task / WT_TASKS_L; int t = task % WT_TASKS_L;
      if (t < 456) { transpose_task(p.in[12] + (size_t)l * 1024 * 3592, 3592, (u16*)(p.ws + WS_WT_IN) + (size_t)l * 3584 * 1024, 1024, 1, t / 57, t % 57, smem); continue; }
      t -= 456;
      if (t < 256) { transpose_task(p.in[21] + (size_t)l * 1024 * 2048, 2048, (u16*)(p.ws + WS_WT_GATE) + (size_t)l * 2048 * 1024, 1024, 0, t / 32, t % 32, smem); continue; }
      t -= 256;
      if (t < 64) { transpose_task(p.in[19] + (size_t)l * 512 * 1024, 1024, (u16*)(p.ws + WS_WT_BRA) + (size_t)l * 1024 * 512, 512, 0, t / 16, t % 16, smem); continue; }
      t -= 64;
      if (t < 64) { transpose_task(p.in[20] + (size_t)l * 512 * 1024, 1024, (u16*)(p.ws + WS_WT_BRB) + (size_t)l * 1024 * 512, 512, 0, t / 16, t % 16, smem); continue; }
      t -= 64;
      if (t < 128) { transpose_task(p.in[23] + (size_t)l * 1024 * 1024, 1024, (u16*)(p.ws + WS_WT_O) + (size_t)l * 1024 * 1024, 1024, 0, t / 16, t % 16, smem); continue; }
      t -= 128;
      if (t < 704) { transpose_task(p.in[26] + (size_t)l * 1024 * 5632, 5632, (u16*)(p.ws + WS_WT_GU) + (size_t)l * 5632 * 1024, 1024, 2, t / 88, t % 88, smem); continue; }
      t -= 704;
      transpose_task(p.in[27] + (size_t)l * 2816 * 1024, 1024, (u16*)(p.ws + WS_WT_DOWN) + (size_t)l * 1024 * 2816, 2816, 0, t / 16, t % 16, smem);
    } else if (task < N_WT + N_ADA) {
      adaln_task(p, task - N_WT, smem);
    } else if (task < N_WT + N_ADA + N_CK) {
      const int t = task - N_WT - N_ADA;
      const float4* src = (const float4*)p.in[4];
      u16* dst = (u16*)(p.ws + WS_KS);
#pragma unroll
      for (int i = 0; i < 8; ++i) {
        const size_t f4 = (size_t)t * 4096 + i * 512 + otid();
        const float4 v = src[f4];
        const size_t e = f4 * 4;
        const size_t lb = e / (1024 * 512), rem = e % (1024 * 512);
        uint2 o; o.x = pack2(v.x, v.y); o.y = pack2(v.z, v.w);
        *(uint2*)(dst + lb * (1056 * 512) + rem) = o;
      }
    } else {
      const int t = task - N_WT - N_ADA - N_CK;
      const int lb = t >> 6, tt = t & 63;
      transpose_task(p.in[5] + (size_t)lb * 1024 * 512, 512, (u16*)(p.ws + WS_VTS) + (size_t)lb * 512 * 1056, 1056, 0, tt >> 3, tt & 7, smem);
    }
  }
}

DI float wave_sum(float v, int lane) {
  (void)lane;
  int x = __float_as_int(v);
  v += __int_as_float(__builtin_amdgcn_update_dpp(0, x, 0xB1, 0xF, 0xF, true));
  x = __float_as_int(v);
  v += __int_as_float(__builtin_amdgcn_update_dpp(0, x, 0x4E, 0xF, 0xF, true));
  x = __float_as_int(v);
  v += __int_as_float(__builtin_amdgcn_update_dpp(0, x, 0x141, 0xF, 0xF, true));
  x = __float_as_int(v);
  v += __int_as_float(__builtin_amdgcn_update_dpp(0, x, 0x140, 0xF, 0xF, true));
  x = __float_as_int(v);
  const float r0 = __int_as_float(__builtin_amdgcn_readlane(x, 0)), r1 = __int_as_float(__builtin_amdgcn_readlane(x, 16));
  const float r2 = __int_as_float(__builtin_amdgcn_readlane(x, 32)), r3 = __int_as_float(__builtin_amdgcn_readlane(x, 48));
  return (r0 + r1) + (r2 + r3);
}
DI void ln_pass(const Params& p, int mode, int l, unsigned char* smem) {
  const int tid = otid();
  const int lane = tid & 63, w = tid >> 6;
  const bool first = mode != 0;
  const bool second = (mode != 2) || (l + 1 < 2);
  const bool gates = (mode == 0) || (mode == 2 && l + 1 < 2);
  const int lm = (mode == 2) ? l + 1 : l;
  const int shi = (mode == 1) ? 3 : 0;
  const float* lng = (mode == 1) ? p.in[24] + l * 1024 : p.in[28] + l * 1024;
  const float* lnb = (mode == 1) ? p.in[25] + l * 1024 : p.in[29] + l * 1024;
  const float* mod = (const float*)(p.ws + WS_MOD);
  u16* H = (u16*)(p.ws + WS_H);
  float* gout = (float*)(p.ws + WS_GATES);
  float* wl = (float*)(smem + 64);
  float bif[8];
  if (gates) {
    const float* wi = p.in[12] + (size_t)lm * 1024 * 3592 + 3072;
    for (int idx = tid; idx < 8192; idx += NTHR) {
      const int c = idx >> 3, j = idx & 7;
      wl[j * 1024 + c] = wi[(size_t)c * 3592 + j];
    }
#pragma unroll
    for (int j = 0; j < 8; ++j) bif[j] = p.in[13][lm * 8 + j];
  }
  __syncthreads();
  float lg[16], lb[16];
  if (first) {
#pragma unroll
    for (int i = 0; i < 4; ++i) {
      const float4 g = *(const float4*)(lng + i * 256 + lane * 4);
      const float4 b = *(const float4*)(lnb + i * 256 + lane * 4);
      lg[i * 4] = g.x; lg[i * 4 + 1] = g.y; lg[i * 4 + 2] = g.z; lg[i * 4 + 3] = g.w;
      lb[i * 4] = b.x; lb[i * 4 + 1] = b.y; lb[i * 4 + 2] = b.z; lb[i * 4 + 3] = b.w;
    }
  }
  const bool write_x = (mode == 2 && l == 1);
  float* stats = (float*)(p.ws + WS_STAT);
  auto process = [&](int row, float (&v)[16], const float (&msh)[16], const float (&msc)[16]) {
    float* xr = p.out + (size_t)row * 1024;
    if (first) {
      float s = 0.f;
#pragma unroll
      for (int i = 0; i < 16; ++i) s += v[i];
      const float mean = wave_sum(s, lane) * (1.f / 1024.f);
      float q = 0.f;
#pragma unroll
      for (int i = 0; i < 16; ++i) { v[i] -= mean; q += v[i] * v[i]; }
      const float rstd = rsqrtf(wave_sum(q, lane) * (1.f / 1024.f) + LN_EPS);
#pragma unroll
      for (int i = 0; i < 4; ++i) {
#pragma unroll
        for (int e = 0; e < 4; ++e) v[i * 4 + e] = v[i * 4 + e] * rstd * lg[i * 4 + e] + lb[i * 4 + e];
        if (write_x) *(float4*)(xr + i * 256 + lane * 4) = make_float4(v[i * 4 + 0], v[i * 4 + 1], v[i * 4 + 2], v[i * 4 + 3]);
      }
      if (!write_x && lane == 0) *(float2*)(stats + (size_t)row * 2) = make_float2(mean, rstd);
    }
    if (second) {
      float s = 0.f;
#pragma unroll
      for (int i = 0; i < 16; ++i) s += v[i];
      const float mean = wave_sum(s, lane) * (1.f / 1024.f);
      float q = 0.f;
#pragma unroll
      for (int i = 0; i < 16; ++i) { v[i] -= mean; q += v[i] * v[i]; }
      const float rstd = rsqrtf(wave_sum(q, lane) * (1.f / 1024.f) + LN_EPS);
#pragma unroll
      for (int i = 0; i < 4; ++i) {
#pragma unroll
        for (int e = 0; e < 4; ++e) v[i * 4 + e] = v[i * 4 + e] * rstd * msc[i * 4 + e] + msh[i * 4 + e];
        uint2 o; o.x = pack2(v[i * 4 + 0], v[i * 4 + 1]); o.y = pack2(v[i * 4 + 2], v[i * 4 + 3]);
        *(uint2*)(H + (size_t)row * 1024 + i * 256 + lane * 4) = o;
      }
      if (gates) {
        float g8[8];
#pragma unroll
        for (int j = 0; j < 8; ++j) {
          float s2 = 0.f;
#pragma unroll
          for (int i = 0; i < 4; ++i) {
            const float4 wv = *(const float4*)(wl + j * 1024 + i * 256 + lane * 4);
            s2 += v[i * 4] * wv.x + v[i * 4 + 1] * wv.y + v[i * 4 + 2] * wv.z + v[i * 4 + 3] * wv.w;
          }
          g8[j] = wave_sum(s2, lane) + bif[j];
        }
        if (lane == 0) {
          *(float4*)(gout + (size_t)row * 8) = make_float4(g8[0], g8[1], g8[2], g8[3]);
          *(float4*)(gout + (size_t)row * 8 + 4) = make_float4(g8[4], g8[5], g8[6], g8[7]);
        }
      }
    }
  };
  auto load_mod = [&](int row, float (&msh)[16], float (&msc)[16]) {
    const float* mb = mod + ((size_t)lm * 40 + batch_of_row(row)) * 6144;
#pragma unroll
    for (int i = 0; i < 4; ++i) {
      const float4 sh = *(const float4*)(mb + shi * 1024 + i * 256 + lane * 4);
      const float4 sc = *(const float4*)(mb + (shi + 1) * 1024 + i * 256 + lane * 4);
      msh[i * 4] = sh.x; msh[i * 4 + 1] = sh.y; msh[i * 4 + 2] = sh.z; msh[i * 4 + 3] = sh.w;
      msc[i * 4] = 1.f + sc.x; msc[i * 4 + 1] = 1.f + sc.y; msc[i * 4 + 2] = 1.f + sc.z; msc[i * 4 + 3] = 1.f + sc.w;
    }
  };
  for (int chunk = blockIdx.x * 8 + w; chunk < TOKP / 32; chunk += gridDim.x * 8) {
    const int row0 = chunk * 32;
    float msh[16], msc[16];
    if (second) load_mod(row0, msh, msc);
    const float* src0 = (mode == 0) ? p.in[0] + (size_t)row0 * 1024 : p.out + (size_t)row0 * 1024;
    float4 nx0 = *(const float4*)(src0 + lane * 4), nx1 = *(const float4*)(src0 + 256 + lane * 4);
    float4 nx2 = *(const float4*)(src0 + 512 + lane * 4), nx3 = *(const float4*)(src0 + 768 + lane * 4);
    for (int ri = 0; ri < 32; ++ri) {
      float v[16];
      v[0] = nx0.x; v[1] = nx0.y; v[2] = nx0.z; v[3] = nx0.w; v[4] = nx1.x; v[5] = nx1.y; v[6] = nx1.z; v[7] = nx1.w;
      v[8] = nx2.x; v[9] = nx2.y; v[10] = nx2.z; v[11] = nx2.w; v[12] = nx3.x; v[13] = nx3.y; v[14] = nx3.z; v[15] = nx3.w;
      {
        const float* sn = src0 + (size_t)(ri < 31 ? ri + 1 : 31) * 1024;
        nx0 = *(const float4*)(sn + lane * 4); nx1 = *(const float4*)(sn + 256 + lane * 4);
        nx2 = *(const float4*)(sn + 512 + lane * 4); nx3 = *(const float4*)(sn + 768 + lane * 4);
      }
      __builtin_amdgcn_sched_barrier(0);
      process(row0 + ri, v, msh, msc);
    }
  }
  if (w == 0) {
    for (int row = TOKP + blockIdx.x; row < TOK; row += gridDim.x) {
      float msh[16], msc[16];
      if (second) load_mod(row, msh, msc);
      const float* src = (mode == 0) ? p.in[1] + (size_t)(row - TOKP) * 1024 : p.out + (size_t)row * 1024;
      float v[16];
#pragma unroll
      for (int i = 0; i < 4; ++i) {
        const float4 t = *(const float4*)(src + i * 256 + lane * 4);
        v[i * 4 + 0] = t.x; v[i * 4 + 1] = t.y; v[i * 4 + 2] = t.z; v[i * 4 + 3] = t.w;
      }
      process(row, v, msh, msc);
    }
  }
}


DI void micro_partial(f32x16& acc, const u16* A, int lda, const u16* Wt, int ldw, int K, int row0, int n0, int w, int r, int h) {
  const int kb = w * (K >> 3), n16 = K >> 7;
  const u16* ap = A + (size_t)(row0 + r) * lda + kb + h * 8;
  const u16* bp = Wt + (size_t)(n0 + r) * ldw + kb + h * 8;
#pragma unroll 4
  for (int k = 0; k < n16; ++k) {
    const bf16x8 a = *(const bf16x8*)(ap + k * 16);
    const bf16x8 b = *(const bf16x8*)(bp + k * 16);
    acc = MFMA(a, b, acc);
  }
}
DI void micro_reduce_store(const f32x16& acc, float* red, int w, int lane) {
#pragma unroll
  for (int i = 0; i < 16; ++i) red[(w * 16 + i) * 64 + lane] = acc[i];
}
DI float micro_sum(const float* red, int i, int lane) {
  float s = 0.f;
#pragma unroll
  for (int q = 0; q < 8; ++q) s += red[(q * 16 + i) * 64 + lane];
  return s;
}

constexpr int EP_LD = 264;
constexpr int EP_LDT = 68;
DI void zero_acc(f32x16 (&acc)[4][2]) {
#pragma unroll
  for (int a = 0; a < 4; ++a)
#pragma unroll
    for (int b = 0; b < 2; ++b) zero16(acc[a][b]);
}
DI void stage_rm(const f32x16& a0, const f32x16& a1, float* stg, int wm, int wn, int r, int h) {
#pragma unroll
  for (int i = 0; i < 16; ++i) *(float2*)(stg + (wm * 32 + crow(i, h)) * EP_LD + wn * 64 + 2 * r) = make_float2(a0[i], a1[i]);
}
DI void stage_tr(const f32x16& a0, const f32x16& a1, float* stg, int wm, int wn, int r, int h) {
#pragma unroll
  for (int g = 0; g < 4; ++g) {
    *(float4*)(stg + (wn * 64 + 2 * r) * EP_LDT + wm * 32 + 8 * g + 4 * h) = make_float4(a0[4 * g], a0[4 * g + 1], a0[4 * g + 2], a0[4 * g + 3]);
    *(float4*)(stg + (wn * 64 + 2 * r + 1) * EP_LDT + wm * 32 + 8 * g + 4 * h) = make_float4(a1[4 * g], a1[4 * g + 1], a1[4 * g + 2], a1[4 * g + 3]);
  }
}
DI int grow_of(int m0, int mi, int lr) { return m0 + (lr >> 5) * 128 + mi * 32 + (lr & 31); }
DI uint4 pack8f(const float4& a, const float4& b) {
  uint4 o; o.x = pack2(a.x, a.y); o.y = pack2(a.z, a.w); o.z = pack2(b.x, b.y); o.w = pack2(b.z, b.w); return o;
}

DI void write_tr(const Params& p, int l, int m0, int mi, const float* stg, int tid, int which, int chbase) {
  const bool prompt = m0 < TOKP;
#pragma unroll 1
  for (int q = 0; q < 4; ++q) {
    const int cid = q * NTHR + tid, ch = cid >> 3, tc = cid & 7;
    const float4 v0 = *(const float4*)(stg + ch * EP_LDT + tc * 8);
    const float4 v1 = *(const float4*)(stg + ch * EP_LDT + tc * 8 + 4);
    const int row0 = grow_of(m0, mi, tc * 8);
    const int chg = chbase + ch;
    u16* d;
    if (prompt) {
      const int b = row0 >> 11, t = row0 & 2047;
      if (which == 0) d = (u16*)(p.ws + WS_VTP) + ((size_t)b * 512 + chg) * 2048 + t;
      else if (which == 1) d = (u16*)(p.ws + WS_MQKT_P) + ((size_t)b * 1024 + chg) * 2048 + t;
      else d = (u16*)(p.ws + WS_MVT_P) + ((size_t)b * 512 + chg) * 2048 + t;
    } else {
      const int rs = row0 - TOKP, bs = rs >> 5, t = rs & 31;
      if (which == 0) d = (u16*)(p.ws + WS_VTS) + ((size_t)(l * 8 + bs) * 512 + chg) * 1056 + 1024 + t;
      else if (which == 1) d = (u16*)(p.ws + WS_MQKT_S) + ((size_t)bs * 1024 + chg) * 32 + t;
      else d = (u16*)(p.ws + WS_MVT_S) + ((size_t)bs * 512 + chg) * 32 + t;
    }
    *(uint4*)d = pack8f(v0, v1);
  }
}


template <class F>
DI void epi_rowmajor_bf16(f32x16 (&acc)[4][2], unsigned char* smem, int m0, u16* dst, int ldd, int dcol0, F xf) {
  const int tid = otid(), lane = tid & 63, w = tid >> 6;
  const int wm = w >> 2, wn = w & 3, r = lane & 31, h = lane >> 5;
  unsigned* stg = (unsigned*)(smem + GS_BASE + GS_STAGE);
#pragma unroll
  for (int ps = 0; ps < 2; ++ps) {
    __syncthreads();
#pragma unroll
    for (int q = 0; q < 2; ++q) {
      const int mi = 2 * ps + q;
#pragma unroll
      for (int i = 0; i < 16; ++i) {
        float a = acc[mi][0][i], b = acc[mi][1][i];
        xf(a, b);
        stg[(q * 64 + wm * 32 + crow(i, h)) * 132 + wn * 32 + r] = pack2(a, b);
      }
    }
    __syncthreads();
#pragma unroll
    for (int q = 0; q < 8; ++q) {
      const int cid = q * NTHR + tid, lr = cid >> 5, c = cid & 31;
      const uint4 v = *(const uint4*)(stg + lr * 132 + c * 4);
      const int row = m0 + ((lr >> 5) & 1) * 128 + (2 * ps + (lr >> 6)) * 32 + (lr & 31);
      *(uint4*)(dst + (size_t)row * ldd + dcol0 + c * 8) = v;
    }
  }
  __syncthreads();
}

DI void epi_in(const Params& p, int l, int m0, int n0, f32x16 (&acc)[4][2], unsigned char* smem) {
  const int tid = otid(), lane = tid & 63, w = tid >> 6;
  const int wm = w >> 2, wn = w & 3, r = lane & 31, h = lane >> 5;
  const bool prompt = m0 < TOKP;
  float* stg = (float*)(smem + GS_BASE + GS_STAGE);
  const int seg = n0 < 512 ? 0 : (n0 < 1024 ? 1 : (n0 < 1536 ? 2 : (n0 < 2560 ? 3 : (n0 < 3072 ? 4 : 5))));
  if (seg == 0) { epi_rowmajor_bf16(acc, smem, m0, (u16*)(p.ws + WS_ZQ), 512, n0, [](float&, float&) {}); return; }
  if (seg == 5) { epi_rowmajor_bf16(acc, smem, m0, (u16*)(p.ws + WS_MO), 512, n0 - 3072, [](float& a, float& b) { a = sigmoidf_(a); b = sigmoidf_(b); }); return; }
  if (seg == 3) {
    const int ch = n0 - 1536 + wn * 64 + 2 * r;
#pragma unroll
    for (int mi = 0; mi < 4; ++mi) {
      const int rb = m0 + wm * 128 + mi * 32 + 4 * h;
#pragma unroll
      for (int i = 0; i < 16; ++i) {
        const int row = rb + (i & 3) + 8 * (i >> 2);
        if (prompt) {
          const int tt = row & 2047;
          if (tt >= 2045) *(float2*)(p.out + O_CVP + ((size_t)(l * 32 + (row >> 11)) * 3 + (tt - 2045)) * 1024 + ch) = make_float2(acc[mi][0][i], acc[mi][1][i]);
        } else {
          const int rs = row - TOKP, tt = rs & 31;
          if (tt >= 29) *(float2*)(p.out + O_CVS + ((size_t)(l * 8 + (rs >> 5)) * 3 + (tt - 29)) * 1024 + ch) = make_float2(acc[mi][0][i], acc[mi][1][i]);
        }
      }
    }
  }
#pragma unroll
  for (int mi = 0; mi < 4; ++mi) {
    if (seg == 0 || seg == 1 || seg == 2 || seg == 5) {
      __syncthreads();
      stage_rm(acc[mi][0], acc[mi][1], stg, wm, wn, r, h);
      __syncthreads();
#pragma unroll 1
      for (int q = 0; q < 4; ++q) {
        const int cid = q * NTHR + tid, lr = cid >> 5, c8 = (cid & 31) * 8;
        const float4 v0 = *(const float4*)(stg + lr * EP_LD + c8);
        const float4 v1 = *(const float4*)(stg + lr * EP_LD + c8 + 4);
        const int row = grow_of(m0, mi, lr);
        const int n = n0 + c8;
        if (seg == 0) {
          *(uint4*)((u16*)(p.ws + WS_ZQ) + (size_t)row * 512 + n) = pack8f(v0, v1);
        } else if (seg == 5) {
          const float4 s0 = make_float4(sigmoidf_(v0.x), sigmoidf_(v0.y), sigmoidf_(v0.z), sigmoidf_(v0.w));
          const float4 s1 = make_float4(sigmoidf_(v1.x), sigmoidf_(v1.y), sigmoidf_(v1.z), sigmoidf_(v1.w));
          *(uint4*)((u16*)(p.ws + WS_MO) + (size_t)row * 512 + (n - 3072)) = pack8f(s0, s1);
        } else {
          const bool isk = seg == 1;
          const int nn = n - (isk ? 512 : 1024);
          float* of = p.out + (isk ? (prompt ? O_KP : O_KSM) : (prompt ? O_VP : O_VSM));
          const size_t orow = prompt ? ((size_t)l * TOKP + row) : ((size_t)l * TOKS + (row - TOKP));
          *(float4*)(of + orow * 512 + nn) = v0;
          *(float4*)(of + orow * 512 + nn + 4) = v1;
          if (isk) {
            u16* kd;
            if (prompt) kd = (u16*)(p.ws + WS_KB) + (size_t)row * 512 + nn;
            else { const int rs = row - TOKP; kd = (u16*)(p.ws + WS_KS) + ((size_t)(l * 8 + (rs >> 5)) * 1056 + 1024 + (rs & 31)) * 512 + nn; }
            *(uint4*)kd = pack8f(v0, v1);
          }
        }
      }
    }
    if (seg == 2 || seg == 3 || seg == 4) {
      __syncthreads();
      stage_tr(acc[mi][0], acc[mi][1], stg, wm, wn, r, h);
      __syncthreads();
      write_tr(p, l, m0, mi, stg, tid, seg == 2 ? 0 : (seg == 3 ? 1 : 2), n0 - (seg == 2 ? 1024 : (seg == 3 ? 1536 : 2560)));
    }
  }
  __syncthreads();
}

DI void phase_in_gate(const Params& p, int l, unsigned char* smem) {
  const int tid = otid(), lane = tid & 63, w = tid >> 6;
  const int wm = w >> 2, wn = w & 3, r = lane & 31, h = lane >> 5;
  const u16* H = (const u16*)(p.ws + WS_H);
  const u16* Win = (const u16*)(p.ws + WS_WT_IN) + (size_t)l * 3584 * 1024;
  const u16* Wg = (const u16*)(p.ws + WS_WT_GATE) + (size_t)l * 2048 * 1024;
  float* stg = (float*)(smem + GS_BASE + GS_STAGE);
  const int NT = 14 + 8, MT = 257;
  auto ptrs = [&](int it, const u16*& ap, const u16*& bp) -> bool {
    int mt, nt;
    if (!tile_of(it, MT, NT, mt, nt)) return false;
    ap = H + (size_t)(mt * 256) * 1024;
    bp = (nt < 14 ? Win + (size_t)(nt * 256) * 1024 : Wg + (size_t)((nt - 14) * 256) * 1024);
    return true;
  };
  auto epi = [&](int it, f32x16 (&acc)[4][2]) {
    const int tid = otid(), lane = tid & 63, w = tid >> 6;
    const int wm = w >> 2, wn = w & 3, r = lane & 31, h = lane >> 5;
    int mt, nt;
    tile_of(it, MT, NT, mt, nt);
    const int m0 = mt * 256;
    if (nt < 14) {
      epi_in(p, l, m0, nt * 256, acc, smem);
    } else {
      const int n0 = (nt - 14) * 256;
      const float2 bg = *(const float2*)(p.in[22] + l * 2048 + n0 + wn * 64 + 2 * r);
      epi_rowmajor_bf16(acc, smem, m0, (u16*)(p.ws + WS_G), 2048, n0, [&](float& a, float& b) { a = sigmoidf_(a + bg.x); b = sigmoidf_(b + bg.y); });
    }
  };
  gemm_stream(1024, 1024, 1024, smem, ptrs, epi);
}

DI void phase_mix(const Params& p, int l, unsigned char* smem) {
  const int tid = otid(), lane = tid & 63, w = tid >> 6;
  const int wm = w >> 2, wn = w & 3, r = lane & 31, h = lane >> 5;
  const u16* G = (const u16*)(p.ws + WS_G);
  u16* MIX = (u16*)(p.ws + WS_MIX);
  float* stg = (float*)(smem + GS_BASE + GS_STAGE);
  const int NT = 4, MT = 256;
  auto ptrs = [&](int it, const u16*& ap, const u16*& bp) -> bool {
    int mt, nt;
    if (!tile_of(it >> 1, MT, NT, mt, nt)) return false;
    const int half = it & 1;
    ap = (const u16*)(p.ws + (half ? WS_MN : WS_AN)) + (size_t)(mt * 256) * 512;
    bp = (const u16*)(p.ws + (half ? WS_WT_BRB : WS_WT_BRA)) + (size_t)l * 1024 * 512 + (size_t)(nt * 256) * 512;
    return true;
  };
  auto epi = [&](int it, f32x16 (&acc)[4][2]) {
    const int tid = otid(), lane = tid & 63, w = tid >> 6;
    const int wm = w >> 2, wn = w & 3, r = lane & 31, h = lane >> 5;
    int mt, nt;
    tile_of(it >> 1, MT, NT, mt, nt);
    const int half = it & 1;
    const int m0 = mt * 256, n0 = nt * 256;
#pragma unroll
    for (int mi = 0; mi < 4; ++mi) {
      __syncthreads();
      stage_rm(acc[mi][0], acc[mi][1], stg, wm, wn, r, h);
      __syncthreads();
#pragma unroll 1
      for (int q = 0; q < 4; ++q) {
        const int cid = q * NTHR + tid, lr = cid >> 5, c8 = (cid & 31) * 8;
        const float4 v0 = *(const float4*)(stg + lr * EP_LD + c8);
        const float4 v1 = *(const float4*)(stg + lr * EP_LD + c8 + 4);
        const int row = grow_of(m0, mi, lr), n = n0 + c8;
        const uint4 g = *(const uint4*)(G + (size_t)row * 2048 + half * 1024 + n);
        float4 o0 = make_float4(bflo(g.x) * v0.x, bfhi(g.x) * v0.y, bflo(g.y) * v0.z, bfhi(g.y) * v0.w);
        float4 o1 = make_float4(bflo(g.z) * v1.x, bfhi(g.z) * v1.y, bflo(g.w) * v1.z, bfhi(g.w) * v1.w);
        uint4* mp = (uint4*)(MIX + (size_t)row * 1024 + n);
        if (half) {
          const uint4 pr = *mp;
          o0.x += bflo(pr.x); o0.y += bfhi(pr.x); o0.z += bflo(pr.y); o0.w += bfhi(pr.y);
          o1.x += bflo(pr.z); o1.y += bfhi(pr.z); o1.z += bflo(pr.w); o1.w += bfhi(pr.w);
        }
        *mp = pack8f(o0, o1);
      }
    }
    __syncthreads();
  };
  gemm_stream(512, 512, 512, smem, ptrs, epi);
  {
    const int tid2 = otid(), lane = tid2 & 63, w = tid2 >> 6, r = lane & 31, h = lane >> 5;
    float* red = (float*)(smem + 64);
    for (int mtile = blockIdx.x; mtile < 256; mtile += gridDim.x) {
      const int row0 = TOKP + (mtile >> 5) * 32, n0 = (mtile & 31) * 32;
      f32x16 pa, pb;
      zero16(pa); zero16(pb);
      micro_partial(pa, (const u16*)(p.ws + WS_AN), 512, (const u16*)(p.ws + WS_WT_BRA) + (size_t)l * 1024 * 512, 512, 512, row0, n0, w, r, h);
      micro_partial(pb, (const u16*)(p.ws + WS_MN), 512, (const u16*)(p.ws + WS_WT_BRB) + (size_t)l * 1024 * 512, 512, 512, row0, n0, w, r, h);
      __syncthreads();
      micro_reduce_store(pa, red, w, lane);
      micro_reduce_store(pb, red + 8192, w, lane);
      __syncthreads();
#pragma unroll
      for (int q = 0; q < 2; ++q) {
        const int i = w + 8 * q;
        const float sa = micro_sum(red, i, lane), sb = micro_sum(red + 8192, i, lane);
        const int row = row0 + crow(i, h), n = n0 + r;
        const float ga = bf2f(G[(size_t)row * 2048 + n]), gb = bf2f(G[(size_t)row * 2048 + 1024 + n]);
        MIX[(size_t)row * 1024 + n] = f2bf(ga * sa + gb * sb);
      }
    }
    __syncthreads();
  }
}

DI void phase_res(const Params& p, int l, int mode, unsigned char* smem) {
  const int tid = otid(), lane = tid & 63, w = tid >> 6;
  const int wm = w >> 2, wn = w & 3, r = lane & 31, h = lane >> 5;
  const float* mod = (const float*)(p.ws + WS_MOD);
  float* stg = (float*)(smem + GS_BASE + GS_STAGE);
  const int NT = 4, MT = 256;
  const int K = (mode == 0) ? 1024 : 2816;
  const u16* Ab = (const u16*)(p.ws + (mode == 0 ? WS_MIX : WS_ACT));
  const u16* Wb = (mode == 0) ? (const u16*)(p.ws + WS_WT_O) + (size_t)l * 1024 * 1024 : (const u16*)(p.ws + WS_WT_DOWN) + (size_t)l * 1024 * 2816;
  const int gi = (mode == 0) ? 2 : 5;
  const float* stats = (const float*)(p.ws + WS_STAT);
  const float* rlg = (mode == 1) ? p.in[24] + l * 1024 : p.in[28] + (l > 0 ? l - 1 : 0) * 1024;
  const float* rlb = (mode == 1) ? p.in[25] + l * 1024 : p.in[29] + (l > 0 ? l - 1 : 0) * 1024;
  auto ptrs = [&](int it, const u16*& ap, const u16*& bp) -> bool {
    int mt, nt;
    if (!tile_of(it, MT, NT, mt, nt)) return false;
    ap = Ab + (size_t)(mt * 256) * K;
    bp = Wb + (size_t)(nt * 256) * K;
    return true;
  };
  auto epi = [&](int it, f32x16 (&acc)[4][2]) {
    const int tid = otid(), lane = tid & 63, w = tid >> 6;
    const int wm = w >> 2, wn = w & 3, r = lane & 31, h = lane >> 5;
    int mt, nt;
    tile_of(it, MT, NT, mt, nt);
    const int m0 = mt * 256, n0 = nt * 256;
#pragma unroll
    for (int mi = 0; mi < 4; ++mi) {
      __syncthreads();
      stage_rm(acc[mi][0], acc[mi][1], stg, wm, wn, r, h);
      __syncthreads();
#pragma unroll 1
      for (int q = 0; q < 8; ++q) {
        const int cid = q * NTHR + tid, lr = cid >> 6, c4 = (cid & 63) * 4;
        const float4 v = *(const float4*)(stg + lr * EP_LD + c4);
        const int row = grow_of(m0, mi, lr), n = n0 + c4;
        const int b = batch_of_row(row);
        const float4 gg = *(const float4*)(mod + ((size_t)l * 40 + b) * 6144 + gi * 1024 + n);
        float* xr = p.out + (size_t)row * 1024 + n;
        const float* xs = (mode == 0 && l == 0) ? (row < TOKP ? p.in[0] + (size_t)row * 1024 + n : p.in[1] + (size_t)(row - TOKP) * 1024 + n) : xr;
        float4 xv = *(const float4*)xs;
        if (!(mode == 0 && l == 0)) {
          const float2 st = *(const float2*)(stats + (size_t)row * 2);
          const float4 g4 = *(const float4*)(rlg + n), b4 = *(const float4*)(rlb + n);
          xv.x = (xv.x - st.x) * st.y * g4.x + b4.x; xv.y = (xv.y - st.x) * st.y * g4.y + b4.y;
          xv.z = (xv.z - st.x) * st.y * g4.z + b4.z; xv.w = (xv.w - st.x) * st.y * g4.w + b4.w;
        }
        *(float4*)xr = make_float4(ALPHA * xv.x + (1.f + gg.x) * v.x, ALPHA * xv.y + (1.f + gg.y) * v.y,
                                   ALPHA * xv.z + (1.f + gg.z) * v.z, ALPHA * xv.w + (1.f + gg.w) * v.w);
      }
    }
    __syncthreads();
  };
  gemm_stream(K, K, K, smem, ptrs, epi);
  {
    const int tid2 = otid(), lane = tid2 & 63, w = tid2 >> 6, r = lane & 31, h = lane >> 5;
    float* red = (float*)(smem + 64);
    for (int mtile = blockIdx.x; mtile < 256; mtile += gridDim.x) {
      const int row0 = TOKP + (mtile >> 5) * 32, n0 = (mtile & 31) * 32;
      f32x16 pa;
      zero16(pa);
      micro_partial(pa, Ab, K, Wb, K, K, row0, n0, w, r, h);
      __syncthreads();
      micro_reduce_store(pa, red, w, lane);
      __syncthreads();
#pragma unroll
      for (int q = 0; q < 2; ++q) {
        const int i = w + 8 * q;
        const float sa = micro_sum(red, i, lane);
        const int row = row0 + crow(i, h), n = n0 + r;
        const float gg = mod[((size_t)l * 40 + batch_of_row(row)) * 6144 + gi * 1024 + n];
        float* xr = p.out + (size_t)row * 1024 + n;
        float xv = (mode == 0 && l == 0) ? p.in[1][(size_t)(row - TOKP) * 1024 + n] : *xr;
        if (!(mode == 0 && l == 0)) {
          const float2 st = *(const float2*)(stats + (size_t)row * 2);
          xv = (xv - st.x) * st.y * rlg[n] + rlb[n];
        }
        *xr = ALPHA * xv + (1.f + gg) * sa;
      }
    }
    __syncthreads();
  }
}

DI void phase_gu(const Params& p, int l, unsigned char* smem) {
  const int tid = otid(), lane = tid & 63, w = tid >> 6;
  const int wm = w >> 2, wn = w & 3, r = lane & 31, h = lane >> 5;
  u16* ACT = (u16*)(p.ws + WS_ACT);
  const u16* Hh = (const u16*)(p.ws + WS_H);
  const u16* Wb = (const u16*)(p.ws + WS_WT_GU) + (size_t)l * 5632 * 1024;
  float* stg = (float*)(smem + GS_BASE + GS_STAGE);
  const int NT = 22, MT = 257;
  auto ptrs = [&](int it, const u16*& ap, const u16*& bp) -> bool {
    int mt, nt;
    if (!tile_of(it, MT, NT, mt, nt)) return false;
    ap = Hh + (size_t)(mt * 256) * 1024;
    bp = Wb + (size_t)(nt * 256) * 1024;
    return true;
  };
  auto epi = [&](int it, f32x16 (&acc)[4][2]) {
    const int tid = otid(), lane = tid & 63, w = tid >> 6;
    const int wm = w >> 2, wn = w & 3, r = lane & 31, h = lane >> 5;
    int mt, nt;
    tile_of(it, MT, NT, mt, nt);
    const int m0 = mt * 256, n0 = nt * 256;
#pragma unroll
    for (int ps = 0; ps < 2; ++ps) {
      __syncthreads();
#pragma unroll
      for (int q = 0; q < 2; ++q) {
        const int mi = 2 * ps + q;
#pragma unroll
        for (int i = 0; i < 16; ++i)
          stg[(q * 64 + wm * 32 + crow(i, h)) * 132 + wn * 32 + r] = siluf_(acc[mi][0][i]) * acc[mi][1][i];
      }
      __syncthreads();
#pragma unroll
      for (int q = 0; q < 4; ++q) {
        const int cid = q * NTHR + tid, lr = cid >> 4, c8 = (cid & 15) * 8;
        const float4 v0 = *(const float4*)(stg + lr * 132 + c8);
        const float4 v1 = *(const float4*)(stg + lr * 132 + c8 + 4);
        const int row = m0 + ((lr >> 5) & 1) * 128 + (2 * ps + (lr >> 6)) * 32 + (lr & 31);
        *(uint4*)(ACT + (size_t)row * 2816 + (n0 >> 1) + c8) = pack8f(v0, v1);
      }
    }
    __syncthreads();
  };
  gemm_stream(1024, 1024, 1024, smem, ptrs, epi);
}

constexpr int AT_BASE = 64;
constexpr int AT_KBYTES = 64 * 272;
constexpr int AT_VBYTES = 128 * 136;
constexpr int AT_STAGE = AT_KBYTES + AT_VBYTES;

DI void attn_item(const Params& p, int l, int b, int head, int qt, float lam, float lam_init, unsigned char* smem) {
  const int tid = otid(), lane = tid & 63, w = tid >> 6, r = lane & 31, h = lane >> 5;
  const int comp = w & 1, rg = w >> 1;
  const bool prompt = b < 32;
  const int bs = b - 32;
  const u16* Kg = prompt ? (const u16*)(p.ws + WS_KB) + (size_t)b * 2048 * 512 : (const u16*)(p.ws + WS_KS) + (size_t)(l * 8 + bs) * 1056 * 512;
  const u16* Vg = prompt ? (const u16*)(p.ws + WS_VTP) + (size_t)b * 512 * 2048 : (const u16*)(p.ws + WS_VTS) + (size_t)(l * 8 + bs) * 512 * 1056;
  const int ldT = prompt ? 2048 : 1056;
  const int nkt = prompt ? 2 * qt + 2 : 17;
  const int nkeys = prompt ? 2048 : 1056;
  const int qtok0 = prompt ? b * 2048 + qt * 128 : TOKP + bs * 32;
  const int qpos0 = prompt ? qt * 128 : 1024;
  const bool active = prompt || rg == 0;
  const int my_nkt = prompt ? (rg < 2 ? nkt - 1 : nkt) : nkt;
  const u16* ZQ = (const u16*)(p.ws + WS_ZQ);
  bf16x8 qf[4];
  {
    const int qrow = active ? qtok0 + rg * 32 + r : qtok0;
#pragma unroll
    for (int ks = 0; ks < 4; ++ks) {
      const uint4 qq = *(const uint4*)(ZQ + (size_t)qrow * 512 + head * 128 + comp * 64 + ks * 16 + h * 8);
      const float cq = 0.125f * LOG2E;
      uint4 qs_;
      qs_.x = pack2(bflo(qq.x) * cq, bfhi(qq.x) * cq); qs_.y = pack2(bflo(qq.y) * cq, bfhi(qq.y) * cq);
      qs_.z = pack2(bflo(qq.z) * cq, bfhi(qq.z) * cq); qs_.w = pack2(bflo(qq.w) * cq, bfhi(qq.w) * cq);
      qf[ks] = __builtin_bit_cast(bf16x8, qs_);
    }
  }
  const float slope2 = exp2f(-2.f * (head + 1)) * LOG2E;
  const float c1 = 0.125f * LOG2E;
  const int qpos = qpos0 + rg * 32 + r;
  f32x16 O[4];
#pragma unroll
  for (int i = 0; i < 4; ++i) zero16(O[i]);
  float m_run = -INFINITY, l_run = 0.f;

  const int krow = tid >> 4, kcc = tid & 15;
  const int vrow = tid >> 3, vcc = tid & 7;
  const u16* kp = Kg + (size_t)((nkt - 1) * 64 + krow) * 512 + head * 128 + kcc * 8;
  const u16* vp = Vg + (size_t)(head * 128 + vrow) * ldT + (nkt - 1) * 64 + vcc * 8;
  uint4 rk0, rk1, rv0, rv1;
  unsigned char* sb = smem + AT_BASE;
  rk0 = *(const uint4*)kp; rk1 = *(const uint4*)(kp + 32 * 512);
  rv0 = *(const uint4*)vp; rv1 = *(const uint4*)(vp + (size_t)64 * ldT);
  {
    *(uint4*)(sb + krow * 272 + kcc * 16) = rk0;
    *(uint4*)(sb + (krow + 32) * 272 + kcc * 16) = rk1;
    *(uint2*)(sb + AT_KBYTES + vrow * 136 + vcc * 16) = make_uint2(rv0.x, rv0.y);
    *(uint2*)(sb + AT_KBYTES + vrow * 136 + vcc * 16 + 8) = make_uint2(rv0.z, rv0.w);
    *(uint2*)(sb + AT_KBYTES + (vrow + 64) * 136 + vcc * 16) = make_uint2(rv1.x, rv1.y);
    *(uint2*)(sb + AT_KBYTES + (vrow + 64) * 136 + vcc * 16 + 8) = make_uint2(rv1.z, rv1.w);
  }
  __syncthreads();
  for (int j = 0; j < nkt; ++j) {
    const int kt = nkt - 1 - j;
    const bool more = j + 1 < nkt;
    if (more) {
      kp -= 64 * 512; vp -= 64;
      rk0 = *(const uint4*)kp; rk1 = *(const uint4*)(kp + 32 * 512);
      rv0 = *(const uint4*)vp; rv1 = *(const uint4*)(vp + (size_t)64 * ldT);
    }
    if (active && kt < my_nkt) {
      const unsigned char* Kt = sb + (j & 1) * AT_STAGE;
      const unsigned char* Vt = Kt + AT_KBYTES;
      f32x16 s[2];
      const bool past = (kt * 64 + 63) < (qpos0 + rg * 32);
      if (past) {
        const float kb0 = slope2 * (float)(kt * 64 + 4 * h);
#pragma unroll
        for (int sub = 0; sub < 2; ++sub)
#pragma unroll
          for (int i = 0; i < 16; ++i) s[sub][i] = __builtin_fmaf(slope2, (float)(sub * 32 + (i & 3) + 8 * (i >> 2)), kb0);
      } else {
        zero16(s[0]); zero16(s[1]);
      }
#pragma unroll
      for (int ks = 0; ks < 4; ++ks) {
#pragma unroll
        for (int sub = 0; sub < 2; ++sub) {
          const bf16x8 kf = *(const bf16x8*)(Kt + (sub * 32 + r) * 272 + (comp * 64 + ks * 16 + h * 8) * 2);
          s[sub] = MFMA(kf, qf[ks], s[sub]);
        }
      }
      float mx = -INFINITY;
      if (!past) {
        const float qk0 = (float)(qpos - kt * 64 - 4 * h);
        const float qb = slope2 * (float)qpos;
#pragma unroll
        for (int sub = 0; sub < 2; ++sub)
#pragma unroll
          for (int i = 0; i < 16; ++i) {
            const float d = qk0 - (float)(sub * 32 + (i & 3) + 8 * (i >> 2));
            s[sub][i] = s[sub][i] - slope2 * fabsf(d) + qb;
          }
      }
      if (!prompt) {
#pragma unroll
        for (int sub = 0; sub < 2; ++sub)
#pragma unroll
          for (int i = 0; i < 16; ++i) {
            const int key = kt * 64 + sub * 32 + crow(i, h);
            if (key >= nkeys) s[sub][i] = -INFINITY;
          }
      }
#pragma unroll
      for (int sub = 0; sub < 2; ++sub)
#pragma unroll
        for (int i = 0; i < 16; ++i) mx = fmaxf(mx, s[sub][i]);
      mx = fmaxf(mx, shx(mx, 32, lane));
      const bool livelane = !(mx - m_run < -150.f);
      if (__ballot(livelane) != 0ull) {
        const float m_new = fmaxf(m_run, mx);
        const float alpha = fexp2(m_run - m_new);
        m_run = m_new;
        float lsum = 0.f;
#pragma unroll
        for (int sub = 0; sub < 2; ++sub)
#pragma unroll
          for (int i = 0; i < 16; ++i) {
            const float pv = fexp2(s[sub][i] - m_new);
            lsum += pv;
            s[sub][i] = pv;
          }
        l_run = l_run * alpha + lsum;
        if (__ballot(alpha != 1.f) != 0ull) {
#pragma unroll
          for (int dt = 0; dt < 4; ++dt)
#pragma unroll
            for (int i = 0; i < 16; ++i) O[dt][i] *= alpha;
        }
#pragma unroll
        for (int sub = 0; sub < 2; ++sub)
#pragma unroll
          for (int s2 = 0; s2 < 2; ++s2) {
            const bf16x8 pf = pack8(s[sub], s2);
#pragma unroll
            for (int dt = 0; dt < 4; ++dt) {
              const unsigned char* va = Vt + (dt * 32 + r) * 136 + (sub * 32 + s2 * 16 + 4 * h) * 2;
              const uint2 lo = *(const uint2*)va;
              const uint2 hi = *(const uint2*)(va + 16);
              const uint4 vv = make_uint4(lo.x, lo.y, hi.x, hi.y);
              O[dt] = MFMA(__builtin_bit_cast(bf16x8, vv), pf, O[dt]);
            }
          }
      }
    }
    if (more) {
      unsigned char* sn = sb + ((j + 1) & 1) * AT_STAGE;
      *(uint4*)(sn + krow * 272 + kcc * 16) = rk0;
      *(uint4*)(sn + (krow + 32) * 272 + kcc * 16) = rk1;
      *(uint2*)(sn + AT_KBYTES + vrow * 136 + vcc * 16) = make_uint2(rv0.x, rv0.y);
      *(uint2*)(sn + AT_KBYTES + vrow * 136 + vcc * 16 + 8) = make_uint2(rv0.z, rv0.w);
      *(uint2*)(sn + AT_KBYTES + (vrow + 64) * 136 + vcc * 16) = make_uint2(rv1.x, rv1.y);
      *(uint2*)(sn + AT_KBYTES + (vrow + 64) * 136 + vcc * 16 + 8) = make_uint2(rv1.z, rv1.w);
    }
    __syncthreads();
  }
  float* exch = (float*)(smem + AT_BASE);
  float inv = 0.f;
  if (active) { const float lt = l_run + shx(l_run, 32, lane); inv = __builtin_amdgcn_rcpf(lt); }
  if (active && comp == 1) {
    const float sc = inv * lam;
#pragma unroll
    for (int dt = 0; dt < 4; ++dt)
#pragma unroll
      for (int i = 0; i < 16; ++i) exch[(rg * 64 + dt * 16 + i) * 64 + lane] = O[dt][i] * sc;
  }
  __syncthreads();
  if (active && comp == 0) {
    float ss = 0.f;
#pragma unroll
    for (int dt = 0; dt < 4; ++dt)
#pragma unroll
      for (int i = 0; i < 16; ++i) {
        const float o = O[dt][i] * inv - exch[(rg * 64 + dt * 16 + i) * 64 + lane];
        O[dt][i] = o;
        ss += o * o;
      }
    ss += shx(ss, 32, lane);
    const float rs = rsqrtf(ss * (1.f / 128.f) + LN_EPS) * (1.f - lam_init);
    u16* AN = (u16*)(p.ws + WS_AN) + (size_t)(qtok0 + rg * 32 + r) * 512 + head * 128;
    const float* gw = p.in[17] + l * 512 + head * 128;
#pragma unroll
    for (int dt = 0; dt < 4; ++dt)
#pragma unroll
      for (int g = 0; g < 4; ++g) {
        const int dv = dt * 32 + 8 * g + 4 * h;
        const float4 g4 = *(const float4*)(gw + dv);
        uint2 o;
        o.x = pack2(O[dt][4 * g] * rs * g4.x, O[dt][4 * g + 1] * rs * g4.y);
        o.y = pack2(O[dt][4 * g + 2] * rs * g4.z, O[dt][4 * g + 3] * rs * g4.w);
        *(uint2*)(AN + dv) = o;
      }
  }
}

constexpr int ML_QS = 64;
constexpr int ML_KS = ML_QS + 64 * 272;
constexpr int ML_KT = ML_KS + 64 * 272;
constexpr int ML_VT = ML_KT + 128 * 144;
constexpr int ML_CB = ML_VT + 128 * 144;
constexpr int ML_HB = ML_CB + 128 * 272;
constexpr int ML_SM = ML_HB + 64 * 132 * 4;
static_assert(ML_SM + 528 * 4 <= LDS_BYTES, "lds");

DI void mlstm_item(const Params& p, int l, int b, int head, unsigned char* smem) {
  const int tid = otid(), lane = tid & 63, w = tid >> 6, r = lane & 31, h = lane >> 5;
  const bool prompt = b < 32;
  const int bs = b - 32;
  const int T = prompt ? 2048 : 32;
  const int nch = prompt ? 32 : 1;
  const int L = prompt ? 64 : 32;
  const int tokbase = prompt ? b * 2048 : TOKP + bs * 32;
  const u16* qkT = prompt ? (const u16*)(p.ws + WS_MQKT_P) + (size_t)b * 1024 * 2048 : (const u16*)(p.ws + WS_MQKT_S) + (size_t)bs * 1024 * 32;
  const u16* vTg = prompt ? (const u16*)(p.ws + WS_MVT_P) + (size_t)b * 512 * 2048 : (const u16*)(p.ws + WS_MVT_S) + (size_t)bs * 512 * 32;
  u16* qs = (u16*)(smem + ML_QS);
  u16* ksm = (u16*)(smem + ML_KS);
  u16* kTw = (u16*)(smem + ML_KT);
  u16* vT = (u16*)(smem + ML_VT);
  u16* Cbf = (u16*)(smem + ML_CB);
  float* hbuf = (float*)(smem + ML_HB);
  float* a_s = (float*)(smem + ML_SM);
  float* mx_s = a_s + 64;
  float* ws_s = a_s + 128;
  float* wi_s = a_s + 192;
  float* emt_s = a_s + 256;
  float* nq_s = a_s + 320;
  float* nvec = a_s + 384;
  float* scal = a_s + 512;

  const int vt = w & 3, kt0 = (w >> 2) * 2;
  f32x16 accC[2];
  float m_run = 0.f;
  if (prompt) {
    zero16(accC[0]); zero16(accC[1]);
    if (tid < 128) nvec[tid] = 0.f;
  } else {
    const float* Cs = p.in[6] + ((size_t)(l * 8 + bs) * 4 + head) * 128 * 128;
#pragma unroll
    for (int q = 0; q < 2; ++q)
#pragma unroll
      for (int g = 0; g < 4; ++g) {
        const float4 c4 = *(const float4*)(Cs + (size_t)(vt * 32 + r) * 128 + (kt0 + q) * 32 + 8 * g + 4 * h);
        accC[q][4 * g] = c4.x; accC[q][4 * g + 1] = c4.y; accC[q][4 * g + 2] = c4.z; accC[q][4 * g + 3] = c4.w;
      }
    if (tid < 128) nvec[tid] = p.in[7][((size_t)(l * 8 + bs) * 4 + head) * 128 + tid];
    m_run = p.in[8][(l * 8 + bs) * 4 + head];
  }
#pragma unroll
  for (int q = 0; q < 2; ++q)
#pragma unroll
    for (int g = 0; g < 4; ++g) {
      uint2 o; o.x = pack2(accC[q][4 * g], accC[q][4 * g + 1]); o.y = pack2(accC[q][4 * g + 2], accC[q][4 * g + 3]);
      *(uint2*)(Cbf + (vt * 32 + r) * 136 + (kt0 + q) * 32 + 8 * g + 4 * h) = o;
    }
  const float* gatesp = (const float*)(p.ws + WS_GATES);
  const int vi = w >> 1, ti = w & 1;

  float ig_n = -INFINITY, fg_n = 0.f;
  if (w == 0 && lane < L) {
    const float* gp = gatesp + (size_t)(tokbase + lane) * 8;
    ig_n = gp[head]; fg_n = gp[4 + head];
  }
  for (int c = 0; c < nch; ++c) {
    const int t0 = c * 64;
    if (w == 0) {
      const int t = lane;
      float ig = -INFINITY, lf = 0.f;
      if (t < L) {
        ig = ig_n;
        const float fg = fg_n;
        lf = fminf(fg, 0.f) - log1pf(__expf(-fabsf(fg)));
        if (c + 1 < nch) {
          const float* gp = gatesp + (size_t)(tokbase + t0 + 64 + t) * 8;
          ig_n = gp[head]; fg_n = gp[4 + head];
        }
      }
      float bc = lf;
#pragma unroll
      for (int off = 1; off < 64; off <<= 1) { const float v = shidx(bc, lane - off, lane); if (lane >= off) bc += v; }
      const float a = ig - bc;
      float M = a;
#pragma unroll
      for (int off = 1; off < 64; off <<= 1) { const float v = shidx(M, lane - off, lane); if (lane >= off) M = fmaxf(M, v); }
      const float mx = fmaxf(m_run, M);
      const float bL = shidx(bc, 63, lane);
      const float mxL = shidx(mx, 63, lane);
      a_s[t] = a; mx_s[t] = mx;
      ws_s[t] = __expf(a - mxL);
      wi_s[t] = __expf(m_run - mx);
      emt_s[t] = __expf(-(bc + mx));
      if (lane == 0) scal[1] = __expf(m_run - mxL);
      m_run = bL + mxL;
    }
    const int ch2 = tid >> 1, th = tid & 1;
    const bool isk = ch2 >= 128;
    const int dd = ch2 & 127;
    const int ch = (isk ? 512 : 0) + head * 128 + dd;
    const u16* rp = qkT + (size_t)ch * T + t0 + th * 32;
    float um3 = 0.f, um2 = 0.f, um1 = 0.f;
    const bool ldrow = prompt || th == 0;
    uint4 uu0 = make_uint4(0, 0, 0, 0), uu1 = uu0, uu2 = uu0, uu3 = uu0, vv0 = uu0, vv1 = uu0;
    if (ldrow) { uu0 = *(const uint4*)(rp); uu1 = *(const uint4*)(rp + 8); uu2 = *(const uint4*)(rp + 16); uu3 = *(const uint4*)(rp + 24); }
    {
      const int row = tid >> 3, cc = tid & 7;
      if (prompt || cc < 4) {
        vv0 = *(const uint4*)(vTg + (size_t)(head * 128 + row) * T + t0 + cc * 8);
        vv1 = *(const uint4*)(vTg + (size_t)(head * 128 + row + 64) * T + t0 + cc * 8);
      }
    }
    if (prompt) {
      if (th == 1 || c > 0) {
        const uint2 pv = *(const uint2*)(rp - 4);
        um3 = bfhi(pv.x); um2 = bflo(pv.y); um1 = bfhi(pv.y);
      }
    } else if (th == 0) {
      const float* cvp = p.in[9] + (size_t)(l * 8 + bs) * 3 * 1024 + ch;
      um3 = cvp[0]; um2 = cvp[1024]; um1 = cvp[2048];
    }
    const float cw0 = p.in[14][(l * 4 + 0) * 1024 + ch], cw1 = p.in[14][(l * 4 + 1) * 1024 + ch];
    const float cw2 = p.in[14][(l * 4 + 2) * 1024 + ch], cw3 = p.in[14][(l * 4 + 3) * 1024 + ch];
    const float cb = p.in[15][l * 1024 + ch];
    __syncthreads();
    {
      u16* dstrm = (isk ? ksm : qs) + (th * 32) * 136 + dd;
      const float oscale = isk ? 0.08838834764831845f : 1.f;
#pragma unroll
      for (int i = 0; i < 4; ++i) {
        const uint4 uu = (i == 0) ? uu0 : (i == 1 ? uu1 : (i == 2 ? uu2 : uu3));
        float u[8];
        u[0] = bflo(uu.x); u[1] = bfhi(uu.x); u[2] = bflo(uu.y); u[3] = bfhi(uu.y);
        u[4] = bflo(uu.z); u[5] = bfhi(uu.z); u[6] = bflo(uu.w); u[7] = bfhi(uu.w);
        float y[8];
#pragma unroll
        for (int e = 0; e < 8; ++e) {
          const float x3 = (e >= 3) ? u[e - 3] : (e == 0 ? um3 : (e == 1 ? um2 : um1));
          const float x2 = (e >= 2) ? u[e - 2] : (e == 0 ? um2 : um1);
          const float x1 = (e >= 1) ? u[e - 1] : um1;
          const float yy = cb + cw0 * x3 + cw1 * x2 + cw2 * x1 + cw3 * u[e];
          y[e] = siluf_(yy) * oscale;
        }
        um3 = u[5]; um2 = u[6]; um1 = u[7];
#pragma unroll
        for (int e = 0; e < 8; ++e) dstrm[(i * 8 + e) * 136] = f2bf(y[e]);
        if (isk) {
          const float4 w0 = *(const float4*)(ws_s + th * 32 + i * 8);
          const float4 w1 = *(const float4*)(ws_s + th * 32 + i * 8 + 4);
          uint4 o;
          o.x = pack2(y[0] * w0.x, y[1] * w0.y); o.y = pack2(y[2] * w0.z, y[3] * w0.w);
          o.z = pack2(y[4] * w1.x, y[5] * w1.y); o.w = pack2(y[6] * w1.z, y[7] * w1.w);
          *(uint4*)(kTw + dd * 72 + th * 32 + i * 8) = o;
        }
      }
      {
        const int row = tid >> 3, cc = tid & 7;
        *(uint4*)(vT + row * 72 + cc * 8) = vv0;
        *(uint4*)(vT + (row + 64) * 72 + cc * 8) = vv1;
      }
    }
    __syncthreads();
    {
      const int t = tid >> 3, part = tid & 7;
      const uint4 q0 = *(const uint4*)(qs + t * 136 + part * 16);
      const uint4 q1 = *(const uint4*)(qs + t * 136 + part * 16 + 8);
      const float* nv = nvec + part * 16;
      float s = bflo(q0.x) * nv[0] + bfhi(q0.x) * nv[1] + bflo(q0.y) * nv[2] + bfhi(q0.y) * nv[3]
              + bflo(q0.z) * nv[4] + bfhi(q0.z) * nv[5] + bflo(q0.w) * nv[6] + bfhi(q0.w) * nv[7]
              + bflo(q1.x) * nv[8] + bfhi(q1.x) * nv[9] + bflo(q1.y) * nv[10] + bfhi(q1.y) * nv[11]
              + bflo(q1.z) * nv[12] + bfhi(q1.z) * nv[13] + bflo(q1.w) * nv[14] + bfhi(q1.w) * nv[15];
      s += shx(s, 1, lane); s += shx(s, 2, lane); s += shx(s, 4, lane);
      if (part == 0) nq_s[t] = s;
    }
    f32x16 accS[2], accO;
    zero16(accS[0]); zero16(accS[1]); zero16(accO);
    {
#pragma unroll
      for (int ks = 0; ks < 8; ++ks) {
        const bf16x8 qfr = *(const bf16x8*)(qs + (ti * 32 + r) * 136 + ks * 16 + h * 8);
        const bf16x8 k0 = *(const bf16x8*)(ksm + r * 136 + ks * 16 + h * 8);
        accS[0] = MFMA(k0, qfr, accS[0]);
        if (ti == 1) {
          const bf16x8 k1 = *(const bf16x8*)(ksm + (32 + r) * 136 + ks * 16 + h * 8);
          accS[1] = MFMA(k1, qfr, accS[1]);
        }
        const bf16x8 cf = *(const bf16x8*)(Cbf + (vi * 32 + r) * 136 + ks * 16 + h * 8);
        accO = MFMA(cf, qfr, accO);
      }
    }
    const int tcol = ti * 32 + r;
    const float mxt = mx_s[tcol];
    const float wit = wi_s[tcol];
    float dsum = 0.f;
#pragma unroll
    for (int sub = 0; sub < 2; ++sub) {
      if (sub <= ti) {
#pragma unroll
        for (int g = 0; g < 4; ++g) {
          const float4 a4 = *(const float4*)(a_s + sub * 32 + 8 * g + 4 * h);
          const float av[4] = {a4.x, a4.y, a4.z, a4.w};
#pragma unroll
          for (int e = 0; e < 4; ++e) {
            const int s = sub * 32 + 8 * g + 4 * h + e;
            const float wgt = (s <= tcol) ? __expf(av[e] - mxt) : 0.f;
            const float pv = accS[sub][4 * g + e] * wgt;
            accS[sub][4 * g + e] = pv;
            dsum += pv;
          }
        }
      }
    }
    dsum += shx(dsum, 32, lane);
#pragma unroll
    for (int i = 0; i < 16; ++i) accO[i] *= wit;
#pragma unroll
    for (int sub = 0; sub < 2; ++sub) {
      if (sub <= ti) {
#pragma unroll
        for (int s2 = 0; s2 < 2; ++s2) {
          const bf16x8 pf = pack8(accS[sub], s2);
          const u16* va = vT + (vi * 32 + r) * 72 + sub * 32 + s2 * 16 + 4 * h;
          const uint2 lo = *(const uint2*)va;
          const uint2 hi = *(const uint2*)(va + 8);
          const uint4 vq = make_uint4(lo.x, lo.y, hi.x, hi.y);
          accO = MFMA(__builtin_bit_cast(bf16x8, vq), pf, accO);
        }
      }
    }
    __syncthreads();
    {
      const float den = dsum + wit * nq_s[tcol];
      const float dn = fmaxf(fabsf(den), emt_s[tcol]);
      const float rinv = __builtin_amdgcn_rcpf(dn);
#pragma unroll
      for (int g = 0; g < 4; ++g)
        *(float4*)(hbuf + tcol * 132 + vi * 32 + 8 * g + 4 * h) =
            make_float4(accO[4 * g] * rinv, accO[4 * g + 1] * rinv, accO[4 * g + 2] * rinv, accO[4 * g + 3] * rinv);
    }
    {
      const float wc = scal[1];
#pragma unroll
      for (int q = 0; q < 2; ++q)
#pragma unroll
        for (int i = 0; i < 16; ++i) accC[q][i] *= wc;
#pragma unroll
      for (int k4 = 0; k4 < 4; ++k4) {
        const bf16x8 vf = *(const bf16x8*)(vT + (vt * 32 + r) * 72 + k4 * 16 + h * 8);
#pragma unroll
        for (int q = 0; q < 2; ++q) {
          const bf16x8 kf = *(const bf16x8*)(kTw + ((kt0 + q) * 32 + r) * 72 + k4 * 16 + h * 8);
          accC[q] = MFMA(kf, vf, accC[q]);
        }
      }
#pragma unroll
      for (int q = 0; q < 2; ++q)
#pragma unroll
        for (int g = 0; g < 4; ++g) {
          uint2 o; o.x = pack2(accC[q][4 * g], accC[q][4 * g + 1]); o.y = pack2(accC[q][4 * g + 2], accC[q][4 * g + 3]);
          *(uint2*)(Cbf + (vt * 32 + r) * 136 + (kt0 + q) * 32 + 8 * g + 4 * h) = o;
        }
      if (tid < 128) {
        float s = 0.f;
#pragma unroll
        for (int i = 0; i < 8; ++i) {
          const uint4 kk = *(const uint4*)(kTw + tid * 72 + i * 8);
          s += bflo(kk.x) + bfhi(kk.x) + bflo(kk.y) + bfhi(kk.y) + bflo(kk.z) + bfhi(kk.z) + bflo(kk.w) + bfhi(kk.w);
        }
        nvec[tid] = wc * nvec[tid] + s;
      }
    }
    __syncthreads();
    {
      const int t = tid >> 3, part = tid & 7;
      float x[16];
#pragma unroll
      for (int i = 0; i < 4; ++i) {
        const float4 f = *(const float4*)(hbuf + t * 132 + part * 16 + i * 4);
        x[i * 4] = f.x; x[i * 4 + 1] = f.y; x[i * 4 + 2] = f.z; x[i * 4 + 3] = f.w;
      }
      float s = 0.f;
#pragma unroll
      for (int i = 0; i < 16; ++i) s += x[i];
      s += shx(s, 1, lane); s += shx(s, 2, lane); s += shx(s, 4, lane);
      const float mean = s * (1.f / 128.f);
      float q = 0.f;
#pragma unroll
      for (int i = 0; i < 16; ++i) { x[i] -= mean; q += x[i] * x[i]; }
      q += shx(q, 1, lane); q += shx(q, 2, lane); q += shx(q, 4, lane);
      const float rstd = rsqrtf(q * (1.f / 128.f) + LN_EPS);
      if (t < L) {
        const size_t tok = (size_t)tokbase + t0 + t;
        const int cbase = head * 128 + part * 16;
        const float* gw = p.in[18] + l * 512 + cbase;
        const u16* mo = (const u16*)(p.ws + WS_MO) + tok * 512 + cbase;
        const uint4 m0 = *(const uint4*)mo;
        const uint4 m1 = *(const uint4*)(mo + 8);
        const float sg[16] = {bflo(m0.x), bfhi(m0.x), bflo(m0.y), bfhi(m0.y), bflo(m0.z), bfhi(m0.z), bflo(m0.w), bfhi(m0.w),
                              bflo(m1.x), bfhi(m1.x), bflo(m1.y), bfhi(m1.y), bflo(m1.z), bfhi(m1.z), bflo(m1.w), bfhi(m1.w)};
        float yv[16];
#pragma unroll
        for (int i = 0; i < 16; ++i) yv[i] = x[i] * rstd * gw[i] * sg[i];
        uint4 o0, o1;
        o0.x = pack2(yv[0], yv[1]); o0.y = pack2(yv[2], yv[3]); o0.z = pack2(yv[4], yv[5]); o0.w = pack2(yv[6], yv[7]);
        o1.x = pack2(yv[8], yv[9]); o1.y = pack2(yv[10], yv[11]); o1.z = pack2(yv[12], yv[13]); o1.w = pack2(yv[14], yv[15]);
        u16* mn = (u16*)(p.ws + WS_MN) + tok * 512 + cbase;
        *(uint4*)mn = o0;
        *(uint4*)(mn + 8) = o1;
      }
    }
  }
  {
    float* oc = p.out + (prompt ? O_CP + ((size_t)(l * 32 + b) * 4 + head) * 16384 : O_CS + ((size_t)(l * 8 + bs) * 4 + head) * 16384);
#pragma unroll
    for (int q = 0; q < 2; ++q)
#pragma unroll
      for (int g = 0; g < 4; ++g)
        *(float4*)(oc + (size_t)(vt * 32 + r) * 128 + (kt0 + q) * 32 + 8 * g + 4 * h) =
            make_float4(accC[q][4 * g], accC[q][4 * g + 1], accC[q][4 * g + 2], accC[q][4 * g + 3]);
    float* on = p.out + (prompt ? O_NP + ((size_t)(l * 32 + b) * 4 + head) * 128 : O_NS + ((size_t)(l * 8 + bs) * 4 + head) * 128);
    if (tid < 128) on[tid] = nvec[tid];
    if (tid == 0) {
      if (prompt) p.out[O_MP + (size_t)(l * 32 + b) * 4 + head] = m_run;
      else p.out[O_MS + (size_t)(l * 8 + bs) * 4 + head] = m_run;
    }
  }
}

DI void phase_mixers(const Params& p, int l, unsigned char* smem) {
  const int tid0 = otid();
  const int lane = tid0 & 63;
  const float* lp = p.in[16] + l * 256;
  float s1 = lp[lane] * lp[64 + lane], s2 = lp[128 + lane] * lp[192 + lane];
  s1 = wave_sum(s1, lane); s2 = wave_sum(s2, lane);
  const float lam_init = 0.8f - 0.6f * expf(-0.3f * (float)l);
  const float lam = expf(s1) - expf(s2) + lam_init;
  int* ctr = (int*)(p.ws + WS_CTR) + l;
  int* sitem = (int*)smem;
  const int N_ML = 160, N_AT = 2048 + 32;
  for (;;) {
    __syncthreads();
    if (tid0 == 0) *sitem = atomicAdd(ctr, 1);
    __syncthreads();
    const int item = *sitem;
    if (item >= N_ML + N_AT) break;
    if (item < N_ML) {
#ifndef NO_ML
      mlstm_item(p, l, item >> 2, item & 3, smem);
#endif
    } else {
#ifndef NO_AT
      const int a = item - N_ML;
      if (a < 2048) {
        const int qt = 15 - (a >> 7), rest = a & 127;
        attn_item(p, l, rest >> 2, rest & 3, qt, lam, lam_init, smem);
      } else {
        const int s = a - 2048;
        attn_item(p, l, 32 + (s >> 2), s & 3, 0, lam, lam_init, smem);
      }
#endif
    }
  }
}

DI void gbar(unsigned* ctl, unsigned& k) {
  __syncthreads();
  ++k;
  if (otid() == 0) {
    __threadfence();
    const unsigned x = blockIdx.x & 7;
    const unsigned gsz = (gridDim.x + 7 - x) >> 3;
    const unsigned ngroups = gridDim.x < 8 ? gridDim.x : 8;
    unsigned* gc = ctl + 64 + x * 32;
    unsigned* gl = ctl + 32;
    const unsigned old = __hip_atomic_fetch_add(gc, 1u, __ATOMIC_RELAXED, __HIP_MEMORY_SCOPE_AGENT);
    if (old + 1 == k * gsz) {
      __threadfence();
      __hip_atomic_fetch_add(gl, 1u, __ATOMIC_RELAXED, __HIP_MEMORY_SCOPE_AGENT);
    }
    while (__hip_atomic_load(gl, __ATOMIC_RELAXED, __HIP_MEMORY_SCOPE_AGENT) < k * ngroups) __builtin_amdgcn_s_sleep(1);
    __threadfence();
  }
  __syncthreads();
}

__global__ void __launch_bounds__(NTHR) fwd_megakernel(Params p) {
  extern __shared__ __attribute__((aligned(16))) unsigned char smem[];
  cg::grid_group grid = cg::this_grid();
#ifndef PH
#define PH 0xffff
#endif
  unsigned* bar = (unsigned*)(p.ws + WS_CTR);
  unsigned epoch = 0;
  if (PH & 1) prologue(p, smem);
  grid.sync();
  if (PH & 1) prologue(p, smem);
  grid.sync();
  if (PH & 2) ln_pass(p, 0, 0, smem);
  gbar(bar, epoch);
#pragma unroll 1
  for (int l = 0; l < 2; ++l) {
    if (PH & 4) phase_in_gate(p, l, smem);
    gbar(bar, epoch);
    if (PH & 8) phase_mixers(p, l, smem);
    gbar(bar, epoch);
    if (PH & 16) phase_mix(p, l, smem);
    gbar(bar, epoch);
    if (PH & 32) phase_res(p, l, 0, smem);
    gbar(bar, epoch);
    if (PH & 64) ln_pass(p, 1, l, smem);
    gbar(bar, epoch);
    if (PH & 128) phase_gu(p, l, smem);
    gbar(bar, epoch);
    if (PH & 256) phase_res(p, l, 1, smem);
    gbar(bar, epoch);
    if (PH & 512) ln_pass(p, 2, l, smem);
    if (l == 0) gbar(bar, epoch);
  }
}

extern "C" void kernel_launch(void* const* d_in, const int* in_sizes, int n_in, void* d_out, int out_size, void* d_ws,
                              size_t ws_size, hipStream_t stream) {
  static int grid_blocks = 0;
  if (!grid_blocks) {
    int dev = 0, cus = 0, per_cu = 0;
    hipGetDevice(&dev);
    hipDeviceGetAttribute(&cus, hipDeviceAttributeMultiprocessorCount, dev);
    if (hipFuncSetAttribute((const void*)fwd_megakernel, hipFuncAttributeMaxDynamicSharedMemorySize, LDS_BYTES) != hipSuccess)
      fprintf(stderr, "kernel_launch: hipFuncSetAttribute failed\n");
    if (hipOccupancyMaxActiveBlocksPerMultiprocessor(&per_cu, (const void*)fwd_megakernel, NTHR, LDS_BYTES) != hipSuccess || per_cu < 1) {
      fprintf(stderr, "kernel_launch: occupancy query gave %d\n", per_cu);
      per_cu = 1;
    }
    (void)hipGetLastError();
    grid_blocks = cus * per_cu;
    if (ws_size < WS_END) fprintf(stderr, "kernel_launch: workspace too small: %zu < %zu\n", ws_size, (size_t)WS_END);
  }
  if (hipMemsetAsync((char*)d_ws + WS_CTR, 0, 4096, stream) != hipSuccess) fprintf(stderr, "kernel_launch: memset failed\n");
  Params p{};
  for (int i = 0; i < 30; ++i) p.in[i] = (const float*)d_in[i];
  p.out = (float*)d_out;
  p.ws = (unsigned char*)d_ws;
  void* args[] = {&p};
  hipError_t e = hipLaunchCooperativeKernel((const void*)fwd_megakernel, dim3(grid_blocks), dim3(NTHR), args, LDS_BYTES, stream);
  if (e != hipSuccess) fprintf(stderr, "cooperative launch failed: %s (grid %d)\n", hipGetErrorString(e), grid_blocks);
}
```

```cpp
#include <hip/hip_runtime.h>
#include <hip/hip_cooperative_groups.h>
#include <cstdio>
namespace cg = cooperative_groups;

#define DI __device__ __forceinline__
typedef unsigned short u16;
using bf16x8 = __attribute__((ext_vector_type(8))) short;
using f32x16 = __attribute__((ext_vector_type(16))) float;
#define MFMA(a, b, c) __builtin_amdgcn_mfma_f32_32x32x16_bf16((a), (b), (c), 0, 0, 0)

constexpr int TOKP = 65536, TOKS = 256, TOK = 65792;
constexpr int NTHR = 512;
constexpr float LN_EPS = 1e-5f;
constexpr float ALPHA = 1.41421356237f;
constexpr float LOG2E = 1.44269504089f;

constexpr size_t WS_WT_IN   = 0;
constexpr size_t WS_WT_GATE = WS_WT_IN + 2ull * 3584 * 1024 * 2;
constexpr size_t WS_WT_BRA  = WS_WT_GATE + 2ull * 2048 * 1024 * 2;
constexpr size_t WS_WT_BRB  = WS_WT_BRA + 2ull * 1024 * 512 * 2;
constexpr size_t WS_WT_O    = WS_WT_BRB + 2ull * 1024 * 512 * 2;
constexpr size_t WS_WT_GU   = WS_WT_O + 2ull * 1024 * 1024 * 2;
constexpr size_t WS_WT_DOWN = WS_WT_GU + 2ull * 5632 * 1024 * 2;
constexpr size_t WS_MOD     = WS_WT_DOWN + 2ull * 1024 * 2816 * 2;
constexpr size_t WS_GATES   = WS_MOD + 2ull * 40 * 6144 * 4;
constexpr size_t WS_CTR     = WS_GATES + (size_t)TOK * 8 * 4;
constexpr size_t WS_STAT    = WS_CTR + 4096;
constexpr size_t WS_KS      = WS_STAT + (size_t)TOK * 8;
constexpr size_t WS_VTS     = WS_KS + 2ull * 8 * 1056 * 512 * 2 + 65536;
constexpr size_t WS_MQKT_S  = WS_VTS + 2ull * 8 * 512 * 1056 * 2 + 65536;
constexpr size_t WS_MVT_S   = WS_MQKT_S + 8ull * 1024 * 32 * 2;
constexpr size_t WS_H       = WS_MVT_S + 8ull * 512 * 32 * 2;
constexpr size_t WS_AN      = WS_H;
constexpr size_t WS_MN      = WS_H + (size_t)TOK * 512 * 2;
constexpr size_t WS_ZQ      = WS_H + (size_t)TOK * 1024 * 2;
constexpr size_t WS_KB      = WS_ZQ + (size_t)TOK * 512 * 2;
constexpr size_t WS_VTP     = WS_KB + (size_t)TOKP * 512 * 2;
constexpr size_t WS_MQKT_P  = WS_VTP + 32ull * 512 * 2048 * 2;
constexpr size_t WS_MVT_P   = WS_MQKT_P + 32ull * 1024 * 2048 * 2;
constexpr size_t WS_MO      = WS_MVT_P + 32ull * 512 * 2048 * 2;
constexpr size_t WS_G       = WS_MO + (size_t)TOK * 512 * 2;
constexpr size_t WS_END     = WS_G + (size_t)TOK * 2048 * 2;
constexpr size_t WS_MIX     = WS_ZQ;
constexpr size_t WS_ACT     = WS_ZQ;

constexpr size_t O_YP  = 0;
constexpr size_t O_YS  = O_YP + (size_t)TOKP * 1024;
constexpr size_t O_KP  = O_YS + (size_t)TOKS * 1024;
constexpr size_t O_VP  = O_KP + 2ull * TOKP * 512;
constexpr size_t O_KSM = O_VP + 2ull * TOKP * 512;
constexpr size_t O_VSM = O_KSM + 2ull * TOKS * 512;
constexpr size_t O_CP  = O_VSM + 2ull * TOKS * 512;
constexpr size_t O_NP  = O_CP + 2ull * 32 * 4 * 128 * 128;
constexpr size_t O_MP  = O_NP + 2ull * 32 * 4 * 128;
constexpr size_t O_CVP = O_MP + 2ull * 32 * 4;
constexpr size_t O_CS  = O_CVP + 2ull * 32 * 3 * 1024;
constexpr size_t O_NS  = O_CS + 2ull * 8 * 4 * 128 * 128;
constexpr size_t O_MS  = O_NS + 2ull * 8 * 4 * 128;
constexpr size_t O_CVS = O_MS + 2ull * 8 * 4;

constexpr int LDS_BYTES = 148480;

struct Params {
  const float* in[30];
  float* out;
  unsigned char* ws;
};


DI float bf2f(unsigned v) { return __uint_as_float(v << 16); }
typedef __bf16 bf16x2_t __attribute__((ext_vector_type(2)));
typedef float f32x2_t __attribute__((ext_vector_type(2)));
DI unsigned pack2(float a, float b) {
  f32x2_t v = {a, b};
  return __builtin_bit_cast(unsigned, __builtin_convertvector(v, bf16x2_t));
}
DI u16 f2bf(float x) { return (u16)(pack2(x, 0.f) & 0xffffu); }
DI float bflo(unsigned v) { return __uint_as_float(v << 16); }
DI float bfhi(unsigned v) { return __uint_as_float(v & 0xffff0000u); }
DI float sigmoidf_(float x) { return __builtin_amdgcn_rcpf(1.f + __expf(-x)); }
DI float siluf_(float x) { return x * __builtin_amdgcn_rcpf(1.f + __expf(-x)); }
DI float fexp2(float x) { return __builtin_amdgcn_exp2f(x); }
DI int otid() { int t = threadIdx.x; asm volatile("" : "+v"(t)); return t; }
DI float shx(float v, int mask, int lane) { return __int_as_float(__builtin_amdgcn_ds_bpermute(((lane ^ mask) & 63) << 2, __float_as_int(v))); }
DI float shidx(float v, int src, int lane) { (void)lane; return __int_as_float(__builtin_amdgcn_ds_bpermute((src & 63) << 2, __float_as_int(v))); }
DI int crow(int i, int h) { return (i & 3) + 8 * (i >> 2) + 4 * h; }
DI bf16x8 pack8(const f32x16& x, int s) {
  uint4 u;
  u.x = pack2(x[8 * s + 0], x[8 * s + 1]); u.y = pack2(x[8 * s + 2], x[8 * s + 3]);
  u.z = pack2(x[8 * s + 4], x[8 * s + 5]); u.w = pack2(x[8 * s + 6], x[8 * s + 7]);
  return __builtin_bit_cast(bf16x8, u);
}
DI void zero16(f32x16& a) {
#pragma unroll
  for (int i = 0; i < 16; ++i) a[i] = 0.f;
}
DI int batch_of_row(int row) { return row < TOKP ? (row >> 11) : 32 + ((row - TOKP) >> 5); }

constexpr int GS_STRIDE = 144;
constexpr int GS_STAGE = 512 * GS_STRIDE;
constexpr int GS_BASE = 64;

DI void gemm_mainloop(f32x16 (&acc)[4][2], const u16* __restrict__ A, int lda, const u16* __restrict__ Wt, int ldw, int K,
                      int m0, int n0, unsigned char* smem) {
  const int tid = otid(), lane = tid & 63, w = tid >> 6;
  const int wm = w >> 2, wn = w & 3, r = lane & 31, h = lane >> 5;
  const int lrow = tid >> 3, lcc = tid & 7;
  const u16* ap = A + (size_t)(m0 + lrow) * lda + lcc * 8;
  const int bn = n0 + 2 * (lrow & 31) + ((lrow >> 5) & 1);
  const u16* bp = Wt + (size_t)bn * ldw + lcc * 8;
  const size_t astep = (size_t)64 * lda, bstep = (size_t)64 * ldw;
  unsigned char* sbase = smem + GS_BASE;
  const int woff = lrow * GS_STRIDE + lcc * 16;
  const int nk = K >> 6;
  uint4 s0, s1, s2, s3, s4, s5, s6, s7, u0, u1, u2, u3, u4, u5, u6, u7;
  int kn = 1;
#define G_ADV() do { const int adv = (kn < nk) ? 64 : 0; ap += adv; bp += adv; ++kn; } while (0)
#define G_ISSUE_A() do { s0 = *(const uint4*)(ap); s1 = *(const uint4*)(ap + astep); s2 = *(const uint4*)(ap + 2 * astep); s3 = *(const uint4*)(ap + 3 * astep); \
    s4 = *(const uint4*)(bp); s5 = *(const uint4*)(bp + bstep); s6 = *(const uint4*)(bp + 2 * bstep); s7 = *(const uint4*)(bp + 3 * bstep); } while (0)
#define G_ISSUE_B() do { u0 = *(const uint4*)(ap); u1 = *(const uint4*)(ap + astep); u2 = *(const uint4*)(ap + 2 * astep); u3 = *(const uint4*)(ap + 3 * astep); \
    u4 = *(const uint4*)(bp); u5 = *(const uint4*)(bp + bstep); u6 = *(const uint4*)(bp + 2 * bstep); u7 = *(const uint4*)(bp + 3 * bstep); } while (0)
#define G_WRITE_A(sn) do { *(uint4*)((sn) + woff) = s0; *(uint4*)((sn) + woff + 64 * GS_STRIDE) = s1; *(uint4*)((sn) + woff + 128 * GS_STRIDE) = s2; \
    *(uint4*)((sn) + woff + 192 * GS_STRIDE) = s3; *(uint4*)((sn) + woff + 256 * GS_STRIDE) = s4; *(uint4*)((sn) + woff + 320 * GS_STRIDE) = s5; \
    *(uint4*)((sn) + woff + 384 * GS_STRIDE) = s6; *(uint4*)((sn) + woff + 448 * GS_STRIDE) = s7; } while (0)
#define G_WRITE_B(sn) do { *(uint4*)((sn) + woff) = u0; *(uint4*)((sn) + woff + 64 * GS_STRIDE) = u1; *(uint4*)((sn) + woff + 128 * GS_STRIDE) = u2; \
    *(uint4*)((sn) + woff + 192 * GS_STRIDE) = u3; *(uint4*)((sn) + woff + 256 * GS_STRIDE) = u4; *(uint4*)((sn) + woff + 320 * GS_STRIDE) = u5; \
    *(uint4*)((sn) + woff + 384 * GS_STRIDE) = u6; *(uint4*)((sn) + woff + 448 * GS_STRIDE) = u7; } while (0)
  const int aoff = (wm * 128 + r) * GS_STRIDE + h * 16;
  const int boff = (256 + wn * 64 + r) * GS_STRIDE + h * 16;
#define G_COMPUTE(st) do { _Pragma("unroll") for (int ks = 0; ks < 4; ++ks) {                                              \
      bf16x8 fa[4], fb[2];                                                                                               \
      _Pragma("unroll") for (int mi = 0; mi < 4; ++mi) fa[mi] = *(const bf16x8*)((st) + aoff + mi * 32 * GS_STRIDE + ks * 32); \
      fb[0] = *(const bf16x8*)((st) + boff + ks * 32);                                                                   \
      fb[1] = *(const bf16x8*)((st) + boff + 32 * GS_STRIDE + ks * 32);                                                  \
      _Pragma("unroll") for (int mi = 0; mi < 4; ++mi) {                                                                 \
        acc[mi][0] = MFMA(fa[mi], fb[0], acc[mi][0]);                                                                    \
        acc[mi][1] = MFMA(fa[mi], fb[1], acc[mi][1]);                                                                    \
      }                                                                                                                  \
      __builtin_amdgcn_sched_barrier(0);                                                                                 \
    } } while (0)
  G_ISSUE_A();
  G_WRITE_A(sbase);
  G_ADV(); G_ISSUE_A();
  G_ADV(); G_ISSUE_B();
  __syncthreads();
  for (int kt = 0; kt < nk; kt += 2) {
    G_WRITE_A(sbase + GS_STAGE);
    G_ADV(); G_ISSUE_A();
    __builtin_amdgcn_sched_barrier(0);
    G_COMPUTE(sbase);
    __syncthreads();
    G_WRITE_B(sbase);
    G_ADV(); G_ISSUE_B();
    __builtin_amdgcn_sched_barrier(0);
    G_COMPUTE(sbase + GS_STAGE);
    __syncthreads();
  }
#undef G_ADV
#undef G_ISSUE_A
#undef G_ISSUE_B
#undef G_WRITE_A
#undef G_WRITE_B
#undef G_COMPUTE
}

DI int rot_unused_(int) { return 0; }
DI bool tile_of(int i, int MT, int NT, int& mt, int& nt) {
  const int per = gridDim.x >> 3;
  const int L = i * (int)gridDim.x + (int)(blockIdx.x & 7) * per + (int)(blockIdx.x >> 3);
  if (L >= MT * NT) return false;
  const int nig = 8 * NT, gid = L / nig, fm = gid * 8, gsz = min(MT - fm, 8), rem = L - gid * nig;
  mt = fm + rem % gsz; nt = rem / gsz;
  return true;
}


template <class PF, class EF>
DI void gemm_stream(int lda, int ldw, int K, unsigned char* smem, PF ptrs, EF epi) {
  const int tid = otid(), lane = tid & 63, w = tid >> 6;
  const int wm = w >> 2, wn = w & 3, r = lane & 31, h = lane >> 5;
  unsigned char* sbase = smem + GS_BASE;
  constexpr int SLOT = 512 * 64;
  const int nh = K >> 5;
  const int c0 = (h ^ ((r >> 2) & 3)) * 16, c1 = c0 ^ 32;
  const int aoff = (wm * 128 + r) * 64, boff = (256 + wn * 64 + r) * 64;
  const int lr16 = lane >> 2, lchunk = (lane & 3) ^ ((lane >> 4) & 3);
  const int wu = __builtin_amdgcn_readfirstlane(w);
  const bool isB = wu >= 4;
  const unsigned goff = isB ? (unsigned)((((wu - 4) * 64 + 2 * lr16) * ldw + lchunk * 8) * 2)
                            : (unsigned)(((wu * 64 + lr16) * lda + lchunk * 8) * 2);
  const unsigned st1 = isB ? (unsigned)(32 * ldw * 2) : (unsigned)(16 * lda * 2);
  const unsigned st2 = isB ? (unsigned)(1 * ldw * 2) : (unsigned)(32 * lda * 2);
#define WAIT_V(n) asm volatile("s_waitcnt vmcnt(" #n ")" ::: "memory")
#define RAWBAR() do { asm volatile("s_waitcnt lgkmcnt(0)" ::: "memory"); __builtin_amdgcn_s_barrier(); asm volatile("" ::: "memory"); } while (0)
#define BAR0() do { asm volatile("" ::: "memory"); __builtin_amdgcn_s_barrier(); asm volatile("" ::: "memory"); } while (0)
#define H_DMA(slotp) do { const char* gsrc_ = (isB ? bp : ap) + goff; unsigned char* ld_ = (slotp) + wu * 4096;            \
    __builtin_amdgcn_global_load_lds((const unsigned*)(gsrc_), (unsigned*)(ld_), 16, 0, 0);                                  \
    __builtin_amdgcn_global_load_lds((const unsigned*)(gsrc_ + st1), (unsigned*)(ld_ + 1024), 16, 0, 0);                     \
    __builtin_amdgcn_global_load_lds((const unsigned*)(gsrc_ + st2), (unsigned*)(ld_ + 2048), 16, 0, 0);                     \
    __builtin_amdgcn_global_load_lds((const unsigned*)(gsrc_ + st2 + st1), (unsigned*)(ld_ + 3072), 16, 0, 0); } while (0)
#define H_READ(sl) do { _Pragma("unroll") for (int mi = 0; mi < 4; ++mi) {                                                   \
      fa[0][mi] = *(const bf16x8*)((sl) + aoff + mi * 2048 + c0); fa[1][mi] = *(const bf16x8*)((sl) + aoff + mi * 2048 + c1); } \
    fb[0][0] = *(const bf16x8*)((sl) + boff + c0); fb[1][0] = *(const bf16x8*)((sl) + boff + c1);                            \
    fb[0][1] = *(const bf16x8*)((sl) + boff + 2048 + c0); fb[1][1] = *(const bf16x8*)((sl) + boff + 2048 + c1); } while (0)
#define H_MMA() do { _Pragma("unroll") for (int ks = 0; ks < 2; ++ks) { _Pragma("unroll") for (int mi = 0; mi < 4; ++mi) {  \
      acc[mi][0] = MFMA(fa[ks][mi], fb[ks][0], acc[mi][0]);                                                       \
      acc[mi][1] = MFMA(fa[ks][mi], fb[ks][1], acc[mi][1]); } } } while (0)
  const char *ap, *bp;
  {
    const u16 *ta, *tb;
    int it0 = 0;
    asm volatile("" : "+s"(it0));
    if (!ptrs(it0, ta, tb)) return;
    ap = (const char*)ta; bp = (const char*)tb;
  }
  H_DMA(sbase); ap += 64; bp += 64;
  H_DMA(sbase + SLOT); ap += 64; bp += 64;
  for (int it = 0;; ++it) {
    f32x16 acc[4][2];
#pragma unroll
    for (int a = 0; a < 4; ++a)
#pragma unroll
      for (int b = 0; b < 2; ++b) zero16(acc[a][b]);
    H_DMA(sbase + 2 * SLOT); ap += 64; bp += 64;
    WAIT_V(4);
    BAR0();
    if (wm == 1) BAR0();
    int rs = 0;
#pragma unroll 1
    for (int hh = 0; hh < nh; ++hh) {
      bf16x8 fa[2][4], fb[2][2];
      const int rem = nh - 2 - hh;
      H_READ(sbase + rs * SLOT);
      if (hh + 3 < nh) { H_DMA(sbase + ((rs + 3) & 3) * SLOT); ap += 64; bp += 64; }
      if (wm == 1) {
        if (rem >= 2) WAIT_V(8); else if (rem == 1) WAIT_V(4); else WAIT_V(0);
      }
      __builtin_amdgcn_sched_barrier(0);
      RAWBAR();
      __builtin_amdgcn_sched_barrier(0);
      H_MMA();
      __builtin_amdgcn_sched_barrier(0);
      if (wm == 0) {
        if (rem >= 2) WAIT_V(8); else if (rem == 1) WAIT_V(4); else WAIT_V(0);
      }
      BAR0();
      rs = (rs + 1) & 3;
    }
    if (wm == 0) BAR0();
    bool more;
    {
      const u16 *ta, *tb;
      more = ptrs(it + 1, ta, tb);
      if (more) {
        ap = (const char*)ta; bp = (const char*)tb;
        H_DMA(sbase); ap += 64; bp += 64;
        H_DMA(sbase + SLOT); ap += 64; bp += 64;
      }
    }
    epi(it, acc);
    if (!more) break;
  }
#undef WAIT_V
#undef RAWBAR
#undef BAR0
#undef H_DMA
#undef H_READ
#undef H_MMA
}

DI int map_row(int maptype, int s) {
  if (maptype == 1) return s < 3072 ? s : (s < 3080 ? -1 : s - 8);
  if (maptype == 2) return s < 2816 ? 2 * s : 2 * (s - 2816) + 1;
  return s;
}
DI void transpose_task(const float* __restrict__ src, int Nsrc, u16* __restrict__ dst, int dld, int maptype, int kt2, int nt,
                       unsigned char* smem) {
  float* tile = (float*)(smem + 64);
  const int tid = otid();
  const int k0 = kt2 * 128, s0 = nt * 64;
  float4 v[4];
#pragma unroll
  for (int i = 0; i < 4; ++i) {
    const int kr = (tid >> 4) + 32 * i, nc = (tid & 15) * 4;
    v[i] = make_float4(0.f, 0.f, 0.f, 0.f);
    if (s0 + nc < Nsrc) v[i] = *(const float4*)(src + (size_t)(k0 + kr) * Nsrc + s0 + nc);
  }
#pragma unroll
  for (int i = 0; i < 4; ++i) {
    const int kr = (tid >> 4) + 32 * i, nc = (tid & 15) * 4;
    tile[kr * 65 + nc + 0] = v[i].x; tile[kr * 65 + nc + 1] = v[i].y; tile[kr * 65 + nc + 2] = v[i].z; tile[kr * 65 + nc + 3] = v[i].w;
  }
  __syncthreads();
  {
    const int n = tid >> 3;
    const int s = s0 + n;
    const int dr = (s < Nsrc) ? map_row(maptype, s) : -1;
    if (dr >= 0) {
#pragma unroll
      for (int j = 0; j < 2; ++j) {
        const int kc = (tid & 7) * 8 + 64 * j;
        uint4 o;
        o.x = pack2(tile[(kc + 0) * 65 + n], tile[(kc + 1) * 65 + n]);
        o.y = pack2(tile[(kc + 2) * 65 + n], tile[(kc + 3) * 65 + n]);
        o.z = pack2(tile[(kc + 4) * 65 + n], tile[(kc + 5) * 65 + n]);
        o.w = pack2(tile[(kc + 6) * 65 + n], tile[(kc + 7) * 65 + n]);
        *(uint4*)(dst + (size_t)dr * dld + k0 + kc) = o;
      }
    }
  }
  __syncthreads();
}

DI void adaln_task(const Params& p, int task, unsigned char* smem) {
  const int bhalf = task & 1, cg_ = (task >> 1) % 96, l = (task >> 1) / 96;
  float* cs = (float*)(smem + 64);
  float* red = (float*)(smem + 64 + 20 * 1024 * 4);
  const int tid = otid();
  const float* cp = p.in[2]; const float* csm = p.in[3];
  for (int idx = tid; idx < 20 * 1024; idx += NTHR) {
    const int bb = idx >> 10, d = idx & 1023, b = bhalf * 20 + bb;
    const float c = b < 32 ? cp[b * 1024 + d] : csm[(b - 32) * 1024 + d];
    cs[idx] = siluf_(c);
  }
  __syncthreads();
  const int dseg = tid >> 6, e = cg_ * 64 + (tid & 63);
  const float* wp = p.in[10] + ((size_t)l * 1024 + dseg * 128) * 6144 + e;
  float acc[20];
#pragma unroll
  for (int i = 0; i < 20; ++i) acc[i] = 0.f;
  for (int d = 0; d < 128; ++d) {
    const float wv = wp[(size_t)d * 6144];
    const float* c0 = cs + dseg * 128 + d;
#pragma unroll
    for (int i = 0; i < 20; ++i) acc[i] += c0[i * 1024] * wv;
  }
#pragma unroll
  for (int i = 0; i < 20; ++i) red[(dseg * 20 + i) * 64 + (tid & 63)] = acc[i];
  __syncthreads();
  float* mod = (float*)(p.ws + WS_MOD);
  for (int idx = tid; idx < 20 * 64; idx += NTHR) {
    const int bb = idx >> 6, ec = idx & 63;
    float s = 0.f;
#pragma unroll
    for (int q = 0; q < 8; ++q) s += red[(q * 20 + bb) * 64 + ec];
    const int ee = cg_ * 64 + ec;
    mod[((size_t)l * 40 + bhalf * 20 + bb) * 6144 + ee] = s + p.in[11][l * 6144 + ee];
  }
  __syncthreads();
}

DI void prologue(const Params& p, unsigned char* smem) {
  const int WT_TASKS_L = 456 + 256 + 64 + 64 + 128 + 704 + 352;
  const int N_WT = 2 * WT_TASKS_L;
  const int N_ADA = 384, N_CK = 512, N_CV = 1024;
  const int total = N_WT + N_ADA + N_CK + N_CV;
  for (int task = blockIdx.x; task < total; task += gridDim.x) {
    if (task < N_WT) {
      const int l = task / WT_TASKS_L; int t = task % WT_TASKS_L;
      if (t < 456) { transpose_task(p.in[12] + (size_t)l * 1024 * 3592, 3592, (u16*)(p.ws + WS_WT_IN) + (size_t)l * 3584 * 1024, 1024, 1, t / 57, t % 57, smem); continue; }
      t -= 456;
      if (t < 256) { transpose_task(p.in[21] + (size_t)l * 1024 * 2048, 2048, (u16*)(p.ws + WS_WT_GATE) + (size_t)l * 2048 * 1024, 1024, 0, t / 32, t % 32, smem); continue; }
      t -= 256;
      if (t < 64) { transpose_task(p.in[19] + (size_t)l * 512 * 1024, 1024, (u16*)(p.ws + WS_WT_BRA) + (size_t)l * 1024 * 512, 512, 0, t / 16, t % 16, smem); continue; }
      t -= 64;
      if (t < 64) { transpose_task(p.in[20] + (size_t)l * 512 * 1024, 1024, (u16*)(p.ws + WS_WT_BRB) + (size_t)l * 1024 * 512, 512, 0, t / 16, t % 16, smem); continue; }
      t -= 64;
      if (t < 128) { transpose_task(p.in[23] + (size_t)l * 1024 * 1024, 1024, (u16*)(p.ws + WS_WT_O) + (size_t)l * 1024 * 1024, 1024, 0, t / 16, t % 16, smem); continue; }
      t -= 128;
      if (t < 704) { transpose_task(p.in[26] + (size_t)l * 1024 * 5632, 5632, (u16*)(p.ws + WS_WT_GU) + (size_t)l * 5632 * 1024, 1024, 2, t / 88, t % 88, smem); continue; }
      t -= 704;
      transpose_task(p.in[27] + (size_t)l * 2816 * 1024, 1024, (u16*)(p.ws + WS_WT_DOWN) + (size_t)l * 1024 * 2816, 2816, 0, t / 16, t % 16, smem);
    } else if (task < N_WT + N_ADA) {
      adaln_task(p, task - N_WT, smem);
    } else if (task < N_WT + N_ADA + N_CK) {
      const int t = task - N_WT - N_ADA;
      const float4* src = (const float4*)p.in[4];
      u16* dst = (u16*)(p.ws + WS_KS);
#pragma unroll
      for (int i = 0; i < 8; ++i) {
        const size_t f4 = (size_t)t * 4096 + i * 512 + otid();
        const float4 v = src[f4];
        const size_t e = f4 * 4;
        const size_t lb = e / (1024 * 512), rem = e % (1024 * 512);
        uint2 o; o.x = pack2(v.x, v.y); o.y = pack2(v.z, v.w);
        *(uint2*)(dst + lb * (1056 * 512) + rem) = o;
      }
    } else {
      const int t = task - N_WT - N_ADA - N_CK;
      const int lb = t >> 6, tt = t & 63;
      transpose_task(p.in[5] + (size_t)lb * 1024 * 512, 512, (u16*)(p.ws + WS_VTS) + (size_t)lb * 512 * 1056, 1056, 0, tt >> 3, tt & 7, smem);
    }
  }
}

DI float wave_sum(float v, int lane) {
  (void)lane;
  int x = __float_as_int(v);
  v += __int_as_float(__builtin_amdgcn_update_dpp(0, x, 0xB1, 0xF, 0xF, true));
  x = __float_as_int(v);
  v += __int_as_float(__builtin_amdgcn_update_dpp(0, x, 0x4E, 0xF, 0xF, true));
  x = __float_as_int(v);
  v += __int_as_float(__builtin_amdgcn_update_dpp(0, x, 0x141, 0xF, 0xF, true));
  x = __float_as_int(v);
  v += __int_as_float(__builtin_amdgcn_update_dpp(0, x, 0x140, 0xF, 0xF, true));
  x = __float_as_int(v);
  const float r0 = __int_as_float(__builtin_amdgcn_readlane(x, 0)), r1 = __int_as_float(__builtin_amdgcn_readlane(x, 16));
  const float r2 = __int_as_float(__builtin_amdgcn_readlane(x, 32)), r3 = __int_as_float(__builtin_amdgcn_readlane(x, 48));
  return (r0 + r1) + (r2 + r3);
}
DI void ln_pass(const Params& p, int mode, int l, unsigned char* smem) {
  const int tid = otid();
  const int lane = tid & 63, w = tid >> 6;
  const bool first = mode != 0;
  const bool second = (mode != 2) || (l + 1 < 2);
  const bool gates = (mode == 0) || (mode == 2 && l + 1 < 2);
  const int lm = (mode == 2) ? l + 1 : l;
  const int shi = (mode == 1) ? 3 : 0;
  const float* lng = (mode == 1) ? p.in[24] + l * 1024 : p.in[28] + l * 1024;
  const float* lnb = (mode == 1) ? p.in[25] + l * 1024 : p.in[29] + l * 1024;
  const float* mod = (const float*)(p.ws + WS_MOD);
  u16* H = (u16*)(p.ws + WS_H);
  float* gout = (float*)(p.ws + WS_GATES);
  float* wl = (float*)(smem + 64);
  float bif[8];
  if (gates) {
    const float* wi = p.in[12] + (size_t)lm * 1024 * 3592 + 3072;
    for (int idx = tid; idx < 8192; idx += NTHR) {
      const int c = idx >> 3, j = idx & 7;
      wl[j * 1024 + c] = wi[(size_t)c * 3592 + j];
    }
#pragma unroll
    for (int j = 0; j < 8; ++j) bif[j] = p.in[13][lm * 8 + j];
  }
  __syncthreads();
  float lg[16], lb[16];
  if (first) {
#pragma unroll
    for (int i = 0; i < 4; ++i) {
      const float4 g = *(const float4*)(lng + i * 256 + lane * 4);
      const float4 b = *(const float4*)(lnb + i * 256 + lane * 4);
      lg[i * 4] = g.x; lg[i * 4 + 1] = g.y; lg[i * 4 + 2] = g.z; lg[i * 4 + 3] = g.w;
      lb[i * 4] = b.x; lb[i * 4 + 1] = b.y; lb[i * 4 + 2] = b.z; lb[i * 4 + 3] = b.w;
    }
  }
  const bool write_x = (mode == 2 && l == 1);
  float* stats = (float*)(p.ws + WS_STAT);
  auto process = [&](int row, float (&v)[16], const float (&msh)[16], const float (&msc)[16]) {
    float* xr = p.out + (size_t)row * 1024;
    if (first) {
      float s = 0.f;
#pragma unroll
      for (int i = 0; i < 16; ++i) s += v[i];
      const float mean = wave_sum(s, lane) * (1.f / 1024.f);
      float q = 0.f;
#pragma unroll
      for (int i = 0; i < 16; ++i) { v[i] -= mean; q += v[i] * v[i]; }
      const float rstd = rsqrtf(wave_sum(q, lane) * (1.f / 1024.f) + LN_EPS);
#pragma unroll
      for (int i = 0; i < 4; ++i) {
#pragma unroll
        for (int e = 0; e < 4; ++e) v[i * 4 + e] = v[i * 4 + e] * rstd * lg[i * 4 + e] + lb[i * 4 + e];
        if (write_x) *(float4*)(xr + i * 256 + lane * 4) = make_float4(v[i * 4 + 0], v[i * 4 + 1], v[i * 4 + 2], v[i * 4 + 3]);
      }
      if (!write_x && lane == 0) *(float2*)(stats + (size_t)row * 2) = make_float2(mean, rstd);
    }
    if (second) {
      float s = 0.f;
#pragma unroll
      for (int i = 0; i < 16; ++i) s += v[i];
      const float mean = wave_sum(s, lane) * (1.f / 1024.f);
      float q = 0.f;
#pragma unroll
      for (int i = 0; i < 16; ++i) { v[i] -= mean; q += v[i] * v[i]; }
      const float rstd = rsqrtf(wave_sum(q, lane) * (1.f / 1024.f) + LN_EPS);
#pragma unroll
      for (int i = 0; i < 4; ++i) {
#pragma unroll
        for (int e = 0; e < 4; ++e) v[i * 4 + e] = v[i * 4 + e] * rstd * msc[i * 4 + e] + msh[i * 4 + e];
        uint2 o; o.x = pack2(v[i * 4 + 0], v[i * 4 + 1]); o.y = pack2(v[i * 4 + 2], v[i * 4 + 3]);
        *(uint2*)(H + (size_t)row * 1024 + i * 256 + lane * 4) = o;
      }
      if (gates) {
        float g8[8];
#pragma unroll
        for (int j = 0; j < 8; ++j) {
          float s2 = 0.f;
#pragma unroll
          for (int i = 0; i < 4; ++i) {
            const float4 wv = *(const float4*)(wl + j * 1024 + i * 256 + lane * 4);
            s2 += v[i * 4] * wv.x + v[i * 4 + 1] * wv.y + v[i * 4 + 2] * wv.z + v[i * 4 + 3] * wv.w;
          }
          g8[j] = wave_sum(s2, lane) + bif[j];
        }
        if (lane == 0) {
          *(float4*)(gout + (size_t)row * 8) = make_float4(g8[0], g8[1], g8[2], g8[3]);
          *(float4*)(gout + (size_t)row * 8 + 4) = make_float4(g8[4], g8[5], g8[6], g8[7]);
        }
      }
    }
  };
  auto load_mod = [&](int row, float (&msh)[16], float (&msc)[16]) {
    const float* mb = mod + ((size_t)lm * 40 + batch_of_row(row)) * 6144;
#pragma unroll
    for (int i = 0; i < 4; ++i) {
      const float4 sh = *(const float4*)(mb + shi * 1024 + i * 256 + lane * 4);
      const float4 sc = *(const float4*)(mb + (shi + 1) * 1024 + i * 256 + lane * 4);
      msh[i * 4] = sh.x; msh[i * 4 + 1] = sh.y; msh[i * 4 + 2] = sh.z; msh[i * 4 + 3] = sh.w;
      msc[i * 4] = 1.f + sc.x; msc[i * 4 + 1] = 1.f + sc.y; msc[i * 4 + 2] = 1.f + sc.z; msc[i * 4 + 3] = 1.f + sc.w;
    }
  };
  for (int chunk = blockIdx.x * 8 + w; chunk < TOKP / 32; chunk += gridDim.x * 8) {
    const int row0 = chunk * 32;
    float msh[16], msc[16];
    if (second) load_mod(row0, msh, msc);
    const float* src0 = (mode == 0) ? p.in[0] + (size_t)row0 * 1024 : p.out + (size_t)row0 * 1024;
    float4 nx0 = *(const float4*)(src0 + lane * 4), nx1 = *(const float4*)(src0 + 256 + lane * 4);
    float4 nx2 = *(const float4*)(src0 + 512 + lane * 4), nx3 = *(const float4*)(src0 + 768 + lane * 4);
    for (int ri = 0; ri < 32; ++ri) {
      float v[16];
      v[0] = nx0.x; v[1] = nx0.y; v[2] = nx0.z; v[3] = nx0.w; v[4] = nx1.x; v[5] = nx1.y; v[6] = nx1.z; v[7] = nx1.w;
      v[8] = nx2.x; v[9] = nx2.y; v[10] = nx2.z; v[11] = nx2.w; v[12] = nx3.x; v[13] = nx3.y; v[14] = nx3.z; v[15] = nx3.w;
      {
        const float* sn = src0 + (size_t)(ri < 31 ? ri + 1 : 31) * 1024;
        nx0 = *(const float4*)(sn + lane * 4); nx1 = *(const float4*)(sn + 256 + lane * 4);
        nx2 = *(const float4*)(sn + 512 + lane * 4); nx3 = *(const float4*)(sn + 768 + lane * 4);
      }
      __builtin_amdgcn_sched_barrier(0);
      process(row0 + ri, v, msh, msc);
    }
  }
  if (w == 0) {
    for (int row = TOKP + blockIdx.x; row < TOK; row += gridDim.x) {
      float msh[16], msc[16];
      if (second) load_mod(row, msh, msc);
      const float* src = (mode == 0) ? p.in[1] + (size_t)(row - TOKP) * 1024 : p.out + (size_t)row * 1024;
      float v[16];
#pragma unroll
      for (int i = 0; i < 4; ++i) {
        const float4 t = *(const float4*)(src + i * 256 + lane * 4);
        v[i * 4 + 0] = t.x; v[i * 4 + 1] = t.y; v[i * 4 + 2] = t.z; v[i * 4 + 3] = t.w;
      }
      process(row, v, msh, msc);
    }
  }
}


DI void micro_partial(f32x16& acc, const u16* A, int lda, const u16* Wt, int ldw, int K, int row0, int n0, int w, int r, int h) {
  const int kb = w * (K >> 3), n16 = K >> 7;
  const u16* ap = A + (size_t)(row0 + r) * lda + kb + h * 8;
  const u16* bp = Wt + (size_t)(n0 + r) * ldw + kb + h * 8;
#pragma unroll 4
  for (int k = 0; k < n16; ++k) {
    const bf16x8 a = *(const bf16x8*)(ap + k * 16);
    const bf16x8 b = *(const bf16x8*)(bp + k * 16);
    acc = MFMA(a, b, acc);
  }
}
DI void micro_reduce_store(const f32x16& acc, float* red, int w, int lane) {
#pragma unroll
  for (int i = 0; i < 16; ++i) red[(w * 16 + i) * 64 + lane] = acc[i];
}
DI float micro_sum(const float* red, int i, int lane) {
  float s = 0.f;
#pragma unroll
  for (int q = 0; q < 8; ++q) s += red[(q * 16 + i) * 64 + lane];
  return s;
}

constexpr int EP_LD = 264;
constexpr int EP_LDT = 68;
DI void zero_acc(f32x16 (&acc)[4][2]) {
#pragma unroll
  for (int a = 0; a < 4; ++a)
#pragma unroll
    for (int b = 0; b < 2; ++b) zero16(acc[a][b]);
}
DI void stage_rm(const f32x16& a0, const f32x16& a1, float* stg, int wm, int wn, int r, int h) {
#pragma unroll
  for (int i = 0; i < 16; ++i) *(float2*)(stg + (wm * 32 + crow(i, h)) * EP_LD + wn * 64 + 2 * r) = make_float2(a0[i], a1[i]);
}
DI void stage_tr(const f32x16& a0, const f32x16& a1, float* stg, int wm, int wn, int r, int h) {
#pragma unroll
  for (int g = 0; g < 4; ++g) {
    *(float4*)(stg + (wn * 64 + 2 * r) * EP_LDT + wm * 32 + 8 * g + 4 * h) = make_float4(a0[4 * g], a0[4 * g + 1], a0[4 * g + 2], a0[4 * g + 3]);
    *(float4*)(stg + (wn * 64 + 2 * r + 1) * EP_LDT + wm * 32 + 8 * g + 4 * h) = make_float4(a1[4 * g], a1[4 * g + 1], a1[4 * g + 2], a1[4 * g + 3]);
  }
}
DI int grow_of(int m0, int mi, int lr) { return m0 + (lr >> 5) * 128 + mi * 32 + (lr & 31); }
DI uint4 pack8f(const float4& a, const float4& b) {
  uint4 o; o.x = pack2(a.x, a.y); o.y = pack2(a.z, a.w); o.z = pack2(b.x, b.y); o.w = pack2(b.z, b.w); return o;
}

DI void write_tr(const Params& p, int l, int m0, int mi, const float* stg, int tid, int which, int chbase) {
  const bool prompt = m0 < TOKP;
#pragma unroll 1
  for (int q = 0; q < 4; ++q) {
    const int cid = q * NTHR + tid, ch = cid >> 3, tc = cid & 7;
    const float4 v0 = *(const float4*)(stg + ch * EP_LDT + tc * 8);
    const float4 v1 = *(const float4*)(stg + ch * EP_LDT + tc * 8 + 4);
    const int row0 = grow_of(m0, mi, tc * 8);
    const int chg = chbase + ch;
    u16* d;
    if (prompt) {
      const int b = row0 >> 11, t = row0 & 2047;
      if (which == 0) d = (u16*)(p.ws + WS_VTP) + ((size_t)b * 512 + chg) * 2048 + t;
      else if (which == 1) d = (u16*)(p.ws + WS_MQKT_P) + ((size_t)b * 1024 + chg) * 2048 + t;
      else d = (u16*)(p.ws + WS_MVT_P) + ((size_t)b * 512 + chg) * 2048 + t;
    } else {
      const int rs = row0 - TOKP, bs = rs >> 5, t = rs & 31;
      if (which == 0) d = (u16*)(p.ws + WS_VTS) + ((size_t)(l * 8 + bs) * 512 + chg) * 1056 + 1024 + t;
      else if (which == 1) d = (u16*)(p.ws + WS_MQKT_S) + ((size_t)bs * 1024 + chg) * 32 + t;
      else d = (u16*)(p.ws + WS_MVT_S) + ((size_t)bs * 512 + chg) * 32 + t;
    }
    *(uint4*)d = pack8f(v0, v1);
  }
}


template <class F>
DI void epi_rowmajor_bf16(f32x16 (&acc)[4][2], unsigned char* smem, int m0, u16* dst, int ldd, int dcol0, F xf) {
  const int tid = otid(), lane = tid & 63, w = tid >> 6;
  const int wm = w >> 2, wn = w & 3, r = lane & 31, h = lane >> 5;
  unsigned* stg = (unsigned*)(smem + GS_BASE + GS_STAGE);
#pragma unroll
  for (int ps = 0; ps < 2; ++ps) {
    __syncthreads();
#pragma unroll
    for (int q = 0; q < 2; ++q) {
      const int mi = 2 * ps + q;
#pragma unroll
      for (int i = 0; i < 16; ++i) {
        float a = acc[mi][0][i], b = acc[mi][1][i];
        xf(a, b);
        stg[(q * 64 + wm * 32 + crow(i, h)) * 132 + wn * 32 + r] = pack2(a, b);
      }
    }
    __syncthreads();
#pragma unroll
    for (int q = 0; q < 8; ++q) {
      const int cid = q * NTHR + tid, lr = cid >> 5, c = cid & 31;
      const uint4 v = *(const uint4*)(stg + lr * 132 + c * 4);
      const int row = m0 + ((lr >> 5) & 1) * 128 + (2 * ps + (lr >> 6)) * 32 + (lr & 31);
      *(uint4*)(dst + (size_t)row * ldd + dcol0 + c * 8) = v;
    }
  }
  __syncthreads();
}

DI void epi_in(const Params& p, int l, int m0, int n0, f32x16 (&acc)[4][2], unsigned char* smem) {
  const int tid = otid(), lane = tid & 63, w = tid >> 6;
  const int wm = w >> 2, wn = w & 3, r = lane & 31, h = lane >> 5;
  const bool prompt = m0 < TOKP;
  float* stg = (float*)(smem + GS_BASE + GS_STAGE);
  const int seg = n0 < 512 ? 0 : (n0 < 1024 ? 1 : (n0 < 1536 ? 2 : (n0 < 2560 ? 3 : (n0 < 3072 ? 4 : 5))));
  if (seg == 0) { epi_rowmajor_bf16(acc, smem, m0, (u16*)(p.ws + WS_ZQ), 512, n0, [](float&, float&) {}); return; }
  if (seg == 5) { epi_rowmajor_bf16(acc, smem, m0, (u16*)(p.ws + WS_MO), 512, n0 - 3072, [](float& a, float& b) { a = sigmoidf_(a); b = sigmoidf_(b); }); return; }
  if (seg == 3) {
    const int ch = n0 - 1536 + wn * 64 + 2 * r;
#pragma unroll
    for (int mi = 0; mi < 4; ++mi) {
      const int rb = m0 + wm * 128 + mi * 32 + 4 * h;
#pragma unroll
      for (int i = 0; i < 16; ++i) {
        const int row = rb + (i & 3) + 8 * (i >> 2);
        if (prompt) {
          const int tt = row & 2047;
          if (tt >= 2045) *(float2*)(p.out + O_CVP + ((size_t)(l * 32 + (row >> 11)) * 3 + (tt - 2045)) * 1024 + ch) = make_float2(acc[mi][0][i], acc[mi][1][i]);
        } else {
          const int rs = row - TOKP, tt = rs & 31;
          if (tt >= 29) *(float2*)(p.out + O_CVS + ((size_t)(l * 8 + (rs >> 5)) * 3 + (tt - 29)) * 1024 + ch) = make_float2(acc[mi][0][i], acc[mi][1][i]);
        }
      }
    }
  }
#pragma unroll
  for (int mi = 0; mi < 4; ++mi) {
    if (seg == 0 || seg == 1 || seg == 2 || seg == 5) {
      __syncthreads();
      stage_rm(acc[mi][0], acc[mi][1], stg, wm, wn, r, h);
      __syncthreads();
#pragma unroll 1
      for (int q = 0; q < 4; ++q) {
        const int cid = q * NTHR + tid, lr = cid >> 5, c8 = (cid & 31) * 8;
        const float4 v0 = *(const float4*)(stg + lr * EP_LD + c8);
        const float4 v1 = *(const float4*)(stg + lr * EP_LD + c8 + 4);
        const int row = grow_of(m0, mi, lr);
        const int n = n0 + c8;
        if (seg == 0) {
          *(uint4*)((u16*)(p.ws + WS_ZQ) + (size_t)row * 512 + n) = pack8f(v0, v1);
        } else if (seg == 5) {
          const float4 s0 = make_float4(sigmoidf_(v0.x), sigmoidf_(v0.y), sigmoidf_(v0.z), sigmoidf_(v0.w));
          const float4 s1 = make_float4(sigmoidf_(v1.x), sigmoidf_(v1.y), sigmoidf_(v1.z), sigmoidf_(v1.w));
          *(uint4*)((u16*)(p.ws + WS_MO) + (size_t)row * 512 + (n - 3072)) = pack8f(s0, s1);
        } else {
          const bool isk = seg == 1;
          const int nn = n - (isk ? 512 : 1024);
          float* of = p.out + (isk ? (prompt ? O_KP : O_KSM) : (prompt ? O_VP : O_VSM));
          const size_t orow = prompt ? ((size_t)l * TOKP + row) : ((size_t)l * TOKS + (row - TOKP));
          *(float4*)(of + orow * 512 + nn) = v0;
          *(float4*)(of + orow * 512 + nn + 4) = v1;
          if (isk) {
            u16* kd;
            if (prompt) kd = (u16*)(p.ws + WS_KB) + (size_t)row * 512 + nn;
            else { const int rs = row - TOKP; kd = (u16*)(p.ws + WS_KS) + ((size_t)(l * 8 + (rs >> 5)) * 1056 + 1024 + (rs & 31)) * 512 + nn; }
            *(uint4*)kd = pack8f(v0, v1);
          }
        }
      }
    }
    if (seg == 2 || seg == 3 || seg == 4) {
      __syncthreads();
      stage_tr(acc[mi][0], acc[mi][1], stg, wm, wn, r, h);
      __syncthreads();
      write_tr(p, l, m0, mi, stg, tid, seg == 2 ? 0 : (seg == 3 ? 1 : 2), n0 - (seg == 2 ? 1024 : (seg == 3 ? 1536 : 2560)));
    }
  }
  __syncthreads();
}

DI void phase_in_gate(const Params& p, int l, unsigned char* smem) {
  const int tid = otid(), lane = tid & 63, w = tid >> 6;
  const int wm = w >> 2, wn = w & 3, r = lane & 31, h = lane >> 5;
  const u16* H = (const u16*)(p.ws + WS_H);
  const u16* Win = (const u16*)(p.ws + WS_WT_IN) + (size_t)l * 3584 * 1024;
  const u16* Wg = (const u16*)(p.ws + WS_WT_GATE) + (size_t)l * 2048 * 1024;
  float* stg = (float*)(smem + GS_BASE + GS_STAGE);
  const int NT = 14 + 8, MT = 257;
  auto ptrs = [&](int it, const u16*& ap, const u16*& bp) -> bool {
    int mt, nt;
    if (!tile_of(it, MT, NT, mt, nt)) return false;
    ap = H + (size_t)(mt * 256) * 1024;
    bp = (nt < 14 ? Win + (size_t)(nt * 256) * 1024 : Wg + (size_t)((nt - 14) * 256) * 1024);
    return true;
  };
  auto epi = [&](int it, f32x16 (&acc)[4][2]) {
    const int tid = otid(), lane = tid & 63, w = tid >> 6;
    const int wm = w >> 2, wn = w & 3, r = lane & 31, h = lane >> 5;
    int mt, nt;
    tile_of(it, MT, NT, mt, nt);
    const int m0 = mt * 256;
    if (nt < 14) {
      epi_in(p, l, m0, nt * 256, acc, smem);
    } else {
      const int n0 = (nt - 14) * 256;
      const float2 bg = *(const float2*)(p.in[22] + l * 2048 + n0 + wn * 64 + 2 * r);
      epi_rowmajor_bf16(acc, smem, m0, (u16*)(p.ws + WS_G), 2048, n0, [&](float& a, float& b) { a = sigmoidf_(a + bg.x); b = sigmoidf_(b + bg.y); });
    }
  };
  gemm_stream(1024, 1024, 1024, smem, ptrs, epi);
}

DI void phase_mix(const Params& p, int l, unsigned char* smem) {
  const int tid = otid(), lane = tid & 63, w = tid >> 6;
  const int wm = w >> 2, wn = w & 3, r = lane & 31, h = lane >> 5;
  const u16* G = (const u16*)(p.ws + WS_G);
  u16* MIX = (u16*)(p.ws + WS_MIX);
  float* stg = (float*)(smem + GS_BASE + GS_STAGE);
  const int NT = 4, MT = 256;
  auto ptrs = [&](int it, const u16*& ap, const u16*& bp) -> bool {
    int mt, nt;
    if (!tile_of(it >> 1, MT, NT, mt, nt)) return false;
    const int half = it & 1;
    ap = (const u16*)(p.ws + (half ? WS_MN : WS_AN)) + (size_t)(mt * 256) * 512;
    bp = (const u16*)(p.ws + (half ? WS_WT_BRB : WS_WT_BRA)) + (size_t)l * 1024 * 512 + (size_t)(nt * 256) * 512;
    return true;
  };
  auto epi = [&](int it, f32x16 (&acc)[4][2]) {
    const int tid = otid(), lane = tid & 63, w = tid >> 6;
    const int wm = w >> 2, wn = w & 3, r = lane & 31, h = lane >> 5;
    int mt, nt;
    tile_of(it >> 1, MT, NT, mt, nt);
    const int half = it & 1;
    const int m0 = mt * 256, n0 = nt * 256;
#pragma unroll
    for (int mi = 0; mi < 4; ++mi) {
      __syncthreads();
      stage_rm(acc[mi][0], acc[mi][1], stg, wm, wn, r, h);
      __syncthreads();
#pragma unroll 1
      for (int q = 0; q < 4; ++q) {
        const int cid = q * NTHR + tid, lr = cid >> 5, c8 = (cid & 31) * 8;
        const float4 v0 = *(const float4*)(stg + lr * EP_LD + c8);
        const float4 v1 = *(const float4*)(stg + lr * EP_LD + c8 + 4);
        const int row = grow_of(m0, mi, lr), n = n0 + c8;
        const uint4 g = *(const uint4*)(G + (size_t)row * 2048 + half * 1024 + n);
        float4 o0 = make_float4(bflo(g.x) * v0.x, bfhi(g.x) * v0.y, bflo(g.y) * v0.z, bfhi(g.y) * v0.w);
        float4 o1 = make_float4(bflo(g.z) * v1.x, bfhi(g.z) * v1.y, bflo(g.w) * v1.z, bfhi(g.w) * v1.w);
        uint4* mp = (uint4*)(MIX + (size_t)row * 1024 + n);
        if (half) {
          const uint4 pr = *mp;
          o0.x += bflo(pr.x); o0.y += bfhi(pr.x); o0.z += bflo(pr.y); o0.w += bfhi(pr.y);
          o1.x += bflo(pr.z); o1.y += bfhi(pr.z); o1.z += bflo(pr.w); o1.w += bfhi(pr.w);
        }
        *mp = pack8f(o0, o1);
      }
    }
    __syncthreads();
  };
  gemm_stream(512, 512, 512, smem, ptrs, epi);
  {
    const int tid2 = otid(), lane = tid2 & 63, w = tid2 >> 6, r = lane & 31, h = lane >> 5;
    float* red = (float*)(smem + 64);
    for (int mtile = blockIdx.x; mtile < 256; mtile += gridDim.x) {
      const int row0 = TOKP + (mtile >> 5) * 32, n0 = (mtile & 31) * 32;
      f32x16 pa, pb;
      zero16(pa); zero16(pb);
      micro_partial(pa, (const u16*)(p.ws + WS_AN), 512, (const u16*)(p.ws + WS_WT_BRA) + (size_t)l * 1024 * 512, 512, 512, row0, n0, w, r, h);
      micro_partial(pb, (const u16*)(p.ws + WS_MN), 512, (const u16*)(p.ws + WS_WT_BRB) + (size_t)l * 1024 * 512, 512, 512, row0, n0, w, r, h);
      __syncthreads();
      micro_reduce_store(pa, red, w, lane);
      micro_reduce_store(pb, red + 8192, w, lane);
      __syncthreads();
#pragma unroll
      for (int q = 0; q < 2; ++q) {
        const int i = w + 8 * q;
        const float sa = micro_sum(red, i, lane), sb = micro_sum(red + 8192, i, lane);
        const int row = row0 + crow(i, h), n = n0 + r;
        const float ga = bf2f(G[(size_t)row * 2048 + n]), gb = bf2f(G[(size_t)row * 2048 + 1024 + n]);
        MIX[(size_t)row * 1024 + n] = f2bf(ga * sa + gb * sb);
      }
    }
    __syncthreads();
  }
}

DI void phase_res(const Params& p, int l, int mode, unsigned char* smem) {
  const int tid = otid(), lane = tid & 63, w = tid >> 6;
  const int wm = w >> 2, wn = w & 3, r = lane & 31, h = lane >> 5;
  const float* mod = (const float*)(p.ws + WS_MOD);
  float* stg = (float*)(smem + GS_BASE + GS_STAGE);
  const int NT = 4, MT = 256;
  const int K = (mode == 0) ? 1024 : 2816;
  const u16* Ab = (const u16*)(p.ws + (mode == 0 ? WS_MIX : WS_ACT));
  const u16* Wb = (mode == 0) ? (const u16*)(p.ws + WS_WT_O) + (size_t)l * 1024 * 1024 : (const u16*)(p.ws + WS_WT_DOWN) + (size_t)l * 1024 * 2816;
  const int gi = (mode == 0) ? 2 : 5;
  const float* stats = (const float*)(p.ws + WS_STAT);
  const float* rlg = (mode == 1) ? p.in[24] + l * 1024 : p.in[28] + (l > 0 ? l - 1 : 0) * 1024;
  const float* rlb = (mode == 1) ? p.in[25] + l * 1024 : p.in[29] + (l > 0 ? l - 1 : 0) * 1024;
  auto ptrs = [&](int it, const u16*& ap, const u16*& bp) -> bool {
    int mt, nt;
    if (!tile_of(it, MT, NT, mt, nt)) return false;
    ap = Ab + (size_t)(mt * 256) * K;
    bp = Wb + (size_t)(nt * 256) * K;
    return true;
  };
  auto epi = [&](int it, f32x16 (&acc)[4][2]) {
    const int tid = otid(), lane = tid & 63, w = tid >> 6;
    const int wm = w >> 2, wn = w & 3, r = lane & 31, h = lane >> 5;
    int mt, nt;
    tile_of(it, MT, NT, mt, nt);
    const int m0 = mt * 256, n0 = nt * 256;
#pragma unroll
    for (int mi = 0; mi < 4; ++mi) {
      __syncthreads();
      stage_rm(acc[mi][0], acc[mi][1], stg, wm, wn, r, h);
      __syncthreads();
#pragma unroll 1
      for (int q = 0; q < 8; ++q) {
        const int cid = q * NTHR + tid, lr = cid >> 6, c4 = (cid & 63) * 4;
        const float4 v = *(const float4*)(stg + lr * EP_LD + c4);
        const int row = grow_of(m0, mi, lr), n = n0 + c4;
        const int b = batch_of_row(row);
        const float4 gg = *(const float4*)(mod + ((size_t)l * 40 + b) * 6144 + gi * 1024 + n);
        float* xr = p.out + (size_t)row * 1024 + n;
        const float* xs = (mode == 0 && l == 0) ? (row < TOKP ? p.in[0] + (size_t)row * 1024 + n : p.in[1] + (size_t)(row - TOKP) * 1024 + n) : xr;
        float4 xv = *(const float4*)xs;
        if (!(mode == 0 && l == 0)) {
          const float2 st = *(const float2*)(stats + (size_t)row * 2);
          const float4 g4 = *(const float4*)(rlg + n), b4 = *(const float4*)(rlb + n);
          xv.x = (xv.x - st.x) * st.y * g4.x + b4.x; xv.y = (xv.y - st.x) * st.y * g4.y + b4.y;
          xv.z = (xv.z - st.x) * st.y * g4.z + b4.z; xv.w = (xv.w - st.x) * st.y * g4.w + b4.w;
        }
        *(float4*)xr = make_float4(ALPHA * xv.x + (1.f + gg.x) * v.x, ALPHA * xv.y + (1.f + gg.y) * v.y,
                                   ALPHA * xv.z + (1.f + gg.z) * v.z, ALPHA * xv.w + (1.f + gg.w) * v.w);
      }
    }
    __syncthreads();
  };
  gemm_stream(K, K, K, smem, ptrs, epi);
  {
    const int tid2 = otid(), lane = tid2 & 63, w = tid2 >> 6, r = lane & 31, h = lane >> 5;
    float* red = (float*)(smem + 64);
    for (int mtile = blockIdx.x; mtile < 256; mtile += gridDim.x) {
      const int row0 = TOKP + (mtile >> 5) * 32, n0 = (mtile & 31) * 32;
      f32x16 pa;
      zero16(pa);
      micro_partial(pa, Ab, K, Wb, K, K, row0, n0, w, r, h);
      __syncthreads();
      micro_reduce_store(pa, red, w, lane);
      __syncthreads();
#pragma unroll
      for (int q = 0; q < 2; ++q) {
        const int i = w + 8 * q;
        const float sa = micro_sum(red, i, lane);
        const int row = row0 + crow(i, h), n = n0 + r;
        const float gg = mod[((size_t)l * 40 + batch_of_row(row)) * 6144 + gi * 1024 + n];
        float* xr = p.out + (size_t)row * 1024 + n;
        float xv = (mode == 0 && l == 0) ? p.in[1][(size_t)(row - TOKP) * 1024 + n] : *xr;
        if (!(mode == 0 && l == 0)) {
          const float2 st = *(const float2*)(stats + (size_t)row * 2);
          xv = (xv - st.x) * st.y * rlg[n] + rlb[n];
        }
        *xr = ALPHA * xv + (1.f + gg) * sa;
      }
    }
    __syncthreads();
  }
}

DI void phase_gu(const Params& p, int l, unsigned char* smem) {
  const int tid = otid(), lane = tid & 63, w = tid >> 6;
  const int wm = w >> 2, wn = w & 3, r = lane & 31, h = lane >> 5;
  u16* ACT = (u16*)(p.ws + WS_ACT);
  const u16* Hh = (const u16*)(p.ws + WS_H);
  const u16* Wb = (const u16*)(p.ws + WS_WT_GU) + (size_t)l * 5632 * 1024;
  float* stg = (float*)(smem + GS_BASE + GS_STAGE);
  const int NT = 22, MT = 257;
  auto ptrs = [&](int it, const u16*& ap, const u16*& bp) -> bool {
    int mt, nt;
    if (!tile_of(it, MT, NT, mt, nt)) return false;
    ap = Hh + (size_t)(mt * 256) * 1024;
    bp = Wb + (size_t)(nt * 256) * 1024;
    return true;
  };
  auto epi = [&](int it, f32x16 (&acc)[4][2]) {
    const int tid = otid(), lane = tid & 63, w = tid >> 6;
    const int wm = w >> 2, wn = w & 3, r = lane & 31, h = lane >> 5;
    int mt, nt;
    tile_of(it, MT, NT, mt, nt);
    const int m0 = mt * 256, n0 = nt * 256;
#pragma unroll
    for (int ps = 0; ps < 2; ++ps) {
      __syncthreads();
#pragma unroll
      for (int q = 0; q < 2; ++q) {
        const int mi = 2 * ps + q;
#pragma unroll
        for (int i = 0; i < 16; ++i)
          stg[(q * 64 + wm * 32 + crow(i, h)) * 132 + wn * 32 + r] = siluf_(acc[mi][0][i]) * acc[mi][1][i];
      }
      __syncthreads();
#pragma unroll
      for (int q = 0; q < 4; ++q) {
        const int cid = q * NTHR + tid, lr = cid >> 4, c8 = (cid & 15) * 8;
        const float4 v0 = *(const float4*)(stg + lr * 132 + c8);
        const float4 v1 = *(const float4*)(stg + lr * 132 + c8 + 4);
        const int row = m0 + ((lr >> 5) & 1) * 128 + (2 * ps + (lr >> 6)) * 32 + (lr & 31);
        *(uint4*)(ACT + (size_t)row * 2816 + (n0 >> 1) + c8) = pack8f(v0, v1);
      }
    }
    __syncthreads();
  };
  gemm_stream(1024, 1024, 1024, smem, ptrs, epi);
}

constexpr int AT_BASE = 64;
constexpr int AT_KBYTES = 64 * 272;
constexpr int AT_VBYTES = 128 * 136;
constexpr int AT_STAGE = AT_KBYTES + AT_VBYTES;

DI void attn_item(const Params& p, int l, int b, int head, int qt, float lam, float lam_init, unsigned char* smem) {
  const int tid = otid(), lane = tid & 63, w = tid >> 6, r = lane & 31, h = lane >> 5;
  const int comp = w & 1, rg = w >> 1;
  const bool prompt = b < 32;
  const int bs = b - 32;
  const u16* Kg = prompt ? (const u16*)(p.ws + WS_KB) + (size_t)b * 2048 * 512 : (const u16*)(p.ws + WS_KS) + (size_t)(l * 8 + bs) * 1056 * 512;
  const u16* Vg = prompt ? (const u16*)(p.ws + WS_VTP) + (size_t)b * 512 * 2048 : (const u16*)(p.ws + WS_VTS) + (size_t)(l * 8 + bs) * 512 * 1056;
  const int ldT = prompt ? 2048 : 1056;
  const int nkt = prompt ? 2 * qt + 2 : 17;
  const int nkeys = prompt ? 2048 : 1056;
  const int qtok0 = prompt ? b * 2048 + qt * 128 : TOKP + bs * 32;
  const int qpos0 = prompt ? qt * 128 : 1024;
  const bool active = prompt || rg == 0;
  const int my_nkt = prompt ? (rg < 2 ? nkt - 1 : nkt) : nkt;
  const u16* ZQ = (const u16*)(p.ws + WS_ZQ);
  bf16x8 qf[4];
  {
    const int qrow = active ? qtok0 + rg * 32 + r : qtok0;
#pragma unroll
    for (int ks = 0; ks < 4; ++ks) {
      const uint4 qq = *(const uint4*)(ZQ + (size_t)qrow * 512 + head * 128 + comp * 64 + ks * 16 + h * 8);
      const float cq = 0.125f * LOG2E;
      uint4 qs_;
      qs_.x = pack2(bflo(qq.x) * cq, bfhi(qq.x) * cq); qs_.y = pack2(bflo(qq.y) * cq, bfhi(qq.y) * cq);
      qs_.z = pack2(bflo(qq.z) * cq, bfhi(qq.z) * cq); qs_.w = pack2(bflo(qq.w) * cq, bfhi(qq.w) * cq);
      qf[ks] = __builtin_bit_cast(bf16x8, qs_);
    }
  }
  const float slope2 = exp2f(-2.f * (head + 1)) * LOG2E;
  const float c1 = 0.125f * LOG2E;
  const int qpos = qpos0 + rg * 32 + r;
  f32x16 O[4];
#pragma unroll
  for (int i = 0; i < 4; ++i) zero16(O[i]);
  float m_run = -INFINITY, l_run = 0.f;

  const int krow = tid >> 4, kcc = tid & 15;
  const int vrow = tid >> 3, vcc = tid & 7;
  const u16* kp = Kg + (size_t)((nkt - 1) * 64 + krow) * 512 + head * 128 + kcc * 8;
  const u16* vp = Vg + (size_t)(head * 128 + vrow) * ldT + (nkt - 1) * 64 + vcc * 8;
  uint4 rk0, rk1, rv0, rv1;
  unsigned char* sb = smem + AT_BASE;
  rk0 = *(const uint4*)kp; rk1 = *(const uint4*)(kp + 32 * 512);
  rv0 = *(const uint4*)vp; rv1 = *(const uint4*)(vp + (size_t)64 * ldT);
  {
    *(uint4*)(sb + krow * 272 + kcc * 16) = rk0;
    *(uint4*)(sb + (krow + 32) * 272 + kcc * 16) = rk1;
    *(uint2*)(sb + AT_KBYTES + vrow * 136 + vcc * 16) = make_uint2(rv0.x, rv0.y);
    *(uint2*)(sb + AT_KBYTES + vrow * 136 + vcc * 16 + 8) = make_uint2(rv0.z, rv0.w);
    *(uint2*)(sb + AT_KBYTES + (vrow + 64) * 136 + vcc * 16) = make_uint2(rv1.x, rv1.y);
    *(uint2*)(sb + AT_KBYTES + (vrow + 64) * 136 + vcc * 16 + 8) = make_uint2(rv1.z, rv1.w);
  }
  __syncthreads();
  for (int j = 0; j < nkt; ++j) {
    const int kt = nkt - 1 - j;
    const bool more = j + 1 < nkt;
    if (more) {
      kp -= 64 * 512; vp -= 64;
      rk0 = *(const uint4*)kp; rk1 = *(const uint4*)(kp + 32 * 512);
      rv0 = *(const uint4*)vp; rv1 = *(const uint4*)(vp + (size_t)64 * ldT);
    }
    if (active && kt < my_nkt) {
      const unsigned char* Kt = sb + (j & 1) * AT_STAGE;
      const unsigned char* Vt = Kt + AT_KBYTES;
      f32x16 s[2];
      const bool past = (kt * 64 + 63) < (qpos0 + rg * 32);
      if (past) {
        const float kb0 = slope2 * (float)(kt * 64 + 4 * h);
#pragma unroll
        for (int sub = 0; sub < 2; ++sub)
#pragma unroll
          for (int i = 0; i < 16; ++i) s[sub][i] = __builtin_fmaf(slope2, (float)(sub * 32 + (i & 3) + 8 * (i >> 2)), kb0);
      } else {
        zero16(s[0]); zero16(s[1]);
      }
#pragma unroll
      for (int ks = 0; ks < 4; ++ks) {
#pragma unroll
        for (int sub = 0; sub < 2; ++sub) {
          const bf16x8 kf = *(const bf16x8*)(Kt + (sub * 32 + r) * 272 + (comp * 64 + ks * 16 + h * 8) * 2);
          s[sub] = MFMA(kf, qf[ks], s[sub]);
        }
      }
      float mx = -INFINITY;
      if (!past) {
        const float qk0 = (float)(qpos - kt * 64 - 4 * h);
        const float qb = slope2 * (float)qpos;
#pragma unroll
        for (int sub = 0; sub < 2; ++sub)
#pragma unroll
          for (int i = 0; i < 16; ++i) {
            const float d = qk0 - (float)(sub * 32 + (i & 3) + 8 * (i >> 2));
            s[sub][i] = s[sub][i] - slope2 * fabsf(d) + qb;
          }
      }
      if (!prompt) {
#pragma unroll
        for (int sub = 0; sub < 2; ++sub)
#pragma unroll
          for (int i = 0; i < 16; ++i) {
            const int key = kt * 64 + sub * 32 + crow(i, h);
            if (key >= nkeys) s[sub][i] = -INFINITY;
          }
      }
#pragma unroll
      for (int sub = 0; sub < 2; ++sub)
#pragma unroll
        for (int i = 0; i < 16; ++i) mx = fmaxf(mx, s[sub][i]);
      mx = fmaxf(mx, shx(mx, 32, lane));
      const bool livelane = !(mx - m_run < -150.f);
      if (__ballot(livelane) != 0ull) {
        const float m_new = fmaxf(m_run, mx);
        const float alpha = fexp2(m_run - m_new);
        m_run = m_new;
        float lsum = 0.f;
#pragma unroll
        for (int sub = 0; sub < 2; ++sub)
#pragma unroll
          for (int i = 0; i < 16; ++i) {
            const float pv = fexp2(s[sub][i] - m_new);
            lsum += pv;
            s[sub][i] = pv;
          }
        l_run = l_run * alpha + lsum;
        if (__ballot(alpha != 1.f) != 0ull) {
#pragma unroll
          for (int dt = 0; dt < 4; ++dt)
#pragma unroll
            for (int i = 0; i < 16; ++i) O[dt][i] *= alpha;
        }
#pragma unroll
        for (int sub = 0; sub < 2; ++sub)
#pragma unroll
          for (int s2 = 0; s2 < 2; ++s2) {
            const bf16x8 pf = pack8(s[sub], s2);
#pragma unroll
            for (int dt = 0; dt < 4; ++dt) {
              const unsigned char* va = Vt + (dt * 32 + r) * 136 + (sub * 32 + s2 * 16 + 4 * h) * 2;
              const uint2 lo = *(const uint2*)va;
              const uint2 hi = *(const uint2*)(va + 16);
              const uint4 vv = make_uint4(lo.x, lo.y, hi.x, hi.y);
              O[dt] = MFMA(__builtin_bit_cast(bf16x8, vv), pf, O[dt]);
            }
          }
      }
    }
    if (more) {
      unsigned char* sn = sb + ((j + 1) & 1) * AT_STAGE;
      *(uint4*)(sn + krow * 272 + kcc * 16) = rk0;
      *(uint4*)(sn + (krow + 32) * 272 + kcc * 16) = rk1;
      *(uint2*)(sn + AT_KBYTES + vrow * 136 + vcc * 16) = make_uint2(rv0.x, rv0.y);
      *(uint2*)(sn + AT_KBYTES + vrow * 136 + vcc * 16 + 8) = make_uint2(rv0.z, rv0.w);
      *(uint2*)(sn + AT_KBYTES + (vrow + 64) * 136 + vcc * 16) = make_uint2(rv1.x, rv1.y);
      *(uint2*)(sn + AT_KBYTES + (vrow + 64) * 136 + vcc * 16 + 8) = make_uint2(rv1.z, rv1.w);
    }
    __syncthreads();
  }
  float* exch = (float*)(smem + AT_BASE);
  float inv = 0.f;
  if (active) { const float lt = l_run + shx(l_run, 32, lane); inv = __builtin_amdgcn_rcpf(lt); }
  if (active && comp == 1) {
    const float sc = inv * lam;
#pragma unroll
    for (int dt = 0; dt < 4; ++dt)
#pragma unroll
      for (int i = 0; i < 16; ++i) exch[(rg * 64 + dt * 16 + i) * 64 + lane] = O[dt][i] * sc;
  }
  __syncthreads();
  if (active && comp == 0) {
    float ss = 0.f;
#pragma unroll
    for (int dt = 0; dt < 4; ++dt)
#pragma unroll
      for (int i = 0; i < 16; ++i) {
        const float o = O[dt][i] * inv - exch[(rg * 64 + dt * 16 + i) * 64 + lane];
        O[dt][i] = o;
        ss += o * o;
      }
    ss += shx(ss, 32, lane);
    const float rs = rsqrtf(ss * (1.f / 128.f) + LN_EPS) * (1.f - lam_init);
    u16* AN = (u16*)(p.ws + WS_AN) + (size_t)(qtok0 + rg * 32 + r) * 512 + head * 128;
    const float* gw = p.in[17] + l * 512 + head * 128;
#pragma unroll
    for (int dt = 0; dt < 4; ++dt)
#pragma unroll
      for (int g = 0; g < 4; ++g) {
        const int dv = dt * 32 + 8 * g + 4 * h;
        const float4 g4 = *(const float4*)(gw + dv);
        uint2 o;
        o.x = pack2(O[dt][4 * g] * rs * g4.x, O[dt][4 * g + 1] * rs * g4.y);
        o.y = pack2(O[dt][4 * g + 2] * rs * g4.z, O[dt][4 * g + 3] * rs * g4.w);
        *(uint2*)(AN + dv) = o;
      }
  }
}

constexpr int ML_QS = 64;
constexpr int ML_KS = ML_QS + 64 * 272;
constexpr int ML_KT = ML_KS + 64 * 272;
constexpr int ML_VT = ML_KT + 128 * 144;
constexpr int ML_CB = ML_VT + 128 * 144;
constexpr int ML_HB = ML_CB + 128 * 272;
constexpr int ML_SM = ML_HB + 64 * 132 * 4;
static_assert(ML_SM + 528 * 4 <= LDS_BYTES, "lds");

DI void mlstm_item(const Params& p, int l, int b, int head, unsigned char* smem) {
  const int tid = otid(), lane = tid & 63, w = tid >> 6, r = lane & 31, h = lane >> 5;
  const bool prompt = b < 32;
  const int bs = b - 32;
  const int T = prompt ? 2048 : 32;
  const int nch = prompt ? 32 : 1;
  const int L = prompt ? 64 : 32;
  const int tokbase = prompt ? b * 2048 : TOKP + bs * 32;
  const u16* qkT = prompt ? (const u16*)(p.ws + WS_MQKT_P) + (size_t)b * 1024 * 2048 : (const u16*)(p.ws + WS_MQKT_S) + (size_t)bs * 1024 * 32;
  const u16* vTg = prompt ? (const u16*)(p.ws + WS_MVT_P) + (size_t)b * 512 * 2048 : (const u16*)(p.ws + WS_MVT_S) + (size_t)bs * 512 * 32;
  u16* qs = (u16*)(smem + ML_QS);
  u16* ksm = (u16*)(smem + ML_KS);
  u16* kTw = (u16*)(smem + ML_KT);
  u16* vT = (u16*)(smem + ML_VT);
  u16* Cbf = (u16*)(smem + ML_CB);
  float* hbuf = (float*)(smem + ML_HB);
  float* a_s = (float*)(smem + ML_SM);
  float* mx_s = a_s + 64;
  float* ws_s = a_s + 128;
  float* wi_s = a_s + 192;
  float* emt_s = a_s + 256;
  float* nq_s = a_s + 320;
  float* nvec = a_s + 384;
  float* scal = a_s + 512;

  const int vt = w & 3, kt0 = (w >> 2) * 2;
  f32x16 accC[2];
  float m_run = 0.f;
  if (prompt) {
    zero16(accC[0]); zero16(accC[1]);
    if (tid < 128) nvec[tid] = 0.f;
  } else {
    const float* Cs = p.in[6] + ((size_t)(l * 8 + bs) * 4 + head) * 128 * 128;
#pragma unroll
    for (int q = 0; q < 2; ++q)
#pragma unroll
      for (int g = 0; g < 4; ++g) {
        const float4 c4 = *(const float4*)(Cs + (size_t)(vt * 32 + r) * 128 + (kt0 + q) * 32 + 8 * g + 4 * h);
        accC[q][4 * g] = c4.x; accC[q][4 * g + 1] = c4.y; accC[q][4 * g + 2] = c4.z; accC[q][4 * g + 3] = c4.w;
      }
    if (tid < 128) nvec[tid] = p.in[7][((size_t)(l * 8 + bs) * 4 + head) * 128 + tid];
    m_run = p.in[8][(l * 8 + bs) * 4 + head];
  }
#pragma unroll
  for (int q = 0; q < 2; ++q)
#pragma unroll
    for (int g = 0; g < 4; ++g) {
      uint2 o; o.x = pack2(accC[q][4 * g], accC[q][4 * g + 1]); o.y = pack2(accC[q][4 * g + 2], accC[q][4 * g + 3]);
      *(uint2*)(Cbf + (vt * 32 + r) * 136 + (kt0 + q) * 32 + 8 * g + 4 * h) = o;
    }
  const float* gatesp = (const float*)(p.ws + WS_GATES);
  const int vi = w >> 1, ti = w & 1;

  float ig_n = -INFINITY, fg_n = 0.f;
  if (w == 0 && lane < L) {
    const float* gp = gatesp + (size_t)(tokbase + lane) * 8;
    ig_n = gp[head]; fg_n = gp[4 + head];
  }
  for (int c = 0; c < nch; ++c) {
    const int t0 = c * 64;
    if (w == 0) {
      const int t = lane;
      float ig = -INFINITY, lf = 0.f;
      if (t < L) {
        ig = ig_n;
        const float fg = fg_n;
        lf = fminf(fg, 0.f) - log1pf(__expf(-fabsf(fg)));
        if (c + 1 < nch) {
          const float* gp = gatesp + (size_t)(tokbase + t0 + 64 + t) * 8;
          ig_n = gp[head]; fg_n = gp[4 + head];
        }
      }
      float bc = lf;
#pragma unroll
      for (int off = 1; off < 64; off <<= 1) { const float v = shidx(bc, lane - off, lane); if (lane >= off) bc += v; }
      const float a = ig - bc;
      float M = a;
#pragma unroll
      for (int off = 1; off < 64; off <<= 1) { const float v = shidx(M, lane - off, lane); if (lane >= off) M = fmaxf(M, v); }
      const float mx = fmaxf(m_run, M);
      const float bL = shidx(bc, 63, lane);
      const float mxL = shidx(mx, 63, lane);
      a_s[t] = a; mx_s[t] = mx;
      ws_s[t] = __expf(a - mxL);
      wi_s[t] = __expf(m_run - mx);
      emt_s[t] = __expf(-(bc + mx));
      if (lane == 0) scal[1] = __expf(m_run - mxL);
      m_run = bL + mxL;
    }
    const int ch2 = tid >> 1, th = tid & 1;
    const bool isk = ch2 >= 128;
    const int dd = ch2 & 127;
    const int ch = (isk ? 512 : 0) + head * 128 + dd;
    const u16* rp = qkT + (size_t)ch * T + t0 + th * 32;
    float um3 = 0.f, um2 = 0.f, um1 = 0.f;
    const bool ldrow = prompt || th == 0;
    uint4 uu0 = make_uint4(0, 0, 0, 0), uu1 = uu0, uu2 = uu0, uu3 = uu0, vv0 = uu0, vv1 = uu0;
    if (ldrow) { uu0 = *(const uint4*)(rp); uu1 = *(const uint4*)(rp + 8); uu2 = *(const uint4*)(rp + 16); uu3 = *(const uint4*)(rp + 24); }
    {
      const int row = tid >> 3, cc = tid & 7;
      if (prompt || cc < 4) {
        vv0 = *(const uint4*)(vTg + (size_t)(head * 128 + row) * T + t0 + cc * 8);
        vv1 = *(const uint4*)(vTg + (size_t)(head * 128 + row + 64) * T + t0 + cc * 8);
      }
    }
    if (prompt) {
      if (th == 1 || c > 0) {
        const uint2 pv = *(const uint2*)(rp - 4);
        um3 = bfhi(pv.x); um2 = bflo(pv.y); um1 = bfhi(pv.y);
      }
    } else if (th == 0) {
      const float* cvp = p.in[9] + (size_t)(l * 8 + bs) * 3 * 1024 + ch;
      um3 = cvp[0]; um2 = cvp[1024]; um1 = cvp[2048];
    }
    const float cw0 = p.in[14][(l * 4 + 0) * 1024 + ch], cw1 = p.in[14][(l * 4 + 1) * 1024 + ch];
    const float cw2 = p.in[14][(l * 4 + 2) * 1024 + ch], cw3 = p.in[14][(l * 4 + 3) * 1024 + ch];
    const float cb = p.in[15][l * 1024 + ch];
    __syncthreads();
    {
      u16* dstrm = (isk ? ksm : qs) + (th * 32) * 136 + dd;
      const float oscale = isk ? 0.08838834764831845f : 1.f;
#pragma unroll
      for (int i = 0; i < 4; ++i) {
        const uint4 uu = (i == 0) ? uu0 : (i == 1 ? uu1 : (i == 2 ? uu2 : uu3));
        float u[8];
        u[0] = bflo(uu.x); u[1] = bfhi(uu.x); u[2] = bflo(uu.y); u[3] = bfhi(uu.y);
        u[4] = bflo(uu.z); u[5] = bfhi(uu.z); u[6] = bflo(uu.w); u[7] = bfhi(uu.w);
        float y[8];
#pragma unroll
        for (int e = 0; e < 8; ++e) {
          const float x3 = (e >= 3) ? u[e - 3] : (e == 0 ? um3 : (e == 1 ? um2 : um1));
          const float x2 = (e >= 2) ? u[e - 2] : (e == 0 ? um2 : um1);
          const float x1 = (e >= 1) ? u[e - 1] : um1;
          const float yy = cb + cw0 * x3 + cw1 * x2 + cw2 * x1 + cw3 * u[e];
          y[e] = siluf_(yy) * oscale;
        }
        um3 = u[5]; um2 = u[6]; um1 = u[7];
#pragma unroll
        for (int e = 0; e < 8; ++e) dstrm[(i * 8 + e) * 136] = f2bf(y[e]);
        if (isk) {
          const float4 w0 = *(const float4*)(ws_s + th * 32 + i * 8);
          const float4 w1 = *(const float4*)(ws_s + th * 32 + i * 8 + 4);
          uint4 o;
          o.x = pack2(y[0] * w0.x, y[1] * w0.y); o.y = pack2(y[2] * w0.z, y[3] * w0.w);
          o.z = pack2(y[4] * w1.x, y[5] * w1.y); o.w = pack2(y[6] * w1.z, y[7] * w1.w);
          *(uint4*)(kTw + dd * 72 + th * 32 + i * 8) = o;
        }
      }
      {
        const int row = tid >> 3, cc = tid & 7;
        *(uint4*)(vT + row * 72 + cc * 8) = vv0;
        *(uint4*)(vT + (row + 64) * 72 + cc * 8) = vv1;
      }
    }
    __syncthreads();
    {
      const int t = tid >> 3, part = tid & 7;
      const uint4 q0 = *(const uint4*)(qs + t * 136 + part * 16);
      const uint4 q1 = *(const uint4*)(qs + t * 136 + part * 16 + 8);
      const float* nv = nvec + part * 16;
      float s = bflo(q0.x) * nv[0] + bfhi(q0.x) * nv[1] + bflo(q0.y) * nv[2] + bfhi(q0.y) * nv[3]
              + bflo(q0.z) * nv[4] + bfhi(q0.z) * nv[5] + bflo(q0.w) * nv[6] + bfhi(q0.w) * nv[7]
              + bflo(q1.x) * nv[8] + bfhi(q1.x) * nv[9] + bflo(q1.y) * nv[10] + bfhi(q1.y) * nv[11]
              + bflo(q1.z) * nv[12] + bfhi(q1.z) * nv[13] + bflo(q1.w) * nv[14] + bfhi(q1.w) * nv[15];
      s += shx(s, 1, lane); s += shx(s, 2, lane); s += shx(s, 4, lane);
      if (part == 0) nq_s[t] = s;
    }
    f32x16 accS[2], accO;
    zero16(accS[0]); zero16(accS[1]); zero16(accO);
    {
#pragma unroll
      for (int ks = 0; ks < 8; ++ks) {
        const bf16x8 qfr = *(const bf16x8*)(qs + (ti * 32 + r) * 136 + ks * 16 + h * 8);
        const bf16x8 k0 = *(const bf16x8*)(ksm + r * 136 + ks * 16 + h * 8);
        accS[0] = MFMA(k0, qfr, accS[0]);
        if (ti == 1) {
          const bf16x8 k1 = *(const bf16x8*)(ksm + (32 + r) * 136 + ks * 16 + h * 8);
          accS[1] = MFMA(k1, qfr, accS[1]);
        }
        const bf16x8 cf = *(const bf16x8*)(Cbf + (vi * 32 + r) * 136 + ks * 16 + h * 8);
        accO = MFMA(cf, qfr, accO);
      }
    }
    const int tcol = ti * 32 + r;
    const float mxt = mx_s[tcol];
    const float wit = wi_s[tcol];
    float dsum = 0.f;
#pragma unroll
    for (int sub = 0; sub < 2; ++sub) {
      if (sub <= ti) {
#pragma unroll
        for (int g = 0; g < 4; ++g) {
          const float4 a4 = *(const float4*)(a_s + sub * 32 + 8 * g + 4 * h);
          const float av[4] = {a4.x, a4.y, a4.z, a4.w};
#pragma unroll
          for (int e = 0; e < 4; ++e) {
            const int s = sub * 32 + 8 * g + 4 * h + e;
            const float wgt = (s <= tcol) ? __expf(av[e] - mxt) : 0.f;
            const float pv = accS[sub][4 * g + e] * wgt;
            accS[sub][4 * g + e] = pv;
            dsum += pv;
          }
        }
      }
    }
    dsum += shx(dsum, 32, lane);
#pragma unroll
    for (int i = 0; i < 16; ++i) accO[i] *= wit;
#pragma unroll
    for (int sub = 0; sub < 2; ++sub) {
      if (sub <= ti) {
#pragma unroll
        for (int s2 = 0; s2 < 2; ++s2) {
          const bf16x8 pf = pack8(accS[sub], s2);
          const u16* va = vT + (vi * 32 + r) * 72 + sub * 32 + s2 * 16 + 4 * h;
          const uint2 lo = *(const uint2*)va;
          const uint2 hi = *(const uint2*)(va + 8);
          const uint4 vq = make_uint4(lo.x, lo.y, hi.x, hi.y);
          accO = MFMA(__builtin_bit_cast(bf16x8, vq), pf, accO);
        }
      }
    }
    __syncthreads();
    {
      const float den = dsum + wit * nq_s[tcol];
      const float dn = fmaxf(fabsf(den), emt_s[tcol]);
      const float rinv = __builtin_amdgcn_rcpf(dn);
#pragma unroll
      for (int g = 0; g < 4; ++g)
        *(float4*)(hbuf + tcol * 132 + vi * 32 + 8 * g + 4 * h) =
            make_float4(accO[4 * g] * rinv, accO[4 * g + 1] * rinv, accO[4 * g + 2] * rinv, accO[4 * g + 3] * rinv);
    }
    {
      const float wc = scal[1];
#pragma unroll
      for (int q = 0; q < 2; ++q)
#pragma unroll
        for (int i = 0; i < 16; ++i) accC[q][i] *= wc;
#pragma unroll
      for (int k4 = 0; k4 < 4; ++k4) {
        const bf16x8 vf = *(const bf16x8*)(vT + (vt * 32 + r) * 72 + k4 * 16 + h * 8);
#pragma unroll
        for (int q = 0; q < 2; ++q) {
          const bf16x8 kf = *(const bf16x8*)(kTw + ((kt0 + q) * 32 + r) * 72 + k4 * 16 + h * 8);
          accC[q] = MFMA(kf, vf, accC[q]);
        }
      }
#pragma unroll
      for (int q = 0; q < 2; ++q)
#pragma unroll
        for (int g = 0; g < 4; ++g) {
          uint2 o; o.x = pack2(accC[q][4 * g], accC[q][4 * g + 1]); o.y = pack2(accC[q][4 * g + 2], accC[q][4 * g + 3]);
          *(uint2*)(Cbf + (vt * 32 + r) * 136 + (kt0 + q) * 32 + 8 * g + 4 * h) = o;
        }
      if (tid < 128) {
        float s = 0.f;
#pragma unroll
        for (int i = 0; i < 8; ++i) {
          const uint4 kk = *(const uint4*)(kTw + tid * 72 + i * 8);
          s += bflo(kk.x) + bfhi(kk.x) + bflo(kk.y) + bfhi(kk.y) + bflo(kk.z) + bfhi(kk.z) + bflo(kk.w) + bfhi(kk.w);
        }
        nvec[tid] = wc * nvec[tid] + s;
      }
    }
    __syncthreads();
    {
      const int t = tid >> 3, part = tid & 7;
      float x[16];
#pragma unroll
      for (int i = 0; i < 4; ++i) {
        const float4 f = *(const float4*)(hbuf + t * 132 + part * 16 + i * 4);
        x[i * 4] = f.x; x[i * 4 + 1] = f.y; x[i * 4 + 2] = f.z; x[i * 4 + 3] = f.w;
      }
      float s = 0.f;
#pragma unroll
      for (int i = 0; i < 16; ++i) s += x[i];
      s += shx(s, 1, lane); s += shx(s, 2, lane); s += shx(s, 4, lane);
      const float mean = s * (1.f / 128.f);
      float q = 0.f;
#pragma unroll
      for (int i = 0; i < 16; ++i) { x[i] -= mean; q += x[i] * x[i]; }
      q += shx(q, 1, lane); q += shx(q, 2, lane); q += shx(q, 4, lane);
      const float rstd = rsqrtf(q * (1.f / 128.f) + LN_EPS);
      if (t < L) {
        const size_t tok = (size_t)tokbase + t0 + t;
        const int cbase = head * 128 + part * 16;
        const float* gw = p.in[18] + l * 512 + cbase;
        const u16* mo = (const u16*)(p.ws + WS_MO) + tok * 512 + cbase;
        const uint4 m0 = *(const uint4*)mo;
        const uint4 m1 = *(const uint4*)(mo + 8);
        const float sg[16] = {bflo(m0.x), bfhi(m0.x), bflo(m0.y), bfhi(m0.y), bflo(m0.z), bfhi(m0.z), bflo(m0.w), bfhi(m0.w),
                              bflo(m1.x), bfhi(m1.x), bflo(m1.y), bfhi(m1.y), bflo(m1.z), bfhi(m1.z), bflo(m1.w), bfhi(m1.w)};
        float yv[16];
#pragma unroll
        for (int i = 0; i < 16; ++i) yv[i] = x[i] * rstd * gw[i] * sg[i];
        uint4 o0, o1;
        o0.x = pack2(yv[0], yv[1]); o0.y = pack2(yv[2], yv[3]); o0.z = pack2(yv[4], yv[5]); o0.w = pack2(yv[6], yv[7]);
        o1.x = pack2(yv[8], yv[9]); o1.y = pack2(yv[10], yv[11]); o1.z = pack2(yv[12], yv[13]); o1.w = pack2(yv[14], yv[15]);
        u16* mn = (u16*)(p.ws + WS_MN) + tok * 512 + cbase;
        *(uint4*)mn = o0;
        *(uint4*)(mn + 8) = o1;
      }
    }
  }
  {
    float* oc = p.out + (prompt ? O_CP + ((size_t)(l * 32 + b) * 4 + head) * 16384 : O_CS + ((size_t)(l * 8 + bs) * 4 + head) * 16384);
#pragma unroll
    for (int q = 0; q < 2; ++q)
#pragma unroll
      for (int g = 0; g < 4; ++g)
        *(float4*)(oc + (size_t)(vt * 32 + r) * 128 + (kt0 + q) * 32 + 8 * g + 4 * h) =
            make_float4(accC[q][4 * g], accC[q][4 * g + 1], accC[q][4 * g + 2], accC[q][4 * g + 3]);
    float* on = p.out + (prompt ? O_NP + ((size_t)(l * 32 + b) * 4 + head) * 128 : O_NS + ((size_t)(l * 8 + bs) * 4 + head) * 128);
    if (tid < 128) on[tid] = nvec[tid];
    if (tid == 0) {
      if (prompt) p.out[O_MP + (size_t)(l * 32 + b) * 4 + head] = m_run;
      else p.out[O_MS + (size_t)(l * 8 + bs) * 4 + head] = m_run;
    }
  }
}

DI void phase_mixers(const Params& p, int l, unsigned char* smem) {
  const int tid0 = otid();
  const int lane = tid0 & 63;
  const float* lp = p.in[16] + l * 256;
  float s1 = lp[lane] * lp[64 + lane], s2 = lp[128 + lane] * lp[192 + lane];
  s1 = wave_sum(s1, lane); s2 = wave_sum(s2, lane);
  const float lam_init = 0.8f - 0.6f * expf(-0.3f * (float)l);
  const float lam = expf(s1) - expf(s2) + lam_init;
  int* ctr = (int*)(p.ws + WS_CTR) + l;
  int* sitem = (int*)smem;
  const int N_ML = 160, N_AT = 2048 + 32;
  for (;;) {
    __syncthreads();
    if (tid0 == 0) *sitem = atomicAdd(ctr, 1);
    __syncthreads();
    const int item = *sitem;
    if (item >= N_ML + N_AT) break;
    if (item < N_ML) {
#ifndef NO_ML
      mlstm_item(p, l, item >> 2, item & 3, smem);
#endif
    } else {
#ifndef NO_AT
      const int a = item - N_ML;
      if (a >= 32) {
        const int a2 = a - 32;
        const int qt = 15 - (a2 >> 7), rest = a2 & 127;
        attn_item(p, l, rest >> 2, rest & 3, qt, lam, lam_init, smem);
      } else {
        attn_item(p, l, 32 + (a >> 2), a & 3, 0, lam, lam_init, smem);
      }
#endif
    }
  }
}

DI void gbar(unsigned* ctl, unsigned& k) {
  __syncthreads();
  ++k;
  if (otid() == 0) {
    __threadfence();
    const unsigned x = blockIdx.x & 7;
    const unsigned gsz = (gridDim.x + 7 - x) >> 3;
    const unsigned ngroups = gridDim.x < 8 ? gridDim.x : 8;
    unsigned* gc = ctl + 64 + x * 32;
    unsigned* gl = ctl + 32;
    const unsigned old = __hip_atomic_fetch_add(gc, 1u, __ATOMIC_RELAXED, __HIP_MEMORY_SCOPE_AGENT);
    if (old + 1 == k * gsz) {
      __threadfence();
      __hip_atomic_fetch_add(gl, 1u, __ATOMIC_RELAXED, __HIP_MEMORY_SCOPE_AGENT);
    }
    while (__hip_atomic_load(gl, __ATOMIC_RELAXED, __HIP_MEMORY_SCOPE_AGENT) < k * ngroups) __builtin_amdgcn_s_sleep(1);
    __threadfence();
  }
  __syncthreads();
}

__global__ void __launch_bounds__(NTHR) fwd_megakernel(Params p) {
  extern __shared__ __attribute__((aligned(16))) unsigned char smem[];
  cg::grid_group grid = cg::this_grid();
#ifndef PH
#define PH 0xffff
#endif
  unsigned* bar = (unsigned*)(p.ws + WS_CTR);
  unsigned epoch = 0;
  if (PH & 1) prologue(p, smem);
  grid.sync();
  if (PH & 1) prologue(p, smem);
  grid.sync();
  if (PH & 2) ln_pass(p, 0, 0, smem);
  gbar(bar, epoch);
#pragma unroll 1
  for (int l = 0; l < 2; ++l) {
    if (PH & 4) phase_in_gate(p, l, smem);
    gbar(bar, epoch);
    if (PH & 8) phase_mixers(p, l, smem);
    gbar(bar, epoch);
    if (PH & 16) phase_mix(p, l, smem);
    gbar(bar, epoch);
    if (PH & 32) phase_res(p, l, 0, smem);
    gbar(bar, epoch);
    if (PH & 64) ln_pass(p, 1, l, smem);
    gbar(bar, epoch);
    if (PH & 128) phase_gu(p, l, smem);
    gbar(bar, epoch);
    if (PH & 256) phase_res(p, l, 1, smem);
    gbar(bar, epoch);
    if (PH & 512) ln_pass(p, 2, l, smem);
    if (l == 0) gbar(bar, epoch);
  }
}

extern "C" void kernel_launch(void* const* d_in, const int* in_sizes, int n_in, void* d_out, int out_size, void* d_ws,
                              size_t ws_size, hipStream_t stream) {
  static int grid_blocks = 0;
  if (!grid_blocks) {
    int dev = 0, cus = 0, per_cu = 0;
    hipGetDevice(&dev);
    hipDeviceGetAttribute(&cus, hipDeviceAttributeMultiprocessorCount, dev);
    if (hipFuncSetAttribute((const void*)fwd_megakernel, hipFuncAttributeMaxDynamicSharedMemorySize, LDS_BYTES) != hipSuccess)
      fprintf(stderr, "kernel_launch: hipFuncSetAttribute failed\n");
    if (hipOccupancyMaxActiveBlocksPerMultiprocessor(&per_cu, (const void*)fwd_megakernel, NTHR, LDS_BYTES) != hipSuccess || per_cu < 1) {
      fprintf(stderr, "kernel_launch: occupancy query gave %d\n", per_cu);
      per_cu = 1;
    }
    (void)hipGetLastError();
    grid_blocks = cus * per_cu;
    if (ws_size < WS_END) fprintf(stderr, "kernel_launch: workspace too small: %zu < %zu\n", ws_size, (size_t)WS_END);
  }
  if (hipMemsetAsync((char*)d_ws + WS_CTR, 0, 4096, stream) != hipSuccess) fprintf(stderr, "kernel_launch: memset failed\n");
  Params p{};
  for (int i = 0; i < 30; ++i) p.in[i] = (const float*)d_in[i];
  p.out = (float*)d_out;
  p.ws = (unsigned char*)d_ws;
  void* args[] = {&p};
  hipError_t e = hipLaunchCooperativeKernel((const void*)fwd_megakernel, dim3(grid_blocks), dim3(NTHR), args, LDS_BYTES, stream);
  if (e != hipSuccess) fprintf(stderr, "cooperative launch failed: %s (grid %d)\n", hipGetErrorString(e), grid_blocks);
}
```
